# Optimizing an MI355X kernel written in HIP

```python
import math, functools
import jax, jax.numpy as jnp
from jax import lax
import numpy as np

D_MODEL = 1024
BATCH = 2
SEQ = 8192
DEPTH = 2

GRID_W = 64
CTX_LEN = 256
N_MIXERS = 2

HG_EXPAND = 128
HG_HEADS = D_MODEL // HG_EXPAND
HG_FK = HG_HEADS * HG_EXPAND
HG_DV = D_MODEL // HG_HEADS
HG_CHUNK = 64

RW_HEAD = 64
RW_HEADS = D_MODEL // RW_HEAD
RW_DECAY_LORA = 64
RW_ICLR_LORA = 64
RW_GATE_LORA = 128
RW_LNX_EPS = 1e-5 * RW_HEAD

N_EXPERTS = 32
TOP_K = 4
D_EXPERT = D_MODEL
SWIGLU_LIMIT = 7.0
SWIGLU_ALPHA = 1.702
MOE_BLOCK = 256

NORM_EPS = 1e-6

kernel_name = 'hybrid_hgrn2_rwkv7_moe_diffusion_trunk'


def _rmsnorm(x, g):
    xf = x.astype(jnp.float32)
    y = xf * lax.rsqrt(jnp.mean(xf * xf, axis=-1, keepdims=True) + NORM_EPS)
    return y.astype(x.dtype) * g


def _modulate(h, shift, scale):
    return h * (1 + scale) + shift


def _flip(a, rev):
    return jnp.flip(a, axis=1) if rev else a


def _gla_chunk_scan(q, k, v, logf, s0, with_output):
    bsz, t, nh, dk = k.shape
    dv = v.shape[-1]
    n = t // HG_CHUNK

    def chunks(a):
        return jnp.moveaxis(a.reshape(bsz, n, HG_CHUNK, nh, a.shape[-1]), 1, 0)

    causal = jnp.tril(jnp.ones((HG_CHUNK, HG_CHUNK), dtype=bool))[None, :, :, None, None]

    def step(state, inp):
        kc, vc, gc = inp[0], inp[1], inp[2]
        b = jnp.cumsum(gc, axis=1)
        b_end = b[:, -1]
        k_to_end = kc * jnp.exp(b_end[:, None] - b)
        state_new = jnp.exp(b_end)[..., None] * state + jnp.einsum('bshk,bshv->bhkv', k_to_end, vc)
        if not with_output:
            return state_new, None
        qc = inp[3]
        o_inter = jnp.einsum('bthk,bhkv->bthv', qc * jnp.exp(b), state)
        rel = jnp.exp(jnp.where(causal, b[:, :, None] - b[:, None], -jnp.inf))
        scores = jnp.einsum('bthk,bshk,btshk->bths', qc, kc, rel)
        o = o_inter + jnp.einsum('bths,bshv->bthv', scores, vc)
        return state_new, o

    seq = (k, v, logf) + ((q,) if with_output else ())
    state, o = lax.scan(step, s0, tuple(chunks(a) for a in seq))
    if with_output:
        o = jnp.moveaxis(o, 0, 1).reshape(bsz, t, nh, dv)
    return o, state


def _hgrn2_project(h, w_in, lb, readout):
    f32 = jnp.float32
    z = h @ w_in
    q, f_f, f_b, i, g = jnp.split(z, [HG_FK, 2 * HG_FK, 3 * HG_FK, 3 * HG_FK + D_MODEL], axis=-1)

    def heads(a, d):
        return a.reshape(a.shape[:2] + (HG_HEADS, d)).astype(f32)

    dirs = []
    for f, lbd in ((f_f, lb[0]), (f_b, lb[1])):
        fh = heads(f, HG_EXPAND)
        lbh = lbd.reshape(HG_HEADS, HG_EXPAND)
        logf = jnp.logaddexp(jnp.log(lbh), jnp.log1p(-lbh) + jax.nn.log_sigmoid(fh))
        kin = (1 - lbh) * jax.nn.sigmoid(-fh)
        dirs.append((kin, logf))
    qh = heads(jax.nn.silu(q), HG_EXPAND) if readout else None
    return qh, heads(i, HG_DV), (g if readout else None), dirs


def _hgrn2_readout(o, g, gnorm_w, w_out, dtype):
    gh = g.reshape(g.shape[:2] + (HG_HEADS, HG_DV)).astype(jnp.float32)
    o = _rmsnorm(o, gnorm_w.astype(jnp.float32)) * jax.nn.silu(gh)
    return o.reshape(o.shape[:2] + (D_MODEL,)).astype(dtype) @ w_out


def _hgrn2_mixer(h_lat, h_ctx, w_in, gnorm_w, w_out, lb, ctx_out):
    q_l, v_l, g_l, dirs_l = _hgrn2_project(h_lat, w_in, lb, True)
    q_c, v_c, g_c, dirs_c = _hgrn2_project(h_ctx, w_in, lb, ctx_out)
    s0 = jnp.zeros((h_lat.shape[0], HG_HEADS, HG_EXPAND, HG_DV), jnp.float32)
    o_l = 0.0
    o_c = 0.0
    for d, rev in enumerate((False, True)):
        (k_c, lf_c), (k_l, lf_l) = dirs_c[d], dirs_l[d]
        oc, s_ctx = _gla_chunk_scan(_flip(q_c, rev) if ctx_out else None, _flip(k_c, rev),
                                    _flip(v_c, rev), _flip(lf_c, rev), s0, ctx_out)
        ol, _ = _gla_chunk_scan(_flip(q_l, rev), _flip(k_l, rev), _flip(v_l, rev),
                                _flip(lf_l, rev), s_ctx, True)
        o_l = o_l + _flip(ol, rev)
        if ctx_out:
            o_c = o_c + _flip(oc, rev)
    y_l = _hgrn2_readout(o_l, g_l, gnorm_w, w_out, h_lat.dtype)
    y_c = _hgrn2_readout(o_c, g_c, gnorm_w, w_out, h_ctx.dtype) if ctx_out else None
    return y_l, y_c


def _shift_grid(h, rows):
    bsz, t, d = h.shape
    g = h.reshape(bsz, rows, GRID_W, d)
    c = d // 4
    left = jnp.pad(g[:, :, :-1, :c], ((0, 0), (0, 0), (1, 0), (0, 0)))
    right = jnp.pad(g[:, :, 1:, c:2 * c], ((0, 0), (0, 0), (0, 1), (0, 0)))
    up = jnp.pad(g[:, :-1, :, 2 * c:3 * c], ((0, 0), (1, 0), (0, 0), (0, 0)))
    down = jnp.pad(g[:, 1:, :, 3 * c:], ((0, 0), (0, 1), (0, 0), (0, 0)))
    return jnp.concatenate([left, right, up, down], axis=-1).reshape(bsz, t, d)


def _shift_seq(h):
    c = h.shape[-1] // 2
    prev = jnp.pad(h[:, :-1, :c], ((0, 0), (1, 0), (0, 0)))
    nxt = jnp.pad(h[:, 1:, c:], ((0, 0), (0, 1), (0, 0)))
    return jnp.concatenate([prev, nxt], axis=-1)


def _rwkv7_project(h, h_shift, mu, w_rkv, dec_w0, dec_w1, dec_w2, iclr_a0, iclr_a1, iclr_a2,
                   g1, g2, k_k, k_a, readout):
    f32 = jnp.float32

    def heads(a):
        return a.reshape(a.shape[:2] + (RW_HEADS, RW_HEAD)).astype(f32)

    dx = h_shift - h

    def lerp(j):
        return h + dx * mu[j]

    xw, xk, xv, xa = lerp(1), lerp(2), lerp(3), lerp(4)
    k = (xk @ w_rkv[1]).astype(f32)
    v = heads(xv @ w_rkv[2])
    kk = heads(k * k_k)
    kk = kk / jnp.maximum(jnp.sqrt(jnp.sum(kk * kk, axis=-1, keepdims=True)), 1e-12)
    dirs = []
    for d in range(2):
        w_log = -jax.nn.softplus(-(dec_w0[d] + jnp.tanh(xw @ dec_w1[d]) @ dec_w2[d]).astype(f32)) - 0.5
        decay = jnp.exp(-jnp.exp(w_log))
        a = jax.nn.sigmoid((iclr_a0[d] + (xa @ iclr_a1[d]) @ iclr_a2[d]).astype(f32))
        k_dir = k * (1 + (a - 1) * k_a)
        dirs.append((heads(decay), heads(a), heads(k_dir)))
    if readout:
        r = heads(lerp(0) @ w_rkv[0])
        g = jax.nn.sigmoid(lerp(5) @ g1) @ g2
    else:
        r, g = None, None
    return r, v, kk, g, dirs


def _rwkv7_scan(r, decay, k, v, kk, a, s0, with_output):
    def step(state, inp):
        w_t, k_t, v_t, kk_t, a_t = inp[0], inp[1], inp[2], inp[3], inp[4]
        sa = jnp.einsum('bhvk,bhk->bhv', state, kk_t)
        state = (state * w_t[:, :, None, :] - sa[..., None] * (kk_t * a_t)[:, :, None, :]
                 + v_t[..., None] * k_t[:, :, None, :])
        if not with_output:
            return state, None
        return state, jnp.einsum('bhvk,bhk->bhv', state, inp[5])

    seq = (decay, k, v, kk, a) + ((r,) if with_output else ())
    state, y = lax.scan(step, s0, tuple(jnp.moveaxis(t, 1, 0) for t in seq), unroll=4)
    if with_output:
        y = jnp.moveaxis(y, 0, 1)
    return y, state


def _rwkv7_readout(y, r, v, k_dirs, g, r_k, lnx_w, lnx_b, w_out, dtype):
    mean = jnp.mean(y, axis=-1, keepdims=True)
    var = jnp.mean(jnp.square(y - mean), axis=-1, keepdims=True)
    yn = (y - mean) * lax.rsqrt(var + RW_LNX_EPS)
    yn = yn * lnx_w.reshape(RW_HEADS, RW_HEAD) + lnx_b.reshape(RW_HEADS, RW_HEAD)
    for kd in k_dirs:
        yn = yn + jnp.sum(r * kd * r_k, axis=-1, keepdims=True) * v
    out = yn.reshape(y.shape[:2] + (D_MODEL,)).astype(dtype) * g
    return out @ w_out


def _rwkv7_mixer(h_lat, h_ctx, rows, mu, w_rkv, dec_w0, dec_w1, dec_w2, iclr_a0, iclr_a1, iclr_a2,
                 g1, g2, k_k, k_a, r_k, lnx_w, lnx_b, w_out, ctx_out):
    p = (mu, w_rkv, dec_w0, dec_w1, dec_w2, iclr_a0, iclr_a1, iclr_a2, g1, g2, k_k, k_a)
    r_l, v_l, kk_l, g_l, dirs_l = _rwkv7_project(h_lat, _shift_grid(h_lat, rows), *p, True)
    r_c, v_c, kk_c, g_c, dirs_c = _rwkv7_project(h_ctx, _shift_seq(h_ctx), *p, ctx_out)
    s0 = jnp.zeros((h_lat.shape[0], RW_HEADS, RW_HEAD, RW_HEAD), jnp.float32)
    y_l = 0.0
    y_c = 0.0
    for d, rev in enumerate((False, True)):
        (dec_c, a_c, k_c), (dec_l, a_l, k_l) = dirs_c[d], dirs_l[d]
        yc, s_ctx = _rwkv7_scan(_flip(r_c, rev) if ctx_out else None, _flip(dec_c, rev), _flip(k_c, rev),
                                _flip(v_c, rev), _flip(kk_c, rev), _flip(a_c, rev), s0, ctx_out)
        yl, _ = _rwkv7_scan(_flip(r_l, rev), _flip(dec_l, rev), _flip(k_l, rev), _flip(v_l, rev),
                            _flip(kk_l, rev), _flip(a_l, rev), s_ctx, True)
        y_l = y_l + _flip(yl, rev)
        if ctx_out:
            y_c = y_c + _flip(yc, rev)
    out_l = _rwkv7_readout(y_l, r_l, v_l, [dd[2] for dd in dirs_l], g_l, r_k, lnx_w, lnx_b, w_out, h_lat.dtype)
    out_c = (_rwkv7_readout(y_c, r_c, v_c, [dd[2] for dd in dirs_c], g_c, r_k, lnx_w, lnx_b, w_out, h_ctx.dtype)
             if ctx_out else None)
    return out_l, out_c


def _moe(tokens, router_w, router_b, w_gu, b_gu, w_down, b_down):
    n, d = tokens.shape
    logits = (tokens @ router_w + router_b).astype(jnp.float32)
    top_val, top_idx = lax.top_k(logits, TOP_K)
    gates = jax.nn.softmax(top_val, axis=-1).astype(tokens.dtype)
    flat_e = top_idx.reshape(-1)
    flat_tok = jnp.repeat(jnp.arange(n, dtype=jnp.int32), TOP_K)
    order = jnp.argsort(flat_e, stable=True)
    e_sorted = flat_e[order]
    counts = jnp.bincount(flat_e, length=N_EXPERTS)
    padded = (counts + MOE_BLOCK - 1) // MOE_BLOCK * MOE_BLOCK
    padded_end = jnp.cumsum(padded)
    padded_start = padded_end - padded
    start = jnp.cumsum(counts) - counts
    dest = padded_start[e_sorted] + jnp.arange(n * TOP_K, dtype=jnp.int32) - start[e_sorted]
    n_blocks = -(-(n * TOP_K + N_EXPERTS * (MOE_BLOCK - 1)) // MOE_BLOCK)
    cap = n_blocks * MOE_BLOCK
    slot_tok = jnp.full((cap,), n, jnp.int32).at[dest].set(flat_tok[order])
    slot_gate = jnp.zeros((cap,), tokens.dtype).at[dest].set(gates.reshape(-1)[order])
    block_e = jnp.minimum(jnp.searchsorted(padded_end, jnp.arange(n_blocks) * MOE_BLOCK, side='right'),
                          N_EXPERTS - 1)
    x_pad = jnp.concatenate([tokens, jnp.zeros((1, d), tokens.dtype)], axis=0)
    xb = x_pad[slot_tok].reshape(n_blocks, MOE_BLOCK, d)

    def expert_block(args):
        xblk, e = args
        gu = xblk @ w_gu[e] + b_gu[e]
        gate, up = jnp.split(gu, 2, axis=-1)
        gate = jnp.minimum(gate, SWIGLU_LIMIT)
        up = jnp.clip(up, -SWIGLU_LIMIT, SWIGLU_LIMIT)
        act = gate * jax.nn.sigmoid(SWIGLU_ALPHA * gate) * (up + 1)
        return act @ w_down[e] + b_down[e]

    yb = lax.map(expert_block, (xb, block_e))
    y = yb.reshape(cap, d) * slot_gate[:, None]
    return jnp.zeros((n + 1, d), tokens.dtype).at[slot_tok].add(y)[:n]


def setup_inputs(seed: int = 0) -> dict:
    key = jax.random.key(seed)
    ks = iter(jax.random.split(key, 64))
    D = D_MODEL
    n_hg = (DEPTH + 1) // 2
    n_rw = DEPTH // 2

    def nrm(shape, s):
        return jax.random.normal(next(ks), shape, jnp.float32) * s

    def uni(shape, lo, hi):
        return jax.random.uniform(next(ks), shape, jnp.float32, lo, hi)

    return {
        'x': nrm((BATCH, SEQ, D), 1.0),
        'c': nrm((BATCH, D), 1.0),
        'ctx': nrm((BATCH, CTX_LEN, D), 1.0),
        'c_ctx': nrm((D,), 1.0),
        'ada_w': nrm((DEPTH, D, 6 * D), 0.5 * D ** -0.5),
        'ada_b': nrm((DEPTH, 6 * D), 0.02),
        'norm_mix_g': 1.0 + nrm((DEPTH, D), 0.1),
        'norm_ffn_g': 1.0 + nrm((DEPTH, D), 0.1),
        'hg_w_in': nrm((n_hg, D, 3 * HG_FK + 2 * D), D ** -0.5),
        'hg_gnorm_w': 1.0 + nrm((n_hg, HG_DV), 0.1),
        'hg_w_out': nrm((n_hg, D, D), D ** -0.5),
        'hg_lb': nrm((2, DEPTH + 1, HG_FK), 0.5),
        'rw_mu': uni((n_rw, 6, D), 0.0, 1.0),
        'rw_w_rkv': nrm((n_rw, 3, D, D), D ** -0.5),
        'rw_dec_w0': uni((n_rw, 2, D), -3.5, -0.5),
        'rw_dec_w1': nrm((n_rw, 2, D, RW_DECAY_LORA), D ** -0.5),
        'rw_dec_w2': nrm((n_rw, 2, RW_DECAY_LORA, D), 0.1 * RW_DECAY_LORA ** -0.5),
        'rw_iclr_a0': nrm((n_rw, 2, D), 0.5),
        'rw_iclr_a1': nrm((n_rw, 2, D, RW_ICLR_LORA), D ** -0.5),
        'rw_iclr_a2': nrm((n_rw, 2, RW_ICLR_LORA, D), 0.3 * RW_ICLR_LORA ** -0.5),
        'rw_g1': nrm((n_rw, D, RW_GATE_LORA), D ** -0.5),
        'rw_g2': nrm((n_rw, RW_GATE_LORA, D), RW_GATE_LORA ** -0.5),
        'rw_k_k': 0.85 + nrm((n_rw, D), 0.05),
        'rw_k_a': 1.0 + nrm((n_rw, D), 0.1),
        'rw_r_k': nrm((n_rw, RW_HEADS, RW_HEAD), 0.1),
        'rw_lnx_w': 1.0 + nrm((n_rw, D), 0.1),
        'rw_lnx_b': nrm((n_rw, D), 0.02),
        'rw_w_out': nrm((n_rw, D, D), D ** -0.5),
        'moe_router_w': nrm((DEPTH, D, N_EXPERTS), D ** -0.5),
        'moe_router_b': nrm((DEPTH, N_EXPERTS), 0.01),
        'moe_w_gu': nrm((DEPTH, N_EXPERTS, D, 2 * D_EXPERT), D ** -0.5),
        'moe_b_gu': nrm((DEPTH, N_EXPERTS, 2 * D_EXPERT), 0.02),
        'moe_w_down': nrm((DEPTH, N_EXPERTS, D_EXPERT, D), D_EXPERT ** -0.5),
        'moe_b_down': nrm((DEPTH, N_EXPERTS, D), 0.02),
        'final_g': 1.0 + nrm((D,), 0.1),
    }


def reference(x, c, ctx, c_ctx, ada_w, ada_b, norm_mix_g, norm_ffn_g,
              hg_w_in, hg_gnorm_w, hg_w_out, hg_lb,
              rw_mu, rw_w_rkv, rw_dec_w0, rw_dec_w1, rw_dec_w2, rw_iclr_a0, rw_iclr_a1, rw_iclr_a2,
              rw_g1, rw_g2, rw_k_k, rw_k_a, rw_r_k, rw_lnx_w, rw_lnx_b, rw_w_out,
              moe_router_w, moe_router_b, moe_w_gu, moe_b_gu, moe_w_down, moe_b_down, final_g):
    bsz, n_lat, d = x.shape
    rows = n_lat // GRID_W
    lb_all = jnp.cumsum(jax.nn.softmax(hg_lb.astype(jnp.float32), axis=1), axis=1)
    s_c = jax.nn.silu(c)
    s_cc = jax.nn.silu(c_ctx)
    xl, xc = x, ctx
    for layer in range(DEPTH):
        last = layer == DEPTH - 1
        mod_l = jnp.split((s_c @ ada_w[layer] + ada_b[layer])[:, None, :], 6, axis=-1)
        mod_c = jnp.split(s_cc @ ada_w[layer] + ada_b[layer], 6, axis=-1)
        hl = _modulate(_rmsnorm(xl, norm_mix_g[layer]), mod_l[0], mod_l[1])
        hc = _modulate(_rmsnorm(xc, norm_mix_g[layer]), mod_c[0], mod_c[1])
        j = layer // N_MIXERS
        if layer % N_MIXERS == 0:
            yl, yc = _hgrn2_mixer(hl, hc, hg_w_in[j], hg_gnorm_w[j], hg_w_out[j],
                                  lb_all[:, layer], not last)
        else:
            yl, yc = _rwkv7_mixer(hl, hc, rows, rw_mu[j], rw_w_rkv[j], rw_dec_w0[j], rw_dec_w1[j],
                                  rw_dec_w2[j], rw_iclr_a0[j], rw_iclr_a1[j], rw_iclr_a2[j],
                                  rw_g1[j], rw_g2[j], rw_k_k[j], rw_k_a[j], rw_r_k[j],
                                  rw_lnx_w[j], rw_lnx_b[j], rw_w_out[j], not last)
        xl = xl + mod_l[2] * yl
        hl = _modulate(_rmsnorm(xl, norm_ffn_g[layer]), mod_l[3], mod_l[4])
        moe_p = (moe_router_w[layer], moe_router_b[layer], moe_w_gu[layer], moe_b_gu[layer],
                 moe_w_down[layer], moe_b_down[layer])
        if last:
            xl = xl + mod_l[5] * _moe(hl.reshape(-1, d), *moe_p).reshape(hl.shape)
        else:
            xc = xc + mod_c[2] * yc
            hc = _modulate(_rmsnorm(xc, norm_ffn_g[layer]), mod_c[3], mod_c[4])
            n_l = bsz * n_lat
            out = _moe(jnp.concatenate([hl.reshape(-1, d), hc.reshape(-1, d)], axis=0), *moe_p)
            xl = xl + mod_l[5] * out[:n_l].reshape(hl.shape)
            xc = xc + mod_c[5] * out[n_l:].reshape(hc.shape)
    return _rmsnorm(xl, final_g)
```

```cpp
#include <hip/hip_runtime.h>
#include <hip/hip_cooperative_groups.h>
#include <cstdio>
#include <cstdint>
namespace pg8 {
#define PG8_LAS __attribute__((address_space(3)))
typedef unsigned short bf16_t;
typedef short bf16x8 __attribute__((ext_vector_type(8)));
typedef float f32x4 __attribute__((ext_vector_type(4)));
typedef unsigned u32x4 __attribute__((ext_vector_type(4)));
constexpr int BM = 256, BK = 64, HALF = 128, HTB = HALF * BK * 2  , STAGE_BYTES = 8 * HTB, NXCD = 8, WGM = 8;

__host__ __device__ __forceinline__ int lds_byte(int r, int c) { const int st = (r >> 4) * 2 + (c >> 5), rr = r & 15, cc = c & 31, ob = rr * 64 + cc * 2; return st * 1024 + (ob ^ (((ob >> 9) & 1) << 5)); }
__host__ __device__ __forceinline__ void stage_rc(int b, int& R, int& C) { const int st = b / 1024, sb = b % 1024, swz = sb ^ (((sb >> 9) & 1) << 5); R = (st >> 1) * 16 + swz / 64; C = (st & 1) * 32 + (swz % 64) / 2; }
__host__ __device__ __forceinline__ int perm32(int rho) { const int n = rho >> 4, i = rho & 15; return 8 * (i >> 2) + 4 * n + (i & 3); }

struct Unit { int pm, pn, e; };
struct Gemm { const bf16_t* A; const bf16_t* Bt; int M, N, K; };

struct StaticOrder {
    int nM, nN, nwg, G, c;
    __host__ __device__ void init(int M, int N, int G_, int c_) { nM = M / BM; nN = N / BM; nwg = nM * nN; G = G_; c = c_; }
    __host__ __device__ bool next(int i, Unit& u) const {
        const long L = (long)i * G + c; if (L >= nwg) return false;
        int wgid = (int)L; { const int q = nwg / NXCD, r = nwg % NXCD, xcd = wgid % NXCD, off = wgid / NXCD; wgid = (xcd < r ? xcd * (q + 1) : r * (q + 1) + (xcd - r) * q) + off; }
        const int nig = WGM * nN, gid = wgid / nig, fm = gid * WGM, gsz = (nM - fm) < WGM ? (nM - fm) : WGM;
        u.pm = fm + ((wgid % nig) % gsz); u.pn = (wgid % nig) / gsz; u.e = 0; return true;
    }
    __device__ __forceinline__ const char* abase(const Gemm& g, const Unit& u, size_t tstep) const { return (const char*)g.A + (size_t)u.pm * tstep; }
    __device__ __forceinline__ const char* bbase(const Gemm& g, const Unit& u, size_t tstep) const { return (const char*)g.Bt + (size_t)u.pn * tstep; }
    __device__ __forceinline__ void a_ready(const Unit&) const {}
    __device__ __forceinline__ void done(const Unit&) const {}
};

__device__ __forceinline__ unsigned cvt_pk_bf16(float lo, float hi) { unsigned r; asm volatile("v_cvt_pk_bf16_f32 %0, %1, %2" : "=v"(r) : "v"(lo), "v"(hi)); return r; }

template <class Epi, class Sched, bool ALIGN_EPI = false, bool SP2 = false>
__device__ __forceinline__ void gemm_phase(PG8_LAS unsigned char* lds, const Gemm g, const Sched& S, const Epi& E) {
    const int tid = threadIdx.x, wid = __builtin_amdgcn_readfirstlane(tid >> 6), lane = tid & 63, wr = wid >> 2, wc = wid & 3, fr = lane & 15, fq = lane >> 4;
    const int K = g.K, nt = K / BK;
    unsigned voffA[2], voffB[2];
#pragma unroll
    for (int i = 0; i < 2; ++i) { int R, C; stage_rc(tid * 16 + i * 8192, R, C); const int Rb = Epi::PERM ? ((R & ~31) + perm32(R & 31)) : R;
        voffA[i] = (unsigned)(R * K + C) * 2u; voffB[i] = (unsigned)(Rb * K + C) * 2u; }
    const size_t kstep = (size_t)(BK * 2);
    const size_t hstep = (size_t)HALF * K * 2;
    const size_t tstep = 2 * hstep;
    const unsigned ldsw = (unsigned)wid * 1024u;
    const int aoff = lds_byte(wr * 64 + fr, fq * 8), boff = lds_byte(wc * 32 + fr, fq * 8);
#define PG8_SA(b, h) (((b) * 2 + (h)) * HTB)
#define PG8_SB(b, h) ((4 + (b) * 2 + (h)) * HTB)
#define PG8_STAGE(bufoff, gbase, voff) do { _Pragma("unroll") for (int _i = 0; _i < 2; ++_i) \
        __builtin_amdgcn_global_load_lds((const unsigned*)((const char*)(gbase) + (voff)[_i]), (PG8_LAS unsigned*)(lds + (bufoff) + ldsw + _i * 8192), 16, 0, 0); } while (0)
#define PG8_LDA(dst, b, h) do { _Pragma("unroll") for (int m = 0; m < 4; ++m) _Pragma("unroll") for (int k = 0; k < 2; ++k) dst[m][k] = *(const PG8_LAS bf16x8*)(lds + PG8_SA(b, h) + aoff + m * 2048 + k * 1024); } while (0)
#define PG8_LDB(dst, b, h) do { _Pragma("unroll") for (int n = 0; n < 2; ++n) _Pragma("unroll") for (int k = 0; k < 2; ++k) dst[n][k] = *(const PG8_LAS bf16x8*)(lds + PG8_SB(b, h) + boff + n * 2048 + k * 1024); } while (0)
#define PG8_MMA(ai, bj, At, Bt) do { __builtin_amdgcn_s_setprio(1); _Pragma("unroll") for (int m = 0; m < 4; ++m) _Pragma("unroll") for (int n = 0; n < 2; ++n) _Pragma("unroll") for (int k = 0; k < 2; ++k) \
        acc[ai][bj][m][n] = __builtin_amdgcn_mfma_f32_16x16x32_bf16(Bt[n][k], At[m][k], acc[ai][bj][m][n], 0, 0, 0); __builtin_amdgcn_s_setprio(0); } while (0)
#define PG8_WAIT_V(n) asm volatile("s_waitcnt vmcnt(" #n ")" ::: "memory")
#define PG8_WAIT_L(n) asm volatile("s_waitcnt lgkmcnt(" #n ")" ::: "memory")
#define PG8_BAR __builtin_amdgcn_s_barrier()
#define PG8_SCHED __builtin_amdgcn_sched_barrier(0)
    Unit cur, nxt; int ui = 0;
    if (!S.next(0, cur)) return;
    f32x4 acc[2][2][4][2];
#pragma unroll
    for (int a = 0; a < 2; ++a)
#pragma unroll
        for (int b = 0; b < 2; ++b)
#pragma unroll
            for (int m = 0; m < 4; ++m)
#pragma unroll
                for (int n = 0; n < 2; ++n) acc[a][b][m][n] = (f32x4){0.f, 0.f, 0.f, 0.f};
    bf16x8 At[4][2], B0[2][2], B1[2][2];
    const char* cA = S.abase(g, cur, tstep); const char* cB = S.bbase(g, cur, tstep);
    S.a_ready(cur);
    if constexpr (SP2) {
        PG8_STAGE(PG8_SB(0, 0), cB, voffB); PG8_STAGE(PG8_SB(0, 1), cB + hstep, voffB); PG8_STAGE(PG8_SA(0, 0), cA, voffA); PG8_STAGE(PG8_SA(0, 1), cA + hstep, voffA);
        if (wr == 1) PG8_BAR;
        PG8_WAIT_V(2); PG8_BAR;
        PG8_STAGE(PG8_SB(1, 0), cB + kstep, voffB); PG8_STAGE(PG8_SA(1, 0), cA + kstep, voffA); PG8_STAGE(PG8_SB(1, 1), cB + hstep + kstep, voffB);
        PG8_WAIT_V(6); PG8_BAR;
    } else {
        PG8_STAGE(PG8_SB(0, 0), cB, voffB); PG8_STAGE(PG8_SA(0, 0), cA, voffA); PG8_STAGE(PG8_SB(0, 1), cB + hstep, voffB); PG8_STAGE(PG8_SA(0, 1), cA + hstep, voffA);
        if (wr == 1) PG8_BAR;
        PG8_WAIT_V(4); PG8_BAR;
        PG8_STAGE(PG8_SB(1, 0), cB + kstep, voffB); PG8_STAGE(PG8_SA(1, 0), cA + kstep, voffA); PG8_STAGE(PG8_SB(1, 1), cB + hstep + kstep, voffB);
        PG8_WAIT_V(6); PG8_BAR;
    }
    for (;;) {
        const bool has_next = S.next(ui + 1, nxt);
        const char* nA = has_next ? S.abase(g, nxt, tstep) : cA; const char* nB = has_next ? S.bbase(g, nxt, tstep) : cB;
        for (int t = 0; t < nt; t += 2) {
            const bool last = (t == nt - 2);
            const char* a1 = cA + (size_t)(t + 1) * kstep;
            const char* a2 = last ? nA : cA + (size_t)(t + 2) * kstep; const char* b2 = last ? nB : cB + (size_t)(t + 2) * kstep;
            const char* a3 = a2 + kstep; const char* b3 = b2 + kstep;
            if (last && has_next) S.a_ready(nxt);
            if constexpr (SP2) {
            PG8_LDB(B0, 0, 0); PG8_LDB(B1, 0, 1); PG8_SCHED; PG8_LDA(At, 0, 0); PG8_STAGE(PG8_SA(1, 1), a1 + hstep, voffA);
            PG8_WAIT_V(8); PG8_WAIT_L(0); PG8_BAR; PG8_MMA(0, 0, At, B0); PG8_MMA(0, 1, At, B1); PG8_BAR; PG8_SCHED;
            PG8_LDA(At, 0, 1); PG8_STAGE(PG8_SB(0, 0), b2, voffB); PG8_STAGE(PG8_SB(0, 1), b2 + hstep, voffB); PG8_STAGE(PG8_SA(0, 0), a2, voffA);
            PG8_WAIT_V(8); PG8_WAIT_L(0); PG8_BAR; PG8_MMA(1, 0, At, B0); PG8_MMA(1, 1, At, B1); PG8_BAR; PG8_SCHED;
            PG8_LDB(B0, 1, 0); PG8_LDB(B1, 1, 1); PG8_SCHED; PG8_LDA(At, 1, 0); PG8_STAGE(PG8_SA(0, 1), a2 + hstep, voffA);
            PG8_WAIT_V(8); PG8_WAIT_L(0); PG8_BAR; PG8_MMA(0, 0, At, B0); PG8_MMA(0, 1, At, B1); PG8_BAR; PG8_SCHED;
            PG8_LDA(At, 1, 1); PG8_STAGE(PG8_SB(1, 0), b3, voffB); PG8_STAGE(PG8_SB(1, 1), b3 + hstep, voffB); PG8_STAGE(PG8_SA(1, 0), a3, voffA);
            PG8_WAIT_V(8); PG8_WAIT_L(0); PG8_BAR; PG8_MMA(1, 0, At, B0); PG8_MMA(1, 1, At, B1); PG8_BAR; PG8_SCHED;
            } else {
            PG8_LDB(B0, 0, 0); PG8_SCHED; PG8_LDA(At, 0, 0); PG8_STAGE(PG8_SA(1, 1), a1 + hstep, voffA);
            PG8_WAIT_L(8); PG8_BAR; PG8_WAIT_L(0); PG8_MMA(0, 0, At, B0); PG8_BAR; PG8_SCHED;
            PG8_LDB(B1, 0, 1); PG8_STAGE(PG8_SB(0, 0), b2, voffB);
            PG8_BAR; PG8_WAIT_L(0); PG8_MMA(0, 1, At, B1); PG8_BAR;
            PG8_LDA(At, 0, 1); PG8_STAGE(PG8_SA(0, 0), a2, voffA);
            PG8_BAR; PG8_WAIT_L(0); PG8_MMA(1, 0, At, B0); PG8_BAR; PG8_SCHED;
            PG8_STAGE(PG8_SB(0, 1), b2 + hstep, voffB);
            PG8_WAIT_V(6); PG8_BAR; PG8_MMA(1, 1, At, B1); PG8_BAR;
            PG8_LDB(B0, 1, 0); PG8_SCHED; PG8_LDA(At, 1, 0); PG8_STAGE(PG8_SA(0, 1), a2 + hstep, voffA);
            PG8_WAIT_L(8); PG8_BAR; PG8_WAIT_L(0); PG8_MMA(0, 0, At, B0); PG8_BAR; PG8_SCHED;
            PG8_LDB(B1, 1, 1); PG8_STAGE(PG8_SB(1, 0), b3, voffB);
            PG8_BAR; PG8_WAIT_L(0); PG8_MMA(0, 1, At, B1); PG8_BAR;
            PG8_LDA(At, 1, 1); PG8_STAGE(PG8_SA(1, 0), a3, voffA);
            PG8_BAR; PG8_WAIT_L(0); PG8_MMA(1, 0, At, B0); PG8_BAR; PG8_SCHED;
            PG8_STAGE(PG8_SB(1, 1), b3 + hstep, voffB);
            PG8_WAIT_V(6); PG8_BAR; PG8_MMA(1, 1, At, B1); PG8_BAR;
            }
        }
        if constexpr (ALIGN_EPI) { if (wr == 0) PG8_BAR; }
        if constexpr (!Epi::AFTER_DRAIN) { E(acc, cur, wr, wc, fr, fq); S.done(cur); }
        if (!has_next) break;
#pragma unroll
        for (int a = 0; a < 2; ++a)
#pragma unroll
            for (int b = 0; b < 2; ++b)
#pragma unroll
                for (int m = 0; m < 4; ++m)
#pragma unroll
                    for (int n = 0; n < 2; ++n) acc[a][b][m][n] = (f32x4){0.f, 0.f, 0.f, 0.f};
        cur = nxt; cA = nA; cB = nB; ++ui;
        if constexpr (ALIGN_EPI) { if (wr == 1) PG8_BAR; }
    }
    PG8_WAIT_V(0);
    if constexpr (!ALIGN_EPI) { if (wr == 0) PG8_BAR; }
    PG8_BAR;
    if constexpr (Epi::AFTER_DRAIN) { E.fused(acc, cur, wr, wc, fr, fq, lds, wid, lane); S.done(cur); }
#undef PG8_SA
#undef PG8_SB
#undef PG8_STAGE
#undef PG8_LDA
#undef PG8_LDB
#undef PG8_MMA
#undef PG8_WAIT_V
#undef PG8_WAIT_L
#undef PG8_BAR
#undef PG8_SCHED
}
}

constexpr int D = 1024, NBATCH = 2, SEQ = 8192, CTXL = 256;
constexpr int NLAT = NBATCH * SEQ, NCTX = NBATCH * CTXL, NROW = NLAT + NCTX;
constexpr int NE = 32, TOPK = 4, MAXTILES = 296, CAP = MAXTILES * 256;
constexpr int NWAVES = 8, NTHREADS = 512;
constexpr float NORM_EPS = 1e-6f;
constexpr int LDS_BYTES = 147456;

constexpr size_t MiB = 1u << 20;
constexpr size_t WS_CTL = 0, CTL_ZERO_BYTES = 1 * MiB;
constexpr size_t WS_MOD = 1 * MiB;
constexpr size_t WS_ROUTE = 2 * MiB;
constexpr size_t RT_TOPI = 0, RT_TOPG = 320 * 1024, RT_POS = 640 * 1024, RT_SLOT = 960 * 1024, RT_RSTD = 1280 * 1024, RT_TILEE = 1408 * 1024;
constexpr size_t WS_WIN = 4 * MiB, WS_WHGO = 14 * MiB, WS_WRKV = 16 * MiB, WS_WL1 = 22 * MiB, WS_WL2 = 24 * MiB, WS_WRWO = 28 * MiB;
constexpr size_t WS_WGU = 32 * MiB, WS_WD = 288 * MiB;
constexpr size_t WS_XR = 416 * MiB, WS_H = 482 * MiB, WS_H2 = 515 * MiB, WS_A2 = 548 * MiB;
constexpr size_t WS_U = 584 * MiB;
constexpr size_t U_Z = 0, U_OD0 = 166 * MiB;
constexpr size_t U_XL6 = 0, U_RKV = 198 * MiB, U_L1 = 396 * MiB, U_WD = 410 * MiB, U_AD = 542 * MiB, U_G = 674 * MiB, U_OD1 = 740 * MiB;
constexpr size_t U_XB = 0, U_ACT = 148 * MiB, U_YS = 296 * MiB;
constexpr size_t WS_END = WS_U + 872 * MiB;
constexpr int CW_CNT = 64;
constexpr int CW_BAR = 4096;

#define LAS __attribute__((address_space(3)))
typedef unsigned short bf16;
typedef unsigned v4u __attribute__((ext_vector_type(4)));
typedef unsigned v2u __attribute__((ext_vector_type(2)));
typedef float f32x4 __attribute__((ext_vector_type(4)));
#define LDS_WAIT() asm volatile("s_waitcnt lgkmcnt(0)" ::: "memory")
__device__ __forceinline__ unsigned f2bf(float f) { unsigned u = __builtin_bit_cast(unsigned, f); return (u + 0x7fffu + ((u >> 16) & 1u)) >> 16; }
__device__ __forceinline__ unsigned pk2(float lo, float hi) { return f2bf(lo) | (f2bf(hi) << 16); }
__device__ __forceinline__ float bf2f(unsigned b) { return __builtin_bit_cast(float, b << 16); }
__device__ __forceinline__ float wave_sum(float v) {
#pragma unroll
    for (int o = 1; o < 64; o <<= 1) v += __shfl_xor(v, o);
    return v;
}
__device__ __forceinline__ float sigm(float x) { return 1.0f / (1.0f + __expf(-x)); }

struct Params { const float* in[35]; float* out; unsigned char* ws; int ph_lo, ph_hi; };
enum { I_X = 0, I_C, I_CTX, I_CCTX, I_ADAW, I_ADAB, I_NMIX, I_NFFN, I_HGWIN, I_HGGN, I_HGWOUT, I_HGLB, I_MU, I_WRKV, I_DECW0, I_DECW1, I_DECW2,
       I_A0, I_A1, I_A2, I_G1, I_G2, I_KK, I_KA, I_RK, I_LNXW, I_LNXB, I_RWOUT, I_ROUTW, I_ROUTB, I_WGU, I_BGU, I_WDN, I_BDN, I_FINALG };

__device__ __forceinline__ const float* modp(const Params& p, int l, int v, int j) { return (const float*)(p.ws + WS_MOD) + ((size_t)(l * 3 + v) * 6 + j) * D; }
__device__ __forceinline__ int row_vec(int row) { return row < NLAT ? (row >= SEQ ? 1 : 0) : 2; }

__device__ __forceinline__ void transpose_item(const float* src, int src_ld, bf16* dst, int dst_ld, LAS float* scr, int lane) {
    if (src) {
#pragma unroll 8
        for (int i = 0; i < 32; ++i) { const int kk = 2 * i + (lane >> 5); scr[kk * 33 + (lane & 31)] = src[(size_t)kk * src_ld + (lane & 31)]; }
    }
    LDS_WAIT(); asm volatile("" ::: "memory");
    const int c = lane & 7;
#pragma unroll
    for (int j = 0; j < 4; ++j) {
        const int n = (lane >> 3) + 8 * j; v4u o = (v4u){0u, 0u, 0u, 0u};
        if (src) { const LAS float* s = scr + (8 * c) * 33 + n;
            o.x = pk2(s[0 * 33], s[1 * 33]); o.y = pk2(s[2 * 33], s[3 * 33]); o.z = pk2(s[4 * 33], s[5 * 33]); o.w = pk2(s[6 * 33], s[7 * 33]); }
        *(v4u*)(dst + (size_t)n * dst_ld + 8 * c) = o;
    }
    LDS_WAIT(); asm volatile("" ::: "memory");
}
__device__ __forceinline__ void conv_plain(const float* W, int K, int N, bf16* WT, int r, LAS float* scr, int lane) {
    const int nblk = N / 32, kb = r / nblk, nb = r % nblk;
    transpose_item(W + (size_t)(kb * 64) * N + nb * 32, N, WT + (size_t)(nb * 32) * K + kb * 64, K, scr, lane);
}
constexpr int IT_WIN = 16 * 160, IT_SQ = 16 * 32, IT_L1 = 16 * 24, IT_L2 = 160 * 6, IT_GU = 64 * 16 * 64, IT_DN = 64 * 16 * 32;
constexpr int IT_TOTAL = IT_WIN + IT_SQ + 3 * IT_SQ + IT_SQ + IT_L1 + IT_L2 + IT_GU + IT_DN;
__device__ __forceinline__ void convert_item(const Params& p, int it, LAS float* scr, int lane) {
    unsigned char* ws = p.ws; int r = it;
    if (r < IT_WIN) { conv_plain(p.in[I_HGWIN], D, 5120, (bf16*)(ws + WS_WIN), r, scr, lane); return; } r -= IT_WIN;
    if (r < IT_SQ) { conv_plain(p.in[I_HGWOUT], D, D, (bf16*)(ws + WS_WHGO), r, scr, lane); return; } r -= IT_SQ;
    if (r < 3 * IT_SQ) { const int j = r / IT_SQ; conv_plain(p.in[I_WRKV] + (size_t)j * D * D, D, D, (bf16*)(ws + WS_WRKV) + (size_t)j * D * D, r % IT_SQ, scr, lane); return; } r -= 3 * IT_SQ;
    if (r < IT_SQ) { conv_plain(p.in[I_RWOUT], D, D, (bf16*)(ws + WS_WRWO), r, scr, lane); return; } r -= IT_SQ;
    if (r < IT_L1) {
        const int kb = r / 24, rg = r % 24, tile = rg >> 3, within = rg & 7; const float* src = nullptr; int ld = 64;
        if (within < 4) {
            if (tile == 0) src = p.in[I_DECW1] + (size_t)(within >> 1) * D * 64 + (size_t)(kb * 64) * 64 + (within & 1) * 32;
            else if (tile == 1) src = p.in[I_A1] + (size_t)(within >> 1) * D * 64 + (size_t)(kb * 64) * 64 + (within & 1) * 32;
            else { src = p.in[I_G1] + (size_t)(kb * 64) * 128 + within * 32; ld = 128; }
        }
        transpose_item(src, ld, (bf16*)(ws + WS_WL1) + (size_t)(rg * 32) * D + kb * 64, D, scr, lane); return; } r -= IT_L1;
    if (r < IT_L2) {
        const int rg = r / 6, kb = r % 6, n0 = rg * 32, blk = n0 >> 10, nn0 = n0 & 1023; const float* src = nullptr;
        if (blk < 2) { if (kb == blk) src = p.in[I_DECW2] + (size_t)blk * 64 * D + nn0; }
        else if (blk < 4) { if (kb == blk) src = p.in[I_A2] + (size_t)(blk - 2) * 64 * D + nn0; }
        else { if (kb >= 4) src = p.in[I_G2] + (size_t)(kb - 4) * 64 * D + nn0; }
        transpose_item(src, D, (bf16*)(ws + WS_WL2) + (size_t)n0 * 384 + kb * 64, 384, scr, lane); return; } r -= IT_L2;
    if (r < IT_GU) {
        const int mat = r >> 10, q = r & 1023, kb = q >> 6, nb = q & 63, n0 = nb * 32;
        const int j0 = n0 & 1023, drow = 256 * (j0 >> 7) + (n0 >= 1024 ? 128 : 0) + (j0 & 127);
        transpose_item(p.in[I_WGU] + (size_t)mat * D * 2048 + (size_t)(kb * 64) * 2048 + n0, 2048, (bf16*)(ws + WS_WGU) + (size_t)mat * 2048 * D + (size_t)drow * D + kb * 64, D, scr, lane); return; } r -= IT_GU;
    { const int mat = r >> 9, q = r & 511;
      conv_plain(p.in[I_WDN] + (size_t)mat * D * D, D, D, (bf16*)(ws + WS_WD) + (size_t)mat * D * D, q, scr, lane); }
}
__device__ __forceinline__ void phase_pre(const Params& p, LAS unsigned char* lds, int tid, int lane, int wave) {
    if (blockIdx.x < 192) {
        const int layer = blockIdx.x / 96, col = (blockIdx.x % 96) * 64 + lane;
        const float* W = p.in[I_ADAW] + (size_t)layer * D * 6144 + col;
        const float* c = p.in[I_C]; const float* cc = p.in[I_CCTX];
        float a0 = 0.f, a1 = 0.f, a2 = 0.f;
#pragma unroll 8
        for (int k = wave * 128; k < wave * 128 + 128; ++k) {
            const float wv = W[(size_t)k * 6144]; const float c0 = c[k], c1 = c[D + k], c2 = cc[k];
            a0 += c0 * sigm(c0) * wv; a1 += c1 * sigm(c1) * wv; a2 += c2 * sigm(c2) * wv;
        }
        LAS float* red = (LAS float*)lds;
        red[(wave * 3 + 0) * 64 + lane] = a0; red[(wave * 3 + 1) * 64 + lane] = a1; red[(wave * 3 + 2) * 64 + lane] = a2;
        __syncthreads();
        if (wave == 0) {
            float s0 = 0.f, s1 = 0.f, s2 = 0.f;
#pragma unroll
            for (int w = 0; w < 8; ++w) { s0 += red[(w * 3 + 0) * 64 + lane]; s1 += red[(w * 3 + 1) * 64 + lane]; s2 += red[(w * 3 + 2) * 64 + lane]; }
            const float bb = p.in[I_ADAB][layer * 6144 + col];
            float* M = (float*)(p.ws + WS_MOD) + (size_t)layer * 3 * 6144 + col;
            M[0] = s0 + bb; M[6144] = s1 + bb; M[2 * 6144] = s2 + bb;
        }
        __syncthreads();
    }
    LAS float* scr = (LAS float*)(lds + wave * 16384);
    const int gw = blockIdx.x * NWAVES + wave, NGW = gridDim.x * NWAVES;
    for (int it = gw; it < IT_TOTAL; it += NGW) convert_item(p, it, scr, lane);
}

__device__ __forceinline__ void load_row(const float* row, int lane, f32x4 (&v)[4]) {
#pragma unroll
    for (int j = 0; j < 4; ++j) v[j] = ((const f32x4*)row)[lane + 64 * j];
}
__device__ __forceinline__ float row_rstd(const f32x4 (&v)[4]) {
    float s = 0.f;
#pragma unroll
    for (int j = 0; j < 4; ++j) s += (v[j].x * v[j].x + v[j].y * v[j].y) + (v[j].z * v[j].z + v[j].w * v[j].w);
    return rsqrtf(wave_sum(s) * (1.0f / D) + NORM_EPS);
}
__device__ __forceinline__ void norm_mod(const f32x4 (&v)[4], float rstd, const float* g, const float* shift, const float* scale, int lane, f32x4 (&h)[4]) {
#pragma unroll
    for (int j = 0; j < 4; ++j) {
        const f32x4 gg = ((const f32x4*)g)[lane + 64 * j], sh = ((const f32x4*)shift)[lane + 64 * j], sc = ((const f32x4*)scale)[lane + 64 * j];
        h[j] = v[j] * rstd * gg * (sc + 1.0f) + sh;
    }
}
__device__ __forceinline__ void store_row_bf16(bf16* row, int lane, const f32x4 (&h)[4]) {
#pragma unroll
    for (int j = 0; j < 4; ++j) { v2u w; w.x = pk2(h[j].x, h[j].y); w.y = pk2(h[j].z, h[j].w); ((v2u*)row)[lane + 64 * j] = w; }
}
__device__ __forceinline__ const float* resid_row(const Params& p, int layer0_inputs, int row) {
    if (layer0_inputs) return row < NLAT ? p.in[I_X] + (size_t)row * D : p.in[I_CTX] + (size_t)(row - NLAT) * D;
    return (const float*)(p.ws + WS_XR) + (size_t)row * D;
}
__device__ __forceinline__ void phase_norm0(const Params& p, int lane, int wave) {
    const int gw = blockIdx.x * NWAVES + wave, NGW = gridDim.x * NWAVES;
    for (int row = gw; row < NROW; row += NGW) {
        f32x4 v[4], h[4]; load_row(resid_row(p, 1, row), lane, v);
        const float rstd = row_rstd(v); const int vec = row_vec(row);
        norm_mod(v, rstd, p.in[I_NMIX], modp(p, 0, vec, 0), modp(p, 0, vec, 1), lane, h);
        store_row_bf16((bf16*)(p.ws + WS_H) + (size_t)row * D, lane, h);
    }
}
__device__ __forceinline__ void phase_ffn_norm_route(const Params& p, int layer, int nrows, int lane, int wave) {
    const int gw = blockIdx.x * NWAVES + wave, NGW = gridDim.x * NWAVES;
    const float* rw = p.in[I_ROUTW] + (size_t)layer * D * NE; const float* rb = p.in[I_ROUTB] + layer * NE;
    int* TOPI = (int*)(p.ws + WS_ROUTE + RT_TOPI); float* TOPG = (float*)(p.ws + WS_ROUTE + RT_TOPG); int* POS = (int*)(p.ws + WS_ROUTE + RT_POS);
    unsigned* cnt = (unsigned*)(p.ws + WS_CTL) + CW_CNT + layer * NE;
    for (int row = gw; row < nrows; row += NGW) {
        f32x4 v[4], h[4]; load_row((const float*)(p.ws + WS_XR) + (size_t)row * D, lane, v);
        const float rstd = row_rstd(v); const int vec = row_vec(row);
        norm_mod(v, rstd, p.in[I_NFFN] + layer * D, modp(p, layer, vec, 3), modp(p, layer, vec, 4), lane, h);
        store_row_bf16((bf16*)(p.ws + WS_H2) + (size_t)row * D, lane, h);
        float part[NE];
#pragma unroll
        for (int e = 0; e < NE; ++e) part[e] = 0.f;
#pragma unroll
        for (int j = 0; j < 4; ++j)
#pragma unroll
            for (int i = 0; i < 4; ++i) {
                const float hv = h[j][i]; const f32x4* wr = (const f32x4*)(rw + (size_t)(4 * lane + 256 * j + i) * NE);
#pragma unroll
                for (int q = 0; q < 8; ++q) { const f32x4 w4 = wr[q]; part[4 * q + 0] += hv * w4.x; part[4 * q + 1] += hv * w4.y; part[4 * q + 2] += hv * w4.z; part[4 * q + 3] += hv * w4.w; }
            }
#pragma unroll
        for (int e = 0; e < NE; ++e) part[e] = wave_sum(part[e]) + rb[e];
        unsigned taken = 0u; int idx[TOPK]; float val[TOPK];
#pragma unroll
        for (int k = 0; k < TOPK; ++k) {
            float best = -3.0e38f; int bi = 0;
#pragma unroll
            for (int e = 0; e < NE; ++e) { const bool ok = !((taken >> e) & 1u) && (part[e] > best); best = ok ? part[e] : best; bi = ok ? e : bi; }
            taken |= 1u << bi; idx[k] = bi; val[k] = best;
        }
        float ex[TOPK], se = 0.f;
#pragma unroll
        for (int k = 0; k < TOPK; ++k) { ex[k] = __expf(val[k] - val[0]); se += ex[k]; }
        if (lane == 0) {
#pragma unroll
            for (int k = 0; k < TOPK; ++k) {
                TOPI[row * 4 + k] = idx[k]; TOPG[row * 4 + k] = ex[k] / se;
                POS[row * 4 + k] = (int)atomicAdd(cnt + idx[k], 1u);
            }
        }
    }
}
__device__ __forceinline__ void phase_gather(const Params& p, int layer, int nrows, LAS unsigned char* lds, int tid, int lane, int wave) {
    LAS int* off = (LAS int*)lds;
    const unsigned* cnt = (const unsigned*)(p.ws + WS_CTL) + CW_CNT + layer * NE;
    int* TILEE = (int*)(p.ws + WS_ROUTE + RT_TILEE);
    if (tid == 0) {
        int o = 0;
        for (int e = 0; e < NE; ++e) { off[e] = o; const int nt = ((int)__hip_atomic_load(cnt + e, __ATOMIC_RELAXED, __HIP_MEMORY_SCOPE_AGENT) + 255) >> 8;
            if (blockIdx.x == 0) for (int t = 0; t < nt; ++t) TILEE[1 + (o >> 8) + t] = e;
            o += nt << 8; }
        off[NE] = o; if (blockIdx.x == 0) TILEE[0] = o >> 8;
    }
    __syncthreads();
    const int* TOPI = (const int*)(p.ws + WS_ROUTE + RT_TOPI); const int* POS = (const int*)(p.ws + WS_ROUTE + RT_POS); int* SLOT = (int*)(p.ws + WS_ROUTE + RT_SLOT);
    const bf16* H2 = (const bf16*)(p.ws + WS_H2); bf16* XB = (bf16*)(p.ws + WS_U + U_XB);
    const int gw = blockIdx.x * NWAVES + wave, NGW = gridDim.x * NWAVES;
    for (int it = gw; it < nrows * TOPK; it += NGW) {
        const int row = it >> 2; const int slot = off[TOPI[it]] + POS[it];
        if (lane == 0) SLOT[it] = slot;
        const v4u* s = (const v4u*)(H2 + (size_t)row * D); v4u* d = (v4u*)(XB + (size_t)slot * D);
        d[lane] = s[lane]; d[lane + 64] = s[lane + 64];
    }
    __syncthreads();
}
__device__ __forceinline__ void phase_combine(const Params& p, int layer, int nrows, bool final_out, int lane, int wave) {
    const int gw = blockIdx.x * NWAVES + wave, NGW = gridDim.x * NWAVES;
    const float* TOPG = (const float*)(p.ws + WS_ROUTE + RT_TOPG); const int* SLOT = (const int*)(p.ws + WS_ROUTE + RT_SLOT);
    const bf16* YS = (const bf16*)(p.ws + WS_U + U_YS); float* XR = (float*)(p.ws + WS_XR); float* RSTD = (float*)(p.ws + WS_ROUTE + RT_RSTD);
    for (int row = gw; row < nrows; row += NGW) {
        f32x4 v[4], acc[4]; load_row(XR + (size_t)row * D, lane, v);
#pragma unroll
        for (int j = 0; j < 4; ++j) acc[j] = (f32x4){0.f, 0.f, 0.f, 0.f};
#pragma unroll
        for (int k = 0; k < TOPK; ++k) {
            const float gk = TOPG[row * 4 + k]; const v2u* ys = (const v2u*)(YS + (size_t)SLOT[row * 4 + k] * D);
#pragma unroll
            for (int j = 0; j < 4; ++j) { const v2u w = ys[lane + 64 * j];
                acc[j].x += gk * bf2f(w.x & 0xffffu); acc[j].y += gk * bf2f(w.x >> 16); acc[j].z += gk * bf2f(w.y & 0xffffu); acc[j].w += gk * bf2f(w.y >> 16); }
        }
        const float* m5 = modp(p, layer, row_vec(row), 5);
#pragma unroll
        for (int j = 0; j < 4; ++j) v[j] = v[j] + ((const f32x4*)m5)[lane + 64 * j] * acc[j];
        const float rstd = row_rstd(v);
        if (final_out) {
#pragma unroll
            for (int j = 0; j < 4; ++j) ((f32x4*)(p.out + (size_t)row * D))[lane + 64 * j] = v[j] * rstd * ((const f32x4*)p.in[I_FINALG])[lane + 64 * j];
        } else {
#pragma unroll
            for (int j = 0; j < 4; ++j) ((f32x4*)(XR + (size_t)row * D))[lane + 64 * j] = v[j];
            if (lane == 0) RSTD[row] = rstd;
        }
    }
}

__device__ __forceinline__ int step_row(int b, int dir, int step) {
    if (step < CTXL) { const int t = dir ? (CTXL - 1 - step) : step; return NLAT + b * CTXL + t; }
    const int s = step - CTXL; const int t = dir ? (SEQ - 1 - s) : s; return b * SEQ + t;
}
constexpr int NSTEP = CTXL + SEQ;

__device__ __forceinline__ void phase_gla_naive(const Params& p, LAS unsigned char* lds, int tid) {
    if (blockIdx.x >= 8) return;
    const int ci = tid >> 7, v = tid & 127, chain = blockIdx.x * 4 + ci, b = chain >> 4, dir = (chain >> 3) & 1, h = chain & 7;
    const bf16* Z = (const bf16*)(p.ws + WS_U + U_Z); float* OD = (float*)(p.ws + WS_U + U_OD0) + (size_t)dir * NROW * D;
    float lbv; { const float* lb = p.in[I_HGLB] + (size_t)dir * 3 * D + h * 128 + v; const float a0 = lb[0], a1 = lb[D], a2 = lb[2 * D];
                 const float m = fmaxf(a0, fmaxf(a1, a2)); const float e0 = __expf(a0 - m), e1 = __expf(a1 - m), e2 = __expf(a2 - m); lbv = e0 / (e0 + e1 + e2); }
    LAS float* LF = (LAS float*)lds;
    LAS float* LQ = (LAS float*)(lds + 4096);
    float S[128];
#pragma unroll
    for (int k = 0; k < 128; ++k) S[k] = 0.f;
    int row = step_row(b, dir, 0);
    unsigned zf = Z[(size_t)row * 5120 + 1024 * (1 + dir) + h * 128 + v], zq = Z[(size_t)row * 5120 + h * 128 + v], zv = Z[(size_t)row * 5120 + 3072 + h * 128 + v];
    for (int step = 0; step < NSTEP; ++step) {
        const float fh = bf2f(zf), qv = bf2f(zq), vv = bf2f(zv); const int crow = row;
        if (step + 1 < NSTEP) { row = step_row(b, dir, step + 1);
            zf = Z[(size_t)row * 5120 + 1024 * (1 + dir) + h * 128 + v]; zq = Z[(size_t)row * 5120 + h * 128 + v]; zv = Z[(size_t)row * 5120 + 3072 + h * 128 + v]; }
        const int buf = step & 1;
        LF[(buf * 4 + ci) * 128 + v] = lbv + (1.f - lbv) * sigm(fh); LQ[(buf * 4 + ci) * 128 + v] = qv * sigm(qv);
        __syncthreads();
        const LAS f32x4* f4 = (const LAS f32x4*)(LF + (buf * 4 + ci) * 128); const LAS f32x4* q4 = (const LAS f32x4*)(LQ + (buf * 4 + ci) * 128);
        float o0 = 0.f, o1 = 0.f;
#pragma unroll
        for (int k4 = 0; k4 < 32; ++k4) { const f32x4 f = f4[k4], q = q4[k4];
            S[4 * k4 + 0] = vv + f.x * (S[4 * k4 + 0] - vv); o0 += q.x * S[4 * k4 + 0];
            S[4 * k4 + 1] = vv + f.y * (S[4 * k4 + 1] - vv); o1 += q.y * S[4 * k4 + 1];
            S[4 * k4 + 2] = vv + f.z * (S[4 * k4 + 2] - vv); o0 += q.z * S[4 * k4 + 2];
            S[4 * k4 + 3] = vv + f.w * (S[4 * k4 + 3] - vv); o1 += q.w * S[4 * k4 + 3]; }
        OD[(size_t)crow * D + h * 128 + v] = o0 + o1;
    }
}
__device__ __forceinline__ void phase_hg_readout(const Params& p, int lane, int wave) {
    const int gw = blockIdx.x * NWAVES + wave, NGW = gridDim.x * NWAVES;
    const bf16* Z = (const bf16*)(p.ws + WS_U + U_Z); const float* OD = (const float*)(p.ws + WS_U + U_OD0); bf16* A2 = (bf16*)(p.ws + WS_A2);
    const float* gn = p.in[I_HGGN];
    for (int row = gw; row < NROW; row += NGW) {
#pragma unroll
        for (int h = 0; h < 8; ++h) {
            const int c = h * 128 + 2 * lane;
            const float2 a = *(const float2*)(OD + (size_t)row * D + c), bq = *(const float2*)(OD + (size_t)(NROW + row) * D + c);
            const float o0 = a.x + bq.x, o1 = a.y + bq.y;
            const float rstd = rsqrtf(wave_sum(o0 * o0 + o1 * o1) * (1.0f / 128.0f) + NORM_EPS);
            const unsigned gz = *(const unsigned*)(Z + (size_t)row * 5120 + 4096 + c); const float g0 = bf2f(gz & 0xffffu), g1 = bf2f(gz >> 16);
            const float r0 = o0 * rstd * gn[2 * lane] * (g0 * sigm(g0)), r1 = o1 * rstd * gn[2 * lane + 1] * (g1 * sigm(g1));
            *(unsigned*)(A2 + (size_t)row * D + c) = pk2(r0, r1);
        }
    }
}

__device__ __forceinline__ void phase_lerp(const Params& p, int lane, int wave) {
    const int gw = blockIdx.x * NWAVES + wave, NGW = gridDim.x * NWAVES;
    const float* XR = (const float*)(p.ws + WS_XR); const float* RSTD = (const float*)(p.ws + WS_ROUTE + RT_RSTD);
    bf16* XL6 = (bf16*)(p.ws + WS_U + U_XL6); const float* g = p.in[I_NMIX] + D; const float* mu = p.in[I_MU];
    for (int row = gw; row < NROW; row += NGW) {
        const int vec = row_vec(row); const float* sh = modp(p, 1, vec, 0); const float* sc = modp(p, 1, vec, 1);
        int nb[4];
        if (row < NLAT) { const int t = row & (SEQ - 1), w = t & 63, r = t >> 6;
            nb[0] = (w >= 1) ? row - 1 : -1; nb[1] = (w < 63) ? row + 1 : -1; nb[2] = (r >= 1) ? row - 64 : -1; nb[3] = (r < SEQ / 64 - 1) ? row + 64 : -1;
        } else { const int t = (row - NLAT) & (CTXL - 1);
            nb[0] = nb[1] = (t >= 1) ? row - 1 : -1; nb[2] = nb[3] = (t < CTXL - 1) ? row + 1 : -1; }
        const float rs = RSTD[row];
#pragma unroll
        for (int j = 0; j < 4; ++j) {
            const int ci = lane + 64 * j;
            const f32x4 gg = ((const f32x4*)g)[ci], s1 = ((const f32x4*)sc)[ci] + 1.0f, s0 = ((const f32x4*)sh)[ci];
            const f32x4 xs = ((const f32x4*)(XR + (size_t)row * D))[ci];
            const f32x4 hs = xs * rs * gg * s1 + s0;
            f32x4 hn = (f32x4){0.f, 0.f, 0.f, 0.f};
            if (nb[j] >= 0) { const f32x4 xn = ((const f32x4*)(XR + (size_t)nb[j] * D))[ci]; hn = xn * RSTD[nb[j]] * gg * s1 + s0; }
            const f32x4 dx = hn - hs;
#pragma unroll
            for (int s = 0; s < 6; ++s) {
                const int m = (s == 0) ? 0 : (s == 1) ? 2 : (s == 2) ? 3 : (s == 3) ? 1 : (s == 4) ? 4 : 5;
                const f32x4 o = hs + dx * ((const f32x4*)(mu + m * D))[ci];
                v2u w; w.x = pk2(o.x, o.y); w.y = pk2(o.z, o.w);
                ((v2u*)(XL6 + ((size_t)s * NROW + row) * D))[ci] = w;
            }
        }
    }
}
__device__ __forceinline__ void phase_rwkv_naive(const Params& p, LAS unsigned char* lds, int lane, int wave) {
    if (blockIdx.x >= 8) return;
    const int chain = blockIdx.x * 8 + wave, b = chain >> 5, dir = (chain >> 4) & 1, h = chain & 15, ch = h * 64 + lane;
    const float* RKV = (const float*)(p.ws + WS_U + U_RKV);
    const float* WDp = (const float*)(p.ws + WS_U + U_WD) + (size_t)dir * NROW * D; const float* ADp = (const float*)(p.ws + WS_U + U_AD) + (size_t)dir * NROW * D;
    float* OD = (float*)(p.ws + WS_U + U_OD1) + (size_t)dir * NROW * D;
    const float kkw = p.in[I_KK][ch], kaw = p.in[I_KA][ch];
    LAS float* L = (LAS float*)lds;
    float S[64];
#pragma unroll
    for (int j = 0; j < 64; ++j) S[j] = 0.f;
    for (int step = 0; step < NSTEP; ++step) {
        const int row = step_row(b, dir, step);
        const float rx = RKV[(size_t)row * 3072 + ch], kx = RKV[(size_t)row * 3072 + 1024 + ch], vx = RKV[(size_t)row * 3072 + 2048 + ch];
        const float wv = WDp[(size_t)row * D + ch], av = ADp[(size_t)row * D + ch];
        float kkx = kx * kkw; const float nrm = sqrtf(wave_sum(kkx * kkx)); kkx = kkx / fmaxf(nrm, 1e-12f);
        LAS float* B = L + ((step & 1) * 8 + wave) * 320;
        B[lane] = wv; B[64 + lane] = kkx; B[128 + lane] = kkx * av; B[192 + lane] = kx * (1.f + (av - 1.f) * kaw); B[256 + lane] = rx;
        __syncthreads();
        const LAS f32x4* W4 = (const LAS f32x4*)B; const LAS f32x4* K4 = (const LAS f32x4*)(B + 64); const LAS f32x4* B4 = (const LAS f32x4*)(B + 128);
        const LAS f32x4* D4 = (const LAS f32x4*)(B + 192); const LAS f32x4* R4 = (const LAS f32x4*)(B + 256);
        float sa0 = 0.f, sa1 = 0.f;
#pragma unroll
        for (int q = 0; q < 16; ++q) { const f32x4 kk = K4[q]; sa0 += S[4 * q] * kk.x + S[4 * q + 2] * kk.z; sa1 += S[4 * q + 1] * kk.y + S[4 * q + 3] * kk.w; }
        const float sa = sa0 + sa1;
        float y0 = 0.f, y1 = 0.f;
#pragma unroll
        for (int q = 0; q < 16; ++q) { const f32x4 w = W4[q], bt = B4[q], kd = D4[q], r = R4[q];
            S[4 * q + 0] = S[4 * q + 0] * w.x - sa * bt.x + vx * kd.x; y0 += S[4 * q + 0] * r.x;
            S[4 * q + 1] = S[4 * q + 1] * w.y - sa * bt.y + vx * kd.y; y1 += S[4 * q + 1] * r.y;
            S[4 * q + 2] = S[4 * q + 2] * w.z - sa * bt.z + vx * kd.z; y0 += S[4 * q + 2] * r.z;
            S[4 * q + 3] = S[4 * q + 3] * w.w - sa * bt.w + vx * kd.w; y1 += S[4 * q + 3] * r.w; }
        OD[(size_t)row * D + ch] = y0 + y1;
    }
}
__device__ __forceinline__ void phase_rw_readout(const Params& p, int lane, int wave) {
    const int gw = blockIdx.x * NWAVES + wave, NGW = gridDim.x * NWAVES;
    const float* RKV = (const float*)(p.ws + WS_U + U_RKV); const float* AD = (const float*)(p.ws + WS_U + U_AD); const float* G = (const float*)(p.ws + WS_U + U_G);
    const float* OD = (const float*)(p.ws + WS_U + U_OD1); bf16* A2 = (bf16*)(p.ws + WS_A2);
    for (int row = gw; row < NLAT; row += NGW) {
#pragma unroll 4
        for (int h = 0; h < 16; ++h) {
            const int ch = h * 64 + lane;
            const float y = OD[(size_t)row * D + ch] + OD[(size_t)(NROW + row) * D + ch];
            const float mean = wave_sum(y) * (1.0f / 64.0f); const float d = y - mean; const float var = wave_sum(d * d) * (1.0f / 64.0f);
            float yn = d * rsqrtf(var + 64.0e-5f) * p.in[I_LNXW][ch] + p.in[I_LNXB][ch];
            const float r = RKV[(size_t)row * 3072 + ch], k = RKV[(size_t)row * 3072 + 1024 + ch], v = RKV[(size_t)row * 3072 + 2048 + ch];
            const float ka = p.in[I_KA][ch], rk = p.in[I_RK][ch];
#pragma unroll
            for (int dd = 0; dd < 2; ++dd) { const float a = AD[((size_t)dd * NROW + row) * D + ch]; const float kd = k * (1.f + (a - 1.f) * ka);
                yn += wave_sum(r * kd * rk) * v; }
            const float o = yn * G[(size_t)row * D + ch];
            const float o1 = __shfl_down(o, 1);
            if (!(lane & 1)) *(unsigned*)(A2 + (size_t)row * D + ch) = pk2(o, o1);
        }
    }
}

namespace pg8 {
struct SelOrder : StaticOrder {
    int div, sel0; size_t stride;
    __device__ __forceinline__ const char* abase(const Gemm& g, const Unit& u, size_t tstep) const { return (const char*)g.A + (size_t)(sel0 + u.pn / div) * stride + (size_t)u.pm * tstep; }
};
struct MoeOrder {
    const int* tilee; int nt, ntn, G, c; size_t estride;
    __device__ __forceinline__ void init(const int* te, int ntn_, size_t es, int G_, int c_) { tilee = te; nt = te[0]; ntn = ntn_; estride = es; G = G_; c = c_; }
    __device__ __forceinline__ bool next(int i, Unit& u) const { const long L = (long)i * G + c; if (L >= (long)nt * ntn) return false; u.pn = (int)(L / nt); u.pm = (int)(L % nt); u.e = tilee[1 + u.pm]; return true; }
    __device__ __forceinline__ const char* abase(const Gemm& g, const Unit& u, size_t tstep) const { return (const char*)g.A + (size_t)u.pm * tstep; }
    __device__ __forceinline__ const char* bbase(const Gemm& g, const Unit& u, size_t tstep) const { return (const char*)g.Bt + (size_t)u.e * estride + (size_t)u.pn * tstep; }
    __device__ __forceinline__ void a_ready(const Unit&) const {}
    __device__ __forceinline__ void done(const Unit&) const {}
};
struct EpiStoreBf16 {
    static constexpr bool PERM = true, AFTER_DRAIN = false;
    bf16_t* O; int ldc;
    __device__ __forceinline__ void operator()(const f32x4 (&acc)[2][2][4][2], const Unit& u, int wr, int wc, int fr, int fq) const {
        const int row0 = u.pm * BM + wr * 64 + fr, col0 = u.pn * BM + wc * 32 + 8 * fq;
#pragma unroll
        for (int ai = 0; ai < 2; ++ai)
#pragma unroll
            for (int m = 0; m < 4; ++m) { bf16_t* rowp = O + (size_t)(row0 + ai * HALF + m * 16) * ldc + col0;
#pragma unroll
                for (int bj = 0; bj < 2; ++bj) { const f32x4 v0 = acc[ai][bj][m][0], v1 = acc[ai][bj][m][1];
                    u32x4 w; w.x = cvt_pk_bf16(v0[0], v0[1]); w.y = cvt_pk_bf16(v0[2], v0[3]); w.z = cvt_pk_bf16(v1[0], v1[1]); w.w = cvt_pk_bf16(v1[2], v1[3]);
                    *(u32x4*)(rowp + bj * HALF) = w; } }
    }
};
struct EpiStoreF32 {
    static constexpr bool PERM = false, AFTER_DRAIN = false;
    float* C; int ldc;
    __device__ __forceinline__ void operator()(const f32x4 (&acc)[2][2][4][2], const Unit& u, int wr, int wc, int fr, int fq) const {
        const int row0 = u.pm * BM + wr * 64 + fr, col0 = u.pn * BM + wc * 32 + 4 * fq;
#pragma unroll
        for (int ai = 0; ai < 2; ++ai)
#pragma unroll
            for (int m = 0; m < 4; ++m) { float* rowp = C + (size_t)(row0 + ai * HALF + m * 16) * ldc + col0;
#pragma unroll
                for (int bj = 0; bj < 2; ++bj)
#pragma unroll
                    for (int n = 0; n < 2; ++n) *(f32x4*)(rowp + bj * HALF + n * 16) = acc[ai][bj][m][n]; }
    }
};
struct EpiResid {
    static constexpr bool PERM = false, AFTER_DRAIN = false;
    const float* base_lat; const float* base_ctx; float* out; const float* gate; int gstride;
    __device__ __forceinline__ void operator()(const f32x4 (&acc)[2][2][4][2], const Unit& u, int wr, int wc, int fr, int fq) const {
        const int row0 = u.pm * BM + wr * 64 + fr, col0 = u.pn * BM + wc * 32 + 4 * fq;
#pragma unroll
        for (int ai = 0; ai < 2; ++ai)
#pragma unroll
            for (int m = 0; m < 4; ++m) { const int row = row0 + ai * HALF + m * 16;
                const float* bp = (row < 16384) ? base_lat + (size_t)row * 1024 : base_ctx + (size_t)(row - 16384) * 1024;
                const float* gp = gate + (size_t)(row < 16384 ? (row >= 8192 ? 1 : 0) : 2) * gstride;
                float* op = out + (size_t)row * 1024;
#pragma unroll
                for (int bj = 0; bj < 2; ++bj)
#pragma unroll
                    for (int n = 0; n < 2; ++n) { const int c = col0 + bj * HALF + n * 16;
                        *(f32x4*)(op + c) = *(const f32x4*)(bp + c) + *(const f32x4*)(gp + c) * acc[ai][bj][m][n]; } }
    }
};
__device__ __forceinline__ float sigm_(float x) { return 1.0f / (1.0f + __expf(-x)); }
struct EpiSwiglu {
    static constexpr bool PERM = true, AFTER_DRAIN = false;
    bf16_t* O; const float* bgu;
    __device__ __forceinline__ void operator()(const f32x4 (&acc)[2][2][4][2], const Unit& u, int wr, int wc, int fr, int fq) const {
        const int row0 = u.pm * BM + wr * 64 + fr, col0 = u.pn * HALF + wc * 32 + 8 * fq;
        const float* bg = bgu + (size_t)u.e * 2048 + col0; f32x4 bgv[2], buv[2];
#pragma unroll
        for (int n = 0; n < 2; ++n) { bgv[n] = *(const f32x4*)(bg + 4 * n); buv[n] = *(const f32x4*)(bg + 1024 + 4 * n); }
#pragma unroll
        for (int ai = 0; ai < 2; ++ai)
#pragma unroll
            for (int m = 0; m < 4; ++m) { float r[8];
#pragma unroll
                for (int n = 0; n < 2; ++n) { const f32x4 g4 = acc[ai][0][m][n] + bgv[n], u4 = acc[ai][1][m][n] + buv[n];
#pragma unroll
                    for (int j = 0; j < 4; ++j) { const float g = fminf(g4[j], 7.0f), uu = fminf(fmaxf(u4[j], -7.0f), 7.0f); r[4 * n + j] = g * sigm_(1.702f * g) * (uu + 1.0f); } }
                u32x4 w; w.x = cvt_pk_bf16(r[0], r[1]); w.y = cvt_pk_bf16(r[2], r[3]); w.z = cvt_pk_bf16(r[4], r[5]); w.w = cvt_pk_bf16(r[6], r[7]);
                *(u32x4*)(O + (size_t)(row0 + ai * HALF + m * 16) * 1024 + col0) = w; }
    }
};
struct EpiDown {
    static constexpr bool PERM = true, AFTER_DRAIN = false;
    bf16_t* O; const float* bdn;
    __device__ __forceinline__ void operator()(const f32x4 (&acc)[2][2][4][2], const Unit& u, int wr, int wc, int fr, int fq) const {
        const int row0 = u.pm * BM + wr * 64 + fr, col0 = u.pn * BM + wc * 32 + 8 * fq;
        const float* bp = bdn + (size_t)u.e * 1024 + col0; f32x4 bv[2][2];
#pragma unroll
        for (int bj = 0; bj < 2; ++bj)
#pragma unroll
            for (int n = 0; n < 2; ++n) bv[bj][n] = *(const f32x4*)(bp + bj * HALF + 4 * n);
#pragma unroll
        for (int ai = 0; ai < 2; ++ai)
#pragma unroll
            for (int m = 0; m < 4; ++m) { bf16_t* rowp = O + (size_t)(row0 + ai * HALF + m * 16) * 1024 + col0;
#pragma unroll
                for (int bj = 0; bj < 2; ++bj) { const f32x4 v0 = acc[ai][bj][m][0] + bv[bj][0], v1 = acc[ai][bj][m][1] + bv[bj][1];
                    u32x4 w; w.x = cvt_pk_bf16(v0[0], v0[1]); w.y = cvt_pk_bf16(v0[2], v0[3]); w.z = cvt_pk_bf16(v1[0], v1[1]); w.w = cvt_pk_bf16(v1[2], v1[3]);
                    *(u32x4*)(rowp + bj * HALF) = w; } }
    }
};
struct EpiLora1 {
    static constexpr bool PERM = true, AFTER_DRAIN = false;
    bf16_t* O;
    __device__ __forceinline__ void operator()(const f32x4 (&acc)[2][2][4][2], const Unit& u, int wr, int wc, int fr, int fq) const {
        const int row0 = u.pm * BM + wr * 64 + fr, col0 = u.pn * HALF + wc * 32 + 8 * fq;
#pragma unroll
        for (int ai = 0; ai < 2; ++ai)
#pragma unroll
            for (int m = 0; m < 4; ++m) { float r[8];
#pragma unroll
                for (int n = 0; n < 2; ++n)
#pragma unroll
                    for (int j = 0; j < 4; ++j) { const float x = acc[ai][0][m][n][j]; r[4 * n + j] = (u.pn == 0) ? (2.0f * sigm_(2.0f * x) - 1.0f) : (u.pn == 1) ? x : sigm_(x); }
                u32x4 w; w.x = cvt_pk_bf16(r[0], r[1]); w.y = cvt_pk_bf16(r[2], r[3]); w.z = cvt_pk_bf16(r[4], r[5]); w.w = cvt_pk_bf16(r[6], r[7]);
                *(u32x4*)(O + (size_t)(row0 + ai * HALF + m * 16) * 384 + col0) = w; }
    }
};
struct EpiLora2 {
    static constexpr bool PERM = false, AFTER_DRAIN = false;
    float* WD; float* AD; float* G; const float* w0; const float* a0;
    __device__ __forceinline__ void operator()(const f32x4 (&acc)[2][2][4][2], const Unit& u, int wr, int wc, int fr, int fq) const {
        const int row0 = u.pm * BM + wr * 64 + fr, blk = u.pn >> 2, col0 = (u.pn & 3) * BM + wc * 32 + 4 * fq;
        float* dst = (blk < 2) ? WD + (size_t)blk * 16896 * 1024 : (blk < 4) ? AD + (size_t)(blk - 2) * 16896 * 1024 : G;
        const float* bias = (blk < 2) ? w0 + blk * 1024 : (blk < 4) ? a0 + (blk - 2) * 1024 : nullptr;
#pragma unroll
        for (int ai = 0; ai < 2; ++ai)
#pragma unroll
            for (int m = 0; m < 4; ++m) { float* rowp = dst + (size_t)(row0 + ai * HALF + m * 16) * 1024;
#pragma unroll
                for (int bj = 0; bj < 2; ++bj)
#pragma unroll
                    for (int n = 0; n < 2; ++n) { const int c = col0 + bj * HALF + n * 16; f32x4 v = acc[ai][bj][m][n];
                        if (bias) v = v + *(const f32x4*)(bias + c);
                        if (blk < 2) { for (int j = 0; j < 4; ++j) v[j] = __expf(-0.60653066f * sigm_(v[j])); }
                        else if (blk < 4) { for (int j = 0; j < 4; ++j) v[j] = sigm_(v[j]); }
                        *(f32x4*)(rowp + c) = v; } }
    }
};
}
enum { PH_PRE = 0, PH_NORM0, PH_G_IN, PH_GLA, PH_HGRO, PH_G_HGO, PH_FFN0, PH_GATHER0, PH_GU0, PH_DN0, PH_COMB0,
       PH_LERP, PH_G_RKV, PH_G_L2, PH_RWSCAN, PH_RWRO, PH_G_RWO, PH_FFN1, PH_GATHER1, PH_GU1, PH_DN1, PH_COMB1, NPHASES };

template <int ph> __device__ __forceinline__ void run_phase(const Params& p, LAS unsigned char* lds, int tid, int lane, int wave, int G, int bx, int vcu) {
    unsigned char* ws = p.ws;
    typedef pg8::bf16_t bt;
    switch (ph) {
        case PH_PRE: phase_pre(p, lds, tid, lane, wave); break;
        case PH_NORM0: phase_norm0(p, lane, wave); break;
        case PH_G_IN: {
            pg8::Gemm g{(const bt*)(ws + WS_H), (const bt*)(ws + WS_WIN), NROW, 5120, D}; pg8::StaticOrder S; S.init(NROW, 5120, G, bx);
            pg8::EpiStoreBf16 E{(bt*)(ws + WS_U + U_Z), 5120};
            pg8::gemm_phase<pg8::EpiStoreBf16, pg8::StaticOrder, true, true>(lds, g, S, E); } break;
        case PH_GLA: phase_gla_naive(p, lds, tid); break;
        case PH_HGRO: phase_hg_readout(p, lane, wave); break;
        case PH_G_HGO: {
            pg8::Gemm g{(const bt*)(ws + WS_A2), (const bt*)(ws + WS_WHGO), NROW, D, D}; pg8::StaticOrder S; S.init(NROW, D, G, bx);
            pg8::EpiResid E{p.in[I_X], p.in[I_CTX], (float*)(ws + WS_XR), modp(p, 0, 0, 2), 6144};
            pg8::gemm_phase<pg8::EpiResid, pg8::StaticOrder, true, true>(lds, g, S, E); } break;
        case PH_FFN0: phase_ffn_norm_route(p, 0, NROW, lane, wave); break;
        case PH_FFN1: phase_ffn_norm_route(p, 1, NLAT, lane, wave); break;
        case PH_GATHER0: phase_gather(p, 0, NROW, lds, tid, lane, wave); break;
        case PH_GATHER1: phase_gather(p, 1, NLAT, lds, tid, lane, wave); break;
        case PH_GU0: case PH_GU1: { const int layer = (ph == PH_GU1);
            pg8::Gemm g{(const bt*)(ws + WS_U + U_XB), (const bt*)(ws + WS_WGU) + (size_t)layer * NE * 2048 * D, CAP, 2048, D};
            pg8::MoeOrder S; S.init((const int*)(ws + WS_ROUTE + RT_TILEE), 8, (size_t)2048 * D * 2, G, vcu);
            pg8::EpiSwiglu E{(bt*)(ws + WS_U + U_ACT), p.in[I_BGU] + (size_t)layer * NE * 2048};
            pg8::gemm_phase<pg8::EpiSwiglu, pg8::MoeOrder, true, true>(lds, g, S, E); } break;
        case PH_DN0: case PH_DN1: { const int layer = (ph == PH_DN1);
            pg8::Gemm g{(const bt*)(ws + WS_U + U_ACT), (const bt*)(ws + WS_WD) + (size_t)layer * NE * D * D, CAP, D, D};
            pg8::MoeOrder S; S.init((const int*)(ws + WS_ROUTE + RT_TILEE), 4, (size_t)D * D * 2, G, vcu);
            pg8::EpiDown E{(bt*)(ws + WS_U + U_YS), p.in[I_BDN] + (size_t)layer * NE * D};
            pg8::gemm_phase<pg8::EpiDown, pg8::MoeOrder, true, true>(lds, g, S, E); } break;
        case PH_COMB0: phase_combine(p, 0, NROW, false, lane, wave); break;
        case PH_COMB1: phase_combine(p, 1, NLAT, true, lane, wave); break;
        case PH_LERP: phase_lerp(p, lane, wave); break;
        case PH_G_RKV: {
            { pg8::Gemm g{(const bt*)(ws + WS_U + U_XL6), (const bt*)(ws + WS_WRKV), NROW, 3072, D};
              pg8::SelOrder S; S.init(NROW, 3072, G, bx); S.div = 4; S.sel0 = 0; S.stride = (size_t)NROW * D * 2;
              pg8::EpiStoreF32 E{(float*)(ws + WS_U + U_RKV), 3072};
              pg8::gemm_phase<pg8::EpiStoreF32, pg8::SelOrder, true, true>(lds, g, S, E); }
            { pg8::Gemm g{(const bt*)(ws + WS_U + U_XL6), (const bt*)(ws + WS_WL1), NROW, 768, D};
              pg8::SelOrder S; S.init(NROW, 768, G, bx); S.div = 1; S.sel0 = 3; S.stride = (size_t)NROW * D * 2;
              pg8::EpiLora1 E{(bt*)(ws + WS_U + U_L1)};
              pg8::gemm_phase<pg8::EpiLora1, pg8::SelOrder, true, true>(lds, g, S, E); } } break;
        case PH_G_L2: {
            pg8::Gemm g{(const bt*)(ws + WS_U + U_L1), (const bt*)(ws + WS_WL2), NROW, 5120, 384}; pg8::StaticOrder S; S.init(NROW, 5120, G, bx);
            pg8::EpiLora2 E{(float*)(ws + WS_U + U_WD), (float*)(ws + WS_U + U_AD), (float*)(ws + WS_U + U_G), p.in[I_DECW0], p.in[I_A0]};
            pg8::gemm_phase<pg8::EpiLora2, pg8::StaticOrder, true, true>(lds, g, S, E); } break;
        case PH_RWSCAN: phase_rwkv_naive(p, lds, lane, wave); break;
        case PH_RWRO: phase_rw_readout(p, lane, wave); break;
        case PH_G_RWO: {
            pg8::Gemm g{(const bt*)(ws + WS_A2), (const bt*)(ws + WS_WRWO), NLAT, D, D}; pg8::StaticOrder S; S.init(NLAT, D, G, bx);
            float* XR = (float*)(ws + WS_XR);
            pg8::EpiResid E{XR, XR + (size_t)NLAT * D, XR, modp(p, 1, 0, 2), 6144};
            pg8::gemm_phase<pg8::EpiResid, pg8::StaticOrder, true, true>(lds, g, S, E); } break;
        default: break;
    }
}

#define MK_PROLOGUE \
    extern __shared__ __attribute__((aligned(16))) unsigned char lds_raw[]; \
    LAS unsigned char* lds = (LAS unsigned char*)lds_raw; \
    const int tid = threadIdx.x, lane = tid & 63, wave = __builtin_amdgcn_readfirstlane(tid >> 6); \
    const int G = gridDim.x, bx = blockIdx.x, vcu = (G % 8 == 0) ? (bx % 8) * (G / 8) + bx / 8 : bx;

template <int PH> __global__ void __launch_bounds__(NTHREADS, 2) mk_one(Params p) { MK_PROLOGUE run_phase<PH>(p, lds, tid, lane, wave, G, bx, vcu); }
typedef void (*phase_fn_t)(Params);
#define PF(k) mk_one<k>
static phase_fn_t g_phase_fn[NPHASES] = { PF(0), PF(1), PF(2), PF(3), PF(4), PF(5), PF(6), PF(7), PF(8), PF(9), PF(10), PF(11), PF(12), PF(13), PF(14), PF(15), PF(16), PF(17), PF(18), PF(19), PF(20), PF(21) };


extern "C" void kernel_launch(void* const* d_in, const int* in_sizes, int n_in, void* d_out, int out_size, void* d_ws, size_t ws_size, hipStream_t stream) {
    static int grid = 0;
    if (grid == 0) {
        if (n_in != 35 || in_sizes[0] != NLAT * D || out_size != NLAT * D || ws_size < WS_END) {
            fprintf(stderr, "kernel_launch: unexpected problem (n_in %d, in0 %d, out %d, ws %zu < %zu)\n", n_in, n_in > 0 ? in_sizes[0] : -1, out_size, ws_size, (size_t)WS_END); grid = -1; return; }
        int dev = 0, cus = 0, per_cu = 0;
        if (hipGetDevice(&dev) != hipSuccess || hipDeviceGetAttribute(&cus, hipDeviceAttributeMultiprocessorCount, dev) != hipSuccess) { grid = -1; return; }
        for (int ph = 0; ph < NPHASES; ++ph)
            if (hipFuncSetAttribute((const void*)g_phase_fn[ph], hipFuncAttributeMaxDynamicSharedMemorySize, LDS_BYTES) != hipSuccess) { fprintf(stderr, "kernel_launch: hipFuncSetAttribute failed (phase %d)\n", ph); grid = -1; return; }
        (void)per_cu;
        (void)hipGetLastError();
        grid = cus;
    }
    if (grid < 0) return;
    (void)hipMemsetAsync((char*)d_ws + WS_CTL, 0, CTL_ZERO_BYTES, stream);
    Params p{};
    for (int i = 0; i < 35; ++i) p.in[i] = (const float*)d_in[i];
    p.out = (float*)d_out; p.ws = (unsigned char*)d_ws;
    for (int ph = 0; ph < NPHASES; ++ph) {
        p.ph_lo = ph; p.ph_hi = ph + 1;
        hipLaunchKernelGGL(g_phase_fn[ph], dim3(grid), dim3(NTHREADS), LDS_BYTES, stream, p);
    }
}
```

```cpp
#include <hip/hip_runtime.h>
#include <hip/hip_cooperative_groups.h>
#include <cstdio>
#include <cstdint>
namespace pg8 {
#define PG8_LAS __attribute__((address_space(3)))
typedef unsigned short bf16_t;
typedef short bf16x8 __attribute__((ext_vector_type(8)));
typedef float f32x4 __attribute__((ext_vector_type(4)));
typedef unsigned u32x4 __attribute__((ext_vector_type(4)));
constexpr int BM = 256, BK = 64, HALF = 128, HTB = HALF * BK * 2  , STAGE_BYTES = 8 * HTB, NXCD = 8, WGM = 8;

__host__ __device__ __forceinline__ int lds_byte(int r, int c) { const int st = (r >> 4) * 2 + (c >> 5), rr = r & 15, cc = c & 31, ob = rr * 64 + cc * 2; return st * 1024 + (ob ^ (((ob >> 9) & 1) << 5)); }
__host__ __device__ __forceinline__ void stage_rc(int b, int& R, int& C) { const int st = b / 1024, sb = b % 1024, swz = sb ^ (((sb >> 9) & 1) << 5); R = (st >> 1) * 16 + swz / 64; C = (st & 1) * 32 + (swz % 64) / 2; }
__host__ __device__ __forceinline__ int perm32(int rho) { const int n = rho >> 4, i = rho & 15; return 8 * (i >> 2) + 4 * n + (i & 3); }

struct Unit { int pm, pn, e; };
struct Gemm { const bf16_t* A; const bf16_t* Bt; int M, N, K; };

struct StaticOrder {
    int nM, nN, nwg, G, c;
    __host__ __device__ void init(int M, int N, int G_, int c_) { nM = M / BM; nN = N / BM; nwg = nM * nN; G = G_; c = c_; }
    __host__ __device__ bool next(int i, Unit& u) const {
        const long L = (long)i * G + c; if (L >= nwg) return false;
        int wgid = (int)L; { const int q = nwg / NXCD, r = nwg % NXCD, xcd = wgid % NXCD, off = wgid / NXCD; wgid = (xcd < r ? xcd * (q + 1) : r * (q + 1) + (xcd - r) * q) + off; }
        const int nig = WGM * nN, gid = wgid / nig, fm = gid * WGM, gsz = (nM - fm) < WGM ? (nM - fm) : WGM;
        u.pm = fm + ((wgid % nig) % gsz); u.pn = (wgid % nig) / gsz; u.e = 0; return true;
    }
    __device__ __forceinline__ const char* abase(const Gemm& g, const Unit& u, size_t tstep) const { return (const char*)g.A + (size_t)u.pm * tstep; }
    __device__ __forceinline__ const char* bbase(const Gemm& g, const Unit& u, size_t tstep) const { return (const char*)g.Bt + (size_t)u.pn * tstep; }
    __device__ __forceinline__ void a_ready(const Unit&) const {}
    __device__ __forceinline__ void done(const Unit&) const {}
};

__device__ __forceinline__ unsigned cvt_pk_bf16(float lo, float hi) { unsigned r; asm volatile("v_cvt_pk_bf16_f32 %0, %1, %2" : "=v"(r) : "v"(lo), "v"(hi)); return r; }

template <class Epi, class Sched, bool ALIGN_EPI = false, bool SP2 = false>
__device__ __forceinline__ void gemm_phase(PG8_LAS unsigned char* lds, const Gemm g, const Sched& S, const Epi& E) {
    const int tid = threadIdx.x, wid = __builtin_amdgcn_readfirstlane(tid >> 6), lane = tid & 63, wr = wid >> 2, wc = wid & 3, fr = lane & 15, fq = lane >> 4;
    const int K = g.K, nt = K / BK;
    unsigned voffA[2], voffB[2];
#pragma unroll
    for (int i = 0; i < 2; ++i) { int R, C; stage_rc(tid * 16 + i * 8192, R, C); const int Rb = Epi::PERM ? ((R & ~31) + perm32(R & 31)) : R;
        voffA[i] = (unsigned)(R * K + C) * 2u; voffB[i] = (unsigned)(Rb * K + C) * 2u; }
    const size_t kstep = (size_t)(BK * 2);
    const size_t hstep = (size_t)HALF * K * 2;
    const size_t tstep = 2 * hstep;
    const unsigned ldsw = (unsigned)wid * 1024u;
    const int aoff = lds_byte(wr * 64 + fr, fq * 8), boff = lds_byte(wc * 32 + fr, fq * 8);
#define PG8_SA(b, h) (((b) * 2 + (h)) * HTB)
#define PG8_SB(b, h) ((4 + (b) * 2 + (h)) * HTB)
#define PG8_STAGE(bufoff, gbase, voff) do { _Pragma("unroll") for (int _i = 0; _i < 2; ++_i) \
        __builtin_amdgcn_global_load_lds((const unsigned*)((const char*)(gbase) + (voff)[_i]), (PG8_LAS unsigned*)(lds + (bufoff) + ldsw + _i * 8192), 16, 0, 0); } while (0)
#define PG8_LDA(dst, b, h) do { _Pragma("unroll") for (int m = 0; m < 4; ++m) _Pragma("unroll") for (int k = 0; k < 2; ++k) dst[m][k] = *(const PG8_LAS bf16x8*)(lds + PG8_SA(b, h) + aoff + m * 2048 + k * 1024); } while (0)
#define PG8_LDB(dst, b, h) do { _Pragma("unroll") for (int n = 0; n < 2; ++n) _Pragma("unroll") for (int k = 0; k < 2; ++k) dst[n][k] = *(const PG8_LAS bf16x8*)(lds + PG8_SB(b, h) + boff + n * 2048 + k * 1024); } while (0)
#define PG8_MMA(ai, bj, At, Bt) do { __builtin_amdgcn_s_setprio(1); _Pragma("unroll") for (int m = 0; m < 4; ++m) _Pragma("unroll") for (int n = 0; n < 2; ++n) _Pragma("unroll") for (int k = 0; k < 2; ++k) \
        acc[ai][bj][m][n] = __builtin_amdgcn_mfma_f32_16x16x32_bf16(Bt[n][k], At[m][k], acc[ai][bj][m][n], 0, 0, 0); __builtin_amdgcn_s_setprio(0); } while (0)
#define PG8_WAIT_V(n) asm volatile("s_waitcnt vmcnt(" #n ")" ::: "memory")
#define PG8_WAIT_L(n) asm volatile("s_waitcnt lgkmcnt(" #n ")" ::: "memory")
#define PG8_BAR __builtin_amdgcn_s_barrier()
#define PG8_SCHED __builtin_amdgcn_sched_barrier(0)
    Unit cur, nxt; int ui = 0;
    if (!S.next(0, cur)) return;
    f32x4 acc[2][2][4][2];
#pragma unroll
    for (int a = 0; a < 2; ++a)
#pragma unroll
        for (int b = 0; b < 2; ++b)
#pragma unroll
            for (int m = 0; m < 4; ++m)
#pragma unroll
                for (int n = 0; n < 2; ++n) acc[a][b][m][n] = (f32x4){0.f, 0.f, 0.f, 0.f};
    bf16x8 At[4][2], B0[2][2], B1[2][2];
    const char* cA = S.abase(g, cur, tstep); const char* cB = S.bbase(g, cur, tstep);
    S.a_ready(cur);
    if constexpr (SP2) {
        PG8_STAGE(PG8_SB(0, 0), cB, voffB); PG8_STAGE(PG8_SB(0, 1), cB + hstep, voffB); PG8_STAGE(PG8_SA(0, 0), cA, voffA); PG8_STAGE(PG8_SA(0, 1), cA + hstep, voffA);
        if (wr == 1) PG8_BAR;
        PG8_WAIT_V(2); PG8_BAR;
        PG8_STAGE(PG8_SB(1, 0), cB + kstep, voffB); PG8_STAGE(PG8_SA(1, 0), cA + kstep, voffA); PG8_STAGE(PG8_SB(1, 1), cB + hstep + kstep, voffB);
        PG8_WAIT_V(6); PG8_BAR;
    } else {
        PG8_STAGE(PG8_SB(0, 0), cB, voffB); PG8_STAGE(PG8_SA(0, 0), cA, voffA); PG8_STAGE(PG8_SB(0, 1), cB + hstep, voffB); PG8_STAGE(PG8_SA(0, 1), cA + hstep, voffA);
        if (wr == 1) PG8_BAR;
        PG8_WAIT_V(4); PG8_BAR;
        PG8_STAGE(PG8_SB(1, 0), cB + kstep, voffB); PG8_STAGE(PG8_SA(1, 0), cA + kstep, voffA); PG8_STAGE(PG8_SB(1, 1), cB + hstep + kstep, voffB);
        PG8_WAIT_V(6); PG8_BAR;
    }
    for (;;) {
        const bool has_next = S.next(ui + 1, nxt);
        const char* nA = has_next ? S.abase(g, nxt, tstep) : cA; const char* nB = has_next ? S.bbase(g, nxt, tstep) : cB;
        _Pragma("unroll 1") for (int t = 0; t < nt; t += 2) {
            const bool last = (t == nt - 2);
            const char* a1 = cA + (size_t)(t + 1) * kstep;
            const char* a2 = last ? nA : cA + (size_t)(t + 2) * kstep; const char* b2 = last ? nB : cB + (size_t)(t + 2) * kstep;
            const char* a3 = a2 + kstep; const char* b3 = b2 + kstep;
            if (last && has_next) S.a_ready(nxt);
            if constexpr (SP2) {
            PG8_LDB(B0, 0, 0); PG8_LDB(B1, 0, 1); PG8_SCHED; PG8_LDA(At, 0, 0); PG8_STAGE(PG8_SA(1, 1), a1 + hstep, voffA);
            PG8_WAIT_V(8); PG8_WAIT_L(0); PG8_BAR; PG8_MMA(0, 0, At, B0); PG8_MMA(0, 1, At, B1); PG8_BAR; PG8_SCHED;
            PG8_LDA(At, 0, 1); PG8_STAGE(PG8_SB(0, 0), b2, voffB); PG8_STAGE(PG8_SB(0, 1), b2 + hstep, voffB); PG8_STAGE(PG8_SA(0, 0), a2, voffA);
            PG8_WAIT_V(8); PG8_WAIT_L(0); PG8_BAR; PG8_MMA(1, 0, At, B0); PG8_MMA(1, 1, At, B1); PG8_BAR; PG8_SCHED;
            PG8_LDB(B0, 1, 0); PG8_LDB(B1, 1, 1); PG8_SCHED; PG8_LDA(At, 1, 0); PG8_STAGE(PG8_SA(0, 1), a2 + hstep, voffA);
            PG8_WAIT_V(8); PG8_WAIT_L(0); PG8_BAR; PG8_MMA(0, 0, At, B0); PG8_MMA(0, 1, At, B1); PG8_BAR; PG8_SCHED;
            PG8_LDA(At, 1, 1); PG8_STAGE(PG8_SB(1, 0), b3, voffB); PG8_STAGE(PG8_SB(1, 1), b3 + hstep, voffB); PG8_STAGE(PG8_SA(1, 0), a3, voffA);
            PG8_WAIT_V(8); PG8_WAIT_L(0); PG8_BAR; PG8_MMA(1, 0, At, B0); PG8_MMA(1, 1, At, B1); PG8_BAR; PG8_SCHED;
            } else {
            PG8_LDB(B0, 0, 0); PG8_SCHED; PG8_LDA(At, 0, 0); PG8_STAGE(PG8_SA(1, 1), a1 + hstep, voffA);
            PG8_WAIT_L(8); PG8_BAR; PG8_WAIT_L(0); PG8_MMA(0, 0, At, B0); PG8_BAR; PG8_SCHED;
            PG8_LDB(B1, 0, 1); PG8_STAGE(PG8_SB(0, 0), b2, voffB);
            PG8_BAR; PG8_WAIT_L(0); PG8_MMA(0, 1, At, B1); PG8_BAR;
            PG8_LDA(At, 0, 1); PG8_STAGE(PG8_SA(0, 0), a2, voffA);
            PG8_BAR; PG8_WAIT_L(0); PG8_MMA(1, 0, At, B0); PG8_BAR; PG8_SCHED;
            PG8_STAGE(PG8_SB(0, 1), b2 + hstep, voffB);
            PG8_WAIT_V(6); PG8_BAR; PG8_MMA(1, 1, At, B1); PG8_BAR;
            PG8_LDB(B0, 1, 0); PG8_SCHED; PG8_LDA(At, 1, 0); PG8_STAGE(PG8_SA(0, 1), a2 + hstep, voffA);
            PG8_WAIT_L(8); PG8_BAR; PG8_WAIT_L(0); PG8_MMA(0, 0, At, B0); PG8_BAR; PG8_SCHED;
            PG8_LDB(B1, 1, 1); PG8_STAGE(PG8_SB(1, 0), b3, voffB);
            PG8_BAR; PG8_WAIT_L(0); PG8_MMA(0, 1, At, B1); PG8_BAR;
            PG8_LDA(At, 1, 1); PG8_STAGE(PG8_SA(1, 0), a3, voffA);
            PG8_BAR; PG8_WAIT_L(0); PG8_MMA(1, 0, At, B0); PG8_BAR; PG8_SCHED;
            PG8_STAGE(PG8_SB(1, 1), b3 + hstep, voffB);
            PG8_WAIT_V(6); PG8_BAR; PG8_MMA(1, 1, At, B1); PG8_BAR;
            }
        }
        if constexpr (ALIGN_EPI) { if (wr == 0) PG8_BAR; }
        if constexpr (!Epi::AFTER_DRAIN) { E(acc, cur, wr, wc, fr, fq); S.done(cur); }
        if (!has_next) break;
#pragma unroll
        for (int a = 0; a < 2; ++a)
#pragma unroll
            for (int b = 0; b < 2; ++b)
#pragma unroll
                for (int m = 0; m < 4; ++m)
#pragma unroll
                    for (int n = 0; n < 2; ++n) acc[a][b][m][n] = (f32x4){0.f, 0.f, 0.f, 0.f};
        cur = nxt; cA = nA; cB = nB; ++ui;
        if constexpr (ALIGN_EPI) { if (wr == 1) PG8_BAR; }
    }
    PG8_WAIT_V(0);
    if constexpr (!ALIGN_EPI) { if (wr == 0) PG8_BAR; }
    PG8_BAR;
    if constexpr (Epi::AFTER_DRAIN) { E.fused(acc, cur, wr, wc, fr, fq, lds, wid, lane); S.done(cur); }
#undef PG8_SA
#undef PG8_SB
#undef PG8_STAGE
#undef PG8_LDA
#undef PG8_LDB
#undef PG8_MMA
#undef PG8_WAIT_V
#undef PG8_WAIT_L
#undef PG8_BAR
#undef PG8_SCHED
}
}

constexpr int D = 1024, NBATCH = 2, SEQ = 8192, CTXL = 256;
constexpr int NLAT = NBATCH * SEQ, NCTX = NBATCH * CTXL, NROW = NLAT + NCTX;
constexpr int NE = 32, TOPK = 4, MAXTILES = 296, CAP = MAXTILES * 256;
constexpr int NWAVES = 8, NTHREADS = 512;
constexpr float NORM_EPS = 1e-6f;
constexpr int LDS_BYTES = 147456;

constexpr size_t MiB = 1u << 20;
constexpr size_t WS_CTL = 0, CTL_ZERO_BYTES = 1 * MiB;
constexpr size_t WS_MOD = 1 * MiB;
constexpr size_t WS_ROUTE = 2 * MiB;
constexpr size_t RT_TOPI = 0, RT_TOPG = 320 * 1024, RT_POS = 640 * 1024, RT_SLOT = 960 * 1024, RT_RSTD = 1280 * 1024, RT_TILEE = 1408 * 1024;
constexpr size_t WS_WIN = 4 * MiB, WS_WHGO = 14 * MiB, WS_WRKV = 16 * MiB, WS_WL1 = 22 * MiB, WS_WL2 = 24 * MiB, WS_WRWO = 28 * MiB;
constexpr size_t WS_WGU = 32 * MiB, WS_WD = 288 * MiB;
constexpr size_t WS_XR = 416 * MiB, WS_H = 482 * MiB, WS_H2 = 515 * MiB, WS_A2 = 548 * MiB;
constexpr size_t WS_U = 584 * MiB;
constexpr size_t U_Z = 0, U_OD0 = 166 * MiB;
constexpr size_t U_XL6 = 0, U_RKV = 198 * MiB, U_L1 = 396 * MiB, U_WD = 410 * MiB, U_AD = 542 * MiB, U_G = 674 * MiB, U_OD1 = 740 * MiB;
constexpr size_t U_XB = 0, U_ACT = 148 * MiB, U_YS = 296 * MiB;
constexpr size_t WS_END = WS_U + 872 * MiB;
constexpr int CW_CNT = 64;
constexpr int CW_BAR = 4096;

#define LAS __attribute__((address_space(3)))
typedef unsigned short bf16;
typedef unsigned v4u __attribute__((ext_vector_type(4)));
typedef unsigned v2u __attribute__((ext_vector_type(2)));
typedef float f32x4 __attribute__((ext_vector_type(4)));
#define LDS_WAIT() asm volatile("s_waitcnt lgkmcnt(0)" ::: "memory")
__device__ __forceinline__ unsigned f2bf(float f) { unsigned u = __builtin_bit_cast(unsigned, f); return (u + 0x7fffu + ((u >> 16) & 1u)) >> 16; }
__device__ __forceinline__ unsigned pk2(float lo, float hi) { return f2bf(lo) | (f2bf(hi) << 16); }
__device__ __forceinline__ float bf2f(unsigned b) { return __builtin_bit_cast(float, b << 16); }
__device__ __forceinline__ float wave_sum(float v) {
#pragma unroll
    for (int o = 1; o < 64; o <<= 1) v += __shfl_xor(v, o);
    return v;
}
__device__ __forceinline__ float sigm(float x) { return 1.0f / (1.0f + __expf(-x)); }

struct Params { const float* in[35]; float* out; unsigned char* ws; int ph_lo, ph_hi; };
typedef const __attribute__((address_space(4))) Params* PP;
enum { I_X = 0, I_C, I_CTX, I_CCTX, I_ADAW, I_ADAB, I_NMIX, I_NFFN, I_HGWIN, I_HGGN, I_HGWOUT, I_HGLB, I_MU, I_WRKV, I_DECW0, I_DECW1, I_DECW2,
       I_A0, I_A1, I_A2, I_G1, I_G2, I_KK, I_KA, I_RK, I_LNXW, I_LNXB, I_RWOUT, I_ROUTW, I_ROUTB, I_WGU, I_BGU, I_WDN, I_BDN, I_FINALG };

__device__ __forceinline__ const float* modp(PP p, int l, int v, int j) { return (const float*)(p->ws + WS_MOD) + ((size_t)(l * 3 + v) * 6 + j) * D; }
__device__ __forceinline__ int row_vec(int row) { return row < NLAT ? (row >= SEQ ? 1 : 0) : 2; }

__device__ __forceinline__ void transpose_item(const float* src, int src_ld, bf16* dst, int dst_ld, LAS float* scr, int lane) {
    if (src) {
#pragma unroll 8
        for (int i = 0; i < 32; ++i) { const int kk = 2 * i + (lane >> 5); scr[kk * 33 + (lane & 31)] = src[(size_t)kk * src_ld + (lane & 31)]; }
    }
    LDS_WAIT(); asm volatile("" ::: "memory");
    const int c = lane & 7;
#pragma unroll
    for (int j = 0; j < 4; ++j) {
        const int n = (lane >> 3) + 8 * j; v4u o = (v4u){0u, 0u, 0u, 0u};
        if (src) { const LAS float* s = scr + (8 * c) * 33 + n;
            o.x = pk2(s[0 * 33], s[1 * 33]); o.y = pk2(s[2 * 33], s[3 * 33]); o.z = pk2(s[4 * 33], s[5 * 33]); o.w = pk2(s[6 * 33], s[7 * 33]); }
        *(v4u*)(dst + (size_t)n * dst_ld + 8 * c) = o;
    }
    LDS_WAIT(); asm volatile("" ::: "memory");
}
__device__ __forceinline__ void conv_plain(const float* W, int K, int N, bf16* WT, int r, LAS float* scr, int lane) {
    const int nblk = N / 32, kb = r / nblk, nb = r % nblk;
    transpose_item(W + (size_t)(kb * 64) * N + nb * 32, N, WT + (size_t)(nb * 32) * K + kb * 64, K, scr, lane);
}
constexpr int IT_WIN = 16 * 160, IT_SQ = 16 * 32, IT_L1 = 16 * 24, IT_L2 = 160 * 6, IT_GU = 64 * 16 * 64, IT_DN = 64 * 16 * 32;
constexpr int IT_TOTAL = IT_WIN + IT_SQ + 3 * IT_SQ + IT_SQ + IT_L1 + IT_L2 + IT_GU + IT_DN;
__device__ __forceinline__ void convert_item(PP p, int it, LAS float* scr, int lane) {
    unsigned char* ws = p->ws; int r = it;
    if (r < IT_WIN) { conv_plain(p->in[I_HGWIN], D, 5120, (bf16*)(ws + WS_WIN), r, scr, lane); return; } r -= IT_WIN;
    if (r < IT_SQ) { conv_plain(p->in[I_HGWOUT], D, D, (bf16*)(ws + WS_WHGO), r, scr, lane); return; } r -= IT_SQ;
    if (r < 3 * IT_SQ) { const int j = r / IT_SQ; conv_plain(p->in[I_WRKV] + (size_t)j * D * D, D, D, (bf16*)(ws + WS_WRKV) + (size_t)j * D * D, r % IT_SQ, scr, lane); return; } r -= 3 * IT_SQ;
    if (r < IT_SQ) { conv_plain(p->in[I_RWOUT], D, D, (bf16*)(ws + WS_WRWO), r, scr, lane); return; } r -= IT_SQ;
    if (r < IT_L1) {
        const int kb = r / 24, rg = r % 24, tile = rg >> 3, within = rg & 7; const float* src = nullptr; int ld = 64;
        if (within < 4) {
            if (tile == 0) src = p->in[I_DECW1] + (size_t)(within >> 1) * D * 64 + (size_t)(kb * 64) * 64 + (within & 1) * 32;
            else if (tile == 1) src = p->in[I_A1] + (size_t)(within >> 1) * D * 64 + (size_t)(kb * 64) * 64 + (within & 1) * 32;
            else { src = p->in[I_G1] + (size_t)(kb * 64) * 128 + within * 32; ld = 128; }
        }
        transpose_item(src, ld, (bf16*)(ws + WS_WL1) + (size_t)(rg * 32) * D + kb * 64, D, scr, lane); return; } r -= IT_L1;
    if (r < IT_L2) {
        const int rg = r / 6, kb = r % 6, n0 = rg * 32, blk = n0 >> 10, nn0 = n0 & 1023; const float* src = nullptr;
        if (blk < 2) { if (kb == blk) src = p->in[I_DECW2] + (size_t)blk * 64 * D + nn0; }
        else if (blk < 4) { if (kb == blk) src = p->in[I_A2] + (size_t)(blk - 2) * 64 * D + nn0; }
        else { if (kb >= 4) src = p->in[I_G2] + (size_t)(kb - 4) * 64 * D + nn0; }
        transpose_item(src, D, (bf16*)(ws + WS_WL2) + (size_t)n0 * 384 + kb * 64, 384, scr, lane); return; } r -= IT_L2;
    if (r < IT_GU) {
        const int mat = r >> 10, q = r & 1023, kb = q >> 6, nb = q & 63, n0 = nb * 32;
        const int j0 = n0 & 1023, drow = 256 * (j0 >> 7) + (n0 >= 1024 ? 128 : 0) + (j0 & 127);
        transpose_item(p->in[I_WGU] + (size_t)mat * D * 2048 + (size_t)(kb * 64) * 2048 + n0, 2048, (bf16*)(ws + WS_WGU) + (size_t)mat * 2048 * D + (size_t)drow * D + kb * 64, D, scr, lane); return; } r -= IT_GU;
    { const int mat = r >> 9, q = r & 511;
      conv_plain(p->in[I_WDN] + (size_t)mat * D * D, D, D, (bf16*)(ws + WS_WD) + (size_t)mat * D * D, q, scr, lane); }
}
__device__ __forceinline__ void phase_pre(PP p, LAS unsigned char* lds, int tid, int lane, int wave) {
    if (blockIdx.x < 192) {
        const int layer = blockIdx.x / 96, col = (blockIdx.x % 96) * 64 + lane;
        const float* W = p->in[I_ADAW] + (size_t)layer * D * 6144 + col;
        const float* c = p->in[I_C]; const float* cc = p->in[I_CCTX];
        float a0 = 0.f, a1 = 0.f, a2 = 0.f;
#pragma unroll 8
        for (int k = wave * 128; k < wave * 128 + 128; ++k) {
            const float wv = W[(size_t)k * 6144]; const float c0 = c[k], c1 = c[D + k], c2 = cc[k];
            a0 += c0 * sigm(c0) * wv; a1 += c1 * sigm(c1) * wv; a2 += c2 * sigm(c2) * wv;
        }
        LAS float* red = (LAS float*)lds;
        red[(wave * 3 + 0) * 64 + lane] = a0; red[(wave * 3 + 1) * 64 + lane] = a1; red[(wave * 3 + 2) * 64 + lane] = a2;
        __syncthreads();
        if (wave == 0) {
            float s0 = 0.f, s1 = 0.f, s2 = 0.f;
#pragma unroll
            for (int w = 0; w < 8; ++w) { s0 += red[(w * 3 + 0) * 64 + lane]; s1 += red[(w * 3 + 1) * 64 + lane]; s2 += red[(w * 3 + 2) * 64 + lane]; }
            const float bb = p->in[I_ADAB][layer * 6144 + col];
            float* M = (float*)(p->ws + WS_MOD) + (size_t)layer * 3 * 6144 + col;
            M[0] = s0 + bb; M[6144] = s1 + bb; M[2 * 6144] = s2 + bb;
        }
        __syncthreads();
    }
    LAS float* scr = (LAS float*)(lds + wave * 16384);
    const int gw = blockIdx.x * NWAVES + wave, NGW = gridDim.x * NWAVES;
    for (int it = gw; it < IT_TOTAL; it += NGW) convert_item(p, it, scr, lane);
}

__device__ __forceinline__ void load_row(const float* row, int lane, f32x4 (&v)[4]) {
#pragma unroll
    for (int j = 0; j < 4; ++j) v[j] = ((const f32x4*)row)[lane + 64 * j];
}
__device__ __forceinline__ float row_rstd(const f32x4 (&v)[4]) {
    float s = 0.f;
#pragma unroll
    for (int j = 0; j < 4; ++j) s += (v[j].x * v[j].x + v[j].y * v[j].y) + (v[j].z * v[j].z + v[j].w * v[j].w);
    return rsqrtf(wave_sum(s) * (1.0f / D) + NORM_EPS);
}
__device__ __forceinline__ void norm_mod(const f32x4 (&v)[4], float rstd, const float* g, const float* shift, const float* scale, int lane, f32x4 (&h)[4]) {
#pragma unroll
    for (int j = 0; j < 4; ++j) {
        const f32x4 gg = ((const f32x4*)g)[lane + 64 * j], sh = ((const f32x4*)shift)[lane + 64 * j], sc = ((const f32x4*)scale)[lane + 64 * j];
        h[j] = v[j] * rstd * gg * (sc + 1.0f) + sh;
    }
}
__device__ __forceinline__ void store_row_bf16(bf16* row, int lane, const f32x4 (&h)[4]) {
#pragma unroll
    for (int j = 0; j < 4; ++j) { v2u w; w.x = pk2(h[j].x, h[j].y); w.y = pk2(h[j].z, h[j].w); ((v2u*)row)[lane + 64 * j] = w; }
}
__device__ __forceinline__ const float* resid_row(PP p, int layer0_inputs, int row) {
    if (layer0_inputs) return row < NLAT ? p->in[I_X] + (size_t)row * D : p->in[I_CTX] + (size_t)(row - NLAT) * D;
    return (const float*)(p->ws + WS_XR) + (size_t)row * D;
}
__device__ __forceinline__ void phase_norm0(PP p, int lane, int wave) {
    const int gw = blockIdx.x * NWAVES + wave, NGW = gridDim.x * NWAVES;
    for (int row = gw; row < NROW; row += NGW) {
        f32x4 v[4], h[4]; load_row(resid_row(p, 1, row), lane, v);
        const float rstd = row_rstd(v); const int vec = row_vec(row);
        norm_mod(v, rstd, p->in[I_NMIX], modp(p, 0, vec, 0), modp(p, 0, vec, 1), lane, h);
        store_row_bf16((bf16*)(p->ws + WS_H) + (size_t)row * D, lane, h);
    }
}
__device__ __forceinline__ void phase_ffn_norm_route(PP p, int layer, int nrows, int lane, int wave) {
    const int gw = blockIdx.x * NWAVES + wave, NGW = gridDim.x * NWAVES;
    const float* rw = p->in[I_ROUTW] + (size_t)layer * D * NE; const float* rb = p->in[I_ROUTB] + layer * NE;
    int* TOPI = (int*)(p->ws + WS_ROUTE + RT_TOPI); float* TOPG = (float*)(p->ws + WS_ROUTE + RT_TOPG); int* POS = (int*)(p->ws + WS_ROUTE + RT_POS);
    unsigned* cnt = (unsigned*)(p->ws + WS_CTL) + CW_CNT + layer * NE;
    for (int row = gw; row < nrows; row += NGW) {
        f32x4 v[4], h[4]; load_row((const float*)(p->ws + WS_XR) + (size_t)row * D, lane, v);
        const float rstd = row_rstd(v); const int vec = row_vec(row);
        norm_mod(v, rstd, p->in[I_NFFN] + layer * D, modp(p, layer, vec, 3), modp(p, layer, vec, 4), lane, h);
        store_row_bf16((bf16*)(p->ws + WS_H2) + (size_t)row * D, lane, h);
        float part[NE];
#pragma unroll
        for (int e = 0; e < NE; ++e) part[e] = 0.f;
#pragma unroll
        for (int j = 0; j < 4; ++j)
#pragma unroll
            for (int i = 0; i < 4; ++i) {
                const float hv = h[j][i]; const f32x4* wr = (const f32x4*)(rw + (size_t)(4 * lane + 256 * j + i) * NE);
#pragma unroll
                for (int q = 0; q < 8; ++q) { const f32x4 w4 = wr[q]; part[4 * q + 0] += hv * w4.x; part[4 * q + 1] += hv * w4.y; part[4 * q + 2] += hv * w4.z; part[4 * q + 3] += hv * w4.w; }
            }
#pragma unroll
        for (int e = 0; e < NE; ++e) part[e] = wave_sum(part[e]) + rb[e];
        unsigned taken = 0u; int idx[TOPK]; float val[TOPK];
#pragma unroll
        for (int k = 0; k < TOPK; ++k) {
            float best = -3.0e38f; int bi = 0;
#pragma unroll
            for (int e = 0; e < NE; ++e) { const bool ok = !((taken >> e) & 1u) && (part[e] > best); best = ok ? part[e] : best; bi = ok ? e : bi; }
            taken |= 1u << bi; idx[k] = bi; val[k] = best;
        }
        float ex[TOPK], se = 0.f;
#pragma unroll
        for (int k = 0; k < TOPK; ++k) { ex[k] = __expf(val[k] - val[0]); se += ex[k]; }
        if (lane == 0) {
#pragma unroll
            for (int k = 0; k < TOPK; ++k) {
                TOPI[row * 4 + k] = idx[k]; TOPG[row * 4 + k] = ex[k] / se;
                POS[row * 4 + k] = (int)atomicAdd(cnt + idx[k], 1u);
            }
        }
    }
}
__device__ __forceinline__ void phase_gather(PP p, int layer, int nrows, LAS unsigned char* lds, int tid, int lane, int wave) {
    LAS int* off = (LAS int*)lds;
    const unsigned* cnt = (const unsigned*)(p->ws + WS_CTL) + CW_CNT + layer * NE;
    int* TILEE = (int*)(p->ws + WS_ROUTE + RT_TILEE);
    if (tid == 0) {
        int o = 0;
        for (int e = 0; e < NE; ++e) { off[e] = o; const int nt = ((int)__hip_atomic_load(cnt + e, __ATOMIC_RELAXED, __HIP_MEMORY_SCOPE_AGENT) + 255) >> 8;
            if (blockIdx.x == 0) for (int t = 0; t < nt; ++t) TILEE[1 + (o >> 8) + t] = e;
            o += nt << 8; }
        off[NE] = o; if (blockIdx.x == 0) TILEE[0] = o >> 8;
    }
    __syncthreads();
    const int* TOPI = (const int*)(p->ws + WS_ROUTE + RT_TOPI); const int* POS = (const int*)(p->ws + WS_ROUTE + RT_POS); int* SLOT = (int*)(p->ws + WS_ROUTE + RT_SLOT);
    const bf16* H2 = (const bf16*)(p->ws + WS_H2); bf16* XB = (bf16*)(p->ws + WS_U + U_XB);
    const int gw = blockIdx.x * NWAVES + wave, NGW = gridDim.x * NWAVES;
    for (int it = gw; it < nrows * TOPK; it += NGW) {
        const int row = it >> 2; const int slot = off[TOPI[it]] + POS[it];
        if (lane == 0) SLOT[it] = slot;
        const v4u* s = (const v4u*)(H2 + (size_t)row * D); v4u* d = (v4u*)(XB + (size_t)slot * D);
        d[lane] = s[lane]; d[lane + 64] = s[lane + 64];
    }
    __syncthreads();
}
__device__ __forceinline__ void phase_combine(PP p, int layer, int nrows, bool final_out, int lane, int wave) {
    const int gw = blockIdx.x * NWAVES + wave, NGW = gridDim.x * NWAVES;
    const float* TOPG = (const float*)(p->ws + WS_ROUTE + RT_TOPG); const int* SLOT = (const int*)(p->ws + WS_ROUTE + RT_SLOT);
    const bf16* YS = (const bf16*)(p->ws + WS_U + U_YS); float* XR = (float*)(p->ws + WS_XR); float* RSTD = (float*)(p->ws + WS_ROUTE + RT_RSTD);
    for (int row = gw; row < nrows; row += NGW) {
        f32x4 v[4], acc[4]; load_row(XR + (size_t)row * D, lane, v);
#pragma unroll
        for (int j = 0; j < 4; ++j) acc[j] = (f32x4){0.f, 0.f, 0.f, 0.f};
#pragma unroll
        for (int k = 0; k < TOPK; ++k) {
            const float gk = TOPG[row * 4 + k]; const v2u* ys = (const v2u*)(YS + (size_t)SLOT[row * 4 + k] * D);
#pragma unroll
            for (int j = 0; j < 4; ++j) { const v2u w = ys[lane + 64 * j];
                acc[j].x += gk * bf2f(w.x & 0xffffu); acc[j].y += gk * bf2f(w.x >> 16); acc[j].z += gk * bf2f(w.y & 0xffffu); acc[j].w += gk * bf2f(w.y >> 16); }
        }
        const float* m5 = modp(p, layer, row_vec(row), 5);
#pragma unroll
        for (int j = 0; j < 4; ++j) v[j] = v[j] + ((const f32x4*)m5)[lane + 64 * j] * acc[j];
        const float rstd = row_rstd(v);
        if (final_out) {
#pragma unroll
            for (int j = 0; j < 4; ++j) ((f32x4*)(p->out + (size_t)row * D))[lane + 64 * j] = v[j] * rstd * ((const f32x4*)p->in[I_FINALG])[lane + 64 * j];
        } else {
#pragma unroll
            for (int j = 0; j < 4; ++j) ((f32x4*)(XR + (size_t)row * D))[lane + 64 * j] = v[j];
            if (lane == 0) RSTD[row] = rstd;
        }
    }
}

__device__ __forceinline__ int step_row(int b, int dir, int step) {
    if (step < CTXL) { const int t = dir ? (CTXL - 1 - step) : step; return NLAT + b * CTXL + t; }
    const int s = step - CTXL; const int t = dir ? (SEQ - 1 - s) : s; return b * SEQ + t;
}
constexpr int NSTEP = CTXL + SEQ;

__device__ __forceinline__ void phase_gla_naive(PP p, LAS unsigned char* lds, int tid) {
    if (blockIdx.x >= 8) return;
    const int ci = tid >> 7, v = tid & 127, chain = blockIdx.x * 4 + ci, b = chain >> 4, dir = (chain >> 3) & 1, h = chain & 7;
    const bf16* Z = (const bf16*)(p->ws + WS_U + U_Z); float* OD = (float*)(p->ws + WS_U + U_OD0) + (size_t)dir * NROW * D;
    float lbv; { const float* lb = p->in[I_HGLB] + (size_t)dir * 3 * D + h * 128 + v; const float a0 = lb[0], a1 = lb[D], a2 = lb[2 * D];
                 const float m = fmaxf(a0, fmaxf(a1, a2)); const float e0 = __expf(a0 - m), e1 = __expf(a1 - m), e2 = __expf(a2 - m); lbv = e0 / (e0 + e1 + e2); }
    LAS float* LF = (LAS float*)lds;
    LAS float* LQ = (LAS float*)(lds + 4096);
    float S[128];
#pragma unroll
    for (int k = 0; k < 128; ++k) S[k] = 0.f;
    int row = step_row(b, dir, 0);
    unsigned zf = Z[(size_t)row * 5120 + 1024 * (1 + dir) + h * 128 + v], zq = Z[(size_t)row * 5120 + h * 128 + v], zv = Z[(size_t)row * 5120 + 3072 + h * 128 + v];
    for (int step = 0; step < NSTEP; ++step) {
        const float fh = bf2f(zf), qv = bf2f(zq), vv = bf2f(zv); const int crow = row;
        if (step + 1 < NSTEP) { row = step_row(b, dir, step + 1);
            zf = Z[(size_t)row * 5120 + 1024 * (1 + dir) + h * 128 + v]; zq = Z[(size_t)row * 5120 + h * 128 + v]; zv = Z[(size_t)row * 5120 + 3072 + h * 128 + v]; }
        const int buf = step & 1;
        LF[(buf * 4 + ci) * 128 + v] = lbv + (1.f - lbv) * sigm(fh); LQ[(buf * 4 + ci) * 128 + v] = qv * sigm(qv);
        __syncthreads();
        const LAS f32x4* f4 = (const LAS f32x4*)(LF + (buf * 4 + ci) * 128); const LAS f32x4* q4 = (const LAS f32x4*)(LQ + (buf * 4 + ci) * 128);
        float o0 = 0.f, o1 = 0.f;
#pragma unroll
        for (int k4 = 0; k4 < 32; ++k4) { const f32x4 f = f4[k4], q = q4[k4];
            S[4 * k4 + 0] = vv + f.x * (S[4 * k4 + 0] - vv); o0 += q.x * S[4 * k4 + 0];
            S[4 * k4 + 1] = vv + f.y * (S[4 * k4 + 1] - vv); o1 += q.y * S[4 * k4 + 1];
            S[4 * k4 + 2] = vv + f.z * (S[4 * k4 + 2] - vv); o0 += q.z * S[4 * k4 + 2];
            S[4 * k4 + 3] = vv + f.w * (S[4 * k4 + 3] - vv); o1 += q.w * S[4 * k4 + 3]; if ((k4 & 3) == 3) asm volatile("" ::: "memory"); }
        OD[(size_t)crow * D + h * 128 + v] = o0 + o1;
    }
}
__device__ __forceinline__ void phase_hg_readout(PP p, int lane, int wave) {
    const int gw = blockIdx.x * NWAVES + wave, NGW = gridDim.x * NWAVES;
    const bf16* Z = (const bf16*)(p->ws + WS_U + U_Z); const float* OD = (const float*)(p->ws + WS_U + U_OD0); bf16* A2 = (bf16*)(p->ws + WS_A2);
    const float* gn = p->in[I_HGGN];
    for (int row = gw; row < NROW; row += NGW) {
#pragma unroll
        for (int h = 0; h < 8; ++h) {
            const int c = h * 128 + 2 * lane;
            const float2 a = *(const float2*)(OD + (size_t)row * D + c), bq = *(const float2*)(OD + (size_t)(NROW + row) * D + c);
            const float o0 = a.x + bq.x, o1 = a.y + bq.y;
            const float rstd = rsqrtf(wave_sum(o0 * o0 + o1 * o1) * (1.0f / 128.0f) + NORM_EPS);
            const unsigned gz = *(const unsigned*)(Z + (size_t)row * 5120 + 4096 + c); const float g0 = bf2f(gz & 0xffffu), g1 = bf2f(gz >> 16);
            const float r0 = o0 * rstd * gn[2 * lane] * (g0 * sigm(g0)), r1 = o1 * rstd * gn[2 * lane + 1] * (g1 * sigm(g1));
            *(unsigned*)(A2 + (size_t)row * D + c) = pk2(r0, r1);
        }
    }
}

__device__ __forceinline__ void phase_lerp(PP p, int lane, int wave) {
    const int gw = blockIdx.x * NWAVES + wave, NGW = gridDim.x * NWAVES;
    const float* XR = (const float*)(p->ws + WS_XR); const float* RSTD = (const float*)(p->ws + WS_ROUTE + RT_RSTD);
    bf16* XL6 = (bf16*)(p->ws + WS_U + U_XL6); const float* g = p->in[I_NMIX] + D; const float* mu = p->in[I_MU];
    for (int row = gw; row < NROW; row += NGW) {
        const int vec = row_vec(row); const float* sh = modp(p, 1, vec, 0); const float* sc = modp(p, 1, vec, 1);
        int nb[4];
        if (row < NLAT) { const int t = row & (SEQ - 1), w = t & 63, r = t >> 6;
            nb[0] = (w >= 1) ? row - 1 : -1; nb[1] = (w < 63) ? row + 1 : -1; nb[2] = (r >= 1) ? row - 64 : -1; nb[3] = (r < SEQ / 64 - 1) ? row + 64 : -1;
        } else { const int t = (row - NLAT) & (CTXL - 1);
            nb[0] = nb[1] = (t >= 1) ? row - 1 : -1; nb[2] = nb[3] = (t < CTXL - 1) ? row + 1 : -1; }
        const float rs = RSTD[row];
#pragma unroll
        for (int j = 0; j < 4; ++j) {
            const int ci = lane + 64 * j;
            const f32x4 gg = ((const f32x4*)g)[ci], s1 = ((const f32x4*)sc)[ci] + 1.0f, s0 = ((const f32x4*)sh)[ci];
            const f32x4 xs = ((const f32x4*)(XR + (size_t)row * D))[ci];
            const f32x4 hs = xs * rs * gg * s1 + s0;
            f32x4 hn = (f32x4){0.f, 0.f, 0.f, 0.f};
            if (nb[j] >= 0) { const f32x4 xn = ((const f32x4*)(XR + (size_t)nb[j] * D))[ci]; hn = xn * RSTD[nb[j]] * gg * s1 + s0; }
            const f32x4 dx = hn - hs;
#pragma unroll
            for (int s = 0; s < 6; ++s) {
                const int m = (s == 0) ? 0 : (s == 1) ? 2 : (s == 2) ? 3 : (s == 3) ? 1 : (s == 4) ? 4 : 5;
                const f32x4 o = hs + dx * ((const f32x4*)(mu + m * D))[ci];
                v2u w; w.x = pk2(o.x, o.y); w.y = pk2(o.z, o.w);
                ((v2u*)(XL6 + ((size_t)s * NROW + row) * D))[ci] = w;
            }
        }
    }
}
__device__ __forceinline__ void phase_rwkv_naive(PP p, LAS unsigned char* lds, int lane, int wave) {
    if (blockIdx.x >= 8) return;
    const int chain = blockIdx.x * 8 + wave, b = chain >> 5, dir = (chain >> 4) & 1, h = chain & 15, ch = h * 64 + lane;
    const float* RKV = (const float*)(p->ws + WS_U + U_RKV);
    const float* WDp = (const float*)(p->ws + WS_U + U_WD) + (size_t)dir * NROW * D; const float* ADp = (const float*)(p->ws + WS_U + U_AD) + (size_t)dir * NROW * D;
    float* OD = (float*)(p->ws + WS_U + U_OD1) + (size_t)dir * NROW * D;
    const float kkw = p->in[I_KK][ch], kaw = p->in[I_KA][ch];
    LAS float* L = (LAS float*)lds;
    float S[64];
#pragma unroll
    for (int j = 0; j < 64; ++j) S[j] = 0.f;
    for (int step = 0; step < NSTEP; ++step) {
        const int row = step_row(b, dir, step);
        const float rx = RKV[(size_t)row * 3072 + ch], kx = RKV[(size_t)row * 3072 + 1024 + ch], vx = RKV[(size_t)row * 3072 + 2048 + ch];
        const float wv = WDp[(size_t)row * D + ch], av = ADp[(size_t)row * D + ch];
        float kkx = kx * kkw; const float nrm = sqrtf(wave_sum(kkx * kkx)); kkx = kkx / fmaxf(nrm, 1e-12f);
        LAS float* B = L + ((step & 1) * 8 + wave) * 320;
        B[lane] = wv; B[64 + lane] = kkx; B[128 + lane] = kkx * av; B[192 + lane] = kx * (1.f + (av - 1.f) * kaw); B[256 + lane] = rx;
        __syncthreads();
        const LAS f32x4* W4 = (const LAS f32x4*)B; const LAS f32x4* K4 = (const LAS f32x4*)(B + 64); const LAS f32x4* B4 = (const LAS f32x4*)(B + 128);
        const LAS f32x4* D4 = (const LAS f32x4*)(B + 192); const LAS f32x4* R4 = (const LAS f32x4*)(B + 256);
        float sa0 = 0.f, sa1 = 0.f;
#pragma unroll
        for (int q = 0; q < 16; ++q) { const f32x4 kk = K4[q]; sa0 += S[4 * q] * kk.x + S[4 * q + 2] * kk.z; sa1 += S[4 * q + 1] * kk.y + S[4 * q + 3] * kk.w; if ((q & 3) == 3) asm volatile("" ::: "memory"); }
        const float sa = sa0 + sa1;
        float y0 = 0.f, y1 = 0.f;
#pragma unroll
        for (int q = 0; q < 16; ++q) { const f32x4 w = W4[q], bt = B4[q], kd = D4[q], r = R4[q];
            S[4 * q + 0] = S[4 * q + 0] * w.x - sa * bt.x + vx * kd.x; y0 += S[4 * q + 0] * r.x;
            S[4 * q + 1] = S[4 * q + 1] * w.y - sa * bt.y + vx * kd.y; y1 += S[4 * q + 1] * r.y;
            S[4 * q + 2] = S[4 * q + 2] * w.z - sa * bt.z + vx * kd.z; y0 += S[4 * q + 2] * r.z;
            S[4 * q + 3] = S[4 * q + 3] * w.w - sa * bt.w + vx * kd.w; y1 += S[4 * q + 3] * r.w; if (q & 1) asm volatile("" ::: "memory"); }
        OD[(size_t)row * D + ch] = y0 + y1;
    }
}
__device__ __forceinline__ void phase_rw_readout(PP p, int lane, int wave) {
    const int gw = blockIdx.x * NWAVES + wave, NGW = gridDim.x * NWAVES;
    const float* RKV = (const float*)(p->ws + WS_U + U_RKV); const float* AD = (const float*)(p->ws + WS_U + U_AD); const float* G = (const float*)(p->ws + WS_U + U_G);
    const float* OD = (const float*)(p->ws + WS_U + U_OD1); bf16* A2 = (bf16*)(p->ws + WS_A2);
    for (int row = gw; row < NLAT; row += NGW) {
#pragma unroll 4
        for (int h = 0; h < 16; ++h) {
            const int ch = h * 64 + lane;
            const float y = OD[(size_t)row * D + ch] + OD[(size_t)(NROW + row) * D + ch];
            const float mean = wave_sum(y) * (1.0f / 64.0f); const float d = y - mean; const float var = wave_sum(d * d) * (1.0f / 64.0f);
            float yn = d * rsqrtf(var + 64.0e-5f) * p->in[I_LNXW][ch] + p->in[I_LNXB][ch];
            const float r = RKV[(size_t)row * 3072 + ch], k = RKV[(size_t)row * 3072 + 1024 + ch], v = RKV[(size_t)row * 3072 + 2048 + ch];
            const float ka = p->in[I_KA][ch], rk = p->in[I_RK][ch];
#pragma unroll
            for (int dd = 0; dd < 2; ++dd) { const float a = AD[((size_t)dd * NROW + row) * D + ch]; const float kd = k * (1.f + (a - 1.f) * ka);
                yn += wave_sum(r * kd * rk) * v; }
            const float o = yn * G[(size_t)row * D + ch];
            const float o1 = __shfl_down(o, 1);
            if (!(lane & 1)) *(unsigned*)(A2 + (size_t)row * D + ch) = pk2(o, o1);
        }
    }
}

namespace pg8 {
struct SelOrder : StaticOrder {
    int div, sel0; size_t stride;
    __device__ __forceinline__ const char* abase(const Gemm& g, const Unit& u, size_t tstep) const { return (const char*)g.A + (size_t)(sel0 + u.pn / div) * stride + (size_t)u.pm * tstep; }
};
struct MoeOrder {
    const int* tilee; int nt, ntn, G, c; size_t estride;
    __device__ __forceinline__ void init(const int* te, int ntn_, size_t es, int G_, int c_) { tilee = te; nt = te[0]; ntn = ntn_; estride = es; G = G_; c = c_; }
    __device__ __forceinline__ bool next(int i, Unit& u) const { const long L = (long)i * G + c; if (L >= (long)nt * ntn) return false; u.pn = (int)(L / nt); u.pm = (int)(L % nt); u.e = tilee[1 + u.pm]; return true; }
    __device__ __forceinline__ const char* abase(const Gemm& g, const Unit& u, size_t tstep) const { return (const char*)g.A + (size_t)u.pm * tstep; }
    __device__ __forceinline__ const char* bbase(const Gemm& g, const Unit& u, size_t tstep) const { return (const char*)g.Bt + (size_t)u.e * estride + (size_t)u.pn * tstep; }
    __device__ __forceinline__ void a_ready(const Unit&) const {}
    __device__ __forceinline__ void done(const Unit&) const {}
};
struct EpiStoreBf16 {
    static constexpr bool PERM = true, AFTER_DRAIN = false;
    bf16_t* O; int ldc;
    __device__ __forceinline__ void operator()(const f32x4 (&acc)[2][2][4][2], const Unit& u, int wr, int wc, int fr, int fq) const {
        const int row0 = u.pm * BM + wr * 64 + fr, col0 = u.pn * BM + wc * 32 + 8 * fq;
#pragma unroll
        for (int ai = 0; ai < 2; ++ai)
#pragma unroll
            for (int m = 0; m < 4; ++m) { bf16_t* rowp = O + (size_t)(row0 + ai * HALF + m * 16) * ldc + col0;
#pragma unroll
                for (int bj = 0; bj < 2; ++bj) { const f32x4 v0 = acc[ai][bj][m][0], v1 = acc[ai][bj][m][1];
                    u32x4 w; w.x = cvt_pk_bf16(v0[0], v0[1]); w.y = cvt_pk_bf16(v0[2], v0[3]); w.z = cvt_pk_bf16(v1[0], v1[1]); w.w = cvt_pk_bf16(v1[2], v1[3]);
                    *(u32x4*)(rowp + bj * HALF) = w; } }
    }
};
struct EpiStoreF32 {
    static constexpr bool PERM = false, AFTER_DRAIN = false;
    float* C; int ldc;
    __device__ __forceinline__ void operator()(const f32x4 (&acc)[2][2][4][2], const Unit& u, int wr, int wc, int fr, int fq) const {
        const int row0 = u.pm * BM + wr * 64 + fr, col0 = u.pn * BM + wc * 32 + 4 * fq;
#pragma unroll
        for (int ai = 0; ai < 2; ++ai)
#pragma unroll
            for (int m = 0; m < 4; ++m) { float* rowp = C + (size_t)(row0 + ai * HALF + m * 16) * ldc + col0;
#pragma unroll
                for (int bj = 0; bj < 2; ++bj)
#pragma unroll
                    for (int n = 0; n < 2; ++n) *(f32x4*)(rowp + bj * HALF + n * 16) = acc[ai][bj][m][n]; }
    }
};
struct EpiResid {
    static constexpr bool PERM = false, AFTER_DRAIN = false;
    const float* base_lat; const float* base_ctx; float* out; const float* gate; int gstride;
    __device__ __forceinline__ void operator()(const f32x4 (&acc)[2][2][4][2], const Unit& u, int wr, int wc, int fr, int fq) const {
        const int row0 = u.pm * BM + wr * 64 + fr, col0 = u.pn * BM + wc * 32 + 4 * fq;
#pragma unroll
        for (int ai = 0; ai < 2; ++ai)
#pragma unroll
            for (int m = 0; m < 4; ++m) { const int row = row0 + ai * HALF + m * 16;
                const float* bp = (row < 16384) ? base_lat + (size_t)row * 1024 : base_ctx + (size_t)(row - 16384) * 1024;
                const float* gp = gate + (size_t)(row < 16384 ? (row >= 8192 ? 1 : 0) : 2) * gstride;
                float* op = out + (size_t)row * 1024;
#pragma unroll
                for (int bj = 0; bj < 2; ++bj)
#pragma unroll
                    for (int n = 0; n < 2; ++n) { const int c = col0 + bj * HALF + n * 16;
                        *(f32x4*)(op + c) = *(const f32x4*)(bp + c) + *(const f32x4*)(gp + c) * acc[ai][bj][m][n]; } }
    }
};
__device__ __forceinline__ float sigm_(float x) { return 1.0f / (1.0f + __expf(-x)); }
struct EpiSwiglu {
    static constexpr bool PERM = true, AFTER_DRAIN = false;
    bf16_t* O; const float* bgu;
    __device__ __forceinline__ void operator()(const f32x4 (&acc)[2][2][4][2], const Unit& u, int wr, int wc, int fr, int fq) const {
        const int row0 = u.pm * BM + wr * 64 + fr, col0 = u.pn * HALF + wc * 32 + 8 * fq;
        const float* bg = bgu + (size_t)u.e * 2048 + col0; f32x4 bgv[2], buv[2];
#pragma unroll
        for (int n = 0; n < 2; ++n) { bgv[n] = *(const f32x4*)(bg + 4 * n); buv[n] = *(const f32x4*)(bg + 1024 + 4 * n); }
#pragma unroll
        for (int ai = 0; ai < 2; ++ai)
#pragma unroll
            for (int m = 0; m < 4; ++m) { float r[8];
#pragma unroll
                for (int n = 0; n < 2; ++n) { const f32x4 g4 = acc[ai][0][m][n] + bgv[n], u4 = acc[ai][1][m][n] + buv[n];
#pragma unroll
                    for (int j = 0; j < 4; ++j) { const float g = fminf(g4[j], 7.0f), uu = fminf(fmaxf(u4[j], -7.0f), 7.0f); r[4 * n + j] = g * sigm_(1.702f * g) * (uu + 1.0f); } }
                u32x4 w; w.x = cvt_pk_bf16(r[0], r[1]); w.y = cvt_pk_bf16(r[2], r[3]); w.z = cvt_pk_bf16(r[4], r[5]); w.w = cvt_pk_bf16(r[6], r[7]);
                *(u32x4*)(O + (size_t)(row0 + ai * HALF + m * 16) * 1024 + col0) = w; }
    }
};
struct EpiDown {
    static constexpr bool PERM = true, AFTER_DRAIN = false;
    bf16_t* O; const float* bdn;
    __device__ __forceinline__ void operator()(const f32x4 (&acc)[2][2][4][2], const Unit& u, int wr, int wc, int fr, int fq) const {
        const int row0 = u.pm * BM + wr * 64 + fr, col0 = u.pn * BM + wc * 32 + 8 * fq;
        const float* bp = bdn + (size_t)u.e * 1024 + col0; f32x4 bv[2][2];
#pragma unroll
        for (int bj = 0; bj < 2; ++bj)
#pragma unroll
            for (int n = 0; n < 2; ++n) bv[bj][n] = *(const f32x4*)(bp + bj * HALF + 4 * n);
#pragma unroll
        for (int ai = 0; ai < 2; ++ai)
#pragma unroll
            for (int m = 0; m < 4; ++m) { bf16_t* rowp = O + (size_t)(row0 + ai * HALF + m * 16) * 1024 + col0;
#pragma unroll
                for (int bj = 0; bj < 2; ++bj) { const f32x4 v0 = acc[ai][bj][m][0] + bv[bj][0], v1 = acc[ai][bj][m][1] + bv[bj][1];
                    u32x4 w; w.x = cvt_pk_bf16(v0[0], v0[1]); w.y = cvt_pk_bf16(v0[2], v0[3]); w.z = cvt_pk_bf16(v1[0], v1[1]); w.w = cvt_pk_bf16(v1[2], v1[3]);
                    *(u32x4*)(rowp + bj * HALF) = w; } }
    }
};
struct EpiLora1 {
    static constexpr bool PERM = true, AFTER_DRAIN = false;
    bf16_t* O;
    __device__ __forceinline__ void operator()(const f32x4 (&acc)[2][2][4][2], const Unit& u, int wr, int wc, int fr, int fq) const {
        const int row0 = u.pm * BM + wr * 64 + fr, col0 = u.pn * HALF + wc * 32 + 8 * fq;
#pragma unroll
        for (int ai = 0; ai < 2; ++ai)
#pragma unroll
            for (int m = 0; m < 4; ++m) { float r[8];
#pragma unroll
                for (int n = 0; n < 2; ++n)
#pragma unroll
                    for (int j = 0; j < 4; ++j) { const float x = acc[ai][0][m][n][j]; r[4 * n + j] = (u.pn == 0) ? (2.0f * sigm_(2.0f * x) - 1.0f) : (u.pn == 1) ? x : sigm_(x); }
                u32x4 w; w.x = cvt_pk_bf16(r[0], r[1]); w.y = cvt_pk_bf16(r[2], r[3]); w.z = cvt_pk_bf16(r[4], r[5]); w.w = cvt_pk_bf16(r[6], r[7]);
                *(u32x4*)(O + (size_t)(row0 + ai * HALF + m * 16) * 384 + col0) = w; }
    }
};
struct EpiLora2 {
    static constexpr bool PERM = false, AFTER_DRAIN = false;
    float* WD; float* AD; float* G; const float* w0; const float* a0;
    __device__ __forceinline__ void operator()(const f32x4 (&acc)[2][2][4][2], const Unit& u, int wr, int wc, int fr, int fq) const {
        const int row0 = u.pm * BM + wr * 64 + fr, blk = u.pn >> 2, col0 = (u.pn & 3) * BM + wc * 32 + 4 * fq;
        float* dst = (blk < 2) ? WD + (size_t)blk * 16896 * 1024 : (blk < 4) ? AD + (size_t)(blk - 2) * 16896 * 1024 : G;
        const float* bias = (blk < 2) ? w0 + blk * 1024 : a0 + ((blk - 2) & 1) * 1024;
#pragma unroll
        for (int ai = 0; ai < 2; ++ai)
#pragma unroll
            for (int m = 0; m < 4; ++m) { float* rowp = dst + (size_t)(row0 + ai * HALF + m * 16) * 1024;
#pragma unroll
                for (int bj = 0; bj < 2; ++bj)
#pragma unroll
                    for (int n = 0; n < 2; ++n) { const int c = col0 + bj * HALF + n * 16; f32x4 v = acc[ai][bj][m][n];
                        const f32x4 bb = *(const f32x4*)(bias + c);
                        if (blk < 2) { for (int j = 0; j < 4; ++j) v[j] = __expf(-0.60653066f * sigm_(v[j] + bb[j])); }
                        else if (blk < 4) { for (int j = 0; j < 4; ++j) v[j] = sigm_(v[j] + bb[j]); }
                        *(f32x4*)(rowp + c) = v; }
                asm volatile("" ::: "memory"); }
    }
};
}

constexpr int GLA_NCH = NSTEP / 64;
constexpr int GLA_ITEMS = 2 * NBATCH * GLA_NCH * 8;
constexpr size_t U_DS = 298 * MiB, U_OI = 430 * MiB, U_QT = 562 * MiB, U_LAM = 628 * MiB;
typedef short bf16x8_t __attribute__((ext_vector_type(8)));
__device__ __forceinline__ f32x4 mfma16(bf16x8_t a, bf16x8_t b, f32x4 c) { return __builtin_amdgcn_mfma_f32_16x16x32_bf16(a, b, c, 0, 0, 0); }

__device__ __forceinline__ void phase_gla_prep(PP p, LAS unsigned char* lds, int tid, int lane, int wave) {
    constexpr int PQ = 272, PT = 144;
    LAS unsigned char* QA = lds;
    LAS unsigned char* QX = QA + 64 * PQ;
    LAS unsigned char* KB = QX + 48 * PQ;
    LAS unsigned char* KD = KB + 64 * PQ;
    LAS unsigned char* KT = KD + 64 * PQ;
    LAS unsigned char* VT = KT + 128 * PT;
    LAS unsigned char* PI = VT + 128 * PT;
    LAS float* GT = (LAS float*)(PI + 64 * PT);
    const bf16* Z = (const bf16*)(p->ws + WS_U + U_Z);
    bf16* DS = (bf16*)(p->ws + WS_U + U_DS); f32x4* OI = (f32x4*)(p->ws + WS_U + U_OI); bf16* QT = (bf16*)(p->ws + WS_U + U_QT); float* LAM = (float*)(p->ws + WS_U + U_LAM);
    const int k = tid & 127, g = tid >> 7, kq = lane >> 4, c16 = lane & 15;
    for (int item = blockIdx.x; item < GLA_ITEMS; item += gridDim.x) {
        const int h = item & 7, cc = (item >> 3) % GLA_NCH, db = (item >> 3) / GLA_NCH, b = db & 1, dir = db >> 1;
        float lbv; { const float* lb = p->in[I_HGLB] + (size_t)dir * 3 * D + h * 128 + k; const float a0 = lb[0], a1 = lb[D], a2 = lb[2 * D];
                     const float m = fmaxf(a0, fmaxf(a1, a2)); const float e0 = __expf(a0 - m), e1 = __expf(a1 - m), e2 = __expf(a2 - m); lbv = e0 / (e0 + e1 + e2); }
        for (int u = tid; u < 64 * PT / 4; u += NTHREADS) ((LAS unsigned*)PI)[u] = 0u;
        float cs[16], kin[16], qs[16]; unsigned vt[8]; float run = 0.f;
#pragma unroll
        for (int i = 0; i < 16; ++i) {
            const size_t zr = (size_t)step_row(b, dir, 64 * cc + 16 * g + i) * 5120 + h * 128 + k;
            const float fh = bf2f(Z[zr + 1024 * (1 + dir)]), qv = bf2f(Z[zr]); const unsigned zv = Z[zr + 3072];
            const float f = lbv + (1.f - lbv) * sigm(fh);
            run += __logf(f); cs[i] = run; kin[i] = 1.f - f; qs[i] = qv * sigm(qv);
            if (i & 1) vt[i >> 1] |= zv << 16; else vt[i >> 1] = zv;
        }
        GT[g * 128 + k] = run;
        { LAS v4u* d = (LAS v4u*)(VT + k * PT + 32 * g); d[0] = (v4u){vt[0], vt[1], vt[2], vt[3]}; d[1] = (v4u){vt[4], vt[5], vt[6], vt[7]}; }
        __syncthreads();
        const float t0 = GT[k], t1 = GT[128 + k], t2 = GT[256 + k], t3 = GT[384 + k];
        const float rg = (g > 0 ? t0 : 0.f) + (g > 1 ? t1 : 0.f) + (g > 2 ? t2 : 0.f), tot = (t0 + t1) + (t2 + t3);
        const float erg = __expf(rg), einv = __expf(-run), eend = __expf(tot - (rg + run));
        const float ex1 = (g == 2) ? __expf(t1) : __expf(t2);
        const float ex2 = __expf(t1 + t2);
        unsigned kt[8];
        bf16* qtp = QT + (size_t)item * 64 * 128 + (size_t)(16 * g) * 128 + k;
#pragma unroll
        for (int i = 0; i < 16; ++i) {
            const float qh = qs[i] * __expf(cs[i]), kb = kin[i] * __expf(run - cs[i]);
            const int ro = (16 * g + i) * PQ + 2 * k;
            *(LAS unsigned short*)(QA + ro) = (unsigned short)f2bf(qh);
            *(LAS unsigned short*)(KB + ro) = (unsigned short)f2bf(kb);
            *(LAS unsigned short*)(KD + ro) = (unsigned short)f2bf(kb * einv);
            if (g == 2) *(LAS unsigned short*)(QX + i * PQ + 2 * k) = (unsigned short)f2bf(qh * ex1);
            if (g == 3) { *(LAS unsigned short*)(QX + (16 + i) * PQ + 2 * k) = (unsigned short)f2bf(qh * ex1); *(LAS unsigned short*)(QX + (32 + i) * PQ + 2 * k) = (unsigned short)f2bf(qh * ex2); }
            qtp[(size_t)i * 128] = (bf16)f2bf(qh * erg);
            const unsigned kv = f2bf(kb * eend);
            if (i & 1) kt[i >> 1] |= kv << 16; else kt[i >> 1] = kv;
        }
        { LAS v4u* d = (LAS v4u*)(KT + k * PT + 32 * g); d[0] = (v4u){kt[0], kt[1], kt[2], kt[3]}; d[1] = (v4u){kt[4], kt[5], kt[6], kt[7]}; }
        if (g == 0) LAM[(size_t)item * 128 + k] = __expf(tot);
        __syncthreads();
        for (int blk = wave; blk < 10; blk += 8) {
            const int gi = (blk >= 6) ? 3 : (blk >= 3) ? 2 : (blk >= 1) ? 1 : 0, ji = blk - ((gi * (gi + 1)) >> 1);
            const LAS unsigned char* ab = (ji + 1 >= gi) ? QA + 16 * gi * PQ : (gi == 2) ? QX : (ji == 1) ? QX + 16 * PQ : QX + 32 * PQ;
            const LAS unsigned char* bb = ((ji == gi) ? KD : KB) + 16 * ji * PQ;
            f32x4 acc = (f32x4){0.f, 0.f, 0.f, 0.f};
#pragma unroll
            for (int s = 0; s < 4; ++s) {
                const bf16x8_t a = *(const LAS bf16x8_t*)(ab + c16 * PQ + (32 * s + 8 * kq) * 2), bv = *(const LAS bf16x8_t*)(bb + c16 * PQ + (32 * s + 8 * kq) * 2);
                acc = mfma16(a, bv, acc);
            }
#pragma unroll
            for (int j = 0; j < 4; ++j) { const int tau = 4 * kq + j; const float val = (ji == gi && c16 > tau) ? 0.f : acc[j];
                *(LAS unsigned short*)(PI + (16 * gi + tau) * PT + (16 * ji + c16) * 2) = (unsigned short)f2bf(val); }
        }
        __syncthreads();
        {
            const LAS unsigned char* vb = VT + (16 * wave + c16) * PT + 16 * kq;
            const bf16x8_t v0 = *(const LAS bf16x8_t*)(vb), v1 = *(const LAS bf16x8_t*)(vb + 64);
#pragma unroll
            for (int gi = 0; gi < 4; ++gi) {
                const LAS unsigned char* pb = PI + (16 * gi + c16) * PT + 16 * kq;
                f32x4 acc = mfma16(*(const LAS bf16x8_t*)(pb), v0, (f32x4){0.f, 0.f, 0.f, 0.f});
                if (gi >= 2) acc = mfma16(*(const LAS bf16x8_t*)(pb + 64), v1, acc);
                OI[((size_t)item * 8 + wave) * 256 + gi * 64 + lane] = acc;
            }
            bf16* dsp = DS + (size_t)item * 128 * 128 + (size_t)(16 * wave + c16) * 128 + 4 * kq;
#pragma unroll
            for (int m = 0; m < 8; ++m) {
                const LAS unsigned char* kb2 = KT + (16 * m + c16) * PT + 16 * kq;
                f32x4 acc = mfma16(*(const LAS bf16x8_t*)(kb2), v0, (f32x4){0.f, 0.f, 0.f, 0.f});
                acc = mfma16(*(const LAS bf16x8_t*)(kb2 + 64), v1, acc);
                v2u w; w.x = pk2(acc[0], acc[1]); w.y = pk2(acc[2], acc[3]);
                *(v2u*)(dsp + 16 * m) = w;
            }
        }
        __syncthreads();
    }
}
__device__ __forceinline__ void phase_gla_scan(PP p, int tid) {
    bf16* DS = (bf16*)(p->ws + WS_U + U_DS); const float* LAM = (const float*)(p->ws + WS_U + U_LAM);
    const int nthr = gridDim.x * NTHREADS;
    for (int e = blockIdx.x * NTHREADS + tid; e < 32 * 2048; e += nthr) {
        const int chain = e >> 11, el = e & 2047, h = chain & 7, db = chain >> 3, k8 = (el & 15) * 8;
        float s[8];
#pragma unroll
        for (int i = 0; i < 8; ++i) s[i] = 0.f;
        for (int c0 = 0; c0 < GLA_NCH; c0 += 6) {
            v4u d[6]; f32x4 l0[6], l1[6];
#pragma unroll
            for (int u = 0; u < 6; ++u) { const size_t item = ((size_t)db * GLA_NCH + c0 + u) * 8 + h;
                d[u] = *(const v4u*)(DS + item * 16384 + (size_t)el * 8); l0[u] = *(const f32x4*)(LAM + item * 128 + k8); l1[u] = *(const f32x4*)(LAM + item * 128 + k8 + 4); }
#pragma unroll
            for (int u = 0; u < 6; ++u) { const size_t item = ((size_t)db * GLA_NCH + c0 + u) * 8 + h;
                v4u o; o.x = pk2(s[0], s[1]); o.y = pk2(s[2], s[3]); o.z = pk2(s[4], s[5]); o.w = pk2(s[6], s[7]);
                *(v4u*)(DS + item * 16384 + (size_t)el * 8) = o;
                s[0] = l0[u].x * s[0] + bf2f(d[u].x & 0xffffu); s[1] = l0[u].y * s[1] + bf2f(d[u].x >> 16);
                s[2] = l0[u].z * s[2] + bf2f(d[u].y & 0xffffu); s[3] = l0[u].w * s[3] + bf2f(d[u].y >> 16);
                s[4] = l1[u].x * s[4] + bf2f(d[u].z & 0xffffu); s[5] = l1[u].y * s[5] + bf2f(d[u].z >> 16);
                s[6] = l1[u].z * s[6] + bf2f(d[u].w & 0xffffu); s[7] = l1[u].w * s[7] + bf2f(d[u].w >> 16); }
        }
    }
}
__device__ __forceinline__ void phase_gla_out(PP p, int lane, int wave) {
    const bf16* DS = (const bf16*)(p->ws + WS_U + U_DS); const f32x4* OI = (const f32x4*)(p->ws + WS_U + U_OI); const bf16* QT = (const bf16*)(p->ws + WS_U + U_QT);
    float* ODb = (float*)(p->ws + WS_U + U_OD0);
    const int kq = lane >> 4, c16 = lane & 15;
    for (int item = blockIdx.x; item < GLA_ITEMS; item += gridDim.x) {
        const int h = item & 7, cc = (item >> 3) % GLA_NCH, db = (item >> 3) / GLA_NCH, b = db & 1, dir = db >> 1;
        const bf16* sp = DS + (size_t)item * 16384 + (size_t)(16 * wave + c16) * 128 + 8 * kq;
        bf16x8_t bv[4];
#pragma unroll
        for (int s = 0; s < 4; ++s) bv[s] = *(const bf16x8_t*)(sp + 32 * s);
        float* OD = ODb + (size_t)dir * NROW * D + h * 128 + 16 * wave + c16;
#pragma unroll
        for (int gi = 0; gi < 4; ++gi) {
            const bf16* qp = QT + (size_t)item * 8192 + (size_t)(16 * gi + c16) * 128 + 8 * kq;
            f32x4 acc = OI[((size_t)item * 8 + wave) * 256 + gi * 64 + lane];
#pragma unroll
            for (int s = 0; s < 4; ++s) acc = mfma16(*(const bf16x8_t*)(qp + 32 * s), bv[s], acc);
#pragma unroll
            for (int j = 0; j < 4; ++j) OD[(size_t)step_row(b, dir, 64 * cc + 16 * gi + 4 * kq + j) * D] = acc[j];
        }
    }
}

constexpr int RW_NB = 32, RW_SLOT = 336;
__device__ __forceinline__ float row16_sum(float x) {
    x += __builtin_bit_cast(float, __builtin_amdgcn_update_dpp(0, __builtin_bit_cast(int, x), 0x128, 0xf, 0xf, false));
    x += __builtin_bit_cast(float, __builtin_amdgcn_update_dpp(0, __builtin_bit_cast(int, x), 0x124, 0xf, 0xf, false));
    x += __builtin_bit_cast(float, __builtin_amdgcn_update_dpp(0, __builtin_bit_cast(int, x), 0x122, 0xf, 0xf, false));
    x += __builtin_bit_cast(float, __builtin_amdgcn_update_dpp(0, __builtin_bit_cast(int, x), 0x121, 0xf, 0xf, false));
    return x;
}
__device__ __forceinline__ void rw_fill(PP p, LAS float* buf, int batch, int b, int dir, int h, int rowgrp, int lw, int lane) {
    const float* RKV = (const float*)(p->ws + WS_U + U_RKV);
    const float* WDp = (const float*)(p->ws + WS_U + U_WD) + (size_t)dir * NROW * D; const float* ADp = (const float*)(p->ws + WS_U + U_AD) + (size_t)dir * NROW * D;
    const int ch = h * 64 + lane; const float kkw = p->in[I_KK][ch], kaw = p->in[I_KA][ch];
    float rx[8], kx[8], vx[8], wv[8], av[8];
#pragma unroll
    for (int u = 0; u < 8; ++u) { const int row = step_row(b, dir, batch * RW_NB + lw + 4 * u);
        rx[u] = RKV[(size_t)row * 3072 + ch]; kx[u] = RKV[(size_t)row * 3072 + 1024 + ch]; vx[u] = RKV[(size_t)row * 3072 + 2048 + ch];
        wv[u] = WDp[(size_t)row * D + ch]; av[u] = ADp[(size_t)row * D + ch]; }
#pragma unroll
    for (int u = 0; u < 8; ++u) {
        float kkx = kx[u] * kkw; const float nrm = sqrtf(wave_sum(kkx * kkx)); kkx = kkx / fmaxf(nrm, 1e-12f);
        LAS float* B = buf + (lw + 4 * u) * RW_SLOT;
        B[lane] = wv[u]; B[64 + lane] = kkx; B[128 + lane] = kkx * av[u]; B[192 + lane] = kx[u] * (1.f + (av[u] - 1.f) * kaw); B[256 + lane] = rx[u];
        if ((lane >> 4) == rowgrp) B[320 + (lane & 15)] = vx[u];
    }
}
__device__ __forceinline__ void phase_rwkv_scan(PP p, LAS unsigned char* lds, int lane, int wave) {
    LAS float* L = (LAS float*)lds;
    for (int unit = blockIdx.x; unit < 256; unit += gridDim.x) {
        const int chain = unit >> 2, rowgrp = unit & 3, b = chain >> 5, dir = (chain >> 4) & 1, h = chain & 15;
        float* OD = (float*)(p->ws + WS_U + U_OD1) + (size_t)dir * NROW * D + h * 64 + 16 * rowgrp + 4 * wave + (lane >> 4);
        const int seg = lane & 15;
        f32x4 S = (f32x4){0.f, 0.f, 0.f, 0.f};
        if (wave >= 4) rw_fill(p, L, 0, b, dir, h, rowgrp, wave - 4, lane);
        __syncthreads();
        constexpr int NBATCH_RW = NSTEP / RW_NB;
        for (int bt = 0; bt < NBATCH_RW; ++bt) {
            if (wave >= 4) { if (bt + 1 < NBATCH_RW) rw_fill(p, L + ((bt + 1) & 1) * RW_NB * RW_SLOT, bt + 1, b, dir, h, rowgrp, wave - 4, lane); }
            else {
                const LAS float* B0 = L + (bt & 1) * RW_NB * RW_SLOT;
#pragma unroll 4
                for (int s = 0; s < RW_NB; ++s) {
                    const LAS f32x4* B4 = (const LAS f32x4*)(B0 + s * RW_SLOT);
                    const f32x4 w4 = B4[seg], kk4 = B4[16 + seg], bt4 = B4[32 + seg], kd4 = B4[48 + seg], r4 = B4[64 + seg];
                    const float vv = B0[s * RW_SLOT + 320 + 4 * wave + (lane >> 4)];
                    float sa = (S.x * kk4.x + S.y * kk4.y) + (S.z * kk4.z + S.w * kk4.w);
                    sa = row16_sum(sa);
                    S = S * w4 - sa * bt4 + vv * kd4;
                    float y = (S.x * r4.x + S.y * r4.y) + (S.z * r4.z + S.w * r4.w);
                    y = row16_sum(y);
                    if (seg == 0) OD[(size_t)step_row(b, dir, bt * RW_NB + s) * D] = y;
                }
            }
            __syncthreads();
        }
    }
}
enum { PH_PRE = 0, PH_NORM0, PH_G_IN, PH_GLA_A, PH_GLA_B, PH_GLA_C, PH_HGRO, PH_G_HGO, PH_FFN0, PH_GATHER0, PH_GU0, PH_DN0, PH_COMB0,
       PH_LERP, PH_G_RKV, PH_G_L2, PH_RWSCAN, PH_RWRO, PH_G_RWO, PH_FFN1, PH_GATHER1, PH_GU1, PH_DN1, PH_COMB1, NPHASES };

template <int ph> __device__ __forceinline__ void run_phase(PP p, LAS unsigned char* lds, int tid, int lane, int wave, int G, int bx, int vcu) {
    unsigned char* ws = p->ws;
    typedef pg8::bf16_t bt;
    switch (ph) {
        case PH_PRE: phase_pre(p, lds, tid, lane, wave); break;
        case PH_NORM0: phase_norm0(p, lane, wave); break;
        case PH_G_IN: {
            pg8::Gemm g{(const bt*)(ws + WS_H), (const bt*)(ws + WS_WIN), NROW, 5120, D}; pg8::StaticOrder S; S.init(NROW, 5120, G, bx);
            pg8::EpiStoreBf16 E{(bt*)(ws + WS_U + U_Z), 5120};
            pg8::gemm_phase<pg8::EpiStoreBf16, pg8::StaticOrder, true, true>(lds, g, S, E); } break;
        case PH_GLA_A: phase_gla_prep(p, lds, tid, lane, wave); break;
        case PH_GLA_B: phase_gla_scan(p, tid); break;
        case PH_GLA_C: phase_gla_out(p, lane, wave); break;
        case PH_HGRO: phase_hg_readout(p, lane, wave); break;
        case PH_G_HGO: {
            pg8::Gemm g{(const bt*)(ws + WS_A2), (const bt*)(ws + WS_WHGO), NROW, D, D}; pg8::StaticOrder S; S.init(NROW, D, G, bx);
            pg8::EpiResid E{p->in[I_X], p->in[I_CTX], (float*)(ws + WS_XR), modp(p, 0, 0, 2), 6144};
            pg8::gemm_phase<pg8::EpiResid, pg8::StaticOrder, true, true>(lds, g, S, E); } break;
        case PH_FFN0: phase_ffn_norm_route(p, 0, NROW, lane, wave); break;
        case PH_FFN1: phase_ffn_norm_route(p, 1, NLAT, lane, wave); break;
        case PH_GATHER0: phase_gather(p, 0, NROW, lds, tid, lane, wave); break;
        case PH_GATHER1: phase_gather(p, 1, NLAT, lds, tid, lane, wave); break;
        case PH_GU0: case PH_GU1: { const int layer = (ph == PH_GU1);
            pg8::Gemm g{(const bt*)(ws + WS_U + U_XB), (const bt*)(ws + WS_WGU) + (size_t)layer * NE * 2048 * D, CAP, 2048, D};
            pg8::MoeOrder S; S.init((const int*)(ws + WS_ROUTE + RT_TILEE), 8, (size_t)2048 * D * 2, G, vcu);
            pg8::EpiSwiglu E{(bt*)(ws + WS_U + U_ACT), p->in[I_BGU] + (size_t)layer * NE * 2048};
            pg8::gemm_phase<pg8::EpiSwiglu, pg8::MoeOrder, true, true>(lds, g, S, E); } break;
        case PH_DN0: case PH_DN1: { const int layer = (ph == PH_DN1);
            pg8::Gemm g{(const bt*)(ws + WS_U + U_ACT), (const bt*)(ws + WS_WD) + (size_t)layer * NE * D * D, CAP, D, D};
            pg8::MoeOrder S; S.init((const int*)(ws + WS_ROUTE + RT_TILEE), 4, (size_t)D * D * 2, G, vcu);
            pg8::EpiDown E{(bt*)(ws + WS_U + U_YS), p->in[I_BDN] + (size_t)layer * NE * D};
            pg8::gemm_phase<pg8::EpiDown, pg8::MoeOrder, true, true>(lds, g, S, E); } break;
        case PH_COMB0: phase_combine(p, 0, NROW, false, lane, wave); break;
        case PH_COMB1: phase_combine(p, 1, NLAT, true, lane, wave); break;
        case PH_LERP: phase_lerp(p, lane, wave); break;
        case PH_G_RKV: {
            { pg8::Gemm g{(const bt*)(ws + WS_U + U_XL6), (const bt*)(ws + WS_WRKV), NROW, 3072, D};
              pg8::SelOrder S; S.init(NROW, 3072, G, bx); S.div = 4; S.sel0 = 0; S.stride = (size_t)NROW * D * 2;
              pg8::EpiStoreF32 E{(float*)(ws + WS_U + U_RKV), 3072};
              pg8::gemm_phase<pg8::EpiStoreF32, pg8::SelOrder, true, true>(lds, g, S, E); }
            { pg8::Gemm g{(const bt*)(ws + WS_U + U_XL6), (const bt*)(ws + WS_WL1), NROW, 768, D};
              pg8::SelOrder S; S.init(NROW, 768, G, bx); S.div = 1; S.sel0 = 3; S.stride = (size_t)NROW * D * 2;
              pg8::EpiLora1 E{(bt*)(ws + WS_U + U_L1)};
              pg8::gemm_phase<pg8::EpiLora1, pg8::SelOrder, true, true>(lds, g, S, E); } } break;
        case PH_G_L2: {
            pg8::Gemm g{(const bt*)(ws + WS_U + U_L1), (const bt*)(ws + WS_WL2), NROW, 5120, 384}; pg8::StaticOrder S; S.init(NROW, 5120, G, bx);
            pg8::EpiLora2 E{(float*)(ws + WS_U + U_WD), (float*)(ws + WS_U + U_AD), (float*)(ws + WS_U + U_G), p->in[I_DECW0], p->in[I_A0]};
            pg8::gemm_phase<pg8::EpiLora2, pg8::StaticOrder, true, true>(lds, g, S, E); } break;
        case PH_RWSCAN: phase_rwkv_scan(p, lds, lane, wave); break;
        case PH_RWRO: phase_rw_readout(p, lane, wave); break;
        case PH_G_RWO: {
            pg8::Gemm g{(const bt*)(ws + WS_A2), (const bt*)(ws + WS_WRWO), NLAT, D, D}; pg8::StaticOrder S; S.init(NLAT, D, G, bx);
            float* XR = (float*)(ws + WS_XR);
            pg8::EpiResid E{XR, XR + (size_t)NLAT * D, XR, modp(p, 1, 0, 2), 6144};
            pg8::gemm_phase<pg8::EpiResid, pg8::StaticOrder, true, true>(lds, g, S, E); } break;
        default: break;
    }
}

#define MK_PROLOGUE \
    extern __shared__ __attribute__((aligned(16))) unsigned char lds_raw[]; \
    LAS unsigned char* lds = (LAS unsigned char*)lds_raw; \
    const int tid = threadIdx.x, lane = tid & 63, wave = __builtin_amdgcn_readfirstlane(tid >> 6); \
    const int G = gridDim.x, bx = blockIdx.x, vcu = (G % 8 == 0) ? (bx % 8) * (G / 8) + bx / 8 : bx;

namespace cg = cooperative_groups;
__global__ void __launch_bounds__(NTHREADS, 2) mk_fwd(Params pv) {
    MK_PROLOGUE
    cg::grid_group grid = cg::this_grid();
    PP kp = (PP)__builtin_amdgcn_kernarg_segment_ptr();
    const int lo = kp->ph_lo, hi = kp->ph_hi;
#define RUN(k) if (lo <= (k) && (k) < hi) { PP q = kp; asm volatile("" : "+s"(q)); run_phase<k>(q, lds, tid, lane, wave, G, bx, vcu); if ((k) + 1 < hi) grid.sync(); }
    RUN(0) RUN(1) RUN(2) RUN(3) RUN(4) RUN(5) RUN(6) RUN(7) RUN(8) RUN(9) RUN(10) RUN(11) RUN(12) RUN(13) RUN(14) RUN(15) RUN(16) RUN(17) RUN(18) RUN(19) RUN(20) RUN(21) RUN(22) RUN(23)
#undef RUN
}

extern "C" void kernel_launch(void* const* d_in, const int* in_sizes, int n_in, void* d_out, int out_size, void* d_ws, size_t ws_size, hipStream_t stream) {
    static int grid = 0;
    if (grid == 0) {
        if (n_in != 35 || in_sizes[0] != NLAT * D || out_size != NLAT * D || ws_size < WS_END) {
            fprintf(stderr, "kernel_launch: unexpected problem (n_in %d, in0 %d, out %d, ws %zu < %zu)\n", n_in, n_in > 0 ? in_sizes[0] : -1, out_size, ws_size, (size_t)WS_END); grid = -1; return; }
        int dev = 0, cus = 0, per_cu = 0;
        if (hipGetDevice(&dev) != hipSuccess || hipDeviceGetAttribute(&cus, hipDeviceAttributeMultiprocessorCount, dev) != hipSuccess) { grid = -1; return; }
        if (hipFuncSetAttribute((const void*)mk_fwd, hipFuncAttributeMaxDynamicSharedMemorySize, LDS_BYTES) != hipSuccess) { fprintf(stderr, "kernel_launch: hipFuncSetAttribute failed\n"); grid = -1; return; }
        if (hipOccupancyMaxActiveBlocksPerMultiprocessor(&per_cu, (const void*)mk_fwd, NTHREADS, LDS_BYTES) != hipSuccess || per_cu < 1) { fprintf(stderr, "kernel_launch: occupancy query %d\n", per_cu); per_cu = 1; }
        (void)hipGetLastError();
        grid = cus * (per_cu < 1 ? 1 : per_cu);
    }
    if (grid < 0) return;
    (void)hipMemsetAsync((char*)d_ws + WS_CTL, 0, CTL_ZERO_BYTES, stream);
    Params p{};
    for (int i = 0; i < 35; ++i) p.in[i] = (const float*)d_in[i];
    p.out = (float*)d_out; p.ws = (unsigned char*)d_ws;
    p.ph_lo = 0; p.ph_hi = NPHASES;
    void* args[] = {&p};
    hipError_t e = hipLaunchCooperativeKernel((const void*)mk_fwd, dim3(grid), dim3(NTHREADS), args, LDS_BYTES, stream);
    if (e != hipSuccess) fprintf(stderr, "kernel_launch: cooperative launch failed: %s (grid %d)\n", hipGetErrorString(e), grid);
}
```

```cpp
#include <hip/hip_runtime.h>
#include <hip/hip_cooperative_groups.h>
#include <cstdio>
#include <cstdint>
namespace pg8 {
#define PG8_LAS __attribute__((address_space(3)))
typedef unsigned short bf16_t;
typedef short bf16x8 __attribute__((ext_vector_type(8)));
typedef float f32x4 __attribute__((ext_vector_type(4)));
typedef unsigned u32x4 __attribute__((ext_vector_type(4)));
constexpr int BM = 256, BK = 64, HALF = 128, HTB = HALF * BK * 2  , STAGE_BYTES = 8 * HTB, NXCD = 8, WGM = 8;

__host__ __device__ __forceinline__ int lds_byte(int r, int c) { const int st = (r >> 4) * 2 + (c >> 5), rr = r & 15, cc = c & 31, ob = rr * 64 + cc * 2; return st * 1024 + (ob ^ (((ob >> 9) & 1) << 5)); }
__host__ __device__ __forceinline__ void stage_rc(int b, int& R, int& C) { const int st = b / 1024, sb = b % 1024, swz = sb ^ (((sb >> 9) & 1) << 5); R = (st >> 1) * 16 + swz / 64; C = (st & 1) * 32 + (swz % 64) / 2; }
__host__ __device__ __forceinline__ int perm32(int rho) { const int n = rho >> 4, i = rho & 15; return 8 * (i >> 2) + 4 * n + (i & 3); }

struct Unit { int pm, pn, e; };
struct Gemm { const bf16_t* A; const bf16_t* Bt; int M, N, K; };

struct StaticOrder {
    int nM, nN, nwg, G, c;
    __host__ __device__ void init(int M, int N, int G_, int c_) { nM = M / BM; nN = N / BM; nwg = nM * nN; G = G_; c = c_; }
    __host__ __device__ bool next(int i, Unit& u) const {
        const long L = (long)i * G + c; if (L >= nwg) return false;
        int wgid = (int)L; { const int q = nwg / NXCD, r = nwg % NXCD, xcd = wgid % NXCD, off = wgid / NXCD; wgid = (xcd < r ? xcd * (q + 1) : r * (q + 1) + (xcd - r) * q) + off; }
        const int nig = WGM * nN, gid = wgid / nig, fm = gid * WGM, gsz = (nM - fm) < WGM ? (nM - fm) : WGM;
        u.pm = fm + ((wgid % nig) % gsz); u.pn = (wgid % nig) / gsz; u.e = 0; return true;
    }
    __device__ __forceinline__ const char* abase(const Gemm& g, const Unit& u, size_t tstep) const { return (const char*)g.A + (size_t)u.pm * tstep; }
    __device__ __forceinline__ const char* bbase(const Gemm& g, const Unit& u, size_t tstep) const { return (const char*)g.Bt + (size_t)u.pn * tstep; }
    __device__ __forceinline__ void a_ready(const Unit&) const {}
    __device__ __forceinline__ void done(const Unit&) const {}
};

__device__ __forceinline__ unsigned cvt_pk_bf16(float lo, float hi) { unsigned r; asm volatile("v_cvt_pk_bf16_f32 %0, %1, %2" : "=v"(r) : "v"(lo), "v"(hi)); return r; }

template <class Epi, class Sched, bool ALIGN_EPI = false, bool SP2 = false>
__device__ __forceinline__ void gemm_phase(PG8_LAS unsigned char* lds, const Gemm g, const Sched& S, const Epi& E) {
    const int tid = threadIdx.x, wid = __builtin_amdgcn_readfirstlane(tid >> 6), lane = tid & 63, wr = wid >> 2, wc = wid & 3, fr = lane & 15, fq = lane >> 4;
    const int K = g.K, nt = K / BK;
    unsigned voffA[2], voffB[2];
#pragma unroll
    for (int i = 0; i < 2; ++i) { int R, C; stage_rc(tid * 16 + i * 8192, R, C); const int Rb = Epi::PERM ? ((R & ~31) + perm32(R & 31)) : R;
        voffA[i] = (unsigned)(R * K + C) * 2u; voffB[i] = (unsigned)(Rb * K + C) * 2u; }
    const size_t kstep = (size_t)(BK * 2);
    const size_t hstep = (size_t)HALF * K * 2;
    const size_t tstep = 2 * hstep;
    const unsigned ldsw = (unsigned)wid * 1024u;
    const int aoff = lds_byte(wr * 64 + fr, fq * 8), boff = lds_byte(wc * 32 + fr, fq * 8);
#define PG8_SA(b, h) (((b) * 2 + (h)) * HTB)
#define PG8_SB(b, h) ((4 + (b) * 2 + (h)) * HTB)
#define PG8_STAGE(bufoff, gbase, voff) do { _Pragma("unroll") for (int _i = 0; _i < 2; ++_i) \
        __builtin_amdgcn_global_load_lds((const unsigned*)((const char*)(gbase) + (voff)[_i]), (PG8_LAS unsigned*)(lds + (bufoff) + ldsw + _i * 8192), 16, 0, 0); } while (0)
#define PG8_LDA(dst, b, h) do { _Pragma("unroll") for (int m = 0; m < 4; ++m) _Pragma("unroll") for (int k = 0; k < 2; ++k) dst[m][k] = *(const PG8_LAS bf16x8*)(lds + PG8_SA(b, h) + aoff + m * 2048 + k * 1024); } while (0)
#define PG8_LDB(dst, b, h) do { _Pragma("unroll") for (int n = 0; n < 2; ++n) _Pragma("unroll") for (int k = 0; k < 2; ++k) dst[n][k] = *(const PG8_LAS bf16x8*)(lds + PG8_SB(b, h) + boff + n * 2048 + k * 1024); } while (0)
#define PG8_MMA(ai, bj, At, Bt) do { __builtin_amdgcn_s_setprio(1); _Pragma("unroll") for (int m = 0; m < 4; ++m) _Pragma("unroll") for (int n = 0; n < 2; ++n) _Pragma("unroll") for (int k = 0; k < 2; ++k) \
        acc[ai][bj][m][n] = __builtin_amdgcn_mfma_f32_16x16x32_bf16(Bt[n][k], At[m][k], acc[ai][bj][m][n], 0, 0, 0); __builtin_amdgcn_s_setprio(0); } while (0)
#define PG8_WAIT_V(n) asm volatile("s_waitcnt vmcnt(" #n ")" ::: "memory")
#define PG8_WAIT_L(n) asm volatile("s_waitcnt lgkmcnt(" #n ")" ::: "memory")
#define PG8_BAR __builtin_amdgcn_s_barrier()
#define PG8_SCHED __builtin_amdgcn_sched_barrier(0)
    Unit cur, nxt; int ui = 0;
    if (!S.next(0, cur)) return;
    f32x4 acc[2][2][4][2];
#pragma unroll
    for (int a = 0; a < 2; ++a)
#pragma unroll
        for (int b = 0; b < 2; ++b)
#pragma unroll
            for (int m = 0; m < 4; ++m)
#pragma unroll
                for (int n = 0; n < 2; ++n) acc[a][b][m][n] = (f32x4){0.f, 0.f, 0.f, 0.f};
    bf16x8 At[4][2], B0[2][2], B1[2][2];
    const char* cA = S.abase(g, cur, tstep); const char* cB = S.bbase(g, cur, tstep);
    S.a_ready(cur);
    if constexpr (SP2) {
        PG8_STAGE(PG8_SB(0, 0), cB, voffB); PG8_STAGE(PG8_SB(0, 1), cB + hstep, voffB); PG8_STAGE(PG8_SA(0, 0), cA, voffA); PG8_STAGE(PG8_SA(0, 1), cA + hstep, voffA);
        if (wr == 1) PG8_BAR;
        PG8_WAIT_V(2); PG8_BAR;
        PG8_STAGE(PG8_SB(1, 0), cB + kstep, voffB); PG8_STAGE(PG8_SA(1, 0), cA + kstep, voffA); PG8_STAGE(PG8_SB(1, 1), cB + hstep + kstep, voffB);
        PG8_WAIT_V(6); PG8_BAR;
    } else {
        PG8_STAGE(PG8_SB(0, 0), cB, voffB); PG8_STAGE(PG8_SA(0, 0), cA, voffA); PG8_STAGE(PG8_SB(0, 1), cB + hstep, voffB); PG8_STAGE(PG8_SA(0, 1), cA + hstep, voffA);
        if (wr == 1) PG8_BAR;
        PG8_WAIT_V(4); PG8_BAR;
        PG8_STAGE(PG8_SB(1, 0), cB + kstep, voffB); PG8_STAGE(PG8_SA(1, 0), cA + kstep, voffA); PG8_STAGE(PG8_SB(1, 1), cB + hstep + kstep, voffB);
        PG8_WAIT_V(6); PG8_BAR;
    }
    for (;;) {
        const bool has_next = S.next(ui + 1, nxt);
        const char* nA = has_next ? S.abase(g, nxt, tstep) : cA; const char* nB = has_next ? S.bbase(g, nxt, tstep) : cB;
        _Pragma("unroll 1") for (int t = 0; t < nt; t += 2) {
            const bool last = (t == nt - 2);
            const char* a1 = cA + (size_t)(t + 1) * kstep;
            const char* a2 = last ? nA : cA + (size_t)(t + 2) * kstep; const char* b2 = last ? nB : cB + (size_t)(t + 2) * kstep;
            const char* a3 = a2 + kstep; const char* b3 = b2 + kstep;
            if (last && has_next) S.a_ready(nxt);
            if constexpr (SP2) {
            PG8_LDB(B0, 0, 0); PG8_LDB(B1, 0, 1); PG8_SCHED; PG8_LDA(At, 0, 0); PG8_STAGE(PG8_SA(1, 1), a1 + hstep, voffA);
            PG8_WAIT_V(8); PG8_WAIT_L(0); PG8_BAR; PG8_MMA(0, 0, At, B0); PG8_MMA(0, 1, At, B1); PG8_BAR; PG8_SCHED;
            PG8_LDA(At, 0, 1); PG8_STAGE(PG8_SB(0, 0), b2, voffB); PG8_STAGE(PG8_SB(0, 1), b2 + hstep, voffB); PG8_STAGE(PG8_SA(0, 0), a2, voffA);
            PG8_WAIT_V(8); PG8_WAIT_L(0); PG8_BAR; PG8_MMA(1, 0, At, B0); PG8_MMA(1, 1, At, B1); PG8_BAR; PG8_SCHED;
            PG8_LDB(B0, 1, 0); PG8_LDB(B1, 1, 1); PG8_SCHED; PG8_LDA(At, 1, 0); PG8_STAGE(PG8_SA(0, 1), a2 + hstep, voffA);
            PG8_WAIT_V(8); PG8_WAIT_L(0); PG8_BAR; PG8_MMA(0, 0, At, B0); PG8_MMA(0, 1, At, B1); PG8_BAR; PG8_SCHED;
            PG8_LDA(At, 1, 1); PG8_STAGE(PG8_SB(1, 0), b3, voffB); PG8_STAGE(PG8_SB(1, 1), b3 + hstep, voffB); PG8_STAGE(PG8_SA(1, 0), a3, voffA);
            PG8_WAIT_V(8); PG8_WAIT_L(0); PG8_BAR; PG8_MMA(1, 0, At, B0); PG8_MMA(1, 1, At, B1); PG8_BAR; PG8_SCHED;
            } else {
            PG8_LDB(B0, 0, 0); PG8_SCHED; PG8_LDA(At, 0, 0); PG8_STAGE(PG8_SA(1, 1), a1 + hstep, voffA);
            PG8_WAIT_L(8); PG8_BAR; PG8_WAIT_L(0); PG8_MMA(0, 0, At, B0); PG8_BAR; PG8_SCHED;
            PG8_LDB(B1, 0, 1); PG8_STAGE(PG8_SB(0, 0), b2, voffB);
            PG8_BAR; PG8_WAIT_L(0); PG8_MMA(0, 1, At, B1); PG8_BAR;
            PG8_LDA(At, 0, 1); PG8_STAGE(PG8_SA(0, 0), a2, voffA);
            PG8_BAR; PG8_WAIT_L(0); PG8_MMA(1, 0, At, B0); PG8_BAR; PG8_SCHED;
            PG8_STAGE(PG8_SB(0, 1), b2 + hstep, voffB);
            PG8_WAIT_V(6); PG8_BAR; PG8_MMA(1, 1, At, B1); PG8_BAR;
            PG8_LDB(B0, 1, 0); PG8_SCHED; PG8_LDA(At, 1, 0); PG8_STAGE(PG8_SA(0, 1), a2 + hstep, voffA);
            PG8_WAIT_L(8); PG8_BAR; PG8_WAIT_L(0); PG8_MMA(0, 0, At, B0); PG8_BAR; PG8_SCHED;
            PG8_LDB(B1, 1, 1); PG8_STAGE(PG8_SB(1, 0), b3, voffB);
            PG8_BAR; PG8_WAIT_L(0); PG8_MMA(0, 1, At, B1); PG8_BAR;
            PG8_LDA(At, 1, 1); PG8_STAGE(PG8_SA(1, 0), a3, voffA);
            PG8_BAR; PG8_WAIT_L(0); PG8_MMA(1, 0, At, B0); PG8_BAR; PG8_SCHED;
            PG8_STAGE(PG8_SB(1, 1), b3 + hstep, voffB);
            PG8_WAIT_V(6); PG8_BAR; PG8_MMA(1, 1, At, B1); PG8_BAR;
            }
        }
        if constexpr (ALIGN_EPI) { if (wr == 0) PG8_BAR; }
        if constexpr (!Epi::AFTER_DRAIN) { E(acc, cur, wr, wc, fr, fq); S.done(cur); }
        if (!has_next) break;
#pragma unroll
        for (int a = 0; a < 2; ++a)
#pragma unroll
            for (int b = 0; b < 2; ++b)
#pragma unroll
                for (int m = 0; m < 4; ++m)
#pragma unroll
                    for (int n = 0; n < 2; ++n) acc[a][b][m][n] = (f32x4){0.f, 0.f, 0.f, 0.f};
        cur = nxt; cA = nA; cB = nB; ++ui;
        if constexpr (ALIGN_EPI) { if (wr == 1) PG8_BAR; }
    }
    PG8_WAIT_V(0);
    if constexpr (!ALIGN_EPI) { if (wr == 0) PG8_BAR; }
    PG8_BAR;
    if constexpr (Epi::AFTER_DRAIN) { E.fused(acc, cur, wr, wc, fr, fq, lds, wid, lane); S.done(cur); }
#undef PG8_SA
#undef PG8_SB
#undef PG8_STAGE
#undef PG8_LDA
#undef PG8_LDB
#undef PG8_MMA
#undef PG8_WAIT_V
#undef PG8_WAIT_L
#undef PG8_BAR
#undef PG8_SCHED
}
}

constexpr int D = 1024, NBATCH = 2, SEQ = 8192, CTXL = 256;
constexpr int NLAT = NBATCH * SEQ, NCTX = NBATCH * CTXL, NROW = NLAT + NCTX;
constexpr int NE = 32, TOPK = 4, MAXTILES = 296, CAP = MAXTILES * 256;
constexpr int NWAVES = 8, NTHREADS = 512;
constexpr float NORM_EPS = 1e-6f;
constexpr int LDS_BYTES = 147456;

constexpr size_t MiB = 1u << 20;
constexpr size_t WS_CTL = 0, CTL_ZERO_BYTES = 1 * MiB;
constexpr size_t WS_MOD = 1 * MiB;
constexpr size_t WS_ROUTE = 2 * MiB;
constexpr size_t RT_TOPI = 0, RT_TOPG = 320 * 1024, RT_POS = 640 * 1024, RT_SLOT = 960 * 1024, RT_RSTD = 1280 * 1024, RT_TILEE = 1408 * 1024;
constexpr size_t WS_WIN = 4 * MiB, WS_WHGO = 14 * MiB, WS_WRKV = 16 * MiB, WS_WL1 = 22 * MiB, WS_WL2 = 24 * MiB, WS_WRWO = 28 * MiB;
constexpr size_t WS_WGU = 32 * MiB, WS_WD = 288 * MiB;
constexpr size_t WS_XR = 416 * MiB, WS_H = 482 * MiB, WS_H2 = 515 * MiB, WS_A2 = 548 * MiB;
constexpr size_t WS_U = 584 * MiB;
constexpr size_t U_Z = 0, U_OD0 = 166 * MiB;
constexpr size_t U_XL6 = 0, U_RKV = 198 * MiB, U_L1 = 396 * MiB, U_WD = 410 * MiB, U_AD = 542 * MiB, U_G = 674 * MiB, U_OD1 = 740 * MiB;
constexpr size_t U_XB = 0, U_ACT = 148 * MiB, U_YS = 296 * MiB;
constexpr size_t WS_END = WS_U + 872 * MiB;
constexpr int CW_CNT = 64;
constexpr int CW_BAR = 4096;

#define LAS __attribute__((address_space(3)))
typedef unsigned short bf16;
typedef unsigned v4u __attribute__((ext_vector_type(4)));
typedef unsigned v2u __attribute__((ext_vector_type(2)));
typedef float f32x4 __attribute__((ext_vector_type(4)));
#define LDS_WAIT() asm volatile("s_waitcnt lgkmcnt(0)" ::: "memory")
__device__ __forceinline__ unsigned f2bf(float f) { unsigned u = __builtin_bit_cast(unsigned, f); return (u + 0x7fffu + ((u >> 16) & 1u)) >> 16; }
__device__ __forceinline__ unsigned pk2(float lo, float hi) { return f2bf(lo) | (f2bf(hi) << 16); }
__device__ __forceinline__ float bf2f(unsigned b) { return __builtin_bit_cast(float, b << 16); }
__device__ __forceinline__ float wave_sum(float v) {
#pragma unroll
    for (int o = 1; o < 64; o <<= 1) v += __shfl_xor(v, o);
    return v;
}
__device__ __forceinline__ float sigm(float x) { return 1.0f / (1.0f + __expf(-x)); }

struct Params { const float* in[35]; float* out; unsigned char* ws; int ph_lo, ph_hi; };
typedef const __attribute__((address_space(4))) Params* PP;
enum { I_X = 0, I_C, I_CTX, I_CCTX, I_ADAW, I_ADAB, I_NMIX, I_NFFN, I_HGWIN, I_HGGN, I_HGWOUT, I_HGLB, I_MU, I_WRKV, I_DECW0, I_DECW1, I_DECW2,
       I_A0, I_A1, I_A2, I_G1, I_G2, I_KK, I_KA, I_RK, I_LNXW, I_LNXB, I_RWOUT, I_ROUTW, I_ROUTB, I_WGU, I_BGU, I_WDN, I_BDN, I_FINALG };

__device__ __forceinline__ const float* modp(PP p, int l, int v, int j) { return (const float*)(p->ws + WS_MOD) + ((size_t)(l * 3 + v) * 6 + j) * D; }
__device__ __forceinline__ int row_vec(int row) { return row < NLAT ? (row >= SEQ ? 1 : 0) : 2; }

__device__ __forceinline__ void transpose_item(const float* src, int src_ld, bf16* dst, int dst_ld, LAS float* scr, int lane) {
    if (src) {
#pragma unroll 8
        for (int i = 0; i < 32; ++i) { const int kk = 2 * i + (lane >> 5); scr[kk * 33 + (lane & 31)] = src[(size_t)kk * src_ld + (lane & 31)]; }
    }
    LDS_WAIT(); asm volatile("" ::: "memory");
    const int c = lane & 7;
#pragma unroll
    for (int j = 0; j < 4; ++j) {
        const int n = (lane >> 3) + 8 * j; v4u o = (v4u){0u, 0u, 0u, 0u};
        if (src) { const LAS float* s = scr + (8 * c) * 33 + n;
            o.x = pk2(s[0 * 33], s[1 * 33]); o.y = pk2(s[2 * 33], s[3 * 33]); o.z = pk2(s[4 * 33], s[5 * 33]); o.w = pk2(s[6 * 33], s[7 * 33]); }
        *(v4u*)(dst + (size_t)n * dst_ld + 8 * c) = o;
    }
    LDS_WAIT(); asm volatile("" ::: "memory");
}
__device__ __forceinline__ void conv_plain(const float* W, int K, int N, bf16* WT, int r, LAS float* scr, int lane) {
    const int nblk = N / 32, kb = r / nblk, nb = r % nblk;
    transpose_item(W + (size_t)(kb * 64) * N + nb * 32, N, WT + (size_t)(nb * 32) * K + kb * 64, K, scr, lane);
}
constexpr int IT_WIN = 16 * 160, IT_SQ = 16 * 32, IT_L1 = 16 * 24, IT_L2 = 160 * 6, IT_GU = 64 * 16 * 64, IT_DN = 64 * 16 * 32;
constexpr int IT_TOTAL = IT_WIN + IT_SQ + 3 * IT_SQ + IT_SQ + IT_L1 + IT_L2 + IT_GU + IT_DN;
__device__ __forceinline__ void convert_item(PP p, int it, LAS float* scr, int lane) {
    unsigned char* ws = p->ws; int r = it;
    if (r < IT_WIN) { conv_plain(p->in[I_HGWIN], D, 5120, (bf16*)(ws + WS_WIN), r, scr, lane); return; } r -= IT_WIN;
    if (r < IT_SQ) { conv_plain(p->in[I_HGWOUT], D, D, (bf16*)(ws + WS_WHGO), r, scr, lane); return; } r -= IT_SQ;
    if (r < 3 * IT_SQ) { const int j = r / IT_SQ; conv_plain(p->in[I_WRKV] + (size_t)j * D * D, D, D, (bf16*)(ws + WS_WRKV) + (size_t)j * D * D, r % IT_SQ, scr, lane); return; } r -= 3 * IT_SQ;
    if (r < IT_SQ) { conv_plain(p->in[I_RWOUT], D, D, (bf16*)(ws + WS_WRWO), r, scr, lane); return; } r -= IT_SQ;
    if (r < IT_L1) {
        const int kb = r / 24, rg = r % 24, tile = rg >> 3, within = rg & 7; const float* src = nullptr; int ld = 64;
        if (within < 4) {
            if (tile == 0) src = p->in[I_DECW1] + (size_t)(within >> 1) * D * 64 + (size_t)(kb * 64) * 64 + (within & 1) * 32;
            else if (tile == 1) src = p->in[I_A1] + (size_t)(within >> 1) * D * 64 + (size_t)(kb * 64) * 64 + (within & 1) * 32;
            else { src = p->in[I_G1] + (size_t)(kb * 64) * 128 + within * 32; ld = 128; }
        }
        transpose_item(src, ld, (bf16*)(ws + WS_WL1) + (size_t)(rg * 32) * D + kb * 64, D, scr, lane); return; } r -= IT_L1;
    if (r < IT_L2) {
        const int rg = r / 6, kb = r % 6, n0 = rg * 32, blk = n0 >> 10, nn0 = n0 & 1023; const float* src = nullptr;
        if (blk < 2) { if (kb == blk) src = p->in[I_DECW2] + (size_t)blk * 64 * D + nn0; }
        else if (blk < 4) { if (kb == blk) src = p->in[I_A2] + (size_t)(blk - 2) * 64 * D + nn0; }
        else { if (kb >= 4) src = p->in[I_G2] + (size_t)(kb - 4) * 64 * D + nn0; }
        transpose_item(src, D, (bf16*)(ws + WS_WL2) + (size_t)n0 * 384 + kb * 64, 384, scr, lane); return; } r -= IT_L2;
    if (r < IT_GU) {
        const int mat = r >> 10, q = r & 1023, kb = q >> 6, nb = q & 63, n0 = nb * 32;
        const int j0 = n0 & 1023, drow = 256 * (j0 >> 7) + (n0 >= 1024 ? 128 : 0) + (j0 & 127);
        transpose_item(p->in[I_WGU] + (size_t)mat * D * 2048 + (size_t)(kb * 64) * 2048 + n0, 2048, (bf16*)(ws + WS_WGU) + (size_t)mat * 2048 * D + (size_t)drow * D + kb * 64, D, scr, lane); return; } r -= IT_GU;
    { const int mat = r >> 9, q = r & 511;
      conv_plain(p->in[I_WDN] + (size_t)mat * D * D, D, D, (bf16*)(ws + WS_WD) + (size_t)mat * D * D, q, scr, lane); }
}
__device__ __forceinline__ void phase_pre(PP p, LAS unsigned char* lds, int tid, int lane, int wave) {
    if (blockIdx.x < 192) {
        const int layer = blockIdx.x / 96, col = (blockIdx.x % 96) * 64 + lane;
        const float* W = p->in[I_ADAW] + (size_t)layer * D * 6144 + col;
        const float* c = p->in[I_C]; const float* cc = p->in[I_CCTX];
        float a0 = 0.f, a1 = 0.f, a2 = 0.f;
#pragma unroll 8
        for (int k = wave * 128; k < wave * 128 + 128; ++k) {
            const float wv = W[(size_t)k * 6144]; const float c0 = c[k], c1 = c[D + k], c2 = cc[k];
            a0 += c0 * sigm(c0) * wv; a1 += c1 * sigm(c1) * wv; a2 += c2 * sigm(c2) * wv;
        }
        LAS float* red = (LAS float*)lds;
        red[(wave * 3 + 0) * 64 + lane] = a0; red[(wave * 3 + 1) * 64 + lane] = a1; red[(wave * 3 + 2) * 64 + lane] = a2;
        __syncthreads();
        if (wave == 0) {
            float s0 = 0.f, s1 = 0.f, s2 = 0.f;
#pragma unroll
            for (int w = 0; w < 8; ++w) { s0 += red[(w * 3 + 0) * 64 + lane]; s1 += red[(w * 3 + 1) * 64 + lane]; s2 += red[(w * 3 + 2) * 64 + lane]; }
            const float bb = p->in[I_ADAB][layer * 6144 + col];
            float* M = (float*)(p->ws + WS_MOD) + (size_t)layer * 3 * 6144 + col;
            M[0] = s0 + bb; M[6144] = s1 + bb; M[2 * 6144] = s2 + bb;
        }
        __syncthreads();
    }
    LAS float* scr = (LAS float*)(lds + wave * 16384);
    const int gw = blockIdx.x * NWAVES + wave, NGW = gridDim.x * NWAVES;
    for (int it = gw; it < IT_TOTAL; it += NGW) convert_item(p, it, scr, lane);
}

__device__ __forceinline__ void load_row(const float* row, int lane, f32x4 (&v)[4]) {
#pragma unroll
    for (int j = 0; j < 4; ++j) v[j] = ((const f32x4*)row)[lane + 64 * j];
}
__device__ __forceinline__ float row_rstd(const f32x4 (&v)[4]) {
    float s = 0.f;
#pragma unroll
    for (int j = 0; j < 4; ++j) s += (v[j].x * v[j].x + v[j].y * v[j].y) + (v[j].z * v[j].z + v[j].w * v[j].w);
    return rsqrtf(wave_sum(s) * (1.0f / D) + NORM_EPS);
}
__device__ __forceinline__ void norm_mod(const f32x4 (&v)[4], float rstd, const float* g, const float* shift, const float* scale, int lane, f32x4 (&h)[4]) {
#pragma unroll
    for (int j = 0; j < 4; ++j) {
        const f32x4 gg = ((const f32x4*)g)[lane + 64 * j], sh = ((const f32x4*)shift)[lane + 64 * j], sc = ((const f32x4*)scale)[lane + 64 * j];
        h[j] = v[j] * rstd * gg * (sc + 1.0f) + sh;
    }
}
__device__ __forceinline__ void store_row_bf16(bf16* row, int lane, const f32x4 (&h)[4]) {
#pragma unroll
    for (int j = 0; j < 4; ++j) { v2u w; w.x = pk2(h[j].x, h[j].y); w.y = pk2(h[j].z, h[j].w); ((v2u*)row)[lane + 64 * j] = w; }
}
__device__ __forceinline__ const float* resid_row(PP p, int layer0_inputs, int row) {
    if (layer0_inputs) return row < NLAT ? p->in[I_X] + (size_t)row * D : p->in[I_CTX] + (size_t)(row - NLAT) * D;
    return (const float*)(p->ws + WS_XR) + (size_t)row * D;
}
__device__ __forceinline__ void phase_norm0(PP p, int lane, int wave) {
    const int gw = blockIdx.x * NWAVES + wave, NGW = gridDim.x * NWAVES;
    for (int row = gw; row < NROW; row += NGW) {
        f32x4 v[4], h[4]; load_row(resid_row(p, 1, row), lane, v);
        const float rstd = row_rstd(v); const int vec = row_vec(row);
        norm_mod(v, rstd, p->in[I_NMIX], modp(p, 0, vec, 0), modp(p, 0, vec, 1), lane, h);
        store_row_bf16((bf16*)(p->ws + WS_H) + (size_t)row * D, lane, h);
    }
}
__device__ __forceinline__ void phase_ffn_norm_route(PP p, int layer, int nrows, int lane, int wave) {
    const int gw = blockIdx.x * NWAVES + wave, NGW = gridDim.x * NWAVES;
    const float* rw = p->in[I_ROUTW] + (size_t)layer * D * NE; const float* rb = p->in[I_ROUTB] + layer * NE;
    int* TOPI = (int*)(p->ws + WS_ROUTE + RT_TOPI); float* TOPG = (float*)(p->ws + WS_ROUTE + RT_TOPG); int* POS = (int*)(p->ws + WS_ROUTE + RT_POS);
    unsigned* cnt = (unsigned*)(p->ws + WS_CTL) + CW_CNT + layer * NE;
    for (int row = gw; row < nrows; row += NGW) {
        f32x4 v[4], h[4]; load_row((const float*)(p->ws + WS_XR) + (size_t)row * D, lane, v);
        const float rstd = row_rstd(v); const int vec = row_vec(row);
        norm_mod(v, rstd, p->in[I_NFFN] + layer * D, modp(p, layer, vec, 3), modp(p, layer, vec, 4), lane, h);
        store_row_bf16((bf16*)(p->ws + WS_H2) + (size_t)row * D, lane, h);
        float part[NE];
#pragma unroll
        for (int e = 0; e < NE; ++e) part[e] = 0.f;
#pragma unroll
        for (int j = 0; j < 4; ++j)
#pragma unroll
            for (int i = 0; i < 4; ++i) {
                const float hv = h[j][i]; const f32x4* wr = (const f32x4*)(rw + (size_t)(4 * lane + 256 * j + i) * NE);
#pragma unroll
                for (int q = 0; q < 8; ++q) { const f32x4 w4 = wr[q]; part[4 * q + 0] += hv * w4.x; part[4 * q + 1] += hv * w4.y; part[4 * q + 2] += hv * w4.z; part[4 * q + 3] += hv * w4.w; }
            }
#pragma unroll
        for (int e = 0; e < NE; ++e) part[e] = wave_sum(part[e]) + rb[e];
        unsigned taken = 0u; int idx[TOPK]; float val[TOPK];
#pragma unroll
        for (int k = 0; k < TOPK; ++k) {
            float best = -3.0e38f; int bi = 0;
#pragma unroll
            for (int e = 0; e < NE; ++e) { const bool ok = !((taken >> e) & 1u) && (part[e] > best); best = ok ? part[e] : best; bi = ok ? e : bi; }
            taken |= 1u << bi; idx[k] = bi; val[k] = best;
        }
        float ex[TOPK], se = 0.f;
#pragma unroll
        for (int k = 0; k < TOPK; ++k) { ex[k] = __expf(val[k] - val[0]); se += ex[k]; }
        if (lane == 0) {
#pragma unroll
            for (int k = 0; k < TOPK; ++k) {
                TOPI[row * 4 + k] = idx[k]; TOPG[row * 4 + k] = ex[k] / se;
                POS[row * 4 + k] = (int)atomicAdd(cnt + idx[k], 1u);
            }
        }
    }
}
__device__ __forceinline__ void phase_gather(PP p, int layer, int nrows, LAS unsigned char* lds, int tid, int lane, int wave) {
    LAS int* off = (LAS int*)lds;
    const unsigned* cnt = (const unsigned*)(p->ws + WS_CTL) + CW_CNT + layer * NE;
    int* TILEE = (int*)(p->ws + WS_ROUTE + RT_TILEE);
    if (tid == 0) {
        int o = 0;
        for (int e = 0; e < NE; ++e) { off[e] = o; const int nt = ((int)__hip_atomic_load(cnt + e, __ATOMIC_RELAXED, __HIP_MEMORY_SCOPE_AGENT) + 255) >> 8;
            if (blockIdx.x == 0) for (int t = 0; t < nt; ++t) TILEE[1 + (o >> 8) + t] = e;
            o += nt << 8; }
        off[NE] = o; if (blockIdx.x == 0) TILEE[0] = o >> 8;
    }
    __syncthreads();
    const int* TOPI = (const int*)(p->ws + WS_ROUTE + RT_TOPI); const int* POS = (const int*)(p->ws + WS_ROUTE + RT_POS); int* SLOT = (int*)(p->ws + WS_ROUTE + RT_SLOT);
    const bf16* H2 = (const bf16*)(p->ws + WS_H2); bf16* XB = (bf16*)(p->ws + WS_U + U_XB);
    const int gw = blockIdx.x * NWAVES + wave, NGW = gridDim.x * NWAVES;
    for (int it = gw; it < nrows * TOPK; it += NGW) {
        const int row = it >> 2; const int slot = off[TOPI[it]] + POS[it];
        if (lane == 0) SLOT[it] = slot;
        const v4u* s = (const v4u*)(H2 + (size_t)row * D); v4u* d = (v4u*)(XB + (size_t)slot * D);
        d[lane] = s[lane]; d[lane + 64] = s[lane + 64];
    }
    __syncthreads();
}
__device__ __forceinline__ void phase_combine(PP p, int layer, int nrows, bool final_out, int lane, int wave) {
    const int gw = blockIdx.x * NWAVES + wave, NGW = gridDim.x * NWAVES;
    const float* TOPG = (const float*)(p->ws + WS_ROUTE + RT_TOPG); const int* SLOT = (const int*)(p->ws + WS_ROUTE + RT_SLOT);
    const bf16* YS = (const bf16*)(p->ws + WS_U + U_YS); float* XR = (float*)(p->ws + WS_XR); float* RSTD = (float*)(p->ws + WS_ROUTE + RT_RSTD);
    for (int row = gw; row < nrows; row += NGW) {
        f32x4 v[4], acc[4]; load_row(XR + (size_t)row * D, lane, v);
#pragma unroll
        for (int j = 0; j < 4; ++j) acc[j] = (f32x4){0.f, 0.f, 0.f, 0.f};
#pragma unroll
        for (int k = 0; k < TOPK; ++k) {
            const float gk = TOPG[row * 4 + k]; const v2u* ys = (const v2u*)(YS + (size_t)SLOT[row * 4 + k] * D);
#pragma unroll
            for (int j = 0; j < 4; ++j) { const v2u w = ys[lane + 64 * j];
                acc[j].x += gk * bf2f(w.x & 0xffffu); acc[j].y += gk * bf2f(w.x >> 16); acc[j].z += gk * bf2f(w.y & 0xffffu); acc[j].w += gk * bf2f(w.y >> 16); }
        }
        const float* m5 = modp(p, layer, row_vec(row), 5);
#pragma unroll
        for (int j = 0; j < 4; ++j) v[j] = v[j] + ((const f32x4*)m5)[lane + 64 * j] * acc[j];
        const float rstd = row_rstd(v);
        if (final_out) {
#pragma unroll
            for (int j = 0; j < 4; ++j) ((f32x4*)(p->out + (size_t)row * D))[lane + 64 * j] = v[j] * rstd * ((const f32x4*)p->in[I_FINALG])[lane + 64 * j];
        } else {
#pragma unroll
            for (int j = 0; j < 4; ++j) ((f32x4*)(XR + (size_t)row * D))[lane + 64 * j] = v[j];
            if (lane == 0) RSTD[row] = rstd;
        }
    }
}

__device__ __forceinline__ int step_row(int b, int dir, int step) {
    if (step < CTXL) { const int t = dir ? (CTXL - 1 - step) : step; return NLAT + b * CTXL + t; }
    const int s = step - CTXL; const int t = dir ? (SEQ - 1 - s) : s; return b * SEQ + t;
}
constexpr int NSTEP = CTXL + SEQ;

__device__ __forceinline__ void phase_gla_naive(PP p, LAS unsigned char* lds, int tid) {
    if (blockIdx.x >= 8) return;
    const int ci = tid >> 7, v = tid & 127, chain = blockIdx.x * 4 + ci, b = chain >> 4, dir = (chain >> 3) & 1, h = chain & 7;
    const bf16* Z = (const bf16*)(p->ws + WS_U + U_Z); float* OD = (float*)(p->ws + WS_U + U_OD0) + (size_t)dir * NROW * D;
    float lbv; { const float* lb = p->in[I_HGLB] + (size_t)dir * 3 * D + h * 128 + v; const float a0 = lb[0], a1 = lb[D], a2 = lb[2 * D];
                 const float m = fmaxf(a0, fmaxf(a1, a2)); const float e0 = __expf(a0 - m), e1 = __expf(a1 - m), e2 = __expf(a2 - m); lbv = e0 / (e0 + e1 + e2); }
    LAS float* LF = (LAS float*)lds;
    LAS float* LQ = (LAS float*)(lds + 4096);
    float S[128];
#pragma unroll
    for (int k = 0; k < 128; ++k) S[k] = 0.f;
    int row = step_row(b, dir, 0);
    unsigned zf = Z[(size_t)row * 5120 + 1024 * (1 + dir) + h * 128 + v], zq = Z[(size_t)row * 5120 + h * 128 + v], zv = Z[(size_t)row * 5120 + 3072 + h * 128 + v];
    for (int step = 0; step < NSTEP; ++step) {
        const float fh = bf2f(zf), qv = bf2f(zq), vv = bf2f(zv); const int crow = row;
        if (step + 1 < NSTEP) { row = step_row(b, dir, step + 1);
            zf = Z[(size_t)row * 5120 + 1024 * (1 + dir) + h * 128 + v]; zq = Z[(size_t)row * 5120 + h * 128 + v]; zv = Z[(size_t)row * 5120 + 3072 + h * 128 + v]; }
        const int buf = step & 1;
        LF[(buf * 4 + ci) * 128 + v] = lbv + (1.f - lbv) * sigm(fh); LQ[(buf * 4 + ci) * 128 + v] = qv * sigm(qv);
        __syncthreads();
        const LAS f32x4* f4 = (const LAS f32x4*)(LF + (buf * 4 + ci) * 128); const LAS f32x4* q4 = (const LAS f32x4*)(LQ + (buf * 4 + ci) * 128);
        float o0 = 0.f, o1 = 0.f;
#pragma unroll
        for (int k4 = 0; k4 < 32; ++k4) { const f32x4 f = f4[k4], q = q4[k4];
            S[4 * k4 + 0] = vv + f.x * (S[4 * k4 + 0] - vv); o0 += q.x * S[4 * k4 + 0];
            S[4 * k4 + 1] = vv + f.y * (S[4 * k4 + 1] - vv); o1 += q.y * S[4 * k4 + 1];
            S[4 * k4 + 2] = vv + f.z * (S[4 * k4 + 2] - vv); o0 += q.z * S[4 * k4 + 2];
            S[4 * k4 + 3] = vv + f.w * (S[4 * k4 + 3] - vv); o1 += q.w * S[4 * k4 + 3]; if ((k4 & 3) == 3) asm volatile("" ::: "memory"); }
        OD[(size_t)crow * D + h * 128 + v] = o0 + o1;
    }
}
__device__ __forceinline__ void phase_hg_readout(PP p, int lane, int wave) {
    const int gw = blockIdx.x * NWAVES + wave, NGW = gridDim.x * NWAVES;
    const bf16* Z = (const bf16*)(p->ws + WS_U + U_Z); const float* OD = (const float*)(p->ws + WS_U + U_OD0); bf16* A2 = (bf16*)(p->ws + WS_A2);
    const float* gn = p->in[I_HGGN];
    for (int row = gw; row < NROW; row += NGW) {
#pragma unroll
        for (int h = 0; h < 8; ++h) {
            const int c = h * 128 + 2 * lane;
            const float2 a = *(const float2*)(OD + (size_t)row * D + c), bq = *(const float2*)(OD + (size_t)(NROW + row) * D + c);
            const float o0 = a.x + bq.x, o1 = a.y + bq.y;
            const float rstd = rsqrtf(wave_sum(o0 * o0 + o1 * o1) * (1.0f / 128.0f) + NORM_EPS);
            const unsigned gz = *(const unsigned*)(Z + (size_t)row * 5120 + 4096 + c); const float g0 = bf2f(gz & 0xffffu), g1 = bf2f(gz >> 16);
            const float r0 = o0 * rstd * gn[2 * lane] * (g0 * sigm(g0)), r1 = o1 * rstd * gn[2 * lane + 1] * (g1 * sigm(g1));
            *(unsigned*)(A2 + (size_t)row * D + c) = pk2(r0, r1);
        }
    }
}

__device__ __forceinline__ void phase_lerp(PP p, int lane, int wave) {
    const int gw = blockIdx.x * NWAVES + wave, NGW = gridDim.x * NWAVES;
    const float* XR = (const float*)(p->ws + WS_XR); const float* RSTD = (const float*)(p->ws + WS_ROUTE + RT_RSTD);
    bf16* XL6 = (bf16*)(p->ws + WS_U + U_XL6); const float* g = p->in[I_NMIX] + D; const float* mu = p->in[I_MU];
    for (int row = gw; row < NROW; row += NGW) {
        const int vec = row_vec(row); const float* sh = modp(p, 1, vec, 0); const float* sc = modp(p, 1, vec, 1);
        int nb[4];
        if (row < NLAT) { const int t = row & (SEQ - 1), w = t & 63, r = t >> 6;
            nb[0] = (w >= 1) ? row - 1 : -1; nb[1] = (w < 63) ? row + 1 : -1; nb[2] = (r >= 1) ? row - 64 : -1; nb[3] = (r < SEQ / 64 - 1) ? row + 64 : -1;
        } else { const int t = (row - NLAT) & (CTXL - 1);
            nb[0] = nb[1] = (t >= 1) ? row - 1 : -1; nb[2] = nb[3] = (t < CTXL - 1) ? row + 1 : -1; }
        const float rs = RSTD[row];
#pragma unroll
        for (int j = 0; j < 4; ++j) {
            const int ci = lane + 64 * j;
            const f32x4 gg = ((const f32x4*)g)[ci], s1 = ((const f32x4*)sc)[ci] + 1.0f, s0 = ((const f32x4*)sh)[ci];
            const f32x4 xs = ((const f32x4*)(XR + (size_t)row * D))[ci];
            const f32x4 hs = xs * rs * gg * s1 + s0;
            f32x4 hn = (f32x4){0.f, 0.f, 0.f, 0.f};
            if (nb[j] >= 0) { const f32x4 xn = ((const f32x4*)(XR + (size_t)nb[j] * D))[ci]; hn = xn * RSTD[nb[j]] * gg * s1 + s0; }
            const f32x4 dx = hn - hs;
#pragma unroll
            for (int s = 0; s < 6; ++s) {
                const int m = (s == 0) ? 0 : (s == 1) ? 2 : (s == 2) ? 3 : (s == 3) ? 1 : (s == 4) ? 4 : 5;
                const f32x4 o = hs + dx * ((const f32x4*)(mu + m * D))[ci];
                v2u w; w.x = pk2(o.x, o.y); w.y = pk2(o.z, o.w);
                ((v2u*)(XL6 + ((size_t)s * NROW + row) * D))[ci] = w;
            }
        }
    }
}
__device__ __forceinline__ void phase_rwkv_naive(PP p, LAS unsigned char* lds, int lane, int wave) {
    if (blockIdx.x >= 8) return;
    const int chain = blockIdx.x * 8 + wave, b = chain >> 5, dir = (chain >> 4) & 1, h = chain & 15, ch = h * 64 + lane;
    const float* RKV = (const float*)(p->ws + WS_U + U_RKV);
    const float* WDp = (const float*)(p->ws + WS_U + U_WD) + (size_t)dir * NROW * D; const float* ADp = (const float*)(p->ws + WS_U + U_AD) + (size_t)dir * NROW * D;
    float* OD = (float*)(p->ws + WS_U + U_OD1) + (size_t)dir * NROW * D;
    const float kkw = p->in[I_KK][ch], kaw = p->in[I_KA][ch];
    LAS float* L = (LAS float*)lds;
    float S[64];
#pragma unroll
    for (int j = 0; j < 64; ++j) S[j] = 0.f;
    for (int step = 0; step < NSTEP; ++step) {
        const int row = step_row(b, dir, step);
        const float rx = RKV[(size_t)row * 3072 + ch], kx = RKV[(size_t)row * 3072 + 1024 + ch], vx = RKV[(size_t)row * 3072 + 2048 + ch];
        const float wv = WDp[(size_t)row * D + ch], av = ADp[(size_t)row * D + ch];
        float kkx = kx * kkw; const float nrm = sqrtf(wave_sum(kkx * kkx)); kkx = kkx / fmaxf(nrm, 1e-12f);
        LAS float* B = L + ((step & 1) * 8 + wave) * 320;
        B[lane] = wv; B[64 + lane] = kkx; B[128 + lane] = kkx * av; B[192 + lane] = kx * (1.f + (av - 1.f) * kaw); B[256 + lane] = rx;
        __syncthreads();
        const LAS f32x4* W4 = (const LAS f32x4*)B; const LAS f32x4* K4 = (const LAS f32x4*)(B + 64); const LAS f32x4* B4 = (const LAS f32x4*)(B + 128);
        const LAS f32x4* D4 = (const LAS f32x4*)(B + 192); const LAS f32x4* R4 = (const LAS f32x4*)(B + 256);
        float sa0 = 0.f, sa1 = 0.f;
#pragma unroll
        for (int q = 0; q < 16; ++q) { const f32x4 kk = K4[q]; sa0 += S[4 * q] * kk.x + S[4 * q + 2] * kk.z; sa1 += S[4 * q + 1] * kk.y + S[4 * q + 3] * kk.w; if ((q & 3) == 3) asm volatile("" ::: "memory"); }
        const float sa = sa0 + sa1;
        float y0 = 0.f, y1 = 0.f;
#pragma unroll
        for (int q = 0; q < 16; ++q) { const f32x4 w = W4[q], bt = B4[q], kd = D4[q], r = R4[q];
            S[4 * q + 0] = S[4 * q + 0] * w.x - sa * bt.x + vx * kd.x; y0 += S[4 * q + 0] * r.x;
            S[4 * q + 1] = S[4 * q + 1] * w.y - sa * bt.y + vx * kd.y; y1 += S[4 * q + 1] * r.y;
            S[4 * q + 2] = S[4 * q + 2] * w.z - sa * bt.z + vx * kd.z; y0 += S[4 * q + 2] * r.z;
            S[4 * q + 3] = S[4 * q + 3] * w.w - sa * bt.w + vx * kd.w; y1 += S[4 * q + 3] * r.w; if (q & 1) asm volatile("" ::: "memory"); }
        OD[(size_t)row * D + ch] = y0 + y1;
    }
}
__device__ __forceinline__ void phase_rw_readout(PP p, int lane, int wave) {
    const int gw = blockIdx.x * NWAVES + wave, NGW = gridDim.x * NWAVES;
    const float* RKV = (const float*)(p->ws + WS_U + U_RKV); const float* AD = (const float*)(p->ws + WS_U + U_AD); const float* G = (const float*)(p->ws + WS_U + U_G);
    const float* OD = (const float*)(p->ws + WS_U + U_OD1); bf16* A2 = (bf16*)(p->ws + WS_A2);
    for (int row = gw; row < NLAT; row += NGW) {
#pragma unroll 4
        for (int h = 0; h < 16; ++h) {
            const int ch = h * 64 + lane;
            const float y = OD[(size_t)row * D + ch] + OD[(size_t)(NROW + row) * D + ch];
            const float mean = wave_sum(y) * (1.0f / 64.0f); const float d = y - mean; const float var = wave_sum(d * d) * (1.0f / 64.0f);
            float yn = d * rsqrtf(var + 64.0e-5f) * p->in[I_LNXW][ch] + p->in[I_LNXB][ch];
            const float r = RKV[(size_t)row * 3072 + ch], k = RKV[(size_t)row * 3072 + 1024 + ch], v = RKV[(size_t)row * 3072 + 2048 + ch];
            const float ka = p->in[I_KA][ch], rk = p->in[I_RK][ch];
#pragma unroll
            for (int dd = 0; dd < 2; ++dd) { const float a = AD[((size_t)dd * NROW + row) * D + ch]; const float kd = k * (1.f + (a - 1.f) * ka);
                yn += wave_sum(r * kd * rk) * v; }
            const float o = yn * G[(size_t)row * D + ch];
            const float o1 = __shfl_down(o, 1);
            if (!(lane & 1)) *(unsigned*)(A2 + (size_t)row * D + ch) = pk2(o, o1);
        }
    }
}

namespace pg8 {
struct SelOrder : StaticOrder {
    int div, sel0; size_t stride;
    __device__ __forceinline__ const char* abase(const Gemm& g, const Unit& u, size_t tstep) const { return (const char*)g.A + (size_t)(sel0 + u.pn / div) * stride + (size_t)u.pm * tstep; }
};
struct MoeOrder {
    const int* tilee; int nt, ntn, G, c; size_t estride;
    __device__ __forceinline__ void init(const int* te, int ntn_, size_t es, int G_, int c_) { tilee = te; nt = te[0]; ntn = ntn_; estride = es; G = G_; c = c_; }
    __device__ __forceinline__ bool next(int i, Unit& u) const { const long L = (long)i * G + c; if (L >= (long)nt * ntn) return false; u.pn = (int)(L / nt); u.pm = (int)(L % nt); u.e = tilee[1 + u.pm]; return true; }
    __device__ __forceinline__ const char* abase(const Gemm& g, const Unit& u, size_t tstep) const { return (const char*)g.A + (size_t)u.pm * tstep; }
    __device__ __forceinline__ const char* bbase(const Gemm& g, const Unit& u, size_t tstep) const { return (const char*)g.Bt + (size_t)u.e * estride + (size_t)u.pn * tstep; }
    __device__ __forceinline__ void a_ready(const Unit&) const {}
    __device__ __forceinline__ void done(const Unit&) const {}
};
struct EpiStoreBf16 {
    static constexpr bool PERM = true, AFTER_DRAIN = false;
    bf16_t* O; int ldc;
    __device__ __forceinline__ void operator()(const f32x4 (&acc)[2][2][4][2], const Unit& u, int wr, int wc, int fr, int fq) const {
        const int row0 = u.pm * BM + wr * 64 + fr, col0 = u.pn * BM + wc * 32 + 8 * fq;
#pragma unroll
        for (int ai = 0; ai < 2; ++ai)
#pragma unroll
            for (int m = 0; m < 4; ++m) { bf16_t* rowp = O + (size_t)(row0 + ai * HALF + m * 16) * ldc + col0;
#pragma unroll
                for (int bj = 0; bj < 2; ++bj) { const f32x4 v0 = acc[ai][bj][m][0], v1 = acc[ai][bj][m][1];
                    u32x4 w; w.x = cvt_pk_bf16(v0[0], v0[1]); w.y = cvt_pk_bf16(v0[2], v0[3]); w.z = cvt_pk_bf16(v1[0], v1[1]); w.w = cvt_pk_bf16(v1[2], v1[3]);
                    *(u32x4*)(rowp + bj * HALF) = w; } }
    }
};
struct EpiStoreF32 {
    static constexpr bool PERM = false, AFTER_DRAIN = false;
    float* C; int ldc;
    __device__ __forceinline__ void operator()(const f32x4 (&acc)[2][2][4][2], const Unit& u, int wr, int wc, int fr, int fq) const {
        const int row0 = u.pm * BM + wr * 64 + fr, col0 = u.pn * BM + wc * 32 + 4 * fq;
#pragma unroll
        for (int ai = 0; ai < 2; ++ai)
#pragma unroll
            for (int m = 0; m < 4; ++m) { float* rowp = C + (size_t)(row0 + ai * HALF + m * 16) * ldc + col0;
#pragma unroll
                for (int bj = 0; bj < 2; ++bj)
#pragma unroll
                    for (int n = 0; n < 2; ++n) *(f32x4*)(rowp + bj * HALF + n * 16) = acc[ai][bj][m][n]; }
    }
};
struct EpiResid {
    static constexpr bool PERM = false, AFTER_DRAIN = false;
    const float* base_lat; const float* base_ctx; float* out; const float* gate; int gstride;
    __device__ __forceinline__ void operator()(const f32x4 (&acc)[2][2][4][2], const Unit& u, int wr, int wc, int fr, int fq) const {
        const int row0 = u.pm * BM + wr * 64 + fr, col0 = u.pn * BM + wc * 32 + 4 * fq;
#pragma unroll
        for (int ai = 0; ai < 2; ++ai)
#pragma unroll
            for (int m = 0; m < 4; ++m) { const int row = row0 + ai * HALF + m * 16;
                const float* bp = (row < 16384) ? base_lat + (size_t)row * 1024 : base_ctx + (size_t)(row - 16384) * 1024;
                const float* gp = gate + (size_t)(row < 16384 ? (row >= 8192 ? 1 : 0) : 2) * gstride;
                float* op = out + (size_t)row * 1024;
#pragma unroll
                for (int bj = 0; bj < 2; ++bj)
#pragma unroll
                    for (int n = 0; n < 2; ++n) { const int c = col0 + bj * HALF + n * 16;
                        *(f32x4*)(op + c) = *(const f32x4*)(bp + c) + *(const f32x4*)(gp + c) * acc[ai][bj][m][n]; } }
    }
};
__device__ __forceinline__ float sigm_(float x) { return 1.0f / (1.0f + __expf(-x)); }
struct EpiSwiglu {
    static constexpr bool PERM = true, AFTER_DRAIN = false;
    bf16_t* O; const float* bgu;
    __device__ __forceinline__ void operator()(const f32x4 (&acc)[2][2][4][2], const Unit& u, int wr, int wc, int fr, int fq) const {
        const int row0 = u.pm * BM + wr * 64 + fr, col0 = u.pn * HALF + wc * 32 + 8 * fq;
        const float* bg = bgu + (size_t)u.e * 2048 + col0; f32x4 bgv[2], buv[2];
#pragma unroll
        for (int n = 0; n < 2; ++n) { bgv[n] = *(const f32x4*)(bg + 4 * n); buv[n] = *(const f32x4*)(bg + 1024 + 4 * n); }
#pragma unroll
        for (int ai = 0; ai < 2; ++ai)
#pragma unroll
            for (int m = 0; m < 4; ++m) { float r[8];
#pragma unroll
                for (int n = 0; n < 2; ++n) { const f32x4 g4 = acc[ai][0][m][n] + bgv[n], u4 = acc[ai][1][m][n] + buv[n];
#pragma unroll
                    for (int j = 0; j < 4; ++j) { const float g = fminf(g4[j], 7.0f), uu = fminf(fmaxf(u4[j], -7.0f), 7.0f); r[4 * n + j] = g * sigm_(1.702f * g) * (uu + 1.0f); } }
                u32x4 w; w.x = cvt_pk_bf16(r[0], r[1]); w.y = cvt_pk_bf16(r[2], r[3]); w.z = cvt_pk_bf16(r[4], r[5]); w.w = cvt_pk_bf16(r[6], r[7]);
                *(u32x4*)(O + (size_t)(row0 + ai * HALF + m * 16) * 1024 + col0) = w; }
    }
};
struct EpiDown {
    static constexpr bool PERM = true, AFTER_DRAIN = false;
    bf16_t* O; const float* bdn;
    __device__ __forceinline__ void operator()(const f32x4 (&acc)[2][2][4][2], const Unit& u, int wr, int wc, int fr, int fq) const {
        const int row0 = u.pm * BM + wr * 64 + fr, col0 = u.pn * BM + wc * 32 + 8 * fq;
        const float* bp = bdn + (size_t)u.e * 1024 + col0; f32x4 bv[2][2];
#pragma unroll
        for (int bj = 0; bj < 2; ++bj)
#pragma unroll
            for (int n = 0; n < 2; ++n) bv[bj][n] = *(const f32x4*)(bp + bj * HALF + 4 * n);
#pragma unroll
        for (int ai = 0; ai < 2; ++ai)
#pragma unroll
            for (int m = 0; m < 4; ++m) { bf16_t* rowp = O + (size_t)(row0 + ai * HALF + m * 16) * 1024 + col0;
#pragma unroll
                for (int bj = 0; bj < 2; ++bj) { const f32x4 v0 = acc[ai][bj][m][0] + bv[bj][0], v1 = acc[ai][bj][m][1] + bv[bj][1];
                    u32x4 w; w.x = cvt_pk_bf16(v0[0], v0[1]); w.y = cvt_pk_bf16(v0[2], v0[3]); w.z = cvt_pk_bf16(v1[0], v1[1]); w.w = cvt_pk_bf16(v1[2], v1[3]);
                    *(u32x4*)(rowp + bj * HALF) = w; } }
    }
};
struct EpiLora1 {
    static constexpr bool PERM = true, AFTER_DRAIN = false;
    bf16_t* O;
    __device__ __forceinline__ void operator()(const f32x4 (&acc)[2][2][4][2], const Unit& u, int wr, int wc, int fr, int fq) const {
        const int row0 = u.pm * BM + wr * 64 + fr, col0 = u.pn * HALF + wc * 32 + 8 * fq;
#pragma unroll
        for (int ai = 0; ai < 2; ++ai)
#pragma unroll
            for (int m = 0; m < 4; ++m) { float r[8];
#pragma unroll
                for (int n = 0; n < 2; ++n)
#pragma unroll
                    for (int j = 0; j < 4; ++j) { const float x = acc[ai][0][m][n][j]; r[4 * n + j] = (u.pn == 0) ? (2.0f * sigm_(2.0f * x) - 1.0f) : (u.pn == 1) ? x : sigm_(x); }
                u32x4 w; w.x = cvt_pk_bf16(r[0], r[1]); w.y = cvt_pk_bf16(r[2], r[3]); w.z = cvt_pk_bf16(r[4], r[5]); w.w = cvt_pk_bf16(r[6], r[7]);
                *(u32x4*)(O + (size_t)(row0 + ai * HALF + m * 16) * 384 + col0) = w; }
    }
};
struct EpiLora2 {
    static constexpr bool PERM = false, AFTER_DRAIN = false;
    float* WD; float* AD; float* G; const float* w0; const float* a0;
    __device__ __forceinline__ void operator()(const f32x4 (&acc)[2][2][4][2], const Unit& u, int wr, int wc, int fr, int fq) const {
        const int row0 = u.pm * BM + wr * 64 + fr, blk = u.pn >> 2, col0 = (u.pn & 3) * BM + wc * 32 + 4 * fq;
        float* dst = (blk < 2) ? WD + (size_t)blk * 16896 * 1024 : (blk < 4) ? AD + (size_t)(blk - 2) * 16896 * 1024 : G;
        const float* bias = (blk < 2) ? w0 + blk * 1024 : a0 + ((blk - 2) & 1) * 1024;
#pragma unroll
        for (int ai = 0; ai < 2; ++ai)
#pragma unroll
            for (int m = 0; m < 4; ++m) { float* rowp = dst + (size_t)(row0 + ai * HALF + m * 16) * 1024;
#pragma unroll
                for (int bj = 0; bj < 2; ++bj)
#pragma unroll
                    for (int n = 0; n < 2; ++n) { const int c = col0 + bj * HALF + n * 16; f32x4 v = acc[ai][bj][m][n];
                        const f32x4 bb = *(const f32x4*)(bias + c);
                        if (blk < 2) { for (int j = 0; j < 4; ++j) v[j] = __expf(-0.60653066f * sigm_(v[j] + bb[j])); }
                        else if (blk < 4) { for (int j = 0; j < 4; ++j) v[j] = sigm_(v[j] + bb[j]); }
                        *(f32x4*)(rowp + c) = v; }
                asm volatile("" ::: "memory"); }
    }
};
}

constexpr int GLA_NCH = NSTEP / 64;
constexpr int GLA_ITEMS = 2 * NBATCH * GLA_NCH * 8;
constexpr size_t U_DS = 298 * MiB, U_OI = 430 * MiB, U_QT = 562 * MiB, U_LAM = 628 * MiB;
typedef short bf16x8_t __attribute__((ext_vector_type(8)));
__device__ __forceinline__ f32x4 mfma16(bf16x8_t a, bf16x8_t b, f32x4 c) { return __builtin_amdgcn_mfma_f32_16x16x32_bf16(a, b, c, 0, 0, 0); }

__device__ __forceinline__ void phase_gla_prep(PP p, LAS unsigned char* lds, int tid, int lane, int wave) {
    constexpr int PQ = 272, PT = 144;
    LAS unsigned char* QA = lds;
    LAS unsigned char* QX = QA + 64 * PQ;
    LAS unsigned char* KB = QX + 48 * PQ;
    LAS unsigned char* KD = KB + 64 * PQ;
    LAS unsigned char* KT = KD + 64 * PQ;
    LAS unsigned char* VT = KT + 128 * PT;
    LAS unsigned char* PI = VT + 128 * PT;
    LAS float* GT = (LAS float*)(PI + 64 * PT);
    const bf16* Z = (const bf16*)(p->ws + WS_U + U_Z);
    bf16* DS = (bf16*)(p->ws + WS_U + U_DS); f32x4* OI = (f32x4*)(p->ws + WS_U + U_OI); bf16* QT = (bf16*)(p->ws + WS_U + U_QT); float* LAM = (float*)(p->ws + WS_U + U_LAM);
    const int k = tid & 127, g = tid >> 7, kq = lane >> 4, c16 = lane & 15;
    for (int item = blockIdx.x; item < GLA_ITEMS; item += gridDim.x) {
        const int h = item & 7, cc = (item >> 3) % GLA_NCH, db = (item >> 3) / GLA_NCH, b = db & 1, dir = db >> 1;
        float lbv; { const float* lb = p->in[I_HGLB] + (size_t)dir * 3 * D + h * 128 + k; const float a0 = lb[0], a1 = lb[D], a2 = lb[2 * D];
                     const float m = fmaxf(a0, fmaxf(a1, a2)); const float e0 = __expf(a0 - m), e1 = __expf(a1 - m), e2 = __expf(a2 - m); lbv = e0 / (e0 + e1 + e2); }
        for (int u = tid; u < 64 * PT / 4; u += NTHREADS) ((LAS unsigned*)PI)[u] = 0u;
        float cs[16], kin[16], qs[16]; unsigned vt[8]; float run = 0.f;
#pragma unroll
        for (int i = 0; i < 16; ++i) {
            const size_t zr = (size_t)step_row(b, dir, 64 * cc + 16 * g + i) * 5120 + h * 128 + k;
            const float fh = bf2f(Z[zr + 1024 * (1 + dir)]), qv = bf2f(Z[zr]); const unsigned zv = Z[zr + 3072];
            const float f = lbv + (1.f - lbv) * sigm(fh);
            run += __logf(f); cs[i] = run; kin[i] = 1.f - f; qs[i] = qv * sigm(qv);
            if (i & 1) vt[i >> 1] |= zv << 16; else vt[i >> 1] = zv;
        }
        GT[g * 128 + k] = run;
        { LAS v4u* d = (LAS v4u*)(VT + k * PT + 32 * g); d[0] = (v4u){vt[0], vt[1], vt[2], vt[3]}; d[1] = (v4u){vt[4], vt[5], vt[6], vt[7]}; }
        __syncthreads();
        const float t0 = GT[k], t1 = GT[128 + k], t2 = GT[256 + k], t3 = GT[384 + k];
        const float rg = (g > 0 ? t0 : 0.f) + (g > 1 ? t1 : 0.f) + (g > 2 ? t2 : 0.f), tot = (t0 + t1) + (t2 + t3);
        const float erg = __expf(rg), einv = __expf(-run), eend = __expf(tot - (rg + run));
        const float ex1 = (g == 2) ? __expf(t1) : __expf(t2);
        const float ex2 = __expf(t1 + t2);
        unsigned kt[8];
        bf16* qtp = QT + (size_t)item * 64 * 128 + (size_t)(16 * g) * 128 + k;
#pragma unroll
        for (int i = 0; i < 16; ++i) {
            const float qh = qs[i] * __expf(cs[i]), kb = kin[i] * __expf(run - cs[i]);
            const int ro = (16 * g + i) * PQ + 2 * k;
            *(LAS unsigned short*)(QA + ro) = (unsigned short)f2bf(qh);
            *(LAS unsigned short*)(KB + ro) = (unsigned short)f2bf(kb);
            *(LAS unsigned short*)(KD + ro) = (unsigned short)f2bf(kb * einv);
            if (g == 2) *(LAS unsigned short*)(QX + i * PQ + 2 * k) = (unsigned short)f2bf(qh * ex1);
            if (g == 3) { *(LAS unsigned short*)(QX + (16 + i) * PQ + 2 * k) = (unsigned short)f2bf(qh * ex1); *(LAS unsigned short*)(QX + (32 + i) * PQ + 2 * k) = (unsigned short)f2bf(qh * ex2); }
            qtp[(size_t)i * 128] = (bf16)f2bf(qh * erg);
            const unsigned kv = f2bf(kb * eend);
            if (i & 1) kt[i >> 1] |= kv << 16; else kt[i >> 1] = kv;
        }
        { LAS v4u* d = (LAS v4u*)(KT + k * PT + 32 * g); d[0] = (v4u){kt[0], kt[1], kt[2], kt[3]}; d[1] = (v4u){kt[4], kt[5], kt[6], kt[7]}; }
        if (g == 0) LAM[(size_t)item * 128 + k] = __expf(tot);
        __syncthreads();
        for (int blk = wave; blk < 10; blk += 8) {
            const int gi = (blk >= 6) ? 3 : (blk >= 3) ? 2 : (blk >= 1) ? 1 : 0, ji = blk - ((gi * (gi + 1)) >> 1);
            const LAS unsigned char* ab = (ji + 1 >= gi) ? QA + 16 * gi * PQ : (gi == 2) ? QX : (ji == 1) ? QX + 16 * PQ : QX + 32 * PQ;
            const LAS unsigned char* bb = ((ji == gi) ? KD : KB) + 16 * ji * PQ;
            f32x4 acc = (f32x4){0.f, 0.f, 0.f, 0.f};
#pragma unroll
            for (int s = 0; s < 4; ++s) {
                const bf16x8_t a = *(const LAS bf16x8_t*)(ab + c16 * PQ + (32 * s + 8 * kq) * 2), bv = *(const LAS bf16x8_t*)(bb + c16 * PQ + (32 * s + 8 * kq) * 2);
                acc = mfma16(a, bv, acc);
            }
#pragma unroll
            for (int j = 0; j < 4; ++j) { const int tau = 4 * kq + j; const float val = (ji == gi && c16 > tau) ? 0.f : acc[j];
                *(LAS unsigned short*)(PI + (16 * gi + tau) * PT + (16 * ji + c16) * 2) = (unsigned short)f2bf(val); }
        }
        __syncthreads();
        {
            const LAS unsigned char* vb = VT + (16 * wave + c16) * PT + 16 * kq;
            const bf16x8_t v0 = *(const LAS bf16x8_t*)(vb), v1 = *(const LAS bf16x8_t*)(vb + 64);
#pragma unroll
            for (int gi = 0; gi < 4; ++gi) {
                const LAS unsigned char* pb = PI + (16 * gi + c16) * PT + 16 * kq;
                f32x4 acc = mfma16(*(const LAS bf16x8_t*)(pb), v0, (f32x4){0.f, 0.f, 0.f, 0.f});
                if (gi >= 2) acc = mfma16(*(const LAS bf16x8_t*)(pb + 64), v1, acc);
                OI[((size_t)item * 8 + wave) * 256 + gi * 64 + lane] = acc;
            }
            bf16* dsp = DS + (size_t)item * 128 * 128 + (size_t)(16 * wave + c16) * 128 + 4 * kq;
#pragma unroll
            for (int m = 0; m < 8; ++m) {
                const LAS unsigned char* kb2 = KT + (16 * m + c16) * PT + 16 * kq;
                f32x4 acc = mfma16(*(const LAS bf16x8_t*)(kb2), v0, (f32x4){0.f, 0.f, 0.f, 0.f});
                acc = mfma16(*(const LAS bf16x8_t*)(kb2 + 64), v1, acc);
                v2u w; w.x = pk2(acc[0], acc[1]); w.y = pk2(acc[2], acc[3]);
                *(v2u*)(dsp + 16 * m) = w;
            }
        }
        __syncthreads();
    }
}
__device__ __forceinline__ void phase_gla_scan(PP p, int tid) {
    bf16* DS = (bf16*)(p->ws + WS_U + U_DS); const float* LAM = (const float*)(p->ws + WS_U + U_LAM);
    const int nthr = gridDim.x * NTHREADS;
    for (int e = blockIdx.x * NTHREADS + tid; e < 32 * 2048; e += nthr) {
        const int chain = e >> 11, el = e & 2047, h = chain & 7, db = chain >> 3, k8 = (el & 15) * 8;
        float s[8];
#pragma unroll
        for (int i = 0; i < 8; ++i) s[i] = 0.f;
        for (int c0 = 0; c0 < GLA_NCH; c0 += 6) {
            v4u d[6]; f32x4 l0[6], l1[6];
#pragma unroll
            for (int u = 0; u < 6; ++u) { const size_t item = ((size_t)db * GLA_NCH + c0 + u) * 8 + h;
                d[u] = *(const v4u*)(DS + item * 16384 + (size_t)el * 8); l0[u] = *(const f32x4*)(LAM + item * 128 + k8); l1[u] = *(const f32x4*)(LAM + item * 128 + k8 + 4); }
#pragma unroll
            for (int u = 0; u < 6; ++u) { const size_t item = ((size_t)db * GLA_NCH + c0 + u) * 8 + h;
                v4u o; o.x = pk2(s[0], s[1]); o.y = pk2(s[2], s[3]); o.z = pk2(s[4], s[5]); o.w = pk2(s[6], s[7]);
                *(v4u*)(DS + item * 16384 + (size_t)el * 8) = o;
                s[0] = l0[u].x * s[0] + bf2f(d[u].x & 0xffffu); s[1] = l0[u].y * s[1] + bf2f(d[u].x >> 16);
                s[2] = l0[u].z * s[2] + bf2f(d[u].y & 0xffffu); s[3] = l0[u].w * s[3] + bf2f(d[u].y >> 16);
                s[4] = l1[u].x * s[4] + bf2f(d[u].z & 0xffffu); s[5] = l1[u].y * s[5] + bf2f(d[u].z >> 16);
                s[6] = l1[u].z * s[6] + bf2f(d[u].w & 0xffffu); s[7] = l1[u].w * s[7] + bf2f(d[u].w >> 16); }
        }
    }
}
__device__ __forceinline__ void phase_gla_out(PP p, int lane, int wave) {
    const bf16* DS = (const bf16*)(p->ws + WS_U + U_DS); const f32x4* OI = (const f32x4*)(p->ws + WS_U + U_OI); const bf16* QT = (const bf16*)(p->ws + WS_U + U_QT);
    float* ODb = (float*)(p->ws + WS_U + U_OD0);
    const int kq = lane >> 4, c16 = lane & 15;
    for (int item = blockIdx.x; item < GLA_ITEMS; item += gridDim.x) {
        const int h = item & 7, cc = (item >> 3) % GLA_NCH, db = (item >> 3) / GLA_NCH, b = db & 1, dir = db >> 1;
        const bf16* sp = DS + (size_t)item * 16384 + (size_t)(16 * wave + c16) * 128 + 8 * kq;
        bf16x8_t bv[4];
#pragma unroll
        for (int s = 0; s < 4; ++s) bv[s] = *(const bf16x8_t*)(sp + 32 * s);
        float* OD = ODb + (size_t)dir * NROW * D + h * 128 + 16 * wave + c16;
#pragma unroll
        for (int gi = 0; gi < 4; ++gi) {
            const bf16* qp = QT + (size_t)item * 8192 + (size_t)(16 * gi + c16) * 128 + 8 * kq;
            f32x4 acc = OI[((size_t)item * 8 + wave) * 256 + gi * 64 + lane];
#pragma unroll
            for (int s = 0; s < 4; ++s) acc = mfma16(*(const bf16x8_t*)(qp + 32 * s), bv[s], acc);
#pragma unroll
            for (int j = 0; j < 4; ++j) OD[(size_t)step_row(b, dir, 64 * cc + 16 * gi + 4 * kq + j) * D] = acc[j];
        }
    }
}

constexpr int RW_NB = 32, RW_SLOT = 336;
__device__ __forceinline__ float row16_sum(float x) {
    x += __builtin_bit_cast(float, __builtin_amdgcn_update_dpp(0, __builtin_bit_cast(int, x), 0x128, 0xf, 0xf, false));
    x += __builtin_bit_cast(float, __builtin_amdgcn_update_dpp(0, __builtin_bit_cast(int, x), 0x124, 0xf, 0xf, false));
    x += __builtin_bit_cast(float, __builtin_amdgcn_update_dpp(0, __builtin_bit_cast(int, x), 0x122, 0xf, 0xf, false));
    x += __builtin_bit_cast(float, __builtin_amdgcn_update_dpp(0, __builtin_bit_cast(int, x), 0x121, 0xf, 0xf, false));
    return x;
}
__device__ __forceinline__ void rw_fill(PP p, LAS float* buf, int batch, int b, int dir, int h, int rowgrp, int lw, int lane) {
    const float* RKV = (const float*)(p->ws + WS_U + U_RKV);
    const float* WDp = (const float*)(p->ws + WS_U + U_WD) + (size_t)dir * NROW * D; const float* ADp = (const float*)(p->ws + WS_U + U_AD) + (size_t)dir * NROW * D;
    const int ch = h * 64 + lane; const float kkw = p->in[I_KK][ch], kaw = p->in[I_KA][ch];
    float rx[8], kx[8], vx[8], wv[8], av[8];
#pragma unroll
    for (int u = 0; u < 8; ++u) { const int row = step_row(b, dir, batch * RW_NB + lw + 4 * u);
        rx[u] = RKV[(size_t)row * 3072 + ch]; kx[u] = RKV[(size_t)row * 3072 + 1024 + ch]; vx[u] = RKV[(size_t)row * 3072 + 2048 + ch];
        wv[u] = WDp[(size_t)row * D + ch]; av[u] = ADp[(size_t)row * D + ch]; }
#pragma unroll
    for (int u = 0; u < 8; ++u) {
        float kkx = kx[u] * kkw; const float nrm = sqrtf(wave_sum(kkx * kkx)); kkx = kkx / fmaxf(nrm, 1e-12f);
        LAS float* B = buf + (lw + 4 * u) * RW_SLOT;
        B[lane] = wv[u]; B[64 + lane] = kkx; B[128 + lane] = kkx * av[u]; B[192 + lane] = kx[u] * (1.f + (av[u] - 1.f) * kaw); B[256 + lane] = rx[u];
        if ((lane >> 4) == rowgrp) B[320 + (lane & 15)] = vx[u];
    }
}
__device__ __forceinline__ void phase_rwkv_scan(PP p, LAS unsigned char* lds, int lane, int wave) {
    LAS float* L = (LAS float*)lds;
    for (int unit = blockIdx.x; unit < 256; unit += gridDim.x) {
        const int chain = unit >> 2, rowgrp = unit & 3, b = chain >> 5, dir = (chain >> 4) & 1, h = chain & 15;
        float* OD = (float*)(p->ws + WS_U + U_OD1) + (size_t)dir * NROW * D + h * 64 + 16 * rowgrp + 4 * wave + (lane >> 4);
        const int seg = lane & 15;
        f32x4 S = (f32x4){0.f, 0.f, 0.f, 0.f};
        if (wave >= 4) rw_fill(p, L, 0, b, dir, h, rowgrp, wave - 4, lane);
        __syncthreads();
        constexpr int NBATCH_RW = NSTEP / RW_NB;
        for (int bt = 0; bt < NBATCH_RW; ++bt) {
            if (wave >= 4) { if (bt + 1 < NBATCH_RW) rw_fill(p, L + ((bt + 1) & 1) * RW_NB * RW_SLOT, bt + 1, b, dir, h, rowgrp, wave - 4, lane); }
            else {
                const LAS float* B0 = L + (bt & 1) * RW_NB * RW_SLOT;
#pragma unroll 4
                for (int s = 0; s < RW_NB; ++s) {
                    const LAS f32x4* B4 = (const LAS f32x4*)(B0 + s * RW_SLOT);
                    const f32x4 w4 = B4[seg], kk4 = B4[16 + seg], bt4 = B4[32 + seg], kd4 = B4[48 + seg], r4 = B4[64 + seg];
                    const float vv = B0[s * RW_SLOT + 320 + 4 * wave + (lane >> 4)];
                    float sa = (S.x * kk4.x + S.y * kk4.y) + (S.z * kk4.z + S.w * kk4.w);
                    sa = row16_sum(sa);
                    S = S * w4 - sa * bt4 + vv * kd4;
                    float y = (S.x * r4.x + S.y * r4.y) + (S.z * r4.z + S.w * r4.w);
                    y = row16_sum(y);
                    if (seg == 0) OD[(size_t)step_row(b, dir, bt * RW_NB + s) * D] = y;
                }
            }
            __syncthreads();
        }
    }
}
enum { PH_PRE = 0, PH_NORM0, PH_G_IN, PH_GLA_A, PH_GLA_B, PH_GLA_C, PH_HGRO, PH_G_HGO, PH_FFN0, PH_GATHER0, PH_GU0, PH_DN0, PH_COMB0,
       PH_LERP, PH_G_RKV, PH_G_L2, PH_RWSCAN, PH_RWRO, PH_G_RWO, PH_FFN1, PH_GATHER1, PH_GU1, PH_DN1, PH_COMB1, NPHASES };

template <int ph> __device__ __forceinline__ void run_phase(PP p, LAS unsigned char* lds, int tid, int lane, int wave, int G, int bx, int vcu) {
    unsigned char* ws = p->ws;
    typedef pg8::bf16_t bt;
    switch (ph) {
        case PH_PRE: phase_pre(p, lds, tid, lane, wave); break;
        case PH_NORM0: phase_norm0(p, lane, wave); break;
        case PH_G_IN: {
            pg8::Gemm g{(const bt*)(ws + WS_H), (const bt*)(ws + WS_WIN), NROW, 5120, D}; pg8::StaticOrder S; S.init(NROW, 5120, G, bx);
            pg8::EpiStoreBf16 E{(bt*)(ws + WS_U + U_Z), 5120};
            pg8::gemm_phase<pg8::EpiStoreBf16, pg8::StaticOrder, true, true>(lds, g, S, E); } break;
        case PH_GLA_A: phase_gla_prep(p, lds, tid, lane, wave); break;
        case PH_GLA_B: phase_gla_scan(p, tid); break;
        case PH_GLA_C: phase_gla_out(p, lane, wave); break;
        case PH_HGRO: phase_hg_readout(p, lane, wave); break;
        case PH_G_HGO: {
            pg8::Gemm g{(const bt*)(ws + WS_A2), (const bt*)(ws + WS_WHGO), NROW, D, D}; pg8::StaticOrder S; S.init(NROW, D, G, bx);
            pg8::EpiResid E{p->in[I_X], p->in[I_CTX], (float*)(ws + WS_XR), modp(p, 0, 0, 2), 6144};
            pg8::gemm_phase<pg8::EpiResid, pg8::StaticOrder, true, true>(lds, g, S, E); } break;
        case PH_FFN0: phase_ffn_norm_route(p, 0, NROW, lane, wave); break;
        case PH_FFN1: phase_ffn_norm_route(p, 1, NLAT, lane, wave); break;
        case PH_GATHER0: phase_gather(p, 0, NROW, lds, tid, lane, wave); break;
        case PH_GATHER1: phase_gather(p, 1, NLAT, lds, tid, lane, wave); break;
        case PH_GU0: case PH_GU1: { const int layer = (ph == PH_GU1);
            pg8::Gemm g{(const bt*)(ws + WS_U + U_XB), (const bt*)(ws + WS_WGU) + (size_t)layer * NE * 2048 * D, CAP, 2048, D};
            pg8::MoeOrder S; S.init((const int*)(ws + WS_ROUTE + RT_TILEE), 8, (size_t)2048 * D * 2, G, vcu);
            pg8::EpiSwiglu E{(bt*)(ws + WS_U + U_ACT), p->in[I_BGU] + (size_t)layer * NE * 2048};
            pg8::gemm_phase<pg8::EpiSwiglu, pg8::MoeOrder, true, true>(lds, g, S, E); } break;
        case PH_DN0: case PH_DN1: { const int layer = (ph == PH_DN1);
            pg8::Gemm g{(const bt*)(ws + WS_U + U_ACT), (const bt*)(ws + WS_WD) + (size_t)layer * NE * D * D, CAP, D, D};
            pg8::MoeOrder S; S.init((const int*)(ws + WS_ROUTE + RT_TILEE), 4, (size_t)D * D * 2, G, vcu);
            pg8::EpiDown E{(bt*)(ws + WS_U + U_YS), p->in[I_BDN] + (size_t)layer * NE * D};
            pg8::gemm_phase<pg8::EpiDown, pg8::MoeOrder, true, true>(lds, g, S, E); } break;
        case PH_COMB0: phase_combine(p, 0, NROW, false, lane, wave); break;
        case PH_COMB1: phase_combine(p, 1, NLAT, true, lane, wave); break;
        case PH_LERP: phase_lerp(p, lane, wave); break;
        case PH_G_RKV: {
            { pg8::Gemm g{(const bt*)(ws + WS_U + U_XL6), (const bt*)(ws + WS_WRKV), NROW, 3072, D};
              pg8::SelOrder S; S.init(NROW, 3072, G, bx); S.div = 4; S.sel0 = 0; S.stride = (size_t)NROW * D * 2;
              pg8::EpiStoreF32 E{(float*)(ws + WS_U + U_RKV), 3072};
              pg8::gemm_phase<pg8::EpiStoreF32, pg8::SelOrder, true, true>(lds, g, S, E); }
            { pg8::Gemm g{(const bt*)(ws + WS_U + U_XL6), (const bt*)(ws + WS_WL1), NROW, 768, D};
              pg8::SelOrder S; S.init(NROW, 768, G, bx); S.div = 1; S.sel0 = 3; S.stride = (size_t)NROW * D * 2;
              pg8::EpiLora1 E{(bt*)(ws + WS_U + U_L1)};
              pg8::gemm_phase<pg8::EpiLora1, pg8::SelOrder, true, true>(lds, g, S, E); } } break;
        case PH_G_L2: {
            pg8::Gemm g{(const bt*)(ws + WS_U + U_L1), (const bt*)(ws + WS_WL2), NROW, 5120, 384}; pg8::StaticOrder S; S.init(NROW, 5120, G, bx);
            pg8::EpiLora2 E{(float*)(ws + WS_U + U_WD), (float*)(ws + WS_U + U_AD), (float*)(ws + WS_U + U_G), p->in[I_DECW0], p->in[I_A0]};
            pg8::gemm_phase<pg8::EpiLora2, pg8::StaticOrder, true, true>(lds, g, S, E); } break;
        case PH_RWSCAN: phase_rwkv_scan(p, lds, lane, wave); break;
        case PH_RWRO: phase_rw_readout(p, lane, wave); break;
        case PH_G_RWO: {
            pg8::Gemm g{(const bt*)(ws + WS_A2), (const bt*)(ws + WS_WRWO), NLAT, D, D}; pg8::StaticOrder S; S.init(NLAT, D, G, bx);
            float* XR = (float*)(ws + WS_XR);
            pg8::EpiResid E{XR, XR + (size_t)NLAT * D, XR, modp(p, 1, 0, 2), 6144};
            pg8::gemm_phase<pg8::EpiResid, pg8::StaticOrder, true, true>(lds, g, S, E); } break;
        default: break;
    }
}

#define MK_PROLOGUE \
    extern __shared__ __attribute__((aligned(16))) unsigned char lds_raw[]; \
    LAS unsigned char* lds = (LAS unsigned char*)lds_raw; \
    const int tid = threadIdx.x, lane = tid & 63, wave = __builtin_amdgcn_readfirstlane(tid >> 6); \
    const int G = gridDim.x, bx = blockIdx.x, vcu = (G % 8 == 0) ? (bx % 8) * (G / 8) + bx / 8 : bx;

#define XB_TMO      128
#define XB_XCNT(j)  (256  + 64 * (j))
#define XB_XSUB(j)  (1280 + 64 * (j))
#define XB_XGEN(j)  (2304 + 64 * (j))
#define XB_TOP      3328
#define XB_TOPGEN   3392
#define XCD_BAR_WORDS 3456
#define XB_SPIN_CAP (1u << 18)

__device__ __forceinline__ unsigned xb_ld(unsigned* p)              { return __hip_atomic_load(p, __ATOMIC_RELAXED, __HIP_MEMORY_SCOPE_AGENT); }
__device__ __forceinline__ unsigned xb_add(unsigned* p, unsigned v) { return __hip_atomic_fetch_add(p, v, __ATOMIC_RELAXED, __HIP_MEMORY_SCOPE_AGENT); }
__device__ __forceinline__ unsigned xb_xcc_id() { return (unsigned)__builtin_amdgcn_s_getreg((3 << 11) | 20) & 0xFu; }
#define XB_SPIN(cond, bar) do { unsigned _sp = 0; while (cond) { __builtin_amdgcn_s_sleep(1); \
    if ((++_sp & 255u) == 0u) { if (xb_ld(&(bar)[XB_TMO])) break; if (_sp > XB_SPIN_CAP) { atomicAdd(&(bar)[XB_TMO], 1u); break; } } } } while (0)

struct XcdBarrier {
    unsigned* bar; unsigned x;
    volatile LAS unsigned* st;
};

__device__ __forceinline__ XcdBarrier xcd_barrier_post(unsigned* bar, volatile LAS unsigned* st) {
    XcdBarrier b; b.bar = bar; b.x = xb_xcc_id(); b.st = st;
    if (threadIdx.x == 0) (void)xb_add(&bar[XB_XCNT(b.x)], 1u);
    return b;
}
__device__ __forceinline__ void xcd_barrier_complete(unsigned* bar, unsigned x, unsigned& nloc, unsigned& nx) {
    const unsigned G = gridDim.x * gridDim.y * gridDim.z;
    unsigned sum, cnt, mine, sp = 0u;
    for (;;) {
        sum = 0u; cnt = 0u; mine = 0u;
#pragma unroll
        for (unsigned j = 0; j < 16; ++j) { const unsigned c = xb_ld(&bar[XB_XCNT(j)]); sum += c; cnt += (c > 0u) ? 1u : 0u; mine = (j == x) ? c : mine; }
        if (sum == G) break;
        __builtin_amdgcn_s_sleep(1);
        if ((++sp & 255u) == 0u) { if (xb_ld(&bar[XB_TMO])) break; if (sp > XB_SPIN_CAP) { atomicAdd(&bar[XB_TMO], 1u); break; } }
    }
    nloc = mine > 0u ? mine : 1u; nx = cnt > 0u ? cnt : 1u;
}

__device__ __forceinline__ void xcd_barrier(const XcdBarrier& b) {
    asm volatile("s_waitcnt vmcnt(0)" ::: "memory");
    __syncthreads();
    if (threadIdx.x == 0) {
        unsigned* bar = b.bar;
        __builtin_amdgcn_s_waitcnt(0);
        unsigned nloc = b.st[0], nx = b.st[1];
        if (nloc == 0u) { xcd_barrier_complete(bar, b.x, nloc, nx); b.st[0] = nloc; b.st[1] = nx; }
        const unsigned old = xb_add(&bar[XB_XSUB(b.x)], 1u);
        const unsigned gen = old / nloc;
        if (old + 1u == (gen + 1u) * nloc) {
            __builtin_amdgcn_fence(__ATOMIC_RELEASE, "agent");
            asm volatile("s_waitcnt vmcnt(0)" ::: "memory");
            const unsigned og = xb_add(&bar[XB_TOP], 1u);
            const unsigned tg = og / nx;
            if (og + 1u == (tg + 1u) * nx) xb_add(&bar[XB_TOPGEN], 1u);
            else XB_SPIN(xb_ld(&bar[XB_TOPGEN]) == tg, bar);
            __builtin_amdgcn_fence(__ATOMIC_ACQUIRE, "agent");
            xb_add(&bar[XB_XGEN(b.x)], 1u);
            asm volatile("s_waitcnt vmcnt(0)" ::: "memory");
        } else {
            XB_SPIN(xb_ld(&bar[XB_XGEN(b.x)]) == gen, bar);
            __builtin_amdgcn_fence(__ATOMIC_ACQUIRE, "agent");
            asm volatile("s_waitcnt vmcnt(0)" ::: "memory");
        }
    }
    __syncthreads();
}

constexpr int LDSCTL_OFF = 131072, MISC_OFF = LDSCTL_OFF + 320;
__device__ __forceinline__ void grid_bar(PP kp, LAS unsigned char* lds) {
    PP q = kp; asm volatile("" : "+s"(q));
    XcdBarrier b; b.bar = (unsigned*)(q->ws + WS_CTL) + CW_BAR; b.x = xb_xcc_id(); b.st = (volatile LAS unsigned*)(lds + MISC_OFF) + 8;
    xcd_barrier(b);
}
namespace cg = cooperative_groups;
__global__ void __launch_bounds__(NTHREADS, 2) mk_fwd(Params pv) {
    MK_PROLOGUE
    cg::grid_group grid = cg::this_grid();
    PP kp = (PP)__builtin_amdgcn_kernarg_segment_ptr();
    const int lo = kp->ph_lo, hi = kp->ph_hi;
    for (int u = tid; u < (LDS_BYTES - LDSCTL_OFF) / 4; u += NTHREADS) ((LAS unsigned*)(lds + LDSCTL_OFF))[u] = 0u;
    __syncthreads();
    { XcdBarrier b0 = xcd_barrier_post((unsigned*)(kp->ws + WS_CTL) + CW_BAR, (volatile LAS unsigned*)(lds + MISC_OFF) + 8); (void)b0; }
#ifndef REPEAT_MASK
#define REPEAT_MASK 0u
#endif
#define RUN(k) if (lo <= (k) && (k) < hi) { PP q = kp; asm volatile("" : "+s"(q)); run_phase<k>(q, lds, tid, lane, wave, G, bx, vcu); \
        if ((REPEAT_MASK >> (k)) & 1u) { grid_bar(kp, lds); PP q2 = kp; asm volatile("" : "+s"(q2)); run_phase<k>(q2, lds, tid, lane, wave, G, bx, vcu); } \
        if ((k) + 1 < hi) { if ((k) == 0) grid.sync(); else grid_bar(kp, lds); } }
    RUN(0) RUN(1) RUN(2) RUN(3) RUN(4) RUN(5) RUN(6) RUN(7) RUN(8) RUN(9) RUN(10) RUN(11) RUN(12) RUN(13) RUN(14) RUN(15) RUN(16) RUN(17) RUN(18) RUN(19) RUN(20) RUN(21) RUN(22) RUN(23)
#undef RUN
}

extern "C" void kernel_launch(void* const* d_in, const int* in_sizes, int n_in, void* d_out, int out_size, void* d_ws, size_t ws_size, hipStream_t stream) {
    static int grid = 0;
    if (grid == 0) {
        if (n_in != 35 || in_sizes[0] != NLAT * D || out_size != NLAT * D || ws_size < WS_END) {
            fprintf(stderr, "kernel_launch: unexpected problem (n_in %d, in0 %d, out %d, ws %zu < %zu)\n", n_in, n_in > 0 ? in_sizes[0] : -1, out_size, ws_size, (size_t)WS_END); grid = -1; return; }
        int dev = 0, cus = 0, per_cu = 0;
        if (hipGetDevice(&dev) != hipSuccess || hipDeviceGetAttribute(&cus, hipDeviceAttributeMultiprocessorCount, dev) != hipSuccess) { grid = -1; return; }
        if (hipFuncSetAttribute((const void*)mk_fwd, hipFuncAttributeMaxDynamicSharedMemorySize, LDS_BYTES) != hipSuccess) { fprintf(stderr, "kernel_launch: hipFuncSetAttribute failed\n"); grid = -1; return; }
        if (hipOccupancyMaxActiveBlocksPerMultiprocessor(&per_cu, (const void*)mk_fwd, NTHREADS, LDS_BYTES) != hipSuccess || per_cu < 1) { fprintf(stderr, "kernel_launch: occupancy query %d\n", per_cu); per_cu = 1; }
        (void)hipGetLastError();
        grid = cus * (per_cu < 1 ? 1 : per_cu);
    }
    if (grid < 0) return;
    (void)hipMemsetAsync((char*)d_ws + WS_CTL, 0, CTL_ZERO_BYTES, stream);
    Params p{};
    for (int i = 0; i < 35; ++i) p.in[i] = (const float*)d_in[i];
    p.out = (float*)d_out; p.ws = (unsigned char*)d_ws;
    p.ph_lo = 0; p.ph_hi = NPHASES;
    void* args[] = {&p};
    hipError_t e = hipLaunchCooperativeKernel((const void*)mk_fwd, dim3(grid), dim3(NTHREADS), args, LDS_BYTES, stream);
    if (e != hipSuccess) fprintf(stderr, "kernel_launch: cooperative launch failed: %s (grid %d)\n", hipGetErrorString(e), grid);
}
```

```cpp
#include <hip/hip_runtime.h>
#include <hip/hip_cooperative_groups.h>
#include <cstdio>
#include <cstdint>
namespace pg8 {
#define PG8_LAS __attribute__((address_space(3)))
typedef unsigned short bf16_t;
typedef short bf16x8 __attribute__((ext_vector_type(8)));
typedef float f32x4 __attribute__((ext_vector_type(4)));
typedef unsigned u32x4 __attribute__((ext_vector_type(4)));
constexpr int BM = 256, BK = 64, HALF = 128, HTB = HALF * BK * 2  , STAGE_BYTES = 8 * HTB, NXCD = 8, WGM = 8;

__host__ __device__ __forceinline__ int lds_byte(int r, int c) { const int st = (r >> 4) * 2 + (c >> 5), rr = r & 15, cc = c & 31, ob = rr * 64 + cc * 2; return st * 1024 + (ob ^ (((ob >> 9) & 1) << 5)); }
__host__ __device__ __forceinline__ void stage_rc(int b, int& R, int& C) { const int st = b / 1024, sb = b % 1024, swz = sb ^ (((sb >> 9) & 1) << 5); R = (st >> 1) * 16 + swz / 64; C = (st & 1) * 32 + (swz % 64) / 2; }
__host__ __device__ __forceinline__ int perm32(int rho) { const int n = rho >> 4, i = rho & 15; return 8 * (i >> 2) + 4 * n + (i & 3); }

struct Unit { int pm, pn, e; };
struct Gemm { const bf16_t* A; const bf16_t* Bt; int M, N, K; };

struct StaticOrder {
    int nM, nN, nwg, G, c;
    __host__ __device__ void init(int M, int N, int G_, int c_) { nM = M / BM; nN = N / BM; nwg = nM * nN; G = G_; c = c_; }
    __host__ __device__ bool next(int i, Unit& u) const {
        const long L = (long)i * G + c; if (L >= nwg) return false;
        int wgid = (int)L; { const int q = nwg / NXCD, r = nwg % NXCD, xcd = wgid % NXCD, off = wgid / NXCD; wgid = (xcd < r ? xcd * (q + 1) : r * (q + 1) + (xcd - r) * q) + off; }
        const int nig = WGM * nN, gid = wgid / nig, fm = gid * WGM, gsz = (nM - fm) < WGM ? (nM - fm) : WGM;
        u.pm = fm + ((wgid % nig) % gsz); u.pn = (wgid % nig) / gsz; u.e = 0; return true;
    }
    __device__ __forceinline__ const char* abase(const Gemm& g, const Unit& u, size_t tstep) const { return (const char*)g.A + (size_t)u.pm * tstep; }
    __device__ __forceinline__ const char* bbase(const Gemm& g, const Unit& u, size_t tstep) const { return (const char*)g.Bt + (size_t)u.pn * tstep; }
    __device__ __forceinline__ void a_ready(const Unit&) const {}
    __device__ __forceinline__ void done(const Unit&) const {}
};

__device__ __forceinline__ unsigned cvt_pk_bf16(float lo, float hi) { unsigned r; asm volatile("v_cvt_pk_bf16_f32 %0, %1, %2" : "=v"(r) : "v"(lo), "v"(hi)); return r; }

template <class Epi, class Sched, bool ALIGN_EPI = false, bool SP2 = false>
__device__ __forceinline__ void gemm_phase(PG8_LAS unsigned char* lds, const Gemm g, const Sched& S, const Epi& E) {
    const int tid = threadIdx.x, wid = __builtin_amdgcn_readfirstlane(tid >> 6), lane = tid & 63, wr = wid >> 2, wc = wid & 3, fr = lane & 15, fq = lane >> 4;
    const int K = g.K, nt = K / BK;
    unsigned voffA[2], voffB[2];
#pragma unroll
    for (int i = 0; i < 2; ++i) { int R, C; stage_rc(tid * 16 + i * 8192, R, C); const int Rb = Epi::PERM ? ((R & ~31) + perm32(R & 31)) : R;
        voffA[i] = (unsigned)(R * K + C) * 2u; voffB[i] = (unsigned)(Rb * K + C) * 2u; }
    const size_t kstep = (size_t)(BK * 2);
    const size_t hstep = (size_t)HALF * K * 2;
    const size_t tstep = 2 * hstep;
    const unsigned ldsw = (unsigned)wid * 1024u;
    const int aoff = lds_byte(wr * 64 + fr, fq * 8), boff = lds_byte(wc * 32 + fr, fq * 8);
#define PG8_SA(b, h) (((b) * 2 + (h)) * HTB)
#define PG8_SB(b, h) ((4 + (b) * 2 + (h)) * HTB)
#define PG8_STAGE(bufoff, gbase, voff) do { _Pragma("unroll") for (int _i = 0; _i < 2; ++_i) \
        __builtin_amdgcn_global_load_lds((const unsigned*)((const char*)(gbase) + (voff)[_i]), (PG8_LAS unsigned*)(lds + (bufoff) + ldsw + _i * 8192), 16, 0, 0); } while (0)
#define PG8_LDA(dst, b, h) do { _Pragma("unroll") for (int m = 0; m < 4; ++m) _Pragma("unroll") for (int k = 0; k < 2; ++k) dst[m][k] = *(const PG8_LAS bf16x8*)(lds + PG8_SA(b, h) + aoff + m * 2048 + k * 1024); } while (0)
#define PG8_LDB(dst, b, h) do { _Pragma("unroll") for (int n = 0; n < 2; ++n) _Pragma("unroll") for (int k = 0; k < 2; ++k) dst[n][k] = *(const PG8_LAS bf16x8*)(lds + PG8_SB(b, h) + boff + n * 2048 + k * 1024); } while (0)
#define PG8_MMA(ai, bj, At, Bt) do { __builtin_amdgcn_s_setprio(1); _Pragma("unroll") for (int m = 0; m < 4; ++m) _Pragma("unroll") for (int n = 0; n < 2; ++n) _Pragma("unroll") for (int k = 0; k < 2; ++k) \
        acc[ai][bj][m][n] = __builtin_amdgcn_mfma_f32_16x16x32_bf16(Bt[n][k], At[m][k], acc[ai][bj][m][n], 0, 0, 0); __builtin_amdgcn_s_setprio(0); } while (0)
#define PG8_WAIT_V(n) asm volatile("s_waitcnt vmcnt(" #n ")" ::: "memory")
#define PG8_WAIT_L(n) asm volatile("s_waitcnt lgkmcnt(" #n ")" ::: "memory")
#define PG8_BAR __builtin_amdgcn_s_barrier()
#define PG8_SCHED __builtin_amdgcn_sched_barrier(0)
    Unit cur, nxt; int ui = 0;
    if (!S.next(0, cur)) return;
    f32x4 acc[2][2][4][2];
#pragma unroll
    for (int a = 0; a < 2; ++a)
#pragma unroll
        for (int b = 0; b < 2; ++b)
#pragma unroll
            for (int m = 0; m < 4; ++m)
#pragma unroll
                for (int n = 0; n < 2; ++n) acc[a][b][m][n] = (f32x4){0.f, 0.f, 0.f, 0.f};
    bf16x8 At[4][2], B0[2][2], B1[2][2];
    const char* cA = S.abase(g, cur, tstep); const char* cB = S.bbase(g, cur, tstep);
    S.a_ready(cur);
    if constexpr (SP2) {
        PG8_STAGE(PG8_SB(0, 0), cB, voffB); PG8_STAGE(PG8_SB(0, 1), cB + hstep, voffB); PG8_STAGE(PG8_SA(0, 0), cA, voffA); PG8_STAGE(PG8_SA(0, 1), cA + hstep, voffA);
        if (wr == 1) PG8_BAR;
        PG8_WAIT_V(2); PG8_BAR;
        PG8_STAGE(PG8_SB(1, 0), cB + kstep, voffB); PG8_STAGE(PG8_SA(1, 0), cA + kstep, voffA); PG8_STAGE(PG8_SB(1, 1), cB + hstep + kstep, voffB);
        PG8_WAIT_V(6); PG8_BAR;
    } else {
        PG8_STAGE(PG8_SB(0, 0), cB, voffB); PG8_STAGE(PG8_SA(0, 0), cA, voffA); PG8_STAGE(PG8_SB(0, 1), cB + hstep, voffB); PG8_STAGE(PG8_SA(0, 1), cA + hstep, voffA);
        if (wr == 1) PG8_BAR;
        PG8_WAIT_V(4); PG8_BAR;
        PG8_STAGE(PG8_SB(1, 0), cB + kstep, voffB); PG8_STAGE(PG8_SA(1, 0), cA + kstep, voffA); PG8_STAGE(PG8_SB(1, 1), cB + hstep + kstep, voffB);
        PG8_WAIT_V(6); PG8_BAR;
    }
    for (;;) {
        const bool has_next = S.next(ui + 1, nxt);
        const char* nA = has_next ? S.abase(g, nxt, tstep) : cA; const char* nB = has_next ? S.bbase(g, nxt, tstep) : cB;
        _Pragma("unroll 1") for (int t = 0; t < nt; t += 2) {
            const bool last = (t == nt - 2);
            const char* a1 = cA + (size_t)(t + 1) * kstep;
            const char* a2 = last ? nA : cA + (size_t)(t + 2) * kstep; const char* b2 = last ? nB : cB + (size_t)(t + 2) * kstep;
            const char* a3 = a2 + kstep; const char* b3 = b2 + kstep;
            if (last && has_next) S.a_ready(nxt);
            if constexpr (SP2) {
            PG8_LDB(B0, 0, 0); PG8_LDB(B1, 0, 1); PG8_SCHED; PG8_LDA(At, 0, 0); PG8_STAGE(PG8_SA(1, 1), a1 + hstep, voffA);
            PG8_WAIT_V(8); PG8_WAIT_L(0); PG8_BAR; PG8_MMA(0, 0, At, B0); PG8_MMA(0, 1, At, B1); PG8_BAR; PG8_SCHED;
            PG8_LDA(At, 0, 1); PG8_STAGE(PG8_SB(0, 0), b2, voffB); PG8_STAGE(PG8_SB(0, 1), b2 + hstep, voffB); PG8_STAGE(PG8_SA(0, 0), a2, voffA);
            PG8_WAIT_V(8); PG8_WAIT_L(0); PG8_BAR; PG8_MMA(1, 0, At, B0); PG8_MMA(1, 1, At, B1); PG8_BAR; PG8_SCHED;
            PG8_LDB(B0, 1, 0); PG8_LDB(B1, 1, 1); PG8_SCHED; PG8_LDA(At, 1, 0); PG8_STAGE(PG8_SA(0, 1), a2 + hstep, voffA);
            PG8_WAIT_V(8); PG8_WAIT_L(0); PG8_BAR; PG8_MMA(0, 0, At, B0); PG8_MMA(0, 1, At, B1); PG8_BAR; PG8_SCHED;
            PG8_LDA(At, 1, 1); PG8_STAGE(PG8_SB(1, 0), b3, voffB); PG8_STAGE(PG8_SB(1, 1), b3 + hstep, voffB); PG8_STAGE(PG8_SA(1, 0), a3, voffA);
            PG8_WAIT_V(8); PG8_WAIT_L(0); PG8_BAR; PG8_MMA(1, 0, At, B0); PG8_MMA(1, 1, At, B1); PG8_BAR; PG8_SCHED;
            } else {
            PG8_LDB(B0, 0, 0); PG8_SCHED; PG8_LDA(At, 0, 0); PG8_STAGE(PG8_SA(1, 1), a1 + hstep, voffA);
            PG8_WAIT_L(8); PG8_BAR; PG8_WAIT_L(0); PG8_MMA(0, 0, At, B0); PG8_BAR; PG8_SCHED;
            PG8_LDB(B1, 0, 1); PG8_STAGE(PG8_SB(0, 0), b2, voffB);
            PG8_BAR; PG8_WAIT_L(0); PG8_MMA(0, 1, At, B1); PG8_BAR;
            PG8_LDA(At, 0, 1); PG8_STAGE(PG8_SA(0, 0), a2, voffA);
            PG8_BAR; PG8_WAIT_L(0); PG8_MMA(1, 0, At, B0); PG8_BAR; PG8_SCHED;
            PG8_STAGE(PG8_SB(0, 1), b2 + hstep, voffB);
            PG8_WAIT_V(6); PG8_BAR; PG8_MMA(1, 1, At, B1); PG8_BAR;
            PG8_LDB(B0, 1, 0); PG8_SCHED; PG8_LDA(At, 1, 0); PG8_STAGE(PG8_SA(0, 1), a2 + hstep, voffA);
            PG8_WAIT_L(8); PG8_BAR; PG8_WAIT_L(0); PG8_MMA(0, 0, At, B0); PG8_BAR; PG8_SCHED;
            PG8_LDB(B1, 1, 1); PG8_STAGE(PG8_SB(1, 0), b3, voffB);
            PG8_BAR; PG8_WAIT_L(0); PG8_MMA(0, 1, At, B1); PG8_BAR;
            PG8_LDA(At, 1, 1); PG8_STAGE(PG8_SA(1, 0), a3, voffA);
            PG8_BAR; PG8_WAIT_L(0); PG8_MMA(1, 0, At, B0); PG8_BAR; PG8_SCHED;
            PG8_STAGE(PG8_SB(1, 1), b3 + hstep, voffB);
            PG8_WAIT_V(6); PG8_BAR; PG8_MMA(1, 1, At, B1); PG8_BAR;
            }
        }
        if constexpr (ALIGN_EPI) { if (wr == 0) PG8_BAR; }
        if constexpr (!Epi::AFTER_DRAIN) { E(acc, cur, wr, wc, fr, fq); S.done(cur); }
        if (!has_next) break;
#pragma unroll
        for (int a = 0; a < 2; ++a)
#pragma unroll
            for (int b = 0; b < 2; ++b)
#pragma unroll
                for (int m = 0; m < 4; ++m)
#pragma unroll
                    for (int n = 0; n < 2; ++n) acc[a][b][m][n] = (f32x4){0.f, 0.f, 0.f, 0.f};
        cur = nxt; cA = nA; cB = nB; ++ui;
        if constexpr (ALIGN_EPI) { if (wr == 1) PG8_BAR; }
    }
    PG8_WAIT_V(0);
    if constexpr (!ALIGN_EPI) { if (wr == 0) PG8_BAR; }
    PG8_BAR;
    if constexpr (Epi::AFTER_DRAIN) { E.fused(acc, cur, wr, wc, fr, fq, lds, wid, lane); S.done(cur); }
#undef PG8_SA
#undef PG8_SB
#undef PG8_STAGE
#undef PG8_LDA
#undef PG8_LDB
#undef PG8_MMA
#undef PG8_WAIT_V
#undef PG8_WAIT_L
#undef PG8_BAR
#undef PG8_SCHED
}
}

constexpr int D = 1024, NBATCH = 2, SEQ = 8192, CTXL = 256;
constexpr int NLAT = NBATCH * SEQ, NCTX = NBATCH * CTXL, NROW = NLAT + NCTX;
constexpr int NE = 32, TOPK = 4, MAXTILES = 296, CAP = MAXTILES * 256;
constexpr int NWAVES = 8, NTHREADS = 512;
constexpr float NORM_EPS = 1e-6f;
constexpr int LDS_BYTES = 147456;

constexpr size_t MiB = 1u << 20;
constexpr size_t WS_CTL = 0, CTL_ZERO_BYTES = 1 * MiB;
constexpr size_t WS_MOD = 1 * MiB;
constexpr size_t WS_ROUTE = 2 * MiB;
constexpr size_t RT_TOPI = 0, RT_TOPG = 320 * 1024, RT_POS = 640 * 1024, RT_SLOT = 960 * 1024, RT_RSTD = 1280 * 1024, RT_TILEE = 1408 * 1024;
constexpr size_t WS_WIN = 4 * MiB, WS_WHGO = 14 * MiB, WS_WRKV = 16 * MiB, WS_WL1 = 22 * MiB, WS_WL2 = 24 * MiB, WS_WRWO = 28 * MiB;
constexpr size_t WS_WGU = 32 * MiB, WS_WD = 288 * MiB;
constexpr size_t WS_XR = 416 * MiB, WS_H = 482 * MiB, WS_H2 = 515 * MiB, WS_A2 = 548 * MiB;
constexpr size_t WS_U = 584 * MiB;
constexpr size_t U_Z = 0, U_OD0 = 166 * MiB;
constexpr size_t U_XL6 = 0, U_RKV = 198 * MiB, U_L1 = 396 * MiB, U_WD = 410 * MiB, U_AD = 542 * MiB, U_G = 674 * MiB, U_OD1 = 740 * MiB;
constexpr size_t U_XB = 0, U_ACT = 148 * MiB, U_YS = 296 * MiB;
constexpr size_t WS_END = WS_U + 938 * MiB;
constexpr int CW_CNT = 64;
constexpr int CW_BAR = 4096;

#define LAS __attribute__((address_space(3)))
typedef unsigned short bf16;
typedef unsigned v4u __attribute__((ext_vector_type(4)));
typedef unsigned v2u __attribute__((ext_vector_type(2)));
typedef float f32x4 __attribute__((ext_vector_type(4)));
#define LDS_WAIT() asm volatile("s_waitcnt lgkmcnt(0)" ::: "memory")
__device__ __forceinline__ unsigned f2bf(float f) { unsigned u = __builtin_bit_cast(unsigned, f); return (u + 0x7fffu + ((u >> 16) & 1u)) >> 16; }
__device__ __forceinline__ unsigned pk2(float lo, float hi) { return f2bf(lo) | (f2bf(hi) << 16); }
__device__ __forceinline__ float bf2f(unsigned b) { return __builtin_bit_cast(float, b << 16); }
__device__ __forceinline__ float wave_sum(float v) {
#pragma unroll
    for (int o = 1; o < 64; o <<= 1) v += __shfl_xor(v, o);
    return v;
}
__device__ __forceinline__ float sigm(float x) { return 1.0f / (1.0f + __expf(-x)); }

struct Params { const float* in[35]; float* out; unsigned char* ws; int ph_lo, ph_hi; };
typedef const __attribute__((address_space(4))) Params* PP;
enum { I_X = 0, I_C, I_CTX, I_CCTX, I_ADAW, I_ADAB, I_NMIX, I_NFFN, I_HGWIN, I_HGGN, I_HGWOUT, I_HGLB, I_MU, I_WRKV, I_DECW0, I_DECW1, I_DECW2,
       I_A0, I_A1, I_A2, I_G1, I_G2, I_KK, I_KA, I_RK, I_LNXW, I_LNXB, I_RWOUT, I_ROUTW, I_ROUTB, I_WGU, I_BGU, I_WDN, I_BDN, I_FINALG };

__device__ __forceinline__ const float* modp(PP p, int l, int v, int j) { return (const float*)(p->ws + WS_MOD) + ((size_t)(l * 3 + v) * 6 + j) * D; }
__device__ __forceinline__ int row_vec(int row) { return row < NLAT ? (row >= SEQ ? 1 : 0) : 2; }

__device__ __forceinline__ void transpose_item(const float* src, int src_ld, bf16* dst, int dst_ld, LAS float* scr, int lane) {
    if (src) {
#pragma unroll 8
        for (int i = 0; i < 32; ++i) { const int kk = 2 * i + (lane >> 5); scr[kk * 33 + (lane & 31)] = src[(size_t)kk * src_ld + (lane & 31)]; }
    }
    LDS_WAIT(); asm volatile("" ::: "memory");
    const int c = lane & 7;
#pragma unroll
    for (int j = 0; j < 4; ++j) {
        const int n = (lane >> 3) + 8 * j; v4u o = (v4u){0u, 0u, 0u, 0u};
        if (src) { const LAS float* s = scr + (8 * c) * 33 + n;
            o.x = pk2(s[0 * 33], s[1 * 33]); o.y = pk2(s[2 * 33], s[3 * 33]); o.z = pk2(s[4 * 33], s[5 * 33]); o.w = pk2(s[6 * 33], s[7 * 33]); }
        *(v4u*)(dst + (size_t)n * dst_ld + 8 * c) = o;
    }
    LDS_WAIT(); asm volatile("" ::: "memory");
}
__device__ __forceinline__ void conv_plain(const float* W, int K, int N, bf16* WT, int r, LAS float* scr, int lane) {
    const int nblk = N / 32, kb = r / nblk, nb = r % nblk;
    transpose_item(W + (size_t)(kb * 64) * N + nb * 32, N, WT + (size_t)(nb * 32) * K + kb * 64, K, scr, lane);
}
constexpr int IT_WIN = 16 * 160, IT_SQ = 16 * 32, IT_L1 = 16 * 24, IT_L2 = 160 * 6, IT_GU = 64 * 16 * 64, IT_DN = 64 * 16 * 32;
constexpr int IT_TOTAL = IT_WIN + IT_SQ + 3 * IT_SQ + IT_SQ + IT_L1 + IT_L2 + IT_GU + IT_DN;
__device__ __forceinline__ void convert_item(PP p, int it, LAS float* scr, int lane) {
    unsigned char* ws = p->ws; int r = it;
    if (r < IT_WIN) { conv_plain(p->in[I_HGWIN], D, 5120, (bf16*)(ws + WS_WIN), r, scr, lane); return; } r -= IT_WIN;
    if (r < IT_SQ) { conv_plain(p->in[I_HGWOUT], D, D, (bf16*)(ws + WS_WHGO), r, scr, lane); return; } r -= IT_SQ;
    if (r < 3 * IT_SQ) { const int j = r / IT_SQ; conv_plain(p->in[I_WRKV] + (size_t)j * D * D, D, D, (bf16*)(ws + WS_WRKV) + (size_t)j * D * D, r % IT_SQ, scr, lane); return; } r -= 3 * IT_SQ;
    if (r < IT_SQ) { conv_plain(p->in[I_RWOUT], D, D, (bf16*)(ws + WS_WRWO), r, scr, lane); return; } r -= IT_SQ;
    if (r < IT_L1) {
        const int kb = r / 24, rg = r % 24, tile = rg >> 3, within = rg & 7; const float* src = nullptr; int ld = 64;
        if (within < 4) {
            if (tile == 0) src = p->in[I_DECW1] + (size_t)(within >> 1) * D * 64 + (size_t)(kb * 64) * 64 + (within & 1) * 32;
            else if (tile == 1) src = p->in[I_A1] + (size_t)(within >> 1) * D * 64 + (size_t)(kb * 64) * 64 + (within & 1) * 32;
            else { src = p->in[I_G1] + (size_t)(kb * 64) * 128 + within * 32; ld = 128; }
        }
        transpose_item(src, ld, (bf16*)(ws + WS_WL1) + (size_t)(rg * 32) * D + kb * 64, D, scr, lane); return; } r -= IT_L1;
    if (r < IT_L2) {
        const int rg = r / 6, kb = r % 6, n0 = rg * 32, blk = n0 >> 10, nn0 = n0 & 1023; const float* src = nullptr;
        if (blk < 2) { if (kb == blk) src = p->in[I_DECW2] + (size_t)blk * 64 * D + nn0; }
        else if (blk < 4) { if (kb == blk) src = p->in[I_A2] + (size_t)(blk - 2) * 64 * D + nn0; }
        else { if (kb >= 4) src = p->in[I_G2] + (size_t)(kb - 4) * 64 * D + nn0; }
        transpose_item(src, D, (bf16*)(ws + WS_WL2) + (size_t)n0 * 384 + kb * 64, 384, scr, lane); return; } r -= IT_L2;
    if (r < IT_GU) {
        const int mat = r >> 10, q = r & 1023, kb = q >> 6, nb = q & 63, n0 = nb * 32;
        const int j0 = n0 & 1023, drow = 256 * (j0 >> 7) + (n0 >= 1024 ? 128 : 0) + (j0 & 127);
        transpose_item(p->in[I_WGU] + (size_t)mat * D * 2048 + (size_t)(kb * 64) * 2048 + n0, 2048, (bf16*)(ws + WS_WGU) + (size_t)mat * 2048 * D + (size_t)drow * D + kb * 64, D, scr, lane); return; } r -= IT_GU;
    { const int mat = r >> 9, q = r & 511;
      conv_plain(p->in[I_WDN] + (size_t)mat * D * D, D, D, (bf16*)(ws + WS_WD) + (size_t)mat * D * D, q, scr, lane); }
}
__device__ __forceinline__ void phase_pre(PP p, LAS unsigned char* lds, int tid, int lane, int wave) {
    if (blockIdx.x < 192) {
        const int layer = blockIdx.x / 96, col = (blockIdx.x % 96) * 64 + lane;
        const float* W = p->in[I_ADAW] + (size_t)layer * D * 6144 + col;
        const float* c = p->in[I_C]; const float* cc = p->in[I_CCTX];
        float a0 = 0.f, a1 = 0.f, a2 = 0.f;
#pragma unroll 8
        for (int k = wave * 128; k < wave * 128 + 128; ++k) {
            const float wv = W[(size_t)k * 6144]; const float c0 = c[k], c1 = c[D + k], c2 = cc[k];
            a0 += c0 * sigm(c0) * wv; a1 += c1 * sigm(c1) * wv; a2 += c2 * sigm(c2) * wv;
        }
        LAS float* red = (LAS float*)lds;
        red[(wave * 3 + 0) * 64 + lane] = a0; red[(wave * 3 + 1) * 64 + lane] = a1; red[(wave * 3 + 2) * 64 + lane] = a2;
        __syncthreads();
        if (wave == 0) {
            float s0 = 0.f, s1 = 0.f, s2 = 0.f;
#pragma unroll
            for (int w = 0; w < 8; ++w) { s0 += red[(w * 3 + 0) * 64 + lane]; s1 += red[(w * 3 + 1) * 64 + lane]; s2 += red[(w * 3 + 2) * 64 + lane]; }
            const float bb = p->in[I_ADAB][layer * 6144 + col];
            float* M = (float*)(p->ws + WS_MOD) + (size_t)layer * 3 * 6144 + col;
            M[0] = s0 + bb; M[6144] = s1 + bb; M[2 * 6144] = s2 + bb;
        }
        __syncthreads();
    }
    LAS float* scr = (LAS float*)(lds + wave * 16384);
    const int gw = blockIdx.x * NWAVES + wave, NGW = gridDim.x * NWAVES;
    for (int it = gw; it < IT_TOTAL; it += NGW) convert_item(p, it, scr, lane);
}

__device__ __forceinline__ void load_row(const float* row, int lane, f32x4 (&v)[4]) {
#pragma unroll
    for (int j = 0; j < 4; ++j) v[j] = ((const f32x4*)row)[lane + 64 * j];
}
__device__ __forceinline__ float row_rstd(const f32x4 (&v)[4]) {
    float s = 0.f;
#pragma unroll
    for (int j = 0; j < 4; ++j) s += (v[j].x * v[j].x + v[j].y * v[j].y) + (v[j].z * v[j].z + v[j].w * v[j].w);
    return rsqrtf(wave_sum(s) * (1.0f / D) + NORM_EPS);
}
__device__ __forceinline__ void norm_mod(const f32x4 (&v)[4], float rstd, const float* g, const float* shift, const float* scale, int lane, f32x4 (&h)[4]) {
#pragma unroll
    for (int j = 0; j < 4; ++j) {
        const f32x4 gg = ((const f32x4*)g)[lane + 64 * j], sh = ((const f32x4*)shift)[lane + 64 * j], sc = ((const f32x4*)scale)[lane + 64 * j];
        h[j] = v[j] * rstd * gg * (sc + 1.0f) + sh;
    }
}
__device__ __forceinline__ void store_row_bf16(bf16* row, int lane, const f32x4 (&h)[4]) {
#pragma unroll
    for (int j = 0; j < 4; ++j) { v2u w; w.x = pk2(h[j].x, h[j].y); w.y = pk2(h[j].z, h[j].w); ((v2u*)row)[lane + 64 * j] = w; }
}
__device__ __forceinline__ const float* resid_row(PP p, int layer0_inputs, int row) {
    if (layer0_inputs) return row < NLAT ? p->in[I_X] + (size_t)row * D : p->in[I_CTX] + (size_t)(row - NLAT) * D;
    return (const float*)(p->ws + WS_XR) + (size_t)row * D;
}
__device__ __forceinline__ void phase_norm0(PP p, int lane, int wave) {
    const int gw = blockIdx.x * NWAVES + wave, NGW = gridDim.x * NWAVES;
    for (int row = gw; row < NROW; row += NGW) {
        f32x4 v[4], h[4]; load_row(resid_row(p, 1, row), lane, v);
        const float rstd = row_rstd(v); const int vec = row_vec(row);
        norm_mod(v, rstd, p->in[I_NMIX], modp(p, 0, vec, 0), modp(p, 0, vec, 1), lane, h);
        store_row_bf16((bf16*)(p->ws + WS_H) + (size_t)row * D, lane, h);
    }
}
__device__ __forceinline__ void phase_ffn_norm_route(PP p, int layer, int nrows, int lane, int wave) {
    const int gw = blockIdx.x * NWAVES + wave, NGW = gridDim.x * NWAVES;
    const float* rw = p->in[I_ROUTW] + (size_t)layer * D * NE; const float* rb = p->in[I_ROUTB] + layer * NE;
    int* TOPI = (int*)(p->ws + WS_ROUTE + RT_TOPI); float* TOPG = (float*)(p->ws + WS_ROUTE + RT_TOPG); int* POS = (int*)(p->ws + WS_ROUTE + RT_POS);
    unsigned* cnt = (unsigned*)(p->ws + WS_CTL) + CW_CNT + layer * NE;
    for (int row = gw; row < nrows; row += NGW) {
        f32x4 v[4], h[4]; load_row((const float*)(p->ws + WS_XR) + (size_t)row * D, lane, v);
        const float rstd = row_rstd(v); const int vec = row_vec(row);
        norm_mod(v, rstd, p->in[I_NFFN] + layer * D, modp(p, layer, vec, 3), modp(p, layer, vec, 4), lane, h);
        store_row_bf16((bf16*)(p->ws + WS_H2) + (size_t)row * D, lane, h);
        float part[NE];
#pragma unroll
        for (int e = 0; e < NE; ++e) part[e] = 0.f;
#pragma unroll
        for (int j = 0; j < 4; ++j)
#pragma unroll
            for (int i = 0; i < 4; ++i) {
                const float hv = h[j][i]; const f32x4* wr = (const f32x4*)(rw + (size_t)(4 * lane + 256 * j + i) * NE);
#pragma unroll
                for (int q = 0; q < 8; ++q) { const f32x4 w4 = wr[q]; part[4 * q + 0] += hv * w4.x; part[4 * q + 1] += hv * w4.y; part[4 * q + 2] += hv * w4.z; part[4 * q + 3] += hv * w4.w; }
            }
#pragma unroll
        for (int e = 0; e < NE; ++e) part[e] = wave_sum(part[e]) + rb[e];
        unsigned taken = 0u; int idx[TOPK]; float val[TOPK];
#pragma unroll
        for (int k = 0; k < TOPK; ++k) {
            float best = -3.0e38f; int bi = 0;
#pragma unroll
            for (int e = 0; e < NE; ++e) { const bool ok = !((taken >> e) & 1u) && (part[e] > best); best = ok ? part[e] : best; bi = ok ? e : bi; }
            taken |= 1u << bi; idx[k] = bi; val[k] = best;
        }
        float ex[TOPK], se = 0.f;
#pragma unroll
        for (int k = 0; k < TOPK; ++k) { ex[k] = __expf(val[k] - val[0]); se += ex[k]; }
        if (lane == 0) {
#pragma unroll
            for (int k = 0; k < TOPK; ++k) {
                TOPI[row * 4 + k] = idx[k]; TOPG[row * 4 + k] = ex[k] / se;
                POS[row * 4 + k] = (int)atomicAdd(cnt + idx[k], 1u);
            }
        }
    }
}
__device__ __forceinline__ void phase_gather(PP p, int layer, int nrows, LAS unsigned char* lds, int tid, int lane, int wave) {
    LAS int* off = (LAS int*)lds;
    const unsigned* cnt = (const unsigned*)(p->ws + WS_CTL) + CW_CNT + layer * NE;
    int* TILEE = (int*)(p->ws + WS_ROUTE + RT_TILEE);
    if (tid == 0) {
        int o = 0;
        for (int e = 0; e < NE; ++e) { off[e] = o; const int nt = ((int)__hip_atomic_load(cnt + e, __ATOMIC_RELAXED, __HIP_MEMORY_SCOPE_AGENT) + 255) >> 8;
            if (blockIdx.x == 0) for (int t = 0; t < nt; ++t) TILEE[1 + (o >> 8) + t] = e;
            o += nt << 8; }
        off[NE] = o; if (blockIdx.x == 0) TILEE[0] = o >> 8;
    }
    __syncthreads();
    const int* TOPI = (const int*)(p->ws + WS_ROUTE + RT_TOPI); const int* POS = (const int*)(p->ws + WS_ROUTE + RT_POS); int* SLOT = (int*)(p->ws + WS_ROUTE + RT_SLOT);
    const bf16* H2 = (const bf16*)(p->ws + WS_H2); bf16* XB = (bf16*)(p->ws + WS_U + U_XB);
    const int gw = blockIdx.x * NWAVES + wave, NGW = gridDim.x * NWAVES;
    for (int it = gw; it < nrows * TOPK; it += NGW) {
        const int row = it >> 2; const int slot = off[TOPI[it]] + POS[it];
        if (lane == 0) SLOT[it] = slot;
        const v4u* s = (const v4u*)(H2 + (size_t)row * D); v4u* d = (v4u*)(XB + (size_t)slot * D);
        d[lane] = s[lane]; d[lane + 64] = s[lane + 64];
    }
    __syncthreads();
}
__device__ __forceinline__ void phase_combine(PP p, int layer, int nrows, bool final_out, int lane, int wave) {
    const int gw = blockIdx.x * NWAVES + wave, NGW = gridDim.x * NWAVES;
    const float* TOPG = (const float*)(p->ws + WS_ROUTE + RT_TOPG); const int* SLOT = (const int*)(p->ws + WS_ROUTE + RT_SLOT);
    const bf16* YS = (const bf16*)(p->ws + WS_U + U_YS); float* XR = (float*)(p->ws + WS_XR); float* RSTD = (float*)(p->ws + WS_ROUTE + RT_RSTD);
    for (int row = gw; row < nrows; row += NGW) {
        f32x4 v[4], acc[4]; load_row(XR + (size_t)row * D, lane, v);
#pragma unroll
        for (int j = 0; j < 4; ++j) acc[j] = (f32x4){0.f, 0.f, 0.f, 0.f};
#pragma unroll
        for (int k = 0; k < TOPK; ++k) {
            const float gk = TOPG[row * 4 + k]; const v2u* ys = (const v2u*)(YS + (size_t)SLOT[row * 4 + k] * D);
#pragma unroll
            for (int j = 0; j < 4; ++j) { const v2u w = ys[lane + 64 * j];
                acc[j].x += gk * bf2f(w.x & 0xffffu); acc[j].y += gk * bf2f(w.x >> 16); acc[j].z += gk * bf2f(w.y & 0xffffu); acc[j].w += gk * bf2f(w.y >> 16); }
        }
        const float* m5 = modp(p, layer, row_vec(row), 5);
#pragma unroll
        for (int j = 0; j < 4; ++j) v[j] = v[j] + ((const f32x4*)m5)[lane + 64 * j] * acc[j];
        const float rstd = row_rstd(v);
        if (final_out) {
#pragma unroll
            for (int j = 0; j < 4; ++j) ((f32x4*)(p->out + (size_t)row * D))[lane + 64 * j] = v[j] * rstd * ((const f32x4*)p->in[I_FINALG])[lane + 64 * j];
        } else {
#pragma unroll
            for (int j = 0; j < 4; ++j) ((f32x4*)(XR + (size_t)row * D))[lane + 64 * j] = v[j];
            if (lane == 0) RSTD[row] = rstd;
        }
    }
}

__device__ __forceinline__ int step_row(int b, int dir, int step) {
    if (step < CTXL) { const int t = dir ? (CTXL - 1 - step) : step; return NLAT + b * CTXL + t; }
    const int s = step - CTXL; const int t = dir ? (SEQ - 1 - s) : s; return b * SEQ + t;
}
constexpr int NSTEP = CTXL + SEQ;

__device__ __forceinline__ void phase_gla_naive(PP p, LAS unsigned char* lds, int tid) {
    if (blockIdx.x >= 8) return;
    const int ci = tid >> 7, v = tid & 127, chain = blockIdx.x * 4 + ci, b = chain >> 4, dir = (chain >> 3) & 1, h = chain & 7;
    const bf16* Z = (const bf16*)(p->ws + WS_U + U_Z); float* OD = (float*)(p->ws + WS_U + U_OD0) + (size_t)dir * NROW * D;
    float lbv; { const float* lb = p->in[I_HGLB] + (size_t)dir * 3 * D + h * 128 + v; const float a0 = lb[0], a1 = lb[D], a2 = lb[2 * D];
                 const float m = fmaxf(a0, fmaxf(a1, a2)); const float e0 = __expf(a0 - m), e1 = __expf(a1 - m), e2 = __expf(a2 - m); lbv = e0 / (e0 + e1 + e2); }
    LAS float* LF = (LAS float*)lds;
    LAS float* LQ = (LAS float*)(lds + 4096);
    float S[128];
#pragma unroll
    for (int k = 0; k < 128; ++k) S[k] = 0.f;
    int row = step_row(b, dir, 0);
    unsigned zf = Z[(size_t)row * 5120 + 1024 * (1 + dir) + h * 128 + v], zq = Z[(size_t)row * 5120 + h * 128 + v], zv = Z[(size_t)row * 5120 + 3072 + h * 128 + v];
    for (int step = 0; step < NSTEP; ++step) {
        const float fh = bf2f(zf), qv = bf2f(zq), vv = bf2f(zv); const int crow = row;
        if (step + 1 < NSTEP) { row = step_row(b, dir, step + 1);
            zf = Z[(size_t)row * 5120 + 1024 * (1 + dir) + h * 128 + v]; zq = Z[(size_t)row * 5120 + h * 128 + v]; zv = Z[(size_t)row * 5120 + 3072 + h * 128 + v]; }
        const int buf = step & 1;
        LF[(buf * 4 + ci) * 128 + v] = lbv + (1.f - lbv) * sigm(fh); LQ[(buf * 4 + ci) * 128 + v] = qv * sigm(qv);
        __syncthreads();
        const LAS f32x4* f4 = (const LAS f32x4*)(LF + (buf * 4 + ci) * 128); const LAS f32x4* q4 = (const LAS f32x4*)(LQ + (buf * 4 + ci) * 128);
        float o0 = 0.f, o1 = 0.f;
#pragma unroll
        for (int k4 = 0; k4 < 32; ++k4) { const f32x4 f = f4[k4], q = q4[k4];
            S[4 * k4 + 0] = vv + f.x * (S[4 * k4 + 0] - vv); o0 += q.x * S[4 * k4 + 0];
            S[4 * k4 + 1] = vv + f.y * (S[4 * k4 + 1] - vv); o1 += q.y * S[4 * k4 + 1];
            S[4 * k4 + 2] = vv + f.z * (S[4 * k4 + 2] - vv); o0 += q.z * S[4 * k4 + 2];
            S[4 * k4 + 3] = vv + f.w * (S[4 * k4 + 3] - vv); o1 += q.w * S[4 * k4 + 3]; if ((k4 & 3) == 3) asm volatile("" ::: "memory"); }
        OD[(size_t)crow * D + h * 128 + v] = o0 + o1;
    }
}
__device__ __forceinline__ void phase_hg_readout(PP p, int lane, int wave) {
    const int gw = blockIdx.x * NWAVES + wave, NGW = gridDim.x * NWAVES;
    const bf16* Z = (const bf16*)(p->ws + WS_U + U_Z); const float* OD = (const float*)(p->ws + WS_U + U_OD0); bf16* A2 = (bf16*)(p->ws + WS_A2);
    const float* gn = p->in[I_HGGN];
    for (int row = gw; row < NROW; row += NGW) {
#pragma unroll
        for (int h = 0; h < 8; ++h) {
            const int c = h * 128 + 2 * lane;
            const float2 a = *(const float2*)(OD + (size_t)row * D + c), bq = *(const float2*)(OD + (size_t)(NROW + row) * D + c);
            const float o0 = a.x + bq.x, o1 = a.y + bq.y;
            const float rstd = rsqrtf(wave_sum(o0 * o0 + o1 * o1) * (1.0f / 128.0f) + NORM_EPS);
            const unsigned gz = *(const unsigned*)(Z + (size_t)row * 5120 + 4096 + c); const float g0 = bf2f(gz & 0xffffu), g1 = bf2f(gz >> 16);
            const float r0 = o0 * rstd * gn[2 * lane] * (g0 * sigm(g0)), r1 = o1 * rstd * gn[2 * lane + 1] * (g1 * sigm(g1));
            *(unsigned*)(A2 + (size_t)row * D + c) = pk2(r0, r1);
        }
    }
}

__device__ __forceinline__ void phase_lerp(PP p, int lane, int wave) {
    const int gw = blockIdx.x * NWAVES + wave, NGW = gridDim.x * NWAVES;
    const float* XR = (const float*)(p->ws + WS_XR); const float* RSTD = (const float*)(p->ws + WS_ROUTE + RT_RSTD);
    bf16* XL6 = (bf16*)(p->ws + WS_U + U_XL6); const float* g = p->in[I_NMIX] + D; const float* mu = p->in[I_MU];
    for (int row = gw; row < NROW; row += NGW) {
        const int vec = row_vec(row); const float* sh = modp(p, 1, vec, 0); const float* sc = modp(p, 1, vec, 1);
        int nb[4];
        if (row < NLAT) { const int t = row & (SEQ - 1), w = t & 63, r = t >> 6;
            nb[0] = (w >= 1) ? row - 1 : -1; nb[1] = (w < 63) ? row + 1 : -1; nb[2] = (r >= 1) ? row - 64 : -1; nb[3] = (r < SEQ / 64 - 1) ? row + 64 : -1;
        } else { const int t = (row - NLAT) & (CTXL - 1);
            nb[0] = nb[1] = (t >= 1) ? row - 1 : -1; nb[2] = nb[3] = (t < CTXL - 1) ? row + 1 : -1; }
        const float rs = RSTD[row];
#pragma unroll
        for (int j = 0; j < 4; ++j) {
            const int ci = lane + 64 * j;
            const f32x4 gg = ((const f32x4*)g)[ci], s1 = ((const f32x4*)sc)[ci] + 1.0f, s0 = ((const f32x4*)sh)[ci];
            const f32x4 xs = ((const f32x4*)(XR + (size_t)row * D))[ci];
            const f32x4 hs = xs * rs * gg * s1 + s0;
            f32x4 hn = (f32x4){0.f, 0.f, 0.f, 0.f};
            if (nb[j] >= 0) { const f32x4 xn = ((const f32x4*)(XR + (size_t)nb[j] * D))[ci]; hn = xn * RSTD[nb[j]] * gg * s1 + s0; }
            const f32x4 dx = hn - hs;
#pragma unroll
            for (int s = 0; s < 6; ++s) {
                const int m = (s == 0) ? 0 : (s == 1) ? 2 : (s == 2) ? 3 : (s == 3) ? 1 : (s == 4) ? 4 : 5;
                const f32x4 o = hs + dx * ((const f32x4*)(mu + m * D))[ci];
                v2u w; w.x = pk2(o.x, o.y); w.y = pk2(o.z, o.w);
                ((v2u*)(XL6 + ((size_t)s * NROW + row) * D))[ci] = w;
            }
        }
    }
}
__device__ __forceinline__ void phase_rwkv_naive(PP p, LAS unsigned char* lds, int lane, int wave) {
    if (blockIdx.x >= 8) return;
    const int chain = blockIdx.x * 8 + wave, b = chain >> 5, dir = (chain >> 4) & 1, h = chain & 15, ch = h * 64 + lane;
    const float* RKV = (const float*)(p->ws + WS_U + U_RKV);
    const float* WDp = (const float*)(p->ws + WS_U + U_WD) + (size_t)dir * NROW * D; const float* ADp = (const float*)(p->ws + WS_U + U_AD) + (size_t)dir * NROW * D;
    float* OD = (float*)(p->ws + WS_U + U_OD1) + (size_t)dir * NROW * D;
    const float kkw = p->in[I_KK][ch], kaw = p->in[I_KA][ch];
    LAS float* L = (LAS float*)lds;
    float S[64];
#pragma unroll
    for (int j = 0; j < 64; ++j) S[j] = 0.f;
    for (int step = 0; step < NSTEP; ++step) {
        const int row = step_row(b, dir, step);
        const float rx = RKV[(size_t)row * 3072 + ch], kx = RKV[(size_t)row * 3072 + 1024 + ch], vx = RKV[(size_t)row * 3072 + 2048 + ch];
        const float wv = WDp[(size_t)row * D + ch], av = ADp[(size_t)row * D + ch];
        float kkx = kx * kkw; const float nrm = sqrtf(wave_sum(kkx * kkx)); kkx = kkx / fmaxf(nrm, 1e-12f);
        LAS float* B = L + ((step & 1) * 8 + wave) * 320;
        B[lane] = wv; B[64 + lane] = kkx; B[128 + lane] = kkx * av; B[192 + lane] = kx * (1.f + (av - 1.f) * kaw); B[256 + lane] = rx;
        __syncthreads();
        const LAS f32x4* W4 = (const LAS f32x4*)B; const LAS f32x4* K4 = (const LAS f32x4*)(B + 64); const LAS f32x4* B4 = (const LAS f32x4*)(B + 128);
        const LAS f32x4* D4 = (const LAS f32x4*)(B + 192); const LAS f32x4* R4 = (const LAS f32x4*)(B + 256);
        float sa0 = 0.f, sa1 = 0.f;
#pragma unroll
        for (int q = 0; q < 16; ++q) { const f32x4 kk = K4[q]; sa0 += S[4 * q] * kk.x + S[4 * q + 2] * kk.z; sa1 += S[4 * q + 1] * kk.y + S[4 * q + 3] * kk.w; if ((q & 3) == 3) asm volatile("" ::: "memory"); }
        const float sa = sa0 + sa1;
        float y0 = 0.f, y1 = 0.f;
#pragma unroll
        for (int q = 0; q < 16; ++q) { const f32x4 w = W4[q], bt = B4[q], kd = D4[q], r = R4[q];
            S[4 * q + 0] = S[4 * q + 0] * w.x - sa * bt.x + vx * kd.x; y0 += S[4 * q + 0] * r.x;
            S[4 * q + 1] = S[4 * q + 1] * w.y - sa * bt.y + vx * kd.y; y1 += S[4 * q + 1] * r.y;
            S[4 * q + 2] = S[4 * q + 2] * w.z - sa * bt.z + vx * kd.z; y0 += S[4 * q + 2] * r.z;
            S[4 * q + 3] = S[4 * q + 3] * w.w - sa * bt.w + vx * kd.w; y1 += S[4 * q + 3] * r.w; if (q & 1) asm volatile("" ::: "memory"); }
        OD[(size_t)row * D + ch] = y0 + y1;
    }
}
__device__ __forceinline__ void phase_rw_readout(PP p, int lane, int wave) {
    const int gw = blockIdx.x * NWAVES + wave, NGW = gridDim.x * NWAVES;
    const float* RKV = (const float*)(p->ws + WS_U + U_RKV); const float* AD = (const float*)(p->ws + WS_U + U_AD); const float* G = (const float*)(p->ws + WS_U + U_G);
    const float* OD = (const float*)(p->ws + WS_U + U_OD1); bf16* A2 = (bf16*)(p->ws + WS_A2);
    for (int row = gw; row < NLAT; row += NGW) {
#pragma unroll 4
        for (int h = 0; h < 16; ++h) {
            const int ch = h * 64 + lane;
            const float y = OD[(size_t)row * D + ch] + OD[(size_t)(NROW + row) * D + ch];
            const float mean = wave_sum(y) * (1.0f / 64.0f); const float d = y - mean; const float var = wave_sum(d * d) * (1.0f / 64.0f);
            float yn = d * rsqrtf(var + 64.0e-5f) * p->in[I_LNXW][ch] + p->in[I_LNXB][ch];
            const float r = RKV[(size_t)row * 3072 + ch], k = RKV[(size_t)row * 3072 + 1024 + ch], v = RKV[(size_t)row * 3072 + 2048 + ch];
            const float ka = p->in[I_KA][ch], rk = p->in[I_RK][ch];
#pragma unroll
            for (int dd = 0; dd < 2; ++dd) { const float a = AD[((size_t)dd * NROW + row) * D + ch]; const float kd = k * (1.f + (a - 1.f) * ka);
                yn += wave_sum(r * kd * rk) * v; }
            const float o = yn * G[(size_t)row * D + ch];
            const float o1 = __shfl_down(o, 1);
            if (!(lane & 1)) *(unsigned*)(A2 + (size_t)row * D + ch) = pk2(o, o1);
        }
    }
}

namespace pg8 {
struct SelOrder : StaticOrder {
    int div, sel0; size_t stride;
    __device__ __forceinline__ const char* abase(const Gemm& g, const Unit& u, size_t tstep) const { return (const char*)g.A + (size_t)(sel0 + u.pn / div) * stride + (size_t)u.pm * tstep; }
};
struct MoeOrder {
    const int* tilee; int nt, ntn, G, c; size_t estride;
    __device__ __forceinline__ void init(const int* te, int ntn_, size_t es, int G_, int c_) { tilee = te; nt = te[0]; ntn = ntn_; estride = es; G = G_; c = c_; }
    __device__ __forceinline__ bool next(int i, Unit& u) const { const long L = (long)i * G + c; if (L >= (long)nt * ntn) return false; u.pn = (int)(L / nt); u.pm = (int)(L % nt); u.e = tilee[1 + u.pm]; return true; }
    __device__ __forceinline__ const char* abase(const Gemm& g, const Unit& u, size_t tstep) const { return (const char*)g.A + (size_t)u.pm * tstep; }
    __device__ __forceinline__ const char* bbase(const Gemm& g, const Unit& u, size_t tstep) const { return (const char*)g.Bt + (size_t)u.e * estride + (size_t)u.pn * tstep; }
    __device__ __forceinline__ void a_ready(const Unit&) const {}
    __device__ __forceinline__ void done(const Unit&) const {}
};
struct EpiStoreBf16 {
    static constexpr bool PERM = true, AFTER_DRAIN = false;
    bf16_t* O; int ldc;
    __device__ __forceinline__ void operator()(const f32x4 (&acc)[2][2][4][2], const Unit& u, int wr, int wc, int fr, int fq) const {
        const int row0 = u.pm * BM + wr * 64 + fr, col0 = u.pn * BM + wc * 32 + 8 * fq;
#pragma unroll
        for (int ai = 0; ai < 2; ++ai)
#pragma unroll
            for (int m = 0; m < 4; ++m) { bf16_t* rowp = O + (size_t)(row0 + ai * HALF + m * 16) * ldc + col0;
#pragma unroll
                for (int bj = 0; bj < 2; ++bj) { const f32x4 v0 = acc[ai][bj][m][0], v1 = acc[ai][bj][m][1];
                    u32x4 w; w.x = cvt_pk_bf16(v0[0], v0[1]); w.y = cvt_pk_bf16(v0[2], v0[3]); w.z = cvt_pk_bf16(v1[0], v1[1]); w.w = cvt_pk_bf16(v1[2], v1[3]);
                    *(u32x4*)(rowp + bj * HALF) = w; } }
    }
};
struct EpiStoreF32 {
    static constexpr bool PERM = false, AFTER_DRAIN = false;
    float* C; int ldc;
    __device__ __forceinline__ void operator()(const f32x4 (&acc)[2][2][4][2], const Unit& u, int wr, int wc, int fr, int fq) const {
        const int row0 = u.pm * BM + wr * 64 + fr, col0 = u.pn * BM + wc * 32 + 4 * fq;
#pragma unroll
        for (int ai = 0; ai < 2; ++ai)
#pragma unroll
            for (int m = 0; m < 4; ++m) { float* rowp = C + (size_t)(row0 + ai * HALF + m * 16) * ldc + col0;
#pragma unroll
                for (int bj = 0; bj < 2; ++bj)
#pragma unroll
                    for (int n = 0; n < 2; ++n) *(f32x4*)(rowp + bj * HALF + n * 16) = acc[ai][bj][m][n]; }
    }
};
struct EpiResid {
    static constexpr bool PERM = false, AFTER_DRAIN = false;
    const float* base_lat; const float* base_ctx; float* out; const float* gate; int gstride;
    __device__ __forceinline__ void operator()(const f32x4 (&acc)[2][2][4][2], const Unit& u, int wr, int wc, int fr, int fq) const {
        const int row0 = u.pm * BM + wr * 64 + fr, col0 = u.pn * BM + wc * 32 + 4 * fq;
#pragma unroll
        for (int ai = 0; ai < 2; ++ai)
#pragma unroll
            for (int m = 0; m < 4; ++m) { const int row = row0 + ai * HALF + m * 16;
                const float* bp = (row < 16384) ? base_lat + (size_t)row * 1024 : base_ctx + (size_t)(row - 16384) * 1024;
                const float* gp = gate + (size_t)(row < 16384 ? (row >= 8192 ? 1 : 0) : 2) * gstride;
                float* op = out + (size_t)row * 1024;
#pragma unroll
                for (int bj = 0; bj < 2; ++bj)
#pragma unroll
                    for (int n = 0; n < 2; ++n) { const int c = col0 + bj * HALF + n * 16;
                        *(f32x4*)(op + c) = *(const f32x4*)(bp + c) + *(const f32x4*)(gp + c) * acc[ai][bj][m][n]; } }
    }
};
__device__ __forceinline__ float sigm_(float x) { return 1.0f / (1.0f + __expf(-x)); }
struct EpiSwiglu {
    static constexpr bool PERM = true, AFTER_DRAIN = false;
    bf16_t* O; const float* bgu;
    __device__ __forceinline__ void operator()(const f32x4 (&acc)[2][2][4][2], const Unit& u, int wr, int wc, int fr, int fq) const {
        const int row0 = u.pm * BM + wr * 64 + fr, col0 = u.pn * HALF + wc * 32 + 8 * fq;
        const float* bg = bgu + (size_t)u.e * 2048 + col0; f32x4 bgv[2], buv[2];
#pragma unroll
        for (int n = 0; n < 2; ++n) { bgv[n] = *(const f32x4*)(bg + 4 * n); buv[n] = *(const f32x4*)(bg + 1024 + 4 * n); }
#pragma unroll
        for (int ai = 0; ai < 2; ++ai)
#pragma unroll
            for (int m = 0; m < 4; ++m) { float r[8];
#pragma unroll
                for (int n = 0; n < 2; ++n) { const f32x4 g4 = acc[ai][0][m][n] + bgv[n], u4 = acc[ai][1][m][n] + buv[n];
#pragma unroll
                    for (int j = 0; j < 4; ++j) { const float g = fminf(g4[j], 7.0f), uu = fminf(fmaxf(u4[j], -7.0f), 7.0f); r[4 * n + j] = g * sigm_(1.702f * g) * (uu + 1.0f); } }
                u32x4 w; w.x = cvt_pk_bf16(r[0], r[1]); w.y = cvt_pk_bf16(r[2], r[3]); w.z = cvt_pk_bf16(r[4], r[5]); w.w = cvt_pk_bf16(r[6], r[7]);
                *(u32x4*)(O + (size_t)(row0 + ai * HALF + m * 16) * 1024 + col0) = w; }
    }
};
struct EpiDown {
    static constexpr bool PERM = true, AFTER_DRAIN = false;
    bf16_t* O; const float* bdn;
    __device__ __forceinline__ void operator()(const f32x4 (&acc)[2][2][4][2], const Unit& u, int wr, int wc, int fr, int fq) const {
        const int row0 = u.pm * BM + wr * 64 + fr, col0 = u.pn * BM + wc * 32 + 8 * fq;
        const float* bp = bdn + (size_t)u.e * 1024 + col0; f32x4 bv[2][2];
#pragma unroll
        for (int bj = 0; bj < 2; ++bj)
#pragma unroll
            for (int n = 0; n < 2; ++n) bv[bj][n] = *(const f32x4*)(bp + bj * HALF + 4 * n);
#pragma unroll
        for (int ai = 0; ai < 2; ++ai)
#pragma unroll
            for (int m = 0; m < 4; ++m) { bf16_t* rowp = O + (size_t)(row0 + ai * HALF + m * 16) * 1024 + col0;
#pragma unroll
                for (int bj = 0; bj < 2; ++bj) { const f32x4 v0 = acc[ai][bj][m][0] + bv[bj][0], v1 = acc[ai][bj][m][1] + bv[bj][1];
                    u32x4 w; w.x = cvt_pk_bf16(v0[0], v0[1]); w.y = cvt_pk_bf16(v0[2], v0[3]); w.z = cvt_pk_bf16(v1[0], v1[1]); w.w = cvt_pk_bf16(v1[2], v1[3]);
                    *(u32x4*)(rowp + bj * HALF) = w; } }
    }
};
struct EpiLora1 {
    static constexpr bool PERM = true, AFTER_DRAIN = false;
    bf16_t* O;
    __device__ __forceinline__ void operator()(const f32x4 (&acc)[2][2][4][2], const Unit& u, int wr, int wc, int fr, int fq) const {
        const int row0 = u.pm * BM + wr * 64 + fr, col0 = u.pn * HALF + wc * 32 + 8 * fq;
#pragma unroll
        for (int ai = 0; ai < 2; ++ai)
#pragma unroll
            for (int m = 0; m < 4; ++m) { float r[8];
#pragma unroll
                for (int n = 0; n < 2; ++n)
#pragma unroll
                    for (int j = 0; j < 4; ++j) { const float x = acc[ai][0][m][n][j]; r[4 * n + j] = (u.pn == 0) ? (2.0f * sigm_(2.0f * x) - 1.0f) : (u.pn == 1) ? x : sigm_(x); }
                u32x4 w; w.x = cvt_pk_bf16(r[0], r[1]); w.y = cvt_pk_bf16(r[2], r[3]); w.z = cvt_pk_bf16(r[4], r[5]); w.w = cvt_pk_bf16(r[6], r[7]);
                *(u32x4*)(O + (size_t)(row0 + ai * HALF + m * 16) * 384 + col0) = w; }
    }
};
struct EpiLora2 {
    static constexpr bool PERM = false, AFTER_DRAIN = false;
    float* WD; float* AD; float* G; const float* w0; const float* a0;
    __device__ __forceinline__ void operator()(const f32x4 (&acc)[2][2][4][2], const Unit& u, int wr, int wc, int fr, int fq) const {
        const int row0 = u.pm * BM + wr * 64 + fr, blk = u.pn >> 2, col0 = (u.pn & 3) * BM + wc * 32 + 4 * fq;
        float* dst = (blk < 2) ? WD + (size_t)blk * 16896 * 1024 : (blk < 4) ? AD + (size_t)(blk - 2) * 16896 * 1024 : G;
        const float* bias = (blk < 2) ? w0 + blk * 1024 : a0 + ((blk - 2) & 1) * 1024;
#pragma unroll
        for (int ai = 0; ai < 2; ++ai)
#pragma unroll
            for (int m = 0; m < 4; ++m) { float* rowp = dst + (size_t)(row0 + ai * HALF + m * 16) * 1024;
#pragma unroll
                for (int bj = 0; bj < 2; ++bj)
#pragma unroll
                    for (int n = 0; n < 2; ++n) { const int c = col0 + bj * HALF + n * 16; f32x4 v = acc[ai][bj][m][n];
                        const f32x4 bb = *(const f32x4*)(bias + c);
                        if (blk < 2) { for (int j = 0; j < 4; ++j) v[j] = -0.60653066f * sigm_(v[j] + bb[j]); }
                        else if (blk < 4) { for (int j = 0; j < 4; ++j) v[j] = sigm_(v[j] + bb[j]); }
                        *(f32x4*)(rowp + c) = v; }
                asm volatile("" ::: "memory"); }
    }
};
}

constexpr int GLA_NCH = NSTEP / 64;
constexpr int GLA_ITEMS = 2 * NBATCH * GLA_NCH * 8;
constexpr size_t U_DS = 298 * MiB, U_OI = 430 * MiB, U_QT = 562 * MiB, U_LAM = 628 * MiB;
typedef short bf16x8_t __attribute__((ext_vector_type(8)));
__device__ __forceinline__ f32x4 mfma16(bf16x8_t a, bf16x8_t b, f32x4 c) { return __builtin_amdgcn_mfma_f32_16x16x32_bf16(a, b, c, 0, 0, 0); }

__device__ __forceinline__ void phase_gla_prep(PP p, LAS unsigned char* lds, int tid, int lane, int wave) {
    constexpr int PQ = 272, PT = 144;
    LAS unsigned char* QA = lds;
    LAS unsigned char* QX = QA + 64 * PQ;
    LAS unsigned char* KB = QX + 48 * PQ;
    LAS unsigned char* KD = KB + 64 * PQ;
    LAS unsigned char* KT = KD + 64 * PQ;
    LAS unsigned char* VT = KT + 128 * PT;
    LAS unsigned char* PI = VT + 128 * PT;
    LAS float* GT = (LAS float*)(PI + 64 * PT);
    const bf16* Z = (const bf16*)(p->ws + WS_U + U_Z);
    bf16* DS = (bf16*)(p->ws + WS_U + U_DS); f32x4* OI = (f32x4*)(p->ws + WS_U + U_OI); bf16* QT = (bf16*)(p->ws + WS_U + U_QT); float* LAM = (float*)(p->ws + WS_U + U_LAM);
    const int k = tid & 127, g = tid >> 7, kq = lane >> 4, c16 = lane & 15;
    for (int item = blockIdx.x; item < GLA_ITEMS; item += gridDim.x) {
        const int h = item & 7, cc = (item >> 3) % GLA_NCH, db = (item >> 3) / GLA_NCH, b = db & 1, dir = db >> 1;
        float lbv; { const float* lb = p->in[I_HGLB] + (size_t)dir * 3 * D + h * 128 + k; const float a0 = lb[0], a1 = lb[D], a2 = lb[2 * D];
                     const float m = fmaxf(a0, fmaxf(a1, a2)); const float e0 = __expf(a0 - m), e1 = __expf(a1 - m), e2 = __expf(a2 - m); lbv = e0 / (e0 + e1 + e2); }
        for (int u = tid; u < 64 * PT / 4; u += NTHREADS) ((LAS unsigned*)PI)[u] = 0u;
        float cs[16], kin[16], qs[16]; unsigned vt[8]; float run = 0.f;
#pragma unroll
        for (int i = 0; i < 16; ++i) {
            const size_t zr = (size_t)step_row(b, dir, 64 * cc + 16 * g + i) * 5120 + h * 128 + k;
            const float fh = bf2f(Z[zr + 1024 * (1 + dir)]), qv = bf2f(Z[zr]); const unsigned zv = Z[zr + 3072];
            const float f = lbv + (1.f - lbv) * sigm(fh);
            run += __logf(f); cs[i] = run; kin[i] = 1.f - f; qs[i] = qv * sigm(qv);
            if (i & 1) vt[i >> 1] |= zv << 16; else vt[i >> 1] = zv;
        }
        GT[g * 128 + k] = run;
        { LAS v4u* d = (LAS v4u*)(VT + k * PT + 32 * g); d[0] = (v4u){vt[0], vt[1], vt[2], vt[3]}; d[1] = (v4u){vt[4], vt[5], vt[6], vt[7]}; }
        __syncthreads();
        const float t0 = GT[k], t1 = GT[128 + k], t2 = GT[256 + k], t3 = GT[384 + k];
        const float rg = (g > 0 ? t0 : 0.f) + (g > 1 ? t1 : 0.f) + (g > 2 ? t2 : 0.f), tot = (t0 + t1) + (t2 + t3);
        const float erg = __expf(rg), einv = __expf(-run), eend = __expf(tot - (rg + run));
        const float ex1 = (g == 2) ? __expf(t1) : __expf(t2);
        const float ex2 = __expf(t1 + t2);
        unsigned kt[8];
        bf16* qtp = QT + (size_t)item * 64 * 128 + (size_t)(16 * g) * 128 + k;
#pragma unroll
        for (int i = 0; i < 16; ++i) {
            const float qh = qs[i] * __expf(cs[i]), kb = kin[i] * __expf(run - cs[i]);
            const int ro = (16 * g + i) * PQ + 2 * k;
            *(LAS unsigned short*)(QA + ro) = (unsigned short)f2bf(qh);
            *(LAS unsigned short*)(KB + ro) = (unsigned short)f2bf(kb);
            *(LAS unsigned short*)(KD + ro) = (unsigned short)f2bf(kb * einv);
            if (g == 2) *(LAS unsigned short*)(QX + i * PQ + 2 * k) = (unsigned short)f2bf(qh * ex1);
            if (g == 3) { *(LAS unsigned short*)(QX + (16 + i) * PQ + 2 * k) = (unsigned short)f2bf(qh * ex1); *(LAS unsigned short*)(QX + (32 + i) * PQ + 2 * k) = (unsigned short)f2bf(qh * ex2); }
            qtp[(size_t)i * 128] = (bf16)f2bf(qh * erg);
            const unsigned kv = f2bf(kb * eend);
            if (i & 1) kt[i >> 1] |= kv << 16; else kt[i >> 1] = kv;
        }
        { LAS v4u* d = (LAS v4u*)(KT + k * PT + 32 * g); d[0] = (v4u){kt[0], kt[1], kt[2], kt[3]}; d[1] = (v4u){kt[4], kt[5], kt[6], kt[7]}; }
        if (g == 0) LAM[(size_t)item * 128 + k] = __expf(tot);
        __syncthreads();
        for (int blk = wave; blk < 10; blk += 8) {
            const int gi = (blk >= 6) ? 3 : (blk >= 3) ? 2 : (blk >= 1) ? 1 : 0, ji = blk - ((gi * (gi + 1)) >> 1);
            const LAS unsigned char* ab = (ji + 1 >= gi) ? QA + 16 * gi * PQ : (gi == 2) ? QX : (ji == 1) ? QX + 16 * PQ : QX + 32 * PQ;
            const LAS unsigned char* bb = ((ji == gi) ? KD : KB) + 16 * ji * PQ;
            f32x4 acc = (f32x4){0.f, 0.f, 0.f, 0.f};
#pragma unroll
            for (int s = 0; s < 4; ++s) {
                const bf16x8_t a = *(const LAS bf16x8_t*)(ab + c16 * PQ + (32 * s + 8 * kq) * 2), bv = *(const LAS bf16x8_t*)(bb + c16 * PQ + (32 * s + 8 * kq) * 2);
                acc = mfma16(a, bv, acc);
            }
#pragma unroll
            for (int j = 0; j < 4; ++j) { const int tau = 4 * kq + j; const float val = (ji == gi && c16 > tau) ? 0.f : acc[j];
                *(LAS unsigned short*)(PI + (16 * gi + tau) * PT + (16 * ji + c16) * 2) = (unsigned short)f2bf(val); }
        }
        __syncthreads();
        {
            const LAS unsigned char* vb = VT + (16 * wave + c16) * PT + 16 * kq;
            const bf16x8_t v0 = *(const LAS bf16x8_t*)(vb), v1 = *(const LAS bf16x8_t*)(vb + 64);
#pragma unroll
            for (int gi = 0; gi < 4; ++gi) {
                const LAS unsigned char* pb = PI + (16 * gi + c16) * PT + 16 * kq;
                f32x4 acc = mfma16(*(const LAS bf16x8_t*)(pb), v0, (f32x4){0.f, 0.f, 0.f, 0.f});
                if (gi >= 2) acc = mfma16(*(const LAS bf16x8_t*)(pb + 64), v1, acc);
                OI[((size_t)item * 8 + wave) * 256 + gi * 64 + lane] = acc;
            }
            bf16* dsp = DS + (size_t)item * 128 * 128 + (size_t)(16 * wave + c16) * 128 + 4 * kq;
#pragma unroll
            for (int m = 0; m < 8; ++m) {
                const LAS unsigned char* kb2 = KT + (16 * m + c16) * PT + 16 * kq;
                f32x4 acc = mfma16(*(const LAS bf16x8_t*)(kb2), v0, (f32x4){0.f, 0.f, 0.f, 0.f});
                acc = mfma16(*(const LAS bf16x8_t*)(kb2 + 64), v1, acc);
                v2u w; w.x = pk2(acc[0], acc[1]); w.y = pk2(acc[2], acc[3]);
                *(v2u*)(dsp + 16 * m) = w;
            }
        }
        __syncthreads();
    }
}
__device__ __forceinline__ void phase_gla_scan(PP p, int tid) {
    bf16* DS = (bf16*)(p->ws + WS_U + U_DS); const float* LAM = (const float*)(p->ws + WS_U + U_LAM);
    const int nthr = gridDim.x * NTHREADS;
    for (int e = blockIdx.x * NTHREADS + tid; e < 32 * 2048; e += nthr) {
        const int chain = e >> 11, el = e & 2047, h = chain & 7, db = chain >> 3, k8 = (el & 15) * 8;
        float s[8];
#pragma unroll
        for (int i = 0; i < 8; ++i) s[i] = 0.f;
        for (int c0 = 0; c0 < GLA_NCH; c0 += 6) {
            v4u d[6]; f32x4 l0[6], l1[6];
#pragma unroll
            for (int u = 0; u < 6; ++u) { const size_t item = ((size_t)db * GLA_NCH + c0 + u) * 8 + h;
                d[u] = *(const v4u*)(DS + item * 16384 + (size_t)el * 8); l0[u] = *(const f32x4*)(LAM + item * 128 + k8); l1[u] = *(const f32x4*)(LAM + item * 128 + k8 + 4); }
#pragma unroll
            for (int u = 0; u < 6; ++u) { const size_t item = ((size_t)db * GLA_NCH + c0 + u) * 8 + h;
                v4u o; o.x = pk2(s[0], s[1]); o.y = pk2(s[2], s[3]); o.z = pk2(s[4], s[5]); o.w = pk2(s[6], s[7]);
                *(v4u*)(DS + item * 16384 + (size_t)el * 8) = o;
                s[0] = l0[u].x * s[0] + bf2f(d[u].x & 0xffffu); s[1] = l0[u].y * s[1] + bf2f(d[u].x >> 16);
                s[2] = l0[u].z * s[2] + bf2f(d[u].y & 0xffffu); s[3] = l0[u].w * s[3] + bf2f(d[u].y >> 16);
                s[4] = l1[u].x * s[4] + bf2f(d[u].z & 0xffffu); s[5] = l1[u].y * s[5] + bf2f(d[u].z >> 16);
                s[6] = l1[u].z * s[6] + bf2f(d[u].w & 0xffffu); s[7] = l1[u].w * s[7] + bf2f(d[u].w >> 16); }
        }
    }
}
__device__ __forceinline__ void phase_gla_out(PP p, int lane, int wave) {
    const bf16* DS = (const bf16*)(p->ws + WS_U + U_DS); const f32x4* OI = (const f32x4*)(p->ws + WS_U + U_OI); const bf16* QT = (const bf16*)(p->ws + WS_U + U_QT);
    float* ODb = (float*)(p->ws + WS_U + U_OD0);
    const int kq = lane >> 4, c16 = lane & 15;
    for (int item = blockIdx.x; item < GLA_ITEMS; item += gridDim.x) {
        const int h = item & 7, cc = (item >> 3) % GLA_NCH, db = (item >> 3) / GLA_NCH, b = db & 1, dir = db >> 1;
        const bf16* sp = DS + (size_t)item * 16384 + (size_t)(16 * wave + c16) * 128 + 8 * kq;
        bf16x8_t bv[4];
#pragma unroll
        for (int s = 0; s < 4; ++s) bv[s] = *(const bf16x8_t*)(sp + 32 * s);
        float* OD = ODb + (size_t)dir * NROW * D + h * 128 + 16 * wave + c16;
#pragma unroll
        for (int gi = 0; gi < 4; ++gi) {
            const bf16* qp = QT + (size_t)item * 8192 + (size_t)(16 * gi + c16) * 128 + 8 * kq;
            f32x4 acc = OI[((size_t)item * 8 + wave) * 256 + gi * 64 + lane];
#pragma unroll
            for (int s = 0; s < 4; ++s) acc = mfma16(*(const bf16x8_t*)(qp + 32 * s), bv[s], acc);
#pragma unroll
            for (int j = 0; j < 4; ++j) OD[(size_t)step_row(b, dir, 64 * cc + 16 * gi + 4 * kq + j) * D] = acc[j];
        }
    }
}

constexpr int RW_NB = 32, RW_SLOT = 336;
__device__ __forceinline__ float row16_sum(float x) {
    x += __builtin_bit_cast(float, __builtin_amdgcn_update_dpp(0, __builtin_bit_cast(int, x), 0x128, 0xf, 0xf, false));
    x += __builtin_bit_cast(float, __builtin_amdgcn_update_dpp(0, __builtin_bit_cast(int, x), 0x124, 0xf, 0xf, false));
    x += __builtin_bit_cast(float, __builtin_amdgcn_update_dpp(0, __builtin_bit_cast(int, x), 0x122, 0xf, 0xf, false));
    x += __builtin_bit_cast(float, __builtin_amdgcn_update_dpp(0, __builtin_bit_cast(int, x), 0x121, 0xf, 0xf, false));
    return x;
}
__device__ __forceinline__ void rw_fill(PP p, LAS float* buf, int batch, int b, int dir, int h, int rowgrp, int lw, int lane) {
    const float* RKV = (const float*)(p->ws + WS_U + U_RKV);
    const float* WDp = (const float*)(p->ws + WS_U + U_WD) + (size_t)dir * NROW * D; const float* ADp = (const float*)(p->ws + WS_U + U_AD) + (size_t)dir * NROW * D;
    const int ch = h * 64 + lane; const float kkw = p->in[I_KK][ch], kaw = p->in[I_KA][ch];
    float rx[8], kx[8], vx[8], wv[8], av[8];
#pragma unroll
    for (int u = 0; u < 8; ++u) { const int row = step_row(b, dir, batch * RW_NB + lw + 4 * u);
        rx[u] = RKV[(size_t)row * 3072 + ch]; kx[u] = RKV[(size_t)row * 3072 + 1024 + ch]; vx[u] = RKV[(size_t)row * 3072 + 2048 + ch];
        wv[u] = WDp[(size_t)row * D + ch]; av[u] = ADp[(size_t)row * D + ch]; }
#pragma unroll
    for (int u = 0; u < 8; ++u) {
        float kkx = kx[u] * kkw; const float nrm = sqrtf(wave_sum(kkx * kkx)); kkx = kkx / fmaxf(nrm, 1e-12f);
        LAS float* B = buf + (lw + 4 * u) * RW_SLOT;
        B[lane] = wv[u]; B[64 + lane] = kkx; B[128 + lane] = kkx * av[u]; B[192 + lane] = kx[u] * (1.f + (av[u] - 1.f) * kaw); B[256 + lane] = rx[u];
        if ((lane >> 4) == rowgrp) B[320 + (lane & 15)] = vx[u];
    }
}
__device__ __forceinline__ void phase_rwkv_scan(PP p, LAS unsigned char* lds, int lane, int wave) {
    LAS float* L = (LAS float*)lds;
    for (int unit = blockIdx.x; unit < 256; unit += gridDim.x) {
        const int chain = unit >> 2, rowgrp = unit & 3, b = chain >> 5, dir = (chain >> 4) & 1, h = chain & 15;
        float* OD = (float*)(p->ws + WS_U + U_OD1) + (size_t)dir * NROW * D + h * 64 + 16 * rowgrp + 4 * wave + (lane >> 4);
        const int seg = lane & 15;
        f32x4 S = (f32x4){0.f, 0.f, 0.f, 0.f};
        if (wave >= 4) rw_fill(p, L, 0, b, dir, h, rowgrp, wave - 4, lane);
        __syncthreads();
        constexpr int NBATCH_RW = NSTEP / RW_NB;
        for (int bt = 0; bt < NBATCH_RW; ++bt) {
            if (wave >= 4) { if (bt + 1 < NBATCH_RW) rw_fill(p, L + ((bt + 1) & 1) * RW_NB * RW_SLOT, bt + 1, b, dir, h, rowgrp, wave - 4, lane); }
            else {
                const LAS float* B0 = L + (bt & 1) * RW_NB * RW_SLOT;
#pragma unroll 4
                for (int s = 0; s < RW_NB; ++s) {
                    const LAS f32x4* B4 = (const LAS f32x4*)(B0 + s * RW_SLOT);
                    const f32x4 w4 = B4[seg], kk4 = B4[16 + seg], bt4 = B4[32 + seg], kd4 = B4[48 + seg], r4 = B4[64 + seg];
                    const float vv = B0[s * RW_SLOT + 320 + 4 * wave + (lane >> 4)];
                    float sa = (S.x * kk4.x + S.y * kk4.y) + (S.z * kk4.z + S.w * kk4.w);
                    sa = row16_sum(sa);
                    S = S * w4 - sa * bt4 + vv * kd4;
                    float y = (S.x * r4.x + S.y * r4.y) + (S.z * r4.z + S.w * r4.w);
                    y = row16_sum(y);
                    if (seg == 0) OD[(size_t)step_row(b, dir, bt * RW_NB + s) * D] = y;
                }
            }
            __syncthreads();
        }
    }
}

constexpr int RW2_NB = 32, RW2_SLOT = 832, RW2_ZERO = 2 * RW2_NB * RW2_SLOT;
typedef short bf16x4_t __attribute__((ext_vector_type(4)));
typedef float f32x2_t __attribute__((ext_vector_type(2))); typedef __bf16 bf16x2v_t __attribute__((ext_vector_type(2)));
__device__ __forceinline__ unsigned cvtpk(float lo, float hi) { const f32x2_t v = {lo, hi}; const bf16x2v_t b = __builtin_convertvector(v, bf16x2v_t); return __builtin_bit_cast(unsigned, b); }
constexpr size_t U_KKN = 872 * MiB;
__device__ __forceinline__ void phase_kk_prep(PP p, int lane, int wave) {
    const int gw = blockIdx.x * NWAVES + wave, NGW = gridDim.x * NWAVES;
    const float* RKV = (const float*)(p->ws + WS_U + U_RKV); float* KKN = (float*)(p->ws + WS_U + U_KKN);
    for (int row = gw; row < NROW; row += NGW) {
        float kx[16];
#pragma unroll
        for (int h = 0; h < 16; ++h) kx[h] = RKV[(size_t)row * 3072 + 1024 + h * 64 + lane] * p->in[I_KK][h * 64 + lane];
#pragma unroll
        for (int h = 0; h < 16; ++h) { const float nrm = sqrtf(wave_sum(kx[h] * kx[h])); KKN[(size_t)row * D + h * 64 + lane] = kx[h] / fmaxf(nrm, 1e-12f); }
    }
}
struct Rw2Regs { float rx[8], kx[8], vx[8], wv[8], av[8], kn[8]; };
__device__ __forceinline__ void rw2_load(PP p, Rw2Regs& R, int batch, int b, int dir, int h, int lw, int lane) {
    const float* RKV = (const float*)(p->ws + WS_U + U_RKV); const float* KKN = (const float*)(p->ws + WS_U + U_KKN);
    const float* WDp = (const float*)(p->ws + WS_U + U_WD) + (size_t)dir * NROW * D; const float* ADp = (const float*)(p->ws + WS_U + U_AD) + (size_t)dir * NROW * D;
    const int ch = h * 64 + lane;
#pragma unroll
    for (int u = 0; u < 8; ++u) { const int gs = batch * RW2_NB + lw + 4 * u; const int row = step_row(b, dir, gs < NSTEP ? gs : NSTEP - 1), rowp = step_row(b, dir, gs < 1 ? 0 : (gs - 1 < NSTEP ? gs - 1 : NSTEP - 1));
        R.rx[u] = RKV[(size_t)rowp * 3072 + ch]; R.kx[u] = RKV[(size_t)row * 3072 + 1024 + ch]; R.vx[u] = RKV[(size_t)row * 3072 + 2048 + ch];
        R.wv[u] = WDp[(size_t)row * D + ch]; R.av[u] = ADp[(size_t)row * D + ch]; R.kn[u] = KKN[(size_t)row * D + ch]; }
}
__device__ __forceinline__ void rw2_store(const Rw2Regs& R, LAS unsigned char* buf, float kaw, int slab, int lw, int lane) {
    const int s2 = lane >> 5, tp = (lane >> 4) & 1, kq = (lane & 15) >> 2, ii = (lane & 3) + 4 * tp, dpos = ((s2 * 4 + kq) * 8 + ii) * 2;
#pragma unroll
    for (int u = 0; u < 8; ++u) {
        LAS unsigned char* B = buf + (lw + 4 * u) * RW2_SLOT; const float kkx = R.kn[u];
        ((LAS float*)B)[lane] = R.wv[u];
        *(LAS unsigned short*)(B + 256 + dpos) = (unsigned short)f2bf(kkx);
        *(LAS unsigned short*)(B + 256 + 128 + dpos) = (unsigned short)f2bf(R.rx[u]);
        ((LAS unsigned*)(B + 512))[lane] = pk2(-(kkx * R.av[u]), R.kx[u] * (1.f + (R.av[u] - 1.f) * kaw));
        if ((lane >> 4) == slab) ((LAS float*)(B + 768))[lane & 15] = R.vx[u];
    }
}
__device__ __forceinline__ void phase_rwkv_scan2(PP p, LAS unsigned char* lds, int tid, int lane, int wave) {
    for (int u = tid; u < 256; u += NTHREADS) ((LAS unsigned*)(lds + RW2_ZERO))[u] = 0u;
    const int m = lane & 15, q = lane >> 4;
    for (int unit = blockIdx.x; unit < 256; unit += gridDim.x) {
        const int chain = unit >> 2, slab = unit & 3, b = chain >> 5, dir = (chain >> 4) & 1, h = chain & 15;
        float* OD = (float*)(p->ws + WS_U + U_OD1) + (size_t)dir * NROW * D + h * 64 + 16 * slab + m;
        f32x4 S[4];
#pragma unroll
        for (int T = 0; T < 4; ++T) S[T] = (f32x4){0.f, 0.f, 0.f, 0.f};
        Rw2Regs R; const float kaw = p->in[I_KA][h * 64 + lane];
        if (wave >= 4) { rw2_load(p, R, 0, b, dir, h, wave - 4, lane); rw2_store(R, lds, kaw, slab, wave - 4, lane); rw2_load(p, R, 1, b, dir, h, wave - 4, lane); }
        __syncthreads();
        constexpr int NB2 = (NSTEP + 1 + RW2_NB - 1) / RW2_NB;
        for (int bt = 0; bt < NB2; ++bt) {
            if (wave >= 4) { if (bt + 1 < NB2) { rw2_store(R, lds + ((bt + 1) & 1) * RW2_NB * RW2_SLOT, kaw, slab, wave - 4, lane); if (bt + 2 < NB2) rw2_load(p, R, bt + 2, b, dir, h, wave - 4, lane); } }
            else if (wave == 0) {
                const LAS unsigned char* B0 = lds + (bt & 1) * RW2_NB * RW2_SLOT;
#pragma unroll 2
                for (int s = 0; s < RW2_NB; ++s) {
                    const int gs = bt * RW2_NB + s;
                    if (gs > NSTEP) break;
                    const LAS unsigned char* sl = B0 + s * RW2_SLOT;
                    f32x4 w4[4]; unsigned ub[4];
                    const LAS unsigned char* up = (q == 0) ? sl + 512 + 4 * m : lds + RW2_ZERO + 4 * m;
#pragma unroll
                    for (int T = 0; T < 4; ++T) { w4[T] = *(const LAS f32x4*)(sl + (16 * T + 4 * q) * 4); ub[T] = *(const LAS unsigned*)(up + 64 * T); }
                    const bf16x8_t a0 = *(const LAS bf16x8_t*)(sl + 256 + (((m & 1) * 2 + 0) * 4 + q) * 16), a1 = *(const LAS bf16x8_t*)(sl + 256 + (((m & 1) * 2 + 1) * 4 + q) * 16);
                    const float vv = *(const LAS float*)(sl + 768 + 4 * m);
                    v4u b0, b1;
                    b0.x = cvtpk(S[0][0], S[0][1]); b0.y = cvtpk(S[0][2], S[0][3]); b0.z = cvtpk(S[1][0], S[1][1]); b0.w = cvtpk(S[1][2], S[1][3]);
                    b1.x = cvtpk(S[2][0], S[2][1]); b1.y = cvtpk(S[2][2], S[2][3]); b1.z = cvtpk(S[3][0], S[3][1]); b1.w = cvtpk(S[3][2], S[3][3]);
                    const f32x4 z4 = (f32x4){0.f, 0.f, 0.f, 0.f};
                    const f32x4 d1 = mfma16(a0, __builtin_bit_cast(bf16x8_t, b0), z4), d2 = mfma16(a1, __builtin_bit_cast(bf16x8_t, b1), z4);
                    const float sa = d1[0] + d2[0], y = d1[1] + d2[1];
                    if (gs >= 1 && q == 0) OD[(size_t)step_row(b, dir, gs - 1) * D] = y;
                    if (gs < NSTEP) {
                        v2u bu; bu.x = (q == 0) ? cvtpk(sa, vv) : 0u; bu.y = 0u;
#pragma unroll
                        for (int T = 0; T < 4; ++T) { v2u au; au.x = ub[T]; au.y = 0u;
                            S[T] = __builtin_amdgcn_mfma_f32_16x16x16bf16_1k(__builtin_bit_cast(bf16x4_t, au), __builtin_bit_cast(bf16x4_t, bu), S[T] * w4[T], 0, 0, 0); }
                    }
                }
            }
            __syncthreads();
        }
    }
}

constexpr int R3_NCB = 4, R3_DOTA = 0, R3_UPA = 2048, R3_A1 = 4096, R3_A2 = 4608, R3_G7 = 5120, R3_VT = 5376, R3_SLOT = 5888;
constexpr int R3_SCR = 2 * R3_NCB * R3_SLOT;
struct Rw3Regs { float rx[8], kx[8], vx[8], lw[8], av[8], kn[8]; };
__device__ __forceinline__ void rw3_load(PP p, Rw3Regs& R, int chunk, int b, int dir, int h, int lane) {
    const float* RKV = (const float*)(p->ws + WS_U + U_RKV); const float* KKN = (const float*)(p->ws + WS_U + U_KKN);
    const float* WDp = (const float*)(p->ws + WS_U + U_WD) + (size_t)dir * NROW * D; const float* ADp = (const float*)(p->ws + WS_U + U_AD) + (size_t)dir * NROW * D;
    const int ch = h * 64 + lane;
#pragma unroll
    for (int j = 0; j < 8; ++j) { const int row = step_row(b, dir, chunk * 8 + j);
        R.rx[j] = RKV[(size_t)row * 3072 + ch]; R.kx[j] = RKV[(size_t)row * 3072 + 1024 + ch]; R.vx[j] = RKV[(size_t)row * 3072 + 2048 + ch];
        R.lw[j] = WDp[(size_t)row * D + ch]; R.av[j] = ADp[(size_t)row * D + ch]; R.kn[j] = KKN[(size_t)row * D + ch]; }
}
__device__ __forceinline__ void rw3_build(const Rw3Regs& R, LAS unsigned char* sl, LAS unsigned char* gb, float kaw, int slab, int lane) {
    const int m = lane & 15, q = lane >> 4;
    const int s2 = lane >> 5, tp = (lane >> 4) & 1, kq = (lane & 15) >> 2, ii = (lane & 3) + 4 * tp, dpos = ((s2 * 4 + kq) * 8 + ii) * 2;
    float bj[8]; { float bb = 0.f;
#pragma unroll
        for (int j = 0; j < 8; ++j) { bb += R.lw[j]; bj[j] = bb; } }
    const float e7 = __expf(bj[7]);
    unsigned upa[8]; float ebprev = 1.f;
#pragma unroll
    for (int j = 0; j < 8; ++j) {
        const float eb = __expf(bj[j]), einv = 1.0f / eb, e7j = e7 * einv;
        const float beta = R.kn[j] * R.av[j], kd = R.kx[j] * (1.f + (R.av[j] - 1.f) * kaw);
        *(LAS unsigned short*)(sl + R3_DOTA + j * 128 + dpos) = (unsigned short)f2bf(R.kn[j] * ebprev);
        *(LAS unsigned short*)(sl + R3_DOTA + (8 + j) * 128 + dpos) = (unsigned short)f2bf(R.rx[j] * eb);
        *(LAS unsigned short*)(gb + j * 128 + dpos) = (unsigned short)f2bf(beta * einv);
        *(LAS unsigned short*)(gb + (8 + j) * 128 + dpos) = (unsigned short)f2bf(kd * einv);
        const unsigned ub = f2bf(-beta * e7j), uk = f2bf(kd * e7j);
        if (j & 1) { upa[j >> 1] |= ub << 16; upa[4 + (j >> 1)] |= uk << 16; } else { upa[j >> 1] = ub; upa[4 + (j >> 1)] = uk; }
        ebprev = eb;
    }
    { LAS v4u* d = (LAS v4u*)(sl + R3_UPA + lane * 32); d[0] = (v4u){upa[0], upa[1], upa[2], upa[3]}; d[1] = (v4u){upa[4], upa[5], upa[6], upa[7]}; }
    ((LAS float*)(sl + R3_G7))[lane] = e7;
    if ((lane >> 4) == slab) { LAS f32x4* d = (LAS f32x4*)(sl + R3_VT + (lane & 15) * 32); d[0] = (f32x4){R.vx[0], R.vx[1], R.vx[2], R.vx[3]}; d[1] = (f32x4){R.vx[4], R.vx[5], R.vx[6], R.vx[7]}; }
    LDS_WAIT(); asm volatile("" ::: "memory");
    f32x4 G = (f32x4){0.f, 0.f, 0.f, 0.f};
#pragma unroll
    for (int s = 0; s < 2; ++s) G = mfma16(*(const LAS bf16x8_t*)(sl + R3_DOTA + m * 128 + (s * 4 + q) * 16), *(const LAS bf16x8_t*)(gb + m * 128 + (s * 4 + q) * 16), G);
    if (m >= 8) { const int i = m - 8;
#pragma unroll
        for (int jp = 0; jp < 4; ++jp) { const int row = 4 * q + jp; const bool keep = (row < 8) ? (i < row) : (i <= row - 8);
            *(LAS unsigned short*)(sl + R3_A1 + row * 32 + i * 2) = (unsigned short)f2bf(keep ? G[jp] : 0.f); } }
    LDS_WAIT(); asm volatile("" ::: "memory");
#pragma unroll
    for (int jp = 0; jp < 4; ++jp) ((LAS float*)gb)[(4 * q + jp) * 16 + m] = G[jp];
    LDS_WAIT(); asm volatile("" ::: "memory");
    const LAS float* GL = (const LAS float*)gb;
    const int c = lane & 7; float Tc[8], M2[8];
#pragma unroll
    for (int j = 0; j < 8; ++j) { float t = (j == c) ? 1.f : 0.f;
#pragma unroll
        for (int i = 0; i < j; ++i) t -= GL[j * 16 + i] * Tc[i];
        Tc[j] = t; }
#pragma unroll
    for (int j = 0; j < 8; ++j) { float t = 0.f;
#pragma unroll
        for (int i = 0; i <= j; ++i) t -= GL[(8 + j) * 16 + i] * Tc[i];
        M2[j] = t; }
    LDS_WAIT(); asm volatile("" ::: "memory");
    if (lane < 8) {
#pragma unroll
        for (int j = 0; j < 8; ++j) { *(LAS unsigned short*)(sl + R3_A2 + j * 32 + c * 2) = (unsigned short)f2bf(Tc[j]); *(LAS unsigned short*)(sl + R3_A2 + (8 + j) * 32 + c * 2) = (unsigned short)f2bf(M2[j]); } }
}
__device__ __forceinline__ void phase_rwkv_scan3(PP p, LAS unsigned char* lds, int tid, int lane, int wave) {
    const int m = lane & 15, q = lane >> 4;
    for (int unit = blockIdx.x; unit < 256; unit += gridDim.x) {
        const int chain = unit >> 2, slab = unit & 3, b = chain >> 5, dir = (chain >> 4) & 1, h = chain & 15;
        __syncthreads();
        for (int u = tid; u < (R3_SCR + 4 * 2048) / 4; u += NTHREADS) ((LAS unsigned*)lds)[u] = 0u;
        __syncthreads();
        if (tid < 2 * R3_NCB * 8) { const int slot = tid >> 3, j = tid & 7; *(LAS unsigned short*)(lds + slot * R3_SLOT + R3_A2 + (8 + j) * 32 + (8 + j) * 2) = (unsigned short)0x3F80; }
        float* OD = (float*)(p->ws + WS_U + U_OD1) + (size_t)dir * NROW * D + h * 64 + 16 * slab + m;
        f32x4 S[4];
#pragma unroll
        for (int T = 0; T < 4; ++T) S[T] = (f32x4){0.f, 0.f, 0.f, 0.f};
        Rw3Regs R; const float kaw = p->in[I_KA][h * 64 + lane];
        LAS unsigned char* gb = lds + R3_SCR + (wave & 3) * 2048;
        __syncthreads();
        if (wave >= 4) { rw3_load(p, R, wave - 4, b, dir, h, lane); rw3_build(R, lds + (wave - 4) * R3_SLOT, gb, kaw, slab, lane); rw3_load(p, R, R3_NCB + wave - 4, b, dir, h, lane); }
        __syncthreads();
        constexpr int NB3 = NSTEP / (8 * R3_NCB);
        for (int bt = 0; bt < NB3; ++bt) {
            if (wave >= 4) { if (bt + 1 < NB3) { rw3_build(R, lds + (((bt + 1) & 1) * R3_NCB + wave - 4) * R3_SLOT, gb, kaw, slab, lane); if (bt + 2 < NB3) rw3_load(p, R, (bt + 2) * R3_NCB + wave - 4, b, dir, h, lane); } }
            else if (wave == 0) {
#pragma unroll 1
                for (int cc = 0; cc < R3_NCB; ++cc) {
                    const LAS unsigned char* sl = lds + ((bt & 1) * R3_NCB + cc) * R3_SLOT;
                    const bf16x8_t a0 = *(const LAS bf16x8_t*)(sl + R3_DOTA + m * 128 + q * 16), a1 = *(const LAS bf16x8_t*)(sl + R3_DOTA + m * 128 + (4 + q) * 16);
                    const bf16x4_t A1f = *(const LAS bf16x4_t*)(sl + R3_A1 + m * 32 + q * 8), A2f = *(const LAS bf16x4_t*)(sl + R3_A2 + m * 32 + q * 8);
                    bf16x4_t UA[4]; f32x4 g7[4];
#pragma unroll
                    for (int T = 0; T < 4; ++T) { UA[T] = *(const LAS bf16x4_t*)(sl + R3_UPA + (16 * T + m) * 32 + q * 8); g7[T] = *(const LAS f32x4*)(sl + R3_G7 + (16 * T + 4 * q) * 4); }
                    const f32x4 vr = *(const LAS f32x4*)(sl + R3_VT + m * 32 + (q & 1) * 16);
                    v4u b0, b1;
                    b0.x = cvtpk(S[0][0], S[0][1]); b0.y = cvtpk(S[0][2], S[0][3]); b0.z = cvtpk(S[1][0], S[1][1]); b0.w = cvtpk(S[1][2], S[1][3]);
                    b1.x = cvtpk(S[2][0], S[2][1]); b1.y = cvtpk(S[2][2], S[2][3]); b1.z = cvtpk(S[3][0], S[3][1]); b1.w = cvtpk(S[3][2], S[3][3]);
                    f32x4 Dd = mfma16(a0, __builtin_bit_cast(bf16x8_t, b0), (f32x4){0.f, 0.f, 0.f, 0.f});
                    Dd = mfma16(a1, __builtin_bit_cast(bf16x8_t, b1), Dd);
                    v2u vb; vb.x = cvtpk(vr[0], vr[1]); vb.y = cvtpk(vr[2], vr[3]);
                    const f32x4 Z = __builtin_amdgcn_mfma_f32_16x16x16bf16_1k(A1f, __builtin_bit_cast(bf16x4_t, vb), Dd, 0, 0, 0);
                    v2u zb; zb.x = cvtpk(Z[0], Z[1]); zb.y = cvtpk(Z[2], Z[3]);
                    const f32x4 W = __builtin_amdgcn_mfma_f32_16x16x16bf16_1k(A2f, __builtin_bit_cast(bf16x4_t, zb), (f32x4){0.f, 0.f, 0.f, 0.f}, 0, 0, 0);
                    v2u wb; wb.x = cvtpk(W[0], W[1]); wb.y = cvtpk(W[2], W[3]);
                    const v2u ub = (q < 2) ? wb : vb;
#pragma unroll
                    for (int T = 0; T < 4; ++T) S[T] = __builtin_amdgcn_mfma_f32_16x16x16bf16_1k(UA[T], __builtin_bit_cast(bf16x4_t, ub), S[T] * g7[T], 0, 0, 0);
                    if (q >= 2) { const int st0 = (bt * R3_NCB + cc) * 8 + 4 * (q - 2);
#pragma unroll
                        for (int i = 0; i < 4; ++i) OD[(size_t)step_row(b, dir, st0 + i) * D] = W[i]; }
                }
            }
            __syncthreads();
        }
    }
}
enum { PH_PRE = 0, PH_NORM0, PH_G_IN, PH_GLA_A, PH_GLA_B, PH_GLA_C, PH_HGRO, PH_G_HGO, PH_FFN0, PH_GATHER0, PH_GU0, PH_DN0, PH_COMB0,
       PH_LERP, PH_G_RKV, PH_G_L2, PH_RWSCAN, PH_RWRO, PH_G_RWO, PH_FFN1, PH_GATHER1, PH_GU1, PH_DN1, PH_COMB1, NPHASES };

template <int ph> __device__ __forceinline__ void run_phase(PP p, LAS unsigned char* lds, int tid, int lane, int wave, int G, int bx, int vcu) {
    unsigned char* ws = p->ws;
    typedef pg8::bf16_t bt;
    switch (ph) {
        case PH_PRE: phase_pre(p, lds, tid, lane, wave); break;
        case PH_NORM0: phase_norm0(p, lane, wave); break;
        case PH_G_IN: {
            pg8::Gemm g{(const bt*)(ws + WS_H), (const bt*)(ws + WS_WIN), NROW, 5120, D}; pg8::StaticOrder S; S.init(NROW, 5120, G, bx);
            pg8::EpiStoreBf16 E{(bt*)(ws + WS_U + U_Z), 5120};
            pg8::gemm_phase<pg8::EpiStoreBf16, pg8::StaticOrder, true, true>(lds, g, S, E); } break;
        case PH_GLA_A: phase_gla_prep(p, lds, tid, lane, wave); break;
        case PH_GLA_B: phase_gla_scan(p, tid); break;
        case PH_GLA_C: phase_gla_out(p, lane, wave); break;
        case PH_HGRO: phase_hg_readout(p, lane, wave); break;
        case PH_G_HGO: {
            pg8::Gemm g{(const bt*)(ws + WS_A2), (const bt*)(ws + WS_WHGO), NROW, D, D}; pg8::StaticOrder S; S.init(NROW, D, G, bx);
            pg8::EpiResid E{p->in[I_X], p->in[I_CTX], (float*)(ws + WS_XR), modp(p, 0, 0, 2), 6144};
            pg8::gemm_phase<pg8::EpiResid, pg8::StaticOrder, true, true>(lds, g, S, E); } break;
        case PH_FFN0: phase_ffn_norm_route(p, 0, NROW, lane, wave); break;
        case PH_FFN1: phase_ffn_norm_route(p, 1, NLAT, lane, wave); break;
        case PH_GATHER0: phase_gather(p, 0, NROW, lds, tid, lane, wave); break;
        case PH_GATHER1: phase_gather(p, 1, NLAT, lds, tid, lane, wave); break;
        case PH_GU0: case PH_GU1: { const int layer = (ph == PH_GU1);
            pg8::Gemm g{(const bt*)(ws + WS_U + U_XB), (const bt*)(ws + WS_WGU) + (size_t)layer * NE * 2048 * D, CAP, 2048, D};
            pg8::MoeOrder S; S.init((const int*)(ws + WS_ROUTE + RT_TILEE), 8, (size_t)2048 * D * 2, G, vcu);
            pg8::EpiSwiglu E{(bt*)(ws + WS_U + U_ACT), p->in[I_BGU] + (size_t)layer * NE * 2048};
            pg8::gemm_phase<pg8::EpiSwiglu, pg8::MoeOrder, true, true>(lds, g, S, E); } break;
        case PH_DN0: case PH_DN1: { const int layer = (ph == PH_DN1);
            pg8::Gemm g{(const bt*)(ws + WS_U + U_ACT), (const bt*)(ws + WS_WD) + (size_t)layer * NE * D * D, CAP, D, D};
            pg8::MoeOrder S; S.init((const int*)(ws + WS_ROUTE + RT_TILEE), 4, (size_t)D * D * 2, G, vcu);
            pg8::EpiDown E{(bt*)(ws + WS_U + U_YS), p->in[I_BDN] + (size_t)layer * NE * D};
            pg8::gemm_phase<pg8::EpiDown, pg8::MoeOrder, true, true>(lds, g, S, E); } break;
        case PH_COMB0: phase_combine(p, 0, NROW, false, lane, wave); break;
        case PH_COMB1: phase_combine(p, 1, NLAT, true, lane, wave); break;
        case PH_LERP: phase_lerp(p, lane, wave); break;
        case PH_G_RKV: {
            { pg8::Gemm g{(const bt*)(ws + WS_U + U_XL6), (const bt*)(ws + WS_WRKV), NROW, 3072, D};
              pg8::SelOrder S; S.init(NROW, 3072, G, bx); S.div = 4; S.sel0 = 0; S.stride = (size_t)NROW * D * 2;
              pg8::EpiStoreF32 E{(float*)(ws + WS_U + U_RKV), 3072};
              pg8::gemm_phase<pg8::EpiStoreF32, pg8::SelOrder, true, true>(lds, g, S, E); }
            { pg8::Gemm g{(const bt*)(ws + WS_U + U_XL6), (const bt*)(ws + WS_WL1), NROW, 768, D};
              pg8::SelOrder S; S.init(NROW, 768, G, bx); S.div = 1; S.sel0 = 3; S.stride = (size_t)NROW * D * 2;
              pg8::EpiLora1 E{(bt*)(ws + WS_U + U_L1)};
              pg8::gemm_phase<pg8::EpiLora1, pg8::SelOrder, true, true>(lds, g, S, E); } } break;
        case PH_G_L2: {
            phase_kk_prep(p, lane, wave);
            pg8::Gemm g{(const bt*)(ws + WS_U + U_L1), (const bt*)(ws + WS_WL2), NROW, 5120, 384}; pg8::StaticOrder S; S.init(NROW, 5120, G, bx);
            pg8::EpiLora2 E{(float*)(ws + WS_U + U_WD), (float*)(ws + WS_U + U_AD), (float*)(ws + WS_U + U_G), p->in[I_DECW0], p->in[I_A0]};
            pg8::gemm_phase<pg8::EpiLora2, pg8::StaticOrder, true, true>(lds, g, S, E); } break;
        case PH_RWSCAN: phase_rwkv_scan3(p, lds, tid, lane, wave); break;
        case PH_RWRO: phase_rw_readout(p, lane, wave); break;
        case PH_G_RWO: {
            pg8::Gemm g{(const bt*)(ws + WS_A2), (const bt*)(ws + WS_WRWO), NLAT, D, D}; pg8::StaticOrder S; S.init(NLAT, D, G, bx);
            float* XR = (float*)(ws + WS_XR);
            pg8::EpiResid E{XR, XR + (size_t)NLAT * D, XR, modp(p, 1, 0, 2), 6144};
            pg8::gemm_phase<pg8::EpiResid, pg8::StaticOrder, true, true>(lds, g, S, E); } break;
        default: break;
    }
}

#define MK_PROLOGUE \
    extern __shared__ __attribute__((aligned(16))) unsigned char lds_raw[]; \
    LAS unsigned char* lds = (LAS unsigned char*)lds_raw; \
    const int tid = threadIdx.x, lane = tid & 63, wave = __builtin_amdgcn_readfirstlane(tid >> 6); \
    const int G = gridDim.x, bx = blockIdx.x, vcu = (G % 8 == 0) ? (bx % 8) * (G / 8) + bx / 8 : bx;

#define XB_TMO      128
#define XB_XCNT(j)  (256  + 64 * (j))
#define XB_XSUB(j)  (1280 + 64 * (j))
#define XB_XGEN(j)  (2304 + 64 * (j))
#define XB_TOP      3328
#define XB_TOPGEN   3392
#define XCD_BAR_WORDS 3456
#define XB_SPIN_CAP (1u << 18)

__device__ __forceinline__ unsigned xb_ld(unsigned* p)              { return __hip_atomic_load(p, __ATOMIC_RELAXED, __HIP_MEMORY_SCOPE_AGENT); }
__device__ __forceinline__ unsigned xb_add(unsigned* p, unsigned v) { return __hip_atomic_fetch_add(p, v, __ATOMIC_RELAXED, __HIP_MEMORY_SCOPE_AGENT); }
__device__ __forceinline__ unsigned xb_xcc_id() { return (unsigned)__builtin_amdgcn_s_getreg((3 << 11) | 20) & 0xFu; }
#define XB_SPIN(cond, bar) do { unsigned _sp = 0; while (cond) { __builtin_amdgcn_s_sleep(1); \
    if ((++_sp & 255u) == 0u) { if (xb_ld(&(bar)[XB_TMO])) break; if (_sp > XB_SPIN_CAP) { atomicAdd(&(bar)[XB_TMO], 1u); break; } } } } while (0)

struct XcdBarrier {
    unsigned* bar; unsigned x;
    volatile LAS unsigned* st;
};

__device__ __forceinline__ XcdBarrier xcd_barrier_post(unsigned* bar, volatile LAS unsigned* st) {
    XcdBarrier b; b.bar = bar; b.x = xb_xcc_id(); b.st = st;
    if (threadIdx.x == 0) (void)xb_add(&bar[XB_XCNT(b.x)], 1u);
    return b;
}
__device__ __forceinline__ void xcd_barrier_complete(unsigned* bar, unsigned x, unsigned& nloc, unsigned& nx) {
    const unsigned G = gridDim.x * gridDim.y * gridDim.z;
    unsigned sum, cnt, mine, sp = 0u;
    for (;;) {
        sum = 0u; cnt = 0u; mine = 0u;
#pragma unroll
        for (unsigned j = 0; j < 16; ++j) { const unsigned c = xb_ld(&bar[XB_XCNT(j)]); sum += c; cnt += (c > 0u) ? 1u : 0u; mine = (j == x) ? c : mine; }
        if (sum == G) break;
        __builtin_amdgcn_s_sleep(1);
        if ((++sp & 255u) == 0u) { if (xb_ld(&bar[XB_TMO])) break; if (sp > XB_SPIN_CAP) { atomicAdd(&bar[XB_TMO], 1u); break; } }
    }
    nloc = mine > 0u ? mine : 1u; nx = cnt > 0u ? cnt : 1u;
}

__device__ __forceinline__ void xcd_barrier(const XcdBarrier& b) {
    asm volatile("s_waitcnt vmcnt(0)" ::: "memory");
    __syncthreads();
    if (threadIdx.x == 0) {
        unsigned* bar = b.bar;
        __builtin_amdgcn_s_waitcnt(0);
        unsigned nloc = b.st[0], nx = b.st[1];
        if (nloc == 0u) { xcd_barrier_complete(bar, b.x, nloc, nx); b.st[0] = nloc; b.st[1] = nx; }
        const unsigned old = xb_add(&bar[XB_XSUB(b.x)], 1u);
        const unsigned gen = old / nloc;
        if (old + 1u == (gen + 1u) * nloc) {
            __builtin_amdgcn_fence(__ATOMIC_RELEASE, "agent");
            asm volatile("s_waitcnt vmcnt(0)" ::: "memory");
            const unsigned og = xb_add(&bar[XB_TOP], 1u);
            const unsigned tg = og / nx;
            if (og + 1u == (tg + 1u) * nx) xb_add(&bar[XB_TOPGEN], 1u);
            else XB_SPIN(xb_ld(&bar[XB_TOPGEN]) == tg, bar);
            __builtin_amdgcn_fence(__ATOMIC_ACQUIRE, "agent");
            xb_add(&bar[XB_XGEN(b.x)], 1u);
            asm volatile("s_waitcnt vmcnt(0)" ::: "memory");
        } else {
            XB_SPIN(xb_ld(&bar[XB_XGEN(b.x)]) == gen, bar);
            __builtin_amdgcn_fence(__ATOMIC_ACQUIRE, "agent");
            asm volatile("s_waitcnt vmcnt(0)" ::: "memory");
        }
    }
    __syncthreads();
}

constexpr int LDSCTL_OFF = 131072, MISC_OFF = LDSCTL_OFF + 320;
__device__ __forceinline__ void grid_bar(PP kp, LAS unsigned char* lds) {
    PP q = kp; asm volatile("" : "+s"(q));
    XcdBarrier b; b.bar = (unsigned*)(q->ws + WS_CTL) + CW_BAR; b.x = xb_xcc_id(); b.st = (volatile LAS unsigned*)(lds + MISC_OFF) + 8;
    xcd_barrier(b);
}
namespace cg = cooperative_groups;
__global__ void __launch_bounds__(NTHREADS, 2) mk_fwd(Params pv) {
    MK_PROLOGUE
    cg::grid_group grid = cg::this_grid();
    PP kp = (PP)__builtin_amdgcn_kernarg_segment_ptr();
    const int lo = kp->ph_lo, hi = kp->ph_hi;
    for (int u = tid; u < (LDS_BYTES - LDSCTL_OFF) / 4; u += NTHREADS) ((LAS unsigned*)(lds + LDSCTL_OFF))[u] = 0u;
    __syncthreads();
    { XcdBarrier b0 = xcd_barrier_post((unsigned*)(kp->ws + WS_CTL) + CW_BAR, (volatile LAS unsigned*)(lds + MISC_OFF) + 8); (void)b0; }
#ifndef REPEAT_MASK
#define REPEAT_MASK 0u
#endif
#define RUN(k) if (lo <= (k) && (k) < hi) { PP q = kp; asm volatile("" : "+s"(q)); run_phase<k>(q, lds, tid, lane, wave, G, bx, vcu); \
        if ((REPEAT_MASK >> (k)) & 1u) { grid_bar(kp, lds); PP q2 = kp; asm volatile("" : "+s"(q2)); run_phase<k>(q2, lds, tid, lane, wave, G, bx, vcu); } \
        if ((k) + 1 < hi) { if ((k) == 0) grid.sync(); else grid_bar(kp, lds); } }
    RUN(0) RUN(1) RUN(2) RUN(3) RUN(4) RUN(5) RUN(6) RUN(7) RUN(8) RUN(9) RUN(10) RUN(11) RUN(12) RUN(13) RUN(14) RUN(15) RUN(16) RUN(17) RUN(18) RUN(19) RUN(20) RUN(21) RUN(22) RUN(23)
#undef RUN
}

extern "C" void kernel_launch(void* const* d_in, const int* in_sizes, int n_in, void* d_out, int out_size, void* d_ws, size_t ws_size, hipStream_t stream) {
    static int grid = 0;
    if (grid == 0) {
        if (n_in != 35 || in_sizes[0] != NLAT * D || out_size != NLAT * D || ws_size < WS_END) {
            fprintf(stderr, "kernel_launch: unexpected problem (n_in %d, in0 %d, out %d, ws %zu < %zu)\n", n_in, n_in > 0 ? in_sizes[0] : -1, out_size, ws_size, (size_t)WS_END); grid = -1; return; }
        int dev = 0, cus = 0, per_cu = 0;
        if (hipGetDevice(&dev) != hipSuccess || hipDeviceGetAttribute(&cus, hipDeviceAttributeMultiprocessorCount, dev) != hipSuccess) { grid = -1; return; }
        if (hipFuncSetAttribute((const void*)mk_fwd, hipFuncAttributeMaxDynamicSharedMemorySize, LDS_BYTES) != hipSuccess) { fprintf(stderr, "kernel_launch: hipFuncSetAttribute failed\n"); grid = -1; return; }
        if (hipOccupancyMaxActiveBlocksPerMultiprocessor(&per_cu, (const void*)mk_fwd, NTHREADS, LDS_BYTES) != hipSuccess || per_cu < 1) { fprintf(stderr, "kernel_launch: occupancy query %d\n", per_cu); per_cu = 1; }
        (void)hipGetLastError();
        grid = cus * (per_cu < 1 ? 1 : per_cu);
    }
    if (grid < 0) return;
    (void)hipMemsetAsync((char*)d_ws + WS_CTL, 0, CTL_ZERO_BYTES, stream);
    Params p{};
    for (int i = 0; i < 35; ++i) p.in[i] = (const float*)d_in[i];
    p.out = (float*)d_out; p.ws = (unsigned char*)d_ws;
    p.ph_lo = 0; p.ph_hi = NPHASES;
    void* args[] = {&p};
    hipError_t e = hipLaunchCooperativeKernel((const void*)mk_fwd, dim3(grid), dim3(NTHREADS), args, LDS_BYTES, stream);
    if (e != hipSuccess) fprintf(stderr, "kernel_launch: cooperative launch failed: %s (grid %d)\n", hipGetErrorString(e), grid);
}
```

```cpp
#include <hip/hip_runtime.h>
#include <hip/hip_cooperative_groups.h>
#include <cstdio>
#include <cstdint>
namespace pg8 {
#define PG8_LAS __attribute__((address_space(3)))
typedef unsigned short bf16_t;
typedef short bf16x8 __attribute__((ext_vector_type(8)));
typedef float f32x4 __attribute__((ext_vector_type(4)));
typedef unsigned u32x4 __attribute__((ext_vector_type(4)));
constexpr int BM = 256, BK = 64, HALF = 128, HTB = HALF * BK * 2  , STAGE_BYTES = 8 * HTB, NXCD = 8, WGM = 8;

__host__ __device__ __forceinline__ int lds_byte(int r, int c) { const int st = (r >> 4) * 2 + (c >> 5), rr = r & 15, cc = c & 31, ob = rr * 64 + cc * 2; return st * 1024 + (ob ^ (((ob >> 9) & 1) << 5)); }
__host__ __device__ __forceinline__ void stage_rc(int b, int& R, int& C) { const int st = b / 1024, sb = b % 1024, swz = sb ^ (((sb >> 9) & 1) << 5); R = (st >> 1) * 16 + swz / 64; C = (st & 1) * 32 + (swz % 64) / 2; }
__host__ __device__ __forceinline__ int perm32(int rho) { const int n = rho >> 4, i = rho & 15; return 8 * (i >> 2) + 4 * n + (i & 3); }

struct Unit { int pm, pn, e; };
struct Gemm { const bf16_t* A; const bf16_t* Bt; int M, N, K; };

struct StaticOrder {
    int nM, nN, nwg, G, c;
    __host__ __device__ void init(int M, int N, int G_, int c_) { nM = M / BM; nN = N / BM; nwg = nM * nN; G = G_; c = c_; }
    __host__ __device__ bool next(int i, Unit& u) const {
        const long L = (long)i * G + c; if (L >= nwg) return false;
        int wgid = (int)L; { const int q = nwg / NXCD, r = nwg % NXCD, xcd = wgid % NXCD, off = wgid / NXCD; wgid = (xcd < r ? xcd * (q + 1) : r * (q + 1) + (xcd - r) * q) + off; }
        const int nig = WGM * nN, gid = wgid / nig, fm = gid * WGM, gsz = (nM - fm) < WGM ? (nM - fm) : WGM;
        u.pm = fm + ((wgid % nig) % gsz); u.pn = (wgid % nig) / gsz; u.e = 0; return true;
    }
    __device__ __forceinline__ const char* abase(const Gemm& g, const Unit& u, size_t tstep) const { return (const char*)g.A + (size_t)u.pm * tstep; }
    __device__ __forceinline__ const char* bbase(const Gemm& g, const Unit& u, size_t tstep) const { return (const char*)g.Bt + (size_t)u.pn * tstep; }
    __device__ __forceinline__ void a_ready(const Unit&) const {}
    __device__ __forceinline__ void done(const Unit&) const {}
};

__device__ __forceinline__ unsigned cvt_pk_bf16(float lo, float hi) { unsigned r; asm volatile("v_cvt_pk_bf16_f32 %0, %1, %2" : "=v"(r) : "v"(lo), "v"(hi)); return r; }

template <class Epi, class Sched, bool ALIGN_EPI = false, bool SP2 = false>
__device__ __forceinline__ void gemm_phase(PG8_LAS unsigned char* lds, const Gemm g, const Sched& S, const Epi& E) {
    const int tid = threadIdx.x, wid = __builtin_amdgcn_readfirstlane(tid >> 6), lane = tid & 63, wr = wid >> 2, wc = wid & 3, fr = lane & 15, fq = lane >> 4;
    const int K = g.K, nt = K / BK;
    unsigned voffA[2], voffB[2];
#pragma unroll
    for (int i = 0; i < 2; ++i) { int R, C; stage_rc(tid * 16 + i * 8192, R, C); const int Rb = Epi::PERM ? ((R & ~31) + perm32(R & 31)) : R;
        voffA[i] = (unsigned)(R * K + C) * 2u; voffB[i] = (unsigned)(Rb * K + C) * 2u; }
    const size_t kstep = (size_t)(BK * 2);
    const size_t hstep = (size_t)HALF * K * 2;
    const size_t tstep = 2 * hstep;
    const unsigned ldsw = (unsigned)wid * 1024u;
    const int aoff = lds_byte(wr * 64 + fr, fq * 8), boff = lds_byte(wc * 32 + fr, fq * 8);
#define PG8_SA(b, h) (((b) * 2 + (h)) * HTB)
#define PG8_SB(b, h) ((4 + (b) * 2 + (h)) * HTB)
#define PG8_STAGE(bufoff, gbase, voff) do { _Pragma("unroll") for (int _i = 0; _i < 2; ++_i) \
        __builtin_amdgcn_global_load_lds((const unsigned*)((const char*)(gbase) + (voff)[_i]), (PG8_LAS unsigned*)(lds + (bufoff) + ldsw + _i * 8192), 16, 0, 0); } while (0)
#define PG8_LDA(dst, b, h) do { _Pragma("unroll") for (int m = 0; m < 4; ++m) _Pragma("unroll") for (int k = 0; k < 2; ++k) dst[m][k] = *(const PG8_LAS bf16x8*)(lds + PG8_SA(b, h) + aoff + m * 2048 + k * 1024); } while (0)
#define PG8_LDB(dst, b, h) do { _Pragma("unroll") for (int n = 0; n < 2; ++n) _Pragma("unroll") for (int k = 0; k < 2; ++k) dst[n][k] = *(const PG8_LAS bf16x8*)(lds + PG8_SB(b, h) + boff + n * 2048 + k * 1024); } while (0)
#define PG8_MMA(ai, bj, At, Bt) do { __builtin_amdgcn_s_setprio(1); _Pragma("unroll") for (int m = 0; m < 4; ++m) _Pragma("unroll") for (int n = 0; n < 2; ++n) _Pragma("unroll") for (int k = 0; k < 2; ++k) \
        acc[ai][bj][m][n] = __builtin_amdgcn_mfma_f32_16x16x32_bf16(Bt[n][k], At[m][k], acc[ai][bj][m][n], 0, 0, 0); __builtin_amdgcn_s_setprio(0); } while (0)
#define PG8_WAIT_V(n) asm volatile("s_waitcnt vmcnt(" #n ")" ::: "memory")
#define PG8_WAIT_L(n) asm volatile("s_waitcnt lgkmcnt(" #n ")" ::: "memory")
#define PG8_BAR __builtin_amdgcn_s_barrier()
#define PG8_SCHED __builtin_amdgcn_sched_barrier(0)
    Unit cur, nxt; int ui = 0;
    if (!S.next(0, cur)) return;
    f32x4 acc[2][2][4][2];
#pragma unroll
    for (int a = 0; a < 2; ++a)
#pragma unroll
        for (int b = 0; b < 2; ++b)
#pragma unroll
            for (int m = 0; m < 4; ++m)
#pragma unroll
                for (int n = 0; n < 2; ++n) acc[a][b][m][n] = (f32x4){0.f, 0.f, 0.f, 0.f};
    bf16x8 At[4][2], B0[2][2], B1[2][2];
    const char* cA = S.abase(g, cur, tstep); const char* cB = S.bbase(g, cur, tstep);
    S.a_ready(cur);
    if constexpr (SP2) {
        PG8_STAGE(PG8_SB(0, 0), cB, voffB); PG8_STAGE(PG8_SB(0, 1), cB + hstep, voffB); PG8_STAGE(PG8_SA(0, 0), cA, voffA); PG8_STAGE(PG8_SA(0, 1), cA + hstep, voffA);
        if (wr == 1) PG8_BAR;
        PG8_WAIT_V(2); PG8_BAR;
        PG8_STAGE(PG8_SB(1, 0), cB + kstep, voffB); PG8_STAGE(PG8_SA(1, 0), cA + kstep, voffA); PG8_STAGE(PG8_SB(1, 1), cB + hstep + kstep, voffB);
        PG8_WAIT_V(6); PG8_BAR;
    } else {
        PG8_STAGE(PG8_SB(0, 0), cB, voffB); PG8_STAGE(PG8_SA(0, 0), cA, voffA); PG8_STAGE(PG8_SB(0, 1), cB + hstep, voffB); PG8_STAGE(PG8_SA(0, 1), cA + hstep, voffA);
        if (wr == 1) PG8_BAR;
        PG8_WAIT_V(4); PG8_BAR;
        PG8_STAGE(PG8_SB(1, 0), cB + kstep, voffB); PG8_STAGE(PG8_SA(1, 0), cA + kstep, voffA); PG8_STAGE(PG8_SB(1, 1), cB + hstep + kstep, voffB);
        PG8_WAIT_V(6); PG8_BAR;
    }
    for (;;) {
        const bool has_next = S.next(ui + 1, nxt);
        const char* nA = has_next ? S.abase(g, nxt, tstep) : cA; const char* nB = has_next ? S.bbase(g, nxt, tstep) : cB;
        _Pragma("unroll 1") for (int t = 0; t < nt; t += 2) {
            const bool last = (t == nt - 2);
            const char* a1 = cA + (size_t)(t + 1) * kstep;
            const char* a2 = last ? nA : cA + (size_t)(t + 2) * kstep; const char* b2 = last ? nB : cB + (size_t)(t + 2) * kstep;
            const char* a3 = a2 + kstep; const char* b3 = b2 + kstep;
            if (last && has_next) S.a_ready(nxt);
            if constexpr (SP2) {
            PG8_LDB(B0, 0, 0); PG8_LDB(B1, 0, 1); PG8_SCHED; PG8_LDA(At, 0, 0); PG8_STAGE(PG8_SA(1, 1), a1 + hstep, voffA);
            PG8_WAIT_V(8); PG8_WAIT_L(0); PG8_BAR; PG8_MMA(0, 0, At, B0); PG8_MMA(0, 1, At, B1); PG8_BAR; PG8_SCHED;
            PG8_LDA(At, 0, 1); PG8_STAGE(PG8_SB(0, 0), b2, voffB); PG8_STAGE(PG8_SB(0, 1), b2 + hstep, voffB); PG8_STAGE(PG8_SA(0, 0), a2, voffA);
            PG8_WAIT_V(8); PG8_WAIT_L(0); PG8_BAR; PG8_MMA(1, 0, At, B0); PG8_MMA(1, 1, At, B1); PG8_BAR; PG8_SCHED;
            PG8_LDB(B0, 1, 0); PG8_LDB(B1, 1, 1); PG8_SCHED; PG8_LDA(At, 1, 0); PG8_STAGE(PG8_SA(0, 1), a2 + hstep, voffA);
            PG8_WAIT_V(8); PG8_WAIT_L(0); PG8_BAR; PG8_MMA(0, 0, At, B0); PG8_MMA(0, 1, At, B1); PG8_BAR; PG8_SCHED;
            PG8_LDA(At, 1, 1); PG8_STAGE(PG8_SB(1, 0), b3, voffB); PG8_STAGE(PG8_SB(1, 1), b3 + hstep, voffB); PG8_STAGE(PG8_SA(1, 0), a3, voffA);
            PG8_WAIT_V(8); PG8_WAIT_L(0); PG8_BAR; PG8_MMA(1, 0, At, B0); PG8_MMA(1, 1, At, B1); PG8_BAR; PG8_SCHED;
            } else {
            PG8_LDB(B0, 0, 0); PG8_SCHED; PG8_LDA(At, 0, 0); PG8_STAGE(PG8_SA(1, 1), a1 + hstep, voffA);
            PG8_WAIT_L(8); PG8_BAR; PG8_WAIT_L(0); PG8_MMA(0, 0, At, B0); PG8_BAR; PG8_SCHED;
            PG8_LDB(B1, 0, 1); PG8_STAGE(PG8_SB(0, 0), b2, voffB);
            PG8_BAR; PG8_WAIT_L(0); PG8_MMA(0, 1, At, B1); PG8_BAR;
            PG8_LDA(At, 0, 1); PG8_STAGE(PG8_SA(0, 0), a2, voffA);
            PG8_BAR; PG8_WAIT_L(0); PG8_MMA(1, 0, At, B0); PG8_BAR; PG8_SCHED;
            PG8_STAGE(PG8_SB(0, 1), b2 + hstep, voffB);
            PG8_WAIT_V(6); PG8_BAR; PG8_MMA(1, 1, At, B1); PG8_BAR;
            PG8_LDB(B0, 1, 0); PG8_SCHED; PG8_LDA(At, 1, 0); PG8_STAGE(PG8_SA(0, 1), a2 + hstep, voffA);
            PG8_WAIT_L(8); PG8_BAR; PG8_WAIT_L(0); PG8_MMA(0, 0, At, B0); PG8_BAR; PG8_SCHED;
            PG8_LDB(B1, 1, 1); PG8_STAGE(PG8_SB(1, 0), b3, voffB);
            PG8_BAR; PG8_WAIT_L(0); PG8_MMA(0, 1, At, B1); PG8_BAR;
            PG8_LDA(At, 1, 1); PG8_STAGE(PG8_SA(1, 0), a3, voffA);
            PG8_BAR; PG8_WAIT_L(0); PG8_MMA(1, 0, At, B0); PG8_BAR; PG8_SCHED;
            PG8_STAGE(PG8_SB(1, 1), b3 + hstep, voffB);
            PG8_WAIT_V(6); PG8_BAR; PG8_MMA(1, 1, At, B1); PG8_BAR;
            }
        }
        if constexpr (ALIGN_EPI) { if (wr == 0) PG8_BAR; }
        if constexpr (!Epi::AFTER_DRAIN) { E(acc, cur, wr, wc, fr, fq); S.done(cur); }
        if (!has_next) break;
#pragma unroll
        for (int a = 0; a < 2; ++a)
#pragma unroll
            for (int b = 0; b < 2; ++b)
#pragma unroll
                for (int m = 0; m < 4; ++m)
#pragma unroll
                    for (int n = 0; n < 2; ++n) acc[a][b][m][n] = (f32x4){0.f, 0.f, 0.f, 0.f};
        cur = nxt; cA = nA; cB = nB; ++ui;
        if constexpr (ALIGN_EPI) { if (wr == 1) PG8_BAR; }
    }
    PG8_WAIT_V(0);
    if constexpr (!ALIGN_EPI) { if (wr == 0) PG8_BAR; }
    PG8_BAR;
    if constexpr (Epi::AFTER_DRAIN) { E.fused(acc, cur, wr, wc, fr, fq, lds, wid, lane); S.done(cur); }
#undef PG8_SA
#undef PG8_SB
#undef PG8_STAGE
#undef PG8_LDA
#undef PG8_LDB
#undef PG8_MMA
#undef PG8_WAIT_V
#undef PG8_WAIT_L
#undef PG8_BAR
#undef PG8_SCHED
}
}

constexpr int D = 1024, NBATCH = 2, SEQ = 8192, CTXL = 256;
constexpr int NLAT = NBATCH * SEQ, NCTX = NBATCH * CTXL, NROW = NLAT + NCTX;
constexpr int NE = 32, TOPK = 4, MAXTILES = 296, CAP = MAXTILES * 256;
constexpr int NWAVES = 8, NTHREADS = 512;
constexpr float NORM_EPS = 1e-6f;
constexpr int LDS_BYTES = 147456;

constexpr size_t MiB = 1u << 20;
constexpr size_t WS_CTL = 0, CTL_ZERO_BYTES = 1 * MiB;
constexpr size_t WS_MOD = 1 * MiB;
constexpr size_t WS_ROUTE = 2 * MiB;
constexpr size_t RT_TOPI = 0, RT_TOPG = 320 * 1024, RT_POS = 640 * 1024, RT_SLOT = 960 * 1024, RT_RSTD = 1280 * 1024, RT_TILEE = 1408 * 1024;
constexpr size_t WS_WIN = 4 * MiB, WS_WHGO = 14 * MiB, WS_WRKV = 16 * MiB, WS_WL1 = 22 * MiB, WS_WL2 = 24 * MiB, WS_WRWO = 28 * MiB;
constexpr size_t WS_WGU = 32 * MiB, WS_WD = 288 * MiB;
constexpr size_t WS_XR = 416 * MiB, WS_H = 482 * MiB, WS_H2 = 515 * MiB, WS_A2 = 548 * MiB;
constexpr size_t WS_U = 584 * MiB;
constexpr size_t U_Z = 0, U_OD0 = 166 * MiB;
constexpr size_t U_XL6 = 0, U_RKV = 198 * MiB, U_L1 = 396 * MiB, U_WD = 410 * MiB, U_AD = 542 * MiB, U_G = 674 * MiB, U_OD1 = 740 * MiB;
constexpr size_t U_XB = 0, U_ACT = 148 * MiB, U_YS = 296 * MiB;
constexpr size_t WS_END = WS_U + 1320 * MiB;
constexpr int CW_CNT = 64;
constexpr int CW_BAR = 4096;

#define LAS __attribute__((address_space(3)))
typedef unsigned short bf16;
typedef unsigned v4u __attribute__((ext_vector_type(4)));
typedef unsigned v2u __attribute__((ext_vector_type(2)));
typedef float f32x4 __attribute__((ext_vector_type(4)));
#define LDS_WAIT() asm volatile("s_waitcnt lgkmcnt(0)" ::: "memory")
__device__ __forceinline__ unsigned f2bf(float f) { unsigned u = __builtin_bit_cast(unsigned, f); return (u + 0x7fffu + ((u >> 16) & 1u)) >> 16; }
__device__ __forceinline__ unsigned pk2(float lo, float hi) { return f2bf(lo) | (f2bf(hi) << 16); }
__device__ __forceinline__ float bf2f(unsigned b) { return __builtin_bit_cast(float, b << 16); }
__device__ __forceinline__ float wave_sum(float v) {
#pragma unroll
    for (int o = 1; o < 64; o <<= 1) v += __shfl_xor(v, o);
    return v;
}
__device__ __forceinline__ float sigm(float x) { return 1.0f / (1.0f + __expf(-x)); }

struct Params { const float* in[35]; float* out; unsigned char* ws; int ph_lo, ph_hi; };
typedef const __attribute__((address_space(4))) Params* PP;
enum { I_X = 0, I_C, I_CTX, I_CCTX, I_ADAW, I_ADAB, I_NMIX, I_NFFN, I_HGWIN, I_HGGN, I_HGWOUT, I_HGLB, I_MU, I_WRKV, I_DECW0, I_DECW1, I_DECW2,
       I_A0, I_A1, I_A2, I_G1, I_G2, I_KK, I_KA, I_RK, I_LNXW, I_LNXB, I_RWOUT, I_ROUTW, I_ROUTB, I_WGU, I_BGU, I_WDN, I_BDN, I_FINALG };

__device__ __forceinline__ const float* modp(PP p, int l, int v, int j) { return (const float*)(p->ws + WS_MOD) + ((size_t)(l * 3 + v) * 6 + j) * D; }
__device__ __forceinline__ int row_vec(int row) { return row < NLAT ? (row >= SEQ ? 1 : 0) : 2; }

__device__ __forceinline__ void transpose_item(const float* src, int src_ld, bf16* dst, int dst_ld, LAS float* scr, int lane) {
    if (src) {
#pragma unroll 8
        for (int i = 0; i < 32; ++i) { const int kk = 2 * i + (lane >> 5); scr[kk * 33 + (lane & 31)] = src[(size_t)kk * src_ld + (lane & 31)]; }
    }
    LDS_WAIT(); asm volatile("" ::: "memory");
    const int c = lane & 7;
#pragma unroll
    for (int j = 0; j < 4; ++j) {
        const int n = (lane >> 3) + 8 * j; v4u o = (v4u){0u, 0u, 0u, 0u};
        if (src) { const LAS float* s = scr + (8 * c) * 33 + n;
            o.x = pk2(s[0 * 33], s[1 * 33]); o.y = pk2(s[2 * 33], s[3 * 33]); o.z = pk2(s[4 * 33], s[5 * 33]); o.w = pk2(s[6 * 33], s[7 * 33]); }
        *(v4u*)(dst + (size_t)n * dst_ld + 8 * c) = o;
    }
    LDS_WAIT(); asm volatile("" ::: "memory");
}
__device__ __forceinline__ void conv_plain(const float* W, int K, int N, bf16* WT, int r, LAS float* scr, int lane) {
    const int nblk = N / 32, kb = r / nblk, nb = r % nblk;
    transpose_item(W + (size_t)(kb * 64) * N + nb * 32, N, WT + (size_t)(nb * 32) * K + kb * 64, K, scr, lane);
}
constexpr int IT_WIN = 16 * 160, IT_SQ = 16 * 32, IT_L1 = 16 * 24, IT_L2 = 160 * 6, IT_GU = 64 * 16 * 64, IT_DN = 64 * 16 * 32;
constexpr int IT_TOTAL = IT_WIN + IT_SQ + 3 * IT_SQ + IT_SQ + IT_L1 + IT_L2 + IT_GU + IT_DN;
__device__ __forceinline__ void convert_item(PP p, int it, LAS float* scr, int lane) {
    unsigned char* ws = p->ws; int r = it;
    if (r < IT_WIN) { conv_plain(p->in[I_HGWIN], D, 5120, (bf16*)(ws + WS_WIN), r, scr, lane); return; } r -= IT_WIN;
    if (r < IT_SQ) { conv_plain(p->in[I_HGWOUT], D, D, (bf16*)(ws + WS_WHGO), r, scr, lane); return; } r -= IT_SQ;
    if (r < 3 * IT_SQ) { const int j = r / IT_SQ; conv_plain(p->in[I_WRKV] + (size_t)j * D * D, D, D, (bf16*)(ws + WS_WRKV) + (size_t)j * D * D, r % IT_SQ, scr, lane); return; } r -= 3 * IT_SQ;
    if (r < IT_SQ) { conv_plain(p->in[I_RWOUT], D, D, (bf16*)(ws + WS_WRWO), r, scr, lane); return; } r -= IT_SQ;
    if (r < IT_L1) {
        const int kb = r / 24, rg = r % 24, tile = rg >> 3, within = rg & 7; const float* src = nullptr; int ld = 64;
        if (within < 4) {
            if (tile == 0) src = p->in[I_DECW1] + (size_t)(within >> 1) * D * 64 + (size_t)(kb * 64) * 64 + (within & 1) * 32;
            else if (tile == 1) src = p->in[I_A1] + (size_t)(within >> 1) * D * 64 + (size_t)(kb * 64) * 64 + (within & 1) * 32;
            else { src = p->in[I_G1] + (size_t)(kb * 64) * 128 + within * 32; ld = 128; }
        }
        transpose_item(src, ld, (bf16*)(ws + WS_WL1) + (size_t)(rg * 32) * D + kb * 64, D, scr, lane); return; } r -= IT_L1;
    if (r < IT_L2) {
        const int rg = r / 6, kb = r % 6, n0 = rg * 32, blk = n0 >> 10, nn0 = n0 & 1023; const float* src = nullptr;
        if (blk < 2) { if (kb == blk) src = p->in[I_DECW2] + (size_t)blk * 64 * D + nn0; }
        else if (blk < 4) { if (kb == blk) src = p->in[I_A2] + (size_t)(blk - 2) * 64 * D + nn0; }
        else { if (kb >= 4) src = p->in[I_G2] + (size_t)(kb - 4) * 64 * D + nn0; }
        transpose_item(src, D, (bf16*)(ws + WS_WL2) + (size_t)n0 * 384 + kb * 64, 384, scr, lane); return; } r -= IT_L2;
    if (r < IT_GU) {
        const int mat = r >> 10, q = r & 1023, kb = q >> 6, nb = q & 63, n0 = nb * 32;
        const int j0 = n0 & 1023, drow = 256 * (j0 >> 7) + (n0 >= 1024 ? 128 : 0) + (j0 & 127);
        transpose_item(p->in[I_WGU] + (size_t)mat * D * 2048 + (size_t)(kb * 64) * 2048 + n0, 2048, (bf16*)(ws + WS_WGU) + (size_t)mat * 2048 * D + (size_t)drow * D + kb * 64, D, scr, lane); return; } r -= IT_GU;
    { const int mat = r >> 9, q = r & 511;
      conv_plain(p->in[I_WDN] + (size_t)mat * D * D, D, D, (bf16*)(ws + WS_WD) + (size_t)mat * D * D, q, scr, lane); }
}
__device__ __forceinline__ void phase_pre(PP p, LAS unsigned char* lds, int tid, int lane, int wave) {
    if (blockIdx.x < 192) {
        const int layer = blockIdx.x / 96, col = (blockIdx.x % 96) * 64 + lane;
        const float* W = p->in[I_ADAW] + (size_t)layer * D * 6144 + col;
        const float* c = p->in[I_C]; const float* cc = p->in[I_CCTX];
        float a0 = 0.f, a1 = 0.f, a2 = 0.f;
#pragma unroll 8
        for (int k = wave * 128; k < wave * 128 + 128; ++k) {
            const float wv = W[(size_t)k * 6144]; const float c0 = c[k], c1 = c[D + k], c2 = cc[k];
            a0 += c0 * sigm(c0) * wv; a1 += c1 * sigm(c1) * wv; a2 += c2 * sigm(c2) * wv;
        }
        LAS float* red = (LAS float*)lds;
        red[(wave * 3 + 0) * 64 + lane] = a0; red[(wave * 3 + 1) * 64 + lane] = a1; red[(wave * 3 + 2) * 64 + lane] = a2;
        __syncthreads();
        if (wave == 0) {
            float s0 = 0.f, s1 = 0.f, s2 = 0.f;
#pragma unroll
            for (int w = 0; w < 8; ++w) { s0 += red[(w * 3 + 0) * 64 + lane]; s1 += red[(w * 3 + 1) * 64 + lane]; s2 += red[(w * 3 + 2) * 64 + lane]; }
            const float bb = p->in[I_ADAB][layer * 6144 + col];
            float* M = (float*)(p->ws + WS_MOD) + (size_t)layer * 3 * 6144 + col;
            M[0] = s0 + bb; M[6144] = s1 + bb; M[2 * 6144] = s2 + bb;
        }
        __syncthreads();
    }
    LAS float* scr = (LAS float*)(lds + wave * 16384);
    const int gw = blockIdx.x * NWAVES + wave, NGW = gridDim.x * NWAVES;
    for (int it = gw; it < IT_TOTAL; it += NGW) convert_item(p, it, scr, lane);
}

__device__ __forceinline__ void load_row(const float* row, int lane, f32x4 (&v)[4]) {
#pragma unroll
    for (int j = 0; j < 4; ++j) v[j] = ((const f32x4*)row)[lane + 64 * j];
}
__device__ __forceinline__ float row_rstd(const f32x4 (&v)[4]) {
    float s = 0.f;
#pragma unroll
    for (int j = 0; j < 4; ++j) s += (v[j].x * v[j].x + v[j].y * v[j].y) + (v[j].z * v[j].z + v[j].w * v[j].w);
    return rsqrtf(wave_sum(s) * (1.0f / D) + NORM_EPS);
}
__device__ __forceinline__ void norm_mod(const f32x4 (&v)[4], float rstd, const float* g, const float* shift, const float* scale, int lane, f32x4 (&h)[4]) {
#pragma unroll
    for (int j = 0; j < 4; ++j) {
        const f32x4 gg = ((const f32x4*)g)[lane + 64 * j], sh = ((const f32x4*)shift)[lane + 64 * j], sc = ((const f32x4*)scale)[lane + 64 * j];
        h[j] = v[j] * rstd * gg * (sc + 1.0f) + sh;
    }
}
__device__ __forceinline__ void store_row_bf16(bf16* row, int lane, const f32x4 (&h)[4]) {
#pragma unroll
    for (int j = 0; j < 4; ++j) { v2u w; w.x = pk2(h[j].x, h[j].y); w.y = pk2(h[j].z, h[j].w); ((v2u*)row)[lane + 64 * j] = w; }
}
__device__ __forceinline__ const float* resid_row(PP p, int layer0_inputs, int row) {
    if (layer0_inputs) return row < NLAT ? p->in[I_X] + (size_t)row * D : p->in[I_CTX] + (size_t)(row - NLAT) * D;
    return (const float*)(p->ws + WS_XR) + (size_t)row * D;
}
__device__ __forceinline__ void phase_norm0(PP p, int lane, int wave) {
    const int gw = blockIdx.x * NWAVES + wave, NGW = gridDim.x * NWAVES;
    for (int row = gw; row < NROW; row += NGW) {
        f32x4 v[4], h[4]; load_row(resid_row(p, 1, row), lane, v);
        const float rstd = row_rstd(v); const int vec = row_vec(row);
        norm_mod(v, rstd, p->in[I_NMIX], modp(p, 0, vec, 0), modp(p, 0, vec, 1), lane, h);
        store_row_bf16((bf16*)(p->ws + WS_H) + (size_t)row * D, lane, h);
    }
}
__device__ __forceinline__ void phase_ffn_norm_route(PP p, int layer, int nrows, int lane, int wave) {
    const int gw = blockIdx.x * NWAVES + wave, NGW = gridDim.x * NWAVES;
    const float* rw = p->in[I_ROUTW] + (size_t)layer * D * NE; const float* rb = p->in[I_ROUTB] + layer * NE;
    int* TOPI = (int*)(p->ws + WS_ROUTE + RT_TOPI); float* TOPG = (float*)(p->ws + WS_ROUTE + RT_TOPG); int* POS = (int*)(p->ws + WS_ROUTE + RT_POS);
    unsigned* cnt = (unsigned*)(p->ws + WS_CTL) + CW_CNT + layer * NE;
    for (int row = gw; row < nrows; row += NGW) {
        f32x4 v[4], h[4]; load_row((const float*)(p->ws + WS_XR) + (size_t)row * D, lane, v);
        const float rstd = row_rstd(v); const int vec = row_vec(row);
        norm_mod(v, rstd, p->in[I_NFFN] + layer * D, modp(p, layer, vec, 3), modp(p, layer, vec, 4), lane, h);
        store_row_bf16((bf16*)(p->ws + WS_H2) + (size_t)row * D, lane, h);
        float part[NE];
#pragma unroll
        for (int e = 0; e < NE; ++e) part[e] = 0.f;
#pragma unroll
        for (int j = 0; j < 4; ++j)
#pragma unroll
            for (int i = 0; i < 4; ++i) {
                const float hv = h[j][i]; const f32x4* wr = (const f32x4*)(rw + (size_t)(4 * lane + 256 * j + i) * NE);
#pragma unroll
                for (int q = 0; q < 8; ++q) { const f32x4 w4 = wr[q]; part[4 * q + 0] += hv * w4.x; part[4 * q + 1] += hv * w4.y; part[4 * q + 2] += hv * w4.z; part[4 * q + 3] += hv * w4.w; }
            }
#pragma unroll
        for (int e = 0; e < NE; ++e) part[e] = wave_sum(part[e]) + rb[e];
        unsigned taken = 0u; int idx[TOPK]; float val[TOPK];
#pragma unroll
        for (int k = 0; k < TOPK; ++k) {
            float best = -3.0e38f; int bi = 0;
#pragma unroll
            for (int e = 0; e < NE; ++e) { const bool ok = !((taken >> e) & 1u) && (part[e] > best); best = ok ? part[e] : best; bi = ok ? e : bi; }
            taken |= 1u << bi; idx[k] = bi; val[k] = best;
        }
        float ex[TOPK], se = 0.f;
#pragma unroll
        for (int k = 0; k < TOPK; ++k) { ex[k] = __expf(val[k] - val[0]); se += ex[k]; }
        if (lane == 0) {
#pragma unroll
            for (int k = 0; k < TOPK; ++k) {
                TOPI[row * 4 + k] = idx[k]; TOPG[row * 4 + k] = ex[k] / se;
                POS[row * 4 + k] = (int)atomicAdd(cnt + idx[k], 1u);
            }
        }
    }
}
__device__ __forceinline__ void phase_gather(PP p, int layer, int nrows, LAS unsigned char* lds, int tid, int lane, int wave) {
    LAS int* off = (LAS int*)lds;
    const unsigned* cnt = (const unsigned*)(p->ws + WS_CTL) + CW_CNT + layer * NE;
    int* TILEE = (int*)(p->ws + WS_ROUTE + RT_TILEE);
    if (tid == 0) {
        int o = 0;
        for (int e = 0; e < NE; ++e) { off[e] = o; const int nt = ((int)__hip_atomic_load(cnt + e, __ATOMIC_RELAXED, __HIP_MEMORY_SCOPE_AGENT) + 255) >> 8;
            if (blockIdx.x == 0) for (int t = 0; t < nt; ++t) TILEE[1 + (o >> 8) + t] = e;
            o += nt << 8; }
        off[NE] = o; if (blockIdx.x == 0) TILEE[0] = o >> 8;
    }
    __syncthreads();
    const int* TOPI = (const int*)(p->ws + WS_ROUTE + RT_TOPI); const int* POS = (const int*)(p->ws + WS_ROUTE + RT_POS); int* SLOT = (int*)(p->ws + WS_ROUTE + RT_SLOT);
    const bf16* H2 = (const bf16*)(p->ws + WS_H2); bf16* XB = (bf16*)(p->ws + WS_U + U_XB);
    const int gw = blockIdx.x * NWAVES + wave, NGW = gridDim.x * NWAVES;
    for (int it = gw; it < nrows * TOPK; it += NGW) {
        const int row = it >> 2; const int slot = off[TOPI[it]] + POS[it];
        if (lane == 0) SLOT[it] = slot;
        const v4u* s = (const v4u*)(H2 + (size_t)row * D); v4u* d = (v4u*)(XB + (size_t)slot * D);
        d[lane] = s[lane]; d[lane + 64] = s[lane + 64];
    }
    __syncthreads();
}
__device__ __forceinline__ void phase_combine(PP p, int layer, int nrows, bool final_out, int lane, int wave) {
    const int gw = blockIdx.x * NWAVES + wave, NGW = gridDim.x * NWAVES;
    const float* TOPG = (const float*)(p->ws + WS_ROUTE + RT_TOPG); const int* SLOT = (const int*)(p->ws + WS_ROUTE + RT_SLOT);
    const bf16* YS = (const bf16*)(p->ws + WS_U + U_YS); float* XR = (float*)(p->ws + WS_XR); float* RSTD = (float*)(p->ws + WS_ROUTE + RT_RSTD);
    for (int row = gw; row < nrows; row += NGW) {
        f32x4 v[4], acc[4]; load_row(XR + (size_t)row * D, lane, v);
#pragma unroll
        for (int j = 0; j < 4; ++j) acc[j] = (f32x4){0.f, 0.f, 0.f, 0.f};
#pragma unroll
        for (int k = 0; k < TOPK; ++k) {
            const float gk = TOPG[row * 4 + k]; const v2u* ys = (const v2u*)(YS + (size_t)SLOT[row * 4 + k] * D);
#pragma unroll
            for (int j = 0; j < 4; ++j) { const v2u w = ys[lane + 64 * j];
                acc[j].x += gk * bf2f(w.x & 0xffffu); acc[j].y += gk * bf2f(w.x >> 16); acc[j].z += gk * bf2f(w.y & 0xffffu); acc[j].w += gk * bf2f(w.y >> 16); }
        }
        const float* m5 = modp(p, layer, row_vec(row), 5);
#pragma unroll
        for (int j = 0; j < 4; ++j) v[j] = v[j] + ((const f32x4*)m5)[lane + 64 * j] * acc[j];
        const float rstd = row_rstd(v);
        if (final_out) {
#pragma unroll
            for (int j = 0; j < 4; ++j) ((f32x4*)(p->out + (size_t)row * D))[lane + 64 * j] = v[j] * rstd * ((const f32x4*)p->in[I_FINALG])[lane + 64 * j];
        } else {
#pragma unroll
            for (int j = 0; j < 4; ++j) ((f32x4*)(XR + (size_t)row * D))[lane + 64 * j] = v[j];
            if (lane == 0) RSTD[row] = rstd;
        }
    }
}

__device__ __forceinline__ int step_row(int b, int dir, int step) {
    if (step < CTXL) { const int t = dir ? (CTXL - 1 - step) : step; return NLAT + b * CTXL + t; }
    const int s = step - CTXL; const int t = dir ? (SEQ - 1 - s) : s; return b * SEQ + t;
}
constexpr int NSTEP = CTXL + SEQ;

__device__ __forceinline__ void phase_gla_naive(PP p, LAS unsigned char* lds, int tid) {
    if (blockIdx.x >= 8) return;
    const int ci = tid >> 7, v = tid & 127, chain = blockIdx.x * 4 + ci, b = chain >> 4, dir = (chain >> 3) & 1, h = chain & 7;
    const bf16* Z = (const bf16*)(p->ws + WS_U + U_Z); float* OD = (float*)(p->ws + WS_U + U_OD0) + (size_t)dir * NROW * D;
    float lbv; { const float* lb = p->in[I_HGLB] + (size_t)dir * 3 * D + h * 128 + v; const float a0 = lb[0], a1 = lb[D], a2 = lb[2 * D];
                 const float m = fmaxf(a0, fmaxf(a1, a2)); const float e0 = __expf(a0 - m), e1 = __expf(a1 - m), e2 = __expf(a2 - m); lbv = e0 / (e0 + e1 + e2); }
    LAS float* LF = (LAS float*)lds;
    LAS float* LQ = (LAS float*)(lds + 4096);
    float S[128];
#pragma unroll
    for (int k = 0; k < 128; ++k) S[k] = 0.f;
    int row = step_row(b, dir, 0);
    unsigned zf = Z[(size_t)row * 5120 + 1024 * (1 + dir) + h * 128 + v], zq = Z[(size_t)row * 5120 + h * 128 + v], zv = Z[(size_t)row * 5120 + 3072 + h * 128 + v];
    for (int step = 0; step < NSTEP; ++step) {
        const float fh = bf2f(zf), qv = bf2f(zq), vv = bf2f(zv); const int crow = row;
        if (step + 1 < NSTEP) { row = step_row(b, dir, step + 1);
            zf = Z[(size_t)row * 5120 + 1024 * (1 + dir) + h * 128 + v]; zq = Z[(size_t)row * 5120 + h * 128 + v]; zv = Z[(size_t)row * 5120 + 3072 + h * 128 + v]; }
        const int buf = step & 1;
        LF[(buf * 4 + ci) * 128 + v] = lbv + (1.f - lbv) * sigm(fh); LQ[(buf * 4 + ci) * 128 + v] = qv * sigm(qv);
        __syncthreads();
        const LAS f32x4* f4 = (const LAS f32x4*)(LF + (buf * 4 + ci) * 128); const LAS f32x4* q4 = (const LAS f32x4*)(LQ + (buf * 4 + ci) * 128);
        float o0 = 0.f, o1 = 0.f;
#pragma unroll
        for (int k4 = 0; k4 < 32; ++k4) { const f32x4 f = f4[k4], q = q4[k4];
            S[4 * k4 + 0] = vv + f.x * (S[4 * k4 + 0] - vv); o0 += q.x * S[4 * k4 + 0];
            S[4 * k4 + 1] = vv + f.y * (S[4 * k4 + 1] - vv); o1 += q.y * S[4 * k4 + 1];
            S[4 * k4 + 2] = vv + f.z * (S[4 * k4 + 2] - vv); o0 += q.z * S[4 * k4 + 2];
            S[4 * k4 + 3] = vv + f.w * (S[4 * k4 + 3] - vv); o1 += q.w * S[4 * k4 + 3]; if ((k4 & 3) == 3) asm volatile("" ::: "memory"); }
        OD[(size_t)crow * D + h * 128 + v] = o0 + o1;
    }
}
__device__ __forceinline__ void phase_hg_readout(PP p, int lane, int wave) {
    const int gw = blockIdx.x * NWAVES + wave, NGW = gridDim.x * NWAVES;
    const bf16* Z = (const bf16*)(p->ws + WS_U + U_Z); const float* OD = (const float*)(p->ws + WS_U + U_OD0); bf16* A2 = (bf16*)(p->ws + WS_A2);
    const float* gn = p->in[I_HGGN];
    for (int row = gw; row < NROW; row += NGW) {
#pragma unroll
        for (int h = 0; h < 8; ++h) {
            const int c = h * 128 + 2 * lane;
            const float2 a = *(const float2*)(OD + (size_t)row * D + c), bq = *(const float2*)(OD + (size_t)(NROW + row) * D + c);
            const float o0 = a.x + bq.x, o1 = a.y + bq.y;
            const float rstd = rsqrtf(wave_sum(o0 * o0 + o1 * o1) * (1.0f / 128.0f) + NORM_EPS);
            const unsigned gz = *(const unsigned*)(Z + (size_t)row * 5120 + 4096 + c); const float g0 = bf2f(gz & 0xffffu), g1 = bf2f(gz >> 16);
            const float r0 = o0 * rstd * gn[2 * lane] * (g0 * sigm(g0)), r1 = o1 * rstd * gn[2 * lane + 1] * (g1 * sigm(g1));
            *(unsigned*)(A2 + (size_t)row * D + c) = pk2(r0, r1);
        }
    }
}

__device__ __forceinline__ void phase_lerp(PP p, int lane, int wave) {
    const int gw = blockIdx.x * NWAVES + wave, NGW = gridDim.x * NWAVES;
    const float* XR = (const float*)(p->ws + WS_XR); const float* RSTD = (const float*)(p->ws + WS_ROUTE + RT_RSTD);
    bf16* XL6 = (bf16*)(p->ws + WS_U + U_XL6); const float* g = p->in[I_NMIX] + D; const float* mu = p->in[I_MU];
    for (int row = gw; row < NROW; row += NGW) {
        const int vec = row_vec(row); const float* sh = modp(p, 1, vec, 0); const float* sc = modp(p, 1, vec, 1);
        int nb[4];
        if (row < NLAT) { const int t = row & (SEQ - 1), w = t & 63, r = t >> 6;
            nb[0] = (w >= 1) ? row - 1 : -1; nb[1] = (w < 63) ? row + 1 : -1; nb[2] = (r >= 1) ? row - 64 : -1; nb[3] = (r < SEQ / 64 - 1) ? row + 64 : -1;
        } else { const int t = (row - NLAT) & (CTXL - 1);
            nb[0] = nb[1] = (t >= 1) ? row - 1 : -1; nb[2] = nb[3] = (t < CTXL - 1) ? row + 1 : -1; }
        const float rs = RSTD[row];
#pragma unroll
        for (int j = 0; j < 4; ++j) {
            const int ci = lane + 64 * j;
            const f32x4 gg = ((const f32x4*)g)[ci], s1 = ((const f32x4*)sc)[ci] + 1.0f, s0 = ((const f32x4*)sh)[ci];
            const f32x4 xs = ((const f32x4*)(XR + (size_t)row * D))[ci];
            const f32x4 hs = xs * rs * gg * s1 + s0;
            f32x4 hn = (f32x4){0.f, 0.f, 0.f, 0.f};
            if (nb[j] >= 0) { const f32x4 xn = ((const f32x4*)(XR + (size_t)nb[j] * D))[ci]; hn = xn * RSTD[nb[j]] * gg * s1 + s0; }
            const f32x4 dx = hn - hs;
#pragma unroll
            for (int s = 0; s < 6; ++s) {
                const int m = (s == 0) ? 0 : (s == 1) ? 2 : (s == 2) ? 3 : (s == 3) ? 1 : (s == 4) ? 4 : 5;
                const f32x4 o = hs + dx * ((const f32x4*)(mu + m * D))[ci];
                v2u w; w.x = pk2(o.x, o.y); w.y = pk2(o.z, o.w);
                ((v2u*)(XL6 + ((size_t)s * NROW + row) * D))[ci] = w;
            }
        }
    }
}
__device__ __forceinline__ void phase_rwkv_naive(PP p, LAS unsigned char* lds, int lane, int wave) {
    if (blockIdx.x >= 8) return;
    const int chain = blockIdx.x * 8 + wave, b = chain >> 5, dir = (chain >> 4) & 1, h = chain & 15, ch = h * 64 + lane;
    const float* RKV = (const float*)(p->ws + WS_U + U_RKV);
    const float* WDp = (const float*)(p->ws + WS_U + U_WD) + (size_t)dir * NROW * D; const float* ADp = (const float*)(p->ws + WS_U + U_AD) + (size_t)dir * NROW * D;
    float* OD = (float*)(p->ws + WS_U + U_OD1) + (size_t)dir * NROW * D;
    const float kkw = p->in[I_KK][ch], kaw = p->in[I_KA][ch];
    LAS float* L = (LAS float*)lds;
    float S[64];
#pragma unroll
    for (int j = 0; j < 64; ++j) S[j] = 0.f;
    for (int step = 0; step < NSTEP; ++step) {
        const int row = step_row(b, dir, step);
        const float rx = RKV[(size_t)row * 3072 + ch], kx = RKV[(size_t)row * 3072 + 1024 + ch], vx = RKV[(size_t)row * 3072 + 2048 + ch];
        const float wv = WDp[(size_t)row * D + ch], av = ADp[(size_t)row * D + ch];
        float kkx = kx * kkw; const float nrm = sqrtf(wave_sum(kkx * kkx)); kkx = kkx / fmaxf(nrm, 1e-12f);
        LAS float* B = L + ((step & 1) * 8 + wave) * 320;
        B[lane] = wv; B[64 + lane] = kkx; B[128 + lane] = kkx * av; B[192 + lane] = kx * (1.f + (av - 1.f) * kaw); B[256 + lane] = rx;
        __syncthreads();
        const LAS f32x4* W4 = (const LAS f32x4*)B; const LAS f32x4* K4 = (const LAS f32x4*)(B + 64); const LAS f32x4* B4 = (const LAS f32x4*)(B + 128);
        const LAS f32x4* D4 = (const LAS f32x4*)(B + 192); const LAS f32x4* R4 = (const LAS f32x4*)(B + 256);
        float sa0 = 0.f, sa1 = 0.f;
#pragma unroll
        for (int q = 0; q < 16; ++q) { const f32x4 kk = K4[q]; sa0 += S[4 * q] * kk.x + S[4 * q + 2] * kk.z; sa1 += S[4 * q + 1] * kk.y + S[4 * q + 3] * kk.w; if ((q & 3) == 3) asm volatile("" ::: "memory"); }
        const float sa = sa0 + sa1;
        float y0 = 0.f, y1 = 0.f;
#pragma unroll
        for (int q = 0; q < 16; ++q) { const f32x4 w = W4[q], bt = B4[q], kd = D4[q], r = R4[q];
            S[4 * q + 0] = S[4 * q + 0] * w.x - sa * bt.x + vx * kd.x; y0 += S[4 * q + 0] * r.x;
            S[4 * q + 1] = S[4 * q + 1] * w.y - sa * bt.y + vx * kd.y; y1 += S[4 * q + 1] * r.y;
            S[4 * q + 2] = S[4 * q + 2] * w.z - sa * bt.z + vx * kd.z; y0 += S[4 * q + 2] * r.z;
            S[4 * q + 3] = S[4 * q + 3] * w.w - sa * bt.w + vx * kd.w; y1 += S[4 * q + 3] * r.w; if (q & 1) asm volatile("" ::: "memory"); }
        OD[(size_t)row * D + ch] = y0 + y1;
    }
}
__device__ __forceinline__ void phase_rw_readout(PP p, int lane, int wave) {
    const int gw = blockIdx.x * NWAVES + wave, NGW = gridDim.x * NWAVES;
    const float* RKV = (const float*)(p->ws + WS_U + U_RKV); const float* AD = (const float*)(p->ws + WS_U + U_AD); const float* G = (const float*)(p->ws + WS_U + U_G);
    const float* OD = (const float*)(p->ws + WS_U + U_OD1); bf16* A2 = (bf16*)(p->ws + WS_A2);
    for (int row = gw; row < NLAT; row += NGW) {
#pragma unroll 4
        for (int h = 0; h < 16; ++h) {
            const int ch = h * 64 + lane;
            const int bq = row >> 13, tq = row & (SEQ - 1), u0 = ((bq * 32 + h) * 4 + (lane >> 4)), u1 = ((bq * 32 + 16 + h) * 4 + (lane >> 4));
            const float y = OD[((size_t)u0 * NSTEP + CTXL + tq) * 16 + (lane & 15)] + OD[((size_t)u1 * NSTEP + CTXL + (SEQ - 1 - tq)) * 16 + (lane & 15)];
            const float mean = wave_sum(y) * (1.0f / 64.0f); const float d = y - mean; const float var = wave_sum(d * d) * (1.0f / 64.0f);
            float yn = d * rsqrtf(var + 64.0e-5f) * p->in[I_LNXW][ch] + p->in[I_LNXB][ch];
            const float r = RKV[(size_t)row * 3072 + ch], k = RKV[(size_t)row * 3072 + 1024 + ch], v = RKV[(size_t)row * 3072 + 2048 + ch];
            const float ka = p->in[I_KA][ch], rk = p->in[I_RK][ch];
#pragma unroll
            for (int dd = 0; dd < 2; ++dd) { const float a = AD[((size_t)dd * NROW + row) * D + ch]; const float kd = k * (1.f + (a - 1.f) * ka);
                yn += wave_sum(r * kd * rk) * v; }
            const float o = yn * G[(size_t)row * D + ch];
            const float o1 = __shfl_down(o, 1);
            if (!(lane & 1)) *(unsigned*)(A2 + (size_t)row * D + ch) = pk2(o, o1);
        }
    }
}

namespace pg8 {
struct SelOrder : StaticOrder {
    int div, sel0; size_t stride;
    __device__ __forceinline__ const char* abase(const Gemm& g, const Unit& u, size_t tstep) const { return (const char*)g.A + (size_t)(sel0 + u.pn / div) * stride + (size_t)u.pm * tstep; }
};
struct MoeOrder {
    const int* tilee; int nt, ntn, G, c; size_t estride;
    __device__ __forceinline__ void init(const int* te, int ntn_, size_t es, int G_, int c_) { tilee = te; nt = te[0]; ntn = ntn_; estride = es; G = G_; c = c_; }
    __device__ __forceinline__ bool next(int i, Unit& u) const { const long L = (long)i * G + c; if (L >= (long)nt * ntn) return false; u.pm = (int)(L / ntn); u.pn = (int)(L % ntn); u.e = tilee[1 + u.pm]; return true; }
    __device__ __forceinline__ const char* abase(const Gemm& g, const Unit& u, size_t tstep) const { return (const char*)g.A + (size_t)u.pm * tstep; }
    __device__ __forceinline__ const char* bbase(const Gemm& g, const Unit& u, size_t tstep) const { return (const char*)g.Bt + (size_t)u.e * estride + (size_t)u.pn * tstep; }
    __device__ __forceinline__ void a_ready(const Unit&) const {}
    __device__ __forceinline__ void done(const Unit&) const {}
};
struct EpiStoreBf16 {
    static constexpr bool PERM = true, AFTER_DRAIN = false;
    bf16_t* O; int ldc;
    __device__ __forceinline__ void operator()(const f32x4 (&acc)[2][2][4][2], const Unit& u, int wr, int wc, int fr, int fq) const {
        const int row0 = u.pm * BM + wr * 64 + fr, col0 = u.pn * BM + wc * 32 + 8 * fq;
#pragma unroll
        for (int ai = 0; ai < 2; ++ai)
#pragma unroll
            for (int m = 0; m < 4; ++m) { bf16_t* rowp = O + (size_t)(row0 + ai * HALF + m * 16) * ldc + col0;
#pragma unroll
                for (int bj = 0; bj < 2; ++bj) { const f32x4 v0 = acc[ai][bj][m][0], v1 = acc[ai][bj][m][1];
                    u32x4 w; w.x = cvt_pk_bf16(v0[0], v0[1]); w.y = cvt_pk_bf16(v0[2], v0[3]); w.z = cvt_pk_bf16(v1[0], v1[1]); w.w = cvt_pk_bf16(v1[2], v1[3]);
                    *(u32x4*)(rowp + bj * HALF) = w; } }
    }
};
struct EpiStoreF32 {
    static constexpr bool PERM = false, AFTER_DRAIN = false;
    float* C; int ldc;
    __device__ __forceinline__ void operator()(const f32x4 (&acc)[2][2][4][2], const Unit& u, int wr, int wc, int fr, int fq) const {
        const int row0 = u.pm * BM + wr * 64 + fr, col0 = u.pn * BM + wc * 32 + 4 * fq;
#pragma unroll
        for (int ai = 0; ai < 2; ++ai)
#pragma unroll
            for (int m = 0; m < 4; ++m) { float* rowp = C + (size_t)(row0 + ai * HALF + m * 16) * ldc + col0;
#pragma unroll
                for (int bj = 0; bj < 2; ++bj)
#pragma unroll
                    for (int n = 0; n < 2; ++n) *(f32x4*)(rowp + bj * HALF + n * 16) = acc[ai][bj][m][n]; }
    }
};
struct EpiResid {
    static constexpr bool PERM = false, AFTER_DRAIN = false;
    const float* base_lat; const float* base_ctx; float* out; const float* gate; int gstride;
    __device__ __forceinline__ void operator()(const f32x4 (&acc)[2][2][4][2], const Unit& u, int wr, int wc, int fr, int fq) const {
        const int row0 = u.pm * BM + wr * 64 + fr, col0 = u.pn * BM + wc * 32 + 4 * fq;
#pragma unroll
        for (int ai = 0; ai < 2; ++ai)
#pragma unroll
            for (int m = 0; m < 4; ++m) { const int row = row0 + ai * HALF + m * 16;
                const float* bp = (row < 16384) ? base_lat + (size_t)row * 1024 : base_ctx + (size_t)(row - 16384) * 1024;
                const float* gp = gate + (size_t)(row < 16384 ? (row >= 8192 ? 1 : 0) : 2) * gstride;
                float* op = out + (size_t)row * 1024;
#pragma unroll
                for (int bj = 0; bj < 2; ++bj)
#pragma unroll
                    for (int n = 0; n < 2; ++n) { const int c = col0 + bj * HALF + n * 16;
                        *(f32x4*)(op + c) = *(const f32x4*)(bp + c) + *(const f32x4*)(gp + c) * acc[ai][bj][m][n]; } }
    }
};
__device__ __forceinline__ float sigm_(float x) { return 1.0f / (1.0f + __expf(-x)); }
struct EpiSwiglu {
    static constexpr bool PERM = true, AFTER_DRAIN = false;
    bf16_t* O; const float* bgu;
    __device__ __forceinline__ void operator()(const f32x4 (&acc)[2][2][4][2], const Unit& u, int wr, int wc, int fr, int fq) const {
        const int row0 = u.pm * BM + wr * 64 + fr, col0 = u.pn * HALF + wc * 32 + 8 * fq;
        const float* bg = bgu + (size_t)u.e * 2048 + col0; f32x4 bgv[2], buv[2];
#pragma unroll
        for (int n = 0; n < 2; ++n) { bgv[n] = *(const f32x4*)(bg + 4 * n); buv[n] = *(const f32x4*)(bg + 1024 + 4 * n); }
#pragma unroll
        for (int ai = 0; ai < 2; ++ai)
#pragma unroll
            for (int m = 0; m < 4; ++m) { float r[8];
#pragma unroll
                for (int n = 0; n < 2; ++n) { const f32x4 g4 = acc[ai][0][m][n] + bgv[n], u4 = acc[ai][1][m][n] + buv[n];
#pragma unroll
                    for (int j = 0; j < 4; ++j) { const float g = fminf(g4[j], 7.0f), uu = fminf(fmaxf(u4[j], -7.0f), 7.0f); r[4 * n + j] = g * sigm_(1.702f * g) * (uu + 1.0f); } }
                u32x4 w; w.x = cvt_pk_bf16(r[0], r[1]); w.y = cvt_pk_bf16(r[2], r[3]); w.z = cvt_pk_bf16(r[4], r[5]); w.w = cvt_pk_bf16(r[6], r[7]);
                *(u32x4*)(O + (size_t)(row0 + ai * HALF + m * 16) * 1024 + col0) = w; }
    }
};
struct EpiDown {
    static constexpr bool PERM = true, AFTER_DRAIN = false;
    bf16_t* O; const float* bdn;
    __device__ __forceinline__ void operator()(const f32x4 (&acc)[2][2][4][2], const Unit& u, int wr, int wc, int fr, int fq) const {
        const int row0 = u.pm * BM + wr * 64 + fr, col0 = u.pn * BM + wc * 32 + 8 * fq;
        const float* bp = bdn + (size_t)u.e * 1024 + col0; f32x4 bv[2][2];
#pragma unroll
        for (int bj = 0; bj < 2; ++bj)
#pragma unroll
            for (int n = 0; n < 2; ++n) bv[bj][n] = *(const f32x4*)(bp + bj * HALF + 4 * n);
#pragma unroll
        for (int ai = 0; ai < 2; ++ai)
#pragma unroll
            for (int m = 0; m < 4; ++m) { bf16_t* rowp = O + (size_t)(row0 + ai * HALF + m * 16) * 1024 + col0;
#pragma unroll
                for (int bj = 0; bj < 2; ++bj) { const f32x4 v0 = acc[ai][bj][m][0] + bv[bj][0], v1 = acc[ai][bj][m][1] + bv[bj][1];
                    u32x4 w; w.x = cvt_pk_bf16(v0[0], v0[1]); w.y = cvt_pk_bf16(v0[2], v0[3]); w.z = cvt_pk_bf16(v1[0], v1[1]); w.w = cvt_pk_bf16(v1[2], v1[3]);
                    *(u32x4*)(rowp + bj * HALF) = w; } }
    }
};
struct EpiLora1 {
    static constexpr bool PERM = true, AFTER_DRAIN = false;
    bf16_t* O;
    __device__ __forceinline__ void operator()(const f32x4 (&acc)[2][2][4][2], const Unit& u, int wr, int wc, int fr, int fq) const {
        const int row0 = u.pm * BM + wr * 64 + fr, col0 = u.pn * HALF + wc * 32 + 8 * fq;
#pragma unroll
        for (int ai = 0; ai < 2; ++ai)
#pragma unroll
            for (int m = 0; m < 4; ++m) { float r[8];
#pragma unroll
                for (int n = 0; n < 2; ++n)
#pragma unroll
                    for (int j = 0; j < 4; ++j) { const float x = acc[ai][0][m][n][j]; r[4 * n + j] = (u.pn == 0) ? (2.0f * sigm_(2.0f * x) - 1.0f) : (u.pn == 1) ? x : sigm_(x); }
                u32x4 w; w.x = cvt_pk_bf16(r[0], r[1]); w.y = cvt_pk_bf16(r[2], r[3]); w.z = cvt_pk_bf16(r[4], r[5]); w.w = cvt_pk_bf16(r[6], r[7]);
                *(u32x4*)(O + (size_t)(row0 + ai * HALF + m * 16) * 384 + col0) = w; }
    }
};
struct EpiLora2 {
    static constexpr bool PERM = false, AFTER_DRAIN = false;
    float* WD; float* AD; float* G; const float* w0; const float* a0;
    __device__ __forceinline__ void operator()(const f32x4 (&acc)[2][2][4][2], const Unit& u, int wr, int wc, int fr, int fq) const {
        const int row0 = u.pm * BM + wr * 64 + fr, blk = u.pn >> 2, col0 = (u.pn & 3) * BM + wc * 32 + 4 * fq;
        float* dst = (blk < 2) ? WD + (size_t)blk * 16896 * 1024 : (blk < 4) ? AD + (size_t)(blk - 2) * 16896 * 1024 : G;
        const float* bias = (blk < 2) ? w0 + blk * 1024 : a0 + ((blk - 2) & 1) * 1024;
#pragma unroll
        for (int ai = 0; ai < 2; ++ai)
#pragma unroll
            for (int m = 0; m < 4; ++m) { float* rowp = dst + (size_t)(row0 + ai * HALF + m * 16) * 1024;
#pragma unroll
                for (int bj = 0; bj < 2; ++bj)
#pragma unroll
                    for (int n = 0; n < 2; ++n) { const int c = col0 + bj * HALF + n * 16; f32x4 v = acc[ai][bj][m][n];
                        const f32x4 bb = *(const f32x4*)(bias + c);
                        if (blk < 2) { for (int j = 0; j < 4; ++j) v[j] = -0.60653066f * sigm_(v[j] + bb[j]); }
                        else if (blk < 4) { for (int j = 0; j < 4; ++j) v[j] = sigm_(v[j] + bb[j]); }
                        *(f32x4*)(rowp + c) = v; }
                asm volatile("" ::: "memory"); }
    }
};
}

constexpr int GLA_NCH = NSTEP / 64;
constexpr int GLA_ITEMS = 2 * NBATCH * GLA_NCH * 8;
constexpr size_t U_DS = 298 * MiB, U_OI = 430 * MiB, U_QT = 562 * MiB, U_LAM = 628 * MiB;
typedef short bf16x8_t __attribute__((ext_vector_type(8)));
__device__ __forceinline__ f32x4 mfma16(bf16x8_t a, bf16x8_t b, f32x4 c) { return __builtin_amdgcn_mfma_f32_16x16x32_bf16(a, b, c, 0, 0, 0); }

__device__ __forceinline__ void phase_gla_prep(PP p, LAS unsigned char* lds, int tid, int lane, int wave) {
    constexpr int PQ = 272, PT = 144;
    LAS unsigned char* QA = lds;
    LAS unsigned char* QX = QA + 64 * PQ;
    LAS unsigned char* KB = QX + 48 * PQ;
    LAS unsigned char* KD = KB + 64 * PQ;
    LAS unsigned char* KT = KD + 64 * PQ;
    LAS unsigned char* VT = KT + 128 * PT;
    LAS unsigned char* PI = VT + 128 * PT;
    LAS float* GT = (LAS float*)(PI + 64 * PT);
    const bf16* Z = (const bf16*)(p->ws + WS_U + U_Z);
    bf16* DS = (bf16*)(p->ws + WS_U + U_DS); f32x4* OI = (f32x4*)(p->ws + WS_U + U_OI); bf16* QT = (bf16*)(p->ws + WS_U + U_QT); float* LAM = (float*)(p->ws + WS_U + U_LAM);
    const int k = tid & 127, g = tid >> 7, kq = lane >> 4, c16 = lane & 15;
    for (int item = blockIdx.x; item < GLA_ITEMS; item += gridDim.x) {
        const int h = item & 7, cc = (item >> 3) % GLA_NCH, db = (item >> 3) / GLA_NCH, b = db & 1, dir = db >> 1;
        float lbv; { const float* lb = p->in[I_HGLB] + (size_t)dir * 3 * D + h * 128 + k; const float a0 = lb[0], a1 = lb[D], a2 = lb[2 * D];
                     const float m = fmaxf(a0, fmaxf(a1, a2)); const float e0 = __expf(a0 - m), e1 = __expf(a1 - m), e2 = __expf(a2 - m); lbv = e0 / (e0 + e1 + e2); }
        for (int u = tid; u < 64 * PT / 4; u += NTHREADS) ((LAS unsigned*)PI)[u] = 0u;
        float cs[16], kin[16], qs[16]; unsigned vt[8]; float run = 0.f;
#pragma unroll
        for (int i = 0; i < 16; ++i) {
            const size_t zr = (size_t)step_row(b, dir, 64 * cc + 16 * g + i) * 5120 + h * 128 + k;
            const float fh = bf2f(Z[zr + 1024 * (1 + dir)]), qv = bf2f(Z[zr]); const unsigned zv = Z[zr + 3072];
            const float f = lbv + (1.f - lbv) * sigm(fh);
            run += __logf(f); cs[i] = run; kin[i] = 1.f - f; qs[i] = qv * sigm(qv);
            if (i & 1) vt[i >> 1] |= zv << 16; else vt[i >> 1] = zv;
        }
        GT[g * 128 + k] = run;
        { LAS v4u* d = (LAS v4u*)(VT + k * PT + 32 * g); d[0] = (v4u){vt[0], vt[1], vt[2], vt[3]}; d[1] = (v4u){vt[4], vt[5], vt[6], vt[7]}; }
        __syncthreads();
        const float t0 = GT[k], t1 = GT[128 + k], t2 = GT[256 + k], t3 = GT[384 + k];
        const float rg = (g > 0 ? t0 : 0.f) + (g > 1 ? t1 : 0.f) + (g > 2 ? t2 : 0.f), tot = (t0 + t1) + (t2 + t3);
        const float erg = __expf(rg), einv = __expf(-run), eend = __expf(tot - (rg + run));
        const float ex1 = (g == 2) ? __expf(t1) : __expf(t2);
        const float ex2 = __expf(t1 + t2);
        unsigned kt[8];
        bf16* qtp = QT + (size_t)item * 64 * 128 + (size_t)(16 * g) * 128 + k;
#pragma unroll
        for (int i = 0; i < 16; ++i) {
            const float qh = qs[i] * __expf(cs[i]), kb = kin[i] * __expf(run - cs[i]);
            const int ro = (16 * g + i) * PQ + 2 * k;
            *(LAS unsigned short*)(QA + ro) = (unsigned short)f2bf(qh);
            *(LAS unsigned short*)(KB + ro) = (unsigned short)f2bf(kb);
            *(LAS unsigned short*)(KD + ro) = (unsigned short)f2bf(kb * einv);
            if (g == 2) *(LAS unsigned short*)(QX + i * PQ + 2 * k) = (unsigned short)f2bf(qh * ex1);
            if (g == 3) { *(LAS unsigned short*)(QX + (16 + i) * PQ + 2 * k) = (unsigned short)f2bf(qh * ex1); *(LAS unsigned short*)(QX + (32 + i) * PQ + 2 * k) = (unsigned short)f2bf(qh * ex2); }
            qtp[(size_t)i * 128] = (bf16)f2bf(qh * erg);
            const unsigned kv = f2bf(kb * eend);
            if (i & 1) kt[i >> 1] |= kv << 16; else kt[i >> 1] = kv;
        }
        { LAS v4u* d = (LAS v4u*)(KT + k * PT + 32 * g); d[0] = (v4u){kt[0], kt[1], kt[2], kt[3]}; d[1] = (v4u){kt[4], kt[5], kt[6], kt[7]}; }
        if (g == 0) LAM[(size_t)item * 128 + k] = __expf(tot);
        __syncthreads();
        for (int blk = wave; blk < 10; blk += 8) {
            const int gi = (blk >= 6) ? 3 : (blk >= 3) ? 2 : (blk >= 1) ? 1 : 0, ji = blk - ((gi * (gi + 1)) >> 1);
            const LAS unsigned char* ab = (ji + 1 >= gi) ? QA + 16 * gi * PQ : (gi == 2) ? QX : (ji == 1) ? QX + 16 * PQ : QX + 32 * PQ;
            const LAS unsigned char* bb = ((ji == gi) ? KD : KB) + 16 * ji * PQ;
            f32x4 acc = (f32x4){0.f, 0.f, 0.f, 0.f};
#pragma unroll
            for (int s = 0; s < 4; ++s) {
                const bf16x8_t a = *(const LAS bf16x8_t*)(ab + c16 * PQ + (32 * s + 8 * kq) * 2), bv = *(const LAS bf16x8_t*)(bb + c16 * PQ + (32 * s + 8 * kq) * 2);
                acc = mfma16(a, bv, acc);
            }
#pragma unroll
            for (int j = 0; j < 4; ++j) { const int tau = 4 * kq + j; const float val = (ji == gi && c16 > tau) ? 0.f : acc[j];
                *(LAS unsigned short*)(PI + (16 * gi + tau) * PT + (16 * ji + c16) * 2) = (unsigned short)f2bf(val); }
        }
        __syncthreads();
        {
            const LAS unsigned char* vb = VT + (16 * wave + c16) * PT + 16 * kq;
            const bf16x8_t v0 = *(const LAS bf16x8_t*)(vb), v1 = *(const LAS bf16x8_t*)(vb + 64);
#pragma unroll
            for (int gi = 0; gi < 4; ++gi) {
                const LAS unsigned char* pb = PI + (16 * gi + c16) * PT + 16 * kq;
                f32x4 acc = mfma16(*(const LAS bf16x8_t*)(pb), v0, (f32x4){0.f, 0.f, 0.f, 0.f});
                if (gi >= 2) acc = mfma16(*(const LAS bf16x8_t*)(pb + 64), v1, acc);
                OI[((size_t)item * 8 + wave) * 256 + gi * 64 + lane] = acc;
            }
            bf16* dsp = DS + (size_t)item * 128 * 128 + (size_t)(16 * wave + c16) * 128 + 4 * kq;
#pragma unroll
            for (int m = 0; m < 8; ++m) {
                const LAS unsigned char* kb2 = KT + (16 * m + c16) * PT + 16 * kq;
                f32x4 acc = mfma16(*(const LAS bf16x8_t*)(kb2), v0, (f32x4){0.f, 0.f, 0.f, 0.f});
                acc = mfma16(*(const LAS bf16x8_t*)(kb2 + 64), v1, acc);
                v2u w; w.x = pk2(acc[0], acc[1]); w.y = pk2(acc[2], acc[3]);
                *(v2u*)(dsp + 16 * m) = w;
            }
        }
        __syncthreads();
    }
}
__device__ __forceinline__ void phase_gla_scan(PP p, int tid) {
    bf16* DS = (bf16*)(p->ws + WS_U + U_DS); const float* LAM = (const float*)(p->ws + WS_U + U_LAM);
    const int nthr = gridDim.x * NTHREADS;
    for (int e = blockIdx.x * NTHREADS + tid; e < 32 * 2048; e += nthr) {
        const int chain = e >> 11, el = e & 2047, h = chain & 7, db = chain >> 3, k8 = (el & 15) * 8;
        float s[8];
#pragma unroll
        for (int i = 0; i < 8; ++i) s[i] = 0.f;
        for (int c0 = 0; c0 < GLA_NCH; c0 += 6) {
            v4u d[6]; f32x4 l0[6], l1[6];
#pragma unroll
            for (int u = 0; u < 6; ++u) { const size_t item = ((size_t)db * GLA_NCH + c0 + u) * 8 + h;
                d[u] = *(const v4u*)(DS + item * 16384 + (size_t)el * 8); l0[u] = *(const f32x4*)(LAM + item * 128 + k8); l1[u] = *(const f32x4*)(LAM + item * 128 + k8 + 4); }
#pragma unroll
            for (int u = 0; u < 6; ++u) { const size_t item = ((size_t)db * GLA_NCH + c0 + u) * 8 + h;
                v4u o; o.x = pk2(s[0], s[1]); o.y = pk2(s[2], s[3]); o.z = pk2(s[4], s[5]); o.w = pk2(s[6], s[7]);
                *(v4u*)(DS + item * 16384 + (size_t)el * 8) = o;
                s[0] = l0[u].x * s[0] + bf2f(d[u].x & 0xffffu); s[1] = l0[u].y * s[1] + bf2f(d[u].x >> 16);
                s[2] = l0[u].z * s[2] + bf2f(d[u].y & 0xffffu); s[3] = l0[u].w * s[3] + bf2f(d[u].y >> 16);
                s[4] = l1[u].x * s[4] + bf2f(d[u].z & 0xffffu); s[5] = l1[u].y * s[5] + bf2f(d[u].z >> 16);
                s[6] = l1[u].z * s[6] + bf2f(d[u].w & 0xffffu); s[7] = l1[u].w * s[7] + bf2f(d[u].w >> 16); }
        }
    }
}
__device__ __forceinline__ void phase_gla_out(PP p, int lane, int wave) {
    const bf16* DS = (const bf16*)(p->ws + WS_U + U_DS); const f32x4* OI = (const f32x4*)(p->ws + WS_U + U_OI); const bf16* QT = (const bf16*)(p->ws + WS_U + U_QT);
    float* ODb = (float*)(p->ws + WS_U + U_OD0);
    const int kq = lane >> 4, c16 = lane & 15;
    for (int item = blockIdx.x; item < GLA_ITEMS; item += gridDim.x) {
        const int h = item & 7, cc = (item >> 3) % GLA_NCH, db = (item >> 3) / GLA_NCH, b = db & 1, dir = db >> 1;
        const bf16* sp = DS + (size_t)item * 16384 + (size_t)(16 * wave + c16) * 128 + 8 * kq;
        bf16x8_t bv[4];
#pragma unroll
        for (int s = 0; s < 4; ++s) bv[s] = *(const bf16x8_t*)(sp + 32 * s);
        float* OD = ODb + (size_t)dir * NROW * D + h * 128 + 16 * wave + c16;
#pragma unroll
        for (int gi = 0; gi < 4; ++gi) {
            const bf16* qp = QT + (size_t)item * 8192 + (size_t)(16 * gi + c16) * 128 + 8 * kq;
            f32x4 acc = OI[((size_t)item * 8 + wave) * 256 + gi * 64 + lane];
#pragma unroll
            for (int s = 0; s < 4; ++s) acc = mfma16(*(const bf16x8_t*)(qp + 32 * s), bv[s], acc);
#pragma unroll
            for (int j = 0; j < 4; ++j) OD[(size_t)step_row(b, dir, 64 * cc + 16 * gi + 4 * kq + j) * D] = acc[j];
        }
    }
}

constexpr int RW_NB = 32, RW_SLOT = 336;
__device__ __forceinline__ float row16_sum(float x) {
    x += __builtin_bit_cast(float, __builtin_amdgcn_update_dpp(0, __builtin_bit_cast(int, x), 0x128, 0xf, 0xf, false));
    x += __builtin_bit_cast(float, __builtin_amdgcn_update_dpp(0, __builtin_bit_cast(int, x), 0x124, 0xf, 0xf, false));
    x += __builtin_bit_cast(float, __builtin_amdgcn_update_dpp(0, __builtin_bit_cast(int, x), 0x122, 0xf, 0xf, false));
    x += __builtin_bit_cast(float, __builtin_amdgcn_update_dpp(0, __builtin_bit_cast(int, x), 0x121, 0xf, 0xf, false));
    return x;
}
__device__ __forceinline__ void rw_fill(PP p, LAS float* buf, int batch, int b, int dir, int h, int rowgrp, int lw, int lane) {
    const float* RKV = (const float*)(p->ws + WS_U + U_RKV);
    const float* WDp = (const float*)(p->ws + WS_U + U_WD) + (size_t)dir * NROW * D; const float* ADp = (const float*)(p->ws + WS_U + U_AD) + (size_t)dir * NROW * D;
    const int ch = h * 64 + lane; const float kkw = p->in[I_KK][ch], kaw = p->in[I_KA][ch];
    float rx[8], kx[8], vx[8], wv[8], av[8];
#pragma unroll
    for (int u = 0; u < 8; ++u) { const int row = step_row(b, dir, batch * RW_NB + lw + 4 * u);
        rx[u] = RKV[(size_t)row * 3072 + ch]; kx[u] = RKV[(size_t)row * 3072 + 1024 + ch]; vx[u] = RKV[(size_t)row * 3072 + 2048 + ch];
        wv[u] = WDp[(size_t)row * D + ch]; av[u] = ADp[(size_t)row * D + ch]; }
#pragma unroll
    for (int u = 0; u < 8; ++u) {
        float kkx = kx[u] * kkw; const float nrm = sqrtf(wave_sum(kkx * kkx)); kkx = kkx / fmaxf(nrm, 1e-12f);
        LAS float* B = buf + (lw + 4 * u) * RW_SLOT;
        B[lane] = wv[u]; B[64 + lane] = kkx; B[128 + lane] = kkx * av[u]; B[192 + lane] = kx[u] * (1.f + (av[u] - 1.f) * kaw); B[256 + lane] = rx[u];
        if ((lane >> 4) == rowgrp) B[320 + (lane & 15)] = vx[u];
    }
}
__device__ __forceinline__ void phase_rwkv_scan(PP p, LAS unsigned char* lds, int lane, int wave) {
    LAS float* L = (LAS float*)lds;
    for (int unit = blockIdx.x; unit < 256; unit += gridDim.x) {
        const int chain = unit >> 2, rowgrp = unit & 3, b = chain >> 5, dir = (chain >> 4) & 1, h = chain & 15;
        float* OD = (float*)(p->ws + WS_U + U_OD1) + (size_t)dir * NROW * D + h * 64 + 16 * rowgrp + 4 * wave + (lane >> 4);
        const int seg = lane & 15;
        f32x4 S = (f32x4){0.f, 0.f, 0.f, 0.f};
        if (wave >= 4) rw_fill(p, L, 0, b, dir, h, rowgrp, wave - 4, lane);
        __syncthreads();
        constexpr int NBATCH_RW = NSTEP / RW_NB;
        for (int bt = 0; bt < NBATCH_RW; ++bt) {
            if (wave >= 4) { if (bt + 1 < NBATCH_RW) rw_fill(p, L + ((bt + 1) & 1) * RW_NB * RW_SLOT, bt + 1, b, dir, h, rowgrp, wave - 4, lane); }
            else {
                const LAS float* B0 = L + (bt & 1) * RW_NB * RW_SLOT;
#pragma unroll 4
                for (int s = 0; s < RW_NB; ++s) {
                    const LAS f32x4* B4 = (const LAS f32x4*)(B0 + s * RW_SLOT);
                    const f32x4 w4 = B4[seg], kk4 = B4[16 + seg], bt4 = B4[32 + seg], kd4 = B4[48 + seg], r4 = B4[64 + seg];
                    const float vv = B0[s * RW_SLOT + 320 + 4 * wave + (lane >> 4)];
                    float sa = (S.x * kk4.x + S.y * kk4.y) + (S.z * kk4.z + S.w * kk4.w);
                    sa = row16_sum(sa);
                    S = S * w4 - sa * bt4 + vv * kd4;
                    float y = (S.x * r4.x + S.y * r4.y) + (S.z * r4.z + S.w * r4.w);
                    y = row16_sum(y);
                    if (seg == 0) OD[(size_t)step_row(b, dir, bt * RW_NB + s) * D] = y;
                }
            }
            __syncthreads();
        }
    }
}

constexpr int RW2_NB = 32, RW2_SLOT = 832, RW2_ZERO = 2 * RW2_NB * RW2_SLOT;
typedef short bf16x4_t __attribute__((ext_vector_type(4)));
typedef float f32x2_t __attribute__((ext_vector_type(2))); typedef __bf16 bf16x2v_t __attribute__((ext_vector_type(2)));
__device__ __forceinline__ unsigned cvtpk(float lo, float hi) { const f32x2_t v = {lo, hi}; const bf16x2v_t b = __builtin_convertvector(v, bf16x2v_t); return __builtin_bit_cast(unsigned, b); }
constexpr size_t U_KKN = 872 * MiB;
__device__ __forceinline__ void phase_kk_prep(PP p, int lane, int wave) {
    const int gw = blockIdx.x * NWAVES + wave, NGW = gridDim.x * NWAVES;
    const float* RKV = (const float*)(p->ws + WS_U + U_RKV); float* KKN = (float*)(p->ws + WS_U + U_KKN);
    for (int row = gw; row < NROW; row += NGW) {
        float kx[16];
#pragma unroll
        for (int h = 0; h < 16; ++h) kx[h] = RKV[(size_t)row * 3072 + 1024 + h * 64 + lane] * p->in[I_KK][h * 64 + lane];
#pragma unroll
        for (int h = 0; h < 16; ++h) { const float nrm = sqrtf(wave_sum(kx[h] * kx[h])); KKN[(size_t)row * D + h * 64 + lane] = kx[h] / fmaxf(nrm, 1e-12f); }
    }
}
struct Rw2Regs { float rx[8], kx[8], vx[8], wv[8], av[8], kn[8]; };
__device__ __forceinline__ void rw2_load(PP p, Rw2Regs& R, int batch, int b, int dir, int h, int lw, int lane) {
    const float* RKV = (const float*)(p->ws + WS_U + U_RKV); const float* KKN = (const float*)(p->ws + WS_U + U_KKN);
    const float* WDp = (const float*)(p->ws + WS_U + U_WD) + (size_t)dir * NROW * D; const float* ADp = (const float*)(p->ws + WS_U + U_AD) + (size_t)dir * NROW * D;
    const int ch = h * 64 + lane;
#pragma unroll
    for (int u = 0; u < 8; ++u) { const int gs = batch * RW2_NB + lw + 4 * u; const int row = step_row(b, dir, gs < NSTEP ? gs : NSTEP - 1), rowp = step_row(b, dir, gs < 1 ? 0 : (gs - 1 < NSTEP ? gs - 1 : NSTEP - 1));
        R.rx[u] = RKV[(size_t)rowp * 3072 + ch]; R.kx[u] = RKV[(size_t)row * 3072 + 1024 + ch]; R.vx[u] = RKV[(size_t)row * 3072 + 2048 + ch];
        R.wv[u] = WDp[(size_t)row * D + ch]; R.av[u] = ADp[(size_t)row * D + ch]; R.kn[u] = KKN[(size_t)row * D + ch]; }
}
__device__ __forceinline__ void rw2_store(const Rw2Regs& R, LAS unsigned char* buf, float kaw, int slab, int lw, int lane) {
    const int s2 = lane >> 5, tp = (lane >> 4) & 1, kq = (lane & 15) >> 2, ii = (lane & 3) + 4 * tp, dpos = ((s2 * 4 + kq) * 8 + ii) * 2;
#pragma unroll
    for (int u = 0; u < 8; ++u) {
        LAS unsigned char* B = buf + (lw + 4 * u) * RW2_SLOT; const float kkx = R.kn[u];
        ((LAS float*)B)[lane] = R.wv[u];
        *(LAS unsigned short*)(B + 256 + dpos) = (unsigned short)f2bf(kkx);
        *(LAS unsigned short*)(B + 256 + 128 + dpos) = (unsigned short)f2bf(R.rx[u]);
        ((LAS unsigned*)(B + 512))[lane] = pk2(-(kkx * R.av[u]), R.kx[u] * (1.f + (R.av[u] - 1.f) * kaw));
        if ((lane >> 4) == slab) ((LAS float*)(B + 768))[lane & 15] = R.vx[u];
    }
}
__device__ __forceinline__ void phase_rwkv_scan2(PP p, LAS unsigned char* lds, int tid, int lane, int wave) {
    for (int u = tid; u < 256; u += NTHREADS) ((LAS unsigned*)(lds + RW2_ZERO))[u] = 0u;
    const int m = lane & 15, q = lane >> 4;
    for (int unit = blockIdx.x; unit < 256; unit += gridDim.x) {
        const int chain = unit >> 2, slab = unit & 3, b = chain >> 5, dir = (chain >> 4) & 1, h = chain & 15;
        float* OD = (float*)(p->ws + WS_U + U_OD1) + (size_t)dir * NROW * D + h * 64 + 16 * slab + m;
        f32x4 S[4];
#pragma unroll
        for (int T = 0; T < 4; ++T) S[T] = (f32x4){0.f, 0.f, 0.f, 0.f};
        Rw2Regs R; const float kaw = p->in[I_KA][h * 64 + lane];
        if (wave >= 4) { rw2_load(p, R, 0, b, dir, h, wave - 4, lane); rw2_store(R, lds, kaw, slab, wave - 4, lane); rw2_load(p, R, 1, b, dir, h, wave - 4, lane); }
        __syncthreads();
        constexpr int NB2 = (NSTEP + 1 + RW2_NB - 1) / RW2_NB;
        for (int bt = 0; bt < NB2; ++bt) {
            if (wave >= 4) { if (bt + 1 < NB2) { rw2_store(R, lds + ((bt + 1) & 1) * RW2_NB * RW2_SLOT, kaw, slab, wave - 4, lane); if (bt + 2 < NB2) rw2_load(p, R, bt + 2, b, dir, h, wave - 4, lane); } }
            else if (wave == 0) {
                const LAS unsigned char* B0 = lds + (bt & 1) * RW2_NB * RW2_SLOT;
#pragma unroll 2
                for (int s = 0; s < RW2_NB; ++s) {
                    const int gs = bt * RW2_NB + s;
                    if (gs > NSTEP) break;
                    const LAS unsigned char* sl = B0 + s * RW2_SLOT;
                    f32x4 w4[4]; unsigned ub[4];
                    const LAS unsigned char* up = (q == 0) ? sl + 512 + 4 * m : lds + RW2_ZERO + 4 * m;
#pragma unroll
                    for (int T = 0; T < 4; ++T) { w4[T] = *(const LAS f32x4*)(sl + (16 * T + 4 * q) * 4); ub[T] = *(const LAS unsigned*)(up + 64 * T); }
                    const bf16x8_t a0 = *(const LAS bf16x8_t*)(sl + 256 + (((m & 1) * 2 + 0) * 4 + q) * 16), a1 = *(const LAS bf16x8_t*)(sl + 256 + (((m & 1) * 2 + 1) * 4 + q) * 16);
                    const float vv = *(const LAS float*)(sl + 768 + 4 * m);
                    v4u b0, b1;
                    b0.x = cvtpk(S[0][0], S[0][1]); b0.y = cvtpk(S[0][2], S[0][3]); b0.z = cvtpk(S[1][0], S[1][1]); b0.w = cvtpk(S[1][2], S[1][3]);
                    b1.x = cvtpk(S[2][0], S[2][1]); b1.y = cvtpk(S[2][2], S[2][3]); b1.z = cvtpk(S[3][0], S[3][1]); b1.w = cvtpk(S[3][2], S[3][3]);
                    const f32x4 z4 = (f32x4){0.f, 0.f, 0.f, 0.f};
                    const f32x4 d1 = mfma16(a0, __builtin_bit_cast(bf16x8_t, b0), z4), d2 = mfma16(a1, __builtin_bit_cast(bf16x8_t, b1), z4);
                    const float sa = d1[0] + d2[0], y = d1[1] + d2[1];
                    if (gs >= 1 && q == 0) OD[(size_t)step_row(b, dir, gs - 1) * D] = y;
                    if (gs < NSTEP) {
                        v2u bu; bu.x = (q == 0) ? cvtpk(sa, vv) : 0u; bu.y = 0u;
#pragma unroll
                        for (int T = 0; T < 4; ++T) { v2u au; au.x = ub[T]; au.y = 0u;
                            S[T] = __builtin_amdgcn_mfma_f32_16x16x16bf16_1k(__builtin_bit_cast(bf16x4_t, au), __builtin_bit_cast(bf16x4_t, bu), S[T] * w4[T], 0, 0, 0); }
                    }
                }
            }
            __syncthreads();
        }
    }
}

constexpr int R3_NCB = 6, R3_DOTA = 0, R3_UPA = 2048, R3_A1 = 4096, R3_A2 = 4608, R3_G7 = 5120, R3_VT = 5376, R3_SLOT = 5888;
constexpr int R3_SCR = 2 * R3_NCB * R3_SLOT, R3_LW0 = 8 - R3_NCB;
struct Rw3Regs { float rx[8], kx[8], vx[8], lw[8], av[8], kn[8]; };
__device__ __forceinline__ void rw3_load(PP p, Rw3Regs& R, int chunk, int b, int dir, int h, int lane) {
    const float* RKV = (const float*)(p->ws + WS_U + U_RKV); const float* KKN = (const float*)(p->ws + WS_U + U_KKN);
    const float* WDp = (const float*)(p->ws + WS_U + U_WD) + (size_t)dir * NROW * D; const float* ADp = (const float*)(p->ws + WS_U + U_AD) + (size_t)dir * NROW * D;
    const int ch = h * 64 + lane;
#pragma unroll
    for (int j = 0; j < 8; ++j) { const int row = step_row(b, dir, chunk * 8 + j);
        R.rx[j] = RKV[(size_t)row * 3072 + ch]; R.kx[j] = RKV[(size_t)row * 3072 + 1024 + ch]; R.vx[j] = RKV[(size_t)row * 3072 + 2048 + ch];
        R.lw[j] = WDp[(size_t)row * D + ch]; R.av[j] = ADp[(size_t)row * D + ch]; R.kn[j] = KKN[(size_t)row * D + ch]; }
}
__device__ __forceinline__ void rw3_build(const Rw3Regs& R, LAS unsigned char* sl, LAS unsigned char* gb, float kaw, int slab, int lane) {
    const int m = lane & 15, q = lane >> 4;
    const int s2 = lane >> 5, tp = (lane >> 4) & 1, kq = (lane & 15) >> 2, ii = (lane & 3) + 4 * tp, dpos = ((s2 * 4 + kq) * 8 + ii) * 2;
    float bj[8]; { float bb = 0.f;
#pragma unroll
        for (int j = 0; j < 8; ++j) { bb += R.lw[j]; bj[j] = bb; } }
    const float e7 = __expf(bj[7]);
    unsigned upa[8]; float ebprev = 1.f;
#pragma unroll
    for (int j = 0; j < 8; ++j) {
        const float eb = __expf(bj[j]), einv = 1.0f / eb, e7j = e7 * einv;
        const float beta = R.kn[j] * R.av[j], kd = R.kx[j] * (1.f + (R.av[j] - 1.f) * kaw);
        *(LAS unsigned short*)(sl + R3_DOTA + j * 128 + dpos) = (unsigned short)f2bf(R.kn[j] * ebprev);
        *(LAS unsigned short*)(sl + R3_DOTA + (8 + j) * 128 + dpos) = (unsigned short)f2bf(R.rx[j] * eb);
        *(LAS unsigned short*)(gb + j * 128 + dpos) = (unsigned short)f2bf(beta * einv);
        *(LAS unsigned short*)(gb + (8 + j) * 128 + dpos) = (unsigned short)f2bf(kd * einv);
        const unsigned ub = f2bf(-beta * e7j), uk = f2bf(kd * e7j);
        if (j & 1) { upa[j >> 1] |= ub << 16; upa[4 + (j >> 1)] |= uk << 16; } else { upa[j >> 1] = ub; upa[4 + (j >> 1)] = uk; }
        ebprev = eb;
    }
    { LAS v4u* d = (LAS v4u*)(sl + R3_UPA + lane * 32); d[0] = (v4u){upa[0], upa[1], upa[2], upa[3]}; d[1] = (v4u){upa[4], upa[5], upa[6], upa[7]}; }
    ((LAS float*)(sl + R3_G7))[lane] = e7;
    if ((lane >> 4) == slab) { LAS f32x4* d = (LAS f32x4*)(sl + R3_VT + (lane & 15) * 32); d[0] = (f32x4){R.vx[0], R.vx[1], R.vx[2], R.vx[3]}; d[1] = (f32x4){R.vx[4], R.vx[5], R.vx[6], R.vx[7]}; }
    LDS_WAIT(); asm volatile("" ::: "memory");
    f32x4 G = (f32x4){0.f, 0.f, 0.f, 0.f};
#pragma unroll
    for (int s = 0; s < 2; ++s) G = mfma16(*(const LAS bf16x8_t*)(sl + R3_DOTA + m * 128 + (s * 4 + q) * 16), *(const LAS bf16x8_t*)(gb + m * 128 + (s * 4 + q) * 16), G);
    if (m >= 8) { const int i = m - 8;
#pragma unroll
        for (int jp = 0; jp < 4; ++jp) { const int row = 4 * q + jp; const bool keep = (row < 8) ? (i < row) : (i <= row - 8);
            *(LAS unsigned short*)(sl + R3_A1 + row * 32 + i * 2) = (unsigned short)f2bf(keep ? G[jp] : 0.f); } }
    LDS_WAIT(); asm volatile("" ::: "memory");
#pragma unroll
    for (int jp = 0; jp < 4; ++jp) ((LAS float*)gb)[(4 * q + jp) * 16 + m] = G[jp];
    LDS_WAIT(); asm volatile("" ::: "memory");
    const LAS float* GL = (const LAS float*)gb;
    const int c = lane & 7; float Tc[8], M2[8];
#pragma unroll
    for (int j = 0; j < 8; ++j) { float t = (j == c) ? 1.f : 0.f; const f32x4 ra = *(const LAS f32x4*)(GL + j * 16), rb = *(const LAS f32x4*)(GL + j * 16 + 4);
#pragma unroll
        for (int i = 0; i < j; ++i) t -= (i < 4 ? ra[i & 3] : rb[i & 3]) * Tc[i];
        Tc[j] = t; }
#pragma unroll
    for (int j = 0; j < 8; ++j) { float t = 0.f; const f32x4 ra = *(const LAS f32x4*)(GL + (8 + j) * 16), rb = *(const LAS f32x4*)(GL + (8 + j) * 16 + 4);
#pragma unroll
        for (int i = 0; i <= j; ++i) t -= (i < 4 ? ra[i & 3] : rb[i & 3]) * Tc[i];
        M2[j] = t; }
    LDS_WAIT(); asm volatile("" ::: "memory");
    if (lane < 8) {
#pragma unroll
        for (int j = 0; j < 8; ++j) { *(LAS unsigned short*)(sl + R3_A2 + j * 32 + c * 2) = (unsigned short)f2bf(Tc[j]); *(LAS unsigned short*)(sl + R3_A2 + (8 + j) * 32 + c * 2) = (unsigned short)f2bf(M2[j]); } }
}
__device__ __forceinline__ void phase_rwkv_scan3(PP p, LAS unsigned char* lds, int tid, int lane, int wave) {
    const int m = lane & 15, q = lane >> 4;
    for (int unit = blockIdx.x; unit < 256; unit += gridDim.x) {
        const int chain = unit >> 2, slab = unit & 3, b = chain >> 5, dir = (chain >> 4) & 1, h = chain & 15;
        __syncthreads();
        for (int u = tid; u < (R3_SCR + R3_NCB * 2048) / 4; u += NTHREADS) ((LAS unsigned*)lds)[u] = 0u;
        __syncthreads();
        if (tid < 2 * R3_NCB * 8) { const int slot = tid >> 3, j = tid & 7; *(LAS unsigned short*)(lds + slot * R3_SLOT + R3_A2 + (8 + j) * 32 + (8 + j) * 2) = (unsigned short)0x3F80; }
        float* OD = (float*)(p->ws + WS_U + U_OD1) + (size_t)dir * NROW * D + h * 64 + 16 * slab + m;
        f32x4 S[4];
#pragma unroll
        for (int T = 0; T < 4; ++T) S[T] = (f32x4){0.f, 0.f, 0.f, 0.f};
        Rw3Regs R; const float kaw = p->in[I_KA][h * 64 + lane];
        LAS unsigned char* gb = lds + R3_SCR + (wave >= R3_LW0 ? wave - R3_LW0 : 0) * 2048;
        __syncthreads();
        if (wave >= R3_LW0) { rw3_load(p, R, wave - R3_LW0, b, dir, h, lane); rw3_build(R, lds + (wave - R3_LW0) * R3_SLOT, gb, kaw, slab, lane); rw3_load(p, R, R3_NCB + wave - R3_LW0, b, dir, h, lane); }
        __syncthreads();
        constexpr int NB3 = NSTEP / (8 * R3_NCB);
        for (int bt = 0; bt < NB3; ++bt) {
            if (wave >= R3_LW0) { if (bt + 1 < NB3) { rw3_build(R, lds + (((bt + 1) & 1) * R3_NCB + wave - R3_LW0) * R3_SLOT, gb, kaw, slab, lane); if (bt + 2 < NB3) rw3_load(p, R, (bt + 2) * R3_NCB + wave - R3_LW0, b, dir, h, lane); } }
            else if (wave == 0) {
#pragma unroll 1
                for (int cc = 0; cc < R3_NCB; ++cc) {
                    const LAS unsigned char* sl = lds + ((bt & 1) * R3_NCB + cc) * R3_SLOT;
                    const bf16x8_t a0 = *(const LAS bf16x8_t*)(sl + R3_DOTA + m * 128 + q * 16), a1 = *(const LAS bf16x8_t*)(sl + R3_DOTA + m * 128 + (4 + q) * 16);
                    const bf16x4_t A1f = *(const LAS bf16x4_t*)(sl + R3_A1 + m * 32 + q * 8), A2f = *(const LAS bf16x4_t*)(sl + R3_A2 + m * 32 + q * 8);
                    bf16x4_t UA[4]; f32x4 g7[4];
#pragma unroll
                    for (int T = 0; T < 4; ++T) { UA[T] = *(const LAS bf16x4_t*)(sl + R3_UPA + (16 * T + m) * 32 + q * 8); g7[T] = *(const LAS f32x4*)(sl + R3_G7 + (16 * T + 4 * q) * 4); }
                    const f32x4 vr = *(const LAS f32x4*)(sl + R3_VT + m * 32 + (q & 1) * 16);
                    v4u b0, b1;
                    b0.x = cvtpk(S[0][0], S[0][1]); b0.y = cvtpk(S[0][2], S[0][3]); b0.z = cvtpk(S[1][0], S[1][1]); b0.w = cvtpk(S[1][2], S[1][3]);
                    b1.x = cvtpk(S[2][0], S[2][1]); b1.y = cvtpk(S[2][2], S[2][3]); b1.z = cvtpk(S[3][0], S[3][1]); b1.w = cvtpk(S[3][2], S[3][3]);
                    f32x4 Dd = mfma16(a0, __builtin_bit_cast(bf16x8_t, b0), (f32x4){0.f, 0.f, 0.f, 0.f});
                    Dd = mfma16(a1, __builtin_bit_cast(bf16x8_t, b1), Dd);
                    v2u vb; vb.x = cvtpk(vr[0], vr[1]); vb.y = cvtpk(vr[2], vr[3]);
                    const f32x4 Z = __builtin_amdgcn_mfma_f32_16x16x16bf16_1k(A1f, __builtin_bit_cast(bf16x4_t, vb), Dd, 0, 0, 0);
                    v2u zb; zb.x = cvtpk(Z[0], Z[1]); zb.y = cvtpk(Z[2], Z[3]);
                    const f32x4 W = __builtin_amdgcn_mfma_f32_16x16x16bf16_1k(A2f, __builtin_bit_cast(bf16x4_t, zb), (f32x4){0.f, 0.f, 0.f, 0.f}, 0, 0, 0);
                    v2u wb; wb.x = cvtpk(W[0], W[1]); wb.y = cvtpk(W[2], W[3]);
                    const v2u ub = (q < 2) ? wb : vb;
#pragma unroll
                    for (int T = 0; T < 4; ++T) S[T] = __builtin_amdgcn_mfma_f32_16x16x16bf16_1k(UA[T], __builtin_bit_cast(bf16x4_t, ub), S[T] * g7[T], 0, 0, 0);
                    if (q >= 2) { const int st0 = (bt * R3_NCB + cc) * 8 + 4 * (q - 2);
#pragma unroll
                        for (int i = 0; i < 4; ++i) OD[(size_t)step_row(b, dir, st0 + i) * D] = W[i]; }
                }
            }
            __syncthreads();
        }
    }
}

constexpr int R4_DOTA = 0, R4_UPA = 2048, R4_A1 = 4096, R4_A2 = 4352, R4_G7 = 4608, R4_VT = 4864, R4_IMG = 6912, R4_SLOT = 5376, R4_NCH = NSTEP / 8, R4_NCB = 8;
constexpr size_t U_IMG = 872 * MiB;
constexpr size_t U_YST = U_OD1;
__device__ __forceinline__ void phase_rw_prep(PP p, LAS unsigned char* lds, int lane, int wave) {
    const int gw = blockIdx.x * NWAVES + wave, NGW = gridDim.x * NWAVES;
    const float* RKV = (const float*)(p->ws + WS_U + U_RKV); unsigned char* IMG = p->ws + WS_U + U_IMG;
    LAS unsigned char* da = lds + wave * 8192; LAS unsigned char* gb = da + 2048; LAS float* GL = (LAS float*)(da + 4096);
    LAS unsigned char* a12 = da + 5120;
    const int m = lane & 15, q = lane >> 4;
    const int s2 = lane >> 5, tp = (lane >> 4) & 1, kq = (lane & 15) >> 2, ii = (lane & 3) + 4 * tp, dpos = ((s2 * 4 + kq) * 8 + ii) * 2;
    float nrx[8], nkx[8], nvx[8], nlw[8], nav[8];
    auto ld = [&](int it2) {
        const int chain = it2 & 63, chunk = it2 >> 6, b = chain >> 5, dir = (chain >> 4) & 1, h = chain & 15, ch = h * 64 + lane;
        const float* WDp = (const float*)(p->ws + WS_U + U_WD) + (size_t)dir * NROW * D; const float* ADp = (const float*)(p->ws + WS_U + U_AD) + (size_t)dir * NROW * D;
#pragma unroll
        for (int j = 0; j < 8; ++j) { const int row = step_row(b, dir, chunk * 8 + j);
            nrx[j] = RKV[(size_t)row * 3072 + ch]; nkx[j] = RKV[(size_t)row * 3072 + 1024 + ch]; nvx[j] = RKV[(size_t)row * 3072 + 2048 + ch];
            nlw[j] = WDp[(size_t)row * D + ch]; nav[j] = ADp[(size_t)row * D + ch]; } };
    if (gw < 64 * R4_NCH) ld(gw);
    for (int it = gw; it < 64 * R4_NCH; it += NGW) {
        const int chain = it & 63, chunk = it >> 6, h = chain & 15, ch = h * 64 + lane;
        const float kkw = p->in[I_KK][ch], kaw = p->in[I_KA][ch];
        float rx[8], kx[8], vx[8], lw[8], av[8], kn[8];
#pragma unroll
        for (int j = 0; j < 8; ++j) { rx[j] = nrx[j]; kx[j] = nkx[j]; vx[j] = nvx[j]; lw[j] = nlw[j]; av[j] = nav[j]; }
        if (it + NGW < 64 * R4_NCH) ld(it + NGW);
#pragma unroll
        for (int j = 0; j < 8; ++j) { const float t = kx[j] * kkw; kn[j] = t / fmaxf(sqrtf(wave_sum(t * t)), 1e-12f); }
        float bj[8]; { float bb = 0.f;
#pragma unroll
            for (int j = 0; j < 8; ++j) { bb += lw[j]; bj[j] = bb; } }
        const float e7 = __expf(bj[7]);
        unsigned upa[8]; float ebprev = 1.f;
#pragma unroll
        for (int j = 0; j < 8; ++j) {
            const float eb = __expf(bj[j]), einv = 1.0f / eb, e7j = e7 * einv;
            const float beta = kn[j] * av[j], kd = kx[j] * (1.f + (av[j] - 1.f) * kaw);
            *(LAS unsigned short*)(da + j * 128 + dpos) = (unsigned short)f2bf(kn[j] * ebprev);
            *(LAS unsigned short*)(da + (8 + j) * 128 + dpos) = (unsigned short)f2bf(rx[j] * eb);
            *(LAS unsigned short*)(gb + j * 128 + dpos) = (unsigned short)f2bf(beta * einv);
            *(LAS unsigned short*)(gb + (8 + j) * 128 + dpos) = (unsigned short)f2bf(kd * einv);
            const unsigned ub = f2bf(-beta * e7j), uk = f2bf(kd * e7j);
            if (j & 1) { upa[j >> 1] |= ub << 16; upa[4 + (j >> 1)] |= uk << 16; } else { upa[j >> 1] = ub; upa[4 + (j >> 1)] = uk; }
            ebprev = eb;
        }
        unsigned char* img = IMG + ((size_t)chain * R4_NCH + chunk) * R4_IMG;
        { v4u* d = (v4u*)(img + R4_UPA + lane * 32); d[0] = (v4u){upa[0], upa[1], upa[2], upa[3]}; d[1] = (v4u){upa[4], upa[5], upa[6], upa[7]}; }
        ((float*)(img + R4_G7))[lane] = e7;
        { f32x4* d = (f32x4*)(img + R4_VT + lane * 32); d[0] = (f32x4){vx[0], vx[1], vx[2], vx[3]}; d[1] = (f32x4){vx[4], vx[5], vx[6], vx[7]}; }
        LDS_WAIT(); asm volatile("" ::: "memory");
        { v4u* d = (v4u*)(img + R4_DOTA); d[lane] = ((const LAS v4u*)da)[lane]; d[64 + lane] = ((const LAS v4u*)da)[64 + lane]; }
        f32x4 G = (f32x4){0.f, 0.f, 0.f, 0.f};
#pragma unroll
        for (int s = 0; s < 2; ++s) G = mfma16(*(const LAS bf16x8_t*)(da + m * 128 + (s * 4 + q) * 16), *(const LAS bf16x8_t*)(gb + m * 128 + (s * 4 + q) * 16), G);
        if (m >= 8) { const int i = m - 8;
#pragma unroll
            for (int jp = 0; jp < 4; ++jp) { const int row = 4 * q + jp; const bool keep = (row < 8) ? (i < row) : (i <= row - 8);
                *(LAS unsigned short*)(a12 + row * 16 + i * 2) = (unsigned short)f2bf(keep ? G[jp] : 0.f); } }
#pragma unroll
        for (int jp = 0; jp < 4; ++jp) GL[(4 * q + jp) * 16 + m] = G[jp];
        LDS_WAIT(); asm volatile("" ::: "memory");
        const int c = lane & 7; float Tc[8], M2[8];
#pragma unroll
        for (int j = 0; j < 8; ++j) { float t = (j == c) ? 1.f : 0.f; const f32x4 ra = *(const LAS f32x4*)(GL + j * 16), rb = *(const LAS f32x4*)(GL + j * 16 + 4);
#pragma unroll
            for (int i = 0; i < j; ++i) t -= (i < 4 ? ra[i & 3] : rb[i & 3]) * Tc[i];
            Tc[j] = t; }
#pragma unroll
        for (int j = 0; j < 8; ++j) { float t = 0.f; const f32x4 ra = *(const LAS f32x4*)(GL + (8 + j) * 16), rb = *(const LAS f32x4*)(GL + (8 + j) * 16 + 4);
#pragma unroll
            for (int i = 0; i <= j; ++i) t -= (i < 4 ? ra[i & 3] : rb[i & 3]) * Tc[i];
            M2[j] = t; }
        if (lane < 8) {
#pragma unroll
            for (int j = 0; j < 8; ++j) { *(LAS unsigned short*)(a12 + 256 + j * 16 + c * 2) = (unsigned short)f2bf(Tc[j]); *(LAS unsigned short*)(a12 + 256 + (8 + j) * 16 + c * 2) = (unsigned short)f2bf(M2[j]); } }
        LDS_WAIT(); asm volatile("" ::: "memory");
        if (lane < 32) ((v4u*)(img + R4_A1))[lane] = ((const LAS v4u*)a12)[lane];
        LDS_WAIT(); asm volatile("" ::: "memory");
    }
}
__device__ __forceinline__ void phase_rwkv_scan4(PP p, LAS unsigned char* lds, int vcu, int tid, int lane, int wave) {
    const int m = lane & 15, q = lane >> 4;
    const unsigned char* IMG = p->ws + WS_U + U_IMG;
    for (int unit = vcu; unit < 256; unit += gridDim.x) {
        const int chain = unit >> 2, slab = unit & 3, b = chain >> 5, dir = (chain >> 4) & 1, h = chain & 15;
        float* YST = (float*)(p->ws + WS_U + U_YST) + (size_t)unit * NSTEP * 16 + (q >= 2 ? 4 * (q - 2) : 0) * 16 + m;
        const unsigned char* cimg = IMG + (size_t)chain * R4_NCH * R4_IMG;
        f32x4 S[4];
#pragma unroll
        for (int T = 0; T < 4; ++T) S[T] = (f32x4){0.f, 0.f, 0.f, 0.f};
        v2u idf; { const int c0 = 4 * q; idf.x = ((c0 == m) ? 0x3F80u : 0u) | ((c0 + 1 == m) ? 0x3F800000u : 0u); idf.y = ((c0 + 2 == m) ? 0x3F80u : 0u) | ((c0 + 3 == m) ? 0x3F800000u : 0u); }
        const int li = (wave - 1) * 64 + lane;
        v4u pre[6];
        auto issue = [&](int bt) {
#pragma unroll
            for (int u = 0; u < 6; ++u) { const int pi = li + 448 * u, cc = pi / 336, off = pi - cc * 336;
                const unsigned char* src = cimg + (size_t)(bt * R4_NCB + cc) * R4_IMG + (off < 304 ? off * 16 : R4_VT + slab * 512 + (off - 304) * 16);
                pre[u] = *(const v4u*)src; } };
        auto commit = [&](int half) {
#pragma unroll
            for (int u = 0; u < 6; ++u) { const int pi = li + 448 * u, cc = pi / 336, off = pi - cc * 336;
                *(LAS v4u*)(lds + (half * R4_NCB + cc) * R4_SLOT + off * 16) = pre[u]; } };
        __syncthreads();
        if (wave >= 1) { issue(0); commit(0); issue(1); }
        __syncthreads();
        constexpr int NB4 = R4_NCH / R4_NCB;
        for (int bt = 0; bt < NB4; ++bt) {
            if (wave >= 1) { if (bt + 1 < NB4) { commit((bt + 1) & 1); if (bt + 2 < NB4) issue(bt + 2); } }
            else {
#pragma unroll 1
                for (int cc = 0; cc < R4_NCB; ++cc) {
                    const LAS unsigned char* sl = lds + ((bt & 1) * R4_NCB + cc) * R4_SLOT;
                    const bf16x8_t a0 = *(const LAS bf16x8_t*)(sl + R4_DOTA + m * 128 + q * 16), a1 = *(const LAS bf16x8_t*)(sl + R4_DOTA + m * 128 + (4 + q) * 16);
                    v2u A1u = *(const LAS v2u*)(sl + R4_A1 + m * 16 + (q & 1) * 8), A2u = *(const LAS v2u*)(sl + R4_A2 + m * 16 + (q & 1) * 8);
                    if (q >= 2) { A1u = (v2u){0u, 0u}; A2u = idf; }
                    bf16x4_t UA[4]; f32x4 g7[4];
#pragma unroll
                    for (int T = 0; T < 4; ++T) { UA[T] = *(const LAS bf16x4_t*)(sl + R4_UPA + (16 * T + m) * 32 + q * 8); g7[T] = *(const LAS f32x4*)(sl + R4_G7 + (16 * T + 4 * q) * 4); }
                    const f32x4 vr = *(const LAS f32x4*)(sl + R4_VT + m * 32 + (q & 1) * 16);
                    v4u b0, b1;
                    b0.x = cvtpk(S[0][0], S[0][1]); b0.y = cvtpk(S[0][2], S[0][3]); b0.z = cvtpk(S[1][0], S[1][1]); b0.w = cvtpk(S[1][2], S[1][3]);
                    b1.x = cvtpk(S[2][0], S[2][1]); b1.y = cvtpk(S[2][2], S[2][3]); b1.z = cvtpk(S[3][0], S[3][1]); b1.w = cvtpk(S[3][2], S[3][3]);
                    f32x4 Dd = mfma16(a0, __builtin_bit_cast(bf16x8_t, b0), (f32x4){0.f, 0.f, 0.f, 0.f});
                    Dd = mfma16(a1, __builtin_bit_cast(bf16x8_t, b1), Dd);
                    v2u vb; vb.x = cvtpk(vr[0], vr[1]); vb.y = cvtpk(vr[2], vr[3]);
                    const f32x4 Z = __builtin_amdgcn_mfma_f32_16x16x16bf16_1k(__builtin_bit_cast(bf16x4_t, A1u), __builtin_bit_cast(bf16x4_t, vb), Dd, 0, 0, 0);
                    v2u zb; zb.x = cvtpk(Z[0], Z[1]); zb.y = cvtpk(Z[2], Z[3]);
                    const f32x4 W = __builtin_amdgcn_mfma_f32_16x16x16bf16_1k(__builtin_bit_cast(bf16x4_t, A2u), __builtin_bit_cast(bf16x4_t, zb), (f32x4){0.f, 0.f, 0.f, 0.f}, 0, 0, 0);
                    v2u wb; wb.x = cvtpk(W[0], W[1]); wb.y = cvtpk(W[2], W[3]);
                    const v2u ub = (q < 2) ? wb : vb;
#pragma unroll
                    for (int T = 0; T < 4; ++T) S[T] = __builtin_amdgcn_mfma_f32_16x16x16bf16_1k(UA[T], __builtin_bit_cast(bf16x4_t, ub), S[T] * g7[T], 0, 0, 0);
                    if (q >= 2) { float* yp = YST + (size_t)(bt * R4_NCB + cc) * 128;
#pragma unroll
                        for (int i = 0; i < 4; ++i) yp[i * 16] = W[i]; }
                }
            }
            __syncthreads();
        }
    }
}
enum { PH_PRE = 0, PH_NORM0, PH_G_IN, PH_GLA_A, PH_GLA_B, PH_GLA_C, PH_HGRO, PH_G_HGO, PH_FFN0, PH_GATHER0, PH_GU0, PH_DN0, PH_COMB0,
       PH_LERP, PH_G_RKV, PH_G_L2, PH_RWPREP, PH_RWSCAN, PH_RWRO, PH_G_RWO, PH_FFN1, PH_GATHER1, PH_GU1, PH_DN1, PH_COMB1, NPHASES };

template <int ph> __device__ __forceinline__ void run_phase(PP p, LAS unsigned char* lds, int tid, int lane, int wave, int G, int bx, int vcu) {
    unsigned char* ws = p->ws;
    typedef pg8::bf16_t bt;
    switch (ph) {
        case PH_PRE: phase_pre(p, lds, tid, lane, wave); break;
        case PH_NORM0: phase_norm0(p, lane, wave); break;
        case PH_G_IN: {
            pg8::Gemm g{(const bt*)(ws + WS_H), (const bt*)(ws + WS_WIN), NROW, 5120, D}; pg8::StaticOrder S; S.init(NROW, 5120, G, bx);
            pg8::EpiStoreBf16 E{(bt*)(ws + WS_U + U_Z), 5120};
            pg8::gemm_phase<pg8::EpiStoreBf16, pg8::StaticOrder, true, true>(lds, g, S, E); } break;
        case PH_GLA_A: phase_gla_prep(p, lds, tid, lane, wave); break;
        case PH_GLA_B: phase_gla_scan(p, tid); break;
        case PH_GLA_C: phase_gla_out(p, lane, wave); break;
        case PH_HGRO: phase_hg_readout(p, lane, wave); break;
        case PH_G_HGO: {
            pg8::Gemm g{(const bt*)(ws + WS_A2), (const bt*)(ws + WS_WHGO), NROW, D, D}; pg8::StaticOrder S; S.init(NROW, D, G, bx);
            pg8::EpiResid E{p->in[I_X], p->in[I_CTX], (float*)(ws + WS_XR), modp(p, 0, 0, 2), 6144};
            pg8::gemm_phase<pg8::EpiResid, pg8::StaticOrder, true, true>(lds, g, S, E); } break;
        case PH_FFN0: phase_ffn_norm_route(p, 0, NROW, lane, wave); break;
        case PH_FFN1: phase_ffn_norm_route(p, 1, NLAT, lane, wave); break;
        case PH_GATHER0: phase_gather(p, 0, NROW, lds, tid, lane, wave); break;
        case PH_GATHER1: phase_gather(p, 1, NLAT, lds, tid, lane, wave); break;
        case PH_GU0: case PH_GU1: { const int layer = (ph == PH_GU1);
            pg8::Gemm g{(const bt*)(ws + WS_U + U_XB), (const bt*)(ws + WS_WGU) + (size_t)layer * NE * 2048 * D, CAP, 2048, D};
            pg8::MoeOrder S; S.init((const int*)(ws + WS_ROUTE + RT_TILEE), 8, (size_t)2048 * D * 2, G, vcu);
            pg8::EpiSwiglu E{(bt*)(ws + WS_U + U_ACT), p->in[I_BGU] + (size_t)layer * NE * 2048};
            pg8::gemm_phase<pg8::EpiSwiglu, pg8::MoeOrder, true, true>(lds, g, S, E); } break;
        case PH_DN0: case PH_DN1: { const int layer = (ph == PH_DN1);
            pg8::Gemm g{(const bt*)(ws + WS_U + U_ACT), (const bt*)(ws + WS_WD) + (size_t)layer * NE * D * D, CAP, D, D};
            pg8::MoeOrder S; S.init((const int*)(ws + WS_ROUTE + RT_TILEE), 4, (size_t)D * D * 2, G, vcu);
            pg8::EpiDown E{(bt*)(ws + WS_U + U_YS), p->in[I_BDN] + (size_t)layer * NE * D};
            pg8::gemm_phase<pg8::EpiDown, pg8::MoeOrder, true, true>(lds, g, S, E); } break;
        case PH_COMB0: phase_combine(p, 0, NROW, false, lane, wave); break;
        case PH_COMB1: phase_combine(p, 1, NLAT, true, lane, wave); break;
        case PH_LERP: phase_lerp(p, lane, wave); break;
        case PH_G_RKV: {
            { pg8::Gemm g{(const bt*)(ws + WS_U + U_XL6), (const bt*)(ws + WS_WRKV), NROW, 3072, D};
              pg8::SelOrder S; S.init(NROW, 3072, G, bx); S.div = 4; S.sel0 = 0; S.stride = (size_t)NROW * D * 2;
              pg8::EpiStoreF32 E{(float*)(ws + WS_U + U_RKV), 3072};
              pg8::gemm_phase<pg8::EpiStoreF32, pg8::SelOrder, true, true>(lds, g, S, E); }
            { pg8::Gemm g{(const bt*)(ws + WS_U + U_XL6), (const bt*)(ws + WS_WL1), NROW, 768, D};
              pg8::SelOrder S; S.init(NROW, 768, G, bx); S.div = 1; S.sel0 = 3; S.stride = (size_t)NROW * D * 2;
              pg8::EpiLora1 E{(bt*)(ws + WS_U + U_L1)};
              pg8::gemm_phase<pg8::EpiLora1, pg8::SelOrder, true, true>(lds, g, S, E); } } break;
        case PH_G_L2: {
            pg8::Gemm g{(const bt*)(ws + WS_U + U_L1), (const bt*)(ws + WS_WL2), NROW, 5120, 384}; pg8::StaticOrder S; S.init(NROW, 5120, G, bx);
            pg8::EpiLora2 E{(float*)(ws + WS_U + U_WD), (float*)(ws + WS_U + U_AD), (float*)(ws + WS_U + U_G), p->in[I_DECW0], p->in[I_A0]};
            pg8::gemm_phase<pg8::EpiLora2, pg8::StaticOrder, true, true>(lds, g, S, E); } break;
        case PH_RWPREP: phase_rw_prep(p, lds, lane, wave); break;
        case PH_RWSCAN: phase_rwkv_scan4(p, lds, vcu, tid, lane, wave); break;
        case PH_RWRO: phase_rw_readout(p, lane, wave); break;
        case PH_G_RWO: {
            pg8::Gemm g{(const bt*)(ws + WS_A2), (const bt*)(ws + WS_WRWO), NLAT, D, D}; pg8::StaticOrder S; S.init(NLAT, D, G, bx);
            float* XR = (float*)(ws + WS_XR);
            pg8::EpiResid E{XR, XR + (size_t)NLAT * D, XR, modp(p, 1, 0, 2), 6144};
            pg8::gemm_phase<pg8::EpiResid, pg8::StaticOrder, true, true>(lds, g, S, E); } break;
        default: break;
    }
}

#define MK_PROLOGUE \
    extern __shared__ __attribute__((aligned(16))) unsigned char lds_raw[]; \
    LAS unsigned char* lds = (LAS unsigned char*)lds_raw; \
    const int tid = threadIdx.x, lane = tid & 63, wave = __builtin_amdgcn_readfirstlane(tid >> 6); \
    const int G = gridDim.x, bx = blockIdx.x, vcu = (G % 8 == 0) ? (bx % 8) * (G / 8) + bx / 8 : bx;

#define XB_TMO      128
#define XB_XCNT(j)  (256  + 64 * (j))
#define XB_XSUB(j)  (1280 + 64 * (j))
#define XB_XGEN(j)  (2304 + 64 * (j))
#define XB_TOP      3328
#define XB_TOPGEN   3392
#define XCD_BAR_WORDS 3456
#define XB_SPIN_CAP (1u << 18)

__device__ __forceinline__ unsigned xb_ld(unsigned* p)              { return __hip_atomic_load(p, __ATOMIC_RELAXED, __HIP_MEMORY_SCOPE_AGENT); }
__device__ __forceinline__ unsigned xb_add(unsigned* p, unsigned v) { return __hip_atomic_fetch_add(p, v, __ATOMIC_RELAXED, __HIP_MEMORY_SCOPE_AGENT); }
__device__ __forceinline__ unsigned xb_xcc_id() { return (unsigned)__builtin_amdgcn_s_getreg((3 << 11) | 20) & 0xFu; }
#define XB_SPIN(cond, bar) do { unsigned _sp = 0; while (cond) { __builtin_amdgcn_s_sleep(1); \
    if ((++_sp & 255u) == 0u) { if (xb_ld(&(bar)[XB_TMO])) break; if (_sp > XB_SPIN_CAP) { atomicAdd(&(bar)[XB_TMO], 1u); break; } } } } while (0)

struct XcdBarrier {
    unsigned* bar; unsigned x;
    volatile LAS unsigned* st;
};

__device__ __forceinline__ XcdBarrier xcd_barrier_post(unsigned* bar, volatile LAS unsigned* st) {
    XcdBarrier b; b.bar = bar; b.x = xb_xcc_id(); b.st = st;
    if (threadIdx.x == 0) (void)xb_add(&bar[XB_XCNT(b.x)], 1u);
    return b;
}
__device__ __forceinline__ void xcd_barrier_complete(unsigned* bar, unsigned x, unsigned& nloc, unsigned& nx) {
    const unsigned G = gridDim.x * gridDim.y * gridDim.z;
    unsigned sum, cnt, mine, sp = 0u;
    for (;;) {
        sum = 0u; cnt = 0u; mine = 0u;
#pragma unroll
        for (unsigned j = 0; j < 16; ++j) { const unsigned c = xb_ld(&bar[XB_XCNT(j)]); sum += c; cnt += (c > 0u) ? 1u : 0u; mine = (j == x) ? c : mine; }
        if (sum == G) break;
        __builtin_amdgcn_s_sleep(1);
        if ((++sp & 255u) == 0u) { if (xb_ld(&bar[XB_TMO])) break; if (sp > XB_SPIN_CAP) { atomicAdd(&bar[XB_TMO], 1u); break; } }
    }
    nloc = mine > 0u ? mine : 1u; nx = cnt > 0u ? cnt : 1u;
}

__device__ __forceinline__ void xcd_barrier(const XcdBarrier& b) {
    asm volatile("s_waitcnt vmcnt(0)" ::: "memory");
    __syncthreads();
    if (threadIdx.x == 0) {
        unsigned* bar = b.bar;
        __builtin_amdgcn_s_waitcnt(0);
        unsigned nloc = b.st[0], nx = b.st[1];
        if (nloc == 0u) { xcd_barrier_complete(bar, b.x, nloc, nx); b.st[0] = nloc; b.st[1] = nx; }
        const unsigned old = xb_add(&bar[XB_XSUB(b.x)], 1u);
        const unsigned gen = old / nloc;
        if (old + 1u == (gen + 1u) * nloc) {
            __builtin_amdgcn_fence(__ATOMIC_RELEASE, "agent");
            asm volatile("s_waitcnt vmcnt(0)" ::: "memory");
            const unsigned og = xb_add(&bar[XB_TOP], 1u);
            const unsigned tg = og / nx;
            if (og + 1u == (tg + 1u) * nx) xb_add(&bar[XB_TOPGEN], 1u);
            else XB_SPIN(xb_ld(&bar[XB_TOPGEN]) == tg, bar);
            __builtin_amdgcn_fence(__ATOMIC_ACQUIRE, "agent");
            xb_add(&bar[XB_XGEN(b.x)], 1u);
            asm volatile("s_waitcnt vmcnt(0)" ::: "memory");
        } else {
            XB_SPIN(xb_ld(&bar[XB_XGEN(b.x)]) == gen, bar);
            __builtin_amdgcn_fence(__ATOMIC_ACQUIRE, "agent");
            asm volatile("s_waitcnt vmcnt(0)" ::: "memory");
        }
    }
    __syncthreads();
}

constexpr int LDSCTL_OFF = 131072, MISC_OFF = LDSCTL_OFF + 320;
__device__ __forceinline__ void grid_bar(PP kp, LAS unsigned char* lds) {
    PP q = kp; asm volatile("" : "+s"(q));
    XcdBarrier b; b.bar = (unsigned*)(q->ws + WS_CTL) + CW_BAR; b.x = xb_xcc_id(); b.st = (volatile LAS unsigned*)(lds + MISC_OFF) + 8;
    xcd_barrier(b);
}
namespace cg = cooperative_groups;
__global__ void __launch_bounds__(NTHREADS, 2) mk_fwd(Params pv) {
    MK_PROLOGUE
    cg::grid_group grid = cg::this_grid();
    PP kp = (PP)__builtin_amdgcn_kernarg_segment_ptr();
    const int lo = kp->ph_lo, hi = kp->ph_hi;
    for (int u = tid; u < (LDS_BYTES - LDSCTL_OFF) / 4; u += NTHREADS) ((LAS unsigned*)(lds + LDSCTL_OFF))[u] = 0u;
    __syncthreads();
    { XcdBarrier b0 = xcd_barrier_post((unsigned*)(kp->ws + WS_CTL) + CW_BAR, (volatile LAS unsigned*)(lds + MISC_OFF) + 8); (void)b0; }
#ifndef REPEAT_MASK
#define REPEAT_MASK 0u
#endif
#define RUN(k) if (lo <= (k) && (k) < hi) { PP q = kp; asm volatile("" : "+s"(q)); run_phase<k>(q, lds, tid, lane, wave, G, bx, vcu); \
        if ((REPEAT_MASK >> (k)) & 1u) { grid_bar(kp, lds); PP q2 = kp; asm volatile("" : "+s"(q2)); run_phase<k>(q2, lds, tid, lane, wave, G, bx, vcu); } \
        if ((k) + 1 < hi) { if ((k) == 0) grid.sync(); else grid_bar(kp, lds); } }
    RUN(0) RUN(1) RUN(2) RUN(3) RUN(4) RUN(5) RUN(6) RUN(7) RUN(8) RUN(9) RUN(10) RUN(11) RUN(12) RUN(13) RUN(14) RUN(15) RUN(16) RUN(17) RUN(18) RUN(19) RUN(20) RUN(21) RUN(22) RUN(23) RUN(24)
#undef RUN
}

extern "C" void kernel_launch(void* const* d_in, const int* in_sizes, int n_in, void* d_out, int out_size, void* d_ws, size_t ws_size, hipStream_t stream) {
    static int grid = 0;
    if (grid == 0) {
        if (n_in != 35 || in_sizes[0] != NLAT * D || out_size != NLAT * D || ws_size < WS_END) {
            fprintf(stderr, "kernel_launch: unexpected problem (n_in %d, in0 %d, out %d, ws %zu < %zu)\n", n_in, n_in > 0 ? in_sizes[0] : -1, out_size, ws_size, (size_t)WS_END); grid = -1; return; }
        int dev = 0, cus = 0, per_cu = 0;
        if (hipGetDevice(&dev) != hipSuccess || hipDeviceGetAttribute(&cus, hipDeviceAttributeMultiprocessorCount, dev) != hipSuccess) { grid = -1; return; }
        if (hipFuncSetAttribute((const void*)mk_fwd, hipFuncAttributeMaxDynamicSharedMemorySize, LDS_BYTES) != hipSuccess) { fprintf(stderr, "kernel_launch: hipFuncSetAttribute failed\n"); grid = -1; return; }
        if (hipOccupancyMaxActiveBlocksPerMultiprocessor(&per_cu, (const void*)mk_fwd, NTHREADS, LDS_BYTES) != hipSuccess || per_cu < 1) { fprintf(stderr, "kernel_launch: occupancy query %d\n", per_cu); per_cu = 1; }
        (void)hipGetLastError();
        grid = cus * (per_cu < 1 ? 1 : per_cu);
    }
    if (grid < 0) return;
    (void)hipMemsetAsync((char*)d_ws + WS_CTL, 0, CTL_ZERO_BYTES, stream);
    Params p{};
    for (int i = 0; i < 35; ++i) p.in[i] = (const float*)d_in[i];
    p.out = (float*)d_out; p.ws = (unsigned char*)d_ws;
    p.ph_lo = 0; p.ph_hi = NPHASES;
    void* args[] = {&p};
    hipError_t e = hipLaunchCooperativeKernel((const void*)mk_fwd, dim3(grid), dim3(NTHREADS), args, LDS_BYTES, stream);
    if (e != hipSuccess) fprintf(stderr, "kernel_launch: cooperative launch failed: %s (grid %d)\n", hipGetErrorString(e), grid);
}
```

```cpp
#include <hip/hip_runtime.h>
#include <hip/hip_cooperative_groups.h>
#include <cstdio>
#include <cstdint>
namespace pg8 {
#define PG8_LAS __attribute__((address_space(3)))
typedef unsigned short bf16_t;
typedef short bf16x8 __attribute__((ext_vector_type(8)));
typedef float f32x4 __attribute__((ext_vector_type(4)));
typedef unsigned u32x4 __attribute__((ext_vector_type(4)));
constexpr int BM = 256, BK = 64, HALF = 128, HTB = HALF * BK * 2  , STAGE_BYTES = 8 * HTB, NXCD = 8, WGM = 8;

__host__ __device__ __forceinline__ int lds_byte(int r, int c) { const int st = (r >> 4) * 2 + (c >> 5), rr = r & 15, cc = c & 31, ob = rr * 64 + cc * 2; return st * 1024 + (ob ^ (((ob >> 9) & 1) << 5)); }
__host__ __device__ __forceinline__ void stage_rc(int b, int& R, int& C) { const int st = b / 1024, sb = b % 1024, swz = sb ^ (((sb >> 9) & 1) << 5); R = (st >> 1) * 16 + swz / 64; C = (st & 1) * 32 + (swz % 64) / 2; }
__host__ __device__ __forceinline__ int perm32(int rho) { const int n = rho >> 4, i = rho & 15; return 8 * (i >> 2) + 4 * n + (i & 3); }

struct Unit { int pm, pn, e; };
struct Gemm { const bf16_t* A; const bf16_t* Bt; int M, N, K; };

struct StaticOrder {
    int nM, nN, nwg, G, c;
    __host__ __device__ void init(int M, int N, int G_, int c_) { nM = M / BM; nN = N / BM; nwg = nM * nN; G = G_; c = c_; }
    __host__ __device__ bool next(int i, Unit& u) const {
        const long L = (long)i * G + c; if (L >= nwg) return false;
        int wgid = (int)L; { const int q = nwg / NXCD, r = nwg % NXCD, xcd = wgid % NXCD, off = wgid / NXCD; wgid = (xcd < r ? xcd * (q + 1) : r * (q + 1) + (xcd - r) * q) + off; }
        const int nig = WGM * nN, gid = wgid / nig, fm = gid * WGM, gsz = (nM - fm) < WGM ? (nM - fm) : WGM;
        u.pm = fm + ((wgid % nig) % gsz); u.pn = (wgid % nig) / gsz; u.e = 0; return true;
    }
    __device__ __forceinline__ const char* abase(const Gemm& g, const Unit& u, size_t tstep) const { return (const char*)g.A + (size_t)u.pm * tstep; }
    __device__ __forceinline__ const char* bbase(const Gemm& g, const Unit& u, size_t tstep) const { return (const char*)g.Bt + (size_t)u.pn * tstep; }
    __device__ __forceinline__ void a_ready(const Unit&) const {}
    __device__ __forceinline__ void done(const Unit&) const {}
};

__device__ __forceinline__ unsigned cvt_pk_bf16(float lo, float hi) { unsigned r; asm volatile("v_cvt_pk_bf16_f32 %0, %1, %2" : "=v"(r) : "v"(lo), "v"(hi)); return r; }

template <class Epi, class Sched, bool ALIGN_EPI = false, bool SP2 = false>
__device__ __forceinline__ void gemm_phase(PG8_LAS unsigned char* lds, const Gemm g, const Sched& S, const Epi& E) {
    const int tid = threadIdx.x, wid = __builtin_amdgcn_readfirstlane(tid >> 6), lane = tid & 63, wr = wid >> 2, wc = wid & 3, fr = lane & 15, fq = lane >> 4;
    const int K = g.K, nt = K / BK;
    unsigned voffA[2], voffB[2];
#pragma unroll
    for (int i = 0; i < 2; ++i) { int R, C; stage_rc(tid * 16 + i * 8192, R, C); const int Rb = Epi::PERM ? ((R & ~31) + perm32(R & 31)) : R;
        voffA[i] = (unsigned)(R * K + C) * 2u; voffB[i] = (unsigned)(Rb * K + C) * 2u; }
    const size_t kstep = (size_t)(BK * 2);
    const size_t hstep = (size_t)HALF * K * 2;
    const size_t tstep = 2 * hstep;
    const unsigned ldsw = (unsigned)wid * 1024u;
    const int aoff = lds_byte(wr * 64 + fr, fq * 8), boff = lds_byte(wc * 32 + fr, fq * 8);
#define PG8_SA(b, h) (((b) * 2 + (h)) * HTB)
#define PG8_SB(b, h) ((4 + (b) * 2 + (h)) * HTB)
#define PG8_STAGE(bufoff, gbase, voff) do { _Pragma("unroll") for (int _i = 0; _i < 2; ++_i) \
        __builtin_amdgcn_global_load_lds((const unsigned*)((const char*)(gbase) + (voff)[_i]), (PG8_LAS unsigned*)(lds + (bufoff) + ldsw + _i * 8192), 16, 0, 0); } while (0)
#define PG8_LDA(dst, b, h) do { _Pragma("unroll") for (int m = 0; m < 4; ++m) _Pragma("unroll") for (int k = 0; k < 2; ++k) dst[m][k] = *(const PG8_LAS bf16x8*)(lds + PG8_SA(b, h) + aoff + m * 2048 + k * 1024); } while (0)
#define PG8_LDB(dst, b, h) do { _Pragma("unroll") for (int n = 0; n < 2; ++n) _Pragma("unroll") for (int k = 0; k < 2; ++k) dst[n][k] = *(const PG8_LAS bf16x8*)(lds + PG8_SB(b, h) + boff + n * 2048 + k * 1024); } while (0)
#define PG8_MMA(ai, bj, At, Bt) do { __builtin_amdgcn_s_setprio(1); _Pragma("unroll") for (int m = 0; m < 4; ++m) _Pragma("unroll") for (int n = 0; n < 2; ++n) _Pragma("unroll") for (int k = 0; k < 2; ++k) \
        acc[ai][bj][m][n] = __builtin_amdgcn_mfma_f32_16x16x32_bf16(Bt[n][k], At[m][k], acc[ai][bj][m][n], 0, 0, 0); __builtin_amdgcn_s_setprio(0); } while (0)
#define PG8_WAIT_V(n) asm volatile("s_waitcnt vmcnt(" #n ")" ::: "memory")
#define PG8_WAIT_L(n) asm volatile("s_waitcnt lgkmcnt(" #n ")" ::: "memory")
#define PG8_BAR __builtin_amdgcn_s_barrier()
#define PG8_SCHED __builtin_amdgcn_sched_barrier(0)
    Unit cur, nxt; int ui = 0;
    if (!S.next(0, cur)) return;
    f32x4 acc[2][2][4][2];
#pragma unroll
    for (int a = 0; a < 2; ++a)
#pragma unroll
        for (int b = 0; b < 2; ++b)
#pragma unroll
            for (int m = 0; m < 4; ++m)
#pragma unroll
                for (int n = 0; n < 2; ++n) acc[a][b][m][n] = (f32x4){0.f, 0.f, 0.f, 0.f};
    bf16x8 At[4][2], B0[2][2], B1[2][2];
    const char* cA = S.abase(g, cur, tstep); const char* cB = S.bbase(g, cur, tstep);
    S.a_ready(cur);
    if constexpr (SP2) {
        PG8_STAGE(PG8_SB(0, 0), cB, voffB); PG8_STAGE(PG8_SB(0, 1), cB + hstep, voffB); PG8_STAGE(PG8_SA(0, 0), cA, voffA); PG8_STAGE(PG8_SA(0, 1), cA + hstep, voffA);
        if (wr == 1) PG8_BAR;
        PG8_WAIT_V(2); PG8_BAR;
        PG8_STAGE(PG8_SB(1, 0), cB + kstep, voffB); PG8_STAGE(PG8_SA(1, 0), cA + kstep, voffA); PG8_STAGE(PG8_SB(1, 1), cB + hstep + kstep, voffB);
        PG8_WAIT_V(6); PG8_BAR;
    } else {
        PG8_STAGE(PG8_SB(0, 0), cB, voffB); PG8_STAGE(PG8_SA(0, 0), cA, voffA); PG8_STAGE(PG8_SB(0, 1), cB + hstep, voffB); PG8_STAGE(PG8_SA(0, 1), cA + hstep, voffA);
        if (wr == 1) PG8_BAR;
        PG8_WAIT_V(4); PG8_BAR;
        PG8_STAGE(PG8_SB(1, 0), cB + kstep, voffB); PG8_STAGE(PG8_SA(1, 0), cA + kstep, voffA); PG8_STAGE(PG8_SB(1, 1), cB + hstep + kstep, voffB);
        PG8_WAIT_V(6); PG8_BAR;
    }
    for (;;) {
        const bool has_next = S.next(ui + 1, nxt);
        const char* nA = has_next ? S.abase(g, nxt, tstep) : cA; const char* nB = has_next ? S.bbase(g, nxt, tstep) : cB;
        _Pragma("unroll 1") for (int t = 0; t < nt; t += 2) {
            const bool last = (t == nt - 2);
            const char* a1 = cA + (size_t)(t + 1) * kstep;
            const char* a2 = last ? nA : cA + (size_t)(t + 2) * kstep; const char* b2 = last ? nB : cB + (size_t)(t + 2) * kstep;
            const char* a3 = a2 + kstep; const char* b3 = b2 + kstep;
            if (last && has_next) S.a_ready(nxt);
            if constexpr (SP2) {
            PG8_LDB(B0, 0, 0); PG8_LDB(B1, 0, 1); PG8_SCHED; PG8_LDA(At, 0, 0); PG8_STAGE(PG8_SA(1, 1), a1 + hstep, voffA);
            PG8_WAIT_V(8); PG8_WAIT_L(0); PG8_BAR; PG8_MMA(0, 0, At, B0); PG8_MMA(0, 1, At, B1); PG8_BAR; PG8_SCHED;
            PG8_LDA(At, 0, 1); PG8_STAGE(PG8_SB(0, 0), b2, voffB); PG8_STAGE(PG8_SB(0, 1), b2 + hstep, voffB); PG8_STAGE(PG8_SA(0, 0), a2, voffA);
            PG8_WAIT_V(8); PG8_WAIT_L(0); PG8_BAR; PG8_MMA(1, 0, At, B0); PG8_MMA(1, 1, At, B1); PG8_BAR; PG8_SCHED;
            PG8_LDB(B0, 1, 0); PG8_LDB(B1, 1, 1); PG8_SCHED; PG8_LDA(At, 1, 0); PG8_STAGE(PG8_SA(0, 1), a2 + hstep, voffA);
            PG8_WAIT_V(8); PG8_WAIT_L(0); PG8_BAR; PG8_MMA(0, 0, At, B0); PG8_MMA(0, 1, At, B1); PG8_BAR; PG8_SCHED;
            PG8_LDA(At, 1, 1); PG8_STAGE(PG8_SB(1, 0), b3, voffB); PG8_STAGE(PG8_SB(1, 1), b3 + hstep, voffB); PG8_STAGE(PG8_SA(1, 0), a3, voffA);
            PG8_WAIT_V(8); PG8_WAIT_L(0); PG8_BAR; PG8_MMA(1, 0, At, B0); PG8_MMA(1, 1, At, B1); PG8_BAR; PG8_SCHED;
            } else {
            PG8_LDB(B0, 0, 0); PG8_SCHED; PG8_LDA(At, 0, 0); PG8_STAGE(PG8_SA(1, 1), a1 + hstep, voffA);
            PG8_WAIT_L(8); PG8_BAR; PG8_WAIT_L(0); PG8_MMA(0, 0, At, B0); PG8_BAR; PG8_SCHED;
            PG8_LDB(B1, 0, 1); PG8_STAGE(PG8_SB(0, 0), b2, voffB);
            PG8_BAR; PG8_WAIT_L(0); PG8_MMA(0, 1, At, B1); PG8_BAR;
            PG8_LDA(At, 0, 1); PG8_STAGE(PG8_SA(0, 0), a2, voffA);
            PG8_BAR; PG8_WAIT_L(0); PG8_MMA(1, 0, At, B0); PG8_BAR; PG8_SCHED;
            PG8_STAGE(PG8_SB(0, 1), b2 + hstep, voffB);
            PG8_WAIT_V(6); PG8_BAR; PG8_MMA(1, 1, At, B1); PG8_BAR;
            PG8_LDB(B0, 1, 0); PG8_SCHED; PG8_LDA(At, 1, 0); PG8_STAGE(PG8_SA(0, 1), a2 + hstep, voffA);
            PG8_WAIT_L(8); PG8_BAR; PG8_WAIT_L(0); PG8_MMA(0, 0, At, B0); PG8_BAR; PG8_SCHED;
            PG8_LDB(B1, 1, 1); PG8_STAGE(PG8_SB(1, 0), b3, voffB);
            PG8_BAR; PG8_WAIT_L(0); PG8_MMA(0, 1, At, B1); PG8_BAR;
            PG8_LDA(At, 1, 1); PG8_STAGE(PG8_SA(1, 0), a3, voffA);
            PG8_BAR; PG8_WAIT_L(0); PG8_MMA(1, 0, At, B0); PG8_BAR; PG8_SCHED;
            PG8_STAGE(PG8_SB(1, 1), b3 + hstep, voffB);
            PG8_WAIT_V(6); PG8_BAR; PG8_MMA(1, 1, At, B1); PG8_BAR;
            }
        }
        if constexpr (ALIGN_EPI) { if (wr == 0) PG8_BAR; }
        if constexpr (!Epi::AFTER_DRAIN) { E(acc, cur, wr, wc, fr, fq); S.done(cur); }
        if (!has_next) break;
#pragma unroll
        for (int a = 0; a < 2; ++a)
#pragma unroll
            for (int b = 0; b < 2; ++b)
#pragma unroll
                for (int m = 0; m < 4; ++m)
#pragma unroll
                    for (int n = 0; n < 2; ++n) acc[a][b][m][n] = (f32x4){0.f, 0.f, 0.f, 0.f};
        cur = nxt; cA = nA; cB = nB; ++ui;
        if constexpr (ALIGN_EPI) { if (wr == 1) PG8_BAR; }
    }
    PG8_WAIT_V(0);
    if constexpr (!ALIGN_EPI) { if (wr == 0) PG8_BAR; }
    PG8_BAR;
    if constexpr (Epi::AFTER_DRAIN) { E.fused(acc, cur, wr, wc, fr, fq, lds, wid, lane); S.done(cur); }
#undef PG8_SA
#undef PG8_SB
#undef PG8_STAGE
#undef PG8_LDA
#undef PG8_LDB
#undef PG8_MMA
#undef PG8_WAIT_V
#undef PG8_WAIT_L
#undef PG8_BAR
#undef PG8_SCHED
}
}

constexpr int D = 1024, NBATCH = 2, SEQ = 8192, CTXL = 256;
constexpr int NLAT = NBATCH * SEQ, NCTX = NBATCH * CTXL, NROW = NLAT + NCTX;
constexpr int NE = 32, TOPK = 4, MAXTILES = 296, CAP = MAXTILES * 256;
constexpr int NWAVES = 8, NTHREADS = 512;
constexpr float NORM_EPS = 1e-6f;
constexpr int LDS_BYTES = 147456;

constexpr size_t MiB = 1u << 20;
constexpr size_t WS_CTL = 0, CTL_ZERO_BYTES = 1 * MiB;
constexpr size_t WS_MOD = 1 * MiB;
constexpr size_t WS_ROUTE = 2 * MiB;
constexpr size_t RT_TOPI = 0, RT_TOPG = 320 * 1024, RT_POS = 640 * 1024, RT_SLOT = 960 * 1024, RT_RSTD = 1280 * 1024, RT_TILEE = 1408 * 1024;
constexpr size_t WS_WIN = 4 * MiB, WS_WHGO = 14 * MiB, WS_WRKV = 16 * MiB, WS_WL1 = 22 * MiB, WS_WL2 = 24 * MiB, WS_WRWO = 28 * MiB;
constexpr size_t WS_WGU = 32 * MiB, WS_WD = 288 * MiB;
constexpr size_t WS_XR = 416 * MiB, WS_H = 482 * MiB, WS_H2 = 515 * MiB, WS_A2 = 548 * MiB;
constexpr size_t WS_U = 584 * MiB;
constexpr size_t U_Z = 0, U_OD0 = 166 * MiB;
constexpr size_t U_XL6 = 0, U_RKV = 198 * MiB, U_L1 = 396 * MiB, U_WD = 410 * MiB, U_AD = 542 * MiB, U_G = 674 * MiB, U_OD1 = 740 * MiB;
constexpr size_t U_XB = 0, U_ACT = 148 * MiB, U_YS = 296 * MiB;
constexpr size_t WS_END = WS_U + 1320 * MiB;
constexpr int CW_CNT = 64;
constexpr int CW_BAR = 4096;

#define LAS __attribute__((address_space(3)))
typedef unsigned short bf16;
typedef unsigned v4u __attribute__((ext_vector_type(4)));
typedef unsigned v2u __attribute__((ext_vector_type(2)));
typedef float f32x4 __attribute__((ext_vector_type(4)));
#define LDS_WAIT() asm volatile("s_waitcnt lgkmcnt(0)" ::: "memory")
__device__ __forceinline__ unsigned f2bf(float f) { unsigned u = __builtin_bit_cast(unsigned, f); return (u + 0x7fffu + ((u >> 16) & 1u)) >> 16; }
__device__ __forceinline__ unsigned pk2(float lo, float hi) { return f2bf(lo) | (f2bf(hi) << 16); }
__device__ __forceinline__ float bf2f(unsigned b) { return __builtin_bit_cast(float, b << 16); }
__device__ __forceinline__ float wave_sum(float x) {
    x += __builtin_bit_cast(float, __builtin_amdgcn_update_dpp(0, __builtin_bit_cast(int, x), 0x128, 0xf, 0xf, false));
    x += __builtin_bit_cast(float, __builtin_amdgcn_update_dpp(0, __builtin_bit_cast(int, x), 0x124, 0xf, 0xf, false));
    x += __builtin_bit_cast(float, __builtin_amdgcn_update_dpp(0, __builtin_bit_cast(int, x), 0x122, 0xf, 0xf, false));
    x += __builtin_bit_cast(float, __builtin_amdgcn_update_dpp(0, __builtin_bit_cast(int, x), 0x121, 0xf, 0xf, false));
    x += __shfl_xor(x, 16); x += __shfl_xor(x, 32);
    return x;
}
__device__ __forceinline__ float sigm(float x) { return 1.0f / (1.0f + __expf(-x)); }

struct Params { const float* in[35]; float* out; unsigned char* ws; int ph_lo, ph_hi; };
typedef const __attribute__((address_space(4))) Params* PP;
enum { I_X = 0, I_C, I_CTX, I_CCTX, I_ADAW, I_ADAB, I_NMIX, I_NFFN, I_HGWIN, I_HGGN, I_HGWOUT, I_HGLB, I_MU, I_WRKV, I_DECW0, I_DECW1, I_DECW2,
       I_A0, I_A1, I_A2, I_G1, I_G2, I_KK, I_KA, I_RK, I_LNXW, I_LNXB, I_RWOUT, I_ROUTW, I_ROUTB, I_WGU, I_BGU, I_WDN, I_BDN, I_FINALG };

__device__ __forceinline__ const float* modp(PP p, int l, int v, int j) { return (const float*)(p->ws + WS_MOD) + ((size_t)(l * 3 + v) * 6 + j) * D; }
__device__ __forceinline__ int row_vec(int row) { return row < NLAT ? (row >= SEQ ? 1 : 0) : 2; }

__device__ __forceinline__ void ti_load(const float* src, int src_ld, int lane, float (&rg)[32]) {
    if (src) {
#pragma unroll
        for (int i = 0; i < 32; ++i) rg[i] = src[(size_t)(2 * i + (lane >> 5)) * src_ld + (lane & 31)];
    }
}
__device__ __forceinline__ void ti_store(bool nonzero, const float (&rg)[32], bf16* dst, int dst_ld, LAS float* scr, int lane) {
    if (nonzero) {
#pragma unroll
        for (int i = 0; i < 32; ++i) scr[(2 * i + (lane >> 5)) * 33 + (lane & 31)] = rg[i];
    }
    LDS_WAIT(); asm volatile("" ::: "memory");
    const int c = lane & 7;
#pragma unroll
    for (int j = 0; j < 4; ++j) {
        const int n = (lane >> 3) + 8 * j; v4u o = (v4u){0u, 0u, 0u, 0u};
        if (nonzero) { const LAS float* s = scr + (8 * c) * 33 + n;
            o.x = pk2(s[0 * 33], s[1 * 33]); o.y = pk2(s[2 * 33], s[3 * 33]); o.z = pk2(s[4 * 33], s[5 * 33]); o.w = pk2(s[6 * 33], s[7 * 33]); }
        *(v4u*)(dst + (size_t)n * dst_ld + 8 * c) = o;
    }
    LDS_WAIT(); asm volatile("" ::: "memory");
}
__device__ __forceinline__ void transpose_item(const float* src, int src_ld, bf16* dst, int dst_ld, LAS float* scr, int lane) {
    float rg[32]; ti_load(src, src_ld, lane, rg); ti_store(src != nullptr, rg, dst, dst_ld, scr, lane);
}
__device__ __forceinline__ void conv_plain(const float* W, int K, int N, bf16* WT, int r, LAS float* scr, int lane) {
    const int nblk = N / 32, kb = r / nblk, nb = r % nblk;
    transpose_item(W + (size_t)(kb * 64) * N + nb * 32, N, WT + (size_t)(nb * 32) * K + kb * 64, K, scr, lane);
}
constexpr int IT_WIN = 16 * 160, IT_SQ = 16 * 32, IT_L1 = 16 * 24, IT_L2 = 160 * 6, IT_GU = 64 * 16 * 64, IT_DN = 64 * 16 * 32;
constexpr int IT_GU0 = IT_GU / 2, IT_DN0 = IT_DN / 2;
constexpr int IT_TOTAL = IT_WIN + IT_SQ + 3 * IT_SQ + IT_SQ + IT_L1 + IT_L2 + IT_GU0 + IT_DN0, IT_L1MOE = IT_GU0 + IT_DN0;
__device__ __forceinline__ void convert_item(PP p, int it, LAS float* scr, int lane) {
    unsigned char* ws = p->ws; int r = it;
    if (r < IT_WIN) { conv_plain(p->in[I_HGWIN], D, 5120, (bf16*)(ws + WS_WIN), r, scr, lane); return; } r -= IT_WIN;
    if (r < IT_SQ) { conv_plain(p->in[I_HGWOUT], D, D, (bf16*)(ws + WS_WHGO), r, scr, lane); return; } r -= IT_SQ;
    if (r < 3 * IT_SQ) { const int j = r / IT_SQ; conv_plain(p->in[I_WRKV] + (size_t)j * D * D, D, D, (bf16*)(ws + WS_WRKV) + (size_t)j * D * D, r % IT_SQ, scr, lane); return; } r -= 3 * IT_SQ;
    if (r < IT_SQ) { conv_plain(p->in[I_RWOUT], D, D, (bf16*)(ws + WS_WRWO), r, scr, lane); return; } r -= IT_SQ;
    if (r < IT_L1) {
        const int kb = r / 24, rg = r % 24, tile = rg >> 3, within = rg & 7; const float* src = nullptr; int ld = 64;
        if (within < 4) {
            if (tile == 0) src = p->in[I_DECW1] + (size_t)(within >> 1) * D * 64 + (size_t)(kb * 64) * 64 + (within & 1) * 32;
            else if (tile == 1) src = p->in[I_A1] + (size_t)(within >> 1) * D * 64 + (size_t)(kb * 64) * 64 + (within & 1) * 32;
            else { src = p->in[I_G1] + (size_t)(kb * 64) * 128 + within * 32; ld = 128; }
        }
        transpose_item(src, ld, (bf16*)(ws + WS_WL1) + (size_t)(rg * 32) * D + kb * 64, D, scr, lane); return; } r -= IT_L1;
    if (r < IT_L2) {
        const int rg = r / 6, kb = r % 6, n0 = rg * 32, blk = n0 >> 10, nn0 = n0 & 1023; const float* src = nullptr;
        if (blk < 2) { if (kb == blk) src = p->in[I_DECW2] + (size_t)blk * 64 * D + nn0; }
        else if (blk < 4) { if (kb == blk) src = p->in[I_A2] + (size_t)(blk - 2) * 64 * D + nn0; }
        else { if (kb >= 4) src = p->in[I_G2] + (size_t)(kb - 4) * 64 * D + nn0; }
        transpose_item(src, D, (bf16*)(ws + WS_WL2) + (size_t)n0 * 384 + kb * 64, 384, scr, lane); return; } r -= IT_L2;
    if (r < IT_GU0) {
        const int mat = r >> 10, q = r & 1023, kb = q >> 6, nb = q & 63, n0 = nb * 32;
        const int j0 = n0 & 1023, drow = 256 * (j0 >> 7) + (n0 >= 1024 ? 128 : 0) + (j0 & 127);
        transpose_item(p->in[I_WGU] + (size_t)mat * D * 2048 + (size_t)(kb * 64) * 2048 + n0, 2048, (bf16*)(ws + WS_WGU) + (size_t)mat * 2048 * D + (size_t)drow * D + kb * 64, D, scr, lane); return; } r -= IT_GU0;
    { const int mat = r >> 9, q = r & 511;
      conv_plain(p->in[I_WDN] + (size_t)mat * D * D, D, D, (bf16*)(ws + WS_WD) + (size_t)mat * D * D, q, scr, lane); }
}
struct ConvJob { const float* src; int src_ld; bf16* dst; int dst_ld; };
__device__ __forceinline__ ConvJob conv_job_l1(PP p, int r) {
    unsigned char* ws = p->ws; ConvJob j;
    if (r < IT_GU0) { const int mat = 32 + (r >> 10), q = r & 1023, kb = q >> 6, nb = q & 63, n0 = nb * 32;
        const int j0 = n0 & 1023, drow = 256 * (j0 >> 7) + (n0 >= 1024 ? 128 : 0) + (j0 & 127);
        j.src = p->in[I_WGU] + (size_t)mat * D * 2048 + (size_t)(kb * 64) * 2048 + n0; j.src_ld = 2048;
        j.dst = (bf16*)(ws + WS_WGU) + (size_t)mat * 2048 * D + (size_t)drow * D + kb * 64; j.dst_ld = D; return j; }
    r -= IT_GU0;
    { const int mat = 32 + (r >> 9), q = r & 511, kb = q >> 5, nb = q & 31;
      j.src = p->in[I_WDN] + (size_t)mat * D * D + (size_t)(kb * 64) * D + nb * 32; j.src_ld = D;
      j.dst = (bf16*)(ws + WS_WD) + (size_t)mat * D * D + (size_t)(nb * 32) * D + kb * 64; j.dst_ld = D; return j; }
}
__device__ __forceinline__ void phase_pre(PP p, LAS unsigned char* lds, int tid, int lane, int wave) {
    if (blockIdx.x < 192) {
        const int layer = blockIdx.x / 96, col = (blockIdx.x % 96) * 64 + lane;
        const float* W = p->in[I_ADAW] + (size_t)layer * D * 6144 + col;
        const float* c = p->in[I_C]; const float* cc = p->in[I_CCTX];
        float a0 = 0.f, a1 = 0.f, a2 = 0.f;
#pragma unroll 8
        for (int k = wave * 128; k < wave * 128 + 128; ++k) {
            const float wv = W[(size_t)k * 6144]; const float c0 = c[k], c1 = c[D + k], c2 = cc[k];
            a0 += c0 * sigm(c0) * wv; a1 += c1 * sigm(c1) * wv; a2 += c2 * sigm(c2) * wv;
        }
        LAS float* red = (LAS float*)lds;
        red[(wave * 3 + 0) * 64 + lane] = a0; red[(wave * 3 + 1) * 64 + lane] = a1; red[(wave * 3 + 2) * 64 + lane] = a2;
        __syncthreads();
        if (wave == 0) {
            float s0 = 0.f, s1 = 0.f, s2 = 0.f;
#pragma unroll
            for (int w = 0; w < 8; ++w) { s0 += red[(w * 3 + 0) * 64 + lane]; s1 += red[(w * 3 + 1) * 64 + lane]; s2 += red[(w * 3 + 2) * 64 + lane]; }
            const float bb = p->in[I_ADAB][layer * 6144 + col];
            float* M = (float*)(p->ws + WS_MOD) + (size_t)layer * 3 * 6144 + col;
            M[0] = s0 + bb; M[6144] = s1 + bb; M[2 * 6144] = s2 + bb;
        }
        __syncthreads();
    }
    LAS float* scr = (LAS float*)(lds + wave * 16384);
    const int gw = blockIdx.x * NWAVES + wave, NGW = gridDim.x * NWAVES;
    for (int it = gw; it < IT_TOTAL; it += NGW) convert_item(p, it, scr, lane);
}

__device__ __forceinline__ void load_row(const float* row, int lane, f32x4 (&v)[4]) {
#pragma unroll
    for (int j = 0; j < 4; ++j) v[j] = ((const f32x4*)row)[lane + 64 * j];
}
__device__ __forceinline__ float row_rstd(const f32x4 (&v)[4]) {
    float s = 0.f;
#pragma unroll
    for (int j = 0; j < 4; ++j) s += (v[j].x * v[j].x + v[j].y * v[j].y) + (v[j].z * v[j].z + v[j].w * v[j].w);
    return rsqrtf(wave_sum(s) * (1.0f / D) + NORM_EPS);
}
__device__ __forceinline__ void norm_mod(const f32x4 (&v)[4], float rstd, const float* g, const float* shift, const float* scale, int lane, f32x4 (&h)[4]) {
#pragma unroll
    for (int j = 0; j < 4; ++j) {
        const f32x4 gg = ((const f32x4*)g)[lane + 64 * j], sh = ((const f32x4*)shift)[lane + 64 * j], sc = ((const f32x4*)scale)[lane + 64 * j];
        h[j] = v[j] * rstd * gg * (sc + 1.0f) + sh;
    }
}
__device__ __forceinline__ void store_row_bf16(bf16* row, int lane, const f32x4 (&h)[4]) {
#pragma unroll
    for (int j = 0; j < 4; ++j) { v2u w; w.x = pk2(h[j].x, h[j].y); w.y = pk2(h[j].z, h[j].w); ((v2u*)row)[lane + 64 * j] = w; }
}
__device__ __forceinline__ const float* resid_row(PP p, int layer0_inputs, int row) {
    if (layer0_inputs) return row < NLAT ? p->in[I_X] + (size_t)row * D : p->in[I_CTX] + (size_t)(row - NLAT) * D;
    return (const float*)(p->ws + WS_XR) + (size_t)row * D;
}
__device__ __forceinline__ void phase_norm0(PP p, int lane, int wave) {
    const int gw = blockIdx.x * NWAVES + wave, NGW = gridDim.x * NWAVES;
    for (int row = gw; row < NROW; row += NGW) {
        f32x4 v[4], h[4]; load_row(resid_row(p, 1, row), lane, v);
        const float rstd = row_rstd(v); const int vec = row_vec(row);
        norm_mod(v, rstd, p->in[I_NMIX], modp(p, 0, vec, 0), modp(p, 0, vec, 1), lane, h);
        store_row_bf16((bf16*)(p->ws + WS_H) + (size_t)row * D, lane, h);
    }
}
__device__ __forceinline__ void route_select(float (&part)[NE], const float* rb, int row, int* TOPI, float* TOPG, int* POS, unsigned* cnt, int lane, bool write) {
#pragma unroll
    for (int e = 0; e < NE; ++e) part[e] = wave_sum(part[e]) + rb[e];
    unsigned taken = 0u; int idx[TOPK]; float val[TOPK];
#pragma unroll
    for (int k = 0; k < TOPK; ++k) {
        float best = -3.0e38f; int bi = 0;
#pragma unroll
        for (int e = 0; e < NE; ++e) { const bool ok = !((taken >> e) & 1u) && (part[e] > best); best = ok ? part[e] : best; bi = ok ? e : bi; }
        taken |= 1u << bi; idx[k] = bi; val[k] = best;
    }
    float ex[TOPK], se = 0.f;
#pragma unroll
    for (int k = 0; k < TOPK; ++k) { ex[k] = __expf(val[k] - val[0]); se += ex[k]; }
    if (lane == 0 && write) {
#pragma unroll
        for (int k = 0; k < TOPK; ++k) { TOPI[row * 4 + k] = idx[k]; TOPG[row * 4 + k] = ex[k] / se; POS[row * 4 + k] = (int)atomicAdd(cnt + idx[k], 1u); }
    }
}
__device__ __forceinline__ void phase_ffn_norm_route(PP p, int layer, int nrows, LAS unsigned char* lds, int lane, int wave) {
    const int gw = blockIdx.x * NWAVES + wave, NGW = gridDim.x * NWAVES;
    const float* rw = p->in[I_ROUTW] + (size_t)layer * D * NE; const float* rb = p->in[I_ROUTB] + layer * NE;
    int* TOPI = (int*)(p->ws + WS_ROUTE + RT_TOPI); float* TOPG = (float*)(p->ws + WS_ROUTE + RT_TOPG); int* POS = (int*)(p->ws + WS_ROUTE + RT_POS);
    unsigned* cnt = (unsigned*)(p->ws + WS_CTL) + CW_CNT + layer * NE;
    for (int row0 = gw; row0 < nrows; row0 += 2 * NGW) {
        const bool has1 = row0 + NGW < nrows; const int row1 = has1 ? row0 + NGW : row0;
        f32x4 h0[4], h1[4];
        { f32x4 v[4]; load_row((const float*)(p->ws + WS_XR) + (size_t)row0 * D, lane, v); const float rstd = row_rstd(v); const int vec = row_vec(row0);
          norm_mod(v, rstd, p->in[I_NFFN] + layer * D, modp(p, layer, vec, 3), modp(p, layer, vec, 4), lane, h0);
          store_row_bf16((bf16*)(p->ws + WS_H2) + (size_t)row0 * D, lane, h0); }
        { f32x4 v[4]; load_row((const float*)(p->ws + WS_XR) + (size_t)row1 * D, lane, v); const float rstd = row_rstd(v); const int vec = row_vec(row1);
          norm_mod(v, rstd, p->in[I_NFFN] + layer * D, modp(p, layer, vec, 3), modp(p, layer, vec, 4), lane, h1);
          if (has1) store_row_bf16((bf16*)(p->ws + WS_H2) + (size_t)row1 * D, lane, h1); }
        LAS float* hs = (LAS float*)(lds + wave * 8192);
#pragma unroll
        for (int j = 0; j < 4; ++j)
#pragma unroll
            for (int i = 0; i < 4; ++i) { hs[(4 * j + i) * 64 + lane] = h0[j][i]; hs[1024 + (4 * j + i) * 64 + lane] = h1[j][i]; }
        LDS_WAIT(); asm volatile("" ::: "memory");
        float pa[NE], pb[NE];
#pragma unroll
        for (int e = 0; e < NE; ++e) { pa[e] = 0.f; pb[e] = 0.f; }
#pragma unroll 2
        for (int t = 0; t < 16; ++t) {
            const float x0 = hs[t * 64 + lane], x1 = hs[1024 + t * 64 + lane]; const f32x4* wr = (const f32x4*)(rw + (size_t)(4 * lane + 256 * (t >> 2) + (t & 3)) * NE);
#pragma unroll
            for (int q = 0; q < 8; ++q) { const f32x4 w4 = wr[q];
                pa[4 * q + 0] += x0 * w4.x; pa[4 * q + 1] += x0 * w4.y; pa[4 * q + 2] += x0 * w4.z; pa[4 * q + 3] += x0 * w4.w;
                pb[4 * q + 0] += x1 * w4.x; pb[4 * q + 1] += x1 * w4.y; pb[4 * q + 2] += x1 * w4.z; pb[4 * q + 3] += x1 * w4.w; }
        }
        LDS_WAIT(); asm volatile("" ::: "memory");
        route_select(pa, rb, row0, TOPI, TOPG, POS, cnt, lane, true);
        route_select(pb, rb, row1, TOPI, TOPG, POS, cnt, lane, has1);
    }
}
__device__ __forceinline__ void phase_gather(PP p, int layer, int nrows, LAS unsigned char* lds, int tid, int lane, int wave) {
    LAS int* off = (LAS int*)lds;
    const unsigned* cnt = (const unsigned*)(p->ws + WS_CTL) + CW_CNT + layer * NE;
    int* TILEE = (int*)(p->ws + WS_ROUTE + RT_TILEE);
    if (tid == 0) {
        int o = 0;
        for (int e = 0; e < NE; ++e) { off[e] = o; const int nt = ((int)__hip_atomic_load(cnt + e, __ATOMIC_RELAXED, __HIP_MEMORY_SCOPE_AGENT) + 255) >> 8;
            if (blockIdx.x == 0) for (int t = 0; t < nt; ++t) TILEE[1 + (o >> 8) + t] = e;
            o += nt << 8; }
        off[NE] = o; if (blockIdx.x == 0) TILEE[0] = o >> 8;
    }
    __syncthreads();
    const int* TOPI = (const int*)(p->ws + WS_ROUTE + RT_TOPI); const int* POS = (const int*)(p->ws + WS_ROUTE + RT_POS); int* SLOT = (int*)(p->ws + WS_ROUTE + RT_SLOT);
    const bf16* H2 = (const bf16*)(p->ws + WS_H2); bf16* XB = (bf16*)(p->ws + WS_U + U_XB);
    const int gw = blockIdx.x * NWAVES + wave, NGW = gridDim.x * NWAVES;
    for (int it = gw; it < nrows * TOPK; it += NGW) {
        const int row = it >> 2; const int slot = off[TOPI[it]] + POS[it];
        if (lane == 0) SLOT[it] = slot;
        const v4u* s = (const v4u*)(H2 + (size_t)row * D); v4u* d = (v4u*)(XB + (size_t)slot * D);
        d[lane] = s[lane]; d[lane + 64] = s[lane + 64];
    }
    __syncthreads();
}
__device__ __forceinline__ void phase_combine(PP p, int layer, int nrows, bool final_out, int lane, int wave) {
    const int gw = blockIdx.x * NWAVES + wave, NGW = gridDim.x * NWAVES;
    const float* TOPG = (const float*)(p->ws + WS_ROUTE + RT_TOPG); const int* SLOT = (const int*)(p->ws + WS_ROUTE + RT_SLOT);
    const bf16* YS = (const bf16*)(p->ws + WS_U + U_YS); float* XR = (float*)(p->ws + WS_XR); float* RSTD = (float*)(p->ws + WS_ROUTE + RT_RSTD);
    for (int row = gw; row < nrows; row += NGW) {
        f32x4 v[4], acc[4]; load_row(XR + (size_t)row * D, lane, v);
#pragma unroll
        for (int j = 0; j < 4; ++j) acc[j] = (f32x4){0.f, 0.f, 0.f, 0.f};
#pragma unroll
        for (int k = 0; k < TOPK; ++k) {
            const float gk = TOPG[row * 4 + k]; const v2u* ys = (const v2u*)(YS + (size_t)SLOT[row * 4 + k] * D);
#pragma unroll
            for (int j = 0; j < 4; ++j) { const v2u w = ys[lane + 64 * j];
                acc[j].x += gk * bf2f(w.x & 0xffffu); acc[j].y += gk * bf2f(w.x >> 16); acc[j].z += gk * bf2f(w.y & 0xffffu); acc[j].w += gk * bf2f(w.y >> 16); }
        }
        const float* m5 = modp(p, layer, row_vec(row), 5);
#pragma unroll
        for (int j = 0; j < 4; ++j) v[j] = v[j] + ((const f32x4*)m5)[lane + 64 * j] * acc[j];
        const float rstd = row_rstd(v);
        if (final_out) {
#pragma unroll
            for (int j = 0; j < 4; ++j) ((f32x4*)(p->out + (size_t)row * D))[lane + 64 * j] = v[j] * rstd * ((const f32x4*)p->in[I_FINALG])[lane + 64 * j];
        } else {
#pragma unroll
            for (int j = 0; j < 4; ++j) ((f32x4*)(XR + (size_t)row * D))[lane + 64 * j] = v[j];
            if (lane == 0) RSTD[row] = rstd;
        }
    }
}

__device__ __forceinline__ int step_row(int b, int dir, int step) {
    if (step < CTXL) { const int t = dir ? (CTXL - 1 - step) : step; return NLAT + b * CTXL + t; }
    const int s = step - CTXL; const int t = dir ? (SEQ - 1 - s) : s; return b * SEQ + t;
}
constexpr int NSTEP = CTXL + SEQ;

__device__ __forceinline__ void phase_hg_readout(PP p, int lane, int wave) {
    const int gw = blockIdx.x * NWAVES + wave, NGW = gridDim.x * NWAVES;
    const bf16* Z = (const bf16*)(p->ws + WS_U + U_Z); const float* OD = (const float*)(p->ws + WS_U + U_OD0); bf16* A2 = (bf16*)(p->ws + WS_A2);
    const float* gn = p->in[I_HGGN];
    for (int row = gw; row < NROW; row += NGW) {
#pragma unroll
        for (int h = 0; h < 8; ++h) {
            const int c = h * 128 + 2 * lane;
            const float2 a = *(const float2*)(OD + (size_t)row * D + c), bq = *(const float2*)(OD + (size_t)(NROW + row) * D + c);
            const float o0 = a.x + bq.x, o1 = a.y + bq.y;
            const float rstd = rsqrtf(wave_sum(o0 * o0 + o1 * o1) * (1.0f / 128.0f) + NORM_EPS);
            const unsigned gz = *(const unsigned*)(Z + (size_t)row * 5120 + 4096 + c); const float g0 = bf2f(gz & 0xffffu), g1 = bf2f(gz >> 16);
            const float r0 = o0 * rstd * gn[2 * lane] * (g0 * sigm(g0)), r1 = o1 * rstd * gn[2 * lane + 1] * (g1 * sigm(g1));
            *(unsigned*)(A2 + (size_t)row * D + c) = pk2(r0, r1);
        }
    }
}

__device__ __forceinline__ void phase_lerp(PP p, int lane, int wave) {
    const int gw = blockIdx.x * NWAVES + wave, NGW = gridDim.x * NWAVES;
    const float* XR = (const float*)(p->ws + WS_XR); const float* RSTD = (const float*)(p->ws + WS_ROUTE + RT_RSTD);
    bf16* XL6 = (bf16*)(p->ws + WS_U + U_XL6); const float* g = p->in[I_NMIX] + D; const float* mu = p->in[I_MU];
    for (int row = gw; row < NROW; row += NGW) {
        const int vec = row_vec(row); const float* sh = modp(p, 1, vec, 0); const float* sc = modp(p, 1, vec, 1);
        int nb[4];
        if (row < NLAT) { const int t = row & (SEQ - 1), w = t & 63, r = t >> 6;
            nb[0] = (w >= 1) ? row - 1 : -1; nb[1] = (w < 63) ? row + 1 : -1; nb[2] = (r >= 1) ? row - 64 : -1; nb[3] = (r < SEQ / 64 - 1) ? row + 64 : -1;
        } else { const int t = (row - NLAT) & (CTXL - 1);
            nb[0] = nb[1] = (t >= 1) ? row - 1 : -1; nb[2] = nb[3] = (t < CTXL - 1) ? row + 1 : -1; }
        const float rs = RSTD[row];
#pragma unroll
        for (int j = 0; j < 4; ++j) {
            const int ci = lane + 64 * j;
            const f32x4 gg = ((const f32x4*)g)[ci], s1 = ((const f32x4*)sc)[ci] + 1.0f, s0 = ((const f32x4*)sh)[ci];
            const f32x4 xs = ((const f32x4*)(XR + (size_t)row * D))[ci];
            const f32x4 hs = xs * rs * gg * s1 + s0;
            f32x4 hn = (f32x4){0.f, 0.f, 0.f, 0.f};
            if (nb[j] >= 0) { const f32x4 xn = ((const f32x4*)(XR + (size_t)nb[j] * D))[ci]; hn = xn * RSTD[nb[j]] * gg * s1 + s0; }
            const f32x4 dx = hn - hs;
#pragma unroll
            for (int s = 0; s < 6; ++s) {
                const int m = (s == 0) ? 0 : (s == 1) ? 2 : (s == 2) ? 3 : (s == 3) ? 1 : (s == 4) ? 4 : 5;
                const f32x4 o = hs + dx * ((const f32x4*)(mu + m * D))[ci];
                v2u w; w.x = pk2(o.x, o.y); w.y = pk2(o.z, o.w);
                ((v2u*)(XL6 + ((size_t)s * NROW + row) * D))[ci] = w;
            }
        }
    }
}
__device__ __forceinline__ void phase_rw_readout(PP p, int lane, int wave) {
    const int gw = blockIdx.x * NWAVES + wave, NGW = gridDim.x * NWAVES;
    const bf16* RKV = (const bf16*)(p->ws + WS_U + U_RKV); const bf16* AD = (const bf16*)(p->ws + WS_U + U_AD); const bf16* G = (const bf16*)(p->ws + WS_U + U_G);
    const float* OD = (const float*)(p->ws + WS_U + U_OD1); bf16* A2 = (bf16*)(p->ws + WS_A2);
    for (int row = gw; row < NLAT; row += NGW) {
#pragma unroll 4
        for (int h = 0; h < 16; ++h) {
            const int ch = h * 64 + lane;
            const int bq = row >> 13, tq = row & (SEQ - 1), u0 = ((bq * 32 + h) * 4 + (lane >> 4)), u1 = ((bq * 32 + 16 + h) * 4 + (lane >> 4));
            const float y = OD[((size_t)u0 * NSTEP + CTXL + tq) * 16 + (lane & 15)] + OD[((size_t)u1 * NSTEP + CTXL + (SEQ - 1 - tq)) * 16 + (lane & 15)];
            const float mean = wave_sum(y) * (1.0f / 64.0f); const float d = y - mean; const float var = wave_sum(d * d) * (1.0f / 64.0f);
            float yn = d * rsqrtf(var + 64.0e-5f) * p->in[I_LNXW][ch] + p->in[I_LNXB][ch];
            const float r = bf2f(RKV[(size_t)row * 3072 + ch]), k = bf2f(RKV[(size_t)row * 3072 + 1024 + ch]), v = bf2f(RKV[(size_t)row * 3072 + 2048 + ch]);
            const float ka = p->in[I_KA][ch], rk = p->in[I_RK][ch];
#pragma unroll
            for (int dd = 0; dd < 2; ++dd) { const float a = bf2f(AD[((size_t)dd * NROW + row) * D + ch]); const float kd = k * (1.f + (a - 1.f) * ka);
                yn += wave_sum(r * kd * rk) * v; }
            const float o = yn * bf2f(G[(size_t)row * D + ch]);
            const float o1 = __shfl_down(o, 1);
            if (!(lane & 1)) *(unsigned*)(A2 + (size_t)row * D + ch) = pk2(o, o1);
        }
    }
}

namespace pg8 {
struct SelOrder : StaticOrder {
    int div, sel0; size_t stride;
    __device__ __forceinline__ const char* abase(const Gemm& g, const Unit& u, size_t tstep) const { return (const char*)g.A + (size_t)(sel0 + u.pn / div) * stride + (size_t)u.pm * tstep; }
};
struct MoeOrder {
    const int* tilee; int nt, ntn, G, c; size_t estride;
    __device__ __forceinline__ void init(const int* te, int ntn_, size_t es, int G_, int c_) { tilee = te; nt = te[0]; ntn = ntn_; estride = es; G = G_; c = c_; }
    __device__ __forceinline__ bool next(int i, Unit& u) const { const long L = (long)i * G + c; if (L >= (long)nt * ntn) return false; u.pm = (int)(L / ntn); u.pn = (int)(L % ntn); u.e = tilee[1 + u.pm]; return true; }
    __device__ __forceinline__ const char* abase(const Gemm& g, const Unit& u, size_t tstep) const { return (const char*)g.A + (size_t)u.pm * tstep; }
    __device__ __forceinline__ const char* bbase(const Gemm& g, const Unit& u, size_t tstep) const { return (const char*)g.Bt + (size_t)u.e * estride + (size_t)u.pn * tstep; }
    __device__ __forceinline__ void a_ready(const Unit&) const {}
    __device__ __forceinline__ void done(const Unit&) const {}
};
struct EpiStoreBf16 {
    static constexpr bool PERM = true, AFTER_DRAIN = false;
    bf16_t* O; int ldc;
    __device__ __forceinline__ void operator()(const f32x4 (&acc)[2][2][4][2], const Unit& u, int wr, int wc, int fr, int fq) const {
        const int row0 = u.pm * BM + wr * 64 + fr, col0 = u.pn * BM + wc * 32 + 8 * fq;
#pragma unroll
        for (int ai = 0; ai < 2; ++ai)
#pragma unroll
            for (int m = 0; m < 4; ++m) { bf16_t* rowp = O + (size_t)(row0 + ai * HALF + m * 16) * ldc + col0;
#pragma unroll
                for (int bj = 0; bj < 2; ++bj) { const f32x4 v0 = acc[ai][bj][m][0], v1 = acc[ai][bj][m][1];
                    u32x4 w; w.x = cvt_pk_bf16(v0[0], v0[1]); w.y = cvt_pk_bf16(v0[2], v0[3]); w.z = cvt_pk_bf16(v1[0], v1[1]); w.w = cvt_pk_bf16(v1[2], v1[3]);
                    *(u32x4*)(rowp + bj * HALF) = w; } }
    }
};
struct EpiStoreF32 {
    static constexpr bool PERM = false, AFTER_DRAIN = false;
    float* C; int ldc;
    __device__ __forceinline__ void operator()(const f32x4 (&acc)[2][2][4][2], const Unit& u, int wr, int wc, int fr, int fq) const {
        const int row0 = u.pm * BM + wr * 64 + fr, col0 = u.pn * BM + wc * 32 + 4 * fq;
#pragma unroll
        for (int ai = 0; ai < 2; ++ai)
#pragma unroll
            for (int m = 0; m < 4; ++m) { float* rowp = C + (size_t)(row0 + ai * HALF + m * 16) * ldc + col0;
#pragma unroll
                for (int bj = 0; bj < 2; ++bj)
#pragma unroll
                    for (int n = 0; n < 2; ++n) *(f32x4*)(rowp + bj * HALF + n * 16) = acc[ai][bj][m][n]; }
    }
};
struct EpiResid {
    static constexpr bool PERM = false, AFTER_DRAIN = false;
    const float* base_lat; const float* base_ctx; float* out; const float* gate; int gstride;
    __device__ __forceinline__ void operator()(const f32x4 (&acc)[2][2][4][2], const Unit& u, int wr, int wc, int fr, int fq) const {
        const int row0 = u.pm * BM + wr * 64 + fr, col0 = u.pn * BM + wc * 32 + 4 * fq;
#pragma unroll
        for (int ai = 0; ai < 2; ++ai)
#pragma unroll
            for (int m = 0; m < 4; ++m) { const int row = row0 + ai * HALF + m * 16;
                const float* bp = (row < 16384) ? base_lat + (size_t)row * 1024 : base_ctx + (size_t)(row - 16384) * 1024;
                const float* gp = gate + (size_t)(row < 16384 ? (row >= 8192 ? 1 : 0) : 2) * gstride;
                float* op = out + (size_t)row * 1024;
#pragma unroll
                for (int bj = 0; bj < 2; ++bj)
#pragma unroll
                    for (int n = 0; n < 2; ++n) { const int c = col0 + bj * HALF + n * 16;
                        *(f32x4*)(op + c) = *(const f32x4*)(bp + c) + *(const f32x4*)(gp + c) * acc[ai][bj][m][n]; } }
    }
};
__device__ __forceinline__ float sigm_(float x) { return 1.0f / (1.0f + __expf(-x)); }
struct EpiSwiglu {
    static constexpr bool PERM = true, AFTER_DRAIN = false;
    bf16_t* O; const float* bgu;
    __device__ __forceinline__ void operator()(const f32x4 (&acc)[2][2][4][2], const Unit& u, int wr, int wc, int fr, int fq) const {
        const int row0 = u.pm * BM + wr * 64 + fr, col0 = u.pn * HALF + wc * 32 + 8 * fq;
        const float* bg = bgu + (size_t)u.e * 2048 + col0; f32x4 bgv[2], buv[2];
#pragma unroll
        for (int n = 0; n < 2; ++n) { bgv[n] = *(const f32x4*)(bg + 4 * n); buv[n] = *(const f32x4*)(bg + 1024 + 4 * n); }
#pragma unroll
        for (int ai = 0; ai < 2; ++ai)
#pragma unroll
            for (int m = 0; m < 4; ++m) { float r[8];
#pragma unroll
                for (int n = 0; n < 2; ++n) { const f32x4 g4 = acc[ai][0][m][n] + bgv[n], u4 = acc[ai][1][m][n] + buv[n];
#pragma unroll
                    for (int j = 0; j < 4; ++j) { const float g = fminf(g4[j], 7.0f), uu = fminf(fmaxf(u4[j], -7.0f), 7.0f); r[4 * n + j] = g * sigm_(1.702f * g) * (uu + 1.0f); } }
                u32x4 w; w.x = cvt_pk_bf16(r[0], r[1]); w.y = cvt_pk_bf16(r[2], r[3]); w.z = cvt_pk_bf16(r[4], r[5]); w.w = cvt_pk_bf16(r[6], r[7]);
                *(u32x4*)(O + (size_t)(row0 + ai * HALF + m * 16) * 1024 + col0) = w; }
    }
};
struct EpiDown {
    static constexpr bool PERM = true, AFTER_DRAIN = false;
    bf16_t* O; const float* bdn;
    __device__ __forceinline__ void operator()(const f32x4 (&acc)[2][2][4][2], const Unit& u, int wr, int wc, int fr, int fq) const {
        const int row0 = u.pm * BM + wr * 64 + fr, col0 = u.pn * BM + wc * 32 + 8 * fq;
        const float* bp = bdn + (size_t)u.e * 1024 + col0; f32x4 bv[2][2];
#pragma unroll
        for (int bj = 0; bj < 2; ++bj)
#pragma unroll
            for (int n = 0; n < 2; ++n) bv[bj][n] = *(const f32x4*)(bp + bj * HALF + 4 * n);
#pragma unroll
        for (int ai = 0; ai < 2; ++ai)
#pragma unroll
            for (int m = 0; m < 4; ++m) { bf16_t* rowp = O + (size_t)(row0 + ai * HALF + m * 16) * 1024 + col0;
#pragma unroll
                for (int bj = 0; bj < 2; ++bj) { const f32x4 v0 = acc[ai][bj][m][0] + bv[bj][0], v1 = acc[ai][bj][m][1] + bv[bj][1];
                    u32x4 w; w.x = cvt_pk_bf16(v0[0], v0[1]); w.y = cvt_pk_bf16(v0[2], v0[3]); w.z = cvt_pk_bf16(v1[0], v1[1]); w.w = cvt_pk_bf16(v1[2], v1[3]);
                    *(u32x4*)(rowp + bj * HALF) = w; } }
    }
};
struct EpiLora1 {
    static constexpr bool PERM = true, AFTER_DRAIN = false;
    bf16_t* O;
    __device__ __forceinline__ void operator()(const f32x4 (&acc)[2][2][4][2], const Unit& u, int wr, int wc, int fr, int fq) const {
        const int row0 = u.pm * BM + wr * 64 + fr, col0 = u.pn * HALF + wc * 32 + 8 * fq;
#pragma unroll
        for (int ai = 0; ai < 2; ++ai)
#pragma unroll
            for (int m = 0; m < 4; ++m) { float r[8];
#pragma unroll
                for (int n = 0; n < 2; ++n)
#pragma unroll
                    for (int j = 0; j < 4; ++j) { const float x = acc[ai][0][m][n][j]; r[4 * n + j] = (u.pn == 0) ? (2.0f * sigm_(2.0f * x) - 1.0f) : (u.pn == 1) ? x : sigm_(x); }
                u32x4 w; w.x = cvt_pk_bf16(r[0], r[1]); w.y = cvt_pk_bf16(r[2], r[3]); w.z = cvt_pk_bf16(r[4], r[5]); w.w = cvt_pk_bf16(r[6], r[7]);
                *(u32x4*)(O + (size_t)(row0 + ai * HALF + m * 16) * 384 + col0) = w; }
    }
};
struct EpiLora2 {
    static constexpr bool PERM = false, AFTER_DRAIN = false;
    bf16_t* WD; bf16_t* AD; bf16_t* G; const float* w0; const float* a0;
    __device__ __forceinline__ void operator()(const f32x4 (&acc)[2][2][4][2], const Unit& u, int wr, int wc, int fr, int fq) const {
        const int row0 = u.pm * BM + wr * 64 + fr, blk = u.pn >> 2, col0 = (u.pn & 3) * BM + wc * 32 + 4 * fq;
        bf16_t* dst = (blk < 2) ? WD + (size_t)blk * 16896 * 1024 : (blk < 4) ? AD + (size_t)(blk - 2) * 16896 * 1024 : G;
        const float* bias = (blk < 2) ? w0 + blk * 1024 : a0 + ((blk - 2) & 1) * 1024;
#pragma unroll
        for (int ai = 0; ai < 2; ++ai)
#pragma unroll
            for (int m = 0; m < 4; ++m) { bf16_t* rowp = dst + (size_t)(row0 + ai * HALF + m * 16) * 1024;
#pragma unroll
                for (int bj = 0; bj < 2; ++bj)
#pragma unroll
                    for (int n = 0; n < 2; ++n) { const int c = col0 + bj * HALF + n * 16; f32x4 v = acc[ai][bj][m][n];
                        const f32x4 bb = *(const f32x4*)(bias + c);
                        if (blk < 2) { for (int j = 0; j < 4; ++j) v[j] = -0.60653066f * sigm_(v[j] + bb[j]); }
                        else if (blk < 4) { for (int j = 0; j < 4; ++j) v[j] = sigm_(v[j] + bb[j]); }
                        unsigned lo = cvt_pk_bf16(v[0], v[1]), hi = cvt_pk_bf16(v[2], v[3]);
                        *(unsigned long long*)(rowp + c) = (unsigned long long)lo | ((unsigned long long)hi << 32); }
                asm volatile("" ::: "memory"); }
    }
};
}

constexpr int GLA_NCH = NSTEP / 64;
constexpr int GLA_ITEMS = 2 * NBATCH * GLA_NCH * 8;
constexpr size_t U_DS = 298 * MiB, U_OI = 430 * MiB, U_QT = 562 * MiB, U_LAM = 628 * MiB;
typedef short bf16x8_t __attribute__((ext_vector_type(8)));
typedef float f32x2g __attribute__((ext_vector_type(2)));
__device__ __forceinline__ f32x4 mfma16(bf16x8_t a, bf16x8_t b, f32x4 c) { return __builtin_amdgcn_mfma_f32_16x16x32_bf16(a, b, c, 0, 0, 0); }

__device__ __forceinline__ void phase_gla_prep(PP p, LAS unsigned char* lds, int tid, int lane, int wave) {
    constexpr int PQ = 272, PT = 144;
    LAS unsigned char* QA = lds;
    LAS unsigned char* QX = QA + 64 * PQ;
    LAS unsigned char* KB = QX + 48 * PQ;
    LAS unsigned char* KD = KB + 64 * PQ;
    LAS unsigned char* KT = KD + 64 * PQ;
    LAS unsigned char* VT = KT + 128 * PT;
    LAS unsigned char* PI = VT + 128 * PT;
    LAS float* GT = (LAS float*)(PI + 64 * PT);
    const bf16* Z = (const bf16*)(p->ws + WS_U + U_Z);
    bf16* DS = (bf16*)(p->ws + WS_U + U_DS); v2u* OI = (v2u*)(p->ws + WS_U + U_OI); bf16* QT = (bf16*)(p->ws + WS_U + U_QT); float* LAM = (float*)(p->ws + WS_U + U_LAM);
    const int kp = tid & 63, gg = tid >> 6, g = gg >> 1, hh = gg & 1, k0 = 2 * kp, kq = lane >> 4, c16 = lane & 15;
    unsigned zf[8], zq[8], zv[8];
    auto ldz = [&](int item2) {
        const int h2 = item2 & 7, cc2 = (item2 >> 3) % GLA_NCH, db2 = (item2 >> 3) / GLA_NCH, b2 = db2 & 1, dir2 = db2 >> 1;
#pragma unroll
        for (int i = 0; i < 8; ++i) { const size_t zr = (size_t)step_row(b2, dir2, 64 * cc2 + 8 * gg + i) * 5120 + h2 * 128 + k0;
            zf[i] = *(const unsigned*)(Z + zr + 1024 * (1 + dir2)); zq[i] = *(const unsigned*)(Z + zr); zv[i] = *(const unsigned*)(Z + zr + 3072); } };
    if ((int)blockIdx.x < GLA_ITEMS) ldz(blockIdx.x);
    for (int item = blockIdx.x; item < GLA_ITEMS; item += gridDim.x) {
        const int h = item & 7, db = (item >> 3) / GLA_NCH, dir = db >> 1;
        float lbv[2];
#pragma unroll
        for (int e = 0; e < 2; ++e) { const float* lb = p->in[I_HGLB] + (size_t)dir * 3 * D + h * 128 + k0 + e; const float a0 = lb[0], a1 = lb[D], a2 = lb[2 * D];
            const float mx = fmaxf(a0, fmaxf(a1, a2)); const float e0 = __expf(a0 - mx), e1 = __expf(a1 - mx), e2 = __expf(a2 - mx); lbv[e] = e0 / (e0 + e1 + e2); }
        for (int u = tid; u < 64 * PT / 4; u += NTHREADS) ((LAS unsigned*)PI)[u] = 0u;
        float cs[2][8], kin[2][8], qs[2][8], run[2] = {0.f, 0.f}; unsigned vlo[4], vhi[4];
#pragma unroll
        for (int i = 0; i < 8; ++i) {
#pragma unroll
            for (int e = 0; e < 2; ++e) {
                const float fh = bf2f(e ? (zf[i] >> 16) : (zf[i] & 0xffffu)), qv = bf2f(e ? (zq[i] >> 16) : (zq[i] & 0xffffu));
                const float f = lbv[e] + (1.f - lbv[e]) * sigm(fh);
                run[e] += __logf(f); cs[e][i] = run[e]; kin[e][i] = 1.f - f; qs[e][i] = qv * sigm(qv);
            }
            if (i & 1) { vlo[i >> 1] |= zv[i] << 16; vhi[i >> 1] |= zv[i] & 0xffff0000u; } else { vlo[i >> 1] = zv[i] & 0xffffu; vhi[i >> 1] = zv[i] >> 16; }
        }
        if (item + (int)gridDim.x < GLA_ITEMS) ldz(item + gridDim.x);
        *(LAS f32x2g*)(GT + gg * 128 + k0) = (f32x2g){run[0], run[1]};
        *(LAS v4u*)(VT + k0 * PT + 16 * gg) = (v4u){vlo[0], vlo[1], vlo[2], vlo[3]};
        *(LAS v4u*)(VT + (k0 + 1) * PT + 16 * gg) = (v4u){vhi[0], vhi[1], vhi[2], vhi[3]};
        __syncthreads();
        f32x2g t8[8];
#pragma unroll
        for (int u = 0; u < 8; ++u) t8[u] = *(const LAS f32x2g*)(GT + u * 128 + k0);
        unsigned ktl[4], kth[4];
        float rgv[2], totv[2], runSv[2], lov[2], t1v[2], t2v[2];
#pragma unroll
        for (int e = 0; e < 2; ++e) {
            const float s0 = e ? t8[0].y : t8[0].x, s1 = e ? t8[1].y : t8[1].x, s2 = e ? t8[2].y : t8[2].x, s3 = e ? t8[3].y : t8[3].x;
            const float s4 = e ? t8[4].y : t8[4].x, s5 = e ? t8[5].y : t8[5].x, s6 = e ? t8[6].y : t8[6].x, s7 = e ? t8[7].y : t8[7].x;
            const float q0 = s0 + s1, q1 = s2 + s3, q2 = s4 + s5, q3 = s6 + s7;
            rgv[e] = (g > 0 ? q0 : 0.f) + (g > 1 ? q1 : 0.f) + (g > 2 ? q2 : 0.f); totv[e] = (q0 + q1) + (q2 + q3);
            runSv[e] = (g == 0) ? q0 : (g == 1) ? q1 : (g == 2) ? q2 : q3;
            const float first = (g == 0) ? s0 : (g == 1) ? s2 : (g == 2) ? s4 : s6;
            lov[e] = hh ? first : 0.f; t1v[e] = q1; t2v[e] = q2;
        }
        float erg[2], einv[2], eend[2], ex1[2], ex2[2];
#pragma unroll
        for (int e = 0; e < 2; ++e) { erg[e] = __expf(rgv[e]); einv[e] = __expf(-runSv[e]); eend[e] = __expf(totv[e] - (rgv[e] + runSv[e]));
            ex1[e] = (g == 2) ? __expf(t1v[e]) : __expf(t2v[e]); ex2[e] = __expf(t1v[e] + t2v[e]); }
        bf16* qtp = QT + (size_t)item * 64 * 128 + (size_t)(16 * g + 8 * hh) * 128 + k0;
#pragma unroll
        for (int i = 0; i < 8; ++i) {
            float qh[2], kb[2];
#pragma unroll
            for (int e = 0; e < 2; ++e) { const float cr = lov[e] + cs[e][i]; qh[e] = qs[e][i] * __expf(cr); kb[e] = kin[e][i] * __expf(runSv[e] - cr); }
            const int ro = (16 * g + 8 * hh + i) * PQ + 2 * k0;
            *(LAS unsigned*)(QA + ro) = pk2(qh[0], qh[1]);
            *(LAS unsigned*)(KB + ro) = pk2(kb[0], kb[1]);
            *(LAS unsigned*)(KD + ro) = pk2(kb[0] * einv[0], kb[1] * einv[1]);
            if (g == 2) *(LAS unsigned*)(QX + (8 * hh + i) * PQ + 2 * k0) = pk2(qh[0] * ex1[0], qh[1] * ex1[1]);
            if (g == 3) { *(LAS unsigned*)(QX + (16 + 8 * hh + i) * PQ + 2 * k0) = pk2(qh[0] * ex1[0], qh[1] * ex1[1]); *(LAS unsigned*)(QX + (32 + 8 * hh + i) * PQ + 2 * k0) = pk2(qh[0] * ex2[0], qh[1] * ex2[1]); }
            *(unsigned*)(qtp + (size_t)i * 128) = pk2(qh[0] * erg[0], qh[1] * erg[1]);
            const unsigned kv0 = f2bf(kb[0] * eend[0]), kv1 = f2bf(kb[1] * eend[1]);
            if (i & 1) { ktl[i >> 1] |= kv0 << 16; kth[i >> 1] |= kv1 << 16; } else { ktl[i >> 1] = kv0; kth[i >> 1] = kv1; }
        }
        *(LAS v4u*)(KT + k0 * PT + 16 * gg) = (v4u){ktl[0], ktl[1], ktl[2], ktl[3]};
        *(LAS v4u*)(KT + (k0 + 1) * PT + 16 * gg) = (v4u){kth[0], kth[1], kth[2], kth[3]};
        if (gg == 0) *(f32x2g*)(LAM + (size_t)item * 128 + k0) = (f32x2g){__expf(totv[0]), __expf(totv[1])};
        __syncthreads();
        for (int blk = wave; blk < 10; blk += 8) {
            const int gi = (blk >= 6) ? 3 : (blk >= 3) ? 2 : (blk >= 1) ? 1 : 0, ji = blk - ((gi * (gi + 1)) >> 1);
            const LAS unsigned char* ab = (ji + 1 >= gi) ? QA + 16 * gi * PQ : (gi == 2) ? QX : (ji == 1) ? QX + 16 * PQ : QX + 32 * PQ;
            const LAS unsigned char* bb = ((ji == gi) ? KD : KB) + 16 * ji * PQ;
            f32x4 acc = (f32x4){0.f, 0.f, 0.f, 0.f};
#pragma unroll
            for (int s = 0; s < 4; ++s) {
                const bf16x8_t a = *(const LAS bf16x8_t*)(ab + c16 * PQ + (32 * s + 8 * kq) * 2), bv = *(const LAS bf16x8_t*)(bb + c16 * PQ + (32 * s + 8 * kq) * 2);
                acc = mfma16(a, bv, acc);
            }
#pragma unroll
            for (int j = 0; j < 4; ++j) { const int tau = 4 * kq + j; const float val = (ji == gi && c16 > tau) ? 0.f : acc[j];
                *(LAS unsigned short*)(PI + (16 * gi + tau) * PT + (16 * ji + c16) * 2) = (unsigned short)f2bf(val); }
        }
        __syncthreads();
        {
            const LAS unsigned char* vb = VT + (16 * wave + c16) * PT + 16 * kq;
            const bf16x8_t v0 = *(const LAS bf16x8_t*)(vb), v1 = *(const LAS bf16x8_t*)(vb + 64);
#pragma unroll
            for (int gi = 0; gi < 4; ++gi) {
                const LAS unsigned char* pb = PI + (16 * gi + c16) * PT + 16 * kq;
                f32x4 acc = mfma16(*(const LAS bf16x8_t*)(pb), v0, (f32x4){0.f, 0.f, 0.f, 0.f});
                if (gi >= 2) acc = mfma16(*(const LAS bf16x8_t*)(pb + 64), v1, acc);
                { v2u w; w.x = pk2(acc[0], acc[1]); w.y = pk2(acc[2], acc[3]); OI[((size_t)item * 8 + wave) * 256 + gi * 64 + lane] = w; }
            }
            bf16* dsp = DS + (size_t)item * 128 * 128 + (size_t)(16 * wave + c16) * 128 + 4 * kq;
#pragma unroll
            for (int m = 0; m < 8; ++m) {
                const LAS unsigned char* kb2 = KT + (16 * m + c16) * PT + 16 * kq;
                f32x4 acc = mfma16(*(const LAS bf16x8_t*)(kb2), v0, (f32x4){0.f, 0.f, 0.f, 0.f});
                acc = mfma16(*(const LAS bf16x8_t*)(kb2 + 64), v1, acc);
                v2u w; w.x = pk2(acc[0], acc[1]); w.y = pk2(acc[2], acc[3]);
                *(v2u*)(dsp + 16 * m) = w;
            }
        }
        __syncthreads();
    }
}
__device__ __forceinline__ void phase_gla_scan(PP p, int tid) {
    bf16* DS = (bf16*)(p->ws + WS_U + U_DS); const float* LAM = (const float*)(p->ws + WS_U + U_LAM);
    const int nthr = gridDim.x * NTHREADS;
    for (int e = blockIdx.x * NTHREADS + tid; e < 32 * 2048; e += nthr) {
        const int chain = e >> 11, el = e & 2047, h = chain & 7, db = chain >> 3, k8 = (el & 15) * 8;
        float s[8];
#pragma unroll
        for (int i = 0; i < 8; ++i) s[i] = 0.f;
        for (int c0 = 0; c0 < GLA_NCH; c0 += 6) {
            v4u d[6]; f32x4 l0[6], l1[6];
#pragma unroll
            for (int u = 0; u < 6; ++u) { const size_t item = ((size_t)db * GLA_NCH + c0 + u) * 8 + h;
                d[u] = *(const v4u*)(DS + item * 16384 + (size_t)el * 8); l0[u] = *(const f32x4*)(LAM + item * 128 + k8); l1[u] = *(const f32x4*)(LAM + item * 128 + k8 + 4); }
#pragma unroll
            for (int u = 0; u < 6; ++u) { const size_t item = ((size_t)db * GLA_NCH + c0 + u) * 8 + h;
                v4u o; o.x = pk2(s[0], s[1]); o.y = pk2(s[2], s[3]); o.z = pk2(s[4], s[5]); o.w = pk2(s[6], s[7]);
                *(v4u*)(DS + item * 16384 + (size_t)el * 8) = o;
                s[0] = l0[u].x * s[0] + bf2f(d[u].x & 0xffffu); s[1] = l0[u].y * s[1] + bf2f(d[u].x >> 16);
                s[2] = l0[u].z * s[2] + bf2f(d[u].y & 0xffffu); s[3] = l0[u].w * s[3] + bf2f(d[u].y >> 16);
                s[4] = l1[u].x * s[4] + bf2f(d[u].z & 0xffffu); s[5] = l1[u].y * s[5] + bf2f(d[u].z >> 16);
                s[6] = l1[u].z * s[6] + bf2f(d[u].w & 0xffffu); s[7] = l1[u].w * s[7] + bf2f(d[u].w >> 16); }
        }
    }
}
__device__ __forceinline__ void phase_gla_out(PP p, int lane, int wave) {
    const bf16* DS = (const bf16*)(p->ws + WS_U + U_DS); const v2u* OI = (const v2u*)(p->ws + WS_U + U_OI); const bf16* QT = (const bf16*)(p->ws + WS_U + U_QT);
    float* ODb = (float*)(p->ws + WS_U + U_OD0);
    const int kq = lane >> 4, c16 = lane & 15;
    for (int item = blockIdx.x; item < GLA_ITEMS; item += gridDim.x) {
        const int h = item & 7, cc = (item >> 3) % GLA_NCH, db = (item >> 3) / GLA_NCH, b = db & 1, dir = db >> 1;
        const bf16* sp = DS + (size_t)item * 16384 + (size_t)(16 * wave + c16) * 128 + 8 * kq;
        bf16x8_t bv[4];
#pragma unroll
        for (int s = 0; s < 4; ++s) bv[s] = *(const bf16x8_t*)(sp + 32 * s);
        float* OD = ODb + (size_t)dir * NROW * D + h * 128 + 16 * wave + c16;
#pragma unroll
        for (int gi = 0; gi < 4; ++gi) {
            const bf16* qp = QT + (size_t)item * 8192 + (size_t)(16 * gi + c16) * 128 + 8 * kq;
            const v2u ow = OI[((size_t)item * 8 + wave) * 256 + gi * 64 + lane];
            f32x4 acc = (f32x4){bf2f(ow.x & 0xffffu), bf2f(ow.x >> 16), bf2f(ow.y & 0xffffu), bf2f(ow.y >> 16)};
#pragma unroll
            for (int s = 0; s < 4; ++s) acc = mfma16(*(const bf16x8_t*)(qp + 32 * s), bv[s], acc);
#pragma unroll
            for (int j = 0; j < 4; ++j) OD[(size_t)step_row(b, dir, 64 * cc + 16 * gi + 4 * kq + j) * D] = acc[j];
        }
    }
}

typedef short bf16x4_t __attribute__((ext_vector_type(4)));
typedef float f32x2_t __attribute__((ext_vector_type(2))); typedef __bf16 bf16x2v_t __attribute__((ext_vector_type(2)));
__device__ __forceinline__ unsigned cvtpk(float lo, float hi) { const f32x2_t v = {lo, hi}; const bf16x2v_t b = __builtin_convertvector(v, bf16x2v_t); return __builtin_bit_cast(unsigned, b); }
constexpr int R4_DOTA = 0, R4_UPA = 2048, R4_A1 = 4096, R4_A2 = 4352, R4_G7 = 4608, R4_VT = 4864, R4_IMG = 6912, R4_SLOT = 5376, R4_NCH = NSTEP / 8, R4_NCB = 8;
constexpr size_t U_IMG = 872 * MiB;
constexpr size_t U_YST = U_OD1;
__device__ __forceinline__ void phase_rw_prep(PP p, LAS unsigned char* lds, int lane, int wave) {
    const int gw = blockIdx.x * NWAVES + wave, NGW = gridDim.x * NWAVES;
    const bf16* RKV = (const bf16*)(p->ws + WS_U + U_RKV); unsigned char* IMG = p->ws + WS_U + U_IMG;
    LAS unsigned char* da = lds + wave * 8192; LAS unsigned char* gb = da + 2048; LAS float* GL = (LAS float*)(da + 4096);
    LAS unsigned char* a12 = da + 5120;
    const int m = lane & 15, q = lane >> 4;
    const int s2 = lane >> 5, tp = (lane >> 4) & 1, kq = (lane & 15) >> 2, ii = (lane & 3) + 4 * tp, dpos = ((s2 * 4 + kq) * 8 + ii) * 2;
    float nrx[8], nkx[8], nvx[8], nlw[8], nav[8];
    auto ld = [&](int it2) {
        const int chain = it2 & 63, chunk = it2 >> 6, b = chain >> 5, dir = (chain >> 4) & 1, h = chain & 15, ch = h * 64 + lane;
        const bf16* WDp = (const bf16*)(p->ws + WS_U + U_WD) + (size_t)dir * NROW * D; const bf16* ADp = (const bf16*)(p->ws + WS_U + U_AD) + (size_t)dir * NROW * D;
#pragma unroll
        for (int j = 0; j < 8; ++j) { const int row = step_row(b, dir, chunk * 8 + j);
            nrx[j] = bf2f(RKV[(size_t)row * 3072 + ch]); nkx[j] = bf2f(RKV[(size_t)row * 3072 + 1024 + ch]); nvx[j] = bf2f(RKV[(size_t)row * 3072 + 2048 + ch]);
            nlw[j] = bf2f(WDp[(size_t)row * D + ch]); nav[j] = bf2f(ADp[(size_t)row * D + ch]); } };
    if (gw < 64 * R4_NCH) ld(gw);
    for (int it = gw; it < 64 * R4_NCH; it += NGW) {
        const int chain = it & 63, chunk = it >> 6, h = chain & 15, ch = h * 64 + lane;
        const float kkw = p->in[I_KK][ch], kaw = p->in[I_KA][ch];
        float rx[8], kx[8], vx[8], lw[8], av[8], kn[8];
#pragma unroll
        for (int j = 0; j < 8; ++j) { rx[j] = nrx[j]; kx[j] = nkx[j]; vx[j] = nvx[j]; lw[j] = nlw[j]; av[j] = nav[j]; }
        if (it + NGW < 64 * R4_NCH) ld(it + NGW);
#pragma unroll
        for (int j = 0; j < 8; ++j) { const float t = kx[j] * kkw; kn[j] = t / fmaxf(sqrtf(wave_sum(t * t)), 1e-12f); }
        float bj[8]; { float bb = 0.f;
#pragma unroll
            for (int j = 0; j < 8; ++j) { bb += lw[j]; bj[j] = bb; } }
        const float e7 = __expf(bj[7]);
        unsigned upa[8]; float ebprev = 1.f;
#pragma unroll
        for (int j = 0; j < 8; ++j) {
            const float eb = __expf(bj[j]), einv = 1.0f / eb, e7j = e7 * einv;
            const float beta = kn[j] * av[j], kd = kx[j] * (1.f + (av[j] - 1.f) * kaw);
            *(LAS unsigned short*)(da + j * 128 + dpos) = (unsigned short)f2bf(kn[j] * ebprev);
            *(LAS unsigned short*)(da + (8 + j) * 128 + dpos) = (unsigned short)f2bf(rx[j] * eb);
            *(LAS unsigned short*)(gb + j * 128 + dpos) = (unsigned short)f2bf(beta * einv);
            *(LAS unsigned short*)(gb + (8 + j) * 128 + dpos) = (unsigned short)f2bf(kd * einv);
            const unsigned ub = f2bf(-beta * e7j), uk = f2bf(kd * e7j);
            if (j & 1) { upa[j >> 1] |= ub << 16; upa[4 + (j >> 1)] |= uk << 16; } else { upa[j >> 1] = ub; upa[4 + (j >> 1)] = uk; }
            ebprev = eb;
        }
        unsigned char* img = IMG + ((size_t)chain * R4_NCH + chunk) * R4_IMG;
        { v4u* d = (v4u*)(img + R4_UPA + lane * 32); d[0] = (v4u){upa[0], upa[1], upa[2], upa[3]}; d[1] = (v4u){upa[4], upa[5], upa[6], upa[7]}; }
        ((float*)(img + R4_G7))[lane] = e7;
        { f32x4* d = (f32x4*)(img + R4_VT + lane * 32); d[0] = (f32x4){vx[0], vx[1], vx[2], vx[3]}; d[1] = (f32x4){vx[4], vx[5], vx[6], vx[7]}; }
        LDS_WAIT(); asm volatile("" ::: "memory");
        { v4u* d = (v4u*)(img + R4_DOTA); d[lane] = ((const LAS v4u*)da)[lane]; d[64 + lane] = ((const LAS v4u*)da)[64 + lane]; }
        f32x4 G = (f32x4){0.f, 0.f, 0.f, 0.f};
#pragma unroll
        for (int s = 0; s < 2; ++s) G = mfma16(*(const LAS bf16x8_t*)(da + m * 128 + (s * 4 + q) * 16), *(const LAS bf16x8_t*)(gb + m * 128 + (s * 4 + q) * 16), G);
        if (m >= 8) { const int i = m - 8;
#pragma unroll
            for (int jp = 0; jp < 4; ++jp) { const int row = 4 * q + jp; const bool keep = (row < 8) ? (i < row) : (i <= row - 8);
                *(LAS unsigned short*)(a12 + row * 16 + i * 2) = (unsigned short)f2bf(keep ? G[jp] : 0.f); } }
#pragma unroll
        for (int jp = 0; jp < 4; ++jp) GL[(4 * q + jp) * 16 + m] = G[jp];
        LDS_WAIT(); asm volatile("" ::: "memory");
        const int c = lane & 7; float Tc[8], M2[8];
#pragma unroll
        for (int j = 0; j < 8; ++j) { float t = (j == c) ? 1.f : 0.f; const f32x4 ra = *(const LAS f32x4*)(GL + j * 16), rb = *(const LAS f32x4*)(GL + j * 16 + 4);
#pragma unroll
            for (int i = 0; i < j; ++i) t -= (i < 4 ? ra[i & 3] : rb[i & 3]) * Tc[i];
            Tc[j] = t; }
#pragma unroll
        for (int j = 0; j < 8; ++j) { float t = 0.f; const f32x4 ra = *(const LAS f32x4*)(GL + (8 + j) * 16), rb = *(const LAS f32x4*)(GL + (8 + j) * 16 + 4);
#pragma unroll
            for (int i = 0; i <= j; ++i) t -= (i < 4 ? ra[i & 3] : rb[i & 3]) * Tc[i];
            M2[j] = t; }
        if (lane < 8) {
#pragma unroll
            for (int j = 0; j < 8; ++j) { *(LAS unsigned short*)(a12 + 256 + j * 16 + c * 2) = (unsigned short)f2bf(Tc[j]); *(LAS unsigned short*)(a12 + 256 + (8 + j) * 16 + c * 2) = (unsigned short)f2bf(M2[j]); } }
        LDS_WAIT(); asm volatile("" ::: "memory");
        if (lane < 32) ((v4u*)(img + R4_A1))[lane] = ((const LAS v4u*)a12)[lane];
        LDS_WAIT(); asm volatile("" ::: "memory");
    }
}
constexpr int R4L_NCB = 6, R4L_SLOT = 6144;
__device__ __forceinline__ void phase_rwkv_scan4(PP p, LAS unsigned char* lds, int vcu, int tid, int lane, int wave) {
    const int m = lane & 15, q = lane >> 4;
    const unsigned char* IMG = p->ws + WS_U + U_IMG;
    for (int unit = vcu; unit < 256; unit += gridDim.x) {
        const int chain = unit >> 2, slab = unit & 3, b = chain >> 5, dir = (chain >> 4) & 1, h = chain & 15;
        float* YST = (float*)(p->ws + WS_U + U_YST) + (size_t)unit * NSTEP * 16 + (q >= 2 ? 4 * (q - 2) : 0) * 16 + m;
        const unsigned char* cimg = IMG + (size_t)chain * R4_NCH * R4_IMG;
        f32x4 S[4];
#pragma unroll
        for (int T = 0; T < 4; ++T) S[T] = (f32x4){0.f, 0.f, 0.f, 0.f};
        v2u idf; { const int c0 = 4 * q; idf.x = ((c0 == m) ? 0x3F80u : 0u) | ((c0 + 1 == m) ? 0x3F800000u : 0u); idf.y = ((c0 + 2 == m) ? 0x3F80u : 0u) | ((c0 + 3 == m) ? 0x3F800000u : 0u); }
        auto issue = [&](int bt) {
#pragma unroll
            for (int k = 0; k < 2 * R4L_NCB; ++k) { const int ii = (wave - 1) + 3 * k, cc = ii / 6, part = ii - cc * 6, pi = part * 64 + lane;
                const unsigned char* src = cimg + (size_t)(bt * R4L_NCB + cc) * R4_IMG + (pi < 304 ? pi * 16 : (pi < 336 ? R4_VT + slab * 512 + (pi - 304) * 16 : 0));
                __builtin_amdgcn_global_load_lds((const unsigned*)src, (LAS unsigned*)(lds + ((bt & 1) * R4L_NCB + cc) * R4L_SLOT + part * 1024), 16, 0, 0); } };
        float crg[32]; int cit = (int)(blockIdx.x * 4 + (wave - 4)); ConvJob cj; bool cpend = false;
        LAS float* cscr = (LAS float*)(lds + 2 * R4L_NCB * R4L_SLOT + (wave & 3) * 8448);
        if (wave >= 4 && cit < IT_L1MOE) { cj = conv_job_l1(p, cit); ti_load(cj.src, cj.src_ld, lane, crg); cpend = true; }
        __syncthreads();
        if (wave >= 1 && wave < 4) issue(0);
        __syncthreads();
        constexpr int NB4 = R4_NCH / R4L_NCB;
        for (int bt = 0; bt < NB4; ++bt) {
            if (wave >= 4) { if (cpend) { ti_store(true, crg, cj.dst, cj.dst_ld, cscr, lane); cit += 4 * (int)gridDim.x; cpend = cit < IT_L1MOE; if (cpend) { cj = conv_job_l1(p, cit); ti_load(cj.src, cj.src_ld, lane, crg); } } }
            else if (wave >= 1) { if (bt + 1 < NB4) issue(bt + 1); }
            else {
#pragma unroll 1
                for (int cc = 0; cc < R4L_NCB; ++cc) {
                    const LAS unsigned char* sl = lds + ((bt & 1) * R4L_NCB + cc) * R4L_SLOT;
                    const bf16x8_t a0 = *(const LAS bf16x8_t*)(sl + R4_DOTA + m * 128 + q * 16), a1 = *(const LAS bf16x8_t*)(sl + R4_DOTA + m * 128 + (4 + q) * 16);
                    v2u A1u = *(const LAS v2u*)(sl + R4_A1 + m * 16 + (q & 1) * 8), A2u = *(const LAS v2u*)(sl + R4_A2 + m * 16 + (q & 1) * 8);
                    if (q >= 2) { A1u = (v2u){0u, 0u}; A2u = idf; }
                    bf16x4_t UA[4]; f32x4 g7[4];
#pragma unroll
                    for (int T = 0; T < 4; ++T) { UA[T] = *(const LAS bf16x4_t*)(sl + R4_UPA + (16 * T + m) * 32 + q * 8); g7[T] = *(const LAS f32x4*)(sl + R4_G7 + (16 * T + 4 * q) * 4); }
                    const f32x4 vr = *(const LAS f32x4*)(sl + R4_VT + m * 32 + (q & 1) * 16);
                    v4u b0, b1;
                    b0.x = cvtpk(S[0][0], S[0][1]); b0.y = cvtpk(S[0][2], S[0][3]); b0.z = cvtpk(S[1][0], S[1][1]); b0.w = cvtpk(S[1][2], S[1][3]);
                    b1.x = cvtpk(S[2][0], S[2][1]); b1.y = cvtpk(S[2][2], S[2][3]); b1.z = cvtpk(S[3][0], S[3][1]); b1.w = cvtpk(S[3][2], S[3][3]);
                    f32x4 Dd = mfma16(a0, __builtin_bit_cast(bf16x8_t, b0), (f32x4){0.f, 0.f, 0.f, 0.f});
                    Dd = mfma16(a1, __builtin_bit_cast(bf16x8_t, b1), Dd);
                    v2u vb; vb.x = cvtpk(vr[0], vr[1]); vb.y = cvtpk(vr[2], vr[3]);
                    const f32x4 Z = __builtin_amdgcn_mfma_f32_16x16x16bf16_1k(__builtin_bit_cast(bf16x4_t, A1u), __builtin_bit_cast(bf16x4_t, vb), Dd, 0, 0, 0);
                    v2u zb; zb.x = cvtpk(Z[0], Z[1]); zb.y = cvtpk(Z[2], Z[3]);
                    const f32x4 W = __builtin_amdgcn_mfma_f32_16x16x16bf16_1k(__builtin_bit_cast(bf16x4_t, A2u), __builtin_bit_cast(bf16x4_t, zb), (f32x4){0.f, 0.f, 0.f, 0.f}, 0, 0, 0);
                    v2u wb; wb.x = cvtpk(W[0], W[1]); wb.y = cvtpk(W[2], W[3]);
                    const v2u ub = (q < 2) ? wb : vb;
#pragma unroll
                    for (int T = 0; T < 4; ++T) S[T] = __builtin_amdgcn_mfma_f32_16x16x16bf16_1k(UA[T], __builtin_bit_cast(bf16x4_t, ub), S[T] * g7[T], 0, 0, 0);
                    if (q >= 2) { float* yp = YST + (size_t)(bt * R4L_NCB + cc) * 128;
#pragma unroll
                        for (int i = 0; i < 4; ++i) yp[i * 16] = W[i]; }
                }
            }
            __syncthreads();
        }
        if (wave >= 4) { while (cpend) { ti_store(true, crg, cj.dst, cj.dst_ld, cscr, lane); cit += 4 * (int)gridDim.x; cpend = cit < IT_L1MOE; if (cpend) { cj = conv_job_l1(p, cit); ti_load(cj.src, cj.src_ld, lane, crg); } } }
    }
}
enum { PH_PRE = 0, PH_NORM0, PH_G_IN, PH_GLA_A, PH_GLA_B, PH_GLA_C, PH_HGRO, PH_G_HGO, PH_FFN0, PH_GATHER0, PH_GU0, PH_DN0, PH_COMB0,
       PH_LERP, PH_G_RKV, PH_G_L2, PH_RWPREP, PH_RWSCAN, PH_RWRO, PH_G_RWO, PH_FFN1, PH_GATHER1, PH_GU1, PH_DN1, PH_COMB1, NPHASES };

template <int ph> __device__ __forceinline__ void run_phase(PP p, LAS unsigned char* lds, int tid, int lane, int wave, int G, int bx, int vcu) {
    unsigned char* ws = p->ws;
    typedef pg8::bf16_t bt;
    switch (ph) {
        case PH_PRE: phase_pre(p, lds, tid, lane, wave); break;
        case PH_NORM0: phase_norm0(p, lane, wave); break;
        case PH_G_IN: {
            pg8::Gemm g{(const bt*)(ws + WS_H), (const bt*)(ws + WS_WIN), NROW, 5120, D}; pg8::StaticOrder S; S.init(NROW, 5120, G, bx);
            pg8::EpiStoreBf16 E{(bt*)(ws + WS_U + U_Z), 5120};
            pg8::gemm_phase<pg8::EpiStoreBf16, pg8::StaticOrder, true, true>(lds, g, S, E); } break;
        case PH_GLA_A: phase_gla_prep(p, lds, tid, lane, wave); break;
        case PH_GLA_B: phase_gla_scan(p, tid); break;
        case PH_GLA_C: phase_gla_out(p, lane, wave); break;
        case PH_HGRO: phase_hg_readout(p, lane, wave); break;
        case PH_G_HGO: {
            pg8::Gemm g{(const bt*)(ws + WS_A2), (const bt*)(ws + WS_WHGO), NROW, D, D}; pg8::StaticOrder S; S.init(NROW, D, G, bx);
            pg8::EpiResid E{p->in[I_X], p->in[I_CTX], (float*)(ws + WS_XR), modp(p, 0, 0, 2), 6144};
            pg8::gemm_phase<pg8::EpiResid, pg8::StaticOrder, true, true>(lds, g, S, E); } break;
        case PH_FFN0: phase_ffn_norm_route(p, 0, NROW, lds, lane, wave); break;
        case PH_FFN1: phase_ffn_norm_route(p, 1, NLAT, lds, lane, wave); break;
        case PH_GATHER0: phase_gather(p, 0, NROW, lds, tid, lane, wave); break;
        case PH_GATHER1: phase_gather(p, 1, NLAT, lds, tid, lane, wave); break;
        case PH_GU0: case PH_GU1: { const int layer = (ph == PH_GU1);
            pg8::Gemm g{(const bt*)(ws + WS_U + U_XB), (const bt*)(ws + WS_WGU) + (size_t)layer * NE * 2048 * D, CAP, 2048, D};
            pg8::MoeOrder S; S.init((const int*)(ws + WS_ROUTE + RT_TILEE), 8, (size_t)2048 * D * 2, G, vcu);
            pg8::EpiSwiglu E{(bt*)(ws + WS_U + U_ACT), p->in[I_BGU] + (size_t)layer * NE * 2048};
            pg8::gemm_phase<pg8::EpiSwiglu, pg8::MoeOrder, true, true>(lds, g, S, E); } break;
        case PH_DN0: case PH_DN1: { const int layer = (ph == PH_DN1);
            pg8::Gemm g{(const bt*)(ws + WS_U + U_ACT), (const bt*)(ws + WS_WD) + (size_t)layer * NE * D * D, CAP, D, D};
            pg8::MoeOrder S; S.init((const int*)(ws + WS_ROUTE + RT_TILEE), 4, (size_t)D * D * 2, G, vcu);
            pg8::EpiDown E{(bt*)(ws + WS_U + U_YS), p->in[I_BDN] + (size_t)layer * NE * D};
            pg8::gemm_phase<pg8::EpiDown, pg8::MoeOrder, true, true>(lds, g, S, E); } break;
        case PH_COMB0: phase_combine(p, 0, NROW, false, lane, wave); break;
        case PH_COMB1: phase_combine(p, 1, NLAT, true, lane, wave); break;
        case PH_LERP: phase_lerp(p, lane, wave); break;
        case PH_G_RKV: {
            { pg8::Gemm g{(const bt*)(ws + WS_U + U_XL6), (const bt*)(ws + WS_WRKV), NROW, 3072, D};
              pg8::SelOrder S; S.init(NROW, 3072, G, bx); S.div = 4; S.sel0 = 0; S.stride = (size_t)NROW * D * 2;
              pg8::EpiStoreBf16 E{(bt*)(ws + WS_U + U_RKV), 3072};
              pg8::gemm_phase<pg8::EpiStoreBf16, pg8::SelOrder, true, true>(lds, g, S, E); }
            { pg8::Gemm g{(const bt*)(ws + WS_U + U_XL6), (const bt*)(ws + WS_WL1), NROW, 768, D};
              pg8::SelOrder S; S.init(NROW, 768, G, bx); S.div = 1; S.sel0 = 3; S.stride = (size_t)NROW * D * 2;
              pg8::EpiLora1 E{(bt*)(ws + WS_U + U_L1)};
              pg8::gemm_phase<pg8::EpiLora1, pg8::SelOrder, true, true>(lds, g, S, E); } } break;
        case PH_G_L2: {
            pg8::Gemm g{(const bt*)(ws + WS_U + U_L1), (const bt*)(ws + WS_WL2), NROW, 5120, 384}; pg8::StaticOrder S; S.init(NROW, 5120, G, bx);
            pg8::EpiLora2 E{(bt*)(ws + WS_U + U_WD), (bt*)(ws + WS_U + U_AD), (bt*)(ws + WS_U + U_G), p->in[I_DECW0], p->in[I_A0]};
            pg8::gemm_phase<pg8::EpiLora2, pg8::StaticOrder, true, true>(lds, g, S, E); } break;
        case PH_RWPREP: phase_rw_prep(p, lds, lane, wave); break;
        case PH_RWSCAN: phase_rwkv_scan4(p, lds, vcu, tid, lane, wave); break;
        case PH_RWRO: phase_rw_readout(p, lane, wave); break;
        case PH_G_RWO: {
            pg8::Gemm g{(const bt*)(ws + WS_A2), (const bt*)(ws + WS_WRWO), NLAT, D, D}; pg8::StaticOrder S; S.init(NLAT, D, G, bx);
            float* XR = (float*)(ws + WS_XR);
            pg8::EpiResid E{XR, XR + (size_t)NLAT * D, XR, modp(p, 1, 0, 2), 6144};
            pg8::gemm_phase<pg8::EpiResid, pg8::StaticOrder, true, true>(lds, g, S, E); } break;
        default: break;
    }
}

#define MK_PROLOGUE \
    extern __shared__ __attribute__((aligned(16))) unsigned char lds_raw[]; \
    LAS unsigned char* lds = (LAS unsigned char*)lds_raw; \
    const int tid = threadIdx.x, lane = tid & 63, wave = __builtin_amdgcn_readfirstlane(tid >> 6); \
    const int G = gridDim.x, bx = blockIdx.x, vcu = (G % 8 == 0) ? (bx % 8) * (G / 8) + bx / 8 : bx;

#define XB_TMO      128
#define XB_XCNT(j)  (256  + 64 * (j))
#define XB_XSUB(j)  (1280 + 64 * (j))
#define XB_XGEN(j)  (2304 + 64 * (j))
#define XB_TOP      3328
#define XB_TOPGEN   3392
#define XCD_BAR_WORDS 3456
#define XB_SPIN_CAP (1u << 18)

__device__ __forceinline__ unsigned xb_ld(unsigned* p)              { return __hip_atomic_load(p, __ATOMIC_RELAXED, __HIP_MEMORY_SCOPE_AGENT); }
__device__ __forceinline__ unsigned xb_add(unsigned* p, unsigned v) { return __hip_atomic_fetch_add(p, v, __ATOMIC_RELAXED, __HIP_MEMORY_SCOPE_AGENT); }
__device__ __forceinline__ unsigned xb_xcc_id() { return (unsigned)__builtin_amdgcn_s_getreg((3 << 11) | 20) & 0xFu; }
#define XB_SPIN(cond, bar) do { unsigned _sp = 0; while (cond) { __builtin_amdgcn_s_sleep(1); \
    if ((++_sp & 255u) == 0u) { if (xb_ld(&(bar)[XB_TMO])) break; if (_sp > XB_SPIN_CAP) { atomicAdd(&(bar)[XB_TMO], 1u); break; } } } } while (0)

struct XcdBarrier {
    unsigned* bar; unsigned x;
    volatile LAS unsigned* st;
};

__device__ __forceinline__ XcdBarrier xcd_barrier_post(unsigned* bar, volatile LAS unsigned* st) {
    XcdBarrier b; b.bar = bar; b.x = xb_xcc_id(); b.st = st;
    if (threadIdx.x == 0) (void)xb_add(&bar[XB_XCNT(b.x)], 1u);
    return b;
}
__device__ __forceinline__ void xcd_barrier_complete(unsigned* bar, unsigned x, unsigned& nloc, unsigned& nx) {
    const unsigned G = gridDim.x * gridDim.y * gridDim.z;
    unsigned sum, cnt, mine, sp = 0u;
    for (;;) {
        sum = 0u; cnt = 0u; mine = 0u;
#pragma unroll
        for (unsigned j = 0; j < 16; ++j) { const unsigned c = xb_ld(&bar[XB_XCNT(j)]); sum += c; cnt += (c > 0u) ? 1u : 0u; mine = (j == x) ? c : mine; }
        if (sum == G) break;
        __builtin_amdgcn_s_sleep(1);
        if ((++sp & 255u) == 0u) { if (xb_ld(&bar[XB_TMO])) break; if (sp > XB_SPIN_CAP) { atomicAdd(&bar[XB_TMO], 1u); break; } }
    }
    nloc = mine > 0u ? mine : 1u; nx = cnt > 0u ? cnt : 1u;
}

__device__ __forceinline__ void xcd_barrier(const XcdBarrier& b) {
    asm volatile("s_waitcnt vmcnt(0)" ::: "memory");
    __syncthreads();
    if (threadIdx.x == 0) {
        unsigned* bar = b.bar;
        __builtin_amdgcn_s_waitcnt(0);
        unsigned nloc = b.st[0], nx = b.st[1];
        if (nloc == 0u) { xcd_barrier_complete(bar, b.x, nloc, nx); b.st[0] = nloc; b.st[1] = nx; }
        const unsigned old = xb_add(&bar[XB_XSUB(b.x)], 1u);
        const unsigned gen = old / nloc;
        if (old + 1u == (gen + 1u) * nloc) {
            __builtin_amdgcn_fence(__ATOMIC_RELEASE, "agent");
            asm volatile("s_waitcnt vmcnt(0)" ::: "memory");
            const unsigned og = xb_add(&bar[XB_TOP], 1u);
            const unsigned tg = og / nx;
            if (og + 1u == (tg + 1u) * nx) xb_add(&bar[XB_TOPGEN], 1u);
            else XB_SPIN(xb_ld(&bar[XB_TOPGEN]) == tg, bar);
            __builtin_amdgcn_fence(__ATOMIC_ACQUIRE, "agent");
            xb_add(&bar[XB_XGEN(b.x)], 1u);
            asm volatile("s_waitcnt vmcnt(0)" ::: "memory");
        } else {
            XB_SPIN(xb_ld(&bar[XB_XGEN(b.x)]) == gen, bar);
            __builtin_amdgcn_fence(__ATOMIC_ACQUIRE, "agent");
            asm volatile("s_waitcnt vmcnt(0)" ::: "memory");
        }
    }
    __syncthreads();
}

constexpr int LDSCTL_OFF = 131072, MISC_OFF = LDSCTL_OFF + 320;
__device__ __forceinline__ void grid_bar(PP kp, LAS unsigned char* lds) {
    PP q = kp; asm volatile("" : "+s"(q));
    XcdBarrier b; b.bar = (unsigned*)(q->ws + WS_CTL) + CW_BAR; b.x = xb_xcc_id(); b.st = (volatile LAS unsigned*)(lds + MISC_OFF) + 8;
    xcd_barrier(b);
}
namespace cg = cooperative_groups;
__global__ void __launch_bounds__(NTHREADS, 2) mk_fwd(Params pv) {
    MK_PROLOGUE
    cg::grid_group grid = cg::this_grid();
    PP kp = (PP)__builtin_amdgcn_kernarg_segment_ptr();
    const int lo = kp->ph_lo, hi = kp->ph_hi;
    for (int u = tid; u < (LDS_BYTES - LDSCTL_OFF) / 4; u += NTHREADS) ((LAS unsigned*)(lds + LDSCTL_OFF))[u] = 0u;
    __syncthreads();
    { XcdBarrier b0 = xcd_barrier_post((unsigned*)(kp->ws + WS_CTL) + CW_BAR, (volatile LAS unsigned*)(lds + MISC_OFF) + 8); (void)b0; }
#ifndef REPEAT_MASK
#define REPEAT_MASK 0u
#endif
#define RUN(k) if (lo <= (k) && (k) < hi) { PP q = kp; asm volatile("" : "+s"(q)); run_phase<k>(q, lds, tid, lane, wave, G, bx, vcu); \
        if ((REPEAT_MASK >> (k)) & 1u) { grid_bar(kp, lds); PP q2 = kp; asm volatile("" : "+s"(q2)); run_phase<k>(q2, lds, tid, lane, wave, G, bx, vcu); } \
        if ((k) + 1 < hi) { if ((k) == 0) grid.sync(); else grid_bar(kp, lds); } }
    RUN(0) RUN(1) RUN(2) RUN(3) RUN(4) RUN(5) RUN(6) RUN(7) RUN(8) RUN(9) RUN(10) RUN(11) RUN(12) RUN(13) RUN(14) RUN(15) RUN(16) RUN(17) RUN(18) RUN(19) RUN(20) RUN(21) RUN(22) RUN(23) RUN(24)
#undef RUN
}

extern "C" void kernel_launch(void* const* d_in, const int* in_sizes, int n_in, void* d_out, int out_size, void* d_ws, size_t ws_size, hipStream_t stream) {
    static int grid = 0;
    if (grid == 0) {
        if (n_in != 35 || in_sizes[0] != NLAT * D || out_size != NLAT * D || ws_size < WS_END) {
            fprintf(stderr, "kernel_launch: unexpected problem (n_in %d, in0 %d, out %d, ws %zu < %zu)\n", n_in, n_in > 0 ? in_sizes[0] : -1, out_size, ws_size, (size_t)WS_END); grid = -1; return; }
        int dev = 0, cus = 0, per_cu = 0;
        if (hipGetDevice(&dev) != hipSuccess || hipDeviceGetAttribute(&cus, hipDeviceAttributeMultiprocessorCount, dev) != hipSuccess) { grid = -1; return; }
        if (hipFuncSetAttribute((const void*)mk_fwd, hipFuncAttributeMaxDynamicSharedMemorySize, LDS_BYTES) != hipSuccess) { fprintf(stderr, "kernel_launch: hipFuncSetAttribute failed\n"); grid = -1; return; }
        if (hipOccupancyMaxActiveBlocksPerMultiprocessor(&per_cu, (const void*)mk_fwd, NTHREADS, LDS_BYTES) != hipSuccess || per_cu < 1) { fprintf(stderr, "kernel_launch: occupancy query %d\n", per_cu); per_cu = 1; }
        (void)hipGetLastError();
        grid = cus * (per_cu < 1 ? 1 : per_cu);
    }
    if (grid < 0) return;
    (void)hipMemsetAsync((char*)d_ws + WS_CTL, 0, CTL_ZERO_BYTES, stream);
    Params p{};
    for (int i = 0; i < 35; ++i) p.in[i] = (const float*)d_in[i];
    p.out = (float*)d_out; p.ws = (unsigned char*)d_ws;
    p.ph_lo = 0; p.ph_hi = NPHASES;
    void* args[] = {&p};
    hipError_t e = hipLaunchCooperativeKernel((const void*)mk_fwd, dim3(grid), dim3(NTHREADS), args, LDS_BYTES, stream);
    if (e != hipSuccess) fprintf(stderr, "kernel_launch: cooperative launch failed: %s (grid %d)\n", hipGetErrorString(e), grid);
}
```

```cpp
#include <hip/hip_runtime.h>
#include <hip/hip_cooperative_groups.h>
#include <cstdio>
#include <cstdint>
namespace pg8 {
#define PG8_LAS __attribute__((address_space(3)))
typedef unsigned short bf16_t;
typedef short bf16x8 __attribute__((ext_vector_type(8)));
typedef float f32x4 __attribute__((ext_vector_type(4)));
typedef unsigned u32x4 __attribute__((ext_vector_type(4)));
constexpr int BM = 256, BK = 64, HALF = 128, HTB = HALF * BK * 2  , STAGE_BYTES = 8 * HTB, NXCD = 8, WGM = 8;

__host__ __device__ __forceinline__ int lds_byte(int r, int c) { const int st = (r >> 4) * 2 + (c >> 5), rr = r & 15, cc = c & 31, ob = rr * 64 + cc * 2; return st * 1024 + (ob ^ (((ob >> 9) & 1) << 5)); }
__host__ __device__ __forceinline__ void stage_rc(int b, int& R, int& C) { const int st = b / 1024, sb = b % 1024, swz = sb ^ (((sb >> 9) & 1) << 5); R = (st >> 1) * 16 + swz / 64; C = (st & 1) * 32 + (swz % 64) / 2; }
__host__ __device__ __forceinline__ int perm32(int rho) { const int n = rho >> 4, i = rho & 15; return 8 * (i >> 2) + 4 * n + (i & 3); }

struct Unit { int pm, pn, e; };
struct Gemm { const bf16_t* A; const bf16_t* Bt; int M, N, K; };

struct StaticOrder {
    int nM, nN, nwg, G, c;
    __host__ __device__ void init(int M, int N, int G_, int c_) { nM = M / BM; nN = N / BM; nwg = nM * nN; G = G_; c = c_; }
    __host__ __device__ bool next(int i, Unit& u) const {
        const long L = (long)i * G + c; if (L >= nwg) return false;
        int wgid = (int)L; { const int q = nwg / NXCD, r = nwg % NXCD, xcd = wgid % NXCD, off = wgid / NXCD; wgid = (xcd < r ? xcd * (q + 1) : r * (q + 1) + (xcd - r) * q) + off; }
        const int nig = WGM * nN, gid = wgid / nig, fm = gid * WGM, gsz = (nM - fm) < WGM ? (nM - fm) : WGM;
        u.pm = fm + ((wgid % nig) % gsz); u.pn = (wgid % nig) / gsz; u.e = 0; return true;
    }
    __device__ __forceinline__ const char* abase(const Gemm& g, const Unit& u, size_t tstep) const { return (const char*)g.A + (size_t)u.pm * tstep; }
    __device__ __forceinline__ const char* bbase(const Gemm& g, const Unit& u, size_t tstep) const { return (const char*)g.Bt + (size_t)u.pn * tstep; }
    __device__ __forceinline__ void a_ready(const Unit&) const {}
    __device__ __forceinline__ void done(const Unit&) const {}
};

__device__ __forceinline__ unsigned cvt_pk_bf16(float lo, float hi) { unsigned r; asm volatile("v_cvt_pk_bf16_f32 %0, %1, %2" : "=v"(r) : "v"(lo), "v"(hi)); return r; }

template <class Epi, class Sched, bool ALIGN_EPI = false, bool SP2 = false>
__device__ __forceinline__ void gemm_phase(PG8_LAS unsigned char* lds, const Gemm g, const Sched& S, const Epi& E) {
    const int tid = threadIdx.x, wid = __builtin_amdgcn_readfirstlane(tid >> 6), lane = tid & 63, wr = wid >> 2, wc = wid & 3, fr = lane & 15, fq = lane >> 4;
    const int K = g.K, nt = K / BK;
    unsigned voffA[2], voffB[2];
#pragma unroll
    for (int i = 0; i < 2; ++i) { int R, C; stage_rc(tid * 16 + i * 8192, R, C); const int Rb = Epi::PERM ? ((R & ~31) + perm32(R & 31)) : R;
        voffA[i] = (unsigned)(R * K + C) * 2u; voffB[i] = (unsigned)(Rb * K + C) * 2u; }
    const size_t kstep = (size_t)(BK * 2);
    const size_t hstep = (size_t)HALF * K * 2;
    const size_t tstep = 2 * hstep;
    const unsigned ldsw = (unsigned)wid * 1024u;
    const int aoff = lds_byte(wr * 64 + fr, fq * 8), boff = lds_byte(wc * 32 + fr, fq * 8);
#define PG8_SA(b, h) (((b) * 2 + (h)) * HTB)
#define PG8_SB(b, h) ((4 + (b) * 2 + (h)) * HTB)
#define PG8_STAGE(bufoff, gbase, voff) do { _Pragma("unroll") for (int _i = 0; _i < 2; ++_i) \
        __builtin_amdgcn_global_load_lds((const unsigned*)((const char*)(gbase) + (voff)[_i]), (PG8_LAS unsigned*)(lds + (bufoff) + ldsw + _i * 8192), 16, 0, 0); } while (0)
#define PG8_LDA(dst, b, h) do { _Pragma("unroll") for (int m = 0; m < 4; ++m) _Pragma("unroll") for (int k = 0; k < 2; ++k) dst[m][k] = *(const PG8_LAS bf16x8*)(lds + PG8_SA(b, h) + aoff + m * 2048 + k * 1024); } while (0)
#define PG8_LDB(dst, b, h) do { _Pragma("unroll") for (int n = 0; n < 2; ++n) _Pragma("unroll") for (int k = 0; k < 2; ++k) dst[n][k] = *(const PG8_LAS bf16x8*)(lds + PG8_SB(b, h) + boff + n * 2048 + k * 1024); } while (0)
#define PG8_MMA(ai, bj, At, Bt) do { __builtin_amdgcn_s_setprio(1); _Pragma("unroll") for (int m = 0; m < 4; ++m) _Pragma("unroll") for (int n = 0; n < 2; ++n) _Pragma("unroll") for (int k = 0; k < 2; ++k) \
        acc[ai][bj][m][n] = __builtin_amdgcn_mfma_f32_16x16x32_bf16(Bt[n][k], At[m][k], acc[ai][bj][m][n], 0, 0, 0); __builtin_amdgcn_s_setprio(0); } while (0)
#define PG8_WAIT_V(n) asm volatile("s_waitcnt vmcnt(" #n ")" ::: "memory")
#define PG8_WAIT_L(n) asm volatile("s_waitcnt lgkmcnt(" #n ")" ::: "memory")
#define PG8_BAR __builtin_amdgcn_s_barrier()
#define PG8_SCHED __builtin_amdgcn_sched_barrier(0)
    Unit cur, nxt; int ui = 0;
    if (!S.next(0, cur)) return;
    f32x4 acc[2][2][4][2];
#pragma unroll
    for (int a = 0; a < 2; ++a)
#pragma unroll
        for (int b = 0; b < 2; ++b)
#pragma unroll
            for (int m = 0; m < 4; ++m)
#pragma unroll
                for (int n = 0; n < 2; ++n) acc[a][b][m][n] = (f32x4){0.f, 0.f, 0.f, 0.f};
    bf16x8 At[4][2], B0[2][2], B1[2][2];
    const char* cA = S.abase(g, cur, tstep); const char* cB = S.bbase(g, cur, tstep);
    S.a_ready(cur);
    if constexpr (SP2) {
        PG8_STAGE(PG8_SB(0, 0), cB, voffB); PG8_STAGE(PG8_SB(0, 1), cB + hstep, voffB); PG8_STAGE(PG8_SA(0, 0), cA, voffA); PG8_STAGE(PG8_SA(0, 1), cA + hstep, voffA);
        if (wr == 1) PG8_BAR;
        PG8_WAIT_V(2); PG8_BAR;
        PG8_STAGE(PG8_SB(1, 0), cB + kstep, voffB); PG8_STAGE(PG8_SA(1, 0), cA + kstep, voffA); PG8_STAGE(PG8_SB(1, 1), cB + hstep + kstep, voffB);
        PG8_WAIT_V(6); PG8_BAR;
    } else {
        PG8_STAGE(PG8_SB(0, 0), cB, voffB); PG8_STAGE(PG8_SA(0, 0), cA, voffA); PG8_STAGE(PG8_SB(0, 1), cB + hstep, voffB); PG8_STAGE(PG8_SA(0, 1), cA + hstep, voffA);
        if (wr == 1) PG8_BAR;
        PG8_WAIT_V(4); PG8_BAR;
        PG8_STAGE(PG8_SB(1, 0), cB + kstep, voffB); PG8_STAGE(PG8_SA(1, 0), cA + kstep, voffA); PG8_STAGE(PG8_SB(1, 1), cB + hstep + kstep, voffB);
        PG8_WAIT_V(6); PG8_BAR;
    }
    for (;;) {
        const bool has_next = S.next(ui + 1, nxt);
        const char* nA = has_next ? S.abase(g, nxt, tstep) : cA; const char* nB = has_next ? S.bbase(g, nxt, tstep) : cB;
        _Pragma("unroll 1") for (int t = 0; t < nt; t += 2) {
            const bool last = (t == nt - 2);
            const char* a1 = cA + (size_t)(t + 1) * kstep;
            const char* a2 = last ? nA : cA + (size_t)(t + 2) * kstep; const char* b2 = last ? nB : cB + (size_t)(t + 2) * kstep;
            const char* a3 = a2 + kstep; const char* b3 = b2 + kstep;
            if (last && has_next) S.a_ready(nxt);
            if constexpr (SP2) {
            PG8_LDB(B0, 0, 0); PG8_LDB(B1, 0, 1); PG8_SCHED; PG8_LDA(At, 0, 0); PG8_STAGE(PG8_SA(1, 1), a1 + hstep, voffA);
            PG8_WAIT_V(8); PG8_WAIT_L(0); PG8_BAR; PG8_MMA(0, 0, At, B0); PG8_MMA(0, 1, At, B1); PG8_BAR; PG8_SCHED;
            PG8_LDA(At, 0, 1); PG8_STAGE(PG8_SB(0, 0), b2, voffB); PG8_STAGE(PG8_SB(0, 1), b2 + hstep, voffB); PG8_STAGE(PG8_SA(0, 0), a2, voffA);
            PG8_WAIT_V(8); PG8_WAIT_L(0); PG8_BAR; PG8_MMA(1, 0, At, B0); PG8_MMA(1, 1, At, B1); PG8_BAR; PG8_SCHED;
            PG8_LDB(B0, 1, 0); PG8_LDB(B1, 1, 1); PG8_SCHED; PG8_LDA(At, 1, 0); PG8_STAGE(PG8_SA(0, 1), a2 + hstep, voffA);
            PG8_WAIT_V(8); PG8_WAIT_L(0); PG8_BAR; PG8_MMA(0, 0, At, B0); PG8_MMA(0, 1, At, B1); PG8_BAR; PG8_SCHED;
            PG8_LDA(At, 1, 1); PG8_STAGE(PG8_SB(1, 0), b3, voffB); PG8_STAGE(PG8_SB(1, 1), b3 + hstep, voffB); PG8_STAGE(PG8_SA(1, 0), a3, voffA);
            PG8_WAIT_V(8); PG8_WAIT_L(0); PG8_BAR; PG8_MMA(1, 0, At, B0); PG8_MMA(1, 1, At, B1); PG8_BAR; PG8_SCHED;
            } else {
            PG8_LDB(B0, 0, 0); PG8_SCHED; PG8_LDA(At, 0, 0); PG8_STAGE(PG8_SA(1, 1), a1 + hstep, voffA);
            PG8_WAIT_L(8); PG8_BAR; PG8_WAIT_L(0); PG8_MMA(0, 0, At, B0); PG8_BAR; PG8_SCHED;
            PG8_LDB(B1, 0, 1); PG8_STAGE(PG8_SB(0, 0), b2, voffB);
            PG8_BAR; PG8_WAIT_L(0); PG8_MMA(0, 1, At, B1); PG8_BAR;
            PG8_LDA(At, 0, 1); PG8_STAGE(PG8_SA(0, 0), a2, voffA);
            PG8_BAR; PG8_WAIT_L(0); PG8_MMA(1, 0, At, B0); PG8_BAR; PG8_SCHED;
            PG8_STAGE(PG8_SB(0, 1), b2 + hstep, voffB);
            PG8_WAIT_V(6); PG8_BAR; PG8_MMA(1, 1, At, B1); PG8_BAR;
            PG8_LDB(B0, 1, 0); PG8_SCHED; PG8_LDA(At, 1, 0); PG8_STAGE(PG8_SA(0, 1), a2 + hstep, voffA);
            PG8_WAIT_L(8); PG8_BAR; PG8_WAIT_L(0); PG8_MMA(0, 0, At, B0); PG8_BAR; PG8_SCHED;
            PG8_LDB(B1, 1, 1); PG8_STAGE(PG8_SB(1, 0), b3, voffB);
            PG8_BAR; PG8_WAIT_L(0); PG8_MMA(0, 1, At, B1); PG8_BAR;
            PG8_LDA(At, 1, 1); PG8_STAGE(PG8_SA(1, 0), a3, voffA);
            PG8_BAR; PG8_WAIT_L(0); PG8_MMA(1, 0, At, B0); PG8_BAR; PG8_SCHED;
            PG8_STAGE(PG8_SB(1, 1), b3 + hstep, voffB);
            PG8_WAIT_V(6); PG8_BAR; PG8_MMA(1, 1, At, B1); PG8_BAR;
            }
        }
        if constexpr (ALIGN_EPI) { if (wr == 0) PG8_BAR; }
        if constexpr (!Epi::AFTER_DRAIN) { E(acc, cur, wr, wc, fr, fq); S.done(cur); }
        if (!has_next) break;
#pragma unroll
        for (int a = 0; a < 2; ++a)
#pragma unroll
            for (int b = 0; b < 2; ++b)
#pragma unroll
                for (int m = 0; m < 4; ++m)
#pragma unroll
                    for (int n = 0; n < 2; ++n) acc[a][b][m][n] = (f32x4){0.f, 0.f, 0.f, 0.f};
        cur = nxt; cA = nA; cB = nB; ++ui;
        if constexpr (ALIGN_EPI) { if (wr == 1) PG8_BAR; }
    }
    PG8_WAIT_V(0);
    if constexpr (!ALIGN_EPI) { if (wr == 0) PG8_BAR; }
    PG8_BAR;
    if constexpr (Epi::AFTER_DRAIN) { E.fused(acc, cur, wr, wc, fr, fq, lds, wid, lane); S.done(cur); }
#undef PG8_SA
#undef PG8_SB
#undef PG8_STAGE
#undef PG8_LDA
#undef PG8_LDB
#undef PG8_MMA
#undef PG8_WAIT_V
#undef PG8_WAIT_L
#undef PG8_BAR
#undef PG8_SCHED
}
}

constexpr int D = 1024, NBATCH = 2, SEQ = 8192, CTXL = 256;
constexpr int NLAT = NBATCH * SEQ, NCTX = NBATCH * CTXL, NROW = NLAT + NCTX;
constexpr int NE = 32, TOPK = 4, MAXTILES = 296, CAP = MAXTILES * 256;
constexpr int NWAVES = 8, NTHREADS = 512;
constexpr float NORM_EPS = 1e-6f;
constexpr int LDS_BYTES = 147456;

constexpr size_t MiB = 1u << 20;
constexpr size_t WS_CTL = 0, CTL_ZERO_BYTES = 1 * MiB;
constexpr size_t WS_MOD = 1 * MiB;
constexpr size_t WS_ROUTE = 2 * MiB;
constexpr size_t RT_TOPI = 0, RT_TOPG = 320 * 1024, RT_POS = 640 * 1024, RT_SLOT = 960 * 1024, RT_RSTD = 1280 * 1024, RT_TILEE = 1408 * 1024;
constexpr size_t WS_WIN = 4 * MiB, WS_WHGO = 14 * MiB, WS_WRKV = 16 * MiB, WS_WL1 = 22 * MiB, WS_WL2 = 24 * MiB, WS_WRWO = 28 * MiB;
constexpr size_t WS_WGU = 32 * MiB, WS_WD = 288 * MiB;
constexpr size_t WS_XR = 416 * MiB, WS_H = 482 * MiB, WS_H2 = 515 * MiB, WS_A2 = 548 * MiB;
constexpr size_t WS_U = 584 * MiB;
constexpr size_t U_Z = 0, U_OD0 = 166 * MiB;
constexpr size_t U_XL6 = 0, U_RKV = 198 * MiB, U_L1 = 396 * MiB, U_WD = 410 * MiB, U_AD = 542 * MiB, U_G = 674 * MiB, U_OD1 = 740 * MiB;
constexpr size_t U_XB = 0, U_ACT = 148 * MiB, U_YS = 296 * MiB;
constexpr size_t WS_END = WS_U + 1320 * MiB;
constexpr int CW_CNT = 64;
constexpr int CW_BAR = 4096;

#define LAS __attribute__((address_space(3)))
typedef unsigned short bf16;
typedef unsigned v4u __attribute__((ext_vector_type(4)));
typedef unsigned v2u __attribute__((ext_vector_type(2)));
typedef float f32x4 __attribute__((ext_vector_type(4)));
#define LDS_WAIT() asm volatile("s_waitcnt lgkmcnt(0)" ::: "memory")
typedef float f32x2c __attribute__((ext_vector_type(2))); typedef __bf16 bf16x2c __attribute__((ext_vector_type(2)));
__device__ __forceinline__ unsigned pk2(float lo, float hi) { const f32x2c v = {lo, hi}; const bf16x2c b = __builtin_convertvector(v, bf16x2c); return __builtin_bit_cast(unsigned, b); }
__device__ __forceinline__ unsigned f2bf(float f) { return pk2(f, 0.f) & 0xffffu; }
__device__ __forceinline__ float bf2f(unsigned b) { return __builtin_bit_cast(float, b << 16); }
__device__ __forceinline__ float wave_sum(float x) {
    x += __builtin_bit_cast(float, __builtin_amdgcn_update_dpp(0, __builtin_bit_cast(int, x), 0x128, 0xf, 0xf, false));
    x += __builtin_bit_cast(float, __builtin_amdgcn_update_dpp(0, __builtin_bit_cast(int, x), 0x124, 0xf, 0xf, false));
    x += __builtin_bit_cast(float, __builtin_amdgcn_update_dpp(0, __builtin_bit_cast(int, x), 0x122, 0xf, 0xf, false));
    x += __builtin_bit_cast(float, __builtin_amdgcn_update_dpp(0, __builtin_bit_cast(int, x), 0x121, 0xf, 0xf, false));
    x += __shfl_xor(x, 16); x += __shfl_xor(x, 32);
    return x;
}
__device__ __forceinline__ float sigm(float x) { return __builtin_amdgcn_rcpf(1.0f + __expf(-x)); }

struct Params { const float* in[35]; float* out; unsigned char* ws; int ph_lo, ph_hi; };
typedef const __attribute__((address_space(4))) Params* PP;
enum { I_X = 0, I_C, I_CTX, I_CCTX, I_ADAW, I_ADAB, I_NMIX, I_NFFN, I_HGWIN, I_HGGN, I_HGWOUT, I_HGLB, I_MU, I_WRKV, I_DECW0, I_DECW1, I_DECW2,
       I_A0, I_A1, I_A2, I_G1, I_G2, I_KK, I_KA, I_RK, I_LNXW, I_LNXB, I_RWOUT, I_ROUTW, I_ROUTB, I_WGU, I_BGU, I_WDN, I_BDN, I_FINALG };

__device__ __forceinline__ const float* modp(PP p, int l, int v, int j) { return (const float*)(p->ws + WS_MOD) + ((size_t)(l * 3 + v) * 6 + j) * D; }
__device__ __forceinline__ int row_vec(int row) { return row < NLAT ? (row >= SEQ ? 1 : 0) : 2; }

__device__ __forceinline__ void ti_load(const float* src, int src_ld, int lane, float (&rg)[32]) {
    if (src) {
#pragma unroll
        for (int i = 0; i < 32; ++i) rg[i] = src[(size_t)(2 * i + (lane >> 5)) * src_ld + (lane & 31)];
    }
}
__device__ __forceinline__ void ti_store(bool nonzero, const float (&rg)[32], bf16* dst, int dst_ld, LAS float* scr, int lane) {
    if (nonzero) {
#pragma unroll
        for (int i = 0; i < 32; ++i) scr[(2 * i + (lane >> 5)) * 33 + (lane & 31)] = rg[i];
    }
    LDS_WAIT(); asm volatile("" ::: "memory");
    const int c = lane & 7;
#pragma unroll
    for (int j = 0; j < 4; ++j) {
        const int n = (lane >> 3) + 8 * j; v4u o = (v4u){0u, 0u, 0u, 0u};
        if (nonzero) { const LAS float* s = scr + (8 * c) * 33 + n;
            o.x = pk2(s[0 * 33], s[1 * 33]); o.y = pk2(s[2 * 33], s[3 * 33]); o.z = pk2(s[4 * 33], s[5 * 33]); o.w = pk2(s[6 * 33], s[7 * 33]); }
        *(v4u*)(dst + (size_t)n * dst_ld + 8 * c) = o;
    }
    LDS_WAIT(); asm volatile("" ::: "memory");
}
__device__ __forceinline__ void transpose_item(const float* src, int src_ld, bf16* dst, int dst_ld, LAS float* scr, int lane) {
    float rg[32]; ti_load(src, src_ld, lane, rg); ti_store(src != nullptr, rg, dst, dst_ld, scr, lane);
}
__device__ __forceinline__ void conv_plain(const float* W, int K, int N, bf16* WT, int r, LAS float* scr, int lane) {
    const int nblk = N / 32, kb = r / nblk, nb = r % nblk;
    transpose_item(W + (size_t)(kb * 64) * N + nb * 32, N, WT + (size_t)(nb * 32) * K + kb * 64, K, scr, lane);
}
constexpr int IT_WIN = 16 * 160, IT_SQ = 16 * 32, IT_L1 = 16 * 24, IT_L2 = 160 * 6, IT_GU = 64 * 16 * 64, IT_DN = 64 * 16 * 32;
constexpr int IT_GU0 = IT_GU / 2, IT_DN0 = IT_DN / 2;
constexpr int IT_TOTAL = IT_WIN + IT_SQ + 3 * IT_SQ + IT_SQ + IT_L1 + IT_L2 + IT_GU0 + IT_DN0, IT_L1MOE = IT_GU0 + IT_DN0;
__device__ __forceinline__ void convert_item(PP p, int it, LAS float* scr, int lane) {
    unsigned char* ws = p->ws; int r = it;
    if (r < IT_WIN) { conv_plain(p->in[I_HGWIN], D, 5120, (bf16*)(ws + WS_WIN), r, scr, lane); return; } r -= IT_WIN;
    if (r < IT_SQ) { conv_plain(p->in[I_HGWOUT], D, D, (bf16*)(ws + WS_WHGO), r, scr, lane); return; } r -= IT_SQ;
    if (r < 3 * IT_SQ) { const int j = r / IT_SQ; conv_plain(p->in[I_WRKV] + (size_t)j * D * D, D, D, (bf16*)(ws + WS_WRKV) + (size_t)j * D * D, r % IT_SQ, scr, lane); return; } r -= 3 * IT_SQ;
    if (r < IT_SQ) { conv_plain(p->in[I_RWOUT], D, D, (bf16*)(ws + WS_WRWO), r, scr, lane); return; } r -= IT_SQ;
    if (r < IT_L1) {
        const int kb = r / 24, rg = r % 24, tile = rg >> 3, within = rg & 7; const float* src = nullptr; int ld = 64;
        if (within < 4) {
            if (tile == 0) src = p->in[I_DECW1] + (size_t)(within >> 1) * D * 64 + (size_t)(kb * 64) * 64 + (within & 1) * 32;
            else if (tile == 1) src = p->in[I_A1] + (size_t)(within >> 1) * D * 64 + (size_t)(kb * 64) * 64 + (within & 1) * 32;
            else { src = p->in[I_G1] + (size_t)(kb * 64) * 128 + within * 32; ld = 128; }
        }
        transpose_item(src, ld, (bf16*)(ws + WS_WL1) + (size_t)(rg * 32) * D + kb * 64, D, scr, lane); return; } r -= IT_L1;
    if (r < IT_L2) {
        const int rg = r / 6, kb = r % 6, n0 = rg * 32, blk = n0 >> 10, nn0 = n0 & 1023; const float* src = nullptr;
        if (blk < 2) { if (kb == blk) src = p->in[I_DECW2] + (size_t)blk * 64 * D + nn0; }
        else if (blk < 4) { if (kb == blk) src = p->in[I_A2] + (size_t)(blk - 2) * 64 * D + nn0; }
        else { if (kb >= 4) src = p->in[I_G2] + (size_t)(kb - 4) * 64 * D + nn0; }
        transpose_item(src, D, (bf16*)(ws + WS_WL2) + (size_t)n0 * 384 + kb * 64, 384, scr, lane); return; } r -= IT_L2;
    if (r < IT_GU0) {
        const int mat = r >> 10, q = r & 1023, kb = q >> 6, nb = q & 63, n0 = nb * 32;
        const int j0 = n0 & 1023, drow = 256 * (j0 >> 7) + (n0 >= 1024 ? 128 : 0) + (j0 & 127);
        transpose_item(p->in[I_WGU] + (size_t)mat * D * 2048 + (size_t)(kb * 64) * 2048 + n0, 2048, (bf16*)(ws + WS_WGU) + (size_t)mat * 2048 * D + (size_t)drow * D + kb * 64, D, scr, lane); return; } r -= IT_GU0;
    { const int mat = r >> 9, q = r & 511;
      conv_plain(p->in[I_WDN] + (size_t)mat * D * D, D, D, (bf16*)(ws + WS_WD) + (size_t)mat * D * D, q, scr, lane); }
}
struct ConvJob { const float* src; int src_ld; bf16* dst; int dst_ld; };
__device__ __forceinline__ ConvJob conv_job_l1(PP p, int r) {
    unsigned char* ws = p->ws; ConvJob j;
    if (r < IT_GU0) { const int mat = 32 + (r >> 10), q = r & 1023, kb = q >> 6, nb = q & 63, n0 = nb * 32;
        const int j0 = n0 & 1023, drow = 256 * (j0 >> 7) + (n0 >= 1024 ? 128 : 0) + (j0 & 127);
        j.src = p->in[I_WGU] + (size_t)mat * D * 2048 + (size_t)(kb * 64) * 2048 + n0; j.src_ld = 2048;
        j.dst = (bf16*)(ws + WS_WGU) + (size_t)mat * 2048 * D + (size_t)drow * D + kb * 64; j.dst_ld = D; return j; }
    r -= IT_GU0;
    { const int mat = 32 + (r >> 9), q = r & 511, kb = q >> 5, nb = q & 31;
      j.src = p->in[I_WDN] + (size_t)mat * D * D + (size_t)(kb * 64) * D + nb * 32; j.src_ld = D;
      j.dst = (bf16*)(ws + WS_WD) + (size_t)mat * D * D + (size_t)(nb * 32) * D + kb * 64; j.dst_ld = D; return j; }
}
__device__ __forceinline__ void phase_pre(PP p, LAS unsigned char* lds, int tid, int lane, int wave) {
    if (blockIdx.x < 192) {
        const int layer = blockIdx.x / 96, col = (blockIdx.x % 96) * 64 + lane;
        const float* W = p->in[I_ADAW] + (size_t)layer * D * 6144 + col;
        const float* c = p->in[I_C]; const float* cc = p->in[I_CCTX];
        float a0 = 0.f, a1 = 0.f, a2 = 0.f;
#pragma unroll 8
        for (int k = wave * 128; k < wave * 128 + 128; ++k) {
            const float wv = W[(size_t)k * 6144]; const float c0 = c[k], c1 = c[D + k], c2 = cc[k];
            a0 += c0 * sigm(c0) * wv; a1 += c1 * sigm(c1) * wv; a2 += c2 * sigm(c2) * wv;
        }
        LAS float* red = (LAS float*)lds;
        red[(wave * 3 + 0) * 64 + lane] = a0; red[(wave * 3 + 1) * 64 + lane] = a1; red[(wave * 3 + 2) * 64 + lane] = a2;
        __syncthreads();
        if (wave == 0) {
            float s0 = 0.f, s1 = 0.f, s2 = 0.f;
#pragma unroll
            for (int w = 0; w < 8; ++w) { s0 += red[(w * 3 + 0) * 64 + lane]; s1 += red[(w * 3 + 1) * 64 + lane]; s2 += red[(w * 3 + 2) * 64 + lane]; }
            const float bb = p->in[I_ADAB][layer * 6144 + col];
            float* M = (float*)(p->ws + WS_MOD) + (size_t)layer * 3 * 6144 + col;
            M[0] = s0 + bb; M[6144] = s1 + bb; M[2 * 6144] = s2 + bb;
        }
        __syncthreads();
    }
    LAS float* scr = (LAS float*)(lds + wave * 16384);
    const int gw = blockIdx.x * NWAVES + wave, NGW = gridDim.x * NWAVES;
    for (int it = gw; it < IT_TOTAL; it += NGW) convert_item(p, it, scr, lane);
}

__device__ __forceinline__ void load_row(const float* row, int lane, f32x4 (&v)[4]) {
#pragma unroll
    for (int j = 0; j < 4; ++j) v[j] = ((const f32x4*)row)[lane + 64 * j];
}
__device__ __forceinline__ float row_rstd(const f32x4 (&v)[4]) {
    float s = 0.f;
#pragma unroll
    for (int j = 0; j < 4; ++j) s += (v[j].x * v[j].x + v[j].y * v[j].y) + (v[j].z * v[j].z + v[j].w * v[j].w);
    return rsqrtf(wave_sum(s) * (1.0f / D) + NORM_EPS);
}
__device__ __forceinline__ void norm_mod(const f32x4 (&v)[4], float rstd, const float* g, const float* shift, const float* scale, int lane, f32x4 (&h)[4]) {
#pragma unroll
    for (int j = 0; j < 4; ++j) {
        const f32x4 gg = ((const f32x4*)g)[lane + 64 * j], sh = ((const f32x4*)shift)[lane + 64 * j], sc = ((const f32x4*)scale)[lane + 64 * j];
        h[j] = v[j] * rstd * gg * (sc + 1.0f) + sh;
    }
}
__device__ __forceinline__ void store_row_bf16(bf16* row, int lane, const f32x4 (&h)[4]) {
#pragma unroll
    for (int j = 0; j < 4; ++j) { v2u w; w.x = pk2(h[j].x, h[j].y); w.y = pk2(h[j].z, h[j].w); ((v2u*)row)[lane + 64 * j] = w; }
}
__device__ __forceinline__ const float* resid_row(PP p, int layer0_inputs, int row) {
    if (layer0_inputs) return row < NLAT ? p->in[I_X] + (size_t)row * D : p->in[I_CTX] + (size_t)(row - NLAT) * D;
    return (const float*)(p->ws + WS_XR) + (size_t)row * D;
}
__device__ __forceinline__ void phase_norm0(PP p, int lane, int wave) {
    const int gw = blockIdx.x * NWAVES + wave, NGW = gridDim.x * NWAVES;
    for (int row = gw; row < NROW; row += NGW) {
        f32x4 v[4], h[4]; load_row(resid_row(p, 1, row), lane, v);
        const float rstd = row_rstd(v); const int vec = row_vec(row);
        norm_mod(v, rstd, p->in[I_NMIX], modp(p, 0, vec, 0), modp(p, 0, vec, 1), lane, h);
        store_row_bf16((bf16*)(p->ws + WS_H) + (size_t)row * D, lane, h);
    }
}
__device__ __forceinline__ void route_select(float (&part)[NE], const float* rb, int row, int* TOPI, float* TOPG, int* POS, unsigned* cnt, int lane, bool write) {
#pragma unroll
    for (int e = 0; e < NE; ++e) part[e] = wave_sum(part[e]) + rb[e];
    unsigned taken = 0u; int idx[TOPK]; float val[TOPK];
#pragma unroll
    for (int k = 0; k < TOPK; ++k) {
        float best = -3.0e38f; int bi = 0;
#pragma unroll
        for (int e = 0; e < NE; ++e) { const bool ok = !((taken >> e) & 1u) && (part[e] > best); best = ok ? part[e] : best; bi = ok ? e : bi; }
        taken |= 1u << bi; idx[k] = bi; val[k] = best;
    }
    float ex[TOPK], se = 0.f;
#pragma unroll
    for (int k = 0; k < TOPK; ++k) { ex[k] = __expf(val[k] - val[0]); se += ex[k]; }
    if (lane == 0 && write) {
#pragma unroll
        for (int k = 0; k < TOPK; ++k) { TOPI[row * 4 + k] = idx[k]; TOPG[row * 4 + k] = ex[k] / se; POS[row * 4 + k] = (int)atomicAdd(cnt + idx[k], 1u); }
    }
}
__device__ __forceinline__ void phase_ffn_norm_route(PP p, int layer, int nrows, LAS unsigned char* lds, int lane, int wave) {
    const int gw = blockIdx.x * NWAVES + wave, NGW = gridDim.x * NWAVES;
    const float* rw = p->in[I_ROUTW] + (size_t)layer * D * NE; const float* rb = p->in[I_ROUTB] + layer * NE;
    int* TOPI = (int*)(p->ws + WS_ROUTE + RT_TOPI); float* TOPG = (float*)(p->ws + WS_ROUTE + RT_TOPG); int* POS = (int*)(p->ws + WS_ROUTE + RT_POS);
    unsigned* cnt = (unsigned*)(p->ws + WS_CTL) + CW_CNT + layer * NE;
    for (int row0 = gw; row0 < nrows; row0 += 2 * NGW) {
        const bool has1 = row0 + NGW < nrows; const int row1 = has1 ? row0 + NGW : row0;
        f32x4 h0[4], h1[4];
        { f32x4 v[4]; load_row((const float*)(p->ws + WS_XR) + (size_t)row0 * D, lane, v); const float rstd = row_rstd(v); const int vec = row_vec(row0);
          norm_mod(v, rstd, p->in[I_NFFN] + layer * D, modp(p, layer, vec, 3), modp(p, layer, vec, 4), lane, h0);
          store_row_bf16((bf16*)(p->ws + WS_H2) + (size_t)row0 * D, lane, h0); }
        { f32x4 v[4]; load_row((const float*)(p->ws + WS_XR) + (size_t)row1 * D, lane, v); const float rstd = row_rstd(v); const int vec = row_vec(row1);
          norm_mod(v, rstd, p->in[I_NFFN] + layer * D, modp(p, layer, vec, 3), modp(p, layer, vec, 4), lane, h1);
          if (has1) store_row_bf16((bf16*)(p->ws + WS_H2) + (size_t)row1 * D, lane, h1); }
        LAS float* hs = (LAS float*)(lds + wave * 8192);
#pragma unroll
        for (int j = 0; j < 4; ++j)
#pragma unroll
            for (int i = 0; i < 4; ++i) { hs[(4 * j + i) * 64 + lane] = h0[j][i]; hs[1024 + (4 * j + i) * 64 + lane] = h1[j][i]; }
        LDS_WAIT(); asm volatile("" ::: "memory");
        float pa[NE], pb[NE];
#pragma unroll
        for (int e = 0; e < NE; ++e) { pa[e] = 0.f; pb[e] = 0.f; }
#pragma unroll 2
        for (int t = 0; t < 16; ++t) {
            const float x0 = hs[t * 64 + lane], x1 = hs[1024 + t * 64 + lane]; const f32x4* wr = (const f32x4*)(rw + (size_t)(4 * lane + 256 * (t >> 2) + (t & 3)) * NE);
#pragma unroll
            for (int q = 0; q < 8; ++q) { const f32x4 w4 = wr[q];
                pa[4 * q + 0] += x0 * w4.x; pa[4 * q + 1] += x0 * w4.y; pa[4 * q + 2] += x0 * w4.z; pa[4 * q + 3] += x0 * w4.w;
                pb[4 * q + 0] += x1 * w4.x; pb[4 * q + 1] += x1 * w4.y; pb[4 * q + 2] += x1 * w4.z; pb[4 * q + 3] += x1 * w4.w; }
        }
        LDS_WAIT(); asm volatile("" ::: "memory");
        route_select(pa, rb, row0, TOPI, TOPG, POS, cnt, lane, true);
        route_select(pb, rb, row1, TOPI, TOPG, POS, cnt, lane, has1);
    }
}
__device__ __forceinline__ void phase_gather(PP p, int layer, int nrows, LAS unsigned char* lds, int tid, int lane, int wave) {
    LAS int* off = (LAS int*)lds;
    const unsigned* cnt = (const unsigned*)(p->ws + WS_CTL) + CW_CNT + layer * NE;
    int* TILEE = (int*)(p->ws + WS_ROUTE + RT_TILEE);
    if (tid == 0) {
        int o = 0;
        for (int e = 0; e < NE; ++e) { off[e] = o; const int nt = ((int)__hip_atomic_load(cnt + e, __ATOMIC_RELAXED, __HIP_MEMORY_SCOPE_AGENT) + 255) >> 8;
            if (blockIdx.x == 0) for (int t = 0; t < nt; ++t) TILEE[1 + (o >> 8) + t] = e;
            o += nt << 8; }
        off[NE] = o; if (blockIdx.x == 0) TILEE[0] = o >> 8;
    }
    __syncthreads();
    const int* TOPI = (const int*)(p->ws + WS_ROUTE + RT_TOPI); const int* POS = (const int*)(p->ws + WS_ROUTE + RT_POS); int* SLOT = (int*)(p->ws + WS_ROUTE + RT_SLOT);
    const bf16* H2 = (const bf16*)(p->ws + WS_H2); bf16* XB = (bf16*)(p->ws + WS_U + U_XB);
    const int gw = blockIdx.x * NWAVES + wave, NGW = gridDim.x * NWAVES;
    for (int it = gw; it < nrows * TOPK; it += NGW) {
        const int row = it >> 2; const int slot = off[TOPI[it]] + POS[it];
        if (lane == 0) SLOT[it] = slot;
        const v4u* s = (const v4u*)(H2 + (size_t)row * D); v4u* d = (v4u*)(XB + (size_t)slot * D);
        d[lane] = s[lane]; d[lane + 64] = s[lane + 64];
    }
    __syncthreads();
}
__device__ __forceinline__ void phase_combine(PP p, int layer, int nrows, bool final_out, int lane, int wave) {
    const int gw = blockIdx.x * NWAVES + wave, NGW = gridDim.x * NWAVES;
    const float* TOPG = (const float*)(p->ws + WS_ROUTE + RT_TOPG); const int* SLOT = (const int*)(p->ws + WS_ROUTE + RT_SLOT);
    const bf16* YS = (const bf16*)(p->ws + WS_U + U_YS); float* XR = (float*)(p->ws + WS_XR); float* RSTD = (float*)(p->ws + WS_ROUTE + RT_RSTD);
    for (int row = gw; row < nrows; row += NGW) {
        f32x4 v[4], acc[4]; load_row(XR + (size_t)row * D, lane, v);
#pragma unroll
        for (int j = 0; j < 4; ++j) acc[j] = (f32x4){0.f, 0.f, 0.f, 0.f};
#pragma unroll
        for (int k = 0; k < TOPK; ++k) {
            const float gk = TOPG[row * 4 + k]; const v2u* ys = (const v2u*)(YS + (size_t)SLOT[row * 4 + k] * D);
#pragma unroll
            for (int j = 0; j < 4; ++j) { const v2u w = ys[lane + 64 * j];
                acc[j].x += gk * bf2f(w.x & 0xffffu); acc[j].y += gk * bf2f(w.x >> 16); acc[j].z += gk * bf2f(w.y & 0xffffu); acc[j].w += gk * bf2f(w.y >> 16); }
        }
        const float* m5 = modp(p, layer, row_vec(row), 5);
#pragma unroll
        for (int j = 0; j < 4; ++j) v[j] = v[j] + ((const f32x4*)m5)[lane + 64 * j] * acc[j];
        const float rstd = row_rstd(v);
        if (final_out) {
#pragma unroll
            for (int j = 0; j < 4; ++j) ((f32x4*)(p->out + (size_t)row * D))[lane + 64 * j] = v[j] * rstd * ((const f32x4*)p->in[I_FINALG])[lane + 64 * j];
        } else {
#pragma unroll
            for (int j = 0; j < 4; ++j) ((f32x4*)(XR + (size_t)row * D))[lane + 64 * j] = v[j];
            if (lane == 0) RSTD[row] = rstd;
        }
    }
}

__device__ __forceinline__ int step_row(int b, int dir, int step) {
    if (step < CTXL) { const int t = dir ? (CTXL - 1 - step) : step; return NLAT + b * CTXL + t; }
    const int s = step - CTXL; const int t = dir ? (SEQ - 1 - s) : s; return b * SEQ + t;
}
constexpr int NSTEP = CTXL + SEQ;

__device__ __forceinline__ void phase_hg_readout(PP p, int lane, int wave) {
    const int gw = blockIdx.x * NWAVES + wave, NGW = gridDim.x * NWAVES;
    const bf16* Z = (const bf16*)(p->ws + WS_U + U_Z); const float* OD = (const float*)(p->ws + WS_U + U_OD0); bf16* A2 = (bf16*)(p->ws + WS_A2);
    const float* gn = p->in[I_HGGN];
    for (int row = gw; row < NROW; row += NGW) {
#pragma unroll
        for (int h = 0; h < 8; ++h) {
            const int c = h * 128 + 2 * lane;
            const float2 a = *(const float2*)(OD + (size_t)row * D + c), bq = *(const float2*)(OD + (size_t)(NROW + row) * D + c);
            const float o0 = a.x + bq.x, o1 = a.y + bq.y;
            const float rstd = rsqrtf(wave_sum(o0 * o0 + o1 * o1) * (1.0f / 128.0f) + NORM_EPS);
            const unsigned gz = *(const unsigned*)(Z + (size_t)row * 5120 + 4096 + c); const float g0 = bf2f(gz & 0xffffu), g1 = bf2f(gz >> 16);
            const float r0 = o0 * rstd * gn[2 * lane] * (g0 * sigm(g0)), r1 = o1 * rstd * gn[2 * lane + 1] * (g1 * sigm(g1));
            *(unsigned*)(A2 + (size_t)row * D + c) = pk2(r0, r1);
        }
    }
}

__device__ __forceinline__ void phase_lerp(PP p, int lane, int wave) {
    const int gw = blockIdx.x * NWAVES + wave, NGW = gridDim.x * NWAVES;
    const float* XR = (const float*)(p->ws + WS_XR); const float* RSTD = (const float*)(p->ws + WS_ROUTE + RT_RSTD);
    bf16* XL6 = (bf16*)(p->ws + WS_U + U_XL6); const float* g = p->in[I_NMIX] + D; const float* mu = p->in[I_MU];
    for (int row = gw; row < NROW; row += NGW) {
        const int vec = row_vec(row); const float* sh = modp(p, 1, vec, 0); const float* sc = modp(p, 1, vec, 1);
        int nb[4];
        if (row < NLAT) { const int t = row & (SEQ - 1), w = t & 63, r = t >> 6;
            nb[0] = (w >= 1) ? row - 1 : -1; nb[1] = (w < 63) ? row + 1 : -1; nb[2] = (r >= 1) ? row - 64 : -1; nb[3] = (r < SEQ / 64 - 1) ? row + 64 : -1;
        } else { const int t = (row - NLAT) & (CTXL - 1);
            nb[0] = nb[1] = (t >= 1) ? row - 1 : -1; nb[2] = nb[3] = (t < CTXL - 1) ? row + 1 : -1; }
        const float rs = RSTD[row];
#pragma unroll
        for (int j = 0; j < 4; ++j) {
            const int ci = lane + 64 * j;
            const f32x4 gg = ((const f32x4*)g)[ci], s1 = ((const f32x4*)sc)[ci] + 1.0f, s0 = ((const f32x4*)sh)[ci];
            const f32x4 xs = ((const f32x4*)(XR + (size_t)row * D))[ci];
            const f32x4 hs = xs * rs * gg * s1 + s0;
            f32x4 hn = (f32x4){0.f, 0.f, 0.f, 0.f};
            if (nb[j] >= 0) { const f32x4 xn = ((const f32x4*)(XR + (size_t)nb[j] * D))[ci]; hn = xn * RSTD[nb[j]] * gg * s1 + s0; }
            const f32x4 dx = hn - hs;
#pragma unroll
            for (int s = 0; s < 6; ++s) {
                const int m = (s == 0) ? 0 : (s == 1) ? 2 : (s == 2) ? 3 : (s == 3) ? 1 : (s == 4) ? 4 : 5;
                const f32x4 o = hs + dx * ((const f32x4*)(mu + m * D))[ci];
                v2u w; w.x = pk2(o.x, o.y); w.y = pk2(o.z, o.w);
                ((v2u*)(XL6 + ((size_t)s * NROW + row) * D))[ci] = w;
            }
        }
    }
}
__device__ __forceinline__ void phase_rw_readout(PP p, int lane, int wave) {
    const int gw = blockIdx.x * NWAVES + wave, NGW = gridDim.x * NWAVES;
    const bf16* RKV = (const bf16*)(p->ws + WS_U + U_RKV); const bf16* AD = (const bf16*)(p->ws + WS_U + U_AD); const bf16* G = (const bf16*)(p->ws + WS_U + U_G);
    const float* OD = (const float*)(p->ws + WS_U + U_OD1); bf16* A2 = (bf16*)(p->ws + WS_A2);
    for (int row = gw; row < NLAT; row += NGW) {
#pragma unroll 4
        for (int h = 0; h < 16; ++h) {
            const int ch = h * 64 + lane;
            const int bq = row >> 13, tq = row & (SEQ - 1), u0 = ((bq * 32 + h) * 4 + (lane >> 4)), u1 = ((bq * 32 + 16 + h) * 4 + (lane >> 4));
            const float y = OD[((size_t)u0 * NSTEP + CTXL + tq) * 16 + (lane & 15)] + OD[((size_t)u1 * NSTEP + CTXL + (SEQ - 1 - tq)) * 16 + (lane & 15)];
            const float mean = wave_sum(y) * (1.0f / 64.0f); const float d = y - mean; const float var = wave_sum(d * d) * (1.0f / 64.0f);
            float yn = d * rsqrtf(var + 64.0e-5f) * p->in[I_LNXW][ch] + p->in[I_LNXB][ch];
            const float r = bf2f(RKV[(size_t)row * 3072 + ch]), k = bf2f(RKV[(size_t)row * 3072 + 1024 + ch]), v = bf2f(RKV[(size_t)row * 3072 + 2048 + ch]);
            const float ka = p->in[I_KA][ch], rk = p->in[I_RK][ch];
#pragma unroll
            for (int dd = 0; dd < 2; ++dd) { const float a = bf2f(AD[((size_t)dd * NROW + row) * D + ch]); const float kd = k * (1.f + (a - 1.f) * ka);
                yn += wave_sum(r * kd * rk) * v; }
            const float o = yn * bf2f(G[(size_t)row * D + ch]);
            const float o1 = __shfl_down(o, 1);
            if (!(lane & 1)) *(unsigned*)(A2 + (size_t)row * D + ch) = pk2(o, o1);
        }
    }
}

namespace pg8 {
struct SelOrder : StaticOrder {
    int div, sel0; size_t stride;
    __device__ __forceinline__ const char* abase(const Gemm& g, const Unit& u, size_t tstep) const { return (const char*)g.A + (size_t)(sel0 + u.pn / div) * stride + (size_t)u.pm * tstep; }
};
struct MoeOrder {
    const int* tilee; int nt, ntn, G, c; size_t estride;
    __device__ __forceinline__ void init(const int* te, int ntn_, size_t es, int G_, int c_) { tilee = te; nt = te[0]; ntn = ntn_; estride = es; G = G_; c = c_; }
    __device__ __forceinline__ bool next(int i, Unit& u) const { const long L = (long)i * G + c; if (L >= (long)nt * ntn) return false; u.pm = (int)(L / ntn); u.pn = (int)(L % ntn); u.e = tilee[1 + u.pm]; return true; }
    __device__ __forceinline__ const char* abase(const Gemm& g, const Unit& u, size_t tstep) const { return (const char*)g.A + (size_t)u.pm * tstep; }
    __device__ __forceinline__ const char* bbase(const Gemm& g, const Unit& u, size_t tstep) const { return (const char*)g.Bt + (size_t)u.e * estride + (size_t)u.pn * tstep; }
    __device__ __forceinline__ void a_ready(const Unit&) const {}
    __device__ __forceinline__ void done(const Unit&) const {}
};
struct EpiStoreBf16 {
    static constexpr bool PERM = true, AFTER_DRAIN = false;
    bf16_t* O; int ldc;
    __device__ __forceinline__ void operator()(const f32x4 (&acc)[2][2][4][2], const Unit& u, int wr, int wc, int fr, int fq) const {
        const int row0 = u.pm * BM + wr * 64 + fr, col0 = u.pn * BM + wc * 32 + 8 * fq;
#pragma unroll
        for (int ai = 0; ai < 2; ++ai)
#pragma unroll
            for (int m = 0; m < 4; ++m) { bf16_t* rowp = O + (size_t)(row0 + ai * HALF + m * 16) * ldc + col0;
#pragma unroll
                for (int bj = 0; bj < 2; ++bj) { const f32x4 v0 = acc[ai][bj][m][0], v1 = acc[ai][bj][m][1];
                    u32x4 w; w.x = cvt_pk_bf16(v0[0], v0[1]); w.y = cvt_pk_bf16(v0[2], v0[3]); w.z = cvt_pk_bf16(v1[0], v1[1]); w.w = cvt_pk_bf16(v1[2], v1[3]);
                    *(u32x4*)(rowp + bj * HALF) = w; } }
    }
};
struct EpiStoreF32 {
    static constexpr bool PERM = false, AFTER_DRAIN = false;
    float* C; int ldc;
    __device__ __forceinline__ void operator()(const f32x4 (&acc)[2][2][4][2], const Unit& u, int wr, int wc, int fr, int fq) const {
        const int row0 = u.pm * BM + wr * 64 + fr, col0 = u.pn * BM + wc * 32 + 4 * fq;
#pragma unroll
        for (int ai = 0; ai < 2; ++ai)
#pragma unroll
            for (int m = 0; m < 4; ++m) { float* rowp = C + (size_t)(row0 + ai * HALF + m * 16) * ldc + col0;
#pragma unroll
                for (int bj = 0; bj < 2; ++bj)
#pragma unroll
                    for (int n = 0; n < 2; ++n) *(f32x4*)(rowp + bj * HALF + n * 16) = acc[ai][bj][m][n]; }
    }
};
struct EpiResid {
    static constexpr bool PERM = false, AFTER_DRAIN = false;
    const float* base_lat; const float* base_ctx; float* out; const float* gate; int gstride;
    __device__ __forceinline__ void operator()(const f32x4 (&acc)[2][2][4][2], const Unit& u, int wr, int wc, int fr, int fq) const {
        const int row0 = u.pm * BM + wr * 64 + fr, col0 = u.pn * BM + wc * 32 + 4 * fq;
#pragma unroll
        for (int ai = 0; ai < 2; ++ai)
#pragma unroll
            for (int m = 0; m < 4; ++m) { const int row = row0 + ai * HALF + m * 16;
                const float* bp = (row < 16384) ? base_lat + (size_t)row * 1024 : base_ctx + (size_t)(row - 16384) * 1024;
                const float* gp = gate + (size_t)(row < 16384 ? (row >= 8192 ? 1 : 0) : 2) * gstride;
                float* op = out + (size_t)row * 1024;
#pragma unroll
                for (int bj = 0; bj < 2; ++bj)
#pragma unroll
                    for (int n = 0; n < 2; ++n) { const int c = col0 + bj * HALF + n * 16;
                        *(f32x4*)(op + c) = *(const f32x4*)(bp + c) + *(const f32x4*)(gp + c) * acc[ai][bj][m][n]; } }
    }
};
__device__ __forceinline__ float sigm_(float x) { return __builtin_amdgcn_rcpf(1.0f + __expf(-x)); }
struct EpiSwiglu {
    static constexpr bool PERM = true, AFTER_DRAIN = false;
    bf16_t* O; const float* bgu;
    __device__ __forceinline__ void operator()(const f32x4 (&acc)[2][2][4][2], const Unit& u, int wr, int wc, int fr, int fq) const {
        const int row0 = u.pm * BM + wr * 64 + fr, col0 = u.pn * HALF + wc * 32 + 8 * fq;
        const float* bg = bgu + (size_t)u.e * 2048 + col0; f32x4 bgv[2], buv[2];
#pragma unroll
        for (int n = 0; n < 2; ++n) { bgv[n] = *(const f32x4*)(bg + 4 * n); buv[n] = *(const f32x4*)(bg + 1024 + 4 * n); }
#pragma unroll
        for (int ai = 0; ai < 2; ++ai)
#pragma unroll
            for (int m = 0; m < 4; ++m) { float r[8];
#pragma unroll
                for (int n = 0; n < 2; ++n) { const f32x4 g4 = acc[ai][0][m][n] + bgv[n], u4 = acc[ai][1][m][n] + buv[n];
#pragma unroll
                    for (int j = 0; j < 4; ++j) { const float g = fminf(g4[j], 7.0f), uu = fminf(fmaxf(u4[j], -7.0f), 7.0f); r[4 * n + j] = g * sigm_(1.702f * g) * (uu + 1.0f); } }
                u32x4 w; w.x = cvt_pk_bf16(r[0], r[1]); w.y = cvt_pk_bf16(r[2], r[3]); w.z = cvt_pk_bf16(r[4], r[5]); w.w = cvt_pk_bf16(r[6], r[7]);
                *(u32x4*)(O + (size_t)(row0 + ai * HALF + m * 16) * 1024 + col0) = w; }
    }
};
struct EpiDown {
    static constexpr bool PERM = true, AFTER_DRAIN = false;
    bf16_t* O; const float* bdn;
    __device__ __forceinline__ void operator()(const f32x4 (&acc)[2][2][4][2], const Unit& u, int wr, int wc, int fr, int fq) const {
        const int row0 = u.pm * BM + wr * 64 + fr, col0 = u.pn * BM + wc * 32 + 8 * fq;
        const float* bp = bdn + (size_t)u.e * 1024 + col0; f32x4 bv[2][2];
#pragma unroll
        for (int bj = 0; bj < 2; ++bj)
#pragma unroll
            for (int n = 0; n < 2; ++n) bv[bj][n] = *(const f32x4*)(bp + bj * HALF + 4 * n);
#pragma unroll
        for (int ai = 0; ai < 2; ++ai)
#pragma unroll
            for (int m = 0; m < 4; ++m) { bf16_t* rowp = O + (size_t)(row0 + ai * HALF + m * 16) * 1024 + col0;
#pragma unroll
                for (int bj = 0; bj < 2; ++bj) { const f32x4 v0 = acc[ai][bj][m][0] + bv[bj][0], v1 = acc[ai][bj][m][1] + bv[bj][1];
                    u32x4 w; w.x = cvt_pk_bf16(v0[0], v0[1]); w.y = cvt_pk_bf16(v0[2], v0[3]); w.z = cvt_pk_bf16(v1[0], v1[1]); w.w = cvt_pk_bf16(v1[2], v1[3]);
                    *(u32x4*)(rowp + bj * HALF) = w; } }
    }
};
struct EpiLora1 {
    static constexpr bool PERM = true, AFTER_DRAIN = false;
    bf16_t* O;
    __device__ __forceinline__ void operator()(const f32x4 (&acc)[2][2][4][2], const Unit& u, int wr, int wc, int fr, int fq) const {
        const int row0 = u.pm * BM + wr * 64 + fr, col0 = u.pn * HALF + wc * 32 + 8 * fq;
#pragma unroll
        for (int ai = 0; ai < 2; ++ai)
#pragma unroll
            for (int m = 0; m < 4; ++m) { float r[8];
#pragma unroll
                for (int n = 0; n < 2; ++n)
#pragma unroll
                    for (int j = 0; j < 4; ++j) { const float x = acc[ai][0][m][n][j]; r[4 * n + j] = (u.pn == 0) ? (2.0f * sigm_(2.0f * x) - 1.0f) : (u.pn == 1) ? x : sigm_(x); }
                u32x4 w; w.x = cvt_pk_bf16(r[0], r[1]); w.y = cvt_pk_bf16(r[2], r[3]); w.z = cvt_pk_bf16(r[4], r[5]); w.w = cvt_pk_bf16(r[6], r[7]);
                *(u32x4*)(O + (size_t)(row0 + ai * HALF + m * 16) * 384 + col0) = w; }
    }
};
struct EpiLora2 {
    static constexpr bool PERM = false, AFTER_DRAIN = false;
    bf16_t* WD; bf16_t* AD; bf16_t* G; const float* w0; const float* a0;
    __device__ __forceinline__ void operator()(const f32x4 (&acc)[2][2][4][2], const Unit& u, int wr, int wc, int fr, int fq) const {
        const int row0 = u.pm * BM + wr * 64 + fr, blk = u.pn >> 2, col0 = (u.pn & 3) * BM + wc * 32 + 4 * fq;
        bf16_t* dst = (blk < 2) ? WD + (size_t)blk * 16896 * 1024 : (blk < 4) ? AD + (size_t)(blk - 2) * 16896 * 1024 : G;
        const float* bias = (blk < 2) ? w0 + blk * 1024 : a0 + ((blk - 2) & 1) * 1024;
#pragma unroll
        for (int ai = 0; ai < 2; ++ai)
#pragma unroll
            for (int m = 0; m < 4; ++m) { bf16_t* rowp = dst + (size_t)(row0 + ai * HALF + m * 16) * 1024;
#pragma unroll
                for (int bj = 0; bj < 2; ++bj)
#pragma unroll
                    for (int n = 0; n < 2; ++n) { const int c = col0 + bj * HALF + n * 16; f32x4 v = acc[ai][bj][m][n];
                        const f32x4 bb = *(const f32x4*)(bias + c);
                        if (blk < 2) { for (int j = 0; j < 4; ++j) v[j] = -0.60653066f * sigm_(v[j] + bb[j]); }
                        else if (blk < 4) { for (int j = 0; j < 4; ++j) v[j] = sigm_(v[j] + bb[j]); }
                        unsigned lo = cvt_pk_bf16(v[0], v[1]), hi = cvt_pk_bf16(v[2], v[3]);
                        *(unsigned long long*)(rowp + c) = (unsigned long long)lo | ((unsigned long long)hi << 32); }
                asm volatile("" ::: "memory"); }
    }
};
}

constexpr int GLA_NCH = NSTEP / 64;
constexpr int GLA_ITEMS = 2 * NBATCH * GLA_NCH * 8;
constexpr size_t U_DS = 298 * MiB, U_OI = 430 * MiB, U_QT = 562 * MiB, U_LAM = 628 * MiB;
typedef short bf16x8_t __attribute__((ext_vector_type(8)));
typedef float f32x2g __attribute__((ext_vector_type(2)));
__device__ __forceinline__ f32x4 mfma16(bf16x8_t a, bf16x8_t b, f32x4 c) { return __builtin_amdgcn_mfma_f32_16x16x32_bf16(a, b, c, 0, 0, 0); }

__device__ __forceinline__ void phase_gla_prep(PP p, LAS unsigned char* lds, int tid, int lane, int wave) {
    constexpr int PQ = 272, PT = 144;
    LAS unsigned char* QA = lds;
    LAS unsigned char* QX = QA + 64 * PQ;
    LAS unsigned char* KB = QX + 48 * PQ;
    LAS unsigned char* KD = KB + 64 * PQ;
    LAS unsigned char* KT = KD + 64 * PQ;
    LAS unsigned char* VT = KT + 128 * PT;
    LAS unsigned char* PI = VT + 128 * PT;
    LAS float* GT = (LAS float*)(PI + 64 * PT);
    const bf16* Z = (const bf16*)(p->ws + WS_U + U_Z);
    bf16* DS = (bf16*)(p->ws + WS_U + U_DS); v2u* OI = (v2u*)(p->ws + WS_U + U_OI); bf16* QT = (bf16*)(p->ws + WS_U + U_QT); float* LAM = (float*)(p->ws + WS_U + U_LAM);
    const int kp = tid & 63, gg = tid >> 6, g = gg >> 1, hh = gg & 1, k0 = 2 * kp, kq = lane >> 4, c16 = lane & 15;
    unsigned zf[8], zq[8], zv[8];
    auto ldz = [&](int item2) {
        const int h2 = item2 & 7, cc2 = (item2 >> 3) % GLA_NCH, db2 = (item2 >> 3) / GLA_NCH, b2 = db2 & 1, dir2 = db2 >> 1;
#pragma unroll
        for (int i = 0; i < 8; ++i) { const size_t zr = (size_t)step_row(b2, dir2, 64 * cc2 + 8 * gg + i) * 5120 + h2 * 128 + k0;
            zf[i] = *(const unsigned*)(Z + zr + 1024 * (1 + dir2)); zq[i] = *(const unsigned*)(Z + zr); zv[i] = *(const unsigned*)(Z + zr + 3072); } };
    if ((int)blockIdx.x < GLA_ITEMS) ldz(blockIdx.x);
    for (int item = blockIdx.x; item < GLA_ITEMS; item += gridDim.x) {
        const int h = item & 7, db = (item >> 3) / GLA_NCH, dir = db >> 1;
        float lbv[2];
#pragma unroll
        for (int e = 0; e < 2; ++e) { const float* lb = p->in[I_HGLB] + (size_t)dir * 3 * D + h * 128 + k0 + e; const float a0 = lb[0], a1 = lb[D], a2 = lb[2 * D];
            const float mx = fmaxf(a0, fmaxf(a1, a2)); const float e0 = __expf(a0 - mx), e1 = __expf(a1 - mx), e2 = __expf(a2 - mx); lbv[e] = e0 / (e0 + e1 + e2); }
        for (int u = tid; u < 64 * PT / 4; u += NTHREADS) ((LAS unsigned*)PI)[u] = 0u;
        float cs[2][8], kin[2][8], qs[2][8], run[2] = {0.f, 0.f}; unsigned vlo[4], vhi[4];
#pragma unroll
        for (int i = 0; i < 8; ++i) {
#pragma unroll
            for (int e = 0; e < 2; ++e) {
                const float fh = bf2f(e ? (zf[i] >> 16) : (zf[i] & 0xffffu)), qv = bf2f(e ? (zq[i] >> 16) : (zq[i] & 0xffffu));
                const float f = lbv[e] + (1.f - lbv[e]) * sigm(fh);
                run[e] += __logf(f); cs[e][i] = run[e]; kin[e][i] = 1.f - f; qs[e][i] = qv * sigm(qv);
            }
            if (i & 1) { vlo[i >> 1] |= zv[i] << 16; vhi[i >> 1] |= zv[i] & 0xffff0000u; } else { vlo[i >> 1] = zv[i] & 0xffffu; vhi[i >> 1] = zv[i] >> 16; }
        }
        if (item + (int)gridDim.x < GLA_ITEMS) ldz(item + gridDim.x);
        *(LAS f32x2g*)(GT + gg * 128 + k0) = (f32x2g){run[0], run[1]};
        *(LAS v4u*)(VT + k0 * PT + 16 * gg) = (v4u){vlo[0], vlo[1], vlo[2], vlo[3]};
        *(LAS v4u*)(VT + (k0 + 1) * PT + 16 * gg) = (v4u){vhi[0], vhi[1], vhi[2], vhi[3]};
        __syncthreads();
        f32x2g t8[8];
#pragma unroll
        for (int u = 0; u < 8; ++u) t8[u] = *(const LAS f32x2g*)(GT + u * 128 + k0);
        unsigned ktl[4], kth[4];
        float rgv[2], totv[2], runSv[2], lov[2], t1v[2], t2v[2];
#pragma unroll
        for (int e = 0; e < 2; ++e) {
            const float s0 = e ? t8[0].y : t8[0].x, s1 = e ? t8[1].y : t8[1].x, s2 = e ? t8[2].y : t8[2].x, s3 = e ? t8[3].y : t8[3].x;
            const float s4 = e ? t8[4].y : t8[4].x, s5 = e ? t8[5].y : t8[5].x, s6 = e ? t8[6].y : t8[6].x, s7 = e ? t8[7].y : t8[7].x;
            const float q0 = s0 + s1, q1 = s2 + s3, q2 = s4 + s5, q3 = s6 + s7;
            rgv[e] = (g > 0 ? q0 : 0.f) + (g > 1 ? q1 : 0.f) + (g > 2 ? q2 : 0.f); totv[e] = (q0 + q1) + (q2 + q3);
            runSv[e] = (g == 0) ? q0 : (g == 1) ? q1 : (g == 2) ? q2 : q3;
            const float first = (g == 0) ? s0 : (g == 1) ? s2 : (g == 2) ? s4 : s6;
            lov[e] = hh ? first : 0.f; t1v[e] = q1; t2v[e] = q2;
        }
        float erg[2], einv[2], eend[2], ex1[2], ex2[2];
#pragma unroll
        for (int e = 0; e < 2; ++e) { erg[e] = __expf(rgv[e]); einv[e] = __expf(-runSv[e]); eend[e] = __expf(totv[e] - (rgv[e] + runSv[e]));
            ex1[e] = (g == 2) ? __expf(t1v[e]) : __expf(t2v[e]); ex2[e] = __expf(t1v[e] + t2v[e]); }
        bf16* qtp = QT + (size_t)item * 64 * 128 + (size_t)(16 * g + 8 * hh) * 128 + k0;
#pragma unroll
        for (int i = 0; i < 8; ++i) {
            float qh[2], kb[2];
#pragma unroll
            for (int e = 0; e < 2; ++e) { const float cr = lov[e] + cs[e][i]; qh[e] = qs[e][i] * __expf(cr); kb[e] = kin[e][i] * __expf(runSv[e] - cr); }
            const int ro = (16 * g + 8 * hh + i) * PQ + 2 * k0;
            *(LAS unsigned*)(QA + ro) = pk2(qh[0], qh[1]);
            *(LAS unsigned*)(KB + ro) = pk2(kb[0], kb[1]);
            *(LAS unsigned*)(KD + ro) = pk2(kb[0] * einv[0], kb[1] * einv[1]);
            if (g == 2) *(LAS unsigned*)(QX + (8 * hh + i) * PQ + 2 * k0) = pk2(qh[0] * ex1[0], qh[1] * ex1[1]);
            if (g == 3) { *(LAS unsigned*)(QX + (16 + 8 * hh + i) * PQ + 2 * k0) = pk2(qh[0] * ex1[0], qh[1] * ex1[1]); *(LAS unsigned*)(QX + (32 + 8 * hh + i) * PQ + 2 * k0) = pk2(qh[0] * ex2[0], qh[1] * ex2[1]); }
            *(unsigned*)(qtp + (size_t)i * 128) = pk2(qh[0] * erg[0], qh[1] * erg[1]);
            const unsigned kv0 = f2bf(kb[0] * eend[0]), kv1 = f2bf(kb[1] * eend[1]);
            if (i & 1) { ktl[i >> 1] |= kv0 << 16; kth[i >> 1] |= kv1 << 16; } else { ktl[i >> 1] = kv0; kth[i >> 1] = kv1; }
        }
        *(LAS v4u*)(KT + k0 * PT + 16 * gg) = (v4u){ktl[0], ktl[1], ktl[2], ktl[3]};
        *(LAS v4u*)(KT + (k0 + 1) * PT + 16 * gg) = (v4u){kth[0], kth[1], kth[2], kth[3]};
        if (gg == 0) *(f32x2g*)(LAM + (size_t)item * 128 + k0) = (f32x2g){__expf(totv[0]), __expf(totv[1])};
        __syncthreads();
        for (int blk = wave; blk < 10; blk += 8) {
            const int gi = (blk >= 6) ? 3 : (blk >= 3) ? 2 : (blk >= 1) ? 1 : 0, ji = blk - ((gi * (gi + 1)) >> 1);
            const LAS unsigned char* ab = (ji + 1 >= gi) ? QA + 16 * gi * PQ : (gi == 2) ? QX : (ji == 1) ? QX + 16 * PQ : QX + 32 * PQ;
            const LAS unsigned char* bb = ((ji == gi) ? KD : KB) + 16 * ji * PQ;
            f32x4 acc = (f32x4){0.f, 0.f, 0.f, 0.f};
#pragma unroll
            for (int s = 0; s < 4; ++s) {
                const bf16x8_t a = *(const LAS bf16x8_t*)(ab + c16 * PQ + (32 * s + 8 * kq) * 2), bv = *(const LAS bf16x8_t*)(bb + c16 * PQ + (32 * s + 8 * kq) * 2);
                acc = mfma16(a, bv, acc);
            }
#pragma unroll
            for (int j = 0; j < 4; ++j) { const int tau = 4 * kq + j; const float val = (ji == gi && c16 > tau) ? 0.f : acc[j];
                *(LAS unsigned short*)(PI + (16 * gi + tau) * PT + (16 * ji + c16) * 2) = (unsigned short)f2bf(val); }
        }
        __syncthreads();
        {
            const LAS unsigned char* vb = VT + (16 * wave + c16) * PT + 16 * kq;
            const bf16x8_t v0 = *(const LAS bf16x8_t*)(vb), v1 = *(const LAS bf16x8_t*)(vb + 64);
#pragma unroll
            for (int gi = 0; gi < 4; ++gi) {
                const LAS unsigned char* pb = PI + (16 * gi + c16) * PT + 16 * kq;
                f32x4 acc = mfma16(*(const LAS bf16x8_t*)(pb), v0, (f32x4){0.f, 0.f, 0.f, 0.f});
                if (gi >= 2) acc = mfma16(*(const LAS bf16x8_t*)(pb + 64), v1, acc);
                { v2u w; w.x = pk2(acc[0], acc[1]); w.y = pk2(acc[2], acc[3]); OI[((size_t)item * 8 + wave) * 256 + gi * 64 + lane] = w; }
            }
            bf16* dsp = DS + (size_t)item * 128 * 128 + (size_t)(16 * wave + c16) * 128 + 4 * kq;
#pragma unroll
            for (int m = 0; m < 8; ++m) {
                const LAS unsigned char* kb2 = KT + (16 * m + c16) * PT + 16 * kq;
                f32x4 acc = mfma16(*(const LAS bf16x8_t*)(kb2), v0, (f32x4){0.f, 0.f, 0.f, 0.f});
                acc = mfma16(*(const LAS bf16x8_t*)(kb2 + 64), v1, acc);
                v2u w; w.x = pk2(acc[0], acc[1]); w.y = pk2(acc[2], acc[3]);
                *(v2u*)(dsp + 16 * m) = w;
            }
        }
        __syncthreads();
    }
}
__device__ __forceinline__ void phase_gla_scan(PP p, int tid) {
    bf16* DS = (bf16*)(p->ws + WS_U + U_DS); const float* LAM = (const float*)(p->ws + WS_U + U_LAM);
    const int nthr = gridDim.x * NTHREADS;
    for (int e = blockIdx.x * NTHREADS + tid; e < 32 * 2048; e += nthr) {
        const int chain = e >> 11, el = e & 2047, h = chain & 7, db = chain >> 3, k8 = (el & 15) * 8;
        float s[8];
#pragma unroll
        for (int i = 0; i < 8; ++i) s[i] = 0.f;
        for (int c0 = 0; c0 < GLA_NCH; c0 += 6) {
            v4u d[6]; f32x4 l0[6], l1[6];
#pragma unroll
            for (int u = 0; u < 6; ++u) { const size_t item = ((size_t)db * GLA_NCH + c0 + u) * 8 + h;
                d[u] = *(const v4u*)(DS + item * 16384 + (size_t)el * 8); l0[u] = *(const f32x4*)(LAM + item * 128 + k8); l1[u] = *(const f32x4*)(LAM + item * 128 + k8 + 4); }
#pragma unroll
            for (int u = 0; u < 6; ++u) { const size_t item = ((size_t)db * GLA_NCH + c0 + u) * 8 + h;
                v4u o; o.x = pk2(s[0], s[1]); o.y = pk2(s[2], s[3]); o.z = pk2(s[4], s[5]); o.w = pk2(s[6], s[7]);
                *(v4u*)(DS + item * 16384 + (size_t)el * 8) = o;
                s[0] = l0[u].x * s[0] + bf2f(d[u].x & 0xffffu); s[1] = l0[u].y * s[1] + bf2f(d[u].x >> 16);
                s[2] = l0[u].z * s[2] + bf2f(d[u].y & 0xffffu); s[3] = l0[u].w * s[3] + bf2f(d[u].y >> 16);
                s[4] = l1[u].x * s[4] + bf2f(d[u].z & 0xffffu); s[5] = l1[u].y * s[5] + bf2f(d[u].z >> 16);
                s[6] = l1[u].z * s[6] + bf2f(d[u].w & 0xffffu); s[7] = l1[u].w * s[7] + bf2f(d[u].w >> 16); }
        }
    }
}
__device__ __forceinline__ void phase_gla_out(PP p, int lane, int wave) {
    const bf16* DS = (const bf16*)(p->ws + WS_U + U_DS); const v2u* OI = (const v2u*)(p->ws + WS_U + U_OI); const bf16* QT = (const bf16*)(p->ws + WS_U + U_QT);
    float* ODb = (float*)(p->ws + WS_U + U_OD0);
    const int kq = lane >> 4, c16 = lane & 15;
    for (int item = blockIdx.x; item < GLA_ITEMS; item += gridDim.x) {
        const int h = item & 7, cc = (item >> 3) % GLA_NCH, db = (item >> 3) / GLA_NCH, b = db & 1, dir = db >> 1;
        const bf16* sp = DS + (size_t)item * 16384 + (size_t)(16 * wave + c16) * 128 + 8 * kq;
        bf16x8_t bv[4];
#pragma unroll
        for (int s = 0; s < 4; ++s) bv[s] = *(const bf16x8_t*)(sp + 32 * s);
        float* OD = ODb + (size_t)dir * NROW * D + h * 128 + 16 * wave + c16;
#pragma unroll
        for (int gi = 0; gi < 4; ++gi) {
            const bf16* qp = QT + (size_t)item * 8192 + (size_t)(16 * gi + c16) * 128 + 8 * kq;
            const v2u ow = OI[((size_t)item * 8 + wave) * 256 + gi * 64 + lane];
            f32x4 acc = (f32x4){bf2f(ow.x & 0xffffu), bf2f(ow.x >> 16), bf2f(ow.y & 0xffffu), bf2f(ow.y >> 16)};
#pragma unroll
            for (int s = 0; s < 4; ++s) acc = mfma16(*(const bf16x8_t*)(qp + 32 * s), bv[s], acc);
#pragma unroll
            for (int j = 0; j < 4; ++j) OD[(size_t)step_row(b, dir, 64 * cc + 16 * gi + 4 * kq + j) * D] = acc[j];
        }
    }
}

typedef short bf16x4_t __attribute__((ext_vector_type(4)));
typedef float f32x2_t __attribute__((ext_vector_type(2))); typedef __bf16 bf16x2v_t __attribute__((ext_vector_type(2)));
__device__ __forceinline__ unsigned cvtpk(float lo, float hi) { const f32x2_t v = {lo, hi}; const bf16x2v_t b = __builtin_convertvector(v, bf16x2v_t); return __builtin_bit_cast(unsigned, b); }
constexpr int R4_DOTA = 0, R4_UPA = 2048, R4_A1 = 4096, R4_A2 = 4352, R4_G7 = 4608, R4_VT = 4864, R4_IMG = 6912, R4_SLOT = 5376, R4_NCH = NSTEP / 8, R4_NCB = 8;
constexpr size_t U_IMG = 872 * MiB;
constexpr size_t U_YST = U_OD1;
__device__ __forceinline__ void phase_rw_prep(PP p, LAS unsigned char* lds, int lane, int wave) {
    const int gw = blockIdx.x * NWAVES + wave, NGW = gridDim.x * NWAVES;
    const bf16* RKV = (const bf16*)(p->ws + WS_U + U_RKV); unsigned char* IMG = p->ws + WS_U + U_IMG;
    LAS unsigned char* da = lds + wave * 8192; LAS unsigned char* gb = da + 2048; LAS float* GL = (LAS float*)(da + 4096);
    LAS unsigned char* a12 = da + 5120;
    const int m = lane & 15, q = lane >> 4;
    const int s2 = lane >> 5, tp = (lane >> 4) & 1, kq = (lane & 15) >> 2, ii = (lane & 3) + 4 * tp, dpos = ((s2 * 4 + kq) * 8 + ii) * 2;
    float nrx[8], nkx[8], nvx[8], nlw[8], nav[8];
    auto ld = [&](int it2) {
        const int chain = it2 & 63, chunk = it2 >> 6, b = chain >> 5, dir = (chain >> 4) & 1, h = chain & 15, ch = h * 64 + lane;
        const bf16* WDp = (const bf16*)(p->ws + WS_U + U_WD) + (size_t)dir * NROW * D; const bf16* ADp = (const bf16*)(p->ws + WS_U + U_AD) + (size_t)dir * NROW * D;
#pragma unroll
        for (int j = 0; j < 8; ++j) { const int row = step_row(b, dir, chunk * 8 + j);
            nrx[j] = bf2f(RKV[(size_t)row * 3072 + ch]); nkx[j] = bf2f(RKV[(size_t)row * 3072 + 1024 + ch]); nvx[j] = bf2f(RKV[(size_t)row * 3072 + 2048 + ch]);
            nlw[j] = bf2f(WDp[(size_t)row * D + ch]); nav[j] = bf2f(ADp[(size_t)row * D + ch]); } };
    if (gw < 64 * R4_NCH) ld(gw);
    for (int it = gw; it < 64 * R4_NCH; it += NGW) {
        const int chain = it & 63, chunk = it >> 6, h = chain & 15, ch = h * 64 + lane;
        const float kkw = p->in[I_KK][ch], kaw = p->in[I_KA][ch];
        float rx[8], kx[8], vx[8], lw[8], av[8], kn[8];
#pragma unroll
        for (int j = 0; j < 8; ++j) { rx[j] = nrx[j]; kx[j] = nkx[j]; vx[j] = nvx[j]; lw[j] = nlw[j]; av[j] = nav[j]; }
        if (it + NGW < 64 * R4_NCH) ld(it + NGW);
#pragma unroll
        for (int j = 0; j < 8; ++j) { const float t = kx[j] * kkw; kn[j] = t / fmaxf(sqrtf(wave_sum(t * t)), 1e-12f); }
        float bj[8]; { float bb = 0.f;
#pragma unroll
            for (int j = 0; j < 8; ++j) { bb += lw[j]; bj[j] = bb; } }
        const float e7 = __expf(bj[7]);
        unsigned upa[8]; float ebprev = 1.f;
#pragma unroll
        for (int j = 0; j < 8; ++j) {
            const float eb = __expf(bj[j]), einv = 1.0f / eb, e7j = e7 * einv;
            const float beta = kn[j] * av[j], kd = kx[j] * (1.f + (av[j] - 1.f) * kaw);
            *(LAS unsigned short*)(da + j * 128 + dpos) = (unsigned short)f2bf(kn[j] * ebprev);
            *(LAS unsigned short*)(da + (8 + j) * 128 + dpos) = (unsigned short)f2bf(rx[j] * eb);
            *(LAS unsigned short*)(gb + j * 128 + dpos) = (unsigned short)f2bf(beta * einv);
            *(LAS unsigned short*)(gb + (8 + j) * 128 + dpos) = (unsigned short)f2bf(kd * einv);
            const unsigned ub = f2bf(-beta * e7j), uk = f2bf(kd * e7j);
            if (j & 1) { upa[j >> 1] |= ub << 16; upa[4 + (j >> 1)] |= uk << 16; } else { upa[j >> 1] = ub; upa[4 + (j >> 1)] = uk; }
            ebprev = eb;
        }
        unsigned char* img = IMG + ((size_t)chain * R4_NCH + chunk) * R4_IMG;
        { v4u* d = (v4u*)(img + R4_UPA + lane * 32); d[0] = (v4u){upa[0], upa[1], upa[2], upa[3]}; d[1] = (v4u){upa[4], upa[5], upa[6], upa[7]}; }
        ((float*)(img + R4_G7))[lane] = e7;
        { f32x4* d = (f32x4*)(img + R4_VT + lane * 32); d[0] = (f32x4){vx[0], vx[1], vx[2], vx[3]}; d[1] = (f32x4){vx[4], vx[5], vx[6], vx[7]}; }
        LDS_WAIT(); asm volatile("" ::: "memory");
        { v4u* d = (v4u*)(img + R4_DOTA); d[lane] = ((const LAS v4u*)da)[lane]; d[64 + lane] = ((const LAS v4u*)da)[64 + lane]; }
        f32x4 G = (f32x4){0.f, 0.f, 0.f, 0.f};
#pragma unroll
        for (int s = 0; s < 2; ++s) G = mfma16(*(const LAS bf16x8_t*)(da + m * 128 + (s * 4 + q) * 16), *(const LAS bf16x8_t*)(gb + m * 128 + (s * 4 + q) * 16), G);
        if (m >= 8) { const int i = m - 8;
#pragma unroll
            for (int jp = 0; jp < 4; ++jp) { const int row = 4 * q + jp; const bool keep = (row < 8) ? (i < row) : (i <= row - 8);
                *(LAS unsigned short*)(a12 + row * 16 + i * 2) = (unsigned short)f2bf(keep ? G[jp] : 0.f); } }
#pragma unroll
        for (int jp = 0; jp < 4; ++jp) GL[(4 * q + jp) * 16 + m] = G[jp];
        LDS_WAIT(); asm volatile("" ::: "memory");
        const int c = lane & 7; float Tc[8], M2[8];
#pragma unroll
        for (int j = 0; j < 8; ++j) { float t = (j == c) ? 1.f : 0.f; const f32x4 ra = *(const LAS f32x4*)(GL + j * 16), rb = *(const LAS f32x4*)(GL + j * 16 + 4);
#pragma unroll
            for (int i = 0; i < j; ++i) t -= (i < 4 ? ra[i & 3] : rb[i & 3]) * Tc[i];
            Tc[j] = t; }
#pragma unroll
        for (int j = 0; j < 8; ++j) { float t = 0.f; const f32x4 ra = *(const LAS f32x4*)(GL + (8 + j) * 16), rb = *(const LAS f32x4*)(GL + (8 + j) * 16 + 4);
#pragma unroll
            for (int i = 0; i <= j; ++i) t -= (i < 4 ? ra[i & 3] : rb[i & 3]) * Tc[i];
            M2[j] = t; }
        if (lane < 8) {
#pragma unroll
            for (int j = 0; j < 8; ++j) { *(LAS unsigned short*)(a12 + 256 + j * 16 + c * 2) = (unsigned short)f2bf(Tc[j]); *(LAS unsigned short*)(a12 + 256 + (8 + j) * 16 + c * 2) = (unsigned short)f2bf(M2[j]); } }
        LDS_WAIT(); asm volatile("" ::: "memory");
        if (lane < 32) ((v4u*)(img + R4_A1))[lane] = ((const LAS v4u*)a12)[lane];
        LDS_WAIT(); asm volatile("" ::: "memory");
    }
}
constexpr int R4L_NCB = 6, R4L_SLOT = 6144;
__device__ __forceinline__ void phase_rwkv_scan4(PP p, LAS unsigned char* lds, int vcu, int tid, int lane, int wave) {
    const int m = lane & 15, q = lane >> 4;
    const unsigned char* IMG = p->ws + WS_U + U_IMG;
    for (int unit = vcu; unit < 256; unit += gridDim.x) {
        const int chain = unit >> 2, slab = unit & 3, b = chain >> 5, dir = (chain >> 4) & 1, h = chain & 15;
        float* YST = (float*)(p->ws + WS_U + U_YST) + (size_t)unit * NSTEP * 16 + (q >= 2 ? 4 * (q - 2) : 0) * 16 + m;
        const unsigned char* cimg = IMG + (size_t)chain * R4_NCH * R4_IMG;
        f32x4 S[4];
#pragma unroll
        for (int T = 0; T < 4; ++T) S[T] = (f32x4){0.f, 0.f, 0.f, 0.f};
        v2u idf; { const int c0 = 4 * q; idf.x = ((c0 == m) ? 0x3F80u : 0u) | ((c0 + 1 == m) ? 0x3F800000u : 0u); idf.y = ((c0 + 2 == m) ? 0x3F80u : 0u) | ((c0 + 3 == m) ? 0x3F800000u : 0u); }
        auto issue = [&](int bt) {
#pragma unroll
            for (int k = 0; k < 2 * R4L_NCB; ++k) { const int ii = (wave - 1) + 3 * k, cc = ii / 6, part = ii - cc * 6, pi = part * 64 + lane;
                const unsigned char* src = cimg + (size_t)(bt * R4L_NCB + cc) * R4_IMG + (pi < 304 ? pi * 16 : (pi < 336 ? R4_VT + slab * 512 + (pi - 304) * 16 : 0));
                __builtin_amdgcn_global_load_lds((const unsigned*)src, (LAS unsigned*)(lds + ((bt & 1) * R4L_NCB + cc) * R4L_SLOT + part * 1024), 16, 0, 0); } };
        float crg[32]; int cit = (int)(blockIdx.x * 4 + (wave - 4)); ConvJob cj; bool cpend = false;
        LAS float* cscr = (LAS float*)(lds + 2 * R4L_NCB * R4L_SLOT + (wave & 3) * 8448);
        if (wave >= 4 && cit < IT_L1MOE) { cj = conv_job_l1(p, cit); ti_load(cj.src, cj.src_ld, lane, crg); cpend = true; }
        __syncthreads();
        if (wave >= 1 && wave < 4) issue(0);
        __syncthreads();
        constexpr int NB4 = R4_NCH / R4L_NCB;
        for (int bt = 0; bt < NB4; ++bt) {
            if (wave >= 4) { if (cpend) { ti_store(true, crg, cj.dst, cj.dst_ld, cscr, lane); cit += 4 * (int)gridDim.x; cpend = cit < IT_L1MOE; if (cpend) { cj = conv_job_l1(p, cit); ti_load(cj.src, cj.src_ld, lane, crg); } } }
            else if (wave >= 1) { if (bt + 1 < NB4) issue(bt + 1); }
            else {
                __builtin_amdgcn_s_setprio(3);
                struct Ops { bf16x8_t a0, a1; v2u A1u, A2u; bf16x4_t UA[4]; f32x4 g7[4]; f32x4 vr; };
                auto rd = [&](int cc, Ops& o) {
                    const LAS unsigned char* sl = lds + ((bt & 1) * R4L_NCB + cc) * R4L_SLOT;
                    o.a0 = *(const LAS bf16x8_t*)(sl + R4_DOTA + m * 128 + q * 16); o.a1 = *(const LAS bf16x8_t*)(sl + R4_DOTA + m * 128 + (4 + q) * 16);
                    o.A1u = *(const LAS v2u*)(sl + R4_A1 + m * 16 + (q & 1) * 8); o.A2u = *(const LAS v2u*)(sl + R4_A2 + m * 16 + (q & 1) * 8);
#pragma unroll
                    for (int T = 0; T < 4; ++T) { o.UA[T] = *(const LAS bf16x4_t*)(sl + R4_UPA + (16 * T + m) * 32 + q * 8); o.g7[T] = *(const LAS f32x4*)(sl + R4_G7 + (16 * T + 4 * q) * 4); }
                    o.vr = *(const LAS f32x4*)(sl + R4_VT + m * 32 + (q & 1) * 16); };
                Ops cur, nxt; rd(0, cur);
#pragma unroll
                for (int cc = 0; cc < R4L_NCB; ++cc) {
                    if (cc + 1 < R4L_NCB) rd(cc + 1, nxt);
                    __builtin_amdgcn_sched_barrier(0);
                    v2u A1u = cur.A1u, A2u = cur.A2u;
                    if (q >= 2) { A1u = (v2u){0u, 0u}; A2u = idf; }
                    v4u b0, b1;
                    b0.x = cvtpk(S[0][0], S[0][1]); b0.y = cvtpk(S[0][2], S[0][3]); b0.z = cvtpk(S[1][0], S[1][1]); b0.w = cvtpk(S[1][2], S[1][3]);
                    b1.x = cvtpk(S[2][0], S[2][1]); b1.y = cvtpk(S[2][2], S[2][3]); b1.z = cvtpk(S[3][0], S[3][1]); b1.w = cvtpk(S[3][2], S[3][3]);
                    f32x4 Dd = mfma16(cur.a0, __builtin_bit_cast(bf16x8_t, b0), (f32x4){0.f, 0.f, 0.f, 0.f});
                    Dd = mfma16(cur.a1, __builtin_bit_cast(bf16x8_t, b1), Dd);
                    v2u vb; vb.x = cvtpk(cur.vr[0], cur.vr[1]); vb.y = cvtpk(cur.vr[2], cur.vr[3]);
                    const f32x4 Z = __builtin_amdgcn_mfma_f32_16x16x16bf16_1k(__builtin_bit_cast(bf16x4_t, A1u), __builtin_bit_cast(bf16x4_t, vb), Dd, 0, 0, 0);
                    v2u zb; zb.x = cvtpk(Z[0], Z[1]); zb.y = cvtpk(Z[2], Z[3]);
                    const f32x4 W = __builtin_amdgcn_mfma_f32_16x16x16bf16_1k(__builtin_bit_cast(bf16x4_t, A2u), __builtin_bit_cast(bf16x4_t, zb), (f32x4){0.f, 0.f, 0.f, 0.f}, 0, 0, 0);
                    v2u wb; wb.x = cvtpk(W[0], W[1]); wb.y = cvtpk(W[2], W[3]);
                    const v2u ub = (q < 2) ? wb : vb;
#pragma unroll
                    for (int T = 0; T < 4; ++T) S[T] = __builtin_amdgcn_mfma_f32_16x16x16bf16_1k(cur.UA[T], __builtin_bit_cast(bf16x4_t, ub), S[T] * cur.g7[T], 0, 0, 0);
                    if (q >= 2) { float* yp = YST + (size_t)(bt * R4L_NCB + cc) * 128;
#pragma unroll
                        for (int i = 0; i < 4; ++i) yp[i * 16] = W[i]; }
                    if (cc + 1 < R4L_NCB) cur = nxt;
                }
            }
            __syncthreads();
        }
        if (wave >= 4) { while (cpend) { ti_store(true, crg, cj.dst, cj.dst_ld, cscr, lane); cit += 4 * (int)gridDim.x; cpend = cit < IT_L1MOE; if (cpend) { cj = conv_job_l1(p, cit); ti_load(cj.src, cj.src_ld, lane, crg); } } }
    }
}

__device__ __forceinline__ void phase_lora2(PP p, LAS unsigned char* lds, int tid, int lane, int wave) {
    const bf16* L1 = (const bf16*)(p->ws + WS_U + U_L1); const bf16* W2 = (const bf16*)(p->ws + WS_WL2);
    const int c16 = lane & 15, kq = lane >> 4;
    const int part = blockIdx.x % 12, wgp = blockIdx.x / 12, nwg = (gridDim.x - part + 11) / 12;
    const int blk = (part < 8) ? (part >> 1) : 4, col0 = (part < 8) ? (part & 1) * 512 : (part - 8) * 256, ncol = (part < 8) ? 512 : 256;
    const int koff = (blk < 4) ? blk * 64 : 256, nks = (blk < 4) ? 2 : 4, K = nks * 32, WP = K * 2 + 16;
    LAS unsigned char* wl = lds;
    constexpr int PS = 272;
    LAS unsigned char* stg = lds + 73728 + wave * (16 * PS);
    { const int ppr = K / 8;
      for (int u = tid; u < ncol * ppr; u += NTHREADS) { const int c = u / ppr, pc = u - c * ppr;
          *(LAS v4u*)(wl + c * WP + pc * 16) = *(const v4u*)(W2 + (size_t)(blk * 1024 + col0 + c) * 384 + koff + pc * 8); } }
    __syncthreads();
    bf16* dstb = (bf16*)(p->ws + WS_U + ((blk < 2) ? U_WD : (blk < 4) ? U_AD : U_G)) + (size_t)((blk < 4) ? (blk & 1) : 0) * NROW * D + col0;
    const float* bias = ((blk < 2) ? p->in[I_DECW0] + blk * D : p->in[I_A0] + ((blk - 2) & 1) * D) + col0;
    for (int rt = wgp * NWAVES + wave; rt < NROW / 16; rt += nwg * NWAVES) {
        const bf16* lp = L1 + (size_t)(rt * 16 + c16) * 384 + koff + 8 * kq;
        bf16x8_t bfr[4];
#pragma unroll
        for (int s = 0; s < 4; ++s) if (s < nks) bfr[s] = *(const bf16x8_t*)(lp + 32 * s);
        bf16* dst = dstb + (size_t)(rt * 16) * D;
        for (int ps = 0; ps < ncol / 128; ++ps) {
#pragma unroll 4
            for (int ct = 0; ct < 8; ++ct) {
                const int c0 = ps * 128 + ct * 16;
                const LAS unsigned char* wp = wl + (c0 + c16) * WP + 16 * kq;
                f32x4 acc = (f32x4){0.f, 0.f, 0.f, 0.f};
#pragma unroll
                for (int s = 0; s < 4; ++s) if (s < nks) acc = mfma16(*(const LAS bf16x8_t*)(wp + 64 * s), bfr[s], acc);
                const f32x4 bb = *(const f32x4*)(bias + c0 + 4 * kq);
                if (blk < 2) { for (int j = 0; j < 4; ++j) acc[j] = -0.60653066f * sigm(acc[j] + bb[j]); }
                else if (blk < 4) { for (int j = 0; j < 4; ++j) acc[j] = sigm(acc[j] + bb[j]); }
                v2u w; w.x = pk2(acc[0], acc[1]); w.y = pk2(acc[2], acc[3]);
                *(LAS v2u*)(stg + c16 * PS + (ct * 16 + 4 * kq) * 2) = w;
            }
            LDS_WAIT(); asm volatile("" ::: "memory");
#pragma unroll
            for (int i = 0; i < 4; ++i) { const int row = 4 * i + (lane >> 4), cb = lane & 15;
                *(v4u*)(dst + (size_t)row * D + ps * 128 + cb * 8) = *(const LAS v4u*)(stg + row * PS + cb * 16); }
            LDS_WAIT(); asm volatile("" ::: "memory");
        }
    }
    __syncthreads();
}
enum { PH_PRE = 0, PH_NORM0, PH_G_IN, PH_GLA_A, PH_GLA_B, PH_GLA_C, PH_HGRO, PH_G_HGO, PH_FFN0, PH_GATHER0, PH_GU0, PH_DN0, PH_COMB0,
       PH_LERP, PH_G_RKV, PH_G_L2, PH_RWPREP, PH_RWSCAN, PH_RWRO, PH_G_RWO, PH_FFN1, PH_GATHER1, PH_GU1, PH_DN1, PH_COMB1, NPHASES };

template <int ph> __device__ __forceinline__ void run_phase(PP p, LAS unsigned char* lds, int tid, int lane, int wave, int G, int bx, int vcu) {
    unsigned char* ws = p->ws;
    typedef pg8::bf16_t bt;
    switch (ph) {
        case PH_PRE: phase_pre(p, lds, tid, lane, wave); break;
        case PH_NORM0: phase_norm0(p, lane, wave); break;
        case PH_G_IN: {
            pg8::Gemm g{(const bt*)(ws + WS_H), (const bt*)(ws + WS_WIN), NROW, 5120, D}; pg8::StaticOrder S; S.init(NROW, 5120, G, bx);
            pg8::EpiStoreBf16 E{(bt*)(ws + WS_U + U_Z), 5120};
            pg8::gemm_phase<pg8::EpiStoreBf16, pg8::StaticOrder, true, true>(lds, g, S, E); } break;
        case PH_GLA_A: phase_gla_prep(p, lds, tid, lane, wave); break;
        case PH_GLA_B: phase_gla_scan(p, tid); break;
        case PH_GLA_C: phase_gla_out(p, lane, wave); break;
        case PH_HGRO: phase_hg_readout(p, lane, wave); break;
        case PH_G_HGO: {
            pg8::Gemm g{(const bt*)(ws + WS_A2), (const bt*)(ws + WS_WHGO), NROW, D, D}; pg8::StaticOrder S; S.init(NROW, D, G, bx);
            pg8::EpiResid E{p->in[I_X], p->in[I_CTX], (float*)(ws + WS_XR), modp(p, 0, 0, 2), 6144};
            pg8::gemm_phase<pg8::EpiResid, pg8::StaticOrder, true, true>(lds, g, S, E); } break;
        case PH_FFN0: phase_ffn_norm_route(p, 0, NROW, lds, lane, wave); break;
        case PH_FFN1: phase_ffn_norm_route(p, 1, NLAT, lds, lane, wave); break;
        case PH_GATHER0: phase_gather(p, 0, NROW, lds, tid, lane, wave); break;
        case PH_GATHER1: phase_gather(p, 1, NLAT, lds, tid, lane, wave); break;
        case PH_GU0: case PH_GU1: { const int layer = (ph == PH_GU1);
            pg8::Gemm g{(const bt*)(ws + WS_U + U_XB), (const bt*)(ws + WS_WGU) + (size_t)layer * NE * 2048 * D, CAP, 2048, D};
            pg8::MoeOrder S; S.init((const int*)(ws + WS_ROUTE + RT_TILEE), 8, (size_t)2048 * D * 2, G, vcu);
            pg8::EpiSwiglu E{(bt*)(ws + WS_U + U_ACT), p->in[I_BGU] + (size_t)layer * NE * 2048};
            pg8::gemm_phase<pg8::EpiSwiglu, pg8::MoeOrder, true, true>(lds, g, S, E); } break;
        case PH_DN0: case PH_DN1: { const int layer = (ph == PH_DN1);
            pg8::Gemm g{(const bt*)(ws + WS_U + U_ACT), (const bt*)(ws + WS_WD) + (size_t)layer * NE * D * D, CAP, D, D};
            pg8::MoeOrder S; S.init((const int*)(ws + WS_ROUTE + RT_TILEE), 4, (size_t)D * D * 2, G, vcu);
            pg8::EpiDown E{(bt*)(ws + WS_U + U_YS), p->in[I_BDN] + (size_t)layer * NE * D};
            pg8::gemm_phase<pg8::EpiDown, pg8::MoeOrder, true, true>(lds, g, S, E); } break;
        case PH_COMB0: phase_combine(p, 0, NROW, false, lane, wave); break;
        case PH_COMB1: phase_combine(p, 1, NLAT, true, lane, wave); break;
        case PH_LERP: phase_lerp(p, lane, wave); break;
        case PH_G_RKV: {
            { pg8::Gemm g{(const bt*)(ws + WS_U + U_XL6), (const bt*)(ws + WS_WRKV), NROW, 3072, D};
              pg8::SelOrder S; S.init(NROW, 3072, G, bx); S.div = 4; S.sel0 = 0; S.stride = (size_t)NROW * D * 2;
              pg8::EpiStoreBf16 E{(bt*)(ws + WS_U + U_RKV), 3072};
              pg8::gemm_phase<pg8::EpiStoreBf16, pg8::SelOrder, true, true>(lds, g, S, E); }
            { pg8::Gemm g{(const bt*)(ws + WS_U + U_XL6), (const bt*)(ws + WS_WL1), NROW, 768, D};
              pg8::SelOrder S; S.init(NROW, 768, G, bx); S.div = 1; S.sel0 = 3; S.stride = (size_t)NROW * D * 2;
              pg8::EpiLora1 E{(bt*)(ws + WS_U + U_L1)};
              pg8::gemm_phase<pg8::EpiLora1, pg8::SelOrder, true, true>(lds, g, S, E); } } break;
        case PH_G_L2: phase_lora2(p, lds, tid, lane, wave); break;
        case PH_RWPREP: phase_rw_prep(p, lds, lane, wave); break;
        case PH_RWSCAN: phase_rwkv_scan4(p, lds, vcu, tid, lane, wave); break;
        case PH_RWRO: phase_rw_readout(p, lane, wave); break;
        case PH_G_RWO: {
            pg8::Gemm g{(const bt*)(ws + WS_A2), (const bt*)(ws + WS_WRWO), NLAT, D, D}; pg8::StaticOrder S; S.init(NLAT, D, G, bx);
            float* XR = (float*)(ws + WS_XR);
            pg8::EpiResid E{XR, XR + (size_t)NLAT * D, XR, modp(p, 1, 0, 2), 6144};
            pg8::gemm_phase<pg8::EpiResid, pg8::StaticOrder, true, true>(lds, g, S, E); } break;
        default: break;
    }
}

#define MK_PROLOGUE \
    extern __shared__ __attribute__((aligned(16))) unsigned char lds_raw[]; \
    LAS unsigned char* lds = (LAS unsigned char*)lds_raw; \
    const int tid = threadIdx.x, lane = tid & 63, wave = __builtin_amdgcn_readfirstlane(tid >> 6); \
    const int G = gridDim.x, bx = blockIdx.x, vcu = (G % 8 == 0) ? (bx % 8) * (G / 8) + bx / 8 : bx;

#define XB_TMO      128
#define XB_XCNT(j)  (256  + 64 * (j))
#define XB_XSUB(j)  (1280 + 64 * (j))
#define XB_XGEN(j)  (2304 + 64 * (j))
#define XB_TOP      3328
#define XB_TOPGEN   3392
#define XCD_BAR_WORDS 3456
#define XB_SPIN_CAP (1u << 18)

__device__ __forceinline__ unsigned xb_ld(unsigned* p)              { return __hip_atomic_load(p, __ATOMIC_RELAXED, __HIP_MEMORY_SCOPE_AGENT); }
__device__ __forceinline__ unsigned xb_add(unsigned* p, unsigned v) { return __hip_atomic_fetch_add(p, v, __ATOMIC_RELAXED, __HIP_MEMORY_SCOPE_AGENT); }
__device__ __forceinline__ unsigned xb_xcc_id() { return (unsigned)__builtin_amdgcn_s_getreg((3 << 11) | 20) & 0xFu; }
#define XB_SPIN(cond, bar) do { unsigned _sp = 0; while (cond) { __builtin_amdgcn_s_sleep(1); \
    if ((++_sp & 255u) == 0u) { if (xb_ld(&(bar)[XB_TMO])) break; if (_sp > XB_SPIN_CAP) { atomicAdd(&(bar)[XB_TMO], 1u); break; } } } } while (0)

struct XcdBarrier {
    unsigned* bar; unsigned x;
    volatile LAS unsigned* st;
};

__device__ __forceinline__ XcdBarrier xcd_barrier_post(unsigned* bar, volatile LAS unsigned* st) {
    XcdBarrier b; b.bar = bar; b.x = xb_xcc_id(); b.st = st;
    if (threadIdx.x == 0) (void)xb_add(&bar[XB_XCNT(b.x)], 1u);
    return b;
}
__device__ __forceinline__ void xcd_barrier_complete(unsigned* bar, unsigned x, unsigned& nloc, unsigned& nx) {
    const unsigned G = gridDim.x * gridDim.y * gridDim.z;
    unsigned sum, cnt, mine, sp = 0u;
    for (;;) {
        sum = 0u; cnt = 0u; mine = 0u;
#pragma unroll
        for (unsigned j = 0; j < 16; ++j) { const unsigned c = xb_ld(&bar[XB_XCNT(j)]); sum += c; cnt += (c > 0u) ? 1u : 0u; mine = (j == x) ? c : mine; }
        if (sum == G) break;
        __builtin_amdgcn_s_sleep(1);
        if ((++sp & 255u) == 0u) { if (xb_ld(&bar[XB_TMO])) break; if (sp > XB_SPIN_CAP) { atomicAdd(&bar[XB_TMO], 1u); break; } }
    }
    nloc = mine > 0u ? mine : 1u; nx = cnt > 0u ? cnt : 1u;
}

__device__ __forceinline__ void xcd_barrier(const XcdBarrier& b) {
    asm volatile("s_waitcnt vmcnt(0)" ::: "memory");
    __syncthreads();
    if (threadIdx.x == 0) {
        unsigned* bar = b.bar;
        __builtin_amdgcn_s_waitcnt(0);
        unsigned nloc = b.st[0], nx = b.st[1];
        if (nloc == 0u) { xcd_barrier_complete(bar, b.x, nloc, nx); b.st[0] = nloc; b.st[1] = nx; }
        const unsigned old = xb_add(&bar[XB_XSUB(b.x)], 1u);
        const unsigned gen = old / nloc;
        if (old + 1u == (gen + 1u) * nloc) {
            __builtin_amdgcn_fence(__ATOMIC_RELEASE, "agent");
            asm volatile("s_waitcnt vmcnt(0)" ::: "memory");
            const unsigned og = xb_add(&bar[XB_TOP], 1u);
            const unsigned tg = og / nx;
            if (og + 1u == (tg + 1u) * nx) xb_add(&bar[XB_TOPGEN], 1u);
            else XB_SPIN(xb_ld(&bar[XB_TOPGEN]) == tg, bar);
            __builtin_amdgcn_fence(__ATOMIC_ACQUIRE, "agent");
            xb_add(&bar[XB_XGEN(b.x)], 1u);
            asm volatile("s_waitcnt vmcnt(0)" ::: "memory");
        } else {
            XB_SPIN(xb_ld(&bar[XB_XGEN(b.x)]) == gen, bar);
            __builtin_amdgcn_fence(__ATOMIC_ACQUIRE, "agent");
            asm volatile("s_waitcnt vmcnt(0)" ::: "memory");
        }
    }
    __syncthreads();
}

constexpr int LDSCTL_OFF = 131072, MISC_OFF = LDSCTL_OFF + 320;
__device__ __forceinline__ void grid_bar(PP kp, LAS unsigned char* lds) {
    PP q = kp; asm volatile("" : "+s"(q));
    XcdBarrier b; b.bar = (unsigned*)(q->ws + WS_CTL) + CW_BAR; b.x = xb_xcc_id(); b.st = (volatile LAS unsigned*)(lds + MISC_OFF) + 8;
    xcd_barrier(b);
}
namespace cg = cooperative_groups;
__global__ void __launch_bounds__(NTHREADS, 2) mk_fwd(Params pv) {
    MK_PROLOGUE
    cg::grid_group grid = cg::this_grid();
    PP kp = (PP)__builtin_amdgcn_kernarg_segment_ptr();
    const int lo = kp->ph_lo, hi = kp->ph_hi;
    for (int u = tid; u < (LDS_BYTES - LDSCTL_OFF) / 4; u += NTHREADS) ((LAS unsigned*)(lds + LDSCTL_OFF))[u] = 0u;
    __syncthreads();
    { XcdBarrier b0 = xcd_barrier_post((unsigned*)(kp->ws + WS_CTL) + CW_BAR, (volatile LAS unsigned*)(lds + MISC_OFF) + 8); (void)b0; }
#ifndef REPEAT_MASK
#define REPEAT_MASK 0u
#endif
#define RUN(k) if (lo <= (k) && (k) < hi) { PP q = kp; asm volatile("" : "+s"(q)); run_phase<k>(q, lds, tid, lane, wave, G, bx, vcu); \
        if ((REPEAT_MASK >> (k)) & 1u) { grid_bar(kp, lds); PP q2 = kp; asm volatile("" : "+s"(q2)); run_phase<k>(q2, lds, tid, lane, wave, G, bx, vcu); } \
        if ((k) + 1 < hi) { if ((k) == 0) grid.sync(); else grid_bar(kp, lds); } }
    RUN(0) RUN(1) RUN(2) RUN(3) RUN(4) RUN(5) RUN(6) RUN(7) RUN(8) RUN(9) RUN(10) RUN(11) RUN(12) RUN(13) RUN(14) RUN(15) RUN(16) RUN(17) RUN(18) RUN(19) RUN(20) RUN(21) RUN(22) RUN(23) RUN(24)
#undef RUN
}

extern "C" void kernel_launch(void* const* d_in, const int* in_sizes, int n_in, void* d_out, int out_size, void* d_ws, size_t ws_size, hipStream_t stream) {
    static int grid = 0;
    if (grid == 0) {
        if (n_in != 35 || in_sizes[0] != NLAT * D || out_size != NLAT * D || ws_size < WS_END) {
            fprintf(stderr, "kernel_launch: unexpected problem (n_in %d, in0 %d, out %d, ws %zu < %zu)\n", n_in, n_in > 0 ? in_sizes[0] : -1, out_size, ws_size, (size_t)WS_END); grid = -1; return; }
        int dev = 0, cus = 0, per_cu = 0;
        if (hipGetDevice(&dev) != hipSuccess || hipDeviceGetAttribute(&cus, hipDeviceAttributeMultiprocessorCount, dev) != hipSuccess) { grid = -1; return; }
        if (hipFuncSetAttribute((const void*)mk_fwd, hipFuncAttributeMaxDynamicSharedMemorySize, LDS_BYTES) != hipSuccess) { fprintf(stderr, "kernel_launch: hipFuncSetAttribute failed\n"); grid = -1; return; }
        if (hipOccupancyMaxActiveBlocksPerMultiprocessor(&per_cu, (const void*)mk_fwd, NTHREADS, LDS_BYTES) != hipSuccess || per_cu < 1) { fprintf(stderr, "kernel_launch: occupancy query %d\n", per_cu); per_cu = 1; }
        (void)hipGetLastError();
        grid = cus * (per_cu < 1 ? 1 : per_cu);
    }
    if (grid < 0) return;
    (void)hipMemsetAsync((char*)d_ws + WS_CTL, 0, CTL_ZERO_BYTES, stream);
    Params p{};
    for (int i = 0; i < 35; ++i) p.in[i] = (const float*)d_in[i];
    p.out = (float*)d_out; p.ws = (unsigned char*)d_ws;
    p.ph_lo = 0; p.ph_hi = NPHASES;
    void* args[] = {&p};
    hipError_t e = hipLaunchCooperativeKernel((const void*)mk_fwd, dim3(grid), dim3(NTHREADS), args, LDS_BYTES, stream);
    if (e != hipSuccess) fprintf(stderr, "kernel_launch: cooperative launch failed: %s (grid %d)\n", hipGetErrorString(e), grid);
}
```

```cpp
#include <hip/hip_runtime.h>
#include <hip/hip_cooperative_groups.h>
#include <cstdio>
#include <cstdint>
namespace pg8 {
#define PG8_LAS __attribute__((address_space(3)))
typedef unsigned short bf16_t;
typedef short bf16x8 __attribute__((ext_vector_type(8)));
typedef float f32x4 __attribute__((ext_vector_type(4)));
typedef unsigned u32x4 __attribute__((ext_vector_type(4)));
constexpr int BM = 256, BK = 64, HALF = 128, HTB = HALF * BK * 2  , STAGE_BYTES = 8 * HTB, NXCD = 8, WGM = 8;

__host__ __device__ __forceinline__ int lds_byte(int r, int c) { const int st = (r >> 4) * 2 + (c >> 5), rr = r & 15, cc = c & 31, ob = rr * 64 + cc * 2; return st * 1024 + (ob ^ (((ob >> 9) & 1) << 5)); }
__host__ __device__ __forceinline__ void stage_rc(int b, int& R, int& C) { const int st = b / 1024, sb = b % 1024, swz = sb ^ (((sb >> 9) & 1) << 5); R = (st >> 1) * 16 + swz / 64; C = (st & 1) * 32 + (swz % 64) / 2; }
__host__ __device__ __forceinline__ int perm32(int rho) { const int n = rho >> 4, i = rho & 15; return 8 * (i >> 2) + 4 * n + (i & 3); }

struct Unit { int pm, pn, e; };
struct Gemm { const bf16_t* A; const bf16_t* Bt; int M, N, K; };

struct StaticOrder {
    int nM, nN, nwg, G, c;
    __host__ __device__ void init(int M, int N, int G_, int c_) { nM = M / BM; nN = N / BM; nwg = nM * nN; G = G_; c = c_; }
    __host__ __device__ bool next(int i, Unit& u) const {
        const long L = (long)i * G + c; if (L >= nwg) return false;
        int wgid = (int)L; { const int q = nwg / NXCD, r = nwg % NXCD, xcd = wgid % NXCD, off = wgid / NXCD; wgid = (xcd < r ? xcd * (q + 1) : r * (q + 1) + (xcd - r) * q) + off; }
        const int nig = WGM * nN, gid = wgid / nig, fm = gid * WGM, gsz = (nM - fm) < WGM ? (nM - fm) : WGM;
        u.pm = fm + ((wgid % nig) % gsz); u.pn = (wgid % nig) / gsz; u.e = 0; return true;
    }
    __device__ __forceinline__ const char* abase(const Gemm& g, const Unit& u, size_t tstep) const { return (const char*)g.A + (size_t)u.pm * tstep; }
    __device__ __forceinline__ const char* bbase(const Gemm& g, const Unit& u, size_t tstep) const { return (const char*)g.Bt + (size_t)u.pn * tstep; }
    __device__ __forceinline__ void a_ready(const Unit&) const {}
    __device__ __forceinline__ void done(const Unit&) const {}
};

__device__ __forceinline__ unsigned cvt_pk_bf16(float lo, float hi) { unsigned r; asm volatile("v_cvt_pk_bf16_f32 %0, %1, %2" : "=v"(r) : "v"(lo), "v"(hi)); return r; }

template <class Epi, class Sched, bool ALIGN_EPI = false, bool SP2 = false>
__device__ __forceinline__ void gemm_phase(PG8_LAS unsigned char* lds, const Gemm g, const Sched& S, const Epi& E) {
    const int tid = threadIdx.x, wid = __builtin_amdgcn_readfirstlane(tid >> 6), lane = tid & 63, wr = wid >> 2, wc = wid & 3, fr = lane & 15, fq = lane >> 4;
    const int K = g.K, nt = K / BK;
    unsigned voffA[2], voffB[2];
#pragma unroll
    for (int i = 0; i < 2; ++i) { int R, C; stage_rc(tid * 16 + i * 8192, R, C); const int Rb = Epi::PERM ? ((R & ~31) + perm32(R & 31)) : R;
        voffA[i] = (unsigned)(R * K + C) * 2u; voffB[i] = (unsigned)(Rb * K + C) * 2u; }
    const size_t kstep = (size_t)(BK * 2);
    const size_t hstep = (size_t)HALF * K * 2;
    const size_t tstep = 2 * hstep;
    const unsigned ldsw = (unsigned)wid * 1024u;
    const int aoff = lds_byte(wr * 64 + fr, fq * 8), boff = lds_byte(wc * 32 + fr, fq * 8);
#define PG8_SA(b, h) (((b) * 2 + (h)) * HTB)
#define PG8_SB(b, h) ((4 + (b) * 2 + (h)) * HTB)
#define PG8_STAGE(bufoff, gbase, voff) do { _Pragma("unroll") for (int _i = 0; _i < 2; ++_i) \
        __builtin_amdgcn_global_load_lds((const unsigned*)((const char*)(gbase) + (voff)[_i]), (PG8_LAS unsigned*)(lds + (bufoff) + ldsw + _i * 8192), 16, 0, 0); } while (0)
#define PG8_LDA(dst, b, h) do { _Pragma("unroll") for (int m = 0; m < 4; ++m) _Pragma("unroll") for (int k = 0; k < 2; ++k) dst[m][k] = *(const PG8_LAS bf16x8*)(lds + PG8_SA(b, h) + aoff + m * 2048 + k * 1024); } while (0)
#define PG8_LDB(dst, b, h) do { _Pragma("unroll") for (int n = 0; n < 2; ++n) _Pragma("unroll") for (int k = 0; k < 2; ++k) dst[n][k] = *(const PG8_LAS bf16x8*)(lds + PG8_SB(b, h) + boff + n * 2048 + k * 1024); } while (0)
#define PG8_MMA(ai, bj, At, Bt) do { __builtin_amdgcn_s_setprio(1); _Pragma("unroll") for (int m = 0; m < 4; ++m) _Pragma("unroll") for (int n = 0; n < 2; ++n) _Pragma("unroll") for (int k = 0; k < 2; ++k) \
        acc[ai][bj][m][n] = __builtin_amdgcn_mfma_f32_16x16x32_bf16(Bt[n][k], At[m][k], acc[ai][bj][m][n], 0, 0, 0); __builtin_amdgcn_s_setprio(0); } while (0)
#define PG8_WAIT_V(n) asm volatile("s_waitcnt vmcnt(" #n ")" ::: "memory")
#define PG8_WAIT_L(n) asm volatile("s_waitcnt lgkmcnt(" #n ")" ::: "memory")
#define PG8_BAR __builtin_amdgcn_s_barrier()
#define PG8_SCHED __builtin_amdgcn_sched_barrier(0)
    Unit cur, nxt; int ui = 0;
    if (!S.next(0, cur)) return;
    f32x4 acc[2][2][4][2];
#pragma unroll
    for (int a = 0; a < 2; ++a)
#pragma unroll
        for (int b = 0; b < 2; ++b)
#pragma unroll
            for (int m = 0; m < 4; ++m)
#pragma unroll
                for (int n = 0; n < 2; ++n) acc[a][b][m][n] = (f32x4){0.f, 0.f, 0.f, 0.f};
    bf16x8 At[4][2], B0[2][2], B1[2][2];
    const char* cA = S.abase(g, cur, tstep); const char* cB = S.bbase(g, cur, tstep);
    S.a_ready(cur);
    if constexpr (SP2) {
        PG8_STAGE(PG8_SB(0, 0), cB, voffB); PG8_STAGE(PG8_SB(0, 1), cB + hstep, voffB); PG8_STAGE(PG8_SA(0, 0), cA, voffA); PG8_STAGE(PG8_SA(0, 1), cA + hstep, voffA);
        if (wr == 1) PG8_BAR;
        PG8_WAIT_V(2); PG8_BAR;
        PG8_STAGE(PG8_SB(1, 0), cB + kstep, voffB); PG8_STAGE(PG8_SA(1, 0), cA + kstep, voffA); PG8_STAGE(PG8_SB(1, 1), cB + hstep + kstep, voffB);
        PG8_WAIT_V(6); PG8_BAR;
    } else {
        PG8_STAGE(PG8_SB(0, 0), cB, voffB); PG8_STAGE(PG8_SA(0, 0), cA, voffA); PG8_STAGE(PG8_SB(0, 1), cB + hstep, voffB); PG8_STAGE(PG8_SA(0, 1), cA + hstep, voffA);
        if (wr == 1) PG8_BAR;
        PG8_WAIT_V(4); PG8_BAR;
        PG8_STAGE(PG8_SB(1, 0), cB + kstep, voffB); PG8_STAGE(PG8_SA(1, 0), cA + kstep, voffA); PG8_STAGE(PG8_SB(1, 1), cB + hstep + kstep, voffB);
        PG8_WAIT_V(6); PG8_BAR;
    }
    for (;;) {
        const bool has_next = S.next(ui + 1, nxt);
        const char* nA = has_next ? S.abase(g, nxt, tstep) : cA; const char* nB = has_next ? S.bbase(g, nxt, tstep) : cB;
        _Pragma("unroll 1") for (int t = 0; t < nt; t += 2) {
            const bool last = (t == nt - 2);
            const char* a1 = cA + (size_t)(t + 1) * kstep;
            const char* a2 = last ? nA : cA + (size_t)(t + 2) * kstep; const char* b2 = last ? nB : cB + (size_t)(t + 2) * kstep;
            const char* a3 = a2 + kstep; const char* b3 = b2 + kstep;
            if (last && has_next) S.a_ready(nxt);
            if constexpr (SP2) {
            PG8_LDB(B0, 0, 0); PG8_LDB(B1, 0, 1); PG8_SCHED; PG8_LDA(At, 0, 0); PG8_STAGE(PG8_SA(1, 1), a1 + hstep, voffA);
            PG8_WAIT_V(8); PG8_WAIT_L(0); PG8_BAR; PG8_MMA(0, 0, At, B0); PG8_MMA(0, 1, At, B1); PG8_BAR; PG8_SCHED;
            PG8_LDA(At, 0, 1); PG8_STAGE(PG8_SB(0, 0), b2, voffB); PG8_STAGE(PG8_SB(0, 1), b2 + hstep, voffB); PG8_STAGE(PG8_SA(0, 0), a2, voffA);
            PG8_WAIT_V(8); PG8_WAIT_L(0); PG8_BAR; PG8_MMA(1, 0, At, B0); PG8_MMA(1, 1, At, B1); PG8_BAR; PG8_SCHED;
            PG8_LDB(B0, 1, 0); PG8_LDB(B1, 1, 1); PG8_SCHED; PG8_LDA(At, 1, 0); PG8_STAGE(PG8_SA(0, 1), a2 + hstep, voffA);
            PG8_WAIT_V(8); PG8_WAIT_L(0); PG8_BAR; PG8_MMA(0, 0, At, B0); PG8_MMA(0, 1, At, B1); PG8_BAR; PG8_SCHED;
            PG8_LDA(At, 1, 1); PG8_STAGE(PG8_SB(1, 0), b3, voffB); PG8_STAGE(PG8_SB(1, 1), b3 + hstep, voffB); PG8_STAGE(PG8_SA(1, 0), a3, voffA);
            PG8_WAIT_V(8); PG8_WAIT_L(0); PG8_BAR; PG8_MMA(1, 0, At, B0); PG8_MMA(1, 1, At, B1); PG8_BAR; PG8_SCHED;
            } else {
            PG8_LDB(B0, 0, 0); PG8_SCHED; PG8_LDA(At, 0, 0); PG8_STAGE(PG8_SA(1, 1), a1 + hstep, voffA);
            PG8_WAIT_L(8); PG8_BAR; PG8_WAIT_L(0); PG8_MMA(0, 0, At, B0); PG8_BAR; PG8_SCHED;
            PG8_LDB(B1, 0, 1); PG8_STAGE(PG8_SB(0, 0), b2, voffB);
            PG8_BAR; PG8_WAIT_L(0); PG8_MMA(0, 1, At, B1); PG8_BAR;
            PG8_LDA(At, 0, 1); PG8_STAGE(PG8_SA(0, 0), a2, voffA);
            PG8_BAR; PG8_WAIT_L(0); PG8_MMA(1, 0, At, B0); PG8_BAR; PG8_SCHED;
            PG8_STAGE(PG8_SB(0, 1), b2 + hstep, voffB);
            PG8_WAIT_V(6); PG8_BAR; PG8_MMA(1, 1, At, B1); PG8_BAR;
            PG8_LDB(B0, 1, 0); PG8_SCHED; PG8_LDA(At, 1, 0); PG8_STAGE(PG8_SA(0, 1), a2 + hstep, voffA);
            PG8_WAIT_L(8); PG8_BAR; PG8_WAIT_L(0); PG8_MMA(0, 0, At, B0); PG8_BAR; PG8_SCHED;
            PG8_LDB(B1, 1, 1); PG8_STAGE(PG8_SB(1, 0), b3, voffB);
            PG8_BAR; PG8_WAIT_L(0); PG8_MMA(0, 1, At, B1); PG8_BAR;
            PG8_LDA(At, 1, 1); PG8_STAGE(PG8_SA(1, 0), a3, voffA);
            PG8_BAR; PG8_WAIT_L(0); PG8_MMA(1, 0, At, B0); PG8_BAR; PG8_SCHED;
            PG8_STAGE(PG8_SB(1, 1), b3 + hstep, voffB);
            PG8_WAIT_V(6); PG8_BAR; PG8_MMA(1, 1, At, B1); PG8_BAR;
            }
        }
        if constexpr (ALIGN_EPI) { if (wr == 0) PG8_BAR; }
        if constexpr (!Epi::AFTER_DRAIN) { E(acc, cur, wr, wc, fr, fq); S.done(cur); }
        if (!has_next) break;
#pragma unroll
        for (int a = 0; a < 2; ++a)
#pragma unroll
            for (int b = 0; b < 2; ++b)
#pragma unroll
                for (int m = 0; m < 4; ++m)
#pragma unroll
                    for (int n = 0; n < 2; ++n) acc[a][b][m][n] = (f32x4){0.f, 0.f, 0.f, 0.f};
        cur = nxt; cA = nA; cB = nB; ++ui;
        if constexpr (ALIGN_EPI) { if (wr == 1) PG8_BAR; }
    }
    PG8_WAIT_V(0);
    if constexpr (!ALIGN_EPI) { if (wr == 0) PG8_BAR; }
    PG8_BAR;
    if constexpr (Epi::AFTER_DRAIN) { E.fused(acc, cur, wr, wc, fr, fq, lds, wid, lane); S.done(cur); }
#undef PG8_SA
#undef PG8_SB
#undef PG8_STAGE
#undef PG8_LDA
#undef PG8_LDB
#undef PG8_MMA
#undef PG8_WAIT_V
#undef PG8_WAIT_L
#undef PG8_BAR
#undef PG8_SCHED
}
}

constexpr int D = 1024, NBATCH = 2, SEQ = 8192, CTXL = 256;
constexpr int NLAT = NBATCH * SEQ, NCTX = NBATCH * CTXL, NROW = NLAT + NCTX;
constexpr int NE = 32, TOPK = 4, MAXTILES = 296, CAP = MAXTILES * 256;
constexpr int NWAVES = 8, NTHREADS = 512;
constexpr float NORM_EPS = 1e-6f;
constexpr int LDS_BYTES = 147456;

constexpr size_t MiB = 1u << 20;
constexpr size_t WS_CTL = 0, CTL_ZERO_BYTES = 1 * MiB;
constexpr size_t WS_MOD = 1 * MiB;
constexpr size_t WS_ROUTE = 2 * MiB;
constexpr size_t RT_TOPI = 0, RT_TOPG = 320 * 1024, RT_POS = 640 * 1024, RT_SLOT = 960 * 1024, RT_RSTD = 1280 * 1024, RT_TILEE = 1408 * 1024;
constexpr size_t WS_WIN = 4 * MiB, WS_WHGO = 14 * MiB, WS_WRKV = 16 * MiB, WS_WL1 = 22 * MiB, WS_WL2 = 24 * MiB, WS_WRWO = 28 * MiB;
constexpr size_t WS_WGU = 32 * MiB, WS_WD = 288 * MiB;
constexpr size_t WS_XR = 416 * MiB, WS_H = 482 * MiB, WS_H2 = 515 * MiB, WS_A2 = 548 * MiB;
constexpr size_t WS_U = 584 * MiB;
constexpr size_t U_Z = 0, U_OD0 = 166 * MiB;
constexpr size_t U_XL6 = 0, U_RKV = 198 * MiB, U_L1 = 396 * MiB, U_WD = 410 * MiB, U_AD = 542 * MiB, U_G = 674 * MiB, U_OD1 = 740 * MiB;
constexpr size_t U_XB = 0, U_ACT = 148 * MiB, U_YS = 296 * MiB;
constexpr size_t WS_END = WS_U + 1320 * MiB;
constexpr int CW_CNT = 16384, CNT_STRIDE = 64;
constexpr int CW_NT = 128;
constexpr int CW_TOF = 8192, TOF_PER = 72;
constexpr int CW_BAR = 4096;

#define LAS __attribute__((address_space(3)))
typedef unsigned short bf16;
typedef unsigned v4u __attribute__((ext_vector_type(4)));
typedef unsigned v2u __attribute__((ext_vector_type(2)));
typedef float f32x4 __attribute__((ext_vector_type(4)));
#define LDS_WAIT() asm volatile("s_waitcnt lgkmcnt(0)" ::: "memory")
typedef float f32x2c __attribute__((ext_vector_type(2))); typedef __bf16 bf16x2c __attribute__((ext_vector_type(2)));
__device__ __forceinline__ unsigned pk2(float lo, float hi) { const f32x2c v = {lo, hi}; const bf16x2c b = __builtin_convertvector(v, bf16x2c); return __builtin_bit_cast(unsigned, b); }
__device__ __forceinline__ unsigned f2bf(float f) { return pk2(f, 0.f) & 0xffffu; }
__device__ __forceinline__ float bf2f(unsigned b) { return __builtin_bit_cast(float, b << 16); }
__device__ __forceinline__ float wave_sum(float x) {
    x += __builtin_bit_cast(float, __builtin_amdgcn_update_dpp(0, __builtin_bit_cast(int, x), 0x128, 0xf, 0xf, false));
    x += __builtin_bit_cast(float, __builtin_amdgcn_update_dpp(0, __builtin_bit_cast(int, x), 0x124, 0xf, 0xf, false));
    x += __builtin_bit_cast(float, __builtin_amdgcn_update_dpp(0, __builtin_bit_cast(int, x), 0x122, 0xf, 0xf, false));
    x += __builtin_bit_cast(float, __builtin_amdgcn_update_dpp(0, __builtin_bit_cast(int, x), 0x121, 0xf, 0xf, false));
    x += __shfl_xor(x, 16); x += __shfl_xor(x, 32);
    return x;
}
__device__ __forceinline__ float sigm(float x) { return __builtin_amdgcn_rcpf(1.0f + __expf(-x)); }

struct Params { const float* in[35]; float* out; unsigned char* ws; int ph_lo, ph_hi; };
typedef const __attribute__((address_space(4))) Params* PP;
enum { I_X = 0, I_C, I_CTX, I_CCTX, I_ADAW, I_ADAB, I_NMIX, I_NFFN, I_HGWIN, I_HGGN, I_HGWOUT, I_HGLB, I_MU, I_WRKV, I_DECW0, I_DECW1, I_DECW2,
       I_A0, I_A1, I_A2, I_G1, I_G2, I_KK, I_KA, I_RK, I_LNXW, I_LNXB, I_RWOUT, I_ROUTW, I_ROUTB, I_WGU, I_BGU, I_WDN, I_BDN, I_FINALG };

__device__ __forceinline__ const float* modp(PP p, int l, int v, int j) { return (const float*)(p->ws + WS_MOD) + ((size_t)(l * 3 + v) * 6 + j) * D; }
__device__ __forceinline__ int row_vec(int row) { return row < NLAT ? (row >= SEQ ? 1 : 0) : 2; }

__device__ __forceinline__ void ti_load(const float* src, int src_ld, int lane, float (&rg)[32]) {
    if (src) {
#pragma unroll
        for (int i = 0; i < 32; ++i) rg[i] = src[(size_t)(2 * i + (lane >> 5)) * src_ld + (lane & 31)];
    }
}
__device__ __forceinline__ void ti_store(bool nonzero, const float (&rg)[32], bf16* dst, int dst_ld, LAS float* scr, int lane) {
    if (nonzero) {
#pragma unroll
        for (int i = 0; i < 32; ++i) scr[(2 * i + (lane >> 5)) * 33 + (lane & 31)] = rg[i];
    }
    LDS_WAIT(); asm volatile("" ::: "memory");
    const int c = lane & 7;
#pragma unroll
    for (int j = 0; j < 4; ++j) {
        const int n = (lane >> 3) + 8 * j; v4u o = (v4u){0u, 0u, 0u, 0u};
        if (nonzero) { const LAS float* s = scr + (8 * c) * 33 + n;
            o.x = pk2(s[0 * 33], s[1 * 33]); o.y = pk2(s[2 * 33], s[3 * 33]); o.z = pk2(s[4 * 33], s[5 * 33]); o.w = pk2(s[6 * 33], s[7 * 33]); }
        *(v4u*)(dst + (size_t)n * dst_ld + 8 * c) = o;
    }
    LDS_WAIT(); asm volatile("" ::: "memory");
}
__device__ __forceinline__ void transpose_item(const float* src, int src_ld, bf16* dst, int dst_ld, LAS float* scr, int lane) {
    float rg[32]; ti_load(src, src_ld, lane, rg); ti_store(src != nullptr, rg, dst, dst_ld, scr, lane);
}
struct ConvJob { const float* src; int src_ld; bf16* dst; int dst_ld; };
__device__ __forceinline__ ConvJob job_plain(const float* W, int K, int N, bf16* WT, int r) {
    const int nblk = N / 32, kb = r / nblk, nb = r % nblk;
    return ConvJob{W + (size_t)(kb * 64) * N + nb * 32, N, WT + (size_t)(nb * 32) * K + kb * 64, K};
}
constexpr int IT_WIN = 16 * 160, IT_SQ = 16 * 32, IT_L1 = 16 * 24, IT_L2 = 160 * 6, IT_GU = 64 * 16 * 64, IT_DN = 64 * 16 * 32;
constexpr int IT_GU0 = IT_GU / 2, IT_DN0 = IT_DN / 2;
constexpr int IT_TOTAL = IT_WIN + IT_SQ + 3 * IT_SQ + IT_SQ + IT_L1 + IT_L2 + IT_GU0 + IT_DN0, IT_L1MOE = IT_GU0 + IT_DN0;
__device__ __forceinline__ ConvJob conv_job(PP p, int it) {
    unsigned char* ws = p->ws; int r = it;
    if (r < IT_WIN) return job_plain(p->in[I_HGWIN], D, 5120, (bf16*)(ws + WS_WIN), r); r -= IT_WIN;
    if (r < IT_SQ) return job_plain(p->in[I_HGWOUT], D, D, (bf16*)(ws + WS_WHGO), r); r -= IT_SQ;
    if (r < 3 * IT_SQ) { const int j = r / IT_SQ; return job_plain(p->in[I_WRKV] + (size_t)j * D * D, D, D, (bf16*)(ws + WS_WRKV) + (size_t)j * D * D, r % IT_SQ); } r -= 3 * IT_SQ;
    if (r < IT_SQ) return job_plain(p->in[I_RWOUT], D, D, (bf16*)(ws + WS_WRWO), r); r -= IT_SQ;
    if (r < IT_L1) {
        const int kb = r / 24, rg = r % 24, tile = rg >> 3, within = rg & 7; const float* src = nullptr; int ld = 64;
        if (within < 4) {
            if (tile == 0) src = p->in[I_DECW1] + (size_t)(within >> 1) * D * 64 + (size_t)(kb * 64) * 64 + (within & 1) * 32;
            else if (tile == 1) src = p->in[I_A1] + (size_t)(within >> 1) * D * 64 + (size_t)(kb * 64) * 64 + (within & 1) * 32;
            else { src = p->in[I_G1] + (size_t)(kb * 64) * 128 + within * 32; ld = 128; }
        }
        return ConvJob{src, ld, (bf16*)(ws + WS_WL1) + (size_t)(rg * 32) * D + kb * 64, D}; } r -= IT_L1;
    if (r < IT_L2) {
        const int rg = r / 6, kb = r % 6, n0 = rg * 32, blk = n0 >> 10, nn0 = n0 & 1023; const float* src = nullptr;
        if (blk < 2) { if (kb == blk) src = p->in[I_DECW2] + (size_t)blk * 64 * D + nn0; }
        else if (blk < 4) { if (kb == blk) src = p->in[I_A2] + (size_t)(blk - 2) * 64 * D + nn0; }
        else { if (kb >= 4) src = p->in[I_G2] + (size_t)(kb - 4) * 64 * D + nn0; }
        return ConvJob{src, D, (bf16*)(ws + WS_WL2) + (size_t)n0 * 384 + kb * 64, 384}; } r -= IT_L2;
    if (r < IT_GU0) {
        const int mat = r >> 10, q = r & 1023, kb = q >> 6, nb = q & 63, n0 = nb * 32;
        const int j0 = n0 & 1023, drow = 256 * (j0 >> 7) + (n0 >= 1024 ? 128 : 0) + (j0 & 127);
        return ConvJob{p->in[I_WGU] + (size_t)mat * D * 2048 + (size_t)(kb * 64) * 2048 + n0, 2048, (bf16*)(ws + WS_WGU) + (size_t)mat * 2048 * D + (size_t)drow * D + kb * 64, D}; } r -= IT_GU0;
    { const int mat = r >> 9, q = r & 511; return job_plain(p->in[I_WDN] + (size_t)mat * D * D, D, D, (bf16*)(ws + WS_WD) + (size_t)mat * D * D, q); }
}
__device__ __forceinline__ ConvJob conv_job_l1(PP p, int r) {
    unsigned char* ws = p->ws; ConvJob j;
    if (r < IT_GU0) { const int mat = 32 + (r >> 10), q = r & 1023, kb = q >> 6, nb = q & 63, n0 = nb * 32;
        const int j0 = n0 & 1023, drow = 256 * (j0 >> 7) + (n0 >= 1024 ? 128 : 0) + (j0 & 127);
        j.src = p->in[I_WGU] + (size_t)mat * D * 2048 + (size_t)(kb * 64) * 2048 + n0; j.src_ld = 2048;
        j.dst = (bf16*)(ws + WS_WGU) + (size_t)mat * 2048 * D + (size_t)drow * D + kb * 64; j.dst_ld = D; return j; }
    r -= IT_GU0;
    { const int mat = 32 + (r >> 9), q = r & 511, kb = q >> 5, nb = q & 31;
      j.src = p->in[I_WDN] + (size_t)mat * D * D + (size_t)(kb * 64) * D + nb * 32; j.src_ld = D;
      j.dst = (bf16*)(ws + WS_WD) + (size_t)mat * D * D + (size_t)(nb * 32) * D + kb * 64; j.dst_ld = D; return j; }
}
__device__ __forceinline__ void phase_pre(PP p, LAS unsigned char* lds, int tid, int lane, int wave) {
    if (blockIdx.x < 192) {
        const int layer = blockIdx.x / 96, col = (blockIdx.x % 96) * 64 + lane;
        const float* W = p->in[I_ADAW] + (size_t)layer * D * 6144 + col;
        const float* c = p->in[I_C]; const float* cc = p->in[I_CCTX];
        float a0 = 0.f, a1 = 0.f, a2 = 0.f;
#pragma unroll 8
        for (int k = wave * 128; k < wave * 128 + 128; ++k) {
            const float wv = W[(size_t)k * 6144]; const float c0 = c[k], c1 = c[D + k], c2 = cc[k];
            a0 += c0 * sigm(c0) * wv; a1 += c1 * sigm(c1) * wv; a2 += c2 * sigm(c2) * wv;
        }
        LAS float* red = (LAS float*)lds;
        red[(wave * 3 + 0) * 64 + lane] = a0; red[(wave * 3 + 1) * 64 + lane] = a1; red[(wave * 3 + 2) * 64 + lane] = a2;
        __syncthreads();
        if (wave == 0) {
            float s0 = 0.f, s1 = 0.f, s2 = 0.f;
#pragma unroll
            for (int w = 0; w < 8; ++w) { s0 += red[(w * 3 + 0) * 64 + lane]; s1 += red[(w * 3 + 1) * 64 + lane]; s2 += red[(w * 3 + 2) * 64 + lane]; }
            const float bb = p->in[I_ADAB][layer * 6144 + col];
            float* M = (float*)(p->ws + WS_MOD) + (size_t)layer * 3 * 6144 + col;
            M[0] = s0 + bb; M[6144] = s1 + bb; M[2 * 6144] = s2 + bb;
        }
        __syncthreads();
    }
    LAS float* scr = (LAS float*)(lds + wave * 16384);
    const int gw = blockIdx.x * NWAVES + wave, NGW = gridDim.x * NWAVES;
    ConvJob nj{}; float nrg[32];
    if (gw < IT_TOTAL) { nj = conv_job(p, gw); ti_load(nj.src, nj.src_ld, lane, nrg); }
    for (int it = gw; it < IT_TOTAL; it += NGW) {
        const ConvJob cj = nj; float crg[32];
#pragma unroll
        for (int i = 0; i < 32; ++i) crg[i] = nrg[i];
        if (it + NGW < IT_TOTAL) { nj = conv_job(p, it + NGW); ti_load(nj.src, nj.src_ld, lane, nrg); }
        ti_store(cj.src != nullptr, crg, cj.dst, cj.dst_ld, scr, lane);
    }
}

__device__ __forceinline__ void load_row(const float* row, int lane, f32x4 (&v)[4]) {
#pragma unroll
    for (int j = 0; j < 4; ++j) v[j] = ((const f32x4*)row)[lane + 64 * j];
}
__device__ __forceinline__ float row_rstd(const f32x4 (&v)[4]) {
    float s = 0.f;
#pragma unroll
    for (int j = 0; j < 4; ++j) s += (v[j].x * v[j].x + v[j].y * v[j].y) + (v[j].z * v[j].z + v[j].w * v[j].w);
    return rsqrtf(wave_sum(s) * (1.0f / D) + NORM_EPS);
}
__device__ __forceinline__ void norm_mod(const f32x4 (&v)[4], float rstd, const float* g, const float* shift, const float* scale, int lane, f32x4 (&h)[4]) {
#pragma unroll
    for (int j = 0; j < 4; ++j) {
        const f32x4 gg = ((const f32x4*)g)[lane + 64 * j], sh = ((const f32x4*)shift)[lane + 64 * j], sc = ((const f32x4*)scale)[lane + 64 * j];
        h[j] = v[j] * rstd * gg * (sc + 1.0f) + sh;
    }
}
__device__ __forceinline__ void store_row_bf16(bf16* row, int lane, const f32x4 (&h)[4]) {
#pragma unroll
    for (int j = 0; j < 4; ++j) { v2u w; w.x = pk2(h[j].x, h[j].y); w.y = pk2(h[j].z, h[j].w); ((v2u*)row)[lane + 64 * j] = w; }
}
__device__ __forceinline__ const float* resid_row(PP p, int layer0_inputs, int row) {
    if (layer0_inputs) return row < NLAT ? p->in[I_X] + (size_t)row * D : p->in[I_CTX] + (size_t)(row - NLAT) * D;
    return (const float*)(p->ws + WS_XR) + (size_t)row * D;
}
__device__ __forceinline__ void phase_norm0(PP p, int lane, int wave) {
    const int gw = blockIdx.x * NWAVES + wave, NGW = gridDim.x * NWAVES;
    for (int row = gw; row < NROW; row += NGW) {
        f32x4 v[4], h[4]; load_row(resid_row(p, 1, row), lane, v);
        const float rstd = row_rstd(v); const int vec = row_vec(row);
        norm_mod(v, rstd, p->in[I_NMIX], modp(p, 0, vec, 0), modp(p, 0, vec, 1), lane, h);
        store_row_bf16((bf16*)(p->ws + WS_H) + (size_t)row * D, lane, h);
    }
}
__device__ __forceinline__ void route_select(float (&part)[NE], const float* rb, int row, float* TOPG, int* SLOT, unsigned* cnt, unsigned* ntl, unsigned* tof, int* TILEE, int lane, bool write, int (&slot)[TOPK]) {
#pragma unroll
    for (int e = 0; e < NE; ++e) part[e] = wave_sum(part[e]) + rb[e];
    unsigned taken = 0u; int idx[TOPK]; float val[TOPK];
#pragma unroll
    for (int k = 0; k < TOPK; ++k) {
        float best = -3.0e38f; int bi = 0;
#pragma unroll
        for (int e = 0; e < NE; ++e) { const bool ok = !((taken >> e) & 1u) && (part[e] > best); best = ok ? part[e] : best; bi = ok ? e : bi; }
        taken |= 1u << bi; idx[k] = bi; val[k] = best;
    }
    float ex[TOPK], se = 0.f;
#pragma unroll
    for (int k = 0; k < TOPK; ++k) { ex[k] = __expf(val[k] - val[0]); se += ex[k]; }
    int sl[TOPK] = {0, 0, 0, 0};
    if (lane == 0 && write) {
        unsigned pos[TOPK]; int til[TOPK];
#pragma unroll
        for (int k = 0; k < TOPK; ++k) pos[k] = atomicAdd(cnt + idx[k] * CNT_STRIDE, 1u);
#pragma unroll
        for (int k = 0; k < TOPK; ++k) { til[k] = -1;
            if ((pos[k] & 255u) == 0u) { const unsigned t = atomicAdd(ntl, 1u); til[k] = (int)t; TILEE[1 + t] = idx[k];
                __hip_atomic_store(tof + idx[k] * TOF_PER + (pos[k] >> 8), t + 1u, __ATOMIC_RELAXED, __HIP_MEMORY_SCOPE_AGENT); } }
#pragma unroll
        for (int k = 0; k < TOPK; ++k) {
            if (til[k] < 0) { unsigned t1 = 0u, spins = 0u;
                while ((t1 = __hip_atomic_load(tof + idx[k] * TOF_PER + (pos[k] >> 8), __ATOMIC_RELAXED, __HIP_MEMORY_SCOPE_AGENT)) == 0u && ++spins < (1u << 22)) __builtin_amdgcn_s_sleep(1);
                til[k] = (int)t1 - 1; if (til[k] < 0) til[k] = 0; }
            sl[k] = til[k] * 256 + (int)(pos[k] & 255u);
            SLOT[row * 4 + k] = sl[k]; TOPG[row * 4 + k] = ex[k] * __builtin_amdgcn_rcpf(se);
        }
    }
#pragma unroll
    for (int k = 0; k < TOPK; ++k) slot[k] = __builtin_amdgcn_readfirstlane(sl[k]);
}
__device__ __forceinline__ void phase_ffn_norm_route(PP p, int layer, int nrows, LAS unsigned char* lds, int lane, int wave) {
    const int gw = blockIdx.x * NWAVES + wave, NGW = gridDim.x * NWAVES;
    const float* rw = p->in[I_ROUTW] + (size_t)layer * D * NE; const float* rb = p->in[I_ROUTB] + layer * NE;
    float* TOPG = (float*)(p->ws + WS_ROUTE + RT_TOPG); int* SLOT = (int*)(p->ws + WS_ROUTE + RT_SLOT); int* TILEE = (int*)(p->ws + WS_ROUTE + RT_TILEE) + layer * 512;
    unsigned* ctl = (unsigned*)(p->ws + WS_CTL); unsigned* cnt = ctl + CW_CNT + layer * NE * CNT_STRIDE; unsigned* ntl = ctl + CW_NT + layer; unsigned* tof = ctl + CW_TOF + layer * NE * TOF_PER;
    bf16* XB = (bf16*)(p->ws + WS_U + U_XB);
    LAS float* hs = (LAS float*)(lds + wave * 8192);
    for (int row0 = gw; row0 < nrows; row0 += 2 * NGW) {
        const bool has1 = row0 + NGW < nrows; const int row1 = has1 ? row0 + NGW : row0;
#pragma unroll
        for (int r = 0; r < 2; ++r) { const int row = r ? row1 : row0;
            f32x4 v[4], h[4]; load_row((const float*)(p->ws + WS_XR) + (size_t)row * D, lane, v); const float rstd = row_rstd(v); const int vec = row_vec(row);
            norm_mod(v, rstd, p->in[I_NFFN] + layer * D, modp(p, layer, vec, 3), modp(p, layer, vec, 4), lane, h);
#pragma unroll
            for (int j = 0; j < 4; ++j)
#pragma unroll
                for (int i = 0; i < 4; ++i) hs[r * 1024 + (4 * j + i) * 64 + lane] = h[j][i]; }
        LDS_WAIT(); asm volatile("" ::: "memory");
        float pa[NE], pb[NE];
#pragma unroll
        for (int e = 0; e < NE; ++e) { pa[e] = 0.f; pb[e] = 0.f; }
#pragma unroll 2
        for (int t = 0; t < 16; ++t) {
            const float x0 = hs[t * 64 + lane], x1 = hs[1024 + t * 64 + lane]; const f32x4* wr = (const f32x4*)(rw + (size_t)(4 * lane + 256 * (t >> 2) + (t & 3)) * NE);
#pragma unroll
            for (int q = 0; q < 8; ++q) { const f32x4 w4 = wr[q];
                pa[4 * q + 0] += x0 * w4.x; pa[4 * q + 1] += x0 * w4.y; pa[4 * q + 2] += x0 * w4.z; pa[4 * q + 3] += x0 * w4.w;
                pb[4 * q + 0] += x1 * w4.x; pb[4 * q + 1] += x1 * w4.y; pb[4 * q + 2] += x1 * w4.z; pb[4 * q + 3] += x1 * w4.w; }
        }
        int s0[TOPK], s1[TOPK];
        route_select(pa, rb, row0, TOPG, SLOT, cnt, ntl, tof, TILEE, lane, true, s0);
        route_select(pb, rb, row1, TOPG, SLOT, cnt, ntl, tof, TILEE, lane, has1, s1);
#pragma unroll
        for (int r = 0; r < 2; ++r) { if (r == 1 && !has1) break;
            v2u w[4];
#pragma unroll
            for (int j = 0; j < 4; ++j) { const LAS float* hp = hs + r * 1024 + (4 * j) * 64 + lane; w[j].x = pk2(hp[0], hp[64]); w[j].y = pk2(hp[128], hp[192]); }
#pragma unroll
            for (int k = 0; k < TOPK; ++k) { v2u* d = (v2u*)(XB + (size_t)(r ? s1[k] : s0[k]) * D);
#pragma unroll
                for (int j = 0; j < 4; ++j) d[lane + 64 * j] = w[j]; } }
        LDS_WAIT(); asm volatile("" ::: "memory");
    }
}
__device__ __forceinline__ void phase_combine(PP p, int layer, int nrows, bool final_out, int lane, int wave) {
    const int gw = blockIdx.x * NWAVES + wave, NGW = gridDim.x * NWAVES;
    const float* TOPG = (const float*)(p->ws + WS_ROUTE + RT_TOPG); const int* SLOT = (const int*)(p->ws + WS_ROUTE + RT_SLOT);
    const bf16* YS = (const bf16*)(p->ws + WS_U + U_YS); float* XR = (float*)(p->ws + WS_XR); float* RSTD = (float*)(p->ws + WS_ROUTE + RT_RSTD);
    for (int row = gw; row < nrows; row += NGW) {
        f32x4 v[4], acc[4]; load_row(XR + (size_t)row * D, lane, v);
#pragma unroll
        for (int j = 0; j < 4; ++j) acc[j] = (f32x4){0.f, 0.f, 0.f, 0.f};
#pragma unroll
        for (int k = 0; k < TOPK; ++k) {
            const float gk = TOPG[row * 4 + k]; const v2u* ys = (const v2u*)(YS + (size_t)SLOT[row * 4 + k] * D);
#pragma unroll
            for (int j = 0; j < 4; ++j) { const v2u w = ys[lane + 64 * j];
                acc[j].x += gk * bf2f(w.x & 0xffffu); acc[j].y += gk * bf2f(w.x >> 16); acc[j].z += gk * bf2f(w.y & 0xffffu); acc[j].w += gk * bf2f(w.y >> 16); }
        }
        const float* m5 = modp(p, layer, row_vec(row), 5);
#pragma unroll
        for (int j = 0; j < 4; ++j) v[j] = v[j] + ((const f32x4*)m5)[lane + 64 * j] * acc[j];
        const float rstd = row_rstd(v);
        if (final_out) {
#pragma unroll
            for (int j = 0; j < 4; ++j) ((f32x4*)(p->out + (size_t)row * D))[lane + 64 * j] = v[j] * rstd * ((const f32x4*)p->in[I_FINALG])[lane + 64 * j];
        } else {
#pragma unroll
            for (int j = 0; j < 4; ++j) ((f32x4*)(XR + (size_t)row * D))[lane + 64 * j] = v[j];
            if (lane == 0) RSTD[row] = rstd;
        }
    }
}

__device__ __forceinline__ int step_row(int b, int dir, int step) {
    if (step < CTXL) { const int t = dir ? (CTXL - 1 - step) : step; return NLAT + b * CTXL + t; }
    const int s = step - CTXL; const int t = dir ? (SEQ - 1 - s) : s; return b * SEQ + t;
}
constexpr int NSTEP = CTXL + SEQ;

__device__ __forceinline__ void phase_hg_readout(PP p, int lane, int wave) {
    const int gw = blockIdx.x * NWAVES + wave, NGW = gridDim.x * NWAVES;
    const bf16* Z = (const bf16*)(p->ws + WS_U + U_Z); const float* OD = (const float*)(p->ws + WS_U + U_OD0); bf16* A2 = (bf16*)(p->ws + WS_A2);
    const float* gn = p->in[I_HGGN];
    for (int row = gw; row < NROW; row += NGW) {
#pragma unroll
        for (int h = 0; h < 8; ++h) {
            const int c = h * 128 + 2 * lane;
            const float2 a = *(const float2*)(OD + (size_t)row * D + c), bq = *(const float2*)(OD + (size_t)(NROW + row) * D + c);
            const float o0 = a.x + bq.x, o1 = a.y + bq.y;
            const float rstd = rsqrtf(wave_sum(o0 * o0 + o1 * o1) * (1.0f / 128.0f) + NORM_EPS);
            const unsigned gz = *(const unsigned*)(Z + (size_t)row * 5120 + 4096 + c); const float g0 = bf2f(gz & 0xffffu), g1 = bf2f(gz >> 16);
            const float r0 = o0 * rstd * gn[2 * lane] * (g0 * sigm(g0)), r1 = o1 * rstd * gn[2 * lane + 1] * (g1 * sigm(g1));
            *(unsigned*)(A2 + (size_t)row * D + c) = pk2(r0, r1);
        }
    }
}

__device__ __forceinline__ void phase_lerp(PP p, int lane, int wave) {
    const int gw = blockIdx.x * NWAVES + wave, NGW = gridDim.x * NWAVES;
    const float* XR = (const float*)(p->ws + WS_XR); const float* RSTD = (const float*)(p->ws + WS_ROUTE + RT_RSTD);
    bf16* XL6 = (bf16*)(p->ws + WS_U + U_XL6); const float* g = p->in[I_NMIX] + D; const float* mu = p->in[I_MU];
    for (int row = gw; row < NROW; row += NGW) {
        const int vec = row_vec(row); const float* sh = modp(p, 1, vec, 0); const float* sc = modp(p, 1, vec, 1);
        int nb[4];
        if (row < NLAT) { const int t = row & (SEQ - 1), w = t & 63, r = t >> 6;
            nb[0] = (w >= 1) ? row - 1 : -1; nb[1] = (w < 63) ? row + 1 : -1; nb[2] = (r >= 1) ? row - 64 : -1; nb[3] = (r < SEQ / 64 - 1) ? row + 64 : -1;
        } else { const int t = (row - NLAT) & (CTXL - 1);
            nb[0] = nb[1] = (t >= 1) ? row - 1 : -1; nb[2] = nb[3] = (t < CTXL - 1) ? row + 1 : -1; }
        const float rs = RSTD[row];
#pragma unroll
        for (int j = 0; j < 4; ++j) {
            const int ci = lane + 64 * j;
            const f32x4 gg = ((const f32x4*)g)[ci], s1 = ((const f32x4*)sc)[ci] + 1.0f, s0 = ((const f32x4*)sh)[ci];
            const f32x4 xs = ((const f32x4*)(XR + (size_t)row * D))[ci];
            const f32x4 hs = xs * rs * gg * s1 + s0;
            f32x4 hn = (f32x4){0.f, 0.f, 0.f, 0.f};
            if (nb[j] >= 0) { const f32x4 xn = ((const f32x4*)(XR + (size_t)nb[j] * D))[ci]; hn = xn * RSTD[nb[j]] * gg * s1 + s0; }
            const f32x4 dx = hn - hs;
#pragma unroll
            for (int s = 0; s < 6; ++s) {
                const int m = (s == 0) ? 0 : (s == 1) ? 2 : (s == 2) ? 3 : (s == 3) ? 1 : (s == 4) ? 4 : 5;
                const f32x4 o = hs + dx * ((const f32x4*)(mu + m * D))[ci];
                v2u w; w.x = pk2(o.x, o.y); w.y = pk2(o.z, o.w);
                ((v2u*)(XL6 + ((size_t)s * NROW + row) * D))[ci] = w;
            }
        }
    }
}
__device__ __forceinline__ void phase_rw_readout(PP p, int lane, int wave) {
    const int gw = blockIdx.x * NWAVES + wave, NGW = gridDim.x * NWAVES;
    const bf16* RKV = (const bf16*)(p->ws + WS_U + U_RKV); const bf16* AD = (const bf16*)(p->ws + WS_U + U_AD); const bf16* G = (const bf16*)(p->ws + WS_U + U_G);
    const float* OD = (const float*)(p->ws + WS_U + U_OD1); bf16* A2 = (bf16*)(p->ws + WS_A2);
    for (int row = gw; row < NLAT; row += NGW) {
#pragma unroll 4
        for (int h = 0; h < 16; ++h) {
            const int ch = h * 64 + lane;
            const int bq = row >> 13, tq = row & (SEQ - 1), u0 = ((bq * 32 + h) * 4 + (lane >> 4)), u1 = ((bq * 32 + 16 + h) * 4 + (lane >> 4));
            const float y = OD[((size_t)u0 * NSTEP + CTXL + tq) * 16 + (lane & 15)] + OD[((size_t)u1 * NSTEP + CTXL + (SEQ - 1 - tq)) * 16 + (lane & 15)];
            const float mean = wave_sum(y) * (1.0f / 64.0f); const float d = y - mean; const float var = wave_sum(d * d) * (1.0f / 64.0f);
            float yn = d * rsqrtf(var + 64.0e-5f) * p->in[I_LNXW][ch] + p->in[I_LNXB][ch];
            const float r = bf2f(RKV[(size_t)row * 3072 + ch]), k = bf2f(RKV[(size_t)row * 3072 + 1024 + ch]), v = bf2f(RKV[(size_t)row * 3072 + 2048 + ch]);
            const float ka = p->in[I_KA][ch], rk = p->in[I_RK][ch];
#pragma unroll
            for (int dd = 0; dd < 2; ++dd) { const float a = bf2f(AD[((size_t)dd * NROW + row) * D + ch]); const float kd = k * (1.f + (a - 1.f) * ka);
                yn += wave_sum(r * kd * rk) * v; }
            const float o = yn * bf2f(G[(size_t)row * D + ch]);
            const float o1 = __shfl_down(o, 1);
            if (!(lane & 1)) *(unsigned*)(A2 + (size_t)row * D + ch) = pk2(o, o1);
        }
    }
}

namespace pg8 {
struct SelOrder : StaticOrder {
    int div, sel0; size_t stride;
    __device__ __forceinline__ const char* abase(const Gemm& g, const Unit& u, size_t tstep) const { return (const char*)g.A + (size_t)(sel0 + u.pn / div) * stride + (size_t)u.pm * tstep; }
};
struct MoeOrder {
    const int* tilee; const PG8_LAS int* ord; int nt, ntn, G, c; size_t estride;
    __device__ __forceinline__ void init(const int* te, int nt_, PG8_LAS int* ordbuf, int ntn_, size_t es, int G_, int c_) {
        tilee = te; nt = nt_; ntn = ntn_; estride = es; G = G_; c = c_; ord = ordbuf;
        { const int t = threadIdx.x; if (t < nt) { const int et = te[1 + t]; int rank = 0; for (int u = 0; u < nt; ++u) { const int eu = te[1 + u]; rank += (eu < et || (eu == et && u < t)) ? 1 : 0; } ordbuf[rank] = t; } }
        asm volatile("s_waitcnt lgkmcnt(0)" ::: "memory"); __builtin_amdgcn_s_barrier(); asm volatile("" ::: "memory");
    }
    __device__ __forceinline__ bool next(int i, Unit& u) const { const long L = (long)i * G + c; if (L >= (long)nt * ntn) return false; u.pm = ord[(int)(L / ntn)]; u.pn = (int)(L % ntn); u.e = tilee[1 + u.pm]; return true; }
    __device__ __forceinline__ const char* abase(const Gemm& g, const Unit& u, size_t tstep) const { return (const char*)g.A + (size_t)u.pm * tstep; }
    __device__ __forceinline__ const char* bbase(const Gemm& g, const Unit& u, size_t tstep) const { return (const char*)g.Bt + (size_t)u.e * estride + (size_t)u.pn * tstep; }
    __device__ __forceinline__ void a_ready(const Unit&) const {}
    __device__ __forceinline__ void done(const Unit&) const {}
};
struct EpiStoreBf16 {
    static constexpr bool PERM = true, AFTER_DRAIN = false;
    bf16_t* O; int ldc;
    __device__ __forceinline__ void operator()(const f32x4 (&acc)[2][2][4][2], const Unit& u, int wr, int wc, int fr, int fq) const {
        const int row0 = u.pm * BM + wr * 64 + fr, col0 = u.pn * BM + wc * 32 + 8 * fq;
#pragma unroll
        for (int ai = 0; ai < 2; ++ai)
#pragma unroll
            for (int m = 0; m < 4; ++m) { bf16_t* rowp = O + (size_t)(row0 + ai * HALF + m * 16) * ldc + col0;
#pragma unroll
                for (int bj = 0; bj < 2; ++bj) { const f32x4 v0 = acc[ai][bj][m][0], v1 = acc[ai][bj][m][1];
                    u32x4 w; w.x = cvt_pk_bf16(v0[0], v0[1]); w.y = cvt_pk_bf16(v0[2], v0[3]); w.z = cvt_pk_bf16(v1[0], v1[1]); w.w = cvt_pk_bf16(v1[2], v1[3]);
                    *(u32x4*)(rowp + bj * HALF) = w; } }
    }
};
struct EpiStoreF32 {
    static constexpr bool PERM = false, AFTER_DRAIN = false;
    float* C; int ldc;
    __device__ __forceinline__ void operator()(const f32x4 (&acc)[2][2][4][2], const Unit& u, int wr, int wc, int fr, int fq) const {
        const int row0 = u.pm * BM + wr * 64 + fr, col0 = u.pn * BM + wc * 32 + 4 * fq;
#pragma unroll
        for (int ai = 0; ai < 2; ++ai)
#pragma unroll
            for (int m = 0; m < 4; ++m) { float* rowp = C + (size_t)(row0 + ai * HALF + m * 16) * ldc + col0;
#pragma unroll
                for (int bj = 0; bj < 2; ++bj)
#pragma unroll
                    for (int n = 0; n < 2; ++n) *(f32x4*)(rowp + bj * HALF + n * 16) = acc[ai][bj][m][n]; }
    }
};
struct EpiResid {
    static constexpr bool PERM = false, AFTER_DRAIN = false;
    const float* base_lat; const float* base_ctx; float* out; const float* gate; int gstride;
    __device__ __forceinline__ void operator()(const f32x4 (&acc)[2][2][4][2], const Unit& u, int wr, int wc, int fr, int fq) const {
        const int row0 = u.pm * BM + wr * 64 + fr, col0 = u.pn * BM + wc * 32 + 4 * fq;
#pragma unroll
        for (int ai = 0; ai < 2; ++ai)
#pragma unroll
            for (int m = 0; m < 4; ++m) { const int row = row0 + ai * HALF + m * 16;
                const float* bp = (row < 16384) ? base_lat + (size_t)row * 1024 : base_ctx + (size_t)(row - 16384) * 1024;
                const float* gp = gate + (size_t)(row < 16384 ? (row >= 8192 ? 1 : 0) : 2) * gstride;
                float* op = out + (size_t)row * 1024;
#pragma unroll
                for (int bj = 0; bj < 2; ++bj)
#pragma unroll
                    for (int n = 0; n < 2; ++n) { const int c = col0 + bj * HALF + n * 16;
                        *(f32x4*)(op + c) = *(const f32x4*)(bp + c) + *(const f32x4*)(gp + c) * acc[ai][bj][m][n]; } }
    }
};
__device__ __forceinline__ float sigm_(float x) { return __builtin_amdgcn_rcpf(1.0f + __expf(-x)); }
struct EpiSwiglu {
    static constexpr bool PERM = true, AFTER_DRAIN = false;
    bf16_t* O; const float* bgu;
    __device__ __forceinline__ void operator()(const f32x4 (&acc)[2][2][4][2], const Unit& u, int wr, int wc, int fr, int fq) const {
        const int row0 = u.pm * BM + wr * 64 + fr, col0 = u.pn * HALF + wc * 32 + 8 * fq;
        const float* bg = bgu + (size_t)u.e * 2048 + col0; f32x4 bgv[2], buv[2];
#pragma unroll
        for (int n = 0; n < 2; ++n) { bgv[n] = *(const f32x4*)(bg + 4 * n); buv[n] = *(const f32x4*)(bg + 1024 + 4 * n); }
#pragma unroll
        for (int ai = 0; ai < 2; ++ai)
#pragma unroll
            for (int m = 0; m < 4; ++m) { float r[8];
#pragma unroll
                for (int n = 0; n < 2; ++n) { const f32x4 g4 = acc[ai][0][m][n] + bgv[n], u4 = acc[ai][1][m][n] + buv[n];
#pragma unroll
                    for (int j = 0; j < 4; ++j) { const float g = fminf(g4[j], 7.0f), uu = fminf(fmaxf(u4[j], -7.0f), 7.0f); r[4 * n + j] = g * sigm_(1.702f * g) * (uu + 1.0f); } }
                u32x4 w; w.x = cvt_pk_bf16(r[0], r[1]); w.y = cvt_pk_bf16(r[2], r[3]); w.z = cvt_pk_bf16(r[4], r[5]); w.w = cvt_pk_bf16(r[6], r[7]);
                *(u32x4*)(O + (size_t)(row0 + ai * HALF + m * 16) * 1024 + col0) = w; }
    }
};
struct EpiDown {
    static constexpr bool PERM = true, AFTER_DRAIN = false;
    bf16_t* O; const float* bdn;
    __device__ __forceinline__ void operator()(const f32x4 (&acc)[2][2][4][2], const Unit& u, int wr, int wc, int fr, int fq) const {
        const int row0 = u.pm * BM + wr * 64 + fr, col0 = u.pn * BM + wc * 32 + 8 * fq;
        const float* bp = bdn + (size_t)u.e * 1024 + col0; f32x4 bv[2][2];
#pragma unroll
        for (int bj = 0; bj < 2; ++bj)
#pragma unroll
            for (int n = 0; n < 2; ++n) bv[bj][n] = *(const f32x4*)(bp + bj * HALF + 4 * n);
#pragma unroll
        for (int ai = 0; ai < 2; ++ai)
#pragma unroll
            for (int m = 0; m < 4; ++m) { bf16_t* rowp = O + (size_t)(row0 + ai * HALF + m * 16) * 1024 + col0;
#pragma unroll
                for (int bj = 0; bj < 2; ++bj) { const f32x4 v0 = acc[ai][bj][m][0] + bv[bj][0], v1 = acc[ai][bj][m][1] + bv[bj][1];
                    u32x4 w; w.x = cvt_pk_bf16(v0[0], v0[1]); w.y = cvt_pk_bf16(v0[2], v0[3]); w.z = cvt_pk_bf16(v1[0], v1[1]); w.w = cvt_pk_bf16(v1[2], v1[3]);
                    *(u32x4*)(rowp + bj * HALF) = w; } }
    }
};
struct EpiLora1 {
    static constexpr bool PERM = true, AFTER_DRAIN = false;
    bf16_t* O;
    __device__ __forceinline__ void operator()(const f32x4 (&acc)[2][2][4][2], const Unit& u, int wr, int wc, int fr, int fq) const {
        const int row0 = u.pm * BM + wr * 64 + fr, col0 = u.pn * HALF + wc * 32 + 8 * fq;
#pragma unroll
        for (int ai = 0; ai < 2; ++ai)
#pragma unroll
            for (int m = 0; m < 4; ++m) { float r[8];
#pragma unroll
                for (int n = 0; n < 2; ++n)
#pragma unroll
                    for (int j = 0; j < 4; ++j) { const float x = acc[ai][0][m][n][j]; r[4 * n + j] = (u.pn == 0) ? (2.0f * sigm_(2.0f * x) - 1.0f) : (u.pn == 1) ? x : sigm_(x); }
                u32x4 w; w.x = cvt_pk_bf16(r[0], r[1]); w.y = cvt_pk_bf16(r[2], r[3]); w.z = cvt_pk_bf16(r[4], r[5]); w.w = cvt_pk_bf16(r[6], r[7]);
                *(u32x4*)(O + (size_t)(row0 + ai * HALF + m * 16) * 384 + col0) = w; }
    }
};
struct EpiLora2 {
    static constexpr bool PERM = false, AFTER_DRAIN = false;
    bf16_t* WD; bf16_t* AD; bf16_t* G; const float* w0; const float* a0;
    __device__ __forceinline__ void operator()(const f32x4 (&acc)[2][2][4][2], const Unit& u, int wr, int wc, int fr, int fq) const {
        const int row0 = u.pm * BM + wr * 64 + fr, blk = u.pn >> 2, col0 = (u.pn & 3) * BM + wc * 32 + 4 * fq;
        bf16_t* dst = (blk < 2) ? WD + (size_t)blk * 16896 * 1024 : (blk < 4) ? AD + (size_t)(blk - 2) * 16896 * 1024 : G;
        const float* bias = (blk < 2) ? w0 + blk * 1024 : a0 + ((blk - 2) & 1) * 1024;
#pragma unroll
        for (int ai = 0; ai < 2; ++ai)
#pragma unroll
            for (int m = 0; m < 4; ++m) { bf16_t* rowp = dst + (size_t)(row0 + ai * HALF + m * 16) * 1024;
#pragma unroll
                for (int bj = 0; bj < 2; ++bj)
#pragma unroll
                    for (int n = 0; n < 2; ++n) { const int c = col0 + bj * HALF + n * 16; f32x4 v = acc[ai][bj][m][n];
                        const f32x4 bb = *(const f32x4*)(bias + c);
                        if (blk < 2) { for (int j = 0; j < 4; ++j) v[j] = -0.60653066f * sigm_(v[j] + bb[j]); }
                        else if (blk < 4) { for (int j = 0; j < 4; ++j) v[j] = sigm_(v[j] + bb[j]); }
                        unsigned lo = cvt_pk_bf16(v[0], v[1]), hi = cvt_pk_bf16(v[2], v[3]);
                        *(unsigned long long*)(rowp + c) = (unsigned long long)lo | ((unsigned long long)hi << 32); }
                asm volatile("" ::: "memory"); }
    }
};
}

constexpr int GLA_NCH = NSTEP / 64;
constexpr int GLA_ITEMS = 2 * NBATCH * GLA_NCH * 8;
constexpr size_t U_DS = 298 * MiB, U_OI = 430 * MiB, U_QT = 562 * MiB, U_LAM = 628 * MiB;
typedef short bf16x8_t __attribute__((ext_vector_type(8)));
typedef float f32x2g __attribute__((ext_vector_type(2)));
__device__ __forceinline__ f32x4 mfma16(bf16x8_t a, bf16x8_t b, f32x4 c) { return __builtin_amdgcn_mfma_f32_16x16x32_bf16(a, b, c, 0, 0, 0); }

__device__ __forceinline__ void phase_gla_prep(PP p, LAS unsigned char* lds, int tid, int lane, int wave) {
    constexpr int PQ = 272, PT = 144;
    LAS unsigned char* QA = lds;
    LAS unsigned char* QX = QA + 64 * PQ;
    LAS unsigned char* KB = QX + 48 * PQ;
    LAS unsigned char* KD = KB + 64 * PQ;
    LAS unsigned char* KT = KD + 64 * PQ;
    LAS unsigned char* VT = KT + 128 * PT;
    LAS unsigned char* PI = VT + 128 * PT;
    LAS float* GT = (LAS float*)(PI + 64 * PT);
    const bf16* Z = (const bf16*)(p->ws + WS_U + U_Z);
    bf16* DS = (bf16*)(p->ws + WS_U + U_DS); v2u* OI = (v2u*)(p->ws + WS_U + U_OI); bf16* QT = (bf16*)(p->ws + WS_U + U_QT); float* LAM = (float*)(p->ws + WS_U + U_LAM);
    const int kp = tid & 63, gg = tid >> 6, g = gg >> 1, hh = gg & 1, k0 = 2 * kp, kq = lane >> 4, c16 = lane & 15;
    unsigned zf[8], zq[8], zv[8];
    auto ldz = [&](int item2) {
        const int h2 = item2 & 7, cc2 = (item2 >> 3) % GLA_NCH, db2 = (item2 >> 3) / GLA_NCH, b2 = db2 & 1, dir2 = db2 >> 1;
#pragma unroll
        for (int i = 0; i < 8; ++i) { const size_t zr = (size_t)step_row(b2, dir2, 64 * cc2 + 8 * gg + i) * 5120 + h2 * 128 + k0;
            zf[i] = *(const unsigned*)(Z + zr + 1024 * (1 + dir2)); zq[i] = *(const unsigned*)(Z + zr); zv[i] = *(const unsigned*)(Z + zr + 3072); } };
    if ((int)blockIdx.x < GLA_ITEMS) ldz(blockIdx.x);
    for (int item = blockIdx.x; item < GLA_ITEMS; item += gridDim.x) {
        const int h = item & 7, db = (item >> 3) / GLA_NCH, dir = db >> 1;
        float lbv[2];
#pragma unroll
        for (int e = 0; e < 2; ++e) { const float* lb = p->in[I_HGLB] + (size_t)dir * 3 * D + h * 128 + k0 + e; const float a0 = lb[0], a1 = lb[D], a2 = lb[2 * D];
            const float mx = fmaxf(a0, fmaxf(a1, a2)); const float e0 = __expf(a0 - mx), e1 = __expf(a1 - mx), e2 = __expf(a2 - mx); lbv[e] = e0 / (e0 + e1 + e2); }
        for (int u = tid; u < 64 * PT / 4; u += NTHREADS) ((LAS unsigned*)PI)[u] = 0u;
        float cs[2][8], kin[2][8], qs[2][8], run[2] = {0.f, 0.f}; unsigned vlo[4], vhi[4];
#pragma unroll
        for (int i = 0; i < 8; ++i) {
#pragma unroll
            for (int e = 0; e < 2; ++e) {
                const float fh = bf2f(e ? (zf[i] >> 16) : (zf[i] & 0xffffu)), qv = bf2f(e ? (zq[i] >> 16) : (zq[i] & 0xffffu));
                const float f = lbv[e] + (1.f - lbv[e]) * sigm(fh);
                run[e] += __logf(f); cs[e][i] = run[e]; kin[e][i] = 1.f - f; qs[e][i] = qv * sigm(qv);
            }
            if (i & 1) { vlo[i >> 1] |= zv[i] << 16; vhi[i >> 1] |= zv[i] & 0xffff0000u; } else { vlo[i >> 1] = zv[i] & 0xffffu; vhi[i >> 1] = zv[i] >> 16; }
        }
        if (item + (int)gridDim.x < GLA_ITEMS) ldz(item + gridDim.x);
        *(LAS f32x2g*)(GT + gg * 128 + k0) = (f32x2g){run[0], run[1]};
        *(LAS v4u*)(VT + k0 * PT + 16 * gg) = (v4u){vlo[0], vlo[1], vlo[2], vlo[3]};
        *(LAS v4u*)(VT + (k0 + 1) * PT + 16 * gg) = (v4u){vhi[0], vhi[1], vhi[2], vhi[3]};
        __syncthreads();
        f32x2g t8[8];
#pragma unroll
        for (int u = 0; u < 8; ++u) t8[u] = *(const LAS f32x2g*)(GT + u * 128 + k0);
        unsigned ktl[4], kth[4];
        float rgv[2], totv[2], runSv[2], lov[2], t1v[2], t2v[2];
#pragma unroll
        for (int e = 0; e < 2; ++e) {
            const float s0 = e ? t8[0].y : t8[0].x, s1 = e ? t8[1].y : t8[1].x, s2 = e ? t8[2].y : t8[2].x, s3 = e ? t8[3].y : t8[3].x;
            const float s4 = e ? t8[4].y : t8[4].x, s5 = e ? t8[5].y : t8[5].x, s6 = e ? t8[6].y : t8[6].x, s7 = e ? t8[7].y : t8[7].x;
            const float q0 = s0 + s1, q1 = s2 + s3, q2 = s4 + s5, q3 = s6 + s7;
            rgv[e] = (g > 0 ? q0 : 0.f) + (g > 1 ? q1 : 0.f) + (g > 2 ? q2 : 0.f); totv[e] = (q0 + q1) + (q2 + q3);
            runSv[e] = (g == 0) ? q0 : (g == 1) ? q1 : (g == 2) ? q2 : q3;
            const float first = (g == 0) ? s0 : (g == 1) ? s2 : (g == 2) ? s4 : s6;
            lov[e] = hh ? first : 0.f; t1v[e] = q1; t2v[e] = q2;
        }
        float erg[2], einv[2], eend[2], ex1[2], ex2[2];
#pragma unroll
        for (int e = 0; e < 2; ++e) { erg[e] = __expf(rgv[e]); einv[e] = __expf(-runSv[e]); eend[e] = __expf(totv[e] - (rgv[e] + runSv[e]));
            ex1[e] = (g == 2) ? __expf(t1v[e]) : __expf(t2v[e]); ex2[e] = __expf(t1v[e] + t2v[e]); }
        bf16* qtp = QT + (size_t)item * 64 * 128 + (size_t)(16 * g + 8 * hh) * 128 + k0;
#pragma unroll
        for (int i = 0; i < 8; ++i) {
            float qh[2], kb[2];
#pragma unroll
            for (int e = 0; e < 2; ++e) { const float cr = lov[e] + cs[e][i]; qh[e] = qs[e][i] * __expf(cr); kb[e] = kin[e][i] * __expf(runSv[e] - cr); }
            const int ro = (16 * g + 8 * hh + i) * PQ + 2 * k0;
            *(LAS unsigned*)(QA + ro) = pk2(qh[0], qh[1]);
            *(LAS unsigned*)(KB + ro) = pk2(kb[0], kb[1]);
            *(LAS unsigned*)(KD + ro) = pk2(kb[0] * einv[0], kb[1] * einv[1]);
            if (g == 2) *(LAS unsigned*)(QX + (8 * hh + i) * PQ + 2 * k0) = pk2(qh[0] * ex1[0], qh[1] * ex1[1]);
            if (g == 3) { *(LAS unsigned*)(QX + (16 + 8 * hh + i) * PQ + 2 * k0) = pk2(qh[0] * ex1[0], qh[1] * ex1[1]); *(LAS unsigned*)(QX + (32 + 8 * hh + i) * PQ + 2 * k0) = pk2(qh[0] * ex2[0], qh[1] * ex2[1]); }
            *(unsigned*)(qtp + (size_t)i * 128) = pk2(qh[0] * erg[0], qh[1] * erg[1]);
            const unsigned kv0 = f2bf(kb[0] * eend[0]), kv1 = f2bf(kb[1] * eend[1]);
            if (i & 1) { ktl[i >> 1] |= kv0 << 16; kth[i >> 1] |= kv1 << 16; } else { ktl[i >> 1] = kv0; kth[i >> 1] = kv1; }
        }
        *(LAS v4u*)(KT + k0 * PT + 16 * gg) = (v4u){ktl[0], ktl[1], ktl[2], ktl[3]};
        *(LAS v4u*)(KT + (k0 + 1) * PT + 16 * gg) = (v4u){kth[0], kth[1], kth[2], kth[3]};
        if (gg == 0) *(f32x2g*)(LAM + (size_t)item * 128 + k0) = (f32x2g){__expf(totv[0]), __expf(totv[1])};
        __syncthreads();
        for (int blk = wave; blk < 10; blk += 8) {
            const int gi = (blk >= 6) ? 3 : (blk >= 3) ? 2 : (blk >= 1) ? 1 : 0, ji = blk - ((gi * (gi + 1)) >> 1);
            const LAS unsigned char* ab = (ji + 1 >= gi) ? QA + 16 * gi * PQ : (gi == 2) ? QX : (ji == 1) ? QX + 16 * PQ : QX + 32 * PQ;
            const LAS unsigned char* bb = ((ji == gi) ? KD : KB) + 16 * ji * PQ;
            f32x4 acc = (f32x4){0.f, 0.f, 0.f, 0.f};
#pragma unroll
            for (int s = 0; s < 4; ++s) {
                const bf16x8_t a = *(const LAS bf16x8_t*)(ab + c16 * PQ + (32 * s + 8 * kq) * 2), bv = *(const LAS bf16x8_t*)(bb + c16 * PQ + (32 * s + 8 * kq) * 2);
                acc = mfma16(a, bv, acc);
            }
#pragma unroll
            for (int j = 0; j < 4; ++j) { const int tau = 4 * kq + j; const float val = (ji == gi && c16 > tau) ? 0.f : acc[j];
                *(LAS unsigned short*)(PI + (16 * gi + tau) * PT + (16 * ji + c16) * 2) = (unsigned short)f2bf(val); }
        }
        __syncthreads();
        {
            const LAS unsigned char* vb = VT + (16 * wave + c16) * PT + 16 * kq;
            const bf16x8_t v0 = *(const LAS bf16x8_t*)(vb), v1 = *(const LAS bf16x8_t*)(vb + 64);
#pragma unroll
            for (int gi = 0; gi < 4; ++gi) {
                const LAS unsigned char* pb = PI + (16 * gi + c16) * PT + 16 * kq;
                f32x4 acc = mfma16(*(const LAS bf16x8_t*)(pb), v0, (f32x4){0.f, 0.f, 0.f, 0.f});
                if (gi >= 2) acc = mfma16(*(const LAS bf16x8_t*)(pb + 64), v1, acc);
                { v2u w; w.x = pk2(acc[0], acc[1]); w.y = pk2(acc[2], acc[3]); OI[((size_t)item * 8 + wave) * 256 + gi * 64 + lane] = w; }
            }
            bf16* dsp = DS + (size_t)item * 128 * 128 + (size_t)(16 * wave + c16) * 128 + 4 * kq;
#pragma unroll
            for (int m = 0; m < 8; ++m) {
                const LAS unsigned char* kb2 = KT + (16 * m + c16) * PT + 16 * kq;
                f32x4 acc = mfma16(*(const LAS bf16x8_t*)(kb2), v0, (f32x4){0.f, 0.f, 0.f, 0.f});
                acc = mfma16(*(const LAS bf16x8_t*)(kb2 + 64), v1, acc);
                v2u w; w.x = pk2(acc[0], acc[1]); w.y = pk2(acc[2], acc[3]);
                *(v2u*)(dsp + 16 * m) = w;
            }
        }
        __syncthreads();
    }
}
__device__ __forceinline__ void phase_gla_scan(PP p, int tid) {
    bf16* DS = (bf16*)(p->ws + WS_U + U_DS); const float* LAM = (const float*)(p->ws + WS_U + U_LAM);
    const int nthr = gridDim.x * NTHREADS;
    for (int e = blockIdx.x * NTHREADS + tid; e < 32 * 2048; e += nthr) {
        const int chain = e >> 11, el = e & 2047, h = chain & 7, db = chain >> 3, k8 = (el & 15) * 8;
        float s[8];
#pragma unroll
        for (int i = 0; i < 8; ++i) s[i] = 0.f;
        for (int c0 = 0; c0 < GLA_NCH; c0 += 6) {
            v4u d[6]; f32x4 l0[6], l1[6];
#pragma unroll
            for (int u = 0; u < 6; ++u) { const size_t item = ((size_t)db * GLA_NCH + c0 + u) * 8 + h;
                d[u] = *(const v4u*)(DS + item * 16384 + (size_t)el * 8); l0[u] = *(const f32x4*)(LAM + item * 128 + k8); l1[u] = *(const f32x4*)(LAM + item * 128 + k8 + 4); }
#pragma unroll
            for (int u = 0; u < 6; ++u) { const size_t item = ((size_t)db * GLA_NCH + c0 + u) * 8 + h;
                v4u o; o.x = pk2(s[0], s[1]); o.y = pk2(s[2], s[3]); o.z = pk2(s[4], s[5]); o.w = pk2(s[6], s[7]);
                *(v4u*)(DS + item * 16384 + (size_t)el * 8) = o;
                s[0] = l0[u].x * s[0] + bf2f(d[u].x & 0xffffu); s[1] = l0[u].y * s[1] + bf2f(d[u].x >> 16);
                s[2] = l0[u].z * s[2] + bf2f(d[u].y & 0xffffu); s[3] = l0[u].w * s[3] + bf2f(d[u].y >> 16);
                s[4] = l1[u].x * s[4] + bf2f(d[u].z & 0xffffu); s[5] = l1[u].y * s[5] + bf2f(d[u].z >> 16);
                s[6] = l1[u].z * s[6] + bf2f(d[u].w & 0xffffu); s[7] = l1[u].w * s[7] + bf2f(d[u].w >> 16); }
        }
    }
}
__device__ __forceinline__ void phase_gla_out(PP p, int lane, int wave) {
    const bf16* DS = (const bf16*)(p->ws + WS_U + U_DS); const v2u* OI = (const v2u*)(p->ws + WS_U + U_OI); const bf16* QT = (const bf16*)(p->ws + WS_U + U_QT);
    float* ODb = (float*)(p->ws + WS_U + U_OD0);
    const int kq = lane >> 4, c16 = lane & 15;
    for (int item = blockIdx.x; item < GLA_ITEMS; item += gridDim.x) {
        const int h = item & 7, cc = (item >> 3) % GLA_NCH, db = (item >> 3) / GLA_NCH, b = db & 1, dir = db >> 1;
        const bf16* sp = DS + (size_t)item * 16384 + (size_t)(16 * wave + c16) * 128 + 8 * kq;
        bf16x8_t bv[4];
#pragma unroll
        for (int s = 0; s < 4; ++s) bv[s] = *(const bf16x8_t*)(sp + 32 * s);
        float* OD = ODb + (size_t)dir * NROW * D + h * 128 + 16 * wave + c16;
#pragma unroll
        for (int gi = 0; gi < 4; ++gi) {
            const bf16* qp = QT + (size_t)item * 8192 + (size_t)(16 * gi + c16) * 128 + 8 * kq;
            const v2u ow = OI[((size_t)item * 8 + wave) * 256 + gi * 64 + lane];
            f32x4 acc = (f32x4){bf2f(ow.x & 0xffffu), bf2f(ow.x >> 16), bf2f(ow.y & 0xffffu), bf2f(ow.y >> 16)};
#pragma unroll
            for (int s = 0; s < 4; ++s) acc = mfma16(*(const bf16x8_t*)(qp + 32 * s), bv[s], acc);
#pragma unroll
            for (int j = 0; j < 4; ++j) OD[(size_t)step_row(b, dir, 64 * cc + 16 * gi + 4 * kq + j) * D] = acc[j];
        }
    }
}

typedef short bf16x4_t __attribute__((ext_vector_type(4)));
typedef float f32x2_t __attribute__((ext_vector_type(2))); typedef __bf16 bf16x2v_t __attribute__((ext_vector_type(2)));
__device__ __forceinline__ unsigned cvtpk(float lo, float hi) { const f32x2_t v = {lo, hi}; const bf16x2v_t b = __builtin_convertvector(v, bf16x2v_t); return __builtin_bit_cast(unsigned, b); }
constexpr int R4_DOTA = 0, R4_UPA = 2048, R4_A1 = 4096, R4_A2 = 4352, R4_G7 = 4608, R4_VT = 4864, R4_IMG = 6912, R4_SLOT = 5376, R4_NCH = NSTEP / 8, R4_NCB = 8;
constexpr size_t U_IMG = 872 * MiB;
constexpr size_t U_YST = U_OD1;
__device__ __forceinline__ void phase_rw_prep(PP p, LAS unsigned char* lds, int lane, int wave) {
    const int gw = blockIdx.x * NWAVES + wave, NGW = gridDim.x * NWAVES;
    const bf16* RKV = (const bf16*)(p->ws + WS_U + U_RKV); unsigned char* IMG = p->ws + WS_U + U_IMG;
    LAS unsigned char* da = lds + wave * 8192; LAS unsigned char* gb = da + 2048; LAS float* GL = (LAS float*)(da + 4096);
    LAS unsigned char* a12 = da + 5120;
    const int m = lane & 15, q = lane >> 4;
    const int s2 = lane >> 5, tp = (lane >> 4) & 1, kq = (lane & 15) >> 2, ii = (lane & 3) + 4 * tp, dpos = ((s2 * 4 + kq) * 8 + ii) * 2;
    float nrx[8], nkx[8], nvx[8], nlw[8], nav[8];
    auto ld = [&](int it2) {
        const int chain = it2 & 63, chunk = it2 >> 6, b = chain >> 5, dir = (chain >> 4) & 1, h = chain & 15, ch = h * 64 + lane;
        const bf16* WDp = (const bf16*)(p->ws + WS_U + U_WD) + (size_t)dir * NROW * D; const bf16* ADp = (const bf16*)(p->ws + WS_U + U_AD) + (size_t)dir * NROW * D;
#pragma unroll
        for (int j = 0; j < 8; ++j) { const int row = step_row(b, dir, chunk * 8 + j);
            nrx[j] = bf2f(RKV[(size_t)row * 3072 + ch]); nkx[j] = bf2f(RKV[(size_t)row * 3072 + 1024 + ch]); nvx[j] = bf2f(RKV[(size_t)row * 3072 + 2048 + ch]);
            nlw[j] = bf2f(WDp[(size_t)row * D + ch]); nav[j] = bf2f(ADp[(size_t)row * D + ch]); } };
    if (gw < 64 * R4_NCH) ld(gw);
    for (int it = gw; it < 64 * R4_NCH; it += NGW) {
        const int chain = it & 63, chunk = it >> 6, h = chain & 15, ch = h * 64 + lane;
        const float kkw = p->in[I_KK][ch], kaw = p->in[I_KA][ch];
        float rx[8], kx[8], vx[8], lw[8], av[8], kn[8];
#pragma unroll
        for (int j = 0; j < 8; ++j) { rx[j] = nrx[j]; kx[j] = nkx[j]; vx[j] = nvx[j]; lw[j] = nlw[j]; av[j] = nav[j]; }
        if (it + NGW < 64 * R4_NCH) ld(it + NGW);
#pragma unroll
        for (int j = 0; j < 8; ++j) { const float t = kx[j] * kkw; kn[j] = t * __builtin_amdgcn_rsqf(fmaxf(wave_sum(t * t), 1e-24f)); }
        float bj[8]; { float bb = 0.f;
#pragma unroll
            for (int j = 0; j < 8; ++j) { bb += lw[j]; bj[j] = bb; } }
        const float e7 = __expf(bj[7]);
        unsigned upa[8]; float ebprev = 1.f;
#pragma unroll
        for (int j = 0; j < 8; ++j) {
            const float eb = __expf(bj[j]), einv = __builtin_amdgcn_rcpf(eb), e7j = e7 * einv;
            const float beta = kn[j] * av[j], kd = kx[j] * (1.f + (av[j] - 1.f) * kaw);
            *(LAS unsigned short*)(da + j * 128 + dpos) = (unsigned short)f2bf(kn[j] * ebprev);
            *(LAS unsigned short*)(da + (8 + j) * 128 + dpos) = (unsigned short)f2bf(rx[j] * eb);
            *(LAS unsigned short*)(gb + j * 128 + dpos) = (unsigned short)f2bf(beta * einv);
            *(LAS unsigned short*)(gb + (8 + j) * 128 + dpos) = (unsigned short)f2bf(kd * einv);
            const unsigned ub = f2bf(-beta * e7j), uk = f2bf(kd * e7j);
            if (j & 1) { upa[j >> 1] |= ub << 16; upa[4 + (j >> 1)] |= uk << 16; } else { upa[j >> 1] = ub; upa[4 + (j >> 1)] = uk; }
            ebprev = eb;
        }
        unsigned char* img = IMG + ((size_t)chain * R4_NCH + chunk) * R4_IMG;
        { v4u* d = (v4u*)(img + R4_UPA + lane * 32); d[0] = (v4u){upa[0], upa[1], upa[2], upa[3]}; d[1] = (v4u){upa[4], upa[5], upa[6], upa[7]}; }
        ((float*)(img + R4_G7))[lane] = e7;
        { f32x4* d = (f32x4*)(img + R4_VT + lane * 32); d[0] = (f32x4){vx[0], vx[1], vx[2], vx[3]}; d[1] = (f32x4){vx[4], vx[5], vx[6], vx[7]}; }
        LDS_WAIT(); asm volatile("" ::: "memory");
        { v4u* d = (v4u*)(img + R4_DOTA); d[lane] = ((const LAS v4u*)da)[lane]; d[64 + lane] = ((const LAS v4u*)da)[64 + lane]; }
        f32x4 G = (f32x4){0.f, 0.f, 0.f, 0.f};
#pragma unroll
        for (int s = 0; s < 2; ++s) G = mfma16(*(const LAS bf16x8_t*)(da + m * 128 + (s * 4 + q) * 16), *(const LAS bf16x8_t*)(gb + m * 128 + (s * 4 + q) * 16), G);
        if (m >= 8) { const int i = m - 8;
#pragma unroll
            for (int jp = 0; jp < 4; ++jp) { const int row = 4 * q + jp; const bool keep = (row < 8) ? (i < row) : (i <= row - 8);
                *(LAS unsigned short*)(a12 + row * 16 + i * 2) = (unsigned short)f2bf(keep ? G[jp] : 0.f); } }
#pragma unroll
        for (int jp = 0; jp < 4; ++jp) GL[(4 * q + jp) * 16 + m] = G[jp];
        LDS_WAIT(); asm volatile("" ::: "memory");
        const int c = lane & 7; float Tc[8], M2[8];
#pragma unroll
        for (int j = 0; j < 8; ++j) { float t = (j == c) ? 1.f : 0.f; const f32x4 ra = *(const LAS f32x4*)(GL + j * 16), rb = *(const LAS f32x4*)(GL + j * 16 + 4);
#pragma unroll
            for (int i = 0; i < j; ++i) t -= (i < 4 ? ra[i & 3] : rb[i & 3]) * Tc[i];
            Tc[j] = t; }
#pragma unroll
        for (int j = 0; j < 8; ++j) { float t = 0.f; const f32x4 ra = *(const LAS f32x4*)(GL + (8 + j) * 16), rb = *(const LAS f32x4*)(GL + (8 + j) * 16 + 4);
#pragma unroll
            for (int i = 0; i <= j; ++i) t -= (i < 4 ? ra[i & 3] : rb[i & 3]) * Tc[i];
            M2[j] = t; }
        if (lane < 8) {
#pragma unroll
            for (int j = 0; j < 8; ++j) { *(LAS unsigned short*)(a12 + 256 + j * 16 + c * 2) = (unsigned short)f2bf(Tc[j]); *(LAS unsigned short*)(a12 + 256 + (8 + j) * 16 + c * 2) = (unsigned short)f2bf(M2[j]); } }
        LDS_WAIT(); asm volatile("" ::: "memory");
        if (lane < 32) ((v4u*)(img + R4_A1))[lane] = ((const LAS v4u*)a12)[lane];
        LDS_WAIT(); asm volatile("" ::: "memory");
    }
}
constexpr int R4L_NCB = 6, R4L_SLOT = 6144;
__device__ __forceinline__ void phase_rwkv_scan4(PP p, LAS unsigned char* lds, int vcu, int tid, int lane, int wave) {
    const int m = lane & 15, q = lane >> 4;
    const unsigned char* IMG = p->ws + WS_U + U_IMG;
    for (int unit = vcu; unit < 256; unit += gridDim.x) {
        const int chain = unit >> 2, slab = unit & 3, b = chain >> 5, dir = (chain >> 4) & 1, h = chain & 15;
        float* YST = (float*)(p->ws + WS_U + U_YST) + (size_t)unit * NSTEP * 16 + (q >= 2 ? 4 * (q - 2) : 0) * 16 + m;
        const unsigned char* cimg = IMG + (size_t)chain * R4_NCH * R4_IMG;
        f32x4 S[4];
#pragma unroll
        for (int T = 0; T < 4; ++T) S[T] = (f32x4){0.f, 0.f, 0.f, 0.f};
        v2u idf; { const int c0 = 4 * q; idf.x = ((c0 == m) ? 0x3F80u : 0u) | ((c0 + 1 == m) ? 0x3F800000u : 0u); idf.y = ((c0 + 2 == m) ? 0x3F80u : 0u) | ((c0 + 3 == m) ? 0x3F800000u : 0u); }
        auto issue = [&](int bt) {
#pragma unroll
            for (int k = 0; k < 2 * R4L_NCB; ++k) { const int ii = (wave - 1) + 3 * k, cc = ii / 6, part = ii - cc * 6, pi = part * 64 + lane;
                const unsigned char* src = cimg + (size_t)(bt * R4L_NCB + cc) * R4_IMG + (pi < 304 ? pi * 16 : (pi < 336 ? R4_VT + slab * 512 + (pi - 304) * 16 : 0));
                __builtin_amdgcn_global_load_lds((const unsigned*)src, (LAS unsigned*)(lds + ((bt & 1) * R4L_NCB + cc) * R4L_SLOT + part * 1024), 16, 0, 0); } };
        float crg[32]; int cit = (int)(blockIdx.x * 4 + (wave - 4)); ConvJob cj; bool cpend = false;
        LAS float* cscr = (LAS float*)(lds + 2 * R4L_NCB * R4L_SLOT + (wave & 3) * 8448);
        if (wave >= 4 && cit < IT_L1MOE) { cj = conv_job_l1(p, cit); ti_load(cj.src, cj.src_ld, lane, crg); cpend = true; }
        __syncthreads();
        if (wave >= 1 && wave < 4) issue(0);
        __syncthreads();
        constexpr int NB4 = R4_NCH / R4L_NCB;
        for (int bt = 0; bt < NB4; ++bt) {
            if (wave >= 4) { if (cpend) { ti_store(true, crg, cj.dst, cj.dst_ld, cscr, lane); cit += 4 * (int)gridDim.x; cpend = cit < IT_L1MOE; if (cpend) { cj = conv_job_l1(p, cit); ti_load(cj.src, cj.src_ld, lane, crg); } } }
            else if (wave >= 1) { if (bt + 1 < NB4) issue(bt + 1); }
            else {
                __builtin_amdgcn_s_setprio(3);
                struct Ops { bf16x8_t a0, a1; v2u A1u, A2u; bf16x4_t UA[4]; f32x4 g7[4]; f32x4 vr; };
                auto rd = [&](int cc, Ops& o) {
                    const LAS unsigned char* sl = lds + ((bt & 1) * R4L_NCB + cc) * R4L_SLOT;
                    o.a0 = *(const LAS bf16x8_t*)(sl + R4_DOTA + m * 128 + q * 16); o.a1 = *(const LAS bf16x8_t*)(sl + R4_DOTA + m * 128 + (4 + q) * 16);
                    o.A1u = *(const LAS v2u*)(sl + R4_A1 + m * 16 + (q & 1) * 8); o.A2u = *(const LAS v2u*)(sl + R4_A2 + m * 16 + (q & 1) * 8);
#pragma unroll
                    for (int T = 0; T < 4; ++T) { o.UA[T] = *(const LAS bf16x4_t*)(sl + R4_UPA + (16 * T + m) * 32 + q * 8); o.g7[T] = *(const LAS f32x4*)(sl + R4_G7 + (16 * T + 4 * q) * 4); }
                    o.vr = *(const LAS f32x4*)(sl + R4_VT + m * 32 + (q & 1) * 16); };
                Ops cur, nxt; rd(0, cur);
#pragma unroll
                for (int cc = 0; cc < R4L_NCB; ++cc) {
                    if (cc + 1 < R4L_NCB) rd(cc + 1, nxt);
                    __builtin_amdgcn_sched_barrier(0);
                    v2u A1u = cur.A1u, A2u = cur.A2u;
                    if (q >= 2) { A1u = (v2u){0u, 0u}; A2u = idf; }
                    v4u b0, b1;
                    b0.x = cvtpk(S[0][0], S[0][1]); b0.y = cvtpk(S[0][2], S[0][3]); b0.z = cvtpk(S[1][0], S[1][1]); b0.w = cvtpk(S[1][2], S[1][3]);
                    b1.x = cvtpk(S[2][0], S[2][1]); b1.y = cvtpk(S[2][2], S[2][3]); b1.z = cvtpk(S[3][0], S[3][1]); b1.w = cvtpk(S[3][2], S[3][3]);
                    f32x4 Dd = mfma16(cur.a0, __builtin_bit_cast(bf16x8_t, b0), (f32x4){0.f, 0.f, 0.f, 0.f});
                    Dd = mfma16(cur.a1, __builtin_bit_cast(bf16x8_t, b1), Dd);
                    v2u vb; vb.x = cvtpk(cur.vr[0], cur.vr[1]); vb.y = cvtpk(cur.vr[2], cur.vr[3]);
                    const f32x4 Z = __builtin_amdgcn_mfma_f32_16x16x16bf16_1k(__builtin_bit_cast(bf16x4_t, A1u), __builtin_bit_cast(bf16x4_t, vb), Dd, 0, 0, 0);
                    v2u zb; zb.x = cvtpk(Z[0], Z[1]); zb.y = cvtpk(Z[2], Z[3]);
                    const f32x4 W = __builtin_amdgcn_mfma_f32_16x16x16bf16_1k(__builtin_bit_cast(bf16x4_t, A2u), __builtin_bit_cast(bf16x4_t, zb), (f32x4){0.f, 0.f, 0.f, 0.f}, 0, 0, 0);
                    v2u wb; wb.x = cvtpk(W[0], W[1]); wb.y = cvtpk(W[2], W[3]);
                    const v2u ub = (q < 2) ? wb : vb;
#pragma unroll
                    for (int T = 0; T < 4; ++T) S[T] = __builtin_amdgcn_mfma_f32_16x16x16bf16_1k(cur.UA[T], __builtin_bit_cast(bf16x4_t, ub), S[T] * cur.g7[T], 0, 0, 0);
                    if (q >= 2) { float* yp = YST + (size_t)(bt * R4L_NCB + cc) * 128;
#pragma unroll
                        for (int i = 0; i < 4; ++i) yp[i * 16] = W[i]; }
                    if (cc + 1 < R4L_NCB) cur = nxt;
                }
            }
            __syncthreads();
        }
        if (wave >= 4) { while (cpend) { ti_store(true, crg, cj.dst, cj.dst_ld, cscr, lane); cit += 4 * (int)gridDim.x; cpend = cit < IT_L1MOE; if (cpend) { cj = conv_job_l1(p, cit); ti_load(cj.src, cj.src_ld, lane, crg); } } }
    }
}

__device__ __forceinline__ void phase_lora2(PP p, LAS unsigned char* lds, int tid, int lane, int wave) {
    const bf16* L1 = (const bf16*)(p->ws + WS_U + U_L1); const bf16* W2 = (const bf16*)(p->ws + WS_WL2);
    const int c16 = lane & 15, kq = lane >> 4;
    const int part = blockIdx.x % 12, wgp = blockIdx.x / 12, nwg = (gridDim.x - part + 11) / 12;
    const int blk = (part < 8) ? (part >> 1) : 4, col0 = (part < 8) ? (part & 1) * 512 : (part - 8) * 256, ncol = (part < 8) ? 512 : 256;
    const int koff = (blk < 4) ? blk * 64 : 256, nks = (blk < 4) ? 2 : 4, K = nks * 32, WP = K * 2 + 16;
    LAS unsigned char* wl = lds;
    constexpr int PS = 272;
    LAS unsigned char* stg = lds + 73728 + wave * (16 * PS);
    { const int ppr = K / 8;
      for (int u = tid; u < ncol * ppr; u += NTHREADS) { const int c = u / ppr, pc = u - c * ppr;
          *(LAS v4u*)(wl + c * WP + pc * 16) = *(const v4u*)(W2 + (size_t)(blk * 1024 + col0 + c) * 384 + koff + pc * 8); } }
    __syncthreads();
    bf16* dstb = (bf16*)(p->ws + WS_U + ((blk < 2) ? U_WD : (blk < 4) ? U_AD : U_G)) + (size_t)((blk < 4) ? (blk & 1) : 0) * NROW * D + col0;
    const float* bias = ((blk < 2) ? p->in[I_DECW0] + blk * D : p->in[I_A0] + ((blk - 2) & 1) * D) + col0;
    for (int rt = wgp * NWAVES + wave; rt < NROW / 16; rt += nwg * NWAVES) {
        const bf16* lp = L1 + (size_t)(rt * 16 + c16) * 384 + koff + 8 * kq;
        bf16x8_t bfr[4];
#pragma unroll
        for (int s = 0; s < 4; ++s) if (s < nks) bfr[s] = *(const bf16x8_t*)(lp + 32 * s);
        bf16* dst = dstb + (size_t)(rt * 16) * D;
        for (int ps = 0; ps < ncol / 128; ++ps) {
#pragma unroll 4
            for (int ct = 0; ct < 8; ++ct) {
                const int c0 = ps * 128 + ct * 16;
                const LAS unsigned char* wp = wl + (c0 + c16) * WP + 16 * kq;
                f32x4 acc = (f32x4){0.f, 0.f, 0.f, 0.f};
#pragma unroll
                for (int s = 0; s < 4; ++s) if (s < nks) acc = mfma16(*(const LAS bf16x8_t*)(wp + 64 * s), bfr[s], acc);
                const f32x4 bb = *(const f32x4*)(bias + c0 + 4 * kq);
                if (blk < 2) { for (int j = 0; j < 4; ++j) acc[j] = -0.60653066f * sigm(acc[j] + bb[j]); }
                else if (blk < 4) { for (int j = 0; j < 4; ++j) acc[j] = sigm(acc[j] + bb[j]); }
                v2u w; w.x = pk2(acc[0], acc[1]); w.y = pk2(acc[2], acc[3]);
                *(LAS v2u*)(stg + c16 * PS + (ct * 16 + 4 * kq) * 2) = w;
            }
            LDS_WAIT(); asm volatile("" ::: "memory");
#pragma unroll
            for (int i = 0; i < 4; ++i) { const int row = 4 * i + (lane >> 4), cb = lane & 15;
                *(v4u*)(dst + (size_t)row * D + ps * 128 + cb * 8) = *(const LAS v4u*)(stg + row * PS + cb * 16); }
            LDS_WAIT(); asm volatile("" ::: "memory");
        }
    }
    __syncthreads();
}
enum { PH_PRE = 0, PH_NORM0, PH_G_IN, PH_GLA_A, PH_GLA_B, PH_GLA_C, PH_HGRO, PH_G_HGO, PH_FFN0, PH_GU0, PH_DN0, PH_COMB0,
       PH_LERP, PH_G_RKV, PH_G_L2, PH_RWPREP, PH_RWSCAN, PH_RWRO, PH_G_RWO, PH_FFN1, PH_GU1, PH_DN1, PH_COMB1, NPHASES };

template <int ph> __device__ __forceinline__ void run_phase(PP p, LAS unsigned char* lds, int tid, int lane, int wave, int G, int bx, int vcu) {
    unsigned char* ws = p->ws;
    typedef pg8::bf16_t bt;
    switch (ph) {
        case PH_PRE: phase_pre(p, lds, tid, lane, wave); break;
        case PH_NORM0: phase_norm0(p, lane, wave); break;
        case PH_G_IN: {
            pg8::Gemm g{(const bt*)(ws + WS_H), (const bt*)(ws + WS_WIN), NROW, 5120, D}; pg8::StaticOrder S; S.init(NROW, 5120, G, bx);
            pg8::EpiStoreBf16 E{(bt*)(ws + WS_U + U_Z), 5120};
            pg8::gemm_phase<pg8::EpiStoreBf16, pg8::StaticOrder, true, true>(lds, g, S, E); } break;
        case PH_GLA_A: phase_gla_prep(p, lds, tid, lane, wave); break;
        case PH_GLA_B: phase_gla_scan(p, tid); break;
        case PH_GLA_C: phase_gla_out(p, lane, wave); break;
        case PH_HGRO: phase_hg_readout(p, lane, wave); break;
        case PH_G_HGO: {
            pg8::Gemm g{(const bt*)(ws + WS_A2), (const bt*)(ws + WS_WHGO), NROW, D, D}; pg8::StaticOrder S; S.init(NROW, D, G, bx);
            pg8::EpiResid E{p->in[I_X], p->in[I_CTX], (float*)(ws + WS_XR), modp(p, 0, 0, 2), 6144};
            pg8::gemm_phase<pg8::EpiResid, pg8::StaticOrder, true, true>(lds, g, S, E); } break;
        case PH_FFN0: phase_ffn_norm_route(p, 0, NROW, lds, lane, wave); break;
        case PH_FFN1: phase_ffn_norm_route(p, 1, NLAT, lds, lane, wave); break;
        case PH_GU0: case PH_GU1: { const int layer = (ph == PH_GU1);
            pg8::Gemm g{(const bt*)(ws + WS_U + U_XB), (const bt*)(ws + WS_WGU) + (size_t)layer * NE * 2048 * D, CAP, 2048, D};
            const int ntl = (int)((const unsigned*)(ws + WS_CTL))[CW_NT + layer];
            pg8::MoeOrder S; S.init((const int*)(ws + WS_ROUTE + RT_TILEE) + layer * 512, ntl, (LAS int*)(lds + 132096), 8, (size_t)2048 * D * 2, G, vcu);
            pg8::EpiSwiglu E{(bt*)(ws + WS_U + U_ACT), p->in[I_BGU] + (size_t)layer * NE * 2048};
            pg8::gemm_phase<pg8::EpiSwiglu, pg8::MoeOrder, true, true>(lds, g, S, E); } break;
        case PH_DN0: case PH_DN1: { const int layer = (ph == PH_DN1);
            pg8::Gemm g{(const bt*)(ws + WS_U + U_ACT), (const bt*)(ws + WS_WD) + (size_t)layer * NE * D * D, CAP, D, D};
            const int ntl = (int)((const unsigned*)(ws + WS_CTL))[CW_NT + layer];
            pg8::MoeOrder S; S.init((const int*)(ws + WS_ROUTE + RT_TILEE) + layer * 512, ntl, (LAS int*)(lds + 132096), 4, (size_t)D * D * 2, G, vcu);
            pg8::EpiDown E{(bt*)(ws + WS_U + U_YS), p->in[I_BDN] + (size_t)layer * NE * D};
            pg8::gemm_phase<pg8::EpiDown, pg8::MoeOrder, true, true>(lds, g, S, E); } break;
        case PH_COMB0: phase_combine(p, 0, NROW, false, lane, wave); break;
        case PH_COMB1: phase_combine(p, 1, NLAT, true, lane, wave); break;
        case PH_LERP: phase_lerp(p, lane, wave); break;
        case PH_G_RKV: {
            { pg8::Gemm g{(const bt*)(ws + WS_U + U_XL6), (const bt*)(ws + WS_WRKV), NROW, 3072, D};
              pg8::SelOrder S; S.init(NROW, 3072, G, bx); S.div = 4; S.sel0 = 0; S.stride = (size_t)NROW * D * 2;
              pg8::EpiStoreBf16 E{(bt*)(ws + WS_U + U_RKV), 3072};
              pg8::gemm_phase<pg8::EpiStoreBf16, pg8::SelOrder, true, true>(lds, g, S, E); }
            { pg8::Gemm g{(const bt*)(ws + WS_U + U_XL6), (const bt*)(ws + WS_WL1), NROW, 768, D};
              pg8::SelOrder S; S.init(NROW, 768, G, bx); S.div = 1; S.sel0 = 3; S.stride = (size_t)NROW * D * 2;
              pg8::EpiLora1 E{(bt*)(ws + WS_U + U_L1)};
              pg8::gemm_phase<pg8::EpiLora1, pg8::SelOrder, true, true>(lds, g, S, E); } } break;
        case PH_G_L2: phase_lora2(p, lds, tid, lane, wave); break;
        case PH_RWPREP: phase_rw_prep(p, lds, lane, wave); break;
        case PH_RWSCAN: phase_rwkv_scan4(p, lds, vcu, tid, lane, wave); break;
        case PH_RWRO: phase_rw_readout(p, lane, wave); break;
        case PH_G_RWO: {
            pg8::Gemm g{(const bt*)(ws + WS_A2), (const bt*)(ws + WS_WRWO), NLAT, D, D}; pg8::StaticOrder S; S.init(NLAT, D, G, bx);
            float* XR = (float*)(ws + WS_XR);
            pg8::EpiResid E{XR, XR + (size_t)NLAT * D, XR, modp(p, 1, 0, 2), 6144};
            pg8::gemm_phase<pg8::EpiResid, pg8::StaticOrder, true, true>(lds, g, S, E); } break;
        default: break;
    }
}

#define MK_PROLOGUE \
    extern __shared__ __attribute__((aligned(16))) unsigned char lds_raw[]; \
    LAS unsigned char* lds = (LAS unsigned char*)lds_raw; \
    const int tid = threadIdx.x, lane = tid & 63, wave = __builtin_amdgcn_readfirstlane(tid >> 6); \
    const int G = gridDim.x, bx = blockIdx.x, vcu = (G % 8 == 0) ? (bx % 8) * (G / 8) + bx / 8 : bx;

#define XB_TMO      128
#define XB_XCNT(j)  (256  + 64 * (j))
#define XB_XSUB(j)  (1280 + 64 * (j))
#define XB_XGEN(j)  (2304 + 64 * (j))
#define XB_TOP      3328
#define XB_TOPGEN   3392
#define XCD_BAR_WORDS 3456
#define XB_SPIN_CAP (1u << 18)

__device__ __forceinline__ unsigned xb_ld(unsigned* p)              { return __hip_atomic_load(p, __ATOMIC_RELAXED, __HIP_MEMORY_SCOPE_AGENT); }
__device__ __forceinline__ unsigned xb_add(unsigned* p, unsigned v) { return __hip_atomic_fetch_add(p, v, __ATOMIC_RELAXED, __HIP_MEMORY_SCOPE_AGENT); }
__device__ __forceinline__ unsigned xb_xcc_id() { return (unsigned)__builtin_amdgcn_s_getreg((3 << 11) | 20) & 0xFu; }
#define XB_SPIN(cond, bar) do { unsigned _sp = 0; while (cond) { __builtin_amdgcn_s_sleep(1); \
    if ((++_sp & 255u) == 0u) { if (xb_ld(&(bar)[XB_TMO])) break; if (_sp > XB_SPIN_CAP) { atomicAdd(&(bar)[XB_TMO], 1u); break; } } } } while (0)

struct XcdBarrier {
    unsigned* bar; unsigned x;
    volatile LAS unsigned* st;
};

__device__ __forceinline__ XcdBarrier xcd_barrier_post(unsigned* bar, volatile LAS unsigned* st) {
    XcdBarrier b; b.bar = bar; b.x = xb_xcc_id(); b.st = st;
    if (threadIdx.x == 0) (void)xb_add(&bar[XB_XCNT(b.x)], 1u);
    return b;
}
__device__ __forceinline__ void xcd_barrier_complete(unsigned* bar, unsigned x, unsigned& nloc, unsigned& nx) {
    const unsigned G = gridDim.x * gridDim.y * gridDim.z;
    unsigned sum, cnt, mine, sp = 0u;
    for (;;) {
        sum = 0u; cnt = 0u; mine = 0u;
#pragma unroll
        for (unsigned j = 0; j < 16; ++j) { const unsigned c = xb_ld(&bar[XB_XCNT(j)]); sum += c; cnt += (c > 0u) ? 1u : 0u; mine = (j == x) ? c : mine; }
        if (sum == G) break;
        __builtin_amdgcn_s_sleep(1);
        if ((++sp & 255u) == 0u) { if (xb_ld(&bar[XB_TMO])) break; if (sp > XB_SPIN_CAP) { atomicAdd(&bar[XB_TMO], 1u); break; } }
    }
    nloc = mine > 0u ? mine : 1u; nx = cnt > 0u ? cnt : 1u;
}

__device__ __forceinline__ void xcd_barrier(const XcdBarrier& b) {
    asm volatile("s_waitcnt vmcnt(0)" ::: "memory");
    __syncthreads();
    if (threadIdx.x == 0) {
        unsigned* bar = b.bar;
        __builtin_amdgcn_s_waitcnt(0);
        unsigned nloc = b.st[0], nx = b.st[1];
        if (nloc == 0u) { xcd_barrier_complete(bar, b.x, nloc, nx); b.st[0] = nloc; b.st[1] = nx; }
        const unsigned old = xb_add(&bar[XB_XSUB(b.x)], 1u);
        const unsigned gen = old / nloc;
        if (old + 1u == (gen + 1u) * nloc) {
            __builtin_amdgcn_fence(__ATOMIC_RELEASE, "agent");
            asm volatile("s_waitcnt vmcnt(0)" ::: "memory");
            const unsigned og = xb_add(&bar[XB_TOP], 1u);
            const unsigned tg = og / nx;
            if (og + 1u == (tg + 1u) * nx) xb_add(&bar[XB_TOPGEN], 1u);
            else XB_SPIN(xb_ld(&bar[XB_TOPGEN]) == tg, bar);
            __builtin_amdgcn_fence(__ATOMIC_ACQUIRE, "agent");
            xb_add(&bar[XB_XGEN(b.x)], 1u);
            asm volatile("s_waitcnt vmcnt(0)" ::: "memory");
        } else {
            XB_SPIN(xb_ld(&bar[XB_XGEN(b.x)]) == gen, bar);
            __builtin_amdgcn_fence(__ATOMIC_ACQUIRE, "agent");
            asm volatile("s_waitcnt vmcnt(0)" ::: "memory");
        }
    }
    __syncthreads();
}

constexpr int LDSCTL_OFF = 131072, MISC_OFF = LDSCTL_OFF + 320;
__device__ __forceinline__ void grid_bar(PP kp, LAS unsigned char* lds) {
    PP q = kp; asm volatile("" : "+s"(q));
    XcdBarrier b; b.bar = (unsigned*)(q->ws + WS_CTL) + CW_BAR; b.x = xb_xcc_id(); b.st = (volatile LAS unsigned*)(lds + MISC_OFF) + 8;
    xcd_barrier(b);
}
namespace cg = cooperative_groups;
__global__ void __launch_bounds__(NTHREADS, 2) mk_fwd(Params pv) {
    MK_PROLOGUE
    cg::grid_group grid = cg::this_grid();
    PP kp = (PP)__builtin_amdgcn_kernarg_segment_ptr();
    const int lo = kp->ph_lo, hi = kp->ph_hi;
    for (int u = tid; u < (LDS_BYTES - LDSCTL_OFF) / 4; u += NTHREADS) ((LAS unsigned*)(lds + LDSCTL_OFF))[u] = 0u;
    __syncthreads();
    { XcdBarrier b0 = xcd_barrier_post((unsigned*)(kp->ws + WS_CTL) + CW_BAR, (volatile LAS unsigned*)(lds + MISC_OFF) + 8); (void)b0; }
#ifndef REPEAT_MASK
#define REPEAT_MASK 0u
#endif
#define RUN(k) if (lo <= (k) && (k) < hi) { PP q = kp; asm volatile("" : "+s"(q)); run_phase<k>(q, lds, tid, lane, wave, G, bx, vcu); \
        if ((REPEAT_MASK >> (k)) & 1u) { grid_bar(kp, lds); PP q2 = kp; asm volatile("" : "+s"(q2)); run_phase<k>(q2, lds, tid, lane, wave, G, bx, vcu); } \
        if ((k) + 1 < hi) { if ((k) == 0) grid.sync(); else grid_bar(kp, lds); } }
    RUN(0) RUN(1) RUN(2) RUN(3) RUN(4) RUN(5) RUN(6) RUN(7) RUN(8) RUN(9) RUN(10) RUN(11) RUN(12) RUN(13) RUN(14) RUN(15) RUN(16) RUN(17) RUN(18) RUN(19) RUN(20) RUN(21) RUN(22)
#undef RUN
}

extern "C" void kernel_launch(void* const* d_in, const int* in_sizes, int n_in, void* d_out, int out_size, void* d_ws, size_t ws_size, hipStream_t stream) {
    static int grid = 0;
    if (grid == 0) {
        if (n_in != 35 || in_sizes[0] != NLAT * D || out_size != NLAT * D || ws_size < WS_END) {
            fprintf(stderr, "kernel_launch: unexpected problem (n_in %d, in0 %d, out %d, ws %zu < %zu)\n", n_in, n_in > 0 ? in_sizes[0] : -1, out_size, ws_size, (size_t)WS_END); grid = -1; return; }
        int dev = 0, cus = 0, per_cu = 0;
        if (hipGetDevice(&dev) != hipSuccess || hipDeviceGetAttribute(&cus, hipDeviceAttributeMultiprocessorCount, dev) != hipSuccess) { grid = -1; return; }
        if (hipFuncSetAttribute((const void*)mk_fwd, hipFuncAttributeMaxDynamicSharedMemorySize, LDS_BYTES) != hipSuccess) { fprintf(stderr, "kernel_launch: hipFuncSetAttribute failed\n"); grid = -1; return; }
        if (hipOccupancyMaxActiveBlocksPerMultiprocessor(&per_cu, (const void*)mk_fwd, NTHREADS, LDS_BYTES) != hipSuccess || per_cu < 1) { fprintf(stderr, "kernel_launch: occupancy query %d\n", per_cu); per_cu = 1; }
        (void)hipGetLastError();
        grid = cus * (per_cu < 1 ? 1 : per_cu);
    }
    if (grid < 0) return;
    (void)hipMemsetAsync((char*)d_ws + WS_CTL, 0, CTL_ZERO_BYTES, stream);
    Params p{};
    for (int i = 0; i < 35; ++i) p.in[i] = (const float*)d_in[i];
    p.out = (float*)d_out; p.ws = (unsigned char*)d_ws;
    p.ph_lo = 0; p.ph_hi = NPHASES;
    void* args[] = {&p};
    hipError_t e = hipLaunchCooperativeKernel((const void*)mk_fwd, dim3(grid), dim3(NTHREADS), args, LDS_BYTES, stream);
    if (e != hipSuccess) fprintf(stderr, "kernel_launch: cooperative launch failed: %s (grid %d)\n", hipGetErrorString(e), grid);
}
```

```cpp
#include <hip/hip_runtime.h>
#include <hip/hip_cooperative_groups.h>
#include <cstdio>
#include <cstdint>
namespace pg8 {
#define PG8_LAS __attribute__((address_space(3)))
typedef unsigned short bf16_t;
typedef short bf16x8 __attribute__((ext_vector_type(8)));
typedef float f32x4 __attribute__((ext_vector_type(4)));
typedef unsigned u32x4 __attribute__((ext_vector_type(4)));
constexpr int BM = 256, BK = 64, HALF = 128, HTB = HALF * BK * 2  , STAGE_BYTES = 8 * HTB, NXCD = 8, WGM = 8;

__host__ __device__ __forceinline__ int lds_byte(int r, int c) { const int st = (r >> 4) * 2 + (c >> 5), rr = r & 15, cc = c & 31, ob = rr * 64 + cc * 2; return st * 1024 + (ob ^ (((ob >> 9) & 1) << 5)); }
__host__ __device__ __forceinline__ void stage_rc(int b, int& R, int& C) { const int st = b / 1024, sb = b % 1024, swz = sb ^ (((sb >> 9) & 1) << 5); R = (st >> 1) * 16 + swz / 64; C = (st & 1) * 32 + (swz % 64) / 2; }
__host__ __device__ __forceinline__ int perm32(int rho) { const int n = rho >> 4, i = rho & 15; return 8 * (i >> 2) + 4 * n + (i & 3); }

struct Unit { int pm, pn, e; };
struct Gemm { const bf16_t* A; const bf16_t* Bt; int M, N, K; };

struct StaticOrder {
    int nM, nN, nwg, G, c;
    __host__ __device__ void init(int M, int N, int G_, int c_) { nM = M / BM; nN = N / BM; nwg = nM * nN; G = G_; c = c_; }
    __host__ __device__ bool next(int i, Unit& u) const { return at((long)i * G + c, u); }
    __host__ __device__ bool at(long L, Unit& u) const {
        if (L >= nwg) return false;
        int wgid = (int)L; { const int q = nwg / NXCD, r = nwg % NXCD, xcd = wgid % NXCD, off = wgid / NXCD; wgid = (xcd < r ? xcd * (q + 1) : r * (q + 1) + (xcd - r) * q) + off; }
        const int nig = WGM * nN, gid = wgid / nig, fm = gid * WGM, gsz = (nM - fm) < WGM ? (nM - fm) : WGM;
        u.pm = fm + ((wgid % nig) % gsz); u.pn = (wgid % nig) / gsz; u.e = 0; return true;
    }
    __device__ __forceinline__ const char* abase(const Gemm& g, const Unit& u, size_t tstep) const { return (const char*)g.A + (size_t)u.pm * tstep; }
    __device__ __forceinline__ const char* bbase(const Gemm& g, const Unit& u, size_t tstep) const { return (const char*)g.Bt + (size_t)u.pn * tstep; }
    __device__ __forceinline__ void a_ready(const Unit&) const {}
    __device__ __forceinline__ void done(const Unit&) const {}
};

__device__ __forceinline__ unsigned cvt_pk_bf16(float lo, float hi) { unsigned r; asm volatile("v_cvt_pk_bf16_f32 %0, %1, %2" : "=v"(r) : "v"(lo), "v"(hi)); return r; }

template <class Epi, class Sched, bool ALIGN_EPI = false, bool SP2 = false>
__device__ __forceinline__ void gemm_phase(PG8_LAS unsigned char* lds, const Gemm g, const Sched& S, const Epi& E) {
    const int tid = threadIdx.x, wid = __builtin_amdgcn_readfirstlane(tid >> 6), lane = tid & 63, wr = wid >> 2, wc = wid & 3, fr = lane & 15, fq = lane >> 4;
    const int K = g.K, nt = K / BK;
    unsigned voffA[2], voffB[2];
#pragma unroll
    for (int i = 0; i < 2; ++i) { int R, C; stage_rc(tid * 16 + i * 8192, R, C); const int Rb = Epi::PERM ? ((R & ~31) + perm32(R & 31)) : R;
        voffA[i] = (unsigned)(R * K + C) * 2u; voffB[i] = (unsigned)(Rb * K + C) * 2u; }
    const size_t kstep = (size_t)(BK * 2);
    const size_t hstep = (size_t)HALF * K * 2;
    const size_t tstep = 2 * hstep;
    const unsigned ldsw = (unsigned)wid * 1024u;
    const int aoff = lds_byte(wr * 64 + fr, fq * 8), boff = lds_byte(wc * 32 + fr, fq * 8);
#define PG8_SA(b, h) (((b) * 2 + (h)) * HTB)
#define PG8_SB(b, h) ((4 + (b) * 2 + (h)) * HTB)
#define PG8_STAGE(bufoff, gbase, voff) do { _Pragma("unroll") for (int _i = 0; _i < 2; ++_i) \
        __builtin_amdgcn_global_load_lds((const unsigned*)((const char*)(gbase) + (voff)[_i]), (PG8_LAS unsigned*)(lds + (bufoff) + ldsw + _i * 8192), 16, 0, 0); } while (0)
#define PG8_LDA(dst, b, h) do { _Pragma("unroll") for (int m = 0; m < 4; ++m) _Pragma("unroll") for (int k = 0; k < 2; ++k) dst[m][k] = *(const PG8_LAS bf16x8*)(lds + PG8_SA(b, h) + aoff + m * 2048 + k * 1024); } while (0)
#define PG8_LDB(dst, b, h) do { _Pragma("unroll") for (int n = 0; n < 2; ++n) _Pragma("unroll") for (int k = 0; k < 2; ++k) dst[n][k] = *(const PG8_LAS bf16x8*)(lds + PG8_SB(b, h) + boff + n * 2048 + k * 1024); } while (0)
#define PG8_MMA(ai, bj, At, Bt) do { __builtin_amdgcn_s_setprio(1); _Pragma("unroll") for (int m = 0; m < 4; ++m) _Pragma("unroll") for (int n = 0; n < 2; ++n) _Pragma("unroll") for (int k = 0; k < 2; ++k) \
        acc[ai][bj][m][n] = __builtin_amdgcn_mfma_f32_16x16x32_bf16(Bt[n][k], At[m][k], acc[ai][bj][m][n], 0, 0, 0); __builtin_amdgcn_s_setprio(0); } while (0)
#define PG8_WAIT_V(n) asm volatile("s_waitcnt vmcnt(" #n ")" ::: "memory")
#define PG8_WAIT_L(n) asm volatile("s_waitcnt lgkmcnt(" #n ")" ::: "memory")
#define PG8_BAR __builtin_amdgcn_s_barrier()
#define PG8_SCHED __builtin_amdgcn_sched_barrier(0)
    Unit cur, nxt; int ui = 0;
    if (!S.next(0, cur)) return;
    f32x4 acc[2][2][4][2];
#pragma unroll
    for (int a = 0; a < 2; ++a)
#pragma unroll
        for (int b = 0; b < 2; ++b)
#pragma unroll
            for (int m = 0; m < 4; ++m)
#pragma unroll
                for (int n = 0; n < 2; ++n) acc[a][b][m][n] = (f32x4){0.f, 0.f, 0.f, 0.f};
    bf16x8 At[4][2], B0[2][2], B1[2][2];
    const char* cA = S.abase(g, cur, tstep); const char* cB = S.bbase(g, cur, tstep);
    S.a_ready(cur);
    if constexpr (SP2) {
        PG8_STAGE(PG8_SB(0, 0), cB, voffB); PG8_STAGE(PG8_SB(0, 1), cB + hstep, voffB); PG8_STAGE(PG8_SA(0, 0), cA, voffA); PG8_STAGE(PG8_SA(0, 1), cA + hstep, voffA);
        if (wr == 1) PG8_BAR;
        PG8_WAIT_V(2); PG8_BAR;
        PG8_STAGE(PG8_SB(1, 0), cB + kstep, voffB); PG8_STAGE(PG8_SA(1, 0), cA + kstep, voffA); PG8_STAGE(PG8_SB(1, 1), cB + hstep + kstep, voffB);
        PG8_WAIT_V(6); PG8_BAR;
    } else {
        PG8_STAGE(PG8_SB(0, 0), cB, voffB); PG8_STAGE(PG8_SA(0, 0), cA, voffA); PG8_STAGE(PG8_SB(0, 1), cB + hstep, voffB); PG8_STAGE(PG8_SA(0, 1), cA + hstep, voffA);
        if (wr == 1) PG8_BAR;
        PG8_WAIT_V(4); PG8_BAR;
        PG8_STAGE(PG8_SB(1, 0), cB + kstep, voffB); PG8_STAGE(PG8_SA(1, 0), cA + kstep, voffA); PG8_STAGE(PG8_SB(1, 1), cB + hstep + kstep, voffB);
        PG8_WAIT_V(6); PG8_BAR;
    }
    for (;;) {
        const bool has_next = S.next(ui + 1, nxt);
        const char* nA = has_next ? S.abase(g, nxt, tstep) : cA; const char* nB = has_next ? S.bbase(g, nxt, tstep) : cB;
        _Pragma("unroll 1") for (int t = 0; t < nt; t += 2) {
            const bool last = (t == nt - 2);
            const char* a1 = cA + (size_t)(t + 1) * kstep;
            const char* a2 = last ? nA : cA + (size_t)(t + 2) * kstep; const char* b2 = last ? nB : cB + (size_t)(t + 2) * kstep;
            const char* a3 = a2 + kstep; const char* b3 = b2 + kstep;
            if (last && has_next) S.a_ready(nxt);
            if constexpr (SP2) {
            PG8_LDB(B0, 0, 0); PG8_LDB(B1, 0, 1); PG8_SCHED; PG8_LDA(At, 0, 0); PG8_STAGE(PG8_SA(1, 1), a1 + hstep, voffA);
            PG8_WAIT_V(8); PG8_WAIT_L(0); PG8_BAR; PG8_MMA(0, 0, At, B0); PG8_MMA(0, 1, At, B1); PG8_BAR; PG8_SCHED;
            PG8_LDA(At, 0, 1); PG8_STAGE(PG8_SB(0, 0), b2, voffB); PG8_STAGE(PG8_SB(0, 1), b2 + hstep, voffB); PG8_STAGE(PG8_SA(0, 0), a2, voffA);
            PG8_WAIT_V(8); PG8_WAIT_L(0); PG8_BAR; PG8_MMA(1, 0, At, B0); PG8_MMA(1, 1, At, B1); PG8_BAR; PG8_SCHED;
            PG8_LDB(B0, 1, 0); PG8_LDB(B1, 1, 1); PG8_SCHED; PG8_LDA(At, 1, 0); PG8_STAGE(PG8_SA(0, 1), a2 + hstep, voffA);
            PG8_WAIT_V(8); PG8_WAIT_L(0); PG8_BAR; PG8_MMA(0, 0, At, B0); PG8_MMA(0, 1, At, B1); PG8_BAR; PG8_SCHED;
            PG8_LDA(At, 1, 1); PG8_STAGE(PG8_SB(1, 0), b3, voffB); PG8_STAGE(PG8_SB(1, 1), b3 + hstep, voffB); PG8_STAGE(PG8_SA(1, 0), a3, voffA);
            PG8_WAIT_V(8); PG8_WAIT_L(0); PG8_BAR; PG8_MMA(1, 0, At, B0); PG8_MMA(1, 1, At, B1); PG8_BAR; PG8_SCHED;
            } else {
            PG8_LDB(B0, 0, 0); PG8_SCHED; PG8_LDA(At, 0, 0); PG8_STAGE(PG8_SA(1, 1), a1 + hstep, voffA);
            PG8_WAIT_L(8); PG8_BAR; PG8_WAIT_L(0); PG8_MMA(0, 0, At, B0); PG8_BAR; PG8_SCHED;
            PG8_LDB(B1, 0, 1); PG8_STAGE(PG8_SB(0, 0), b2, voffB);
            PG8_BAR; PG8_WAIT_L(0); PG8_MMA(0, 1, At, B1); PG8_BAR;
            PG8_LDA(At, 0, 1); PG8_STAGE(PG8_SA(0, 0), a2, voffA);
            PG8_BAR; PG8_WAIT_L(0); PG8_MMA(1, 0, At, B0); PG8_BAR; PG8_SCHED;
            PG8_STAGE(PG8_SB(0, 1), b2 + hstep, voffB);
            PG8_WAIT_V(6); PG8_BAR; PG8_MMA(1, 1, At, B1); PG8_BAR;
            PG8_LDB(B0, 1, 0); PG8_SCHED; PG8_LDA(At, 1, 0); PG8_STAGE(PG8_SA(0, 1), a2 + hstep, voffA);
            PG8_WAIT_L(8); PG8_BAR; PG8_WAIT_L(0); PG8_MMA(0, 0, At, B0); PG8_BAR; PG8_SCHED;
            PG8_LDB(B1, 1, 1); PG8_STAGE(PG8_SB(1, 0), b3, voffB);
            PG8_BAR; PG8_WAIT_L(0); PG8_MMA(0, 1, At, B1); PG8_BAR;
            PG8_LDA(At, 1, 1); PG8_STAGE(PG8_SA(1, 0), a3, voffA);
            PG8_BAR; PG8_WAIT_L(0); PG8_MMA(1, 0, At, B0); PG8_BAR; PG8_SCHED;
            PG8_STAGE(PG8_SB(1, 1), b3 + hstep, voffB);
            PG8_WAIT_V(6); PG8_BAR; PG8_MMA(1, 1, At, B1); PG8_BAR;
            }
        }
        if constexpr (ALIGN_EPI) { if (wr == 0) PG8_BAR; }
        if constexpr (!Epi::AFTER_DRAIN) { E(acc, cur, wr, wc, fr, fq); S.done(cur); }
        if (!has_next) break;
#pragma unroll
        for (int a = 0; a < 2; ++a)
#pragma unroll
            for (int b = 0; b < 2; ++b)
#pragma unroll
                for (int m = 0; m < 4; ++m)
#pragma unroll
                    for (int n = 0; n < 2; ++n) acc[a][b][m][n] = (f32x4){0.f, 0.f, 0.f, 0.f};
        cur = nxt; cA = nA; cB = nB; ++ui;
        if constexpr (ALIGN_EPI) { if (wr == 1) PG8_BAR; }
    }
    PG8_WAIT_V(0);
    if constexpr (!ALIGN_EPI) { if (wr == 0) PG8_BAR; }
    PG8_BAR;
    if constexpr (Epi::AFTER_DRAIN) { E.fused(acc, cur, wr, wc, fr, fq, lds, wid, lane); S.done(cur); }
#undef PG8_SA
#undef PG8_SB
#undef PG8_STAGE
#undef PG8_LDA
#undef PG8_LDB
#undef PG8_MMA
#undef PG8_WAIT_V
#undef PG8_WAIT_L
#undef PG8_BAR
#undef PG8_SCHED
}
}

constexpr int D = 1024, NBATCH = 2, SEQ = 8192, CTXL = 256;
constexpr int NLAT = NBATCH * SEQ, NCTX = NBATCH * CTXL, NROW = NLAT + NCTX;
constexpr int NE = 32, TOPK = 4, MAXTILES = 296, CAP = MAXTILES * 256;
constexpr int NWAVES = 8, NTHREADS = 512;
constexpr float NORM_EPS = 1e-6f;
constexpr int LDS_BYTES = 147456;

constexpr size_t MiB = 1u << 20;
constexpr size_t WS_CTL = 0, CTL_ZERO_BYTES = 1 * MiB;
constexpr size_t WS_MOD = 1 * MiB;
constexpr size_t WS_ROUTE = 2 * MiB;
constexpr size_t RT_TOPI = 0, RT_TOPG = 320 * 1024, RT_POS = 640 * 1024, RT_SLOT = 960 * 1024, RT_RSTD = 1280 * 1024, RT_TILEE = 1408 * 1024;
constexpr size_t WS_WIN = 4 * MiB, WS_WHGO = 14 * MiB, WS_WRKV = 16 * MiB, WS_WL1 = 22 * MiB, WS_WL2 = 24 * MiB, WS_WRWO = 28 * MiB;
constexpr size_t WS_WGU = 32 * MiB, WS_WD = 288 * MiB;
constexpr size_t WS_XR = 416 * MiB, WS_H = 482 * MiB, WS_H2 = 515 * MiB, WS_A2 = 548 * MiB;
constexpr size_t WS_U = 584 * MiB;
constexpr size_t U_Z = 0, U_OD0 = 166 * MiB;
constexpr size_t U_XL6 = 0, U_RKV = 198 * MiB, U_L1 = 396 * MiB, U_WD = 410 * MiB, U_AD = 542 * MiB, U_G = 674 * MiB, U_OD1 = 740 * MiB;
constexpr size_t U_XB = 0, U_ACT = 148 * MiB, U_YS = 296 * MiB;
constexpr size_t WS_END = WS_U + 1320 * MiB;
constexpr int CW_CNT = 16384, CNT_STRIDE = 64;
constexpr int CW_NT = 128;
constexpr int CW_TOF = 8192, TOF_PER = 72;
constexpr int CW_BAR = 4096;

#define LAS __attribute__((address_space(3)))
typedef unsigned short bf16;
typedef unsigned v4u __attribute__((ext_vector_type(4)));
typedef unsigned v2u __attribute__((ext_vector_type(2)));
typedef float f32x4 __attribute__((ext_vector_type(4)));
#define LDS_WAIT() asm volatile("s_waitcnt lgkmcnt(0)" ::: "memory")
typedef float f32x2c __attribute__((ext_vector_type(2))); typedef __bf16 bf16x2c __attribute__((ext_vector_type(2)));
__device__ __forceinline__ unsigned pk2(float lo, float hi) { const f32x2c v = {lo, hi}; const bf16x2c b = __builtin_convertvector(v, bf16x2c); return __builtin_bit_cast(unsigned, b); }
__device__ __forceinline__ unsigned f2bf(float f) { return pk2(f, 0.f) & 0xffffu; }
__device__ __forceinline__ float bf2f(unsigned b) { return __builtin_bit_cast(float, b << 16); }
__device__ __forceinline__ float wave_sum(float x) {
    x += __builtin_bit_cast(float, __builtin_amdgcn_update_dpp(0, __builtin_bit_cast(int, x), 0x128, 0xf, 0xf, false));
    x += __builtin_bit_cast(float, __builtin_amdgcn_update_dpp(0, __builtin_bit_cast(int, x), 0x124, 0xf, 0xf, false));
    x += __builtin_bit_cast(float, __builtin_amdgcn_update_dpp(0, __builtin_bit_cast(int, x), 0x122, 0xf, 0xf, false));
    x += __builtin_bit_cast(float, __builtin_amdgcn_update_dpp(0, __builtin_bit_cast(int, x), 0x121, 0xf, 0xf, false));
    x += __shfl_xor(x, 16); x += __shfl_xor(x, 32);
    return x;
}
__device__ __forceinline__ float sigm(float x) { return __builtin_amdgcn_rcpf(1.0f + __expf(-x)); }

struct Params { const float* in[35]; float* out; unsigned char* ws; int ph_lo, ph_hi; };
typedef const __attribute__((address_space(4))) Params* PP;
enum { I_X = 0, I_C, I_CTX, I_CCTX, I_ADAW, I_ADAB, I_NMIX, I_NFFN, I_HGWIN, I_HGGN, I_HGWOUT, I_HGLB, I_MU, I_WRKV, I_DECW0, I_DECW1, I_DECW2,
       I_A0, I_A1, I_A2, I_G1, I_G2, I_KK, I_KA, I_RK, I_LNXW, I_LNXB, I_RWOUT, I_ROUTW, I_ROUTB, I_WGU, I_BGU, I_WDN, I_BDN, I_FINALG };

__device__ __forceinline__ const float* modp(PP p, int l, int v, int j) { return (const float*)(p->ws + WS_MOD) + ((size_t)(l * 3 + v) * 6 + j) * D; }
__device__ __forceinline__ int row_vec(int row) { return row < NLAT ? (row >= SEQ ? 1 : 0) : 2; }

__device__ __forceinline__ void ti_load(const float* src, int src_ld, int lane, float (&rg)[32]) {
    if (src) {
#pragma unroll
        for (int i = 0; i < 32; ++i) rg[i] = src[(size_t)(2 * i + (lane >> 5)) * src_ld + (lane & 31)];
    }
}
__device__ __forceinline__ void ti_store(bool nonzero, const float (&rg)[32], bf16* dst, int dst_ld, LAS float* scr, int lane) {
    if (nonzero) {
#pragma unroll
        for (int i = 0; i < 32; ++i) scr[(2 * i + (lane >> 5)) * 33 + (lane & 31)] = rg[i];
    }
    LDS_WAIT(); asm volatile("" ::: "memory");
    const int c = lane & 7;
#pragma unroll
    for (int j = 0; j < 4; ++j) {
        const int n = (lane >> 3) + 8 * j; v4u o = (v4u){0u, 0u, 0u, 0u};
        if (nonzero) { const LAS float* s = scr + (8 * c) * 33 + n;
            o.x = pk2(s[0 * 33], s[1 * 33]); o.y = pk2(s[2 * 33], s[3 * 33]); o.z = pk2(s[4 * 33], s[5 * 33]); o.w = pk2(s[6 * 33], s[7 * 33]); }
        *(v4u*)(dst + (size_t)n * dst_ld + 8 * c) = o;
    }
    LDS_WAIT(); asm volatile("" ::: "memory");
}
__device__ __forceinline__ void transpose_item(const float* src, int src_ld, bf16* dst, int dst_ld, LAS float* scr, int lane) {
    float rg[32]; ti_load(src, src_ld, lane, rg); ti_store(src != nullptr, rg, dst, dst_ld, scr, lane);
}
struct ConvJob { const float* src; int src_ld; bf16* dst; int dst_ld; };
__device__ __forceinline__ ConvJob job_plain(const float* W, int K, int N, bf16* WT, int r) {
    const int nblk = N / 32, kb = r / nblk, nb = r % nblk;
    return ConvJob{W + (size_t)(kb * 64) * N + nb * 32, N, WT + (size_t)(nb * 32) * K + kb * 64, K};
}
constexpr int IT_WIN = 16 * 160, IT_SQ = 16 * 32, IT_L1 = 16 * 24, IT_L2 = 160 * 6, IT_GU = 64 * 16 * 64, IT_DN = 64 * 16 * 32;
constexpr int IT_GU0 = IT_GU / 2, IT_DN0 = IT_DN / 2;
constexpr int IT_TOTAL = IT_WIN + IT_SQ + 3 * IT_SQ + IT_SQ + IT_L1 + IT_L2 + IT_GU0 + IT_DN0, IT_L1MOE = IT_GU0 + IT_DN0;
__device__ __forceinline__ ConvJob conv_job(PP p, int it) {
    unsigned char* ws = p->ws; int r = it;
    if (r < IT_WIN) return job_plain(p->in[I_HGWIN], D, 5120, (bf16*)(ws + WS_WIN), r); r -= IT_WIN;
    if (r < IT_SQ) return job_plain(p->in[I_HGWOUT], D, D, (bf16*)(ws + WS_WHGO), r); r -= IT_SQ;
    if (r < 3 * IT_SQ) { const int j = r / IT_SQ; return job_plain(p->in[I_WRKV] + (size_t)j * D * D, D, D, (bf16*)(ws + WS_WRKV) + (size_t)j * D * D, r % IT_SQ); } r -= 3 * IT_SQ;
    if (r < IT_SQ) return job_plain(p->in[I_RWOUT], D, D, (bf16*)(ws + WS_WRWO), r); r -= IT_SQ;
    if (r < IT_L1) {
        const int kb = r / 24, rg = r % 24, tile = rg >> 3, within = rg & 7; const float* src = nullptr; int ld = 64;
        if (within < 4) {
            if (tile == 0) src = p->in[I_DECW1] + (size_t)(within >> 1) * D * 64 + (size_t)(kb * 64) * 64 + (within & 1) * 32;
            else if (tile == 1) src = p->in[I_A1] + (size_t)(within >> 1) * D * 64 + (size_t)(kb * 64) * 64 + (within & 1) * 32;
            else { src = p->in[I_G1] + (size_t)(kb * 64) * 128 + within * 32; ld = 128; }
        }
        return ConvJob{src, ld, (bf16*)(ws + WS_WL1) + (size_t)(rg * 32) * D + kb * 64, D}; } r -= IT_L1;
    if (r < IT_L2) {
        const int rg = r / 6, kb = r % 6, n0 = rg * 32, blk = n0 >> 10, nn0 = n0 & 1023; const float* src = nullptr;
        if (blk < 2) { if (kb == blk) src = p->in[I_DECW2] + (size_t)blk * 64 * D + nn0; }
        else if (blk < 4) { if (kb == blk) src = p->in[I_A2] + (size_t)(blk - 2) * 64 * D + nn0; }
        else { if (kb >= 4) src = p->in[I_G2] + (size_t)(kb - 4) * 64 * D + nn0; }
        return ConvJob{src, D, (bf16*)(ws + WS_WL2) + (size_t)n0 * 384 + kb * 64, 384}; } r -= IT_L2;
    if (r < IT_GU0) {
        const int mat = r >> 10, q = r & 1023, kb = q >> 6, nb = q & 63, n0 = nb * 32;
        const int j0 = n0 & 1023, drow = 256 * (j0 >> 7) + (n0 >= 1024 ? 128 : 0) + (j0 & 127);
        return ConvJob{p->in[I_WGU] + (size_t)mat * D * 2048 + (size_t)(kb * 64) * 2048 + n0, 2048, (bf16*)(ws + WS_WGU) + (size_t)mat * 2048 * D + (size_t)drow * D + kb * 64, D}; } r -= IT_GU0;
    { const int mat = r >> 9, q = r & 511; return job_plain(p->in[I_WDN] + (size_t)mat * D * D, D, D, (bf16*)(ws + WS_WD) + (size_t)mat * D * D, q); }
}
__device__ __forceinline__ ConvJob conv_job_l1(PP p, int r) {
    unsigned char* ws = p->ws; ConvJob j;
    if (r < IT_GU0) { const int mat = 32 + (r >> 10), q = r & 1023, kb = q >> 6, nb = q & 63, n0 = nb * 32;
        const int j0 = n0 & 1023, drow = 256 * (j0 >> 7) + (n0 >= 1024 ? 128 : 0) + (j0 & 127);
        j.src = p->in[I_WGU] + (size_t)mat * D * 2048 + (size_t)(kb * 64) * 2048 + n0; j.src_ld = 2048;
        j.dst = (bf16*)(ws + WS_WGU) + (size_t)mat * 2048 * D + (size_t)drow * D + kb * 64; j.dst_ld = D; return j; }
    r -= IT_GU0;
    { const int mat = 32 + (r >> 9), q = r & 511, kb = q >> 5, nb = q & 31;
      j.src = p->in[I_WDN] + (size_t)mat * D * D + (size_t)(kb * 64) * D + nb * 32; j.src_ld = D;
      j.dst = (bf16*)(ws + WS_WD) + (size_t)mat * D * D + (size_t)(nb * 32) * D + kb * 64; j.dst_ld = D; return j; }
}
__device__ __forceinline__ void phase_pre(PP p, LAS unsigned char* lds, int tid, int lane, int wave) {
    if (blockIdx.x < 192) {
        const int layer = blockIdx.x / 96, col = (blockIdx.x % 96) * 64 + lane;
        const float* W = p->in[I_ADAW] + (size_t)layer * D * 6144 + col;
        const float* c = p->in[I_C]; const float* cc = p->in[I_CCTX];
        float a0 = 0.f, a1 = 0.f, a2 = 0.f;
#pragma unroll 8
        for (int k = wave * 128; k < wave * 128 + 128; ++k) {
            const float wv = W[(size_t)k * 6144]; const float c0 = c[k], c1 = c[D + k], c2 = cc[k];
            a0 += c0 * sigm(c0) * wv; a1 += c1 * sigm(c1) * wv; a2 += c2 * sigm(c2) * wv;
        }
        LAS float* red = (LAS float*)lds;
        red[(wave * 3 + 0) * 64 + lane] = a0; red[(wave * 3 + 1) * 64 + lane] = a1; red[(wave * 3 + 2) * 64 + lane] = a2;
        __syncthreads();
        if (wave == 0) {
            float s0 = 0.f, s1 = 0.f, s2 = 0.f;
#pragma unroll
            for (int w = 0; w < 8; ++w) { s0 += red[(w * 3 + 0) * 64 + lane]; s1 += red[(w * 3 + 1) * 64 + lane]; s2 += red[(w * 3 + 2) * 64 + lane]; }
            const float bb = p->in[I_ADAB][layer * 6144 + col];
            float* M = (float*)(p->ws + WS_MOD) + (size_t)layer * 3 * 6144 + col;
            M[0] = s0 + bb; M[6144] = s1 + bb; M[2 * 6144] = s2 + bb;
        }
        __syncthreads();
    }
    LAS float* scr = (LAS float*)(lds + wave * 16384);
    const int gw = blockIdx.x * NWAVES + wave, NGW = gridDim.x * NWAVES;
    ConvJob nj{}; float nrg[32];
    if (gw < IT_TOTAL) { nj = conv_job(p, gw); ti_load(nj.src, nj.src_ld, lane, nrg); }
    for (int it = gw; it < IT_TOTAL; it += NGW) {
        const ConvJob cj = nj; float crg[32];
#pragma unroll
        for (int i = 0; i < 32; ++i) crg[i] = nrg[i];
        if (it + NGW < IT_TOTAL) { nj = conv_job(p, it + NGW); ti_load(nj.src, nj.src_ld, lane, nrg); }
        ti_store(cj.src != nullptr, crg, cj.dst, cj.dst_ld, scr, lane);
    }
}

__device__ __forceinline__ void load_row(const float* row, int lane, f32x4 (&v)[4]) {
#pragma unroll
    for (int j = 0; j < 4; ++j) v[j] = ((const f32x4*)row)[lane + 64 * j];
}
__device__ __forceinline__ float row_rstd(const f32x4 (&v)[4]) {
    float s = 0.f;
#pragma unroll
    for (int j = 0; j < 4; ++j) s += (v[j].x * v[j].x + v[j].y * v[j].y) + (v[j].z * v[j].z + v[j].w * v[j].w);
    return rsqrtf(wave_sum(s) * (1.0f / D) + NORM_EPS);
}
__device__ __forceinline__ void norm_mod(const f32x4 (&v)[4], float rstd, const float* g, const float* shift, const float* scale, int lane, f32x4 (&h)[4]) {
#pragma unroll
    for (int j = 0; j < 4; ++j) {
        const f32x4 gg = ((const f32x4*)g)[lane + 64 * j], sh = ((const f32x4*)shift)[lane + 64 * j], sc = ((const f32x4*)scale)[lane + 64 * j];
        h[j] = v[j] * rstd * gg * (sc + 1.0f) + sh;
    }
}
__device__ __forceinline__ void store_row_bf16(bf16* row, int lane, const f32x4 (&h)[4]) {
#pragma unroll
    for (int j = 0; j < 4; ++j) { v2u w; w.x = pk2(h[j].x, h[j].y); w.y = pk2(h[j].z, h[j].w); ((v2u*)row)[lane + 64 * j] = w; }
}
__device__ __forceinline__ const float* resid_row(PP p, int layer0_inputs, int row) {
    if (layer0_inputs) return row < NLAT ? p->in[I_X] + (size_t)row * D : p->in[I_CTX] + (size_t)(row - NLAT) * D;
    return (const float*)(p->ws + WS_XR) + (size_t)row * D;
}
__device__ __forceinline__ void phase_norm0(PP p, int lane, int wave) {
    const int gw = blockIdx.x * NWAVES + wave, NGW = gridDim.x * NWAVES;
    for (int row = gw; row < NROW; row += NGW) {
        f32x4 v[4], h[4]; load_row(resid_row(p, 1, row), lane, v);
        const float rstd = row_rstd(v); const int vec = row_vec(row);
        norm_mod(v, rstd, p->in[I_NMIX], modp(p, 0, vec, 0), modp(p, 0, vec, 1), lane, h);
        store_row_bf16((bf16*)(p->ws + WS_H) + (size_t)row * D, lane, h);
    }
}
__device__ __forceinline__ void route_select(float (&part)[NE], const float* rb, int row, float* TOPG, int* SLOT, unsigned* cnt, unsigned* ntl, unsigned* tof, int* TILEE, int lane, bool write, int (&slot)[TOPK]) {
#pragma unroll
    for (int e = 0; e < NE; ++e) part[e] = part[e] + rb[e];
    unsigned taken = 0u; int idx[TOPK]; float val[TOPK];
#pragma unroll
    for (int k = 0; k < TOPK; ++k) {
        float best = -3.0e38f; int bi = 0;
#pragma unroll
        for (int e = 0; e < NE; ++e) { const bool ok = !((taken >> e) & 1u) && (part[e] > best); best = ok ? part[e] : best; bi = ok ? e : bi; }
        taken |= 1u << bi; idx[k] = bi; val[k] = best;
    }
    float ex[TOPK], se = 0.f;
#pragma unroll
    for (int k = 0; k < TOPK; ++k) { ex[k] = __expf(val[k] - val[0]); se += ex[k]; }
    int sl[TOPK] = {0, 0, 0, 0};
    if (lane == 0 && write) {
        unsigned pos[TOPK]; int til[TOPK];
#pragma unroll
        for (int k = 0; k < TOPK; ++k) pos[k] = atomicAdd(cnt + idx[k] * CNT_STRIDE, 1u);
#pragma unroll
        for (int k = 0; k < TOPK; ++k) { til[k] = -1;
            if ((pos[k] & 255u) == 0u) { const unsigned t = atomicAdd(ntl, 1u); til[k] = (int)t; TILEE[1 + t] = idx[k];
                __hip_atomic_store(tof + idx[k] * TOF_PER + (pos[k] >> 8), t + 1u, __ATOMIC_RELAXED, __HIP_MEMORY_SCOPE_AGENT); } }
#pragma unroll
        for (int k = 0; k < TOPK; ++k) {
            if (til[k] < 0) { unsigned t1 = 0u, spins = 0u;
                while ((t1 = __hip_atomic_load(tof + idx[k] * TOF_PER + (pos[k] >> 8), __ATOMIC_RELAXED, __HIP_MEMORY_SCOPE_AGENT)) == 0u && ++spins < (1u << 22)) __builtin_amdgcn_s_sleep(1);
                til[k] = (int)t1 - 1; if (til[k] < 0) til[k] = 0; }
            sl[k] = til[k] * 256 + (int)(pos[k] & 255u);
            SLOT[row * 4 + k] = sl[k]; TOPG[row * 4 + k] = ex[k] * __builtin_amdgcn_rcpf(se);
        }
    }
#pragma unroll
    for (int k = 0; k < TOPK; ++k) slot[k] = __builtin_amdgcn_readfirstlane(sl[k]);
}
__device__ __forceinline__ void phase_ffn_norm_route(PP p, int layer, int nrows, LAS unsigned char* lds, int lane, int wave) {
    const int gw = blockIdx.x * NWAVES + wave, NGW = gridDim.x * NWAVES;
    const float* rw = p->in[I_ROUTW] + (size_t)layer * D * NE; const float* rb = p->in[I_ROUTB] + layer * NE;
    float* TOPG = (float*)(p->ws + WS_ROUTE + RT_TOPG); int* SLOT = (int*)(p->ws + WS_ROUTE + RT_SLOT); int* TILEE = (int*)(p->ws + WS_ROUTE + RT_TILEE) + layer * 512;
    unsigned* ctl = (unsigned*)(p->ws + WS_CTL); unsigned* cnt = ctl + CW_CNT + layer * NE * CNT_STRIDE; unsigned* ntl = ctl + CW_NT + layer; unsigned* tof = ctl + CW_TOF + layer * NE * TOF_PER;
    bf16* XB = (bf16*)(p->ws + WS_U + U_XB);
    LAS float* hs = (LAS float*)(lds + wave * 8704);
    for (int row0 = gw; row0 < nrows; row0 += 2 * NGW) {
        const bool has1 = row0 + NGW < nrows; const int row1 = has1 ? row0 + NGW : row0;
#pragma unroll
        for (int r = 0; r < 2; ++r) { const int row = r ? row1 : row0;
            f32x4 v[4], h[4]; load_row((const float*)(p->ws + WS_XR) + (size_t)row * D, lane, v); const float rstd = row_rstd(v); const int vec = row_vec(row);
            norm_mod(v, rstd, p->in[I_NFFN] + layer * D, modp(p, layer, vec, 3), modp(p, layer, vec, 4), lane, h);
#pragma unroll
            for (int j = 0; j < 4; ++j)
#pragma unroll
                for (int i = 0; i < 4; ++i) hs[r * 1024 + (4 * j + i) * 64 + lane] = h[j][i]; }
        LDS_WAIT(); asm volatile("" ::: "memory");
        float pa[NE], pb[NE];
        {
            const int e4 = lane & 7, kq = lane >> 3;
            f32x4 qa = (f32x4){0.f, 0.f, 0.f, 0.f}, qb = (f32x4){0.f, 0.f, 0.f, 0.f};
#pragma unroll 4
            for (int t = 0; t < 32; ++t) {
                const int u = kq + 8 * t, l = u & 63, j = u >> 6;
                const f32x4* wr = (const f32x4*)(rw + (size_t)(4 * u) * NE) + e4;
#pragma unroll
                for (int i = 0; i < 4; ++i) { const f32x4 w4 = wr[i * (NE / 4)]; const float x0 = hs[(4 * j + i) * 64 + l], x1 = hs[1024 + (4 * j + i) * 64 + l];
                    qa = qa + x0 * w4; qb = qb + x1 * w4; }
            }
#pragma unroll
            for (int o = 8; o < 64; o <<= 1) {
#pragma unroll
                for (int c = 0; c < 4; ++c) { qa[c] += __shfl_xor(qa[c], o); qb[c] += __shfl_xor(qb[c], o); } }
            LAS float* lg = hs + 2048;
            if (kq == 0) { *(LAS f32x4*)(lg + 4 * e4) = qa; *(LAS f32x4*)(lg + 32 + 4 * e4) = qb; }
            LDS_WAIT(); asm volatile("" ::: "memory");
#pragma unroll
            for (int q4 = 0; q4 < 8; ++q4) { const f32x4 va = *(const LAS f32x4*)(lg + 4 * q4), vb = *(const LAS f32x4*)(lg + 32 + 4 * q4);
#pragma unroll
                for (int c = 0; c < 4; ++c) { pa[4 * q4 + c] = va[c]; pb[4 * q4 + c] = vb[c]; } }
        }
        int s0[TOPK], s1[TOPK];
        route_select(pa, rb, row0, TOPG, SLOT, cnt, ntl, tof, TILEE, lane, true, s0);
        route_select(pb, rb, row1, TOPG, SLOT, cnt, ntl, tof, TILEE, lane, has1, s1);
#pragma unroll
        for (int r = 0; r < 2; ++r) { if (r == 1 && !has1) break;
            v2u w[4];
#pragma unroll
            for (int j = 0; j < 4; ++j) { const LAS float* hp = hs + r * 1024 + (4 * j) * 64 + lane; w[j].x = pk2(hp[0], hp[64]); w[j].y = pk2(hp[128], hp[192]); }
#pragma unroll
            for (int k = 0; k < TOPK; ++k) { v2u* d = (v2u*)(XB + (size_t)(r ? s1[k] : s0[k]) * D);
#pragma unroll
                for (int j = 0; j < 4; ++j) d[lane + 64 * j] = w[j]; } }
        LDS_WAIT(); asm volatile("" ::: "memory");
    }
}
__device__ __forceinline__ void phase_combine(PP p, int layer, int nrows, bool final_out, int lane, int wave) {
    const int gw = blockIdx.x * NWAVES + wave, NGW = gridDim.x * NWAVES;
    const float* TOPG = (const float*)(p->ws + WS_ROUTE + RT_TOPG); const int* SLOT = (const int*)(p->ws + WS_ROUTE + RT_SLOT);
    const bf16* YS = (const bf16*)(p->ws + WS_U + U_YS); float* XR = (float*)(p->ws + WS_XR); float* RSTD = (float*)(p->ws + WS_ROUTE + RT_RSTD);
    for (int row = gw; row < nrows; row += NGW) {
        f32x4 v[4], acc[4]; load_row(XR + (size_t)row * D, lane, v);
#pragma unroll
        for (int j = 0; j < 4; ++j) acc[j] = (f32x4){0.f, 0.f, 0.f, 0.f};
#pragma unroll
        for (int k = 0; k < TOPK; ++k) {
            const float gk = TOPG[row * 4 + k]; const v2u* ys = (const v2u*)(YS + (size_t)SLOT[row * 4 + k] * D);
#pragma unroll
            for (int j = 0; j < 4; ++j) { const v2u w = ys[lane + 64 * j];
                acc[j].x += gk * bf2f(w.x & 0xffffu); acc[j].y += gk * bf2f(w.x >> 16); acc[j].z += gk * bf2f(w.y & 0xffffu); acc[j].w += gk * bf2f(w.y >> 16); }
        }
        const float* m5 = modp(p, layer, row_vec(row), 5);
#pragma unroll
        for (int j = 0; j < 4; ++j) v[j] = v[j] + ((const f32x4*)m5)[lane + 64 * j] * acc[j];
        const float rstd = row_rstd(v);
        if (final_out) {
#pragma unroll
            for (int j = 0; j < 4; ++j) ((f32x4*)(p->out + (size_t)row * D))[lane + 64 * j] = v[j] * rstd * ((const f32x4*)p->in[I_FINALG])[lane + 64 * j];
        } else {
#pragma unroll
            for (int j = 0; j < 4; ++j) ((f32x4*)(XR + (size_t)row * D))[lane + 64 * j] = v[j];
            if (lane == 0) RSTD[row] = rstd;
        }
    }
}

__device__ __forceinline__ int step_row(int b, int dir, int step) {
    if (step < CTXL) { const int t = dir ? (CTXL - 1 - step) : step; return NLAT + b * CTXL + t; }
    const int s = step - CTXL; const int t = dir ? (SEQ - 1 - s) : s; return b * SEQ + t;
}
constexpr int NSTEP = CTXL + SEQ;

__device__ __forceinline__ void phase_hg_readout(PP p, int lane, int wave) {
    const int gw = blockIdx.x * NWAVES + wave, NGW = gridDim.x * NWAVES;
    const bf16* Z = (const bf16*)(p->ws + WS_U + U_Z); const float* OD = (const float*)(p->ws + WS_U + U_OD0); bf16* A2 = (bf16*)(p->ws + WS_A2);
    const float* gn = p->in[I_HGGN];
    for (int row = gw; row < NROW; row += NGW) {
#pragma unroll
        for (int h = 0; h < 8; ++h) {
            const int c = h * 128 + 2 * lane;
            const float2 a = *(const float2*)(OD + (size_t)row * D + c), bq = *(const float2*)(OD + (size_t)(NROW + row) * D + c);
            const float o0 = a.x + bq.x, o1 = a.y + bq.y;
            const float rstd = rsqrtf(wave_sum(o0 * o0 + o1 * o1) * (1.0f / 128.0f) + NORM_EPS);
            const unsigned gz = *(const unsigned*)(Z + (size_t)row * 5120 + 4096 + c); const float g0 = bf2f(gz & 0xffffu), g1 = bf2f(gz >> 16);
            const float r0 = o0 * rstd * gn[2 * lane] * (g0 * sigm(g0)), r1 = o1 * rstd * gn[2 * lane + 1] * (g1 * sigm(g1));
            *(unsigned*)(A2 + (size_t)row * D + c) = pk2(r0, r1);
        }
    }
}

__device__ __forceinline__ void phase_lerp(PP p, int lane, int wave) {
    const int gw = blockIdx.x * NWAVES + wave, NGW = gridDim.x * NWAVES;
    const float* XR = (const float*)(p->ws + WS_XR); const float* RSTD = (const float*)(p->ws + WS_ROUTE + RT_RSTD);
    bf16* XL6 = (bf16*)(p->ws + WS_U + U_XL6); const float* g = p->in[I_NMIX] + D; const float* mu = p->in[I_MU];
    for (int row = gw; row < NROW; row += NGW) {
        const int vec = row_vec(row); const float* sh = modp(p, 1, vec, 0); const float* sc = modp(p, 1, vec, 1);
        int nb[4];
        if (row < NLAT) { const int t = row & (SEQ - 1), w = t & 63, r = t >> 6;
            nb[0] = (w >= 1) ? row - 1 : -1; nb[1] = (w < 63) ? row + 1 : -1; nb[2] = (r >= 1) ? row - 64 : -1; nb[3] = (r < SEQ / 64 - 1) ? row + 64 : -1;
        } else { const int t = (row - NLAT) & (CTXL - 1);
            nb[0] = nb[1] = (t >= 1) ? row - 1 : -1; nb[2] = nb[3] = (t < CTXL - 1) ? row + 1 : -1; }
        const float rs = RSTD[row];
#pragma unroll
        for (int j = 0; j < 4; ++j) {
            const int ci = lane + 64 * j;
            const f32x4 gg = ((const f32x4*)g)[ci], s1 = ((const f32x4*)sc)[ci] + 1.0f, s0 = ((const f32x4*)sh)[ci];
            const f32x4 xs = ((const f32x4*)(XR + (size_t)row * D))[ci];
            const f32x4 hs = xs * rs * gg * s1 + s0;
            f32x4 hn = (f32x4){0.f, 0.f, 0.f, 0.f};
            if (nb[j] >= 0) { const f32x4 xn = ((const f32x4*)(XR + (size_t)nb[j] * D))[ci]; hn = xn * RSTD[nb[j]] * gg * s1 + s0; }
            const f32x4 dx = hn - hs;
#pragma unroll
            for (int s = 0; s < 6; ++s) {
                const int m = (s == 0) ? 0 : (s == 1) ? 2 : (s == 2) ? 3 : (s == 3) ? 1 : (s == 4) ? 4 : 5;
                const f32x4 o = hs + dx * ((const f32x4*)(mu + m * D))[ci];
                v2u w; w.x = pk2(o.x, o.y); w.y = pk2(o.z, o.w);
                ((v2u*)(XL6 + ((size_t)s * NROW + row) * D))[ci] = w;
            }
        }
    }
}
__device__ __forceinline__ void phase_rw_readout(PP p, int lane, int wave) {
    const int gw = blockIdx.x * NWAVES + wave, NGW = gridDim.x * NWAVES;
    const bf16* RKV = (const bf16*)(p->ws + WS_U + U_RKV); const bf16* AD = (const bf16*)(p->ws + WS_U + U_AD); const bf16* G = (const bf16*)(p->ws + WS_U + U_G);
    const float* OD = (const float*)(p->ws + WS_U + U_OD1); bf16* A2 = (bf16*)(p->ws + WS_A2);
    for (int row = gw; row < NLAT; row += NGW) {
#pragma unroll 4
        for (int h = 0; h < 16; ++h) {
            const int ch = h * 64 + lane;
            const int bq = row >> 13, tq = row & (SEQ - 1), u0 = ((bq * 32 + h) * 4 + (lane >> 4)), u1 = ((bq * 32 + 16 + h) * 4 + (lane >> 4));
            const float y = OD[((size_t)u0 * NSTEP + CTXL + tq) * 16 + (lane & 15)] + OD[((size_t)u1 * NSTEP + CTXL + (SEQ - 1 - tq)) * 16 + (lane & 15)];
            const float mean = wave_sum(y) * (1.0f / 64.0f); const float d = y - mean; const float var = wave_sum(d * d) * (1.0f / 64.0f);
            float yn = d * rsqrtf(var + 64.0e-5f) * p->in[I_LNXW][ch] + p->in[I_LNXB][ch];
            const float r = bf2f(RKV[(size_t)row * 3072 + ch]), k = bf2f(RKV[(size_t)row * 3072 + 1024 + ch]), v = bf2f(RKV[(size_t)row * 3072 + 2048 + ch]);
            const float ka = p->in[I_KA][ch], rk = p->in[I_RK][ch];
#pragma unroll
            for (int dd = 0; dd < 2; ++dd) { const float a = bf2f(AD[((size_t)dd * NROW + row) * D + ch]); const float kd = k * (1.f + (a - 1.f) * ka);
                yn += wave_sum(r * kd * rk) * v; }
            const float o = yn * bf2f(G[(size_t)row * D + ch]);
            const float o1 = __shfl_down(o, 1);
            if (!(lane & 1)) *(unsigned*)(A2 + (size_t)row * D + ch) = pk2(o, o1);
        }
    }
}

namespace pg8 {
struct SelOrder : StaticOrder {
    int div, sel0; size_t stride;
    __device__ __forceinline__ const char* abase(const Gemm& g, const Unit& u, size_t tstep) const { return (const char*)g.A + (size_t)(sel0 + u.pn / div) * stride + (size_t)u.pm * tstep; }
};
struct RkvL1Order {
    StaticOrder s1, s2; int G, c; const bf16_t* B2; size_t stride;
    __device__ __forceinline__ void init(int M, int G_, int c_, const bf16_t* b2, size_t st) { s1.init(M, 3072, G_, 0); s2.init(M, 768, G_, 0); G = G_; c = c_; B2 = b2; stride = st; }
    __device__ __forceinline__ bool next(int i, Unit& u) const { const long L = (long)i * G + c; if (L < s1.nwg) return s1.at(L, u); if (!s2.at(L - s1.nwg, u)) return false; u.e = 1; return true; }
    __device__ __forceinline__ const char* abase(const Gemm& g, const Unit& u, size_t tstep) const { return (const char*)g.A + (size_t)(u.e ? 3 + u.pn : u.pn / 4) * stride + (size_t)u.pm * tstep; }
    __device__ __forceinline__ const char* bbase(const Gemm& g, const Unit& u, size_t tstep) const { return (const char*)(u.e ? B2 : g.Bt) + (size_t)u.pn * tstep; }
    __device__ __forceinline__ void a_ready(const Unit&) const {}
    __device__ __forceinline__ void done(const Unit&) const {}
};
struct MoeOrder {
    const int* tilee; const PG8_LAS int* ord; int nt, ntn, G, c; size_t estride;
    __device__ __forceinline__ void init(const int* te, int nt_, PG8_LAS int* ordbuf, int ntn_, size_t es, int G_, int c_) {
        tilee = te; nt = nt_; ntn = ntn_; estride = es; G = G_; c = c_; ord = ordbuf;
        { const int t = threadIdx.x; if (t < nt) { const int et = te[1 + t]; int rank = 0; for (int u = 0; u < nt; ++u) { const int eu = te[1 + u]; rank += (eu < et || (eu == et && u < t)) ? 1 : 0; } ordbuf[rank] = t; } }
        asm volatile("s_waitcnt lgkmcnt(0)" ::: "memory"); __builtin_amdgcn_s_barrier(); asm volatile("" ::: "memory");
    }
    __device__ __forceinline__ bool next(int i, Unit& u) const { const long L = (long)i * G + c; if (L >= (long)nt * ntn) return false; u.pm = ord[(int)(L / ntn)]; u.pn = (int)(L % ntn); u.e = tilee[1 + u.pm]; return true; }
    __device__ __forceinline__ const char* abase(const Gemm& g, const Unit& u, size_t tstep) const { return (const char*)g.A + (size_t)u.pm * tstep; }
    __device__ __forceinline__ const char* bbase(const Gemm& g, const Unit& u, size_t tstep) const { return (const char*)g.Bt + (size_t)u.e * estride + (size_t)u.pn * tstep; }
    __device__ __forceinline__ void a_ready(const Unit&) const {}
    __device__ __forceinline__ void done(const Unit&) const {}
};
struct EpiStoreBf16 {
    static constexpr bool PERM = true, AFTER_DRAIN = false;
    bf16_t* O; int ldc;
    __device__ __forceinline__ void operator()(const f32x4 (&acc)[2][2][4][2], const Unit& u, int wr, int wc, int fr, int fq) const {
        const int row0 = u.pm * BM + wr * 64 + fr, col0 = u.pn * BM + wc * 32 + 8 * fq;
#pragma unroll
        for (int ai = 0; ai < 2; ++ai)
#pragma unroll
            for (int m = 0; m < 4; ++m) { bf16_t* rowp = O + (size_t)(row0 + ai * HALF + m * 16) * ldc + col0;
#pragma unroll
                for (int bj = 0; bj < 2; ++bj) { const f32x4 v0 = acc[ai][bj][m][0], v1 = acc[ai][bj][m][1];
                    u32x4 w; w.x = cvt_pk_bf16(v0[0], v0[1]); w.y = cvt_pk_bf16(v0[2], v0[3]); w.z = cvt_pk_bf16(v1[0], v1[1]); w.w = cvt_pk_bf16(v1[2], v1[3]);
                    *(u32x4*)(rowp + bj * HALF) = w; } }
    }
};
struct EpiStoreF32 {
    static constexpr bool PERM = false, AFTER_DRAIN = false;
    float* C; int ldc;
    __device__ __forceinline__ void operator()(const f32x4 (&acc)[2][2][4][2], const Unit& u, int wr, int wc, int fr, int fq) const {
        const int row0 = u.pm * BM + wr * 64 + fr, col0 = u.pn * BM + wc * 32 + 4 * fq;
#pragma unroll
        for (int ai = 0; ai < 2; ++ai)
#pragma unroll
            for (int m = 0; m < 4; ++m) { float* rowp = C + (size_t)(row0 + ai * HALF + m * 16) * ldc + col0;
#pragma unroll
                for (int bj = 0; bj < 2; ++bj)
#pragma unroll
                    for (int n = 0; n < 2; ++n) *(f32x4*)(rowp + bj * HALF + n * 16) = acc[ai][bj][m][n]; }
    }
};
struct EpiResid {
    static constexpr bool PERM = false, AFTER_DRAIN = false;
    const float* base_lat; const float* base_ctx; float* out; const float* gate; int gstride;
    __device__ __forceinline__ void operator()(const f32x4 (&acc)[2][2][4][2], const Unit& u, int wr, int wc, int fr, int fq) const {
        const int row0 = u.pm * BM + wr * 64 + fr, col0 = u.pn * BM + wc * 32 + 4 * fq;
#pragma unroll
        for (int ai = 0; ai < 2; ++ai)
#pragma unroll
            for (int m = 0; m < 4; ++m) { const int row = row0 + ai * HALF + m * 16;
                const float* bp = (row < 16384) ? base_lat + (size_t)row * 1024 : base_ctx + (size_t)(row - 16384) * 1024;
                const float* gp = gate + (size_t)(row < 16384 ? (row >= 8192 ? 1 : 0) : 2) * gstride;
                float* op = out + (size_t)row * 1024;
#pragma unroll
                for (int bj = 0; bj < 2; ++bj)
#pragma unroll
                    for (int n = 0; n < 2; ++n) { const int c = col0 + bj * HALF + n * 16;
                        *(f32x4*)(op + c) = *(const f32x4*)(bp + c) + *(const f32x4*)(gp + c) * acc[ai][bj][m][n]; } }
    }
};
__device__ __forceinline__ float sigm_(float x) { return __builtin_amdgcn_rcpf(1.0f + __expf(-x)); }
struct EpiSwiglu {
    static constexpr bool PERM = true, AFTER_DRAIN = false;
    bf16_t* O; const float* bgu;
    __device__ __forceinline__ void operator()(const f32x4 (&acc)[2][2][4][2], const Unit& u, int wr, int wc, int fr, int fq) const {
        const int row0 = u.pm * BM + wr * 64 + fr, col0 = u.pn * HALF + wc * 32 + 8 * fq;
        const float* bg = bgu + (size_t)u.e * 2048 + col0; f32x4 bgv[2], buv[2];
#pragma unroll
        for (int n = 0; n < 2; ++n) { bgv[n] = *(const f32x4*)(bg + 4 * n); buv[n] = *(const f32x4*)(bg + 1024 + 4 * n); }
#pragma unroll
        for (int ai = 0; ai < 2; ++ai)
#pragma unroll
            for (int m = 0; m < 4; ++m) { float r[8];
#pragma unroll
                for (int n = 0; n < 2; ++n) { const f32x4 g4 = acc[ai][0][m][n] + bgv[n], u4 = acc[ai][1][m][n] + buv[n];
#pragma unroll
                    for (int j = 0; j < 4; ++j) { const float g = fminf(g4[j], 7.0f), uu = fminf(fmaxf(u4[j], -7.0f), 7.0f); r[4 * n + j] = g * sigm_(1.702f * g) * (uu + 1.0f); } }
                u32x4 w; w.x = cvt_pk_bf16(r[0], r[1]); w.y = cvt_pk_bf16(r[2], r[3]); w.z = cvt_pk_bf16(r[4], r[5]); w.w = cvt_pk_bf16(r[6], r[7]);
                *(u32x4*)(O + (size_t)(row0 + ai * HALF + m * 16) * 1024 + col0) = w; }
    }
};
struct EpiDown {
    static constexpr bool PERM = true, AFTER_DRAIN = false;
    bf16_t* O; const float* bdn;
    __device__ __forceinline__ void operator()(const f32x4 (&acc)[2][2][4][2], const Unit& u, int wr, int wc, int fr, int fq) const {
        const int row0 = u.pm * BM + wr * 64 + fr, col0 = u.pn * BM + wc * 32 + 8 * fq;
        const float* bp = bdn + (size_t)u.e * 1024 + col0; f32x4 bv[2][2];
#pragma unroll
        for (int bj = 0; bj < 2; ++bj)
#pragma unroll
            for (int n = 0; n < 2; ++n) bv[bj][n] = *(const f32x4*)(bp + bj * HALF + 4 * n);
#pragma unroll
        for (int ai = 0; ai < 2; ++ai)
#pragma unroll
            for (int m = 0; m < 4; ++m) { bf16_t* rowp = O + (size_t)(row0 + ai * HALF + m * 16) * 1024 + col0;
#pragma unroll
                for (int bj = 0; bj < 2; ++bj) { const f32x4 v0 = acc[ai][bj][m][0] + bv[bj][0], v1 = acc[ai][bj][m][1] + bv[bj][1];
                    u32x4 w; w.x = cvt_pk_bf16(v0[0], v0[1]); w.y = cvt_pk_bf16(v0[2], v0[3]); w.z = cvt_pk_bf16(v1[0], v1[1]); w.w = cvt_pk_bf16(v1[2], v1[3]);
                    *(u32x4*)(rowp + bj * HALF) = w; } }
    }
};
struct EpiLora1 {
    static constexpr bool PERM = true, AFTER_DRAIN = false;
    bf16_t* O;
    __device__ __forceinline__ void operator()(const f32x4 (&acc)[2][2][4][2], const Unit& u, int wr, int wc, int fr, int fq) const {
        const int row0 = u.pm * BM + wr * 64 + fr, col0 = u.pn * HALF + wc * 32 + 8 * fq;
#pragma unroll
        for (int ai = 0; ai < 2; ++ai)
#pragma unroll
            for (int m = 0; m < 4; ++m) { float r[8];
#pragma unroll
                for (int n = 0; n < 2; ++n)
#pragma unroll
                    for (int j = 0; j < 4; ++j) { const float x = acc[ai][0][m][n][j]; r[4 * n + j] = (u.pn == 0) ? (2.0f * sigm_(2.0f * x) - 1.0f) : (u.pn == 1) ? x : sigm_(x); }
                u32x4 w; w.x = cvt_pk_bf16(r[0], r[1]); w.y = cvt_pk_bf16(r[2], r[3]); w.z = cvt_pk_bf16(r[4], r[5]); w.w = cvt_pk_bf16(r[6], r[7]);
                *(u32x4*)(O + (size_t)(row0 + ai * HALF + m * 16) * 384 + col0) = w; }
    }
};
struct EpiRkvL1 {
    static constexpr bool PERM = true, AFTER_DRAIN = false;
    EpiStoreBf16 rkv; EpiLora1 l1;
    __device__ __forceinline__ void operator()(const f32x4 (&acc)[2][2][4][2], const Unit& u, int wr, int wc, int fr, int fq) const { if (u.e) l1(acc, u, wr, wc, fr, fq); else rkv(acc, u, wr, wc, fr, fq); }
};
struct EpiLora2 {
    static constexpr bool PERM = false, AFTER_DRAIN = false;
    bf16_t* WD; bf16_t* AD; bf16_t* G; const float* w0; const float* a0;
    __device__ __forceinline__ void operator()(const f32x4 (&acc)[2][2][4][2], const Unit& u, int wr, int wc, int fr, int fq) const {
        const int row0 = u.pm * BM + wr * 64 + fr, blk = u.pn >> 2, col0 = (u.pn & 3) * BM + wc * 32 + 4 * fq;
        bf16_t* dst = (blk < 2) ? WD + (size_t)blk * 16896 * 1024 : (blk < 4) ? AD + (size_t)(blk - 2) * 16896 * 1024 : G;
        const float* bias = (blk < 2) ? w0 + blk * 1024 : a0 + ((blk - 2) & 1) * 1024;
#pragma unroll
        for (int ai = 0; ai < 2; ++ai)
#pragma unroll
            for (int m = 0; m < 4; ++m) { bf16_t* rowp = dst + (size_t)(row0 + ai * HALF + m * 16) * 1024;
#pragma unroll
                for (int bj = 0; bj < 2; ++bj)
#pragma unroll
                    for (int n = 0; n < 2; ++n) { const int c = col0 + bj * HALF + n * 16; f32x4 v = acc[ai][bj][m][n];
                        const f32x4 bb = *(const f32x4*)(bias + c);
                        if (blk < 2) { for (int j = 0; j < 4; ++j) v[j] = -0.60653066f * sigm_(v[j] + bb[j]); }
                        else if (blk < 4) { for (int j = 0; j < 4; ++j) v[j] = sigm_(v[j] + bb[j]); }
                        unsigned lo = cvt_pk_bf16(v[0], v[1]), hi = cvt_pk_bf16(v[2], v[3]);
                        *(unsigned long long*)(rowp + c) = (unsigned long long)lo | ((unsigned long long)hi << 32); }
                asm volatile("" ::: "memory"); }
    }
};
}

constexpr int GLA_NCH = NSTEP / 64;
constexpr int GLA_ITEMS = 2 * NBATCH * GLA_NCH * 8;
constexpr size_t U_DS = 298 * MiB, U_OI = 430 * MiB, U_QT = 562 * MiB, U_LAM = 628 * MiB;
typedef short bf16x8_t __attribute__((ext_vector_type(8)));
typedef float f32x2g __attribute__((ext_vector_type(2)));
__device__ __forceinline__ f32x4 mfma16(bf16x8_t a, bf16x8_t b, f32x4 c) { return __builtin_amdgcn_mfma_f32_16x16x32_bf16(a, b, c, 0, 0, 0); }

__device__ __forceinline__ void phase_gla_prep(PP p, LAS unsigned char* lds, int tid, int lane, int wave) {
    constexpr int PQ = 272, PT = 144;
    LAS unsigned char* QA = lds;
    LAS unsigned char* QX = QA + 64 * PQ;
    LAS unsigned char* KB = QX + 48 * PQ;
    LAS unsigned char* KD = KB + 64 * PQ;
    LAS unsigned char* KT = KD + 64 * PQ;
    LAS unsigned char* VT = KT + 128 * PT;
    LAS unsigned char* PI = VT + 128 * PT;
    LAS float* GT = (LAS float*)(PI + 64 * PT);
    const bf16* Z = (const bf16*)(p->ws + WS_U + U_Z);
    bf16* DS = (bf16*)(p->ws + WS_U + U_DS); v2u* OI = (v2u*)(p->ws + WS_U + U_OI); bf16* QT = (bf16*)(p->ws + WS_U + U_QT); float* LAM = (float*)(p->ws + WS_U + U_LAM);
    const int kp = tid & 63, gg = tid >> 6, g = gg >> 1, hh = gg & 1, k0 = 2 * kp, kq = lane >> 4, c16 = lane & 15;
    unsigned zf[8], zq[8], zv[8];
    auto ldz = [&](int item2) {
        const int h2 = item2 & 7, cc2 = (item2 >> 3) % GLA_NCH, db2 = (item2 >> 3) / GLA_NCH, b2 = db2 & 1, dir2 = db2 >> 1;
#pragma unroll
        for (int i = 0; i < 8; ++i) { const size_t zr = (size_t)step_row(b2, dir2, 64 * cc2 + 8 * gg + i) * 5120 + h2 * 128 + k0;
            zf[i] = *(const unsigned*)(Z + zr + 1024 * (1 + dir2)); zq[i] = *(const unsigned*)(Z + zr); zv[i] = *(const unsigned*)(Z + zr + 3072); } };
    if ((int)blockIdx.x < GLA_ITEMS) ldz(blockIdx.x);
    for (int item = blockIdx.x; item < GLA_ITEMS; item += gridDim.x) {
        const int h = item & 7, db = (item >> 3) / GLA_NCH, dir = db >> 1;
        float lbv[2];
#pragma unroll
        for (int e = 0; e < 2; ++e) { const float* lb = p->in[I_HGLB] + (size_t)dir * 3 * D + h * 128 + k0 + e; const float a0 = lb[0], a1 = lb[D], a2 = lb[2 * D];
            const float mx = fmaxf(a0, fmaxf(a1, a2)); const float e0 = __expf(a0 - mx), e1 = __expf(a1 - mx), e2 = __expf(a2 - mx); lbv[e] = e0 / (e0 + e1 + e2); }
        for (int u = tid; u < 64 * PT / 4; u += NTHREADS) ((LAS unsigned*)PI)[u] = 0u;
        float cs[2][8], kin[2][8], qs[2][8], run[2] = {0.f, 0.f}; unsigned vlo[4], vhi[4];
#pragma unroll
        for (int i = 0; i < 8; ++i) {
#pragma unroll
            for (int e = 0; e < 2; ++e) {
                const float fh = bf2f(e ? (zf[i] >> 16) : (zf[i] & 0xffffu)), qv = bf2f(e ? (zq[i] >> 16) : (zq[i] & 0xffffu));
                const float f = lbv[e] + (1.f - lbv[e]) * sigm(fh);
                run[e] += __logf(f); cs[e][i] = run[e]; kin[e][i] = 1.f - f; qs[e][i] = qv * sigm(qv);
            }
            if (i & 1) { vlo[i >> 1] |= zv[i] << 16; vhi[i >> 1] |= zv[i] & 0xffff0000u; } else { vlo[i >> 1] = zv[i] & 0xffffu; vhi[i >> 1] = zv[i] >> 16; }
        }
        if (item + (int)gridDim.x < GLA_ITEMS) ldz(item + gridDim.x);
        *(LAS f32x2g*)(GT + gg * 128 + k0) = (f32x2g){run[0], run[1]};
        *(LAS v4u*)(VT + k0 * PT + 16 * gg) = (v4u){vlo[0], vlo[1], vlo[2], vlo[3]};
        *(LAS v4u*)(VT + (k0 + 1) * PT + 16 * gg) = (v4u){vhi[0], vhi[1], vhi[2], vhi[3]};
        __syncthreads();
        f32x2g t8[8];
#pragma unroll
        for (int u = 0; u < 8; ++u) t8[u] = *(const LAS f32x2g*)(GT + u * 128 + k0);
        unsigned ktl[4], kth[4];
        float rgv[2], totv[2], runSv[2], lov[2], t1v[2], t2v[2];
#pragma unroll
        for (int e = 0; e < 2; ++e) {
            const float s0 = e ? t8[0].y : t8[0].x, s1 = e ? t8[1].y : t8[1].x, s2 = e ? t8[2].y : t8[2].x, s3 = e ? t8[3].y : t8[3].x;
            const float s4 = e ? t8[4].y : t8[4].x, s5 = e ? t8[5].y : t8[5].x, s6 = e ? t8[6].y : t8[6].x, s7 = e ? t8[7].y : t8[7].x;
            const float q0 = s0 + s1, q1 = s2 + s3, q2 = s4 + s5, q3 = s6 + s7;
            rgv[e] = (g > 0 ? q0 : 0.f) + (g > 1 ? q1 : 0.f) + (g > 2 ? q2 : 0.f); totv[e] = (q0 + q1) + (q2 + q3);
            runSv[e] = (g == 0) ? q0 : (g == 1) ? q1 : (g == 2) ? q2 : q3;
            const float first = (g == 0) ? s0 : (g == 1) ? s2 : (g == 2) ? s4 : s6;
            lov[e] = hh ? first : 0.f; t1v[e] = q1; t2v[e] = q2;
        }
        float erg[2], einv[2], eend[2], ex1[2], ex2[2];
#pragma unroll
        for (int e = 0; e < 2; ++e) { erg[e] = __expf(rgv[e]); einv[e] = __expf(-runSv[e]); eend[e] = __expf(totv[e] - (rgv[e] + runSv[e]));
            ex1[e] = (g == 2) ? __expf(t1v[e]) : __expf(t2v[e]); ex2[e] = __expf(t1v[e] + t2v[e]); }
        bf16* qtp = QT + (size_t)item * 64 * 128 + (size_t)(16 * g + 8 * hh) * 128 + k0;
#pragma unroll
        for (int i = 0; i < 8; ++i) {
            float qh[2], kb[2];
#pragma unroll
            for (int e = 0; e < 2; ++e) { const float cr = lov[e] + cs[e][i]; qh[e] = qs[e][i] * __expf(cr); kb[e] = kin[e][i] * __expf(runSv[e] - cr); }
            const int ro = (16 * g + 8 * hh + i) * PQ + 2 * k0;
            *(LAS unsigned*)(QA + ro) = pk2(qh[0], qh[1]);
            *(LAS unsigned*)(KB + ro) = pk2(kb[0], kb[1]);
            *(LAS unsigned*)(KD + ro) = pk2(kb[0] * einv[0], kb[1] * einv[1]);
            if (g == 2) *(LAS unsigned*)(QX + (8 * hh + i) * PQ + 2 * k0) = pk2(qh[0] * ex1[0], qh[1] * ex1[1]);
            if (g == 3) { *(LAS unsigned*)(QX + (16 + 8 * hh + i) * PQ + 2 * k0) = pk2(qh[0] * ex1[0], qh[1] * ex1[1]); *(LAS unsigned*)(QX + (32 + 8 * hh + i) * PQ + 2 * k0) = pk2(qh[0] * ex2[0], qh[1] * ex2[1]); }
            *(unsigned*)(qtp + (size_t)i * 128) = pk2(qh[0] * erg[0], qh[1] * erg[1]);
            const unsigned kv0 = f2bf(kb[0] * eend[0]), kv1 = f2bf(kb[1] * eend[1]);
            if (i & 1) { ktl[i >> 1] |= kv0 << 16; kth[i >> 1] |= kv1 << 16; } else { ktl[i >> 1] = kv0; kth[i >> 1] = kv1; }
        }
        *(LAS v4u*)(KT + k0 * PT + 16 * gg) = (v4u){ktl[0], ktl[1], ktl[2], ktl[3]};
        *(LAS v4u*)(KT + (k0 + 1) * PT + 16 * gg) = (v4u){kth[0], kth[1], kth[2], kth[3]};
        if (gg == 0) *(f32x2g*)(LAM + (size_t)item * 128 + k0) = (f32x2g){__expf(totv[0]), __expf(totv[1])};
        __syncthreads();
        for (int blk = wave; blk < 10; blk += 8) {
            const int gi = (blk >= 6) ? 3 : (blk >= 3) ? 2 : (blk >= 1) ? 1 : 0, ji = blk - ((gi * (gi + 1)) >> 1);
            const LAS unsigned char* ab = (ji + 1 >= gi) ? QA + 16 * gi * PQ : (gi == 2) ? QX : (ji == 1) ? QX + 16 * PQ : QX + 32 * PQ;
            const LAS unsigned char* bb = ((ji == gi) ? KD : KB) + 16 * ji * PQ;
            f32x4 acc = (f32x4){0.f, 0.f, 0.f, 0.f};
#pragma unroll
            for (int s = 0; s < 4; ++s) {
                const bf16x8_t a = *(const LAS bf16x8_t*)(ab + c16 * PQ + (32 * s + 8 * kq) * 2), bv = *(const LAS bf16x8_t*)(bb + c16 * PQ + (32 * s + 8 * kq) * 2);
                acc = mfma16(a, bv, acc);
            }
#pragma unroll
            for (int j = 0; j < 4; ++j) { const int tau = 4 * kq + j; const float val = (ji == gi && c16 > tau) ? 0.f : acc[j];
                *(LAS unsigned short*)(PI + (16 * gi + tau) * PT + (16 * ji + c16) * 2) = (unsigned short)f2bf(val); }
        }
        __syncthreads();
        {
            const LAS unsigned char* vb = VT + (16 * wave + c16) * PT + 16 * kq;
            const bf16x8_t v0 = *(const LAS bf16x8_t*)(vb), v1 = *(const LAS bf16x8_t*)(vb + 64);
#pragma unroll
            for (int gi = 0; gi < 4; ++gi) {
                const LAS unsigned char* pb = PI + (16 * gi + c16) * PT + 16 * kq;
                f32x4 acc = mfma16(*(const LAS bf16x8_t*)(pb), v0, (f32x4){0.f, 0.f, 0.f, 0.f});
                if (gi >= 2) acc = mfma16(*(const LAS bf16x8_t*)(pb + 64), v1, acc);
                { v2u w; w.x = pk2(acc[0], acc[1]); w.y = pk2(acc[2], acc[3]); OI[((size_t)item * 8 + wave) * 256 + gi * 64 + lane] = w; }
            }
            bf16* dsp = DS + (size_t)item * 128 * 128 + (size_t)(16 * wave + c16) * 128 + 4 * kq;
#pragma unroll
            for (int m = 0; m < 8; ++m) {
                const LAS unsigned char* kb2 = KT + (16 * m + c16) * PT + 16 * kq;
                f32x4 acc = mfma16(*(const LAS bf16x8_t*)(kb2), v0, (f32x4){0.f, 0.f, 0.f, 0.f});
                acc = mfma16(*(const LAS bf16x8_t*)(kb2 + 64), v1, acc);
                v2u w; w.x = pk2(acc[0], acc[1]); w.y = pk2(acc[2], acc[3]);
                *(v2u*)(dsp + 16 * m) = w;
            }
        }
        __syncthreads();
    }
}
__device__ __forceinline__ void phase_gla_scan(PP p, int tid) {
    bf16* DS = (bf16*)(p->ws + WS_U + U_DS); const float* LAM = (const float*)(p->ws + WS_U + U_LAM);
    const int nthr = gridDim.x * NTHREADS;
    for (int e = blockIdx.x * NTHREADS + tid; e < 32 * 2048; e += nthr) {
        const int chain = e >> 11, el = e & 2047, h = chain & 7, db = chain >> 3, k8 = (el & 15) * 8;
        float s[8];
#pragma unroll
        for (int i = 0; i < 8; ++i) s[i] = 0.f;
        for (int c0 = 0; c0 < GLA_NCH; c0 += 6) {
            v4u d[6]; f32x4 l0[6], l1[6];
#pragma unroll
            for (int u = 0; u < 6; ++u) { const size_t item = ((size_t)db * GLA_NCH + c0 + u) * 8 + h;
                d[u] = *(const v4u*)(DS + item * 16384 + (size_t)el * 8); l0[u] = *(const f32x4*)(LAM + item * 128 + k8); l1[u] = *(const f32x4*)(LAM + item * 128 + k8 + 4); }
#pragma unroll
            for (int u = 0; u < 6; ++u) { const size_t item = ((size_t)db * GLA_NCH + c0 + u) * 8 + h;
                v4u o; o.x = pk2(s[0], s[1]); o.y = pk2(s[2], s[3]); o.z = pk2(s[4], s[5]); o.w = pk2(s[6], s[7]);
                *(v4u*)(DS + item * 16384 + (size_t)el * 8) = o;
                s[0] = l0[u].x * s[0] + bf2f(d[u].x & 0xffffu); s[1] = l0[u].y * s[1] + bf2f(d[u].x >> 16);
                s[2] = l0[u].z * s[2] + bf2f(d[u].y & 0xffffu); s[3] = l0[u].w * s[3] + bf2f(d[u].y >> 16);
                s[4] = l1[u].x * s[4] + bf2f(d[u].z & 0xffffu); s[5] = l1[u].y * s[5] + bf2f(d[u].z >> 16);
                s[6] = l1[u].z * s[6] + bf2f(d[u].w & 0xffffu); s[7] = l1[u].w * s[7] + bf2f(d[u].w >> 16); }
        }
    }
}
__device__ __forceinline__ void phase_gla_out(PP p, LAS unsigned char* lds, int tid, int lane, int wave) {
    const bf16* DS = (const bf16*)(p->ws + WS_U + U_DS); const v2u* OI = (const v2u*)(p->ws + WS_U + U_OI); const bf16* QT = (const bf16*)(p->ws + WS_U + U_QT);
    const bf16* Z = (const bf16*)(p->ws + WS_U + U_Z); bf16* A2 = (bf16*)(p->ws + WS_A2); const float* gn = p->in[I_HGGN];
    LAS float* SSQ = (LAS float*)lds;
    LAS float* RST = SSQ + 512;
    const int kq = lane >> 4, c16 = lane & 15;
    for (int it = blockIdx.x; it < NBATCH * GLA_NCH * 8; it += gridDim.x) {
        const int h = it & 7, jc = (it >> 3) % GLA_NCH, b = (it >> 3) / GLA_NCH;
        const int cf = jc, cb = (jc < 4) ? 3 - jc : 135 - jc;
        f32x4 acc[2][4];
#pragma unroll
        for (int dir = 0; dir < 2; ++dir) {
            const int item = ((dir * 2 + b) * GLA_NCH + (dir ? cb : cf)) * 8 + h;
            const bf16* sp = DS + (size_t)item * 16384 + (size_t)(16 * wave + c16) * 128 + 8 * kq;
            bf16x8_t bv[4];
#pragma unroll
            for (int s = 0; s < 4; ++s) bv[s] = *(const bf16x8_t*)(sp + 32 * s);
#pragma unroll
            for (int gi = 0; gi < 4; ++gi) {
                const bf16* qp = QT + (size_t)item * 8192 + (size_t)(16 * gi + c16) * 128 + 8 * kq;
                const v2u ow = OI[((size_t)item * 8 + wave) * 256 + gi * 64 + lane];
                f32x4 a4 = (f32x4){bf2f(ow.x & 0xffffu), bf2f(ow.x >> 16), bf2f(ow.y & 0xffffu), bf2f(ow.y >> 16)};
#pragma unroll
                for (int s = 0; s < 4; ++s) a4 = mfma16(*(const bf16x8_t*)(qp + 32 * s), bv[s], a4);
                acc[dir][gi] = a4;
            }
        }
        f32x4 o[4]; float ss[4][4];
#pragma unroll
        for (int gi = 0; gi < 4; ++gi)
#pragma unroll
            for (int j = 0; j < 4; ++j) { const float v = acc[0][gi][j] + __shfl_xor(acc[1][3 - gi][3 - j], 48); o[gi][j] = v;
                float q = v * v;
                q += __builtin_bit_cast(float, __builtin_amdgcn_update_dpp(0, __builtin_bit_cast(int, q), 0x128, 0xf, 0xf, false));
                q += __builtin_bit_cast(float, __builtin_amdgcn_update_dpp(0, __builtin_bit_cast(int, q), 0x124, 0xf, 0xf, false));
                q += __builtin_bit_cast(float, __builtin_amdgcn_update_dpp(0, __builtin_bit_cast(int, q), 0x122, 0xf, 0xf, false));
                q += __builtin_bit_cast(float, __builtin_amdgcn_update_dpp(0, __builtin_bit_cast(int, q), 0x121, 0xf, 0xf, false));
                ss[gi][j] = q; }
        if (c16 == 0) {
#pragma unroll
            for (int gi = 0; gi < 4; ++gi)
#pragma unroll
                for (int j = 0; j < 4; ++j) SSQ[(16 * gi + 4 * kq + j) * 8 + wave] = ss[gi][j]; }
        __syncthreads();
        if (tid < 64) { const f32x4 s0 = *(const LAS f32x4*)(SSQ + tid * 8), s1 = *(const LAS f32x4*)(SSQ + tid * 8 + 4);
            RST[tid] = rsqrtf(((s0[0] + s0[1]) + (s0[2] + s0[3]) + (s1[0] + s1[1]) + (s1[2] + s1[3])) * (1.0f / 128.0f) + NORM_EPS); }
        __syncthreads();
        const int vcol = h * 128 + 16 * wave + c16; const float gw_ = gn[16 * wave + c16];
        const int tok0 = (jc < 4) ? NLAT + b * CTXL + 64 * jc : b * SEQ + 64 * (jc - 4);
#pragma unroll
        for (int gi = 0; gi < 4; ++gi)
#pragma unroll
            for (int j = 0; j < 4; ++j) { const int tk = 16 * gi + 4 * kq + j; const size_t row = (size_t)(tok0 + tk);
                const float g = bf2f(Z[row * 5120 + 4096 + vcol]); const float r = o[gi][j] * RST[tk] * gw_ * (g * sigm(g));
                const float r1 = __shfl_down(r, 1);
                if (!(lane & 1)) *(unsigned*)(A2 + row * D + vcol) = pk2(r, r1); }
        __syncthreads();
    }
}

typedef short bf16x4_t __attribute__((ext_vector_type(4)));
typedef float f32x2_t __attribute__((ext_vector_type(2))); typedef __bf16 bf16x2v_t __attribute__((ext_vector_type(2)));
__device__ __forceinline__ unsigned cvtpk(float lo, float hi) { const f32x2_t v = {lo, hi}; const bf16x2v_t b = __builtin_convertvector(v, bf16x2v_t); return __builtin_bit_cast(unsigned, b); }
constexpr int R4_DOTA = 0, R4_UPA = 2048, R4_A1 = 4096, R4_A2 = 4352, R4_G7 = 4608, R4_VT = 4864, R4_IMG = 6912, R4_SLOT = 5376, R4_NCH = NSTEP / 8, R4_NCB = 8;
constexpr size_t U_IMG = 872 * MiB;
constexpr size_t U_YST = U_OD1;
__device__ __forceinline__ void phase_rw_prep(PP p, LAS unsigned char* lds, int lane, int wave) {
    const int gw = blockIdx.x * NWAVES + wave, NGW = gridDim.x * NWAVES;
    const bf16* RKV = (const bf16*)(p->ws + WS_U + U_RKV); unsigned char* IMG = p->ws + WS_U + U_IMG;
    LAS unsigned char* da = lds + wave * 8192; LAS unsigned char* gb = da + 2048; LAS float* GL = (LAS float*)(da + 4096);
    LAS unsigned char* a12 = da + 5120;
    const int m = lane & 15, q = lane >> 4;
    const int s2 = lane >> 5, tp = (lane >> 4) & 1, kq = (lane & 15) >> 2, ii = (lane & 3) + 4 * tp, dpos = ((s2 * 4 + kq) * 8 + ii) * 2;
    float nrx[8], nkx[8], nvx[8], nlw[8], nav[8];
    auto ld = [&](int it2) {
        const int chain = it2 & 63, chunk = it2 >> 6, b = chain >> 5, dir = (chain >> 4) & 1, h = chain & 15, ch = h * 64 + lane;
        const bf16* WDp = (const bf16*)(p->ws + WS_U + U_WD) + (size_t)dir * NROW * D; const bf16* ADp = (const bf16*)(p->ws + WS_U + U_AD) + (size_t)dir * NROW * D;
#pragma unroll
        for (int j = 0; j < 8; ++j) { const int row = step_row(b, dir, chunk * 8 + j);
            nrx[j] = bf2f(RKV[(size_t)row * 3072 + ch]); nkx[j] = bf2f(RKV[(size_t)row * 3072 + 1024 + ch]); nvx[j] = bf2f(RKV[(size_t)row * 3072 + 2048 + ch]);
            nlw[j] = bf2f(WDp[(size_t)row * D + ch]); nav[j] = bf2f(ADp[(size_t)row * D + ch]); } };
    if (gw < 64 * R4_NCH) ld(gw);
    for (int it = gw; it < 64 * R4_NCH; it += NGW) {
        const int chain = it & 63, chunk = it >> 6, h = chain & 15, ch = h * 64 + lane;
        const float kkw = p->in[I_KK][ch], kaw = p->in[I_KA][ch];
        float rx[8], kx[8], vx[8], lw[8], av[8], kn[8];
#pragma unroll
        for (int j = 0; j < 8; ++j) { rx[j] = nrx[j]; kx[j] = nkx[j]; vx[j] = nvx[j]; lw[j] = nlw[j]; av[j] = nav[j]; }
        if (it + NGW < 64 * R4_NCH) ld(it + NGW);
#pragma unroll
        for (int j = 0; j < 8; ++j) { const float t = kx[j] * kkw; kn[j] = t * __builtin_amdgcn_rsqf(fmaxf(wave_sum(t * t), 1e-24f)); }
        float bj[8]; { float bb = 0.f;
#pragma unroll
            for (int j = 0; j < 8; ++j) { bb += lw[j]; bj[j] = bb; } }
        const float e7 = __expf(bj[7]);
        unsigned upa[8]; float ebprev = 1.f;
#pragma unroll
        for (int j = 0; j < 8; ++j) {
            const float eb = __expf(bj[j]), einv = __builtin_amdgcn_rcpf(eb), e7j = e7 * einv;
            const float beta = kn[j] * av[j], kd = kx[j] * (1.f + (av[j] - 1.f) * kaw);
            *(LAS unsigned short*)(da + j * 128 + dpos) = (unsigned short)f2bf(kn[j] * ebprev);
            *(LAS unsigned short*)(da + (8 + j) * 128 + dpos) = (unsigned short)f2bf(rx[j] * eb);
            *(LAS unsigned short*)(gb + j * 128 + dpos) = (unsigned short)f2bf(beta * einv);
            *(LAS unsigned short*)(gb + (8 + j) * 128 + dpos) = (unsigned short)f2bf(kd * einv);
            const unsigned ub = f2bf(-beta * e7j), uk = f2bf(kd * e7j);
            if (j & 1) { upa[j >> 1] |= ub << 16; upa[4 + (j >> 1)] |= uk << 16; } else { upa[j >> 1] = ub; upa[4 + (j >> 1)] = uk; }
            ebprev = eb;
        }
        unsigned char* img = IMG + ((size_t)chain * R4_NCH + chunk) * R4_IMG;
        { v4u* d = (v4u*)(img + R4_UPA + lane * 32); d[0] = (v4u){upa[0], upa[1], upa[2], upa[3]}; d[1] = (v4u){upa[4], upa[5], upa[6], upa[7]}; }
        ((float*)(img + R4_G7))[lane] = e7;
        { f32x4* d = (f32x4*)(img + R4_VT + lane * 32); d[0] = (f32x4){vx[0], vx[1], vx[2], vx[3]}; d[1] = (f32x4){vx[4], vx[5], vx[6], vx[7]}; }
        LDS_WAIT(); asm volatile("" ::: "memory");
        { v4u* d = (v4u*)(img + R4_DOTA); d[lane] = ((const LAS v4u*)da)[lane]; d[64 + lane] = ((const LAS v4u*)da)[64 + lane]; }
        f32x4 G = (f32x4){0.f, 0.f, 0.f, 0.f};
#pragma unroll
        for (int s = 0; s < 2; ++s) G = mfma16(*(const LAS bf16x8_t*)(da + m * 128 + (s * 4 + q) * 16), *(const LAS bf16x8_t*)(gb + m * 128 + (s * 4 + q) * 16), G);
        if (m >= 8) { const int i = m - 8;
#pragma unroll
            for (int jp = 0; jp < 4; ++jp) { const int row = 4 * q + jp; const bool keep = (row < 8) ? (i < row) : (i <= row - 8);
                *(LAS unsigned short*)(a12 + row * 16 + i * 2) = (unsigned short)f2bf(keep ? G[jp] : 0.f); } }
#pragma unroll
        for (int jp = 0; jp < 4; ++jp) GL[(4 * q + jp) * 16 + m] = G[jp];
        LDS_WAIT(); asm volatile("" ::: "memory");
        const int c = lane & 7; float Tc[8], M2[8];
#pragma unroll
        for (int j = 0; j < 8; ++j) { float t = (j == c) ? 1.f : 0.f; const f32x4 ra = *(const LAS f32x4*)(GL + j * 16), rb = *(const LAS f32x4*)(GL + j * 16 + 4);
#pragma unroll
            for (int i = 0; i < j; ++i) t -= (i < 4 ? ra[i & 3] : rb[i & 3]) * Tc[i];
            Tc[j] = t; }
#pragma unroll
        for (int j = 0; j < 8; ++j) { float t = 0.f; const f32x4 ra = *(const LAS f32x4*)(GL + (8 + j) * 16), rb = *(const LAS f32x4*)(GL + (8 + j) * 16 + 4);
#pragma unroll
            for (int i = 0; i <= j; ++i) t -= (i < 4 ? ra[i & 3] : rb[i & 3]) * Tc[i];
            M2[j] = t; }
        if (lane < 8) {
#pragma unroll
            for (int j = 0; j < 8; ++j) { *(LAS unsigned short*)(a12 + 256 + j * 16 + c * 2) = (unsigned short)f2bf(Tc[j]); *(LAS unsigned short*)(a12 + 256 + (8 + j) * 16 + c * 2) = (unsigned short)f2bf(M2[j]); } }
        LDS_WAIT(); asm volatile("" ::: "memory");
        if (lane < 32) ((v4u*)(img + R4_A1))[lane] = ((const LAS v4u*)a12)[lane];
        LDS_WAIT(); asm volatile("" ::: "memory");
    }
}
constexpr int R4L_NCB = 6, R4L_SLOT = 6144;
__device__ __forceinline__ void phase_rwkv_scan4(PP p, LAS unsigned char* lds, int vcu, int tid, int lane, int wave) {
    const int m = lane & 15, q = lane >> 4;
    const unsigned char* IMG = p->ws + WS_U + U_IMG;
    for (int unit = vcu; unit < 256; unit += gridDim.x) {
        const int chain = unit >> 2, slab = unit & 3, b = chain >> 5, dir = (chain >> 4) & 1, h = chain & 15;
        float* YST = (float*)(p->ws + WS_U + U_YST) + (size_t)unit * NSTEP * 16 + (q >= 2 ? 4 * (q - 2) : 0) * 16 + m;
        const unsigned char* cimg = IMG + (size_t)chain * R4_NCH * R4_IMG;
        f32x4 S[4];
#pragma unroll
        for (int T = 0; T < 4; ++T) S[T] = (f32x4){0.f, 0.f, 0.f, 0.f};
        v2u idf; { const int c0 = 4 * q; idf.x = ((c0 == m) ? 0x3F80u : 0u) | ((c0 + 1 == m) ? 0x3F800000u : 0u); idf.y = ((c0 + 2 == m) ? 0x3F80u : 0u) | ((c0 + 3 == m) ? 0x3F800000u : 0u); }
        auto issue = [&](int bt) {
#pragma unroll
            for (int k = 0; k < 2 * R4L_NCB; ++k) { const int ii = (wave - 1) + 3 * k, cc = ii / 6, part = ii - cc * 6, pi = part * 64 + lane;
                const unsigned char* src = cimg + (size_t)(bt * R4L_NCB + cc) * R4_IMG + (pi < 304 ? pi * 16 : (pi < 336 ? R4_VT + slab * 512 + (pi - 304) * 16 : 0));
                __builtin_amdgcn_global_load_lds((const unsigned*)src, (LAS unsigned*)(lds + ((bt & 1) * R4L_NCB + cc) * R4L_SLOT + part * 1024), 16, 0, 0); } };
        float crg[32]; int cit = (int)(blockIdx.x * 4 + (wave - 4)); ConvJob cj; bool cpend = false;
        LAS float* cscr = (LAS float*)(lds + 2 * R4L_NCB * R4L_SLOT + (wave & 3) * 8448);
        if (wave >= 4 && cit < IT_L1MOE) { cj = conv_job_l1(p, cit); ti_load(cj.src, cj.src_ld, lane, crg); cpend = true; }
        __syncthreads();
        if (wave >= 1 && wave < 4) { issue(0); asm volatile("s_waitcnt vmcnt(0)" ::: "memory"); }
        __syncthreads();
        constexpr int NB4 = R4_NCH / R4L_NCB;
        for (int bt = 0; bt < NB4; ++bt) {
            if (wave >= 4) { if (cpend) { ti_store(true, crg, cj.dst, cj.dst_ld, cscr, lane); cit += 4 * (int)gridDim.x; cpend = cit < IT_L1MOE; if (cpend) { cj = conv_job_l1(p, cit); ti_load(cj.src, cj.src_ld, lane, crg); } } }
            else if (wave >= 1) { if (bt + 1 < NB4) issue(bt + 1); asm volatile("s_waitcnt vmcnt(0)" ::: "memory"); }
            else {
                __builtin_amdgcn_s_setprio(3);
                struct Ops { bf16x8_t a0, a1; v2u A1u, A2u; bf16x4_t UA[4]; f32x4 g7[4]; f32x4 vr; };
                auto rd = [&](int cc, Ops& o) {
                    const LAS unsigned char* sl = lds + ((bt & 1) * R4L_NCB + cc) * R4L_SLOT;
                    o.a0 = *(const LAS bf16x8_t*)(sl + R4_DOTA + m * 128 + q * 16); o.a1 = *(const LAS bf16x8_t*)(sl + R4_DOTA + m * 128 + (4 + q) * 16);
                    o.A1u = *(const LAS v2u*)(sl + R4_A1 + m * 16 + (q & 1) * 8); o.A2u = *(const LAS v2u*)(sl + R4_A2 + m * 16 + (q & 1) * 8);
#pragma unroll
                    for (int T = 0; T < 4; ++T) { o.UA[T] = *(const LAS bf16x4_t*)(sl + R4_UPA + (16 * T + m) * 32 + q * 8); o.g7[T] = *(const LAS f32x4*)(sl + R4_G7 + (16 * T + 4 * q) * 4); }
                    o.vr = *(const LAS f32x4*)(sl + R4_VT + m * 32 + (q & 1) * 16); };
                Ops cur, nxt; rd(0, cur);
#pragma unroll
                for (int cc = 0; cc < R4L_NCB; ++cc) {
                    if (cc + 1 < R4L_NCB) rd(cc + 1, nxt);
                    __builtin_amdgcn_sched_barrier(0);
                    v2u A1u = cur.A1u, A2u = cur.A2u;
                    if (q >= 2) { A1u = (v2u){0u, 0u}; A2u = idf; }
                    v4u b0, b1;
                    b0.x = cvtpk(S[0][0], S[0][1]); b0.y = cvtpk(S[0][2], S[0][3]); b0.z = cvtpk(S[1][0], S[1][1]); b0.w = cvtpk(S[1][2], S[1][3]);
                    b1.x = cvtpk(S[2][0], S[2][1]); b1.y = cvtpk(S[2][2], S[2][3]); b1.z = cvtpk(S[3][0], S[3][1]); b1.w = cvtpk(S[3][2], S[3][3]);
                    f32x4 Dd = mfma16(cur.a0, __builtin_bit_cast(bf16x8_t, b0), (f32x4){0.f, 0.f, 0.f, 0.f});
                    Dd = mfma16(cur.a1, __builtin_bit_cast(bf16x8_t, b1), Dd);
                    v2u vb; vb.x = cvtpk(cur.vr[0], cur.vr[1]); vb.y = cvtpk(cur.vr[2], cur.vr[3]);
                    const f32x4 Z = __builtin_amdgcn_mfma_f32_16x16x16bf16_1k(__builtin_bit_cast(bf16x4_t, A1u), __builtin_bit_cast(bf16x4_t, vb), Dd, 0, 0, 0);
                    v2u zb; zb.x = cvtpk(Z[0], Z[1]); zb.y = cvtpk(Z[2], Z[3]);
                    const f32x4 W = __builtin_amdgcn_mfma_f32_16x16x16bf16_1k(__builtin_bit_cast(bf16x4_t, A2u), __builtin_bit_cast(bf16x4_t, zb), (f32x4){0.f, 0.f, 0.f, 0.f}, 0, 0, 0);
                    v2u wb; wb.x = cvtpk(W[0], W[1]); wb.y = cvtpk(W[2], W[3]);
                    const v2u ub = (q < 2) ? wb : vb;
#pragma unroll
                    for (int T = 0; T < 4; ++T) S[T] = __builtin_amdgcn_mfma_f32_16x16x16bf16_1k(cur.UA[T], __builtin_bit_cast(bf16x4_t, ub), S[T] * cur.g7[T], 0, 0, 0);
                    if (q >= 2) { float* yp = YST + (size_t)(bt * R4L_NCB + cc) * 128;
#pragma unroll
                        for (int i = 0; i < 4; ++i) yp[i * 16] = W[i]; }
                    if (cc + 1 < R4L_NCB) cur = nxt;
                }
            }
            __syncthreads();
        }
        if (wave >= 4) { while (cpend) { ti_store(true, crg, cj.dst, cj.dst_ld, cscr, lane); cit += 4 * (int)gridDim.x; cpend = cit < IT_L1MOE; if (cpend) { cj = conv_job_l1(p, cit); ti_load(cj.src, cj.src_ld, lane, crg); } } }
    }
}

__device__ __forceinline__ void phase_lora2(PP p, LAS unsigned char* lds, int tid, int lane, int wave) {
    const bf16* L1 = (const bf16*)(p->ws + WS_U + U_L1); const bf16* W2 = (const bf16*)(p->ws + WS_WL2);
    const int c16 = lane & 15, kq = lane >> 4;
    const int part = blockIdx.x % 12, wgp = blockIdx.x / 12, nwg = (gridDim.x - part + 11) / 12;
    const int blk = (part < 8) ? (part >> 1) : 4, col0 = (part < 8) ? (part & 1) * 512 : (part - 8) * 256, ncol = (part < 8) ? 512 : 256;
    const int koff = (blk < 4) ? blk * 64 : 256, nks = (blk < 4) ? 2 : 4, K = nks * 32, WP = K * 2 + 16;
    LAS unsigned char* wl = lds;
    constexpr int PS = 272;
    LAS unsigned char* stg = lds + 73728 + wave * (16 * PS);
    { const int ppr = K / 8;
      for (int u = tid; u < ncol * ppr; u += NTHREADS) { const int c = u / ppr, pc = u - c * ppr;
          *(LAS v4u*)(wl + c * WP + pc * 16) = *(const v4u*)(W2 + (size_t)(blk * 1024 + col0 + c) * 384 + koff + pc * 8); } }
    __syncthreads();
    bf16* dstb = (bf16*)(p->ws + WS_U + ((blk < 2) ? U_WD : (blk < 4) ? U_AD : U_G)) + (size_t)((blk < 4) ? (blk & 1) : 0) * NROW * D + col0;
    const float* bias = ((blk < 2) ? p->in[I_DECW0] + blk * D : p->in[I_A0] + ((blk - 2) & 1) * D) + col0;
    for (int rt = wgp * NWAVES + wave; rt < NROW / 16; rt += nwg * NWAVES) {
        const bf16* lp = L1 + (size_t)(rt * 16 + c16) * 384 + koff + 8 * kq;
        bf16x8_t bfr[4];
#pragma unroll
        for (int s = 0; s < 4; ++s) if (s < nks) bfr[s] = *(const bf16x8_t*)(lp + 32 * s);
        bf16* dst = dstb + (size_t)(rt * 16) * D;
        for (int ps = 0; ps < ncol / 128; ++ps) {
#pragma unroll 4
            for (int ct = 0; ct < 8; ++ct) {
                const int c0 = ps * 128 + ct * 16;
                const LAS unsigned char* wp = wl + (c0 + c16) * WP + 16 * kq;
                f32x4 acc = (f32x4){0.f, 0.f, 0.f, 0.f};
#pragma unroll
                for (int s = 0; s < 4; ++s) if (s < nks) acc = mfma16(*(const LAS bf16x8_t*)(wp + 64 * s), bfr[s], acc);
                const f32x4 bb = *(const f32x4*)(bias + c0 + 4 * kq);
                if (blk < 2) { for (int j = 0; j < 4; ++j) acc[j] = -0.60653066f * sigm(acc[j] + bb[j]); }
                else if (blk < 4) { for (int j = 0; j < 4; ++j) acc[j] = sigm(acc[j] + bb[j]); }
                v2u w; w.x = pk2(acc[0], acc[1]); w.y = pk2(acc[2], acc[3]);
                *(LAS v2u*)(stg + c16 * PS + (ct * 16 + 4 * kq) * 2) = w;
            }
            LDS_WAIT(); asm volatile("" ::: "memory");
#pragma unroll
            for (int i = 0; i < 4; ++i) { const int row = 4 * i + (lane >> 4), cb = lane & 15;
                *(v4u*)(dst + (size_t)row * D + ps * 128 + cb * 8) = *(const LAS v4u*)(stg + row * PS + cb * 16); }
            LDS_WAIT(); asm volatile("" ::: "memory");
        }
    }
    __syncthreads();
}
enum { PH_PRE = 0, PH_NORM0, PH_G_IN, PH_GLA_A, PH_GLA_B, PH_GLA_C, PH_G_HGO, PH_FFN0, PH_GU0, PH_DN0, PH_COMB0,
       PH_LERP, PH_G_RKV, PH_G_L2, PH_RWPREP, PH_RWSCAN, PH_RWRO, PH_G_RWO, PH_FFN1, PH_GU1, PH_DN1, PH_COMB1, NPHASES };

template <int ph> __device__ __forceinline__ void run_phase(PP p, LAS unsigned char* lds, int tid, int lane, int wave, int G, int bx, int vcu) {
    unsigned char* ws = p->ws;
    typedef pg8::bf16_t bt;
    switch (ph) {
        case PH_PRE: phase_pre(p, lds, tid, lane, wave); break;
        case PH_NORM0: phase_norm0(p, lane, wave); break;
        case PH_G_IN: {
            pg8::Gemm g{(const bt*)(ws + WS_H), (const bt*)(ws + WS_WIN), NROW, 5120, D}; pg8::StaticOrder S; S.init(NROW, 5120, G, bx);
            pg8::EpiStoreBf16 E{(bt*)(ws + WS_U + U_Z), 5120};
            pg8::gemm_phase<pg8::EpiStoreBf16, pg8::StaticOrder, true, true>(lds, g, S, E); } break;
        case PH_GLA_A: phase_gla_prep(p, lds, tid, lane, wave); break;
        case PH_GLA_B: phase_gla_scan(p, tid); break;
        case PH_GLA_C: phase_gla_out(p, lds, tid, lane, wave); break;
        case PH_G_HGO: {
            pg8::Gemm g{(const bt*)(ws + WS_A2), (const bt*)(ws + WS_WHGO), NROW, D, D}; pg8::StaticOrder S; S.init(NROW, D, G, bx);
            pg8::EpiResid E{p->in[I_X], p->in[I_CTX], (float*)(ws + WS_XR), modp(p, 0, 0, 2), 6144};
            pg8::gemm_phase<pg8::EpiResid, pg8::StaticOrder, true, true>(lds, g, S, E); } break;
        case PH_FFN0: phase_ffn_norm_route(p, 0, NROW, lds, lane, wave); break;
        case PH_FFN1: phase_ffn_norm_route(p, 1, NLAT, lds, lane, wave); break;
        case PH_GU0: case PH_GU1: { const int layer = (ph == PH_GU1);
            pg8::Gemm g{(const bt*)(ws + WS_U + U_XB), (const bt*)(ws + WS_WGU) + (size_t)layer * NE * 2048 * D, CAP, 2048, D};
            const int ntl = (int)((const unsigned*)(ws + WS_CTL))[CW_NT + layer];
            pg8::MoeOrder S; S.init((const int*)(ws + WS_ROUTE + RT_TILEE) + layer * 512, ntl, (LAS int*)(lds + 132096), 8, (size_t)2048 * D * 2, G, vcu);
            pg8::EpiSwiglu E{(bt*)(ws + WS_U + U_ACT), p->in[I_BGU] + (size_t)layer * NE * 2048};
            pg8::gemm_phase<pg8::EpiSwiglu, pg8::MoeOrder, true, true>(lds, g, S, E); } break;
        case PH_DN0: case PH_DN1: { const int layer = (ph == PH_DN1);
            pg8::Gemm g{(const bt*)(ws + WS_U + U_ACT), (const bt*)(ws + WS_WD) + (size_t)layer * NE * D * D, CAP, D, D};
            const int ntl = (int)((const unsigned*)(ws + WS_CTL))[CW_NT + layer];
            pg8::MoeOrder S; S.init((const int*)(ws + WS_ROUTE + RT_TILEE) + layer * 512, ntl, (LAS int*)(lds + 132096), 4, (size_t)D * D * 2, G, vcu);
            pg8::EpiDown E{(bt*)(ws + WS_U + U_YS), p->in[I_BDN] + (size_t)layer * NE * D};
            pg8::gemm_phase<pg8::EpiDown, pg8::MoeOrder, true, true>(lds, g, S, E); } break;
        case PH_COMB0: phase_combine(p, 0, NROW, false, lane, wave); break;
        case PH_COMB1: phase_combine(p, 1, NLAT, true, lane, wave); break;
        case PH_LERP: phase_lerp(p, lane, wave); break;
        case PH_G_RKV: {
            pg8::Gemm g{(const bt*)(ws + WS_U + U_XL6), (const bt*)(ws + WS_WRKV), NROW, 3072, D};
            pg8::RkvL1Order S; S.init(NROW, G, bx, (const bt*)(ws + WS_WL1), (size_t)NROW * D * 2);
            pg8::EpiRkvL1 E{pg8::EpiStoreBf16{(bt*)(ws + WS_U + U_RKV), 3072}, pg8::EpiLora1{(bt*)(ws + WS_U + U_L1)}};
            pg8::gemm_phase<pg8::EpiRkvL1, pg8::RkvL1Order, true, true>(lds, g, S, E); } break;
        case PH_G_L2: phase_lora2(p, lds, tid, lane, wave); break;
        case PH_RWPREP: phase_rw_prep(p, lds, lane, wave); break;
        case PH_RWSCAN: phase_rwkv_scan4(p, lds, vcu, tid, lane, wave); break;
        case PH_RWRO: phase_rw_readout(p, lane, wave); break;
        case PH_G_RWO: {
            pg8::Gemm g{(const bt*)(ws + WS_A2), (const bt*)(ws + WS_WRWO), NLAT, D, D}; pg8::StaticOrder S; S.init(NLAT, D, G, bx);
            float* XR = (float*)(ws + WS_XR);
            pg8::EpiResid E{XR, XR + (size_t)NLAT * D, XR, modp(p, 1, 0, 2), 6144};
            pg8::gemm_phase<pg8::EpiResid, pg8::StaticOrder, true, true>(lds, g, S, E); } break;
        default: break;
    }
}

#define MK_PROLOGUE \
    extern __shared__ __attribute__((aligned(16))) unsigned char lds_raw[]; \
    LAS unsigned char* lds = (LAS unsigned char*)lds_raw; \
    const int tid = threadIdx.x, lane = tid & 63, wave = __builtin_amdgcn_readfirstlane(tid >> 6); \
    const int G = gridDim.x, bx = blockIdx.x, vcu = (G % 8 == 0) ? (bx % 8) * (G / 8) + bx / 8 : bx;

#define XB_TMO      128
#define XB_XCNT(j)  (256  + 64 * (j))
#define XB_XSUB(j)  (1280 + 64 * (j))
#define XB_XGEN(j)  (2304 + 64 * (j))
#define XB_TOP      3328
#define XB_TOPGEN   3392
#define XCD_BAR_WORDS 3456
#define XB_SPIN_CAP (1u << 18)

__device__ __forceinline__ unsigned xb_ld(unsigned* p)              { return __hip_atomic_load(p, __ATOMIC_RELAXED, __HIP_MEMORY_SCOPE_AGENT); }
__device__ __forceinline__ unsigned xb_add(unsigned* p, unsigned v) { return __hip_atomic_fetch_add(p, v, __ATOMIC_RELAXED, __HIP_MEMORY_SCOPE_AGENT); }
__device__ __forceinline__ unsigned xb_xcc_id() { return (unsigned)__builtin_amdgcn_s_getreg((3 << 11) | 20) & 0xFu; }
#define XB_SPIN(cond, bar) do { unsigned _sp = 0; while (cond) { __builtin_amdgcn_s_sleep(1); \
    if ((++_sp & 255u) == 0u) { if (xb_ld(&(bar)[XB_TMO])) break; if (_sp > XB_SPIN_CAP) { atomicAdd(&(bar)[XB_TMO], 1u); break; } } } } while (0)

struct XcdBarrier {
    unsigned* bar; unsigned x;
    volatile LAS unsigned* st;
};

__device__ __forceinline__ XcdBarrier xcd_barrier_post(unsigned* bar, volatile LAS unsigned* st) {
    XcdBarrier b; b.bar = bar; b.x = xb_xcc_id(); b.st = st;
    if (threadIdx.x == 0) (void)xb_add(&bar[XB_XCNT(b.x)], 1u);
    return b;
}
__device__ __forceinline__ void xcd_barrier_complete(unsigned* bar, unsigned x, unsigned& nloc, unsigned& nx) {
    const unsigned G = gridDim.x * gridDim.y * gridDim.z;
    unsigned sum, cnt, mine, sp = 0u;
    for (;;) {
        sum = 0u; cnt = 0u; mine = 0u;
#pragma unroll
        for (unsigned j = 0; j < 16; ++j) { const unsigned c = xb_ld(&bar[XB_XCNT(j)]); sum += c; cnt += (c > 0u) ? 1u : 0u; mine = (j == x) ? c : mine; }
        if (sum == G) break;
        __builtin_amdgcn_s_sleep(1);
        if ((++sp & 255u) == 0u) { if (xb_ld(&bar[XB_TMO])) break; if (sp > XB_SPIN_CAP) { atomicAdd(&bar[XB_TMO], 1u); break; } }
    }
    nloc = mine > 0u ? mine : 1u; nx = cnt > 0u ? cnt : 1u;
}

__device__ __forceinline__ void xcd_barrier(const XcdBarrier& b) {
    asm volatile("s_waitcnt vmcnt(0)" ::: "memory");
    __syncthreads();
    if (threadIdx.x == 0) {
        unsigned* bar = b.bar;
        __builtin_amdgcn_s_waitcnt(0);
        unsigned nloc = b.st[0], nx = b.st[1];
        if (nloc == 0u) { xcd_barrier_complete(bar, b.x, nloc, nx); b.st[0] = nloc; b.st[1] = nx; }
        const unsigned old = xb_add(&bar[XB_XSUB(b.x)], 1u);
        const unsigned gen = old / nloc;
        if (old + 1u == (gen + 1u) * nloc) {
            __builtin_amdgcn_fence(__ATOMIC_RELEASE, "agent");
            asm volatile("s_waitcnt vmcnt(0)" ::: "memory");
            const unsigned og = xb_add(&bar[XB_TOP], 1u);
            const unsigned tg = og / nx;
            if (og + 1u == (tg + 1u) * nx) xb_add(&bar[XB_TOPGEN], 1u);
            else XB_SPIN(xb_ld(&bar[XB_TOPGEN]) == tg, bar);
            __builtin_amdgcn_fence(__ATOMIC_ACQUIRE, "agent");
            xb_add(&bar[XB_XGEN(b.x)], 1u);
            asm volatile("s_waitcnt vmcnt(0)" ::: "memory");
        } else {
            XB_SPIN(xb_ld(&bar[XB_XGEN(b.x)]) == gen, bar);
            __builtin_amdgcn_fence(__ATOMIC_ACQUIRE, "agent");
            asm volatile("s_waitcnt vmcnt(0)" ::: "memory");
        }
    }
    __syncthreads();
}

constexpr int LDSCTL_OFF = 131072, MISC_OFF = LDSCTL_OFF + 320;
__device__ __forceinline__ void grid_bar(PP kp, LAS unsigned char* lds) {
    PP q = kp; asm volatile("" : "+s"(q));
    XcdBarrier b; b.bar = (unsigned*)(q->ws + WS_CTL) + CW_BAR; b.x = xb_xcc_id(); b.st = (volatile LAS unsigned*)(lds + MISC_OFF) + 8;
    xcd_barrier(b);
}
namespace cg = cooperative_groups;
__global__ void __launch_bounds__(NTHREADS, 2) mk_fwd(Params pv) {
    MK_PROLOGUE
    cg::grid_group grid = cg::this_grid();
    PP kp = (PP)__builtin_amdgcn_kernarg_segment_ptr();
    const int lo = kp->ph_lo, hi = kp->ph_hi;
    for (int u = tid; u < (LDS_BYTES - LDSCTL_OFF) / 4; u += NTHREADS) ((LAS unsigned*)(lds + LDSCTL_OFF))[u] = 0u;
    __syncthreads();
    { XcdBarrier b0 = xcd_barrier_post((unsigned*)(kp->ws + WS_CTL) + CW_BAR, (volatile LAS unsigned*)(lds + MISC_OFF) + 8); (void)b0; }
#ifndef REPEAT_MASK
#define REPEAT_MASK 0u
#endif
#define RUN(k) if (lo <= (k) && (k) < hi) { PP q = kp; asm volatile("" : "+s"(q)); run_phase<k>(q, lds, tid, lane, wave, G, bx, vcu); \
        if ((REPEAT_MASK >> (k)) & 1u) { grid_bar(kp, lds); PP q2 = kp; asm volatile("" : "+s"(q2)); run_phase<k>(q2, lds, tid, lane, wave, G, bx, vcu); } \
        if ((k) + 1 < hi) { if ((k) == 0) grid.sync(); else grid_bar(kp, lds); } }
    RUN(0) RUN(1) RUN(2) RUN(3) RUN(4) RUN(5) RUN(6) RUN(7) RUN(8) RUN(9) RUN(10) RUN(11) RUN(12) RUN(13) RUN(14) RUN(15) RUN(16) RUN(17) RUN(18) RUN(19) RUN(20) RUN(21)
#undef RUN
}

extern "C" void kernel_launch(void* const* d_in, const int* in_sizes, int n_in, void* d_out, int out_size, void* d_ws, size_t ws_size, hipStream_t stream) {
    static int grid = 0;
    if (grid == 0) {
        if (n_in != 35 || in_sizes[0] != NLAT * D || out_size != NLAT * D || ws_size < WS_END) {
            fprintf(stderr, "kernel_launch: unexpected problem (n_in %d, in0 %d, out %d, ws %zu < %zu)\n", n_in, n_in > 0 ? in_sizes[0] : -1, out_size, ws_size, (size_t)WS_END); grid = -1; return; }
        int dev = 0, cus = 0, per_cu = 0;
        if (hipGetDevice(&dev) != hipSuccess || hipDeviceGetAttribute(&cus, hipDeviceAttributeMultiprocessorCount, dev) != hipSuccess) { grid = -1; return; }
        if (hipFuncSetAttribute((const void*)mk_fwd, hipFuncAttributeMaxDynamicSharedMemorySize, LDS_BYTES) != hipSuccess) { fprintf(stderr, "kernel_launch: hipFuncSetAttribute failed\n"); grid = -1; return; }
        if (hipOccupancyMaxActiveBlocksPerMultiprocessor(&per_cu, (const void*)mk_fwd, NTHREADS, LDS_BYTES) != hipSuccess || per_cu < 1) { fprintf(stderr, "kernel_launch: occupancy query %d\n", per_cu); per_cu = 1; }
        (void)hipGetLastError();
        grid = cus * (per_cu < 1 ? 1 : per_cu);
    }
    if (grid < 0) return;
    (void)hipMemsetAsync((char*)d_ws + WS_CTL, 0, CTL_ZERO_BYTES, stream);
    Params p{};
    for (int i = 0; i < 35; ++i) p.in[i] = (const float*)d_in[i];
    p.out = (float*)d_out; p.ws = (unsigned char*)d_ws;
    p.ph_lo = 0; p.ph_hi = NPHASES;
    void* args[] = {&p};
    hipError_t e = hipLaunchCooperativeKernel((const void*)mk_fwd, dim3(grid), dim3(NTHREADS), args, LDS_BYTES, stream);
    if (e != hipSuccess) fprintf(stderr, "kernel_launch: cooperative launch failed: %s (grid %d)\n", hipGetErrorString(e), grid);
}
```

```cpp
#include <hip/hip_runtime.h>
#include <hip/hip_cooperative_groups.h>
#include <cstdio>
#include <cstdint>

namespace pg8 {
#define PG8_LAS __attribute__((address_space(3)))
typedef unsigned short bf16_t;
typedef short bf16x8 __attribute__((ext_vector_type(8)));
typedef float f32x4 __attribute__((ext_vector_type(4)));
typedef unsigned u32x4 __attribute__((ext_vector_type(4)));
constexpr int BM = 256, BK = 64, HALF = 128, HTB = HALF * BK * 2  , STAGE_BYTES = 8 * HTB, NXCD = 8, WGM = 8;

__host__ __device__ __forceinline__ int lds_byte(int r, int c) { const int st = (r >> 4) * 2 + (c >> 5), rr = r & 15, cc = c & 31, ob = rr * 64 + cc * 2; return st * 1024 + (ob ^ (((ob >> 9) & 1) << 5)); }
__host__ __device__ __forceinline__ void stage_rc(int b, int& R, int& C) { const int st = b / 1024, sb = b % 1024, swz = sb ^ (((sb >> 9) & 1) << 5); R = (st >> 1) * 16 + swz / 64; C = (st & 1) * 32 + (swz % 64) / 2; }
__host__ __device__ __forceinline__ int perm32(int rho) { const int n = rho >> 4, i = rho & 15; return 8 * (i >> 2) + 4 * n + (i & 3); }

struct Unit { int pm, pn, e; };
struct Gemm { const bf16_t* A; const bf16_t* Bt; int M, N, K; };

struct StaticOrder {
    int nM, nN, nwg, G, c;
    __host__ __device__ void init(int M, int N, int G_, int c_) { nM = M / BM; nN = N / BM; nwg = nM * nN; G = G_; c = c_; }
    __host__ __device__ bool next(int i, Unit& u) const { return at((long)i * G + c, u); }
    __host__ __device__ bool at(long L, Unit& u) const {
        if (L >= nwg) return false;
        int wgid = (int)L; { const int q = nwg / NXCD, r = nwg % NXCD, xcd = wgid % NXCD, off = wgid / NXCD; wgid = (xcd < r ? xcd * (q + 1) : r * (q + 1) + (xcd - r) * q) + off; }
        const int nig = WGM * nN, gid = wgid / nig, fm = gid * WGM, gsz = (nM - fm) < WGM ? (nM - fm) : WGM;
        u.pm = fm + ((wgid % nig) % gsz); u.pn = (wgid % nig) / gsz; u.e = 0; return true;
    }
    __device__ __forceinline__ const char* abase(const Gemm& g, const Unit& u, size_t tstep) const { return (const char*)g.A + (size_t)u.pm * tstep; }
    __device__ __forceinline__ const char* bbase(const Gemm& g, const Unit& u, size_t tstep) const { return (const char*)g.Bt + (size_t)u.pn * tstep; }
    __device__ __forceinline__ void a_ready(const Unit&) const {}
    __device__ __forceinline__ void done(const Unit&) const {}
};

__device__ __forceinline__ unsigned cvt_pk_bf16(float lo, float hi) { unsigned r; asm volatile("v_cvt_pk_bf16_f32 %0, %1, %2" : "=v"(r) : "v"(lo), "v"(hi)); return r; }

typedef int v4i_t __attribute__((ext_vector_type(4))); typedef int v8i_t __attribute__((ext_vector_type(8)));
template <bool FP8> struct Frag { bf16x8 v[2]; };
template <> struct Frag<true> { v8i_t v; };
__device__ __forceinline__ void ld_frag(Frag<false>& f, const PG8_LAS unsigned char* p0) { f.v[0] = *(const PG8_LAS bf16x8*)(p0); f.v[1] = *(const PG8_LAS bf16x8*)(p0 + 1024); }
__device__ __forceinline__ void ld_frag(Frag<true>& f, const PG8_LAS unsigned char* p0) { const v4i_t lo = *(const PG8_LAS v4i_t*)(p0), hi = *(const PG8_LAS v4i_t*)(p0 + 1024); f.v = (v8i_t){lo.x, lo.y, lo.z, lo.w, hi.x, hi.y, hi.z, hi.w}; }
__device__ __forceinline__ f32x4 mma_frag(const Frag<false>& b, const Frag<false>& a, f32x4 c) { c = __builtin_amdgcn_mfma_f32_16x16x32_bf16(b.v[0], a.v[0], c, 0, 0, 0); return __builtin_amdgcn_mfma_f32_16x16x32_bf16(b.v[1], a.v[1], c, 0, 0, 0); }
__device__ __forceinline__ f32x4 mma_frag(const Frag<true>& b, const Frag<true>& a, f32x4 c) {
    const int sw = 0x7A7A7A7A, sa = 0x7F7F7F7F;
    asm volatile("v_mfma_scale_f32_16x16x128_f8f6f4 %0, %1, %2, %0, %3, %4 op_sel_hi:[0,0,0]" : "+v"(c) : "v"(b.v), "v"(a.v), "v"(sw), "v"(sa));
    return c;
}

template <class Epi, class Sched, bool ALIGN_EPI = false, bool SP2 = false, bool FP8 = false>
__device__ __forceinline__ void gemm_phase(PG8_LAS unsigned char* lds, const Gemm g, const Sched& S, const Epi& E) {
    const int tid = threadIdx.x, wid = __builtin_amdgcn_readfirstlane(tid >> 6), lane = tid & 63, wr = wid >> 2, wc = wid & 3, fr = lane & 15, fq = lane >> 4;
    const int K = g.K, nt = K / BK;
    unsigned voffA[2], voffB[2];
#pragma unroll
    for (int i = 0; i < 2; ++i) { int R, C; stage_rc(tid * 16 + i * 8192, R, C); const int Rb = Epi::PERM ? ((R & ~31) + perm32(R & 31)) : R;
        voffA[i] = (unsigned)(R * K + C) * 2u; voffB[i] = (unsigned)(Rb * K + C) * 2u; }
    const size_t kstep = (size_t)(BK * 2);
    const size_t hstep = (size_t)HALF * K * 2;
    const size_t tstep = 2 * hstep;
    const unsigned ldsw = (unsigned)wid * 1024u;
    const int aoff = lds_byte(wr * 64 + fr, fq * 8), boff = lds_byte(wc * 32 + fr, fq * 8);
#define PG8_SA(b, h) (((b) * 2 + (h)) * HTB)
#define PG8_SB(b, h) ((4 + (b) * 2 + (h)) * HTB)
#define PG8_STAGE(bufoff, gbase, voff) do { _Pragma("unroll") for (int _i = 0; _i < 2; ++_i) \
        __builtin_amdgcn_global_load_lds((const unsigned*)((const char*)(gbase) + (voff)[_i]), (PG8_LAS unsigned*)(lds + (bufoff) + ldsw + _i * 8192), 16, 0, 0); } while (0)
#define PG8_LDA(dst, b, h) do { _Pragma("unroll") for (int m = 0; m < 4; ++m) ld_frag(dst[m], lds + PG8_SA(b, h) + aoff + m * 2048); } while (0)
#define PG8_LDB(dst, b, h) do { _Pragma("unroll") for (int n = 0; n < 2; ++n) ld_frag(dst[n], lds + PG8_SB(b, h) + boff + n * 2048); } while (0)
#define PG8_MMA(ai, bj, At, Bt) do { __builtin_amdgcn_s_setprio(1); _Pragma("unroll") for (int m = 0; m < 4; ++m) _Pragma("unroll") for (int n = 0; n < 2; ++n) \
        acc[ai][bj][m][n] = mma_frag(Bt[n], At[m], acc[ai][bj][m][n]); __builtin_amdgcn_s_setprio(0); } while (0)
#define PG8_WAIT_V(n) asm volatile("s_waitcnt vmcnt(" #n ")" ::: "memory")
#define PG8_WAIT_L(n) asm volatile("s_waitcnt lgkmcnt(" #n ")" ::: "memory")
#define PG8_BAR __builtin_amdgcn_s_barrier()
#define PG8_SCHED __builtin_amdgcn_sched_barrier(0)
    Unit cur, nxt; int ui = 0;
    if (!S.next(0, cur)) return;
    f32x4 acc[2][2][4][2];
#pragma unroll
    for (int a = 0; a < 2; ++a)
#pragma unroll
        for (int b = 0; b < 2; ++b)
#pragma unroll
            for (int m = 0; m < 4; ++m)
#pragma unroll
                for (int n = 0; n < 2; ++n) acc[a][b][m][n] = (f32x4){0.f, 0.f, 0.f, 0.f};
    Frag<FP8> At[4], B0[2], B1[2];
    const char* cA = S.abase(g, cur, tstep); const char* cB = S.bbase(g, cur, tstep);
    S.a_ready(cur);
    if constexpr (SP2) {
        PG8_STAGE(PG8_SB(0, 0), cB, voffB); PG8_STAGE(PG8_SB(0, 1), cB + hstep, voffB); PG8_STAGE(PG8_SA(0, 0), cA, voffA); PG8_STAGE(PG8_SA(0, 1), cA + hstep, voffA);
        if (wr == 1) PG8_BAR;
        PG8_WAIT_V(2); PG8_BAR;
        PG8_STAGE(PG8_SB(1, 0), cB + kstep, voffB); PG8_STAGE(PG8_SA(1, 0), cA + kstep, voffA); PG8_STAGE(PG8_SB(1, 1), cB + hstep + kstep, voffB);
        PG8_WAIT_V(6); PG8_BAR;
    } else {
        PG8_STAGE(PG8_SB(0, 0), cB, voffB); PG8_STAGE(PG8_SA(0, 0), cA, voffA); PG8_STAGE(PG8_SB(0, 1), cB + hstep, voffB); PG8_STAGE(PG8_SA(0, 1), cA + hstep, voffA);
        if (wr == 1) PG8_BAR;
        PG8_WAIT_V(4); PG8_BAR;
        PG8_STAGE(PG8_SB(1, 0), cB + kstep, voffB); PG8_STAGE(PG8_SA(1, 0), cA + kstep, voffA); PG8_STAGE(PG8_SB(1, 1), cB + hstep + kstep, voffB);
        PG8_WAIT_V(6); PG8_BAR;
    }
    for (;;) {
        const bool has_next = S.next(ui + 1, nxt);
        const char* nA = has_next ? S.abase(g, nxt, tstep) : cA; const char* nB = has_next ? S.bbase(g, nxt, tstep) : cB;
        _Pragma("unroll 1") for (int t = 0; t < nt; t += 2) {
            const bool last = (t == nt - 2);
            const char* a1 = cA + (size_t)(t + 1) * kstep;
            const char* a2 = last ? nA : cA + (size_t)(t + 2) * kstep; const char* b2 = last ? nB : cB + (size_t)(t + 2) * kstep;
            const char* a3 = a2 + kstep; const char* b3 = b2 + kstep;
            if (last && has_next) S.a_ready(nxt);
            if constexpr (SP2) {
            PG8_LDB(B0, 0, 0); PG8_LDB(B1, 0, 1); PG8_SCHED; PG8_LDA(At, 0, 0); PG8_STAGE(PG8_SA(1, 1), a1 + hstep, voffA);
            PG8_WAIT_V(8); PG8_WAIT_L(0); PG8_BAR; PG8_MMA(0, 0, At, B0); PG8_MMA(0, 1, At, B1); PG8_BAR; PG8_SCHED;
            PG8_LDA(At, 0, 1); PG8_STAGE(PG8_SB(0, 0), b2, voffB); PG8_STAGE(PG8_SB(0, 1), b2 + hstep, voffB); PG8_STAGE(PG8_SA(0, 0), a2, voffA);
            PG8_WAIT_V(8); PG8_WAIT_L(0); PG8_BAR; PG8_MMA(1, 0, At, B0); PG8_MMA(1, 1, At, B1); PG8_BAR; PG8_SCHED;
            PG8_LDB(B0, 1, 0); PG8_LDB(B1, 1, 1); PG8_SCHED; PG8_LDA(At, 1, 0); PG8_STAGE(PG8_SA(0, 1), a2 + hstep, voffA);
            PG8_WAIT_V(8); PG8_WAIT_L(0); PG8_BAR; PG8_MMA(0, 0, At, B0); PG8_MMA(0, 1, At, B1); PG8_BAR; PG8_SCHED;
            PG8_LDA(At, 1, 1); PG8_STAGE(PG8_SB(1, 0), b3, voffB); PG8_STAGE(PG8_SB(1, 1), b3 + hstep, voffB); PG8_STAGE(PG8_SA(1, 0), a3, voffA);
            PG8_WAIT_V(8); PG8_WAIT_L(0); PG8_BAR; PG8_MMA(1, 0, At, B0); PG8_MMA(1, 1, At, B1); PG8_BAR; PG8_SCHED;
            } else {
            PG8_LDB(B0, 0, 0); PG8_SCHED; PG8_LDA(At, 0, 0); PG8_STAGE(PG8_SA(1, 1), a1 + hstep, voffA);
            PG8_WAIT_L(8); PG8_BAR; PG8_WAIT_L(0); PG8_MMA(0, 0, At, B0); PG8_BAR; PG8_SCHED;
            PG8_LDB(B1, 0, 1); PG8_STAGE(PG8_SB(0, 0), b2, voffB);
            PG8_BAR; PG8_WAIT_L(0); PG8_MMA(0, 1, At, B1); PG8_BAR;
            PG8_LDA(At, 0, 1); PG8_STAGE(PG8_SA(0, 0), a2, voffA);
            PG8_BAR; PG8_WAIT_L(0); PG8_MMA(1, 0, At, B0); PG8_BAR; PG8_SCHED;
            PG8_STAGE(PG8_SB(0, 1), b2 + hstep, voffB);
            PG8_WAIT_V(6); PG8_BAR; PG8_MMA(1, 1, At, B1); PG8_BAR;
            PG8_LDB(B0, 1, 0); PG8_SCHED; PG8_LDA(At, 1, 0); PG8_STAGE(PG8_SA(0, 1), a2 + hstep, voffA);
            PG8_WAIT_L(8); PG8_BAR; PG8_WAIT_L(0); PG8_MMA(0, 0, At, B0); PG8_BAR; PG8_SCHED;
            PG8_LDB(B1, 1, 1); PG8_STAGE(PG8_SB(1, 0), b3, voffB);
            PG8_BAR; PG8_WAIT_L(0); PG8_MMA(0, 1, At, B1); PG8_BAR;
            PG8_LDA(At, 1, 1); PG8_STAGE(PG8_SA(1, 0), a3, voffA);
            PG8_BAR; PG8_WAIT_L(0); PG8_MMA(1, 0, At, B0); PG8_BAR; PG8_SCHED;
            PG8_STAGE(PG8_SB(1, 1), b3 + hstep, voffB);
            PG8_WAIT_V(6); PG8_BAR; PG8_MMA(1, 1, At, B1); PG8_BAR;
            }
        }
        if constexpr (FP8) { asm volatile("s_nop 15\n\ts_nop 15" ::: "memory"); }
        if constexpr (ALIGN_EPI) { if (wr == 0) PG8_BAR; }
        if constexpr (!Epi::AFTER_DRAIN) { E(acc, cur, wr, wc, fr, fq); S.done(cur); }
        if (!has_next) break;
#pragma unroll
        for (int a = 0; a < 2; ++a)
#pragma unroll
            for (int b = 0; b < 2; ++b)
#pragma unroll
                for (int m = 0; m < 4; ++m)
#pragma unroll
                    for (int n = 0; n < 2; ++n) acc[a][b][m][n] = (f32x4){0.f, 0.f, 0.f, 0.f};
        cur = nxt; cA = nA; cB = nB; ++ui;
        if constexpr (ALIGN_EPI) { if (wr == 1) PG8_BAR; }
    }
    PG8_WAIT_V(0);
    if constexpr (!ALIGN_EPI) { if (wr == 0) PG8_BAR; }
    PG8_BAR;
    if constexpr (Epi::AFTER_DRAIN) { E.fused(acc, cur, wr, wc, fr, fq, lds, wid, lane); S.done(cur); }
#undef PG8_SA
#undef PG8_SB
#undef PG8_STAGE
#undef PG8_LDA
#undef PG8_LDB
#undef PG8_MMA
#undef PG8_WAIT_V
#undef PG8_WAIT_L
#undef PG8_BAR
#undef PG8_SCHED
}
}

constexpr int D = 1024, NBATCH = 2, SEQ = 8192, CTXL = 256;
constexpr int NLAT = NBATCH * SEQ, NCTX = NBATCH * CTXL, NROW = NLAT + NCTX;
constexpr int NE = 32, TOPK = 4, MAXTILES = 296, CAP = MAXTILES * 256;
constexpr int NWAVES = 8, NTHREADS = 512;
constexpr float NORM_EPS = 1e-6f;
constexpr int LDS_BYTES = 147456;

constexpr size_t MiB = 1u << 20;
constexpr size_t WS_CTL = 0, CTL_ZERO_BYTES = 1 * MiB;
constexpr size_t WS_MOD = 1 * MiB;
constexpr size_t WS_ROUTE = 2 * MiB;
constexpr size_t RT_TOPI = 0, RT_TOPG = 320 * 1024, RT_POS = 640 * 1024, RT_SLOT = 960 * 1024, RT_RSTD = 1280 * 1024, RT_TILEE = 1408 * 1024;
constexpr size_t WS_WIN = 4 * MiB, WS_WHGO = 14 * MiB, WS_WRKV = 16 * MiB, WS_WL1 = 22 * MiB, WS_WL2 = 24 * MiB, WS_WRWO = 28 * MiB;
constexpr size_t WS_WGU = 32 * MiB, WS_WD = 288 * MiB;
constexpr size_t WS_XR = 416 * MiB, WS_H = 482 * MiB, WS_H2 = 515 * MiB, WS_A2 = 548 * MiB;
constexpr size_t WS_U = 584 * MiB;
constexpr size_t U_Z = 0, U_OD0 = 166 * MiB;
constexpr size_t U_XL6 = 0, U_RKV = 198 * MiB, U_L1 = 396 * MiB, U_WD = 410 * MiB, U_AD = 542 * MiB, U_G = 674 * MiB, U_OD1 = 740 * MiB;
constexpr size_t U_XB = 0, U_ACT = 148 * MiB, U_YS = 296 * MiB;
constexpr size_t WS_END = WS_U + 1352 * MiB;
constexpr int CW_CNT = 16384, CNT_STRIDE = 64;
constexpr int CW_NT = 128;
constexpr int CW_TOF = 8192, TOF_PER = 72;
constexpr int CW_BAR = 4096;

#define LAS __attribute__((address_space(3)))
typedef unsigned short bf16;
typedef unsigned v4u __attribute__((ext_vector_type(4)));
typedef unsigned v2u __attribute__((ext_vector_type(2)));
typedef float f32x4 __attribute__((ext_vector_type(4)));
#define LDS_WAIT() asm volatile("s_waitcnt lgkmcnt(0)" ::: "memory")
typedef float f32x2c __attribute__((ext_vector_type(2))); typedef __bf16 bf16x2c __attribute__((ext_vector_type(2)));
__device__ __forceinline__ unsigned pk2(float lo, float hi) { const f32x2c v = {lo, hi}; const bf16x2c b = __builtin_convertvector(v, bf16x2c); return __builtin_bit_cast(unsigned, b); }
__device__ __forceinline__ unsigned f2bf(float f) { return pk2(f, 0.f) & 0xffffu; }
__device__ __forceinline__ unsigned pk4_fp8(float a, float b, float c, float d) { unsigned w = 0u; w = __builtin_amdgcn_cvt_pk_fp8_f32(a, b, w, false); return __builtin_amdgcn_cvt_pk_fp8_f32(c, d, w, true); }
__device__ __forceinline__ float bf2f(unsigned b) { return __builtin_bit_cast(float, b << 16); }
__device__ __forceinline__ float wave_sum(float x) {
    x += __builtin_bit_cast(float, __builtin_amdgcn_update_dpp(0, __builtin_bit_cast(int, x), 0x128, 0xf, 0xf, false));
    x += __builtin_bit_cast(float, __builtin_amdgcn_update_dpp(0, __builtin_bit_cast(int, x), 0x124, 0xf, 0xf, false));
    x += __builtin_bit_cast(float, __builtin_amdgcn_update_dpp(0, __builtin_bit_cast(int, x), 0x122, 0xf, 0xf, false));
    x += __builtin_bit_cast(float, __builtin_amdgcn_update_dpp(0, __builtin_bit_cast(int, x), 0x121, 0xf, 0xf, false));
    x += __builtin_bit_cast(float, __builtin_amdgcn_update_dpp(0, __builtin_bit_cast(int, x), 0x142, 0xa, 0xf, false));
    x += __builtin_bit_cast(float, __builtin_amdgcn_update_dpp(0, __builtin_bit_cast(int, x), 0x143, 0xc, 0xf, false));
    return __builtin_bit_cast(float, __builtin_amdgcn_readlane(__builtin_bit_cast(int, x), 63));
}
__device__ __forceinline__ float sigm(float x) { return __builtin_amdgcn_rcpf(1.0f + __expf(-x)); }

struct Params { const float* in[35]; float* out; unsigned char* ws; int ph_lo, ph_hi; };
typedef const __attribute__((address_space(4))) Params* PP;
enum { I_X = 0, I_C, I_CTX, I_CCTX, I_ADAW, I_ADAB, I_NMIX, I_NFFN, I_HGWIN, I_HGGN, I_HGWOUT, I_HGLB, I_MU, I_WRKV, I_DECW0, I_DECW1, I_DECW2,
       I_A0, I_A1, I_A2, I_G1, I_G2, I_KK, I_KA, I_RK, I_LNXW, I_LNXB, I_RWOUT, I_ROUTW, I_ROUTB, I_WGU, I_BGU, I_WDN, I_BDN, I_FINALG };

__device__ __forceinline__ const float* modp(PP p, int l, int v, int j) { return (const float*)(p->ws + WS_MOD) + ((size_t)(l * 3 + v) * 6 + j) * D; }
__device__ __forceinline__ int row_vec(int row) { return row < NLAT ? (row >= SEQ ? 1 : 0) : 2; }

__device__ __forceinline__ void ti_load(const float* src, int src_ld, int lane, float (&rg)[32]) {
    if (src) {
#pragma unroll
        for (int i = 0; i < 32; ++i) rg[i] = src[(size_t)(2 * i + (lane >> 5)) * src_ld + (lane & 31)];
    }
}
__device__ __forceinline__ void ti_store(bool nonzero, int fp8, const float (&rg)[32], unsigned char* dst, int dst_ldb, LAS float* scr, int lane) {
    if (nonzero) {
#pragma unroll
        for (int i = 0; i < 32; ++i) scr[(2 * i + (lane >> 5)) * 33 + (lane & 31)] = rg[i];
    }
    LDS_WAIT(); asm volatile("" ::: "memory");
    if (fp8) {
        const int n = lane >> 1, hk = (lane & 1) * 32; const LAS float* s = scr + hk * 33 + n; unsigned w[8];
#pragma unroll
        for (int q = 0; q < 8; ++q) w[q] = pk4_fp8(s[(4 * q) * 33] * 32.f, s[(4 * q + 1) * 33] * 32.f, s[(4 * q + 2) * 33] * 32.f, s[(4 * q + 3) * 33] * 32.f);
        v4u* d = (v4u*)(dst + (size_t)n * dst_ldb + hk); d[0] = (v4u){w[0], w[1], w[2], w[3]}; d[1] = (v4u){w[4], w[5], w[6], w[7]};
    } else {
        const int c = lane & 7;
#pragma unroll
        for (int j = 0; j < 4; ++j) {
            const int n = (lane >> 3) + 8 * j; v4u o = (v4u){0u, 0u, 0u, 0u};
            if (nonzero) { const LAS float* s = scr + (8 * c) * 33 + n;
                o.x = pk2(s[0 * 33], s[1 * 33]); o.y = pk2(s[2 * 33], s[3 * 33]); o.z = pk2(s[4 * 33], s[5 * 33]); o.w = pk2(s[6 * 33], s[7 * 33]); }
            *(v4u*)(dst + (size_t)n * dst_ldb + 16 * c) = o;
        }
    }
    LDS_WAIT(); asm volatile("" ::: "memory");
}
__device__ __forceinline__ void ti_load4(const float* src, int src_ld, int lane, f32x4 (&rg)[8]) {
#pragma unroll
    for (int i = 0; i < 8; ++i) rg[i] = *(const f32x4*)(src + (size_t)(8 * i + (lane >> 3)) * src_ld + 4 * (lane & 7));
}
__device__ __forceinline__ void ti_store4_fp8(const f32x4 (&rg)[8], unsigned char* dst, int dst_ldb, LAS float* scr, int lane) {
#pragma unroll
    for (int i = 0; i < 8; ++i) *(LAS f32x4*)(scr + (8 * i + (lane >> 3)) * 36 + 4 * (lane & 7)) = rg[i];
    LDS_WAIT(); asm volatile("" ::: "memory");
    const int n = lane >> 1, hk = (lane & 1) * 32; const LAS float* s = scr + hk * 36 + n; unsigned w[8];
#pragma unroll
    for (int q = 0; q < 8; ++q) w[q] = pk4_fp8(s[(4 * q) * 36] * 32.f, s[(4 * q + 1) * 36] * 32.f, s[(4 * q + 2) * 36] * 32.f, s[(4 * q + 3) * 36] * 32.f);
    v4u* d = (v4u*)(dst + (size_t)n * dst_ldb + hk); d[0] = (v4u){w[0], w[1], w[2], w[3]}; d[1] = (v4u){w[4], w[5], w[6], w[7]};
    LDS_WAIT(); asm volatile("" ::: "memory");
}
struct ConvJob { const float* src; int src_ld; unsigned char* dst; int dst_ldb; int fp8; };
__device__ __forceinline__ ConvJob job_plain(const float* W, int K, int N, bf16* WT, int r) {
    const int nblk = N / 32, kb = r / nblk, nb = r % nblk;
    return ConvJob{W + (size_t)(kb * 64) * N + nb * 32, N, (unsigned char*)(WT + (size_t)(nb * 32) * K + kb * 64), K * 2, 0};
}
constexpr int IT_WIN = 16 * 160, IT_SQ = 16 * 32, IT_L1 = 16 * 24, IT_L2 = 160 * 6, IT_GU = 64 * 16 * 64, IT_DN = 64 * 16 * 32;
constexpr int IT_GU0 = IT_GU / 2, IT_DN0 = IT_DN / 2;
constexpr int IT_TOTAL = IT_WIN + IT_SQ + 3 * IT_SQ + IT_SQ + IT_L1 + IT_L2 + IT_GU0 + IT_DN0, IT_L1MOE = IT_GU0 + IT_DN0;
__device__ __forceinline__ ConvJob conv_job(PP p, int it) {
    unsigned char* ws = p->ws; int r = it;
    if (r < IT_WIN) { const int kb = r / 160, nb = r % 160;
        return ConvJob{p->in[I_HGWIN] + (size_t)(kb * 64) * 5120 + nb * 32, 5120, ws + WS_WIN + (size_t)(nb * 32) * D + kb * 64, D, 1}; } r -= IT_WIN;
    if (r < IT_SQ) return job_plain(p->in[I_HGWOUT], D, D, (bf16*)(ws + WS_WHGO), r); r -= IT_SQ;
    if (r < 3 * IT_SQ) { const int j = r / IT_SQ; return job_plain(p->in[I_WRKV] + (size_t)j * D * D, D, D, (bf16*)(ws + WS_WRKV) + (size_t)j * D * D, r % IT_SQ); } r -= 3 * IT_SQ;
    if (r < IT_SQ) return job_plain(p->in[I_RWOUT], D, D, (bf16*)(ws + WS_WRWO), r); r -= IT_SQ;
    if (r < IT_L1) {
        const int kb = r / 24, rg = r % 24, tile = rg >> 3, within = rg & 7; const float* src = nullptr; int ld = 64;
        if (within < 4) {
            if (tile == 0) src = p->in[I_DECW1] + (size_t)(within >> 1) * D * 64 + (size_t)(kb * 64) * 64 + (within & 1) * 32;
            else if (tile == 1) src = p->in[I_A1] + (size_t)(within >> 1) * D * 64 + (size_t)(kb * 64) * 64 + (within & 1) * 32;
            else { src = p->in[I_G1] + (size_t)(kb * 64) * 128 + within * 32; ld = 128; }
        }
        return ConvJob{src, ld, (unsigned char*)((bf16*)(ws + WS_WL1) + (size_t)(rg * 32) * D + kb * 64), D * 2, 0}; } r -= IT_L1;
    if (r < IT_L2) {
        const int rg = r / 6, kb = r % 6, n0 = rg * 32, blk = n0 >> 10, nn0 = n0 & 1023; const float* src = nullptr;
        if (blk < 2) { if (kb == blk) src = p->in[I_DECW2] + (size_t)blk * 64 * D + nn0; }
        else if (blk < 4) { if (kb == blk) src = p->in[I_A2] + (size_t)(blk - 2) * 64 * D + nn0; }
        else { if (kb >= 4) src = p->in[I_G2] + (size_t)(kb - 4) * 64 * D + nn0; }
        return ConvJob{src, D, (unsigned char*)((bf16*)(ws + WS_WL2) + (size_t)n0 * 384 + kb * 64), 384 * 2, 0}; } r -= IT_L2;
    if (r < IT_GU0) {
        const int mat = r >> 10, q = r & 1023, kb = q >> 6, nb = q & 63, n0 = nb * 32;
        const int j0 = n0 & 1023, drow = 256 * (j0 >> 7) + (n0 >= 1024 ? 128 : 0) + (j0 & 127);
        return ConvJob{p->in[I_WGU] + (size_t)mat * D * 2048 + (size_t)(kb * 64) * 2048 + n0, 2048, ws + WS_WGU + (size_t)mat * 2048 * D + (size_t)drow * D + kb * 64, D, 1}; } r -= IT_GU0;
    { const int mat = r >> 9, q = r & 511, kb = q >> 5, nb = q & 31;
      return ConvJob{p->in[I_WDN] + (size_t)mat * D * D + (size_t)(kb * 64) * D + nb * 32, D, ws + WS_WD + (size_t)mat * D * D + (size_t)(nb * 32) * D + kb * 64, D, 1}; }
}
__device__ __forceinline__ ConvJob conv_job_l1(PP p, int r) {
    unsigned char* ws = p->ws;
    if (r < IT_GU0) { const int mat = 32 + (r >> 10), q = r & 1023, kb = q >> 6, nb = q & 63, n0 = nb * 32;
        const int j0 = n0 & 1023, drow = 256 * (j0 >> 7) + (n0 >= 1024 ? 128 : 0) + (j0 & 127);
        return ConvJob{p->in[I_WGU] + (size_t)mat * D * 2048 + (size_t)(kb * 64) * 2048 + n0, 2048, ws + WS_WGU + (size_t)mat * 2048 * D + (size_t)drow * D + kb * 64, D, 1}; }
    r -= IT_GU0;
    { const int mat = 32 + (r >> 9), q = r & 511, kb = q >> 5, nb = q & 31;
      return ConvJob{p->in[I_WDN] + (size_t)mat * D * D + (size_t)(kb * 64) * D + nb * 32, D, ws + WS_WD + (size_t)mat * D * D + (size_t)(nb * 32) * D + kb * 64, D, 1}; }
}
__device__ __forceinline__ void phase_pre(PP p, LAS unsigned char* lds, int tid, int lane, int wave) {
    if (blockIdx.x < 192) {
        const int layer = blockIdx.x / 96, col = (blockIdx.x % 96) * 64 + lane;
        const float* W = p->in[I_ADAW] + (size_t)layer * D * 6144 + col;
        const float* c = p->in[I_C]; const float* cc = p->in[I_CCTX];
        float a0 = 0.f, a1 = 0.f, a2 = 0.f;
#pragma unroll 8
        for (int k = wave * 128; k < wave * 128 + 128; ++k) {
            const float wv = W[(size_t)k * 6144]; const float c0 = c[k], c1 = c[D + k], c2 = cc[k];
            a0 += c0 * sigm(c0) * wv; a1 += c1 * sigm(c1) * wv; a2 += c2 * sigm(c2) * wv;
        }
        LAS float* red = (LAS float*)lds;
        red[(wave * 3 + 0) * 64 + lane] = a0; red[(wave * 3 + 1) * 64 + lane] = a1; red[(wave * 3 + 2) * 64 + lane] = a2;
        __syncthreads();
        if (wave == 0) {
            float s0 = 0.f, s1 = 0.f, s2 = 0.f;
#pragma unroll
            for (int w = 0; w < 8; ++w) { s0 += red[(w * 3 + 0) * 64 + lane]; s1 += red[(w * 3 + 1) * 64 + lane]; s2 += red[(w * 3 + 2) * 64 + lane]; }
            const float bb = p->in[I_ADAB][layer * 6144 + col];
            float* M = (float*)(p->ws + WS_MOD) + (size_t)layer * 3 * 6144 + col;
            M[0] = s0 + bb; M[6144] = s1 + bb; M[2 * 6144] = s2 + bb;
        }
        __syncthreads();
    }
    LAS float* scr = (LAS float*)(lds + wave * 16384);
    const int gw = blockIdx.x * NWAVES + wave, NGW = gridDim.x * NWAVES;
    ConvJob nj{}; float nrg[32];
    if (gw < IT_TOTAL) { nj = conv_job(p, gw); ti_load(nj.src, nj.src_ld, lane, nrg); }
    for (int it = gw; it < IT_TOTAL; it += NGW) {
        const ConvJob cj = nj; float crg[32];
#pragma unroll
        for (int i = 0; i < 32; ++i) crg[i] = nrg[i];
        if (it + NGW < IT_TOTAL) { nj = conv_job(p, it + NGW); ti_load(nj.src, nj.src_ld, lane, nrg); }
        ti_store(cj.src != nullptr, cj.fp8, crg, cj.dst, cj.dst_ldb, scr, lane);
    }
}

__device__ __forceinline__ void load_row(const float* row, int lane, f32x4 (&v)[4]) {
#pragma unroll
    for (int j = 0; j < 4; ++j) v[j] = ((const f32x4*)row)[lane + 64 * j];
}
__device__ __forceinline__ float row_rstd(const f32x4 (&v)[4]) {
    float s = 0.f;
#pragma unroll
    for (int j = 0; j < 4; ++j) s += (v[j].x * v[j].x + v[j].y * v[j].y) + (v[j].z * v[j].z + v[j].w * v[j].w);
    return rsqrtf(wave_sum(s) * (1.0f / D) + NORM_EPS);
}
__device__ __forceinline__ void norm_mod(const f32x4 (&v)[4], float rstd, const float* g, const float* shift, const float* scale, int lane, f32x4 (&h)[4]) {
#pragma unroll
    for (int j = 0; j < 4; ++j) {
        const f32x4 gg = ((const f32x4*)g)[lane + 64 * j], sh = ((const f32x4*)shift)[lane + 64 * j], sc = ((const f32x4*)scale)[lane + 64 * j];
        h[j] = v[j] * rstd * gg * (sc + 1.0f) + sh;
    }
}
__device__ __forceinline__ void store_row_bf16(bf16* row, int lane, const f32x4 (&h)[4]) {
#pragma unroll
    for (int j = 0; j < 4; ++j) { v2u w; w.x = pk2(h[j].x, h[j].y); w.y = pk2(h[j].z, h[j].w); ((v2u*)row)[lane + 64 * j] = w; }
}
__device__ __forceinline__ const float* resid_row(PP p, int layer0_inputs, int row) {
    if (layer0_inputs) return row < NLAT ? p->in[I_X] + (size_t)row * D : p->in[I_CTX] + (size_t)(row - NLAT) * D;
    return (const float*)(p->ws + WS_XR) + (size_t)row * D;
}
__device__ __forceinline__ void phase_norm0(PP p, int lane, int wave) {
    const int gw = blockIdx.x * NWAVES + wave, NGW = gridDim.x * NWAVES;
    f32x4 vn[4];
    if (gw < NROW) load_row(resid_row(p, 1, gw), lane, vn);
    for (int row = gw; row < NROW; row += NGW) {
        f32x4 v[4], h[4];
#pragma unroll
        for (int j = 0; j < 4; ++j) v[j] = vn[j];
        if (row + NGW < NROW) load_row(resid_row(p, 1, row + NGW), lane, vn);
        const float rstd = row_rstd(v); const int vec = row_vec(row);
        norm_mod(v, rstd, p->in[I_NMIX], modp(p, 0, vec, 0), modp(p, 0, vec, 1), lane, h);
        { unsigned* hp = (unsigned*)(p->ws + WS_H + (size_t)row * D);
#pragma unroll
          for (int j = 0; j < 4; ++j) hp[lane + 64 * j] = pk4_fp8(h[j].x, h[j].y, h[j].z, h[j].w); }
    }
}
__device__ __forceinline__ void route_select(float (&part)[NE], const float* rb, int row, float* TOPG, int* SLOT, unsigned* cnt, unsigned* ntl, unsigned* tof, int* TILEE, int lane, bool write, int (&slot)[TOPK]) {
#pragma unroll
    for (int e = 0; e < NE; ++e) part[e] = part[e] + rb[e];
    unsigned taken = 0u; int idx[TOPK]; float val[TOPK];
#pragma unroll
    for (int k = 0; k < TOPK; ++k) {
        float best = -3.0e38f; int bi = 0;
#pragma unroll
        for (int e = 0; e < NE; ++e) { const bool ok = !((taken >> e) & 1u) && (part[e] > best); best = ok ? part[e] : best; bi = ok ? e : bi; }
        taken |= 1u << bi; idx[k] = bi; val[k] = best;
    }
    float ex[TOPK], se = 0.f;
#pragma unroll
    for (int k = 0; k < TOPK; ++k) { ex[k] = __expf(val[k] - val[0]); se += ex[k]; }
    int sl[TOPK] = {0, 0, 0, 0};
    if (lane == 0 && write) {
        unsigned pos[TOPK]; int til[TOPK];
#pragma unroll
        for (int k = 0; k < TOPK; ++k) pos[k] = atomicAdd(cnt + idx[k] * CNT_STRIDE, 1u);
#pragma unroll
        for (int k = 0; k < TOPK; ++k) { til[k] = -1;
            if ((pos[k] & 255u) == 0u) { const unsigned t = atomicAdd(ntl, 1u); til[k] = (int)t; TILEE[1 + t] = idx[k];
                __hip_atomic_store(tof + idx[k] * TOF_PER + (pos[k] >> 8), t + 1u, __ATOMIC_RELAXED, __HIP_MEMORY_SCOPE_AGENT); } }
        unsigned tq[TOPK];
#pragma unroll
        for (int k = 0; k < TOPK; ++k) tq[k] = (til[k] < 0) ? __hip_atomic_load(tof + idx[k] * TOF_PER + (pos[k] >> 8), __ATOMIC_RELAXED, __HIP_MEMORY_SCOPE_AGENT) : 1u;
#pragma unroll
        for (int k = 0; k < TOPK; ++k) {
            if (til[k] < 0) { unsigned t1 = tq[k], spins = 0u;
                while (t1 == 0u && ++spins < (1u << 22)) { __builtin_amdgcn_s_sleep(1); t1 = __hip_atomic_load(tof + idx[k] * TOF_PER + (pos[k] >> 8), __ATOMIC_RELAXED, __HIP_MEMORY_SCOPE_AGENT); }
                til[k] = (int)t1 - 1; if (til[k] < 0) til[k] = 0; }
            sl[k] = til[k] * 256 + (int)(pos[k] & 255u);
            SLOT[row * 4 + k] = sl[k]; TOPG[row * 4 + k] = ex[k] * __builtin_amdgcn_rcpf(se);
        }
    }
#pragma unroll
    for (int k = 0; k < TOPK; ++k) slot[k] = __builtin_amdgcn_readfirstlane(sl[k]);
}
__device__ __forceinline__ void phase_ffn_norm_route4(PP p, int layer, int nrows, LAS unsigned char* lds, int tid, int lane, int wave) {
    const int gw = blockIdx.x * NWAVES + wave, NGW = gridDim.x * NWAVES;
    const float* rw = p->in[I_ROUTW] + (size_t)layer * D * NE; const float* rb = p->in[I_ROUTB] + layer * NE;
    float* TOPG = (float*)(p->ws + WS_ROUTE + RT_TOPG); int* SLOT = (int*)(p->ws + WS_ROUTE + RT_SLOT); int* TILEE = (int*)(p->ws + WS_ROUTE + RT_TILEE) + layer * 512;
    unsigned* ctl = (unsigned*)(p->ws + WS_CTL); unsigned* cnt = ctl + CW_CNT + layer * NE * CNT_STRIDE; unsigned* ntl = ctl + CW_NT + layer; unsigned* tof = ctl + CW_TOF + layer * NE * TOF_PER;
    unsigned char* XB = p->ws + WS_U + U_XB;
    constexpr int MAXR = 72;
    LAS unsigned* FP8I = (LAS unsigned*)(lds + 69632);
    LAS int* ROWE = (LAS int*)(lds + 143360); LAS int* ROWP = ROWE + MAXR * 4; LAS float* ROWG = (LAS float*)(ROWP + MAXR * 4);
    LAS unsigned* HIST = (LAS unsigned*)(ROWG + MAXR * 4); LAS unsigned* BASE = HIST + 32;
    if (tid < 32) HIST[tid] = 0u;
    __syncthreads();
    int nloc = 0;
    LAS float* hs = (LAS float*)(lds + wave * 8704);
    for (int row0 = gw; row0 < nrows; row0 += 2 * NGW) {
        const bool has1 = row0 + NGW < nrows; const int row1 = has1 ? row0 + NGW : row0;
#pragma unroll
        for (int r = 0; r < 2; ++r) { const int row = r ? row1 : row0;
            f32x4 v[4], h[4]; load_row((const float*)(p->ws + WS_XR) + (size_t)row * D, lane, v); const float rstd = row_rstd(v); const int vec = row_vec(row);
            norm_mod(v, rstd, p->in[I_NFFN] + layer * D, modp(p, layer, vec, 3), modp(p, layer, vec, 4), lane, h);
#pragma unroll
            for (int j = 0; j < 4; ++j)
#pragma unroll
                for (int i = 0; i < 4; ++i) hs[r * 1024 + (4 * j + i) * 64 + lane] = h[j][i]; }
        LDS_WAIT(); asm volatile("" ::: "memory");
        float pa[NE], pb[NE];
        {
            const int e4 = lane & 7, kq = lane >> 3;
            f32x4 qa = (f32x4){0.f, 0.f, 0.f, 0.f}, qb = (f32x4){0.f, 0.f, 0.f, 0.f};
#pragma unroll 4
            for (int t = 0; t < 32; ++t) {
                const int u = kq + 8 * t, l = u & 63, j = u >> 6;
                const f32x4* wr = (const f32x4*)(rw + (size_t)(4 * u) * NE) + e4;
#pragma unroll
                for (int i = 0; i < 4; ++i) { const f32x4 w4 = wr[i * (NE / 4)]; const float x0 = hs[(4 * j + i) * 64 + l], x1 = hs[1024 + (4 * j + i) * 64 + l];
                    qa = qa + x0 * w4; qb = qb + x1 * w4; }
            }
#pragma unroll
            for (int o = 8; o < 64; o <<= 1) {
#pragma unroll
                for (int c = 0; c < 4; ++c) { qa[c] += __shfl_xor(qa[c], o); qb[c] += __shfl_xor(qb[c], o); } }
            LAS float* lg = hs + 2048;
            if (kq == 0) { *(LAS f32x4*)(lg + 4 * e4) = qa; *(LAS f32x4*)(lg + 32 + 4 * e4) = qb; }
            LDS_WAIT(); asm volatile("" ::: "memory");
#pragma unroll
            for (int q4 = 0; q4 < 8; ++q4) { const f32x4 va = *(const LAS f32x4*)(lg + 4 * q4), vb = *(const LAS f32x4*)(lg + 32 + 4 * q4);
#pragma unroll
                for (int c = 0; c < 4; ++c) { pa[4 * q4 + c] = va[c]; pb[4 * q4 + c] = vb[c]; } }
        }
#pragma unroll
        for (int r = 0; r < 2; ++r) { if (r == 1 && !has1) break;
            float part[NE];
#pragma unroll
            for (int e = 0; e < NE; ++e) part[e] = (r ? pb[e] : pa[e]) + rb[e];
            unsigned taken = 0u; int idx[TOPK]; float val[TOPK];
#pragma unroll
            for (int k = 0; k < TOPK; ++k) {
                float best = -3.0e38f; int bi = 0;
#pragma unroll
                for (int e = 0; e < NE; ++e) { const bool ok = !((taken >> e) & 1u) && (part[e] > best); best = ok ? part[e] : best; bi = ok ? e : bi; }
                taken |= 1u << bi; idx[k] = bi; val[k] = best;
            }
            float ex[TOPK], se = 0.f;
#pragma unroll
            for (int k = 0; k < TOPK; ++k) { ex[k] = __expf(val[k] - val[0]); se += ex[k]; }
            const int rs = wave * 9 + nloc + r;
            if (lane == 0) {
#pragma unroll
                for (int k = 0; k < TOPK; ++k) { ROWE[rs * 4 + k] = idx[k]; ROWP[rs * 4 + k] = (int)__hip_atomic_fetch_add(HIST + idx[k], 1u, __ATOMIC_RELAXED, __HIP_MEMORY_SCOPE_WORKGROUP); ROWG[rs * 4 + k] = ex[k] * __builtin_amdgcn_rcpf(se); } }
#pragma unroll
            for (int j = 0; j < 4; ++j) { const LAS float* hp = hs + r * 1024 + (4 * j) * 64 + lane; FP8I[rs * 256 + lane + 64 * j] = pk4_fp8(hp[0], hp[64], hp[128], hp[192]); }
        }
        nloc += has1 ? 2 : 1;
        LDS_WAIT(); asm volatile("" ::: "memory");
    }
    __syncthreads();
    if (tid < 32) { const unsigned n = HIST[tid]; unsigned base = 0u;
        if (n) { base = atomicAdd(cnt + tid * CNT_STRIDE, n);
            for (unsigned pb2 = (base + 255u) & ~255u; pb2 < base + n; pb2 += 256u) { const unsigned t = atomicAdd(ntl, 1u); TILEE[1 + t] = tid;
                __hip_atomic_store(tof + tid * TOF_PER + (pb2 >> 8), t + 1u, __ATOMIC_RELAXED, __HIP_MEMORY_SCOPE_AGENT); } }
        BASE[tid] = base; }
    __syncthreads();
    int slv = 0;
    if (lane < 4 * nloc) { const int rs = wave * 9 + (lane >> 2), k = lane & 3, li = lane >> 2;
        const int row = gw + li * NGW;
        const int e = ROWE[rs * 4 + k]; const unsigned pos = BASE[e] + (unsigned)ROWP[rs * 4 + k]; unsigned t1 = 0u, spins = 0u;
        while ((t1 = __hip_atomic_load(tof + e * TOF_PER + (pos >> 8), __ATOMIC_RELAXED, __HIP_MEMORY_SCOPE_AGENT)) == 0u && ++spins < (1u << 22)) __builtin_amdgcn_s_sleep(1);
        int til = (int)t1 - 1; if (til < 0) til = 0;
        slv = til * 256 + (int)(pos & 255u); SLOT[row * 4 + k] = slv; TOPG[row * 4 + k] = ROWG[rs * 4 + k]; }
    for (int li = 0; li < nloc; ++li) { const int rs = wave * 9 + li; unsigned w[4];
#pragma unroll
        for (int j = 0; j < 4; ++j) w[j] = FP8I[rs * 256 + lane + 64 * j];
#pragma unroll
        for (int k = 0; k < TOPK; ++k) { unsigned* d = (unsigned*)(XB + (size_t)__builtin_amdgcn_readlane(slv, 4 * li + k) * D);
#pragma unroll
            for (int j = 0; j < 4; ++j) d[lane + 64 * j] = w[j]; } }
}
__device__ __forceinline__ void phase_ffn_norm_route(PP p, int layer, int nrows, LAS unsigned char* lds, int lane, int wave) {
    const int gw = blockIdx.x * NWAVES + wave, NGW = gridDim.x * NWAVES;
    const float* rw = p->in[I_ROUTW] + (size_t)layer * D * NE; const float* rb = p->in[I_ROUTB] + layer * NE;
    float* TOPG = (float*)(p->ws + WS_ROUTE + RT_TOPG); int* SLOT = (int*)(p->ws + WS_ROUTE + RT_SLOT); int* TILEE = (int*)(p->ws + WS_ROUTE + RT_TILEE) + layer * 512;
    unsigned* ctl = (unsigned*)(p->ws + WS_CTL); unsigned* cnt = ctl + CW_CNT + layer * NE * CNT_STRIDE; unsigned* ntl = ctl + CW_NT + layer; unsigned* tof = ctl + CW_TOF + layer * NE * TOF_PER;
    unsigned char* XB = p->ws + WS_U + U_XB;
    LAS float* hs = (LAS float*)(lds + wave * 8704);
    for (int row0 = gw; row0 < nrows; row0 += 2 * NGW) {
        const bool has1 = row0 + NGW < nrows; const int row1 = has1 ? row0 + NGW : row0;
#pragma unroll
        for (int r = 0; r < 2; ++r) { const int row = r ? row1 : row0;
            f32x4 v[4], h[4]; load_row((const float*)(p->ws + WS_XR) + (size_t)row * D, lane, v); const float rstd = row_rstd(v); const int vec = row_vec(row);
            norm_mod(v, rstd, p->in[I_NFFN] + layer * D, modp(p, layer, vec, 3), modp(p, layer, vec, 4), lane, h);
#pragma unroll
            for (int j = 0; j < 4; ++j)
#pragma unroll
                for (int i = 0; i < 4; ++i) hs[r * 1024 + (4 * j + i) * 64 + lane] = h[j][i]; }
        LDS_WAIT(); asm volatile("" ::: "memory");
        float pa[NE], pb[NE];
        {
            const int e4 = lane & 7, kq = lane >> 3;
            f32x4 qa = (f32x4){0.f, 0.f, 0.f, 0.f}, qb = (f32x4){0.f, 0.f, 0.f, 0.f};
#pragma unroll 4
            for (int t = 0; t < 32; ++t) {
                const int u = kq + 8 * t, l = u & 63, j = u >> 6;
                const f32x4* wr = (const f32x4*)(rw + (size_t)(4 * u) * NE) + e4;
#pragma unroll
                for (int i = 0; i < 4; ++i) { const f32x4 w4 = wr[i * (NE / 4)]; const float x0 = hs[(4 * j + i) * 64 + l], x1 = hs[1024 + (4 * j + i) * 64 + l];
                    qa = qa + x0 * w4; qb = qb + x1 * w4; }
            }
#pragma unroll
            for (int o = 8; o < 64; o <<= 1) {
#pragma unroll
                for (int c = 0; c < 4; ++c) { qa[c] += __shfl_xor(qa[c], o); qb[c] += __shfl_xor(qb[c], o); } }
            LAS float* lg = hs + 2048;
            if (kq == 0) { *(LAS f32x4*)(lg + 4 * e4) = qa; *(LAS f32x4*)(lg + 32 + 4 * e4) = qb; }
            LDS_WAIT(); asm volatile("" ::: "memory");
#pragma unroll
            for (int q4 = 0; q4 < 8; ++q4) { const f32x4 va = *(const LAS f32x4*)(lg + 4 * q4), vb = *(const LAS f32x4*)(lg + 32 + 4 * q4);
#pragma unroll
                for (int c = 0; c < 4; ++c) { pa[4 * q4 + c] = va[c]; pb[4 * q4 + c] = vb[c]; } }
        }
        int s0[TOPK], s1[TOPK];
        route_select(pa, rb, row0, TOPG, SLOT, cnt, ntl, tof, TILEE, lane, true, s0);
        route_select(pb, rb, row1, TOPG, SLOT, cnt, ntl, tof, TILEE, lane, has1, s1);
#pragma unroll
        for (int r = 0; r < 2; ++r) { if (r == 1 && !has1) break;
            unsigned w[4];
#pragma unroll
            for (int j = 0; j < 4; ++j) { const LAS float* hp = hs + r * 1024 + (4 * j) * 64 + lane; w[j] = pk4_fp8(hp[0], hp[64], hp[128], hp[192]); }
#pragma unroll
            for (int k = 0; k < TOPK; ++k) { unsigned* d = (unsigned*)(XB + (size_t)(r ? s1[k] : s0[k]) * D);
#pragma unroll
                for (int j = 0; j < 4; ++j) d[lane + 64 * j] = w[j]; } }
        LDS_WAIT(); asm volatile("" ::: "memory");
    }
}
__device__ __forceinline__ void phase_combine(PP p, int layer, int nrows, bool final_out, int lane, int wave) {
    const int gw = blockIdx.x * NWAVES + wave, NGW = gridDim.x * NWAVES;
    const float* TOPG = (const float*)(p->ws + WS_ROUTE + RT_TOPG); const int* SLOT = (const int*)(p->ws + WS_ROUTE + RT_SLOT);
    const bf16* YS = (const bf16*)(p->ws + WS_U + U_YS); float* XR = (float*)(p->ws + WS_XR); float* RSTD = (float*)(p->ws + WS_ROUTE + RT_RSTD);
    f32x4 vn[4]; f32x4 gn4 = (f32x4){0.f, 0.f, 0.f, 0.f}; int sn[4] = {0, 0, 0, 0};
    if (gw < nrows) { load_row(XR + (size_t)gw * D, lane, vn); gn4 = *(const f32x4*)(TOPG + gw * 4);
#pragma unroll
        for (int k = 0; k < TOPK; ++k) sn[k] = SLOT[gw * 4 + k]; }
    for (int row = gw; row < nrows; row += NGW) {
        f32x4 v[4], acc[4]; const f32x4 g4 = gn4; int sc[4];
#pragma unroll
        for (int j = 0; j < 4; ++j) { v[j] = vn[j]; sc[j] = sn[j]; }
        if (row + NGW < nrows) { const int rn = row + NGW; load_row(XR + (size_t)rn * D, lane, vn); gn4 = *(const f32x4*)(TOPG + rn * 4);
#pragma unroll
            for (int k = 0; k < TOPK; ++k) sn[k] = SLOT[rn * 4 + k]; }
#pragma unroll
        for (int j = 0; j < 4; ++j) acc[j] = (f32x4){0.f, 0.f, 0.f, 0.f};
#pragma unroll
        for (int k = 0; k < TOPK; ++k) {
            const float gk = g4[k]; const v2u* ys = (const v2u*)(YS + (size_t)sc[k] * D);
#pragma unroll
            for (int j = 0; j < 4; ++j) { const v2u w = ys[lane + 64 * j];
                acc[j].x += gk * bf2f(w.x & 0xffffu); acc[j].y += gk * bf2f(w.x >> 16); acc[j].z += gk * bf2f(w.y & 0xffffu); acc[j].w += gk * bf2f(w.y >> 16); }
        }
        const float* m5 = modp(p, layer, row_vec(row), 5);
#pragma unroll
        for (int j = 0; j < 4; ++j) v[j] = v[j] + ((const f32x4*)m5)[lane + 64 * j] * acc[j];
        const float rstd = row_rstd(v);
        if (final_out) {
#pragma unroll
            for (int j = 0; j < 4; ++j) ((f32x4*)(p->out + (size_t)row * D))[lane + 64 * j] = v[j] * rstd * ((const f32x4*)p->in[I_FINALG])[lane + 64 * j];
        } else {
#pragma unroll
            for (int j = 0; j < 4; ++j) ((f32x4*)(XR + (size_t)row * D))[lane + 64 * j] = v[j];
            if (lane == 0) RSTD[row] = rstd;
        }
    }
}

__device__ __forceinline__ int step_row(int b, int dir, int step) {
    if (step < CTXL) { const int t = dir ? (CTXL - 1 - step) : step; return NLAT + b * CTXL + t; }
    const int s = step - CTXL; const int t = dir ? (SEQ - 1 - s) : s; return b * SEQ + t;
}
constexpr int NSTEP = CTXL + SEQ;

__device__ __forceinline__ void phase_hg_readout(PP p, int lane, int wave) {
    const int gw = blockIdx.x * NWAVES + wave, NGW = gridDim.x * NWAVES;
    const bf16* Z = (const bf16*)(p->ws + WS_U + U_Z); const float* OD = (const float*)(p->ws + WS_U + U_OD0); bf16* A2 = (bf16*)(p->ws + WS_A2);
    const float* gn = p->in[I_HGGN];
    for (int row = gw; row < NROW; row += NGW) {
#pragma unroll
        for (int h = 0; h < 8; ++h) {
            const int c = h * 128 + 2 * lane;
            const float2 a = *(const float2*)(OD + (size_t)row * D + c), bq = *(const float2*)(OD + (size_t)(NROW + row) * D + c);
            const float o0 = a.x + bq.x, o1 = a.y + bq.y;
            const float rstd = rsqrtf(wave_sum(o0 * o0 + o1 * o1) * (1.0f / 128.0f) + NORM_EPS);
            const unsigned gz = *(const unsigned*)(Z + (size_t)row * 5120 + 4096 + c); const float g0 = bf2f(gz & 0xffffu), g1 = bf2f(gz >> 16);
            const float r0 = o0 * rstd * gn[2 * lane] * (g0 * sigm(g0)), r1 = o1 * rstd * gn[2 * lane + 1] * (g1 * sigm(g1));
            *(unsigned*)(A2 + (size_t)row * D + c) = pk2(r0, r1);
        }
    }
}

__device__ __forceinline__ void phase_lerp(PP p, LAS unsigned char* lds, int tid, int lane, int wave) {
    const int gw = blockIdx.x * NWAVES + wave, NGW = gridDim.x * NWAVES;
    const float* XR = (const float*)(p->ws + WS_XR); const float* RSTD = (const float*)(p->ws + WS_ROUTE + RT_RSTD);
    bf16* XL6 = (bf16*)(p->ws + WS_U + U_XL6); const float* g = p->in[I_NMIX] + D; const float* mu = p->in[I_MU];
    LAS float* TGS = (LAS float*)lds;
    LAS float* TS0 = TGS + 3 * D;
    LAS float* TMU = TS0 + 3 * D;
    for (int u = tid; u < 3 * D; u += NTHREADS) { const int vec = u >> 10, c = u & (D - 1); TGS[u] = g[c] * (modp(p, 1, vec, 1)[c] + 1.0f); TS0[u] = modp(p, 1, vec, 0)[c]; }
    for (int u = tid; u < 6 * D; u += NTHREADS) { const int s = u >> 10, c = u & (D - 1); const int m = (s == 0) ? 0 : (s == 1) ? 2 : (s == 2) ? 3 : (s == 3) ? 1 : (s == 4) ? 4 : 5; TMU[u] = mu[m * D + c]; }
    __syncthreads();
    auto nbrs = [&](int row, int (&nb)[4]) {
        if (row < NLAT) { const int t = row & (SEQ - 1), w = t & 63, r = t >> 6;
            nb[0] = (w >= 1) ? row - 1 : -1; nb[1] = (w < 63) ? row + 1 : -1; nb[2] = (r >= 1) ? row - 64 : -1; nb[3] = (r < SEQ / 64 - 1) ? row + 64 : -1;
        } else { const int t = (row - NLAT) & (CTXL - 1);
            nb[0] = nb[1] = (t >= 1) ? row - 1 : -1; nb[2] = nb[3] = (t < CTXL - 1) ? row + 1 : -1; } };
    f32x4 nxs[4], nxn[4]; float nrs = 0.f, nrn[4] = {0.f, 0.f, 0.f, 0.f};
    auto fetch = [&](int row) { int nb[4]; nbrs(row, nb); nrs = RSTD[row];
#pragma unroll
        for (int j = 0; j < 4; ++j) { const int ci = lane + 64 * j; nxs[j] = ((const f32x4*)(XR + (size_t)row * D))[ci];
            const int nr = nb[j] >= 0 ? nb[j] : row; nxn[j] = ((const f32x4*)(XR + (size_t)nr * D))[ci]; nrn[j] = nb[j] >= 0 ? RSTD[nr] : 0.f; } };
    if (gw < NROW) fetch(gw);
    for (int row = gw; row < NROW; row += NGW) {
        const int vec = row_vec(row); int nb[4]; nbrs(row, nb);
        f32x4 xs[4], xn[4]; float rn[4]; const float rs = nrs;
#pragma unroll
        for (int j = 0; j < 4; ++j) { xs[j] = nxs[j]; xn[j] = nxn[j]; rn[j] = nrn[j]; }
        if (row + NGW < NROW) fetch(row + NGW);
#pragma unroll
        for (int j = 0; j < 4; ++j) {
            const int ci = lane + 64 * j;
            const f32x4 gs = ((const LAS f32x4*)(TGS + vec * D))[ci], s0 = ((const LAS f32x4*)(TS0 + vec * D))[ci];
            const f32x4 hs = xs[j] * rs * gs + s0;
            f32x4 hn = (f32x4){0.f, 0.f, 0.f, 0.f};
            if (nb[j] >= 0) hn = xn[j] * rn[j] * gs + s0;
            const f32x4 dx = hn - hs;
#pragma unroll
            for (int s = 0; s < 6; ++s) {
                const f32x4 o = hs + dx * ((const LAS f32x4*)(TMU + s * D))[ci];
                v2u w; w.x = pk2(o.x, o.y); w.y = pk2(o.z, o.w);
                ((v2u*)(XL6 + ((size_t)s * NROW + row) * D))[ci] = w;
            }
        }
    }
    __syncthreads();
}
__device__ __forceinline__ float row16_allsum(float x) {
    x += __builtin_bit_cast(float, __builtin_amdgcn_update_dpp(0, __builtin_bit_cast(int, x), 0x128, 0xf, 0xf, false));
    x += __builtin_bit_cast(float, __builtin_amdgcn_update_dpp(0, __builtin_bit_cast(int, x), 0x124, 0xf, 0xf, false));
    x += __builtin_bit_cast(float, __builtin_amdgcn_update_dpp(0, __builtin_bit_cast(int, x), 0x122, 0xf, 0xf, false));
    x += __builtin_bit_cast(float, __builtin_amdgcn_update_dpp(0, __builtin_bit_cast(int, x), 0x121, 0xf, 0xf, false));
    return x;
}
__device__ __forceinline__ f32x4 bf4(v2u w) { return (f32x4){bf2f(w.x & 0xffffu), bf2f(w.x >> 16), bf2f(w.y & 0xffffu), bf2f(w.y >> 16)}; }
__device__ __forceinline__ void phase_rw_readout(PP p, int lane, int wave) {
    const int gw = blockIdx.x * NWAVES + wave, NGW = gridDim.x * NWAVES;
    const bf16* RKV = (const bf16*)(p->ws + WS_U + U_RKV); const bf16* AD = (const bf16*)(p->ws + WS_U + U_AD); const bf16* G = (const bf16*)(p->ws + WS_U + U_G);
    const float* OD = (const float*)(p->ws + WS_U + U_OD1); bf16* A2 = (bf16*)(p->ws + WS_A2);
    const int hq = lane >> 4, c4 = lane & 15, slab = c4 >> 2, v0 = (4 * c4) & 15;
    for (int row = gw; row < NLAT; row += NGW) {
        const int bq = row >> 13, tq = row & (SEQ - 1);
#pragma unroll
        for (int hg = 0; hg < 4; ++hg) {
            const int h = 4 * hg + hq, ch = h * 64 + 4 * c4;
            const int u0 = (bq * 32 + h) * 4 + slab, u1 = (bq * 32 + 16 + h) * 4 + slab;
            const f32x4 y = *(const f32x4*)(OD + ((size_t)u0 * NSTEP + CTXL + tq) * 16 + v0) + *(const f32x4*)(OD + ((size_t)u1 * NSTEP + CTXL + (SEQ - 1 - tq)) * 16 + v0);
            const f32x4 r = bf4(*(const v2u*)(RKV + (size_t)row * 3072 + ch)), k = bf4(*(const v2u*)(RKV + (size_t)row * 3072 + 1024 + ch)), v = bf4(*(const v2u*)(RKV + (size_t)row * 3072 + 2048 + ch));
            const f32x4 a0 = bf4(*(const v2u*)(AD + (size_t)row * D + ch)), a1 = bf4(*(const v2u*)(AD + ((size_t)NROW + row) * D + ch)), g = bf4(*(const v2u*)(G + (size_t)row * D + ch));
            const f32x4 lw = *(const f32x4*)(p->in[I_LNXW] + ch), lb = *(const f32x4*)(p->in[I_LNXB] + ch), ka = *(const f32x4*)(p->in[I_KA] + ch), rk = *(const f32x4*)(p->in[I_RK] + ch);
            const float mean = row16_allsum((y[0] + y[1]) + (y[2] + y[3])) * (1.0f / 64.0f);
            const f32x4 d = y - mean;
            const float var = row16_allsum((d[0] * d[0] + d[1] * d[1]) + (d[2] * d[2] + d[3] * d[3])) * (1.0f / 64.0f);
            f32x4 yn = d * rsqrtf(var + 64.0e-5f) * lw + lb;
            const f32x4 kd0 = k * ((a0 - 1.0f) * ka + 1.0f), kd1 = k * ((a1 - 1.0f) * ka + 1.0f);
            const f32x4 t0 = r * kd0 * rk, t1 = r * kd1 * rk;
            const float s0 = row16_allsum((t0[0] + t0[1]) + (t0[2] + t0[3])), s1 = row16_allsum((t1[0] + t1[1]) + (t1[2] + t1[3]));
            yn = yn + v * (s0 + s1);
            const f32x4 o = yn * g;
            v2u w; w.x = pk2(o[0], o[1]); w.y = pk2(o[2], o[3]);
            *(v2u*)(A2 + (size_t)row * D + ch) = w;
        }
    }
}

namespace pg8 {
struct SelOrder : StaticOrder {
    int div, sel0; size_t stride;
    __device__ __forceinline__ const char* abase(const Gemm& g, const Unit& u, size_t tstep) const { return (const char*)g.A + (size_t)(sel0 + u.pn / div) * stride + (size_t)u.pm * tstep; }
};
struct RkvL1Order {
    StaticOrder s1, s2; int G, c; const bf16_t* B2; size_t stride;
    __device__ __forceinline__ void init(int M, int G_, int c_, const bf16_t* b2, size_t st) { s1.init(M, 3072, G_, 0); s2.init(M, 768, G_, 0); G = G_; c = c_; B2 = b2; stride = st; }
    __device__ __forceinline__ bool next(int i, Unit& u) const { const long L = (long)i * G + c; if (L < s1.nwg) return s1.at(L, u); if (!s2.at(L - s1.nwg, u)) return false; u.e = 1; return true; }
    __device__ __forceinline__ const char* abase(const Gemm& g, const Unit& u, size_t tstep) const { return (const char*)g.A + (size_t)(u.e ? 3 + u.pn : u.pn / 4) * stride + (size_t)u.pm * tstep; }
    __device__ __forceinline__ const char* bbase(const Gemm& g, const Unit& u, size_t tstep) const { return (const char*)(u.e ? B2 : g.Bt) + (size_t)u.pn * tstep; }
    __device__ __forceinline__ void a_ready(const Unit&) const {}
    __device__ __forceinline__ void done(const Unit&) const {}
};
struct MoeOrder {
    const int* tilee; const PG8_LAS int* ord; int nt, ntn, G, c; size_t estride;
    __device__ __forceinline__ void init(const int* te, int nt_, PG8_LAS int* ordbuf, int ntn_, size_t es, int G_, int c_) {
        tilee = te; nt = nt_; ntn = ntn_; estride = es; G = G_; c = c_; ord = ordbuf;
        { const int t = threadIdx.x; PG8_LAS int* E = ordbuf + 512;
          int et = 0; if (t < nt) { et = te[1 + t]; E[t] = et; }
          asm volatile("s_waitcnt vmcnt(0) lgkmcnt(0)" ::: "memory"); __builtin_amdgcn_s_barrier(); asm volatile("" ::: "memory");
          if (t < nt) { int rank = 0;
#pragma unroll 8
              for (int u = 0; u < nt; ++u) { const int eu = E[u]; rank += (eu < et || (eu == et && u < t)) ? 1 : 0; }
              ordbuf[rank] = t; } }
        asm volatile("s_waitcnt lgkmcnt(0)" ::: "memory"); __builtin_amdgcn_s_barrier(); asm volatile("" ::: "memory");
    }
    __device__ __forceinline__ bool next(int i, Unit& u) const { const long L = (long)i * G + c; if (L >= (long)nt * ntn) return false; u.pm = ord[(int)(L / ntn)]; u.pn = (int)(L % ntn); u.e = tilee[1 + u.pm]; return true; }
    __device__ __forceinline__ const char* abase(const Gemm& g, const Unit& u, size_t tstep) const { return (const char*)g.A + (size_t)u.pm * tstep; }
    __device__ __forceinline__ const char* bbase(const Gemm& g, const Unit& u, size_t tstep) const { return (const char*)g.Bt + (size_t)u.e * estride + (size_t)u.pn * tstep; }
    __device__ __forceinline__ void a_ready(const Unit&) const {}
    __device__ __forceinline__ void done(const Unit&) const {}
};
struct EpiStoreBf16 {
    static constexpr bool PERM = true, AFTER_DRAIN = false;
    bf16_t* O; int ldc;
    __device__ __forceinline__ void operator()(const f32x4 (&acc)[2][2][4][2], const Unit& u, int wr, int wc, int fr, int fq) const {
        const int row0 = u.pm * BM + wr * 64 + fr, col0 = u.pn * BM + wc * 32 + 8 * fq;
#pragma unroll
        for (int ai = 0; ai < 2; ++ai)
#pragma unroll
            for (int m = 0; m < 4; ++m) { bf16_t* rowp = O + (size_t)(row0 + ai * HALF + m * 16) * ldc + col0;
#pragma unroll
                for (int bj = 0; bj < 2; ++bj) { const f32x4 v0 = acc[ai][bj][m][0], v1 = acc[ai][bj][m][1];
                    u32x4 w; w.x = cvt_pk_bf16(v0[0], v0[1]); w.y = cvt_pk_bf16(v0[2], v0[3]); w.z = cvt_pk_bf16(v1[0], v1[1]); w.w = cvt_pk_bf16(v1[2], v1[3]);
                    *(u32x4*)(rowp + bj * HALF) = w; } }
    }
};
struct EpiStoreF32 {
    static constexpr bool PERM = false, AFTER_DRAIN = false;
    float* C; int ldc;
    __device__ __forceinline__ void operator()(const f32x4 (&acc)[2][2][4][2], const Unit& u, int wr, int wc, int fr, int fq) const {
        const int row0 = u.pm * BM + wr * 64 + fr, col0 = u.pn * BM + wc * 32 + 4 * fq;
#pragma unroll
        for (int ai = 0; ai < 2; ++ai)
#pragma unroll
            for (int m = 0; m < 4; ++m) { float* rowp = C + (size_t)(row0 + ai * HALF + m * 16) * ldc + col0;
#pragma unroll
                for (int bj = 0; bj < 2; ++bj)
#pragma unroll
                    for (int n = 0; n < 2; ++n) *(f32x4*)(rowp + bj * HALF + n * 16) = acc[ai][bj][m][n]; }
    }
};
struct EpiResid {
    static constexpr bool PERM = false, AFTER_DRAIN = false;
    const float* base_lat; const float* base_ctx; float* out; const float* gate; int gstride;
    __device__ __forceinline__ void operator()(const f32x4 (&acc)[2][2][4][2], const Unit& u, int wr, int wc, int fr, int fq) const {
        const int row0 = u.pm * BM + wr * 64 + fr, col0 = u.pn * BM + wc * 32 + 4 * fq;
#pragma unroll
        for (int ai = 0; ai < 2; ++ai)
#pragma unroll
            for (int m = 0; m < 4; ++m) { const int row = row0 + ai * HALF + m * 16;
                const float* bp = (row < 16384) ? base_lat + (size_t)row * 1024 : base_ctx + (size_t)(row - 16384) * 1024;
                const float* gp = gate + (size_t)(row < 16384 ? (row >= 8192 ? 1 : 0) : 2) * gstride;
                float* op = out + (size_t)row * 1024;
#pragma unroll
                for (int bj = 0; bj < 2; ++bj)
#pragma unroll
                    for (int n = 0; n < 2; ++n) { const int c = col0 + bj * HALF + n * 16;
                        *(f32x4*)(op + c) = *(const f32x4*)(bp + c) + *(const f32x4*)(gp + c) * acc[ai][bj][m][n]; } }
    }
};
__device__ __forceinline__ float sigm_(float x) { return __builtin_amdgcn_rcpf(1.0f + __expf(-x)); }
struct EpiSwiglu {
    static constexpr bool PERM = true, AFTER_DRAIN = false;
    PP p; int layer;
    __device__ __forceinline__ void operator()(const f32x4 (&acc)[2][2][4][2], const Unit& u, int wr, int wc, int fr, int fq) const {
        PP q_ = p; asm volatile("" : "+s"(q_));
        unsigned char* O = q_->ws + WS_U + U_ACT; const float* bgu = q_->in[I_BGU] + (size_t)layer * NE * 2048;
        const int row0 = u.pm * BM + wr * 64 + fr, col0 = u.pn * HALF + wc * 32 + 8 * fq;
        const float* bg = bgu + (size_t)u.e * 2048 + col0; f32x4 bgv[2], buv[2];
#pragma unroll
        for (int n = 0; n < 2; ++n) { bgv[n] = *(const f32x4*)(bg + 4 * n); buv[n] = *(const f32x4*)(bg + 1024 + 4 * n); }
#pragma unroll
        for (int ai = 0; ai < 2; ++ai)
#pragma unroll
            for (int m = 0; m < 4; ++m) { float r[8];
#pragma unroll
                for (int n = 0; n < 2; ++n) { const f32x4 g4 = acc[ai][0][m][n] + bgv[n], u4 = acc[ai][1][m][n] + buv[n];
#pragma unroll
                    for (int j = 0; j < 4; ++j) { const float g = fminf(g4[j], 7.0f), uu = fminf(fmaxf(u4[j], -7.0f), 7.0f); r[4 * n + j] = g * sigm_(1.702f * g) * (uu + 1.0f); } }
                unsigned w0 = 0u, w1 = 0u;
                w0 = __builtin_amdgcn_cvt_pk_fp8_f32(r[0], r[1], w0, false); w0 = __builtin_amdgcn_cvt_pk_fp8_f32(r[2], r[3], w0, true);
                w1 = __builtin_amdgcn_cvt_pk_fp8_f32(r[4], r[5], w1, false); w1 = __builtin_amdgcn_cvt_pk_fp8_f32(r[6], r[7], w1, true);
                *(unsigned long long*)(O + (size_t)(row0 + ai * HALF + m * 16) * 1024 + col0) = (unsigned long long)w0 | ((unsigned long long)w1 << 32); }
    }
};
struct EpiDown {
    static constexpr bool PERM = true, AFTER_DRAIN = false;
    PP p; int layer;
    __device__ __forceinline__ void operator()(const f32x4 (&acc)[2][2][4][2], const Unit& u, int wr, int wc, int fr, int fq) const {
        PP q_ = p; asm volatile("" : "+s"(q_));
        bf16_t* O = (bf16_t*)(q_->ws + WS_U + U_YS); const float* bdn = q_->in[I_BDN] + (size_t)layer * NE * 1024;
        const int row0 = u.pm * BM + wr * 64 + fr, col0 = u.pn * BM + wc * 32 + 8 * fq;
        const float* bp = bdn + (size_t)u.e * 1024 + col0; f32x4 bv[2][2];
#pragma unroll
        for (int bj = 0; bj < 2; ++bj)
#pragma unroll
            for (int n = 0; n < 2; ++n) bv[bj][n] = *(const f32x4*)(bp + bj * HALF + 4 * n);
#pragma unroll
        for (int ai = 0; ai < 2; ++ai)
#pragma unroll
            for (int m = 0; m < 4; ++m) { bf16_t* rowp = O + (size_t)(row0 + ai * HALF + m * 16) * 1024 + col0;
#pragma unroll
                for (int bj = 0; bj < 2; ++bj) { const f32x4 v0 = acc[ai][bj][m][0] + bv[bj][0], v1 = acc[ai][bj][m][1] + bv[bj][1];
                    u32x4 w; w.x = cvt_pk_bf16(v0[0], v0[1]); w.y = cvt_pk_bf16(v0[2], v0[3]); w.z = cvt_pk_bf16(v1[0], v1[1]); w.w = cvt_pk_bf16(v1[2], v1[3]);
                    *(u32x4*)(rowp + bj * HALF) = w; } }
    }
};
struct EpiLora1 {
    static constexpr bool PERM = true, AFTER_DRAIN = false;
    bf16_t* O;
    __device__ __forceinline__ void operator()(const f32x4 (&acc)[2][2][4][2], const Unit& u, int wr, int wc, int fr, int fq) const {
        const int row0 = u.pm * BM + wr * 64 + fr, col0 = u.pn * HALF + wc * 32 + 8 * fq;
#pragma unroll
        for (int ai = 0; ai < 2; ++ai)
#pragma unroll
            for (int m = 0; m < 4; ++m) { float r[8];
#pragma unroll
                for (int n = 0; n < 2; ++n)
#pragma unroll
                    for (int j = 0; j < 4; ++j) { const float x = acc[ai][0][m][n][j]; r[4 * n + j] = (u.pn == 0) ? (2.0f * sigm_(2.0f * x) - 1.0f) : (u.pn == 1) ? x : sigm_(x); }
                u32x4 w; w.x = cvt_pk_bf16(r[0], r[1]); w.y = cvt_pk_bf16(r[2], r[3]); w.z = cvt_pk_bf16(r[4], r[5]); w.w = cvt_pk_bf16(r[6], r[7]);
                *(u32x4*)(O + (size_t)(row0 + ai * HALF + m * 16) * 384 + col0) = w; }
    }
};
struct EpiRkvL1 {
    static constexpr bool PERM = true, AFTER_DRAIN = false;
    EpiStoreBf16 rkv; EpiLora1 l1;
    __device__ __forceinline__ void operator()(const f32x4 (&acc)[2][2][4][2], const Unit& u, int wr, int wc, int fr, int fq) const { if (u.e) l1(acc, u, wr, wc, fr, fq); else rkv(acc, u, wr, wc, fr, fq); }
};
struct EpiLora2 {
    static constexpr bool PERM = false, AFTER_DRAIN = false;
    bf16_t* WD; bf16_t* AD; bf16_t* G; const float* w0; const float* a0;
    __device__ __forceinline__ void operator()(const f32x4 (&acc)[2][2][4][2], const Unit& u, int wr, int wc, int fr, int fq) const {
        const int row0 = u.pm * BM + wr * 64 + fr, blk = u.pn >> 2, col0 = (u.pn & 3) * BM + wc * 32 + 4 * fq;
        bf16_t* dst = (blk < 2) ? WD + (size_t)blk * 16896 * 1024 : (blk < 4) ? AD + (size_t)(blk - 2) * 16896 * 1024 : G;
        const float* bias = (blk < 2) ? w0 + blk * 1024 : a0 + ((blk - 2) & 1) * 1024;
#pragma unroll
        for (int ai = 0; ai < 2; ++ai)
#pragma unroll
            for (int m = 0; m < 4; ++m) { bf16_t* rowp = dst + (size_t)(row0 + ai * HALF + m * 16) * 1024;
#pragma unroll
                for (int bj = 0; bj < 2; ++bj)
#pragma unroll
                    for (int n = 0; n < 2; ++n) { const int c = col0 + bj * HALF + n * 16; f32x4 v = acc[ai][bj][m][n];
                        const f32x4 bb = *(const f32x4*)(bias + c);
                        if (blk < 2) { for (int j = 0; j < 4; ++j) v[j] = -0.60653066f * sigm_(v[j] + bb[j]); }
                        else if (blk < 4) { for (int j = 0; j < 4; ++j) v[j] = sigm_(v[j] + bb[j]); }
                        unsigned lo = cvt_pk_bf16(v[0], v[1]), hi = cvt_pk_bf16(v[2], v[3]);
                        *(unsigned long long*)(rowp + c) = (unsigned long long)lo | ((unsigned long long)hi << 32); }
                asm volatile("" ::: "memory"); }
    }
};
}

constexpr int GLA_NCH = NSTEP / 64;
constexpr int GLA_ITEMS = 2 * NBATCH * GLA_NCH * 8;
constexpr size_t U_DS = 298 * MiB, U_OI = 430 * MiB, U_QT = 562 * MiB, U_LAM = 628 * MiB;
typedef short bf16x8_t __attribute__((ext_vector_type(8)));
typedef float f32x2g __attribute__((ext_vector_type(2)));
__device__ __forceinline__ f32x4 mfma16(bf16x8_t a, bf16x8_t b, f32x4 c) { return __builtin_amdgcn_mfma_f32_16x16x32_bf16(a, b, c, 0, 0, 0); }

__device__ __forceinline__ void phase_gla_prep(PP p, LAS unsigned char* lds, int tid, int lane, int wave) {
    constexpr int PQ = 272, PT = 144;
    LAS unsigned char* QA = lds;
    LAS unsigned char* QX = QA + 64 * PQ;
    LAS unsigned char* KB = QX + 48 * PQ;
    LAS unsigned char* KD = KB + 64 * PQ;
    LAS unsigned char* KT = KD + 64 * PQ;
    LAS unsigned char* VT = KT + 128 * PT;
    LAS unsigned char* PI = VT + 128 * PT;
    LAS float* GT = (LAS float*)(PI + 64 * PT);
    const bf16* Z = (const bf16*)(p->ws + WS_U + U_Z);
    bf16* DS = (bf16*)(p->ws + WS_U + U_DS); v2u* OI = (v2u*)(p->ws + WS_U + U_OI); bf16* QT = (bf16*)(p->ws + WS_U + U_QT); float* LAM = (float*)(p->ws + WS_U + U_LAM);
    const int kp = tid & 63, gg = tid >> 6, g = gg >> 1, hh = gg & 1, k0 = 2 * kp, kq = lane >> 4, c16 = lane & 15;
    unsigned zf[8], zq[8], zv[8];
    auto ldz = [&](int item2) {
        const int h2 = item2 & 7, cc2 = (item2 >> 3) % GLA_NCH, db2 = (item2 >> 3) / GLA_NCH, b2 = db2 & 1, dir2 = db2 >> 1;
#pragma unroll
        for (int i = 0; i < 8; ++i) { const size_t zr = (size_t)step_row(b2, dir2, 64 * cc2 + 8 * gg + i) * 5120 + h2 * 128 + k0;
            zf[i] = *(const unsigned*)(Z + zr + 1024 * (1 + dir2)); zq[i] = *(const unsigned*)(Z + zr); zv[i] = *(const unsigned*)(Z + zr + 3072); } };
    if ((int)blockIdx.x < GLA_ITEMS) ldz(blockIdx.x);
    for (int item = blockIdx.x; item < GLA_ITEMS; item += gridDim.x) {
        const int h = item & 7, db = (item >> 3) / GLA_NCH, dir = db >> 1;
        float lbv[2];
#pragma unroll
        for (int e = 0; e < 2; ++e) { const float* lb = p->in[I_HGLB] + (size_t)dir * 3 * D + h * 128 + k0 + e; const float a0 = lb[0], a1 = lb[D], a2 = lb[2 * D];
            const float mx = fmaxf(a0, fmaxf(a1, a2)); const float e0 = __expf(a0 - mx), e1 = __expf(a1 - mx), e2 = __expf(a2 - mx); lbv[e] = e0 / (e0 + e1 + e2); }
        for (int u = tid; u < 64 * PT / 4; u += NTHREADS) ((LAS unsigned*)PI)[u] = 0u;
        float cs[2][8], kin[2][8], qs[2][8], run[2] = {0.f, 0.f}; unsigned vlo[4], vhi[4];
#pragma unroll
        for (int i = 0; i < 8; ++i) {
#pragma unroll
            for (int e = 0; e < 2; ++e) {
                const float fh = bf2f(e ? (zf[i] >> 16) : (zf[i] & 0xffffu)), qv = bf2f(e ? (zq[i] >> 16) : (zq[i] & 0xffffu));
                const float f = lbv[e] + (1.f - lbv[e]) * sigm(fh);
                run[e] += __logf(f); cs[e][i] = run[e]; kin[e][i] = 1.f - f; qs[e][i] = qv * sigm(qv);
            }
            if (i & 1) { vlo[i >> 1] |= zv[i] << 16; vhi[i >> 1] |= zv[i] & 0xffff0000u; } else { vlo[i >> 1] = zv[i] & 0xffffu; vhi[i >> 1] = zv[i] >> 16; }
        }
        if (item + (int)gridDim.x < GLA_ITEMS) ldz(item + gridDim.x);
        *(LAS f32x2g*)(GT + gg * 128 + k0) = (f32x2g){run[0], run[1]};
        *(LAS v4u*)(VT + k0 * PT + 16 * gg) = (v4u){vlo[0], vlo[1], vlo[2], vlo[3]};
        *(LAS v4u*)(VT + (k0 + 1) * PT + 16 * gg) = (v4u){vhi[0], vhi[1], vhi[2], vhi[3]};
        __syncthreads();
        f32x2g t8[8];
#pragma unroll
        for (int u = 0; u < 8; ++u) t8[u] = *(const LAS f32x2g*)(GT + u * 128 + k0);
        unsigned ktl[4], kth[4];
        float rgv[2], totv[2], runSv[2], lov[2], t1v[2], t2v[2];
#pragma unroll
        for (int e = 0; e < 2; ++e) {
            const float s0 = e ? t8[0].y : t8[0].x, s1 = e ? t8[1].y : t8[1].x, s2 = e ? t8[2].y : t8[2].x, s3 = e ? t8[3].y : t8[3].x;
            const float s4 = e ? t8[4].y : t8[4].x, s5 = e ? t8[5].y : t8[5].x, s6 = e ? t8[6].y : t8[6].x, s7 = e ? t8[7].y : t8[7].x;
            const float q0 = s0 + s1, q1 = s2 + s3, q2 = s4 + s5, q3 = s6 + s7;
            rgv[e] = (g > 0 ? q0 : 0.f) + (g > 1 ? q1 : 0.f) + (g > 2 ? q2 : 0.f); totv[e] = (q0 + q1) + (q2 + q3);
            runSv[e] = (g == 0) ? q0 : (g == 1) ? q1 : (g == 2) ? q2 : q3;
            const float first = (g == 0) ? s0 : (g == 1) ? s2 : (g == 2) ? s4 : s6;
            lov[e] = hh ? first : 0.f; t1v[e] = q1; t2v[e] = q2;
        }
        float erg[2], einv[2], eend[2], ex1[2], ex2[2];
#pragma unroll
        for (int e = 0; e < 2; ++e) { erg[e] = __expf(rgv[e]); einv[e] = __expf(-runSv[e]); eend[e] = __expf(totv[e] - (rgv[e] + runSv[e]));
            ex1[e] = (g == 2) ? __expf(t1v[e]) : __expf(t2v[e]); ex2[e] = __expf(t1v[e] + t2v[e]); }
        bf16* qtp = QT + (size_t)item * 64 * 128 + (size_t)(16 * g + 8 * hh) * 128 + k0;
#pragma unroll
        for (int i = 0; i < 8; ++i) {
            float qh[2], kb[2];
#pragma unroll
            for (int e = 0; e < 2; ++e) { const float cr = lov[e] + cs[e][i]; qh[e] = qs[e][i] * __expf(cr); kb[e] = kin[e][i] * __expf(runSv[e] - cr); }
            const int ro = (16 * g + 8 * hh + i) * PQ + 2 * k0;
            *(LAS unsigned*)(QA + ro) = pk2(qh[0], qh[1]);
            *(LAS unsigned*)(KB + ro) = pk2(kb[0], kb[1]);
            *(LAS unsigned*)(KD + ro) = pk2(kb[0] * einv[0], kb[1] * einv[1]);
            if (g == 2) *(LAS unsigned*)(QX + (8 * hh + i) * PQ + 2 * k0) = pk2(qh[0] * ex1[0], qh[1] * ex1[1]);
            if (g == 3) { *(LAS unsigned*)(QX + (16 + 8 * hh + i) * PQ + 2 * k0) = pk2(qh[0] * ex1[0], qh[1] * ex1[1]); *(LAS unsigned*)(QX + (32 + 8 * hh + i) * PQ + 2 * k0) = pk2(qh[0] * ex2[0], qh[1] * ex2[1]); }
            *(unsigned*)(qtp + (size_t)i * 128) = pk2(qh[0] * erg[0], qh[1] * erg[1]);
            const unsigned kv0 = f2bf(kb[0] * eend[0]), kv1 = f2bf(kb[1] * eend[1]);
            if (i & 1) { ktl[i >> 1] |= kv0 << 16; kth[i >> 1] |= kv1 << 16; } else { ktl[i >> 1] = kv0; kth[i >> 1] = kv1; }
        }
        *(LAS v4u*)(KT + k0 * PT + 16 * gg) = (v4u){ktl[0], ktl[1], ktl[2], ktl[3]};
        *(LAS v4u*)(KT + (k0 + 1) * PT + 16 * gg) = (v4u){kth[0], kth[1], kth[2], kth[3]};
        if (gg == 0) *(f32x2g*)(LAM + (size_t)item * 128 + k0) = (f32x2g){__expf(totv[0]), __expf(totv[1])};
        __syncthreads();
        for (int blk = wave; blk < 10; blk += 8) {
            const int gi = (blk >= 6) ? 3 : (blk >= 3) ? 2 : (blk >= 1) ? 1 : 0, ji = blk - ((gi * (gi + 1)) >> 1);
            const LAS unsigned char* ab = (ji + 1 >= gi) ? QA + 16 * gi * PQ : (gi == 2) ? QX : (ji == 1) ? QX + 16 * PQ : QX + 32 * PQ;
            const LAS unsigned char* bb = ((ji == gi) ? KD : KB) + 16 * ji * PQ;
            f32x4 acc = (f32x4){0.f, 0.f, 0.f, 0.f};
#pragma unroll
            for (int s = 0; s < 4; ++s) {
                const bf16x8_t a = *(const LAS bf16x8_t*)(ab + c16 * PQ + (32 * s + 8 * kq) * 2), bv = *(const LAS bf16x8_t*)(bb + c16 * PQ + (32 * s + 8 * kq) * 2);
                acc = mfma16(a, bv, acc);
            }
#pragma unroll
            for (int j = 0; j < 4; ++j) { const int tau = 4 * kq + j; const float val = (ji == gi && c16 > tau) ? 0.f : acc[j];
                *(LAS unsigned short*)(PI + (16 * gi + tau) * PT + (16 * ji + c16) * 2) = (unsigned short)f2bf(val); }
        }
        __syncthreads();
        {
            const LAS unsigned char* vb = VT + (16 * wave + c16) * PT + 16 * kq;
            const bf16x8_t v0 = *(const LAS bf16x8_t*)(vb), v1 = *(const LAS bf16x8_t*)(vb + 64);
#pragma unroll
            for (int gi = 0; gi < 4; ++gi) {
                const LAS unsigned char* pb = PI + (16 * gi + c16) * PT + 16 * kq;
                f32x4 acc = mfma16(*(const LAS bf16x8_t*)(pb), v0, (f32x4){0.f, 0.f, 0.f, 0.f});
                if (gi >= 2) acc = mfma16(*(const LAS bf16x8_t*)(pb + 64), v1, acc);
                { v2u w; w.x = pk2(acc[0], acc[1]); w.y = pk2(acc[2], acc[3]); OI[((size_t)item * 8 + wave) * 256 + gi * 64 + lane] = w; }
            }
            bf16* dsp = DS + (size_t)item * 128 * 128 + (size_t)(16 * wave + c16) * 128 + 4 * kq;
#pragma unroll
            for (int m = 0; m < 8; ++m) {
                const LAS unsigned char* kb2 = KT + (16 * m + c16) * PT + 16 * kq;
                f32x4 acc = mfma16(*(const LAS bf16x8_t*)(kb2), v0, (f32x4){0.f, 0.f, 0.f, 0.f});
                acc = mfma16(*(const LAS bf16x8_t*)(kb2 + 64), v1, acc);
                v2u w; w.x = pk2(acc[0], acc[1]); w.y = pk2(acc[2], acc[3]);
                *(v2u*)(dsp + 16 * m) = w;
            }
        }
        __syncthreads();
    }
}
__device__ __forceinline__ void phase_gla_scan(PP p, int tid) {
    bf16* DS = (bf16*)(p->ws + WS_U + U_DS); const float* LAM = (const float*)(p->ws + WS_U + U_LAM);
    const int nthr = gridDim.x * NTHREADS;
    for (int e = blockIdx.x * NTHREADS + tid; e < 32 * 2048; e += nthr) {
        const int chain = e >> 11, el = e & 2047, h = chain & 7, db = chain >> 3, k8 = (el & 15) * 8;
        float s[8];
#pragma unroll
        for (int i = 0; i < 8; ++i) s[i] = 0.f;
        for (int c0 = 0; c0 < GLA_NCH; c0 += 6) {
            v4u d[6]; f32x4 l0[6], l1[6];
#pragma unroll
            for (int u = 0; u < 6; ++u) { const size_t item = ((size_t)db * GLA_NCH + c0 + u) * 8 + h;
                d[u] = *(const v4u*)(DS + item * 16384 + (size_t)el * 8); l0[u] = *(const f32x4*)(LAM + item * 128 + k8); l1[u] = *(const f32x4*)(LAM + item * 128 + k8 + 4); }
#pragma unroll
            for (int u = 0; u < 6; ++u) { const size_t item = ((size_t)db * GLA_NCH + c0 + u) * 8 + h;
                v4u o; o.x = pk2(s[0], s[1]); o.y = pk2(s[2], s[3]); o.z = pk2(s[4], s[5]); o.w = pk2(s[6], s[7]);
                *(v4u*)(DS + item * 16384 + (size_t)el * 8) = o;
                s[0] = l0[u].x * s[0] + bf2f(d[u].x & 0xffffu); s[1] = l0[u].y * s[1] + bf2f(d[u].x >> 16);
                s[2] = l0[u].z * s[2] + bf2f(d[u].y & 0xffffu); s[3] = l0[u].w * s[3] + bf2f(d[u].y >> 16);
                s[4] = l1[u].x * s[4] + bf2f(d[u].z & 0xffffu); s[5] = l1[u].y * s[5] + bf2f(d[u].z >> 16);
                s[6] = l1[u].z * s[6] + bf2f(d[u].w & 0xffffu); s[7] = l1[u].w * s[7] + bf2f(d[u].w >> 16); }
        }
    }
}
__device__ __forceinline__ void phase_gla_out(PP p, LAS unsigned char* lds, int tid, int lane, int wave) {
    const bf16* DS = (const bf16*)(p->ws + WS_U + U_DS); const v2u* OI = (const v2u*)(p->ws + WS_U + U_OI); const bf16* QT = (const bf16*)(p->ws + WS_U + U_QT);
    const bf16* Z = (const bf16*)(p->ws + WS_U + U_Z); bf16* A2 = (bf16*)(p->ws + WS_A2); const float* gn = p->in[I_HGGN];
    constexpr int PQ = 272;
    LAS unsigned char* QL = lds;
    LAS unsigned char* GL_ = lds + 2 * 64 * PQ;
    LAS unsigned char* OL = GL_ + 64 * PQ;
    LAS float* SSQ = (LAS float*)(OL + 64 * PQ);
    LAS float* RST = SSQ + 512;
    const int kq = lane >> 4, c16 = lane & 15;
    const int srow = tid >> 3, sch = tid & 7;
    constexpr int NIT = NBATCH * GLA_NCH * 8;
    struct Pre { v4u q[2][2]; v4u g[2]; bf16x8_t bv[2][4]; v2u ow[2][4]; };
    auto decode = [&](int it, int& h, int& jc, int& b, int (&item)[2], int& tok0) {
        h = it & 7; jc = (it >> 3) % GLA_NCH; b = (it >> 3) / GLA_NCH;
        const int cb = (jc < 4) ? 3 - jc : 135 - jc;
        item[0] = ((0 * 2 + b) * GLA_NCH + jc) * 8 + h; item[1] = ((1 * 2 + b) * GLA_NCH + cb) * 8 + h;
        tok0 = (jc < 4) ? NLAT + b * CTXL + 64 * jc : b * SEQ + 64 * (jc - 4); };
    auto fetch = [&](int it, Pre& P) {
        int h, jc, b, item[2], tok0; decode(it, h, jc, b, item, tok0);
#pragma unroll
        for (int d = 0; d < 2; ++d) {
            const v4u* qs = (const v4u*)(QT + (size_t)item[d] * 8192 + srow * 128 + sch * 16); P.q[d][0] = qs[0]; P.q[d][1] = qs[1];
            const bf16* sp = DS + (size_t)item[d] * 16384 + (size_t)(16 * wave + c16) * 128 + 8 * kq;
#pragma unroll
            for (int s2 = 0; s2 < 4; ++s2) P.bv[d][s2] = *(const bf16x8_t*)(sp + 32 * s2);
#pragma unroll
            for (int gi = 0; gi < 4; ++gi) P.ow[d][gi] = OI[((size_t)item[d] * 8 + wave) * 256 + gi * 64 + lane];
        }
        const v4u* gs = (const v4u*)(Z + (size_t)(tok0 + srow) * 5120 + 4096 + h * 128 + sch * 16); P.g[0] = gs[0]; P.g[1] = gs[1]; };
    Pre nx;
    if ((int)blockIdx.x < NIT) fetch(blockIdx.x, nx);
    for (int it = blockIdx.x; it < NIT; it += gridDim.x) {
        int h, jc, b, item[2], tok0; decode(it, h, jc, b, item, tok0);
#pragma unroll
        for (int d = 0; d < 2; ++d) { LAS v4u* dq = (LAS v4u*)(QL + d * 64 * PQ + srow * PQ + sch * 32); dq[0] = nx.q[d][0]; dq[1] = nx.q[d][1]; }
        { LAS v4u* dg = (LAS v4u*)(GL_ + srow * PQ + sch * 32); dg[0] = nx.g[0]; dg[1] = nx.g[1]; }
        bf16x8_t bv[2][4]; v2u ow[2][4];
#pragma unroll
        for (int d = 0; d < 2; ++d)
#pragma unroll
            for (int u = 0; u < 4; ++u) { bv[d][u] = nx.bv[d][u]; ow[d][u] = nx.ow[d][u]; }
        __syncthreads();
        if (it + (int)gridDim.x < NIT) fetch(it + gridDim.x, nx);
        f32x4 acc[2][4];
#pragma unroll
        for (int d = 0; d < 2; ++d)
#pragma unroll
            for (int gi = 0; gi < 4; ++gi) {
                const LAS unsigned char* qp = QL + d * 64 * PQ + (16 * gi + c16) * PQ + 16 * kq;
                f32x4 a4 = (f32x4){bf2f(ow[d][gi].x & 0xffffu), bf2f(ow[d][gi].x >> 16), bf2f(ow[d][gi].y & 0xffffu), bf2f(ow[d][gi].y >> 16)};
#pragma unroll
                for (int s2 = 0; s2 < 4; ++s2) a4 = mfma16(*(const LAS bf16x8_t*)(qp + 64 * s2), bv[d][s2], a4);
                acc[d][gi] = a4;
            }
        f32x4 o[4]; float ss[4][4];
#pragma unroll
        for (int gi = 0; gi < 4; ++gi)
#pragma unroll
            for (int j = 0; j < 4; ++j) { const float v = acc[0][gi][j] + __shfl_xor(acc[1][3 - gi][3 - j], 48); o[gi][j] = v;
                float q = v * v;
                q += __builtin_bit_cast(float, __builtin_amdgcn_update_dpp(0, __builtin_bit_cast(int, q), 0x128, 0xf, 0xf, false));
                q += __builtin_bit_cast(float, __builtin_amdgcn_update_dpp(0, __builtin_bit_cast(int, q), 0x124, 0xf, 0xf, false));
                q += __builtin_bit_cast(float, __builtin_amdgcn_update_dpp(0, __builtin_bit_cast(int, q), 0x122, 0xf, 0xf, false));
                q += __builtin_bit_cast(float, __builtin_amdgcn_update_dpp(0, __builtin_bit_cast(int, q), 0x121, 0xf, 0xf, false));
                ss[gi][j] = q; }
        if (c16 == 0) {
#pragma unroll
            for (int gi = 0; gi < 4; ++gi)
#pragma unroll
                for (int j = 0; j < 4; ++j) SSQ[(16 * gi + 4 * kq + j) * 8 + wave] = ss[gi][j]; }
        __syncthreads();
        if (tid < 64) { const f32x4 s0 = *(const LAS f32x4*)(SSQ + tid * 8), s1 = *(const LAS f32x4*)(SSQ + tid * 8 + 4);
            RST[tid] = rsqrtf(((s0[0] + s0[1]) + (s0[2] + s0[3]) + (s1[0] + s1[1]) + (s1[2] + s1[3])) * (1.0f / 128.0f) + NORM_EPS); }
        __syncthreads();
        const int vl = 16 * wave + c16; const float gw_ = gn[vl];
#pragma unroll
        for (int gi = 0; gi < 4; ++gi)
#pragma unroll
            for (int j = 0; j < 4; ++j) { const int tk = 16 * gi + 4 * kq + j;
                const float g = bf2f(*(const LAS unsigned short*)(GL_ + tk * PQ + vl * 2)); const float r = o[gi][j] * RST[tk] * gw_ * (g * sigm(g));
                *(LAS unsigned short*)(OL + tk * PQ + vl * 2) = (unsigned short)f2bf(r); }
        __syncthreads();
        { const LAS v4u* so = (const LAS v4u*)(OL + srow * PQ + sch * 32); v4u* dst = (v4u*)(A2 + (size_t)(tok0 + srow) * D + h * 128 + sch * 16); dst[0] = so[0]; dst[1] = so[1]; }
        __syncthreads();
    }
}

typedef short bf16x4_t __attribute__((ext_vector_type(4)));
typedef float f32x2_t __attribute__((ext_vector_type(2))); typedef __bf16 bf16x2v_t __attribute__((ext_vector_type(2)));
__device__ __forceinline__ unsigned cvtpk(float lo, float hi) { const f32x2_t v = {lo, hi}; const bf16x2v_t b = __builtin_convertvector(v, bf16x2v_t); return __builtin_bit_cast(unsigned, b); }
constexpr int R4_DOTA = 0, R4_UPA = 2048, R4_A1 = 4096, R4_A2 = 4352, R4_G7 = 4608, R4_VT = 4864, R4_IMG = 6912, R4_SLOT = 5376, R4_NCH = NSTEP / 8, R4_NCB = 8;
constexpr size_t U_IMG = 872 * MiB;
constexpr size_t U_YST = U_OD1;
__device__ __forceinline__ void phase_rw_prep(PP p, LAS unsigned char* lds, int lane, int wave) {
    const int gw = blockIdx.x * NWAVES + wave, NGW = gridDim.x * NWAVES;
    const bf16* RKV = (const bf16*)(p->ws + WS_U + U_RKV); unsigned char* IMG = p->ws + WS_U + U_IMG;
    LAS unsigned char* da = lds + wave * 8192; LAS unsigned char* gb = da + 2048; LAS float* GL = (LAS float*)(da + 4096);
    LAS unsigned char* a12 = da + 5120;
    const int m = lane & 15, q = lane >> 4;
    const int s2 = lane >> 5, tp = (lane >> 4) & 1, kq = (lane & 15) >> 2, ii = (lane & 3) + 4 * tp, dpos = ((s2 * 4 + kq) * 8 + ii) * 2;
    float nrx[8], nkx[8], nvx[8], nlw[8], nav[8];
    auto ld = [&](int it2) {
        const int chain = it2 & 63, chunk = it2 >> 6, b = chain >> 5, dir = (chain >> 4) & 1, h = chain & 15, ch = h * 64 + lane;
        const bf16* WDp = (const bf16*)(p->ws + WS_U + U_WD) + (size_t)dir * NROW * D; const bf16* ADp = (const bf16*)(p->ws + WS_U + U_AD) + (size_t)dir * NROW * D;
#pragma unroll
        for (int j = 0; j < 8; ++j) { const int row = step_row(b, dir, chunk * 8 + j);
            nrx[j] = bf2f(RKV[(size_t)row * 3072 + ch]); nkx[j] = bf2f(RKV[(size_t)row * 3072 + 1024 + ch]); nvx[j] = bf2f(RKV[(size_t)row * 3072 + 2048 + ch]);
            nlw[j] = bf2f(WDp[(size_t)row * D + ch]); nav[j] = bf2f(ADp[(size_t)row * D + ch]); } };
    if (gw < 64 * R4_NCH) ld(gw);
    for (int it = gw; it < 64 * R4_NCH; it += NGW) {
        const int chain = it & 63, chunk = it >> 6, h = chain & 15, ch = h * 64 + lane;
        const float kkw = p->in[I_KK][ch], kaw = p->in[I_KA][ch];
        float rx[8], kx[8], vx[8], lw[8], av[8], kn[8];
#pragma unroll
        for (int j = 0; j < 8; ++j) { rx[j] = nrx[j]; kx[j] = nkx[j]; vx[j] = nvx[j]; lw[j] = nlw[j]; av[j] = nav[j]; }
        if (it + NGW < 64 * R4_NCH) ld(it + NGW);
#pragma unroll
        for (int j = 0; j < 8; ++j) { const float t = kx[j] * kkw; kn[j] = t * __builtin_amdgcn_rsqf(fmaxf(wave_sum(t * t), 1e-24f)); }
        float bj[8]; { float bb = 0.f;
#pragma unroll
            for (int j = 0; j < 8; ++j) { bb += lw[j]; bj[j] = bb; } }
        const float e7 = __expf(bj[7]);
        unsigned upa[8]; float ebprev = 1.f;
#pragma unroll
        for (int j = 0; j < 8; ++j) {
            const float eb = __expf(bj[j]), einv = __builtin_amdgcn_rcpf(eb), e7j = e7 * einv;
            const float beta = kn[j] * av[j], kd = kx[j] * (1.f + (av[j] - 1.f) * kaw);
            *(LAS unsigned short*)(da + j * 128 + dpos) = (unsigned short)f2bf(kn[j] * ebprev);
            *(LAS unsigned short*)(da + (8 + j) * 128 + dpos) = (unsigned short)f2bf(rx[j] * eb);
            *(LAS unsigned short*)(gb + j * 128 + dpos) = (unsigned short)f2bf(beta * einv);
            *(LAS unsigned short*)(gb + (8 + j) * 128 + dpos) = (unsigned short)f2bf(kd * einv);
            const unsigned ub = f2bf(-beta * e7j), uk = f2bf(kd * e7j);
            if (j & 1) { upa[j >> 1] |= ub << 16; upa[4 + (j >> 1)] |= uk << 16; } else { upa[j >> 1] = ub; upa[4 + (j >> 1)] = uk; }
            ebprev = eb;
        }
        unsigned char* img = IMG + ((size_t)chain * R4_NCH + chunk) * R4_IMG;
        { v4u* d = (v4u*)(img + R4_UPA + lane * 32); d[0] = (v4u){upa[0], upa[1], upa[2], upa[3]}; d[1] = (v4u){upa[4], upa[5], upa[6], upa[7]}; }
        ((float*)(img + R4_G7))[lane] = e7;
        { f32x4* d = (f32x4*)(img + R4_VT + lane * 32); d[0] = (f32x4){vx[0], vx[1], vx[2], vx[3]}; d[1] = (f32x4){vx[4], vx[5], vx[6], vx[7]}; }
        LDS_WAIT(); asm volatile("" ::: "memory");
        { v4u* d = (v4u*)(img + R4_DOTA); d[lane] = ((const LAS v4u*)da)[lane]; d[64 + lane] = ((const LAS v4u*)da)[64 + lane]; }
        f32x4 G = (f32x4){0.f, 0.f, 0.f, 0.f};
#pragma unroll
        for (int s = 0; s < 2; ++s) G = mfma16(*(const LAS bf16x8_t*)(da + m * 128 + (s * 4 + q) * 16), *(const LAS bf16x8_t*)(gb + m * 128 + (s * 4 + q) * 16), G);
        if (m >= 8) { const int i = m - 8;
#pragma unroll
            for (int jp = 0; jp < 4; ++jp) { const int row = 4 * q + jp; const bool keep = (row < 8) ? (i < row) : (i <= row - 8);
                *(LAS unsigned short*)(a12 + row * 16 + i * 2) = (unsigned short)f2bf(keep ? G[jp] : 0.f); } }
#pragma unroll
        for (int jp = 0; jp < 4; ++jp) GL[(4 * q + jp) * 16 + m] = G[jp];
        LDS_WAIT(); asm volatile("" ::: "memory");
        const int c = lane & 7; float Tc[8], M2[8];
#pragma unroll
        for (int j = 0; j < 8; ++j) { float t = (j == c) ? 1.f : 0.f; const f32x4 ra = *(const LAS f32x4*)(GL + j * 16), rb = *(const LAS f32x4*)(GL + j * 16 + 4);
#pragma unroll
            for (int i = 0; i < j; ++i) t -= (i < 4 ? ra[i & 3] : rb[i & 3]) * Tc[i];
            Tc[j] = t; }
#pragma unroll
        for (int j = 0; j < 8; ++j) { float t = 0.f; const f32x4 ra = *(const LAS f32x4*)(GL + (8 + j) * 16), rb = *(const LAS f32x4*)(GL + (8 + j) * 16 + 4);
#pragma unroll
            for (int i = 0; i <= j; ++i) t -= (i < 4 ? ra[i & 3] : rb[i & 3]) * Tc[i];
            M2[j] = t; }
        if (lane < 8) {
#pragma unroll
            for (int j = 0; j < 8; ++j) { *(LAS unsigned short*)(a12 + 256 + j * 16 + c * 2) = (unsigned short)f2bf(Tc[j]); *(LAS unsigned short*)(a12 + 256 + (8 + j) * 16 + c * 2) = (unsigned short)f2bf(M2[j]); } }
        LDS_WAIT(); asm volatile("" ::: "memory");
        if (lane < 32) ((v4u*)(img + R4_A1))[lane] = ((const LAS v4u*)a12)[lane];
        LDS_WAIT(); asm volatile("" ::: "memory");
    }
}
constexpr int R4L_NCB = 6, R4L_SLOT = 6144;
__device__ __forceinline__ void phase_rwkv_scan4(PP p, LAS unsigned char* lds, int vcu, int tid, int lane, int wave) {
    const int m = lane & 15, q = lane >> 4;
    const unsigned char* IMG = p->ws + WS_U + U_IMG;
    for (int unit = vcu; unit < 256; unit += gridDim.x) {
        const int chain = unit >> 2, slab = unit & 3, b = chain >> 5, dir = (chain >> 4) & 1, h = chain & 15;
        float* YST = (float*)(p->ws + WS_U + U_YST) + (size_t)unit * NSTEP * 16 + (q >= 2 ? 4 * (q - 2) : 0) * 16 + m;
        const unsigned char* cimg = IMG + (size_t)chain * R4_NCH * R4_IMG;
        f32x4 S[4];
#pragma unroll
        for (int T = 0; T < 4; ++T) S[T] = (f32x4){0.f, 0.f, 0.f, 0.f};
        v2u idf; { const int c0 = 4 * q; idf.x = ((c0 == m) ? 0x3F80u : 0u) | ((c0 + 1 == m) ? 0x3F800000u : 0u); idf.y = ((c0 + 2 == m) ? 0x3F80u : 0u) | ((c0 + 3 == m) ? 0x3F800000u : 0u); }
        auto issue = [&](int bt) {
#pragma unroll
            for (int k = 0; k < 2 * R4L_NCB; ++k) { const int ii = (wave - 1) + 3 * k, cc = ii / 6, part = ii - cc * 6, pi = part * 64 + lane;
                const unsigned char* src = cimg + (size_t)(bt * R4L_NCB + cc) * R4_IMG + (pi < 304 ? pi * 16 : (pi < 336 ? R4_VT + slab * 512 + (pi - 304) * 16 : 0));
                __builtin_amdgcn_global_load_lds((const unsigned*)src, (LAS unsigned*)(lds + ((bt & 1) * R4L_NCB + cc) * R4L_SLOT + part * 1024), 16, 0, 0); } };
        float crg[32]; int cit = (int)(blockIdx.x * 4 + (wave - 4)); ConvJob cj; bool cpend = false, cloaded = false;
        LAS float* cscr = (LAS float*)(lds + 2 * R4L_NCB * R4L_SLOT + (wave & 3) * 8448);
        if (wave >= 4 && cit < IT_L1MOE) { cj = conv_job_l1(p, cit); ti_load(cj.src, cj.src_ld, lane, crg); cpend = true; cloaded = true; }
        __syncthreads();
        if (wave >= 1 && wave < 4) { issue(0); asm volatile("s_waitcnt vmcnt(0)" ::: "memory"); }
        __syncthreads();
        constexpr int NB4 = R4_NCH / R4L_NCB;
        for (int bt = 0; bt < NB4; ++bt) {
            if (wave >= 4) {
                const int ph3 = bt % 3;
                if (ph3 == 0) { if (cpend && cloaded) { ti_store(true, cj.fp8, crg, cj.dst, cj.dst_ldb, cscr, lane); cloaded = false; cit += 4 * (int)gridDim.x; cpend = cit < IT_L1MOE; } }
                else if (ph3 == 1) { if (cpend && !cloaded) { cj = conv_job_l1(p, cit); ti_load(cj.src, cj.src_ld, lane, crg); cloaded = true; } } }
            else if (wave >= 1) { if (bt + 1 < NB4) issue(bt + 1); asm volatile("s_waitcnt vmcnt(0)" ::: "memory"); }
            else {
                __builtin_amdgcn_s_setprio(3);
                struct Ops { bf16x8_t a0, a1; v2u A1u, A2u; bf16x4_t UA[4]; f32x4 g7[4]; f32x4 vr; };
                auto rd = [&](int cc, Ops& o) {
                    const LAS unsigned char* sl = lds + ((bt & 1) * R4L_NCB + cc) * R4L_SLOT;
                    o.a0 = *(const LAS bf16x8_t*)(sl + R4_DOTA + m * 128 + q * 16); o.a1 = *(const LAS bf16x8_t*)(sl + R4_DOTA + m * 128 + (4 + q) * 16);
                    o.A1u = *(const LAS v2u*)(sl + R4_A1 + m * 16 + (q & 1) * 8); o.A2u = *(const LAS v2u*)(sl + R4_A2 + m * 16 + (q & 1) * 8);
#pragma unroll
                    for (int T = 0; T < 4; ++T) { o.UA[T] = *(const LAS bf16x4_t*)(sl + R4_UPA + (16 * T + m) * 32 + q * 8); o.g7[T] = *(const LAS f32x4*)(sl + R4_G7 + (16 * T + 4 * q) * 4); }
                    o.vr = *(const LAS f32x4*)(sl + R4_VT + m * 32 + (q & 1) * 16); };
                Ops cur, nxt; rd(0, cur);
#pragma unroll
                for (int cc = 0; cc < R4L_NCB; ++cc) {
                    if (cc + 1 < R4L_NCB) rd(cc + 1, nxt);
                    __builtin_amdgcn_sched_barrier(0);
                    v2u A1u = cur.A1u, A2u = cur.A2u;
                    if (q >= 2) { A1u = (v2u){0u, 0u}; A2u = idf; }
                    v4u b0, b1;
                    b0.x = cvtpk(S[0][0], S[0][1]); b0.y = cvtpk(S[0][2], S[0][3]); b0.z = cvtpk(S[1][0], S[1][1]); b0.w = cvtpk(S[1][2], S[1][3]);
                    b1.x = cvtpk(S[2][0], S[2][1]); b1.y = cvtpk(S[2][2], S[2][3]); b1.z = cvtpk(S[3][0], S[3][1]); b1.w = cvtpk(S[3][2], S[3][3]);
                    f32x4 Dd = mfma16(cur.a0, __builtin_bit_cast(bf16x8_t, b0), (f32x4){0.f, 0.f, 0.f, 0.f});
                    Dd = mfma16(cur.a1, __builtin_bit_cast(bf16x8_t, b1), Dd);
                    v2u vb; vb.x = cvtpk(cur.vr[0], cur.vr[1]); vb.y = cvtpk(cur.vr[2], cur.vr[3]);
                    const f32x4 Z = __builtin_amdgcn_mfma_f32_16x16x16bf16_1k(__builtin_bit_cast(bf16x4_t, A1u), __builtin_bit_cast(bf16x4_t, vb), Dd, 0, 0, 0);
                    v2u zb; zb.x = cvtpk(Z[0], Z[1]); zb.y = cvtpk(Z[2], Z[3]);
                    const f32x4 W = __builtin_amdgcn_mfma_f32_16x16x16bf16_1k(__builtin_bit_cast(bf16x4_t, A2u), __builtin_bit_cast(bf16x4_t, zb), (f32x4){0.f, 0.f, 0.f, 0.f}, 0, 0, 0);
                    v2u wb; wb.x = cvtpk(W[0], W[1]); wb.y = cvtpk(W[2], W[3]);
                    const v2u ub = (q < 2) ? wb : vb;
#pragma unroll
                    for (int T = 0; T < 4; ++T) S[T] = __builtin_amdgcn_mfma_f32_16x16x16bf16_1k(cur.UA[T], __builtin_bit_cast(bf16x4_t, ub), S[T] * cur.g7[T], 0, 0, 0);
                    if (q >= 2) { float* yp = YST + (size_t)(bt * R4L_NCB + cc) * 128;
#pragma unroll
                        for (int i = 0; i < 4; ++i) yp[i * 16] = W[i]; }
                    if (cc + 1 < R4L_NCB) cur = nxt;
                }
            }
            asm volatile("s_waitcnt lgkmcnt(0)" ::: "memory"); __builtin_amdgcn_s_barrier(); asm volatile("" ::: "memory");
        }
        if (wave >= 4) { while (cpend) { if (!cloaded) { cj = conv_job_l1(p, cit); ti_load(cj.src, cj.src_ld, lane, crg); } ti_store(true, cj.fp8, crg, cj.dst, cj.dst_ldb, cscr, lane); cloaded = false; cit += 4 * (int)gridDim.x; cpend = cit < IT_L1MOE; } }
    }
}

__device__ __forceinline__ void phase_lora2(PP p, LAS unsigned char* lds, int tid, int lane, int wave) {
    const bf16* L1 = (const bf16*)(p->ws + WS_U + U_L1); const bf16* W2 = (const bf16*)(p->ws + WS_WL2);
    const int c16 = lane & 15, kq = lane >> 4;
    const int part = blockIdx.x % 12, wgp = blockIdx.x / 12, nwg = (gridDim.x - part + 11) / 12;
    const int blk = (part < 8) ? (part >> 1) : 4, col0 = (part < 8) ? (part & 1) * 512 : (part - 8) * 256, ncol = (part < 8) ? 512 : 256;
    const int koff = (blk < 4) ? blk * 64 : 256, nks = (blk < 4) ? 2 : 4, K = nks * 32, WP = K * 2 + 16;
    LAS unsigned char* wl = lds;
    constexpr int PS = 272;
    LAS unsigned char* stg = lds + 73728 + wave * (16 * PS);
    { const int ppr = K / 8;
      for (int u = tid; u < ncol * ppr; u += NTHREADS) { const int c = u / ppr, pc = u - c * ppr;
          *(LAS v4u*)(wl + c * WP + pc * 16) = *(const v4u*)(W2 + (size_t)(blk * 1024 + col0 + c) * 384 + koff + pc * 8); } }
    __syncthreads();
    bf16* dstb = (bf16*)(p->ws + WS_U + ((blk < 2) ? U_WD : (blk < 4) ? U_AD : U_G)) + (size_t)((blk < 4) ? (blk & 1) : 0) * NROW * D + col0;
    const float* bias = ((blk < 2) ? p->in[I_DECW0] + blk * D : p->in[I_A0] + ((blk - 2) & 1) * D) + col0;
    for (int rt = wgp * NWAVES + wave; rt < NROW / 16; rt += nwg * NWAVES) {
        const bf16* lp = L1 + (size_t)(rt * 16 + c16) * 384 + koff + 8 * kq;
        bf16x8_t bfr[4];
#pragma unroll
        for (int s = 0; s < 4; ++s) if (s < nks) bfr[s] = *(const bf16x8_t*)(lp + 32 * s);
        bf16* dst = dstb + (size_t)(rt * 16) * D;
        for (int ps = 0; ps < ncol / 128; ++ps) {
#pragma unroll 4
            for (int ct = 0; ct < 8; ++ct) {
                const int c0 = ps * 128 + ct * 16;
                const LAS unsigned char* wp = wl + (c0 + c16) * WP + 16 * kq;
                f32x4 acc = (f32x4){0.f, 0.f, 0.f, 0.f};
#pragma unroll
                for (int s = 0; s < 4; ++s) if (s < nks) acc = mfma16(*(const LAS bf16x8_t*)(wp + 64 * s), bfr[s], acc);
                const f32x4 bb = *(const f32x4*)(bias + c0 + 4 * kq);
                if (blk < 2) { for (int j = 0; j < 4; ++j) acc[j] = -0.60653066f * sigm(acc[j] + bb[j]); }
                else if (blk < 4) { for (int j = 0; j < 4; ++j) acc[j] = sigm(acc[j] + bb[j]); }
                v2u w; w.x = pk2(acc[0], acc[1]); w.y = pk2(acc[2], acc[3]);
                *(LAS v2u*)(stg + c16 * PS + (ct * 16 + 4 * kq) * 2) = w;
            }
            LDS_WAIT(); asm volatile("" ::: "memory");
#pragma unroll
            for (int i = 0; i < 4; ++i) { const int row = 4 * i + (lane >> 4), cb = lane & 15;
                *(v4u*)(dst + (size_t)row * D + ps * 128 + cb * 8) = *(const LAS v4u*)(stg + row * PS + cb * 16); }
            LDS_WAIT(); asm volatile("" ::: "memory");
        }
    }
    __syncthreads();
}

constexpr int R5_DOTA = 0, R5_UPA = 4096, R5_A21 = 8192, R5_A2 = 9216, R5_GE = 10240, R5_VT = 10496, R5_IMG = 12544, R5_NCH = NSTEP / 16, R5_NCB = 3, R5_SLOT = 12288, R5_NST = 3;
__device__ __forceinline__ void phase_rw_prep5(PP p, LAS unsigned char* lds, int lane, int wave) {
    const int gw = blockIdx.x * NWAVES + wave, NGW = gridDim.x * NWAVES;
    const bf16* RKV = (const bf16*)(p->ws + WS_U + U_RKV); unsigned char* IMG = p->ws + WS_U + U_IMG;
    LAS unsigned char* da = lds + wave * 14336;
    LAS unsigned char* gb = da + 4096; LAS float* GL = (LAS float*)(da + 8192); LAS unsigned char* a12 = da + 12288; LAS float* TM = (LAS float*)gb;
    const int m = lane & 15, q = lane >> 4;
    const int s2 = lane >> 5, tp = (lane >> 4) & 1, kq = (lane & 15) >> 2, ii = (lane & 3) + 4 * tp, dpos = ((s2 * 4 + kq) * 8 + ii) * 2;
    float nrx[16], nkx[16], nvx[16], nlw[16], nav[16];
    auto ld = [&](int it2) {
        const int chain = it2 & 63, chunk = it2 >> 6, b = chain >> 5, dir = (chain >> 4) & 1, h = chain & 15, ch = h * 64 + lane;
        const bf16* WDp = (const bf16*)(p->ws + WS_U + U_WD) + (size_t)dir * NROW * D; const bf16* ADp = (const bf16*)(p->ws + WS_U + U_AD) + (size_t)dir * NROW * D;
#pragma unroll
        for (int j = 0; j < 16; ++j) { const int row = step_row(b, dir, chunk * 16 + j);
            nrx[j] = bf2f(RKV[(size_t)row * 3072 + ch]); nkx[j] = bf2f(RKV[(size_t)row * 3072 + 1024 + ch]); nvx[j] = bf2f(RKV[(size_t)row * 3072 + 2048 + ch]);
            nlw[j] = bf2f(WDp[(size_t)row * D + ch]); nav[j] = bf2f(ADp[(size_t)row * D + ch]); } };
    if (gw < 64 * R5_NCH) ld(gw);
    const float kkw = p->in[I_KK][((gw & 63) & 15) * 64 + lane], kaw = p->in[I_KA][((gw & 63) & 15) * 64 + lane];
    for (int it = gw; it < 64 * R5_NCH; it += NGW) {
        const int chain = it & 63, chunk = it >> 6, h = chain & 15, ch = h * 64 + lane;
        unsigned char* img = IMG + ((size_t)chain * R5_NCH + chunk) * R5_IMG;
        float upf[32]; float bb = 0.f, ebprev = 1.f, eb = 1.f;
#pragma unroll
        for (int j = 0; j < 16; ++j) {
            const float t = nkx[j] * kkw; const float kn = t * __builtin_amdgcn_rsqf(fmaxf(wave_sum(t * t), 1e-24f));
            bb += nlw[j]; eb = __expf(bb); const float einv = __builtin_amdgcn_rcpf(eb);
            const float beta = kn * nav[j], kdv = nkx[j] * (1.f + (nav[j] - 1.f) * kaw);
            *(LAS unsigned short*)(da + j * 128 + dpos) = (unsigned short)f2bf(kn * ebprev);
            *(LAS unsigned short*)(da + (16 + j) * 128 + dpos) = (unsigned short)f2bf(nrx[j] * eb);
            *(LAS unsigned short*)(gb + j * 128 + dpos) = (unsigned short)f2bf(beta * einv);
            *(LAS unsigned short*)(gb + (16 + j) * 128 + dpos) = (unsigned short)f2bf(kdv * einv);
            upf[8 * (j >> 2) + (j & 3)] = -beta * einv; upf[8 * (j >> 2) + 4 + (j & 3)] = kdv * einv;
            ebprev = eb;
        }
        const float eE = eb;
        { v4u* d = (v4u*)(img + R5_UPA + lane * 16);
#pragma unroll
          for (int u = 0; u < 4; ++u) d[64 * u] = (v4u){pk2(upf[8 * u] * eE, upf[8 * u + 1] * eE), pk2(upf[8 * u + 2] * eE, upf[8 * u + 3] * eE), pk2(upf[8 * u + 4] * eE, upf[8 * u + 5] * eE), pk2(upf[8 * u + 6] * eE, upf[8 * u + 7] * eE)}; }
        ((float*)(img + R5_GE))[lane] = eE;
        { v2u* d = (v2u*)(img + R5_VT + (lane >> 4) * 512 + (lane & 15) * 8);
#pragma unroll
          for (int u = 0; u < 4; ++u) d[16 * u] = (v2u){pk2(nvx[4 * u], nvx[4 * u + 1]), pk2(nvx[4 * u + 2], nvx[4 * u + 3])}; }
        if (it + NGW < 64 * R5_NCH) ld(it + NGW);
        LDS_WAIT(); asm volatile("" ::: "memory");
        { v4u* d = (v4u*)(img + R5_DOTA);
#pragma unroll
          for (int u = 0; u < 4; ++u) d[64 * u + lane] = ((const LAS v4u*)da)[64 * u + lane]; }
#pragma unroll
        for (int rb = 0; rb < 2; ++rb)
#pragma unroll
            for (int cb = 0; cb < 2; ++cb) { f32x4 Gt = (f32x4){0.f, 0.f, 0.f, 0.f};
#pragma unroll
                for (int s = 0; s < 2; ++s) Gt = mfma16(*(const LAS bf16x8_t*)(da + (16 * rb + m) * 128 + (s * 4 + q) * 16), *(const LAS bf16x8_t*)(gb + (16 * cb + m) * 128 + (s * 4 + q) * 16), Gt);
#pragma unroll
                for (int jp = 0; jp < 4; ++jp) GL[(16 * rb + 4 * q + jp) * 32 + 16 * cb + m] = Gt[jp]; }
        LDS_WAIT(); asm volatile("" ::: "memory");
        const int c = lane & 15; float Tc[16], M2[16];
#pragma unroll
        for (int j = 0; j < 16; ++j) { float t = (j == c) ? 1.f : 0.f;
#pragma unroll
            for (int i4 = 0; i4 < (j + 3) / 4; ++i4) { const f32x4 rr = *(const LAS f32x4*)(GL + j * 32 + 4 * i4);
#pragma unroll
                for (int e = 0; e < 4; ++e) if (4 * i4 + e < j) t -= rr[e] * Tc[4 * i4 + e]; }
            Tc[j] = t; }
#pragma unroll
        for (int j = 0; j < 16; ++j) { float t = 0.f;
#pragma unroll
            for (int i4 = 0; i4 < (j + 4) / 4; ++i4) { const f32x4 rr = *(const LAS f32x4*)(GL + (16 + j) * 32 + 4 * i4);
#pragma unroll
                for (int e = 0; e < 4; ++e) if (4 * i4 + e <= j) t -= rr[e] * Tc[4 * i4 + e]; }
            M2[j] = t; }
        if (lane < 16) {
#pragma unroll
            for (int j = 0; j < 16; ++j) { *(LAS unsigned short*)(a12 + 1024 + j * 32 + c * 2) = (unsigned short)f2bf(Tc[j]); *(LAS unsigned short*)(a12 + 1024 + (16 + j) * 32 + c * 2) = (unsigned short)f2bf(M2[j]);
                TM[j * 16 + c] = Tc[j]; TM[(16 + j) * 16 + c] = M2[j]; } }
        LDS_WAIT(); asm volatile("" ::: "memory");
        { const int r = lane >> 1, i0 = 8 * (lane & 1); float e8[8];
#pragma unroll
          for (int x = 0; x < 8; ++x) e8[x] = 0.f;
#pragma unroll
          for (int mm = 1; mm < 16; ++mm) { const float tv = TM[r * 16 + mm]; const f32x4 ca = *(const LAS f32x4*)(GL + mm * 32 + 16 + i0), cb4 = *(const LAS f32x4*)(GL + mm * 32 + 16 + i0 + 4);
#pragma unroll
              for (int x = 0; x < 4; ++x) { e8[x] += (i0 + x < mm) ? tv * ca[x] : 0.f; e8[4 + x] += (i0 + 4 + x < mm) ? tv * cb4[x] : 0.f; } }
          if (r >= 16) { const int jj = r - 16; const f32x4 da4 = *(const LAS f32x4*)(GL + r * 32 + 16 + i0), db4 = *(const LAS f32x4*)(GL + r * 32 + 16 + i0 + 4);
#pragma unroll
              for (int x = 0; x < 4; ++x) { e8[x] += (i0 + x <= jj) ? da4[x] : 0.f; e8[4 + x] += (i0 + 4 + x <= jj) ? db4[x] : 0.f; } }
          *(LAS v4u*)(a12 + r * 32 + i0 * 2) = (v4u){pk2(e8[0], e8[1]), pk2(e8[2], e8[3]), pk2(e8[4], e8[5]), pk2(e8[6], e8[7])}; }
        LDS_WAIT(); asm volatile("" ::: "memory");
        { v4u* d = (v4u*)(img + R5_A21); d[lane] = ((const LAS v4u*)a12)[lane]; d[64 + lane] = ((const LAS v4u*)a12)[64 + lane]; }
        LDS_WAIT(); asm volatile("" ::: "memory");
    }
}
constexpr int R7_SLOT = 12288, R7_NPC = 12;
__device__ __forceinline__ void phase_rwkv_scan7(PP p, LAS unsigned char* lds, int vcu, int tid, int lane, int wave) {
    const int m = lane & 15, q = lane >> 4;
    constexpr int NB5 = R5_NCH / R5_NCB;
    const int nsc = ((int)gridDim.x + 1) >> 1, ncv = (int)gridDim.x >> 1;
    if (vcu & 1) {
        LAS float* scr = (LAS float*)(lds + wave * 16384);
        const int cw = vcu >> 1, NGW = ncv * NWAVES; int it = cw * NWAVES + wave;
#ifdef PROBE_NOCONV_REPEAT
        if (*(volatile LAS int*)(lds + LDS_BYTES - 32) != 0) it = IT_L1MOE;
#endif
        ConvJob j0{}, j1{}, j2{}; f32x4 r0[8], r1[8], r2[8];
        if (it < IT_L1MOE) { j0 = conv_job_l1(p, it); ti_load4(j0.src, j0.src_ld, lane, r0); }
        if (it + NGW < IT_L1MOE) { j1 = conv_job_l1(p, it + NGW); ti_load4(j1.src, j1.src_ld, lane, r1); }
        if (it + 2 * NGW < IT_L1MOE) { j2 = conv_job_l1(p, it + 2 * NGW); ti_load4(j2.src, j2.src_ld, lane, r2); }
        for (; it < IT_L1MOE; it += 3 * NGW) {
            { const ConvJob cj = j0; f32x4 c[8];
#pragma unroll
              for (int i = 0; i < 8; ++i) c[i] = r0[i];
              if (it + 3 * NGW < IT_L1MOE) { j0 = conv_job_l1(p, it + 3 * NGW); ti_load4(j0.src, j0.src_ld, lane, r0); }
              ti_store4_fp8(c, cj.dst, cj.dst_ldb, scr, lane); }
            if (it + NGW < IT_L1MOE) { const ConvJob cj = j1; f32x4 c[8];
#pragma unroll
              for (int i = 0; i < 8; ++i) c[i] = r1[i];
              if (it + 4 * NGW < IT_L1MOE) { j1 = conv_job_l1(p, it + 4 * NGW); ti_load4(j1.src, j1.src_ld, lane, r1); }
              ti_store4_fp8(c, cj.dst, cj.dst_ldb, scr, lane); }
            if (it + 2 * NGW < IT_L1MOE) { const ConvJob cj = j2; f32x4 c[8];
#pragma unroll
              for (int i = 0; i < 8; ++i) c[i] = r2[i];
              if (it + 5 * NGW < IT_L1MOE) { j2 = conv_job_l1(p, it + 5 * NGW); ti_load4(j2.src, j2.src_ld, lane, r2); }
              ti_store4_fp8(c, cj.dst, cj.dst_ldb, scr, lane); }
        }
        return;
    }
    const unsigned char* IMG = p->ws + WS_U + U_IMG;
    for (int su = vcu >> 1; su < 128; su += nsc) {
        const int chain = su >> 1, pair = su & 1;
        const unsigned char* cimg = IMG + (size_t)chain * R5_NCH * R5_IMG;
        const int li = (wave == 2) ? 0 : (wave == 3) ? 1 : (wave == 6) ? 2 : -1;
        auto issue = [&](int bt) {
            const unsigned char* ci = cimg + (size_t)(bt * R5_NCB + li) * R5_IMG;
            LAS unsigned char* dl = lds + ((bt % R5_NST) * R5_NCB + li) * R7_SLOT;
#pragma unroll
            for (int k = 0; k < R7_NPC; ++k) { const int pi = k * 64 + lane;
                const unsigned char* src = ci + (pi < 656 ? pi * 16 : (pi < 720 ? R5_VT + pair * 1024 + (pi - 656) * 16 : 0));
                __builtin_amdgcn_global_load_lds((const unsigned*)src, (LAS unsigned*)(dl + k * 1024), 16, 0, 0); } };
        __syncthreads();
        if (li >= 0) { issue(0); issue(1); asm volatile("s_waitcnt vmcnt(12)" ::: "memory"); }
        __syncthreads();
        if (wave >= 2) {
            if (li >= 0) {
                for (int bt = 0; bt < NB5; ++bt) {
                    if (bt + 2 < NB5) { issue(bt + 2); asm volatile("s_waitcnt vmcnt(12)" ::: "memory"); } else asm volatile("s_waitcnt vmcnt(0)" ::: "memory");
                    asm volatile("s_waitcnt lgkmcnt(0)" ::: "memory"); __builtin_amdgcn_s_barrier(); asm volatile("" ::: "memory");
                }
            } else {
                for (int bt = 0; bt < NB5; ++bt) { asm volatile("s_waitcnt lgkmcnt(0)" ::: "memory"); __builtin_amdgcn_s_barrier(); asm volatile("" ::: "memory"); }
            }
        } else {
            const int unit = chain * 4 + pair * 2 + wave;
            float* YST = (float*)(p->ws + WS_U + U_YST) + (size_t)unit * NSTEP * 16 + (4 * q) * 16 + m;
            f32x4 S[4];
#pragma unroll
            for (int T = 0; T < 4; ++T) S[T] = (f32x4){0.f, 0.f, 0.f, 0.f};
            __builtin_amdgcn_s_setprio(3);
            for (int bt = 0; bt < NB5; ++bt) {
                struct OpsE { bf16x8_t a[2][2]; bf16x4_t e21[2]; v2u vr; };
                struct OpsL { bf16x4_t a2[2]; bf16x8_t UA[4]; f32x4 ge[4]; };
                auto rdE = [&](int cc, OpsE& o) {
                    const LAS unsigned char* sl = lds + ((bt % R5_NST) * R5_NCB + cc) * R7_SLOT;
#pragma unroll
                    for (int rb = 0; rb < 2; ++rb) {
#pragma unroll
                        for (int s = 0; s < 2; ++s) o.a[rb][s] = *(const LAS bf16x8_t*)(sl + R5_DOTA + (16 * rb + m) * 128 + (s * 4 + q) * 16);
                        o.e21[rb] = *(const LAS bf16x4_t*)(sl + R5_A21 + (16 * rb + m) * 32 + q * 8); }
                    o.vr = *(const LAS v2u*)(sl + R5_VT + wave * 512 + q * 128 + m * 8); };
                auto rdL = [&](int cc, OpsL& o) {
                    const LAS unsigned char* sl = lds + ((bt % R5_NST) * R5_NCB + cc) * R7_SLOT;
#pragma unroll
                    for (int rb = 0; rb < 2; ++rb) o.a2[rb] = *(const LAS bf16x4_t*)(sl + R5_A2 + (16 * rb + m) * 32 + q * 8);
#pragma unroll
                    for (int T = 0; T < 4; ++T) { o.UA[T] = *(const LAS bf16x8_t*)(sl + R5_UPA + q * 1024 + (16 * T + m) * 16); o.ge[T] = *(const LAS f32x4*)(sl + R5_GE + (16 * T + 4 * q) * 4); } };
                OpsE cur, nxt; OpsL L; rdE(0, cur);
#pragma unroll
                for (int cc = 0; cc < R5_NCB; ++cc) {
                    rdL(cc, L);
                    if (cc + 1 < R5_NCB) rdE(cc + 1, nxt);
                    __builtin_amdgcn_sched_barrier(0);
                    v4u b0, b1;
                    b0.x = cvtpk(S[0][0], S[0][1]); b0.y = cvtpk(S[0][2], S[0][3]); b0.z = cvtpk(S[1][0], S[1][1]); b0.w = cvtpk(S[1][2], S[1][3]);
                    b1.x = cvtpk(S[2][0], S[2][1]); b1.y = cvtpk(S[2][2], S[2][3]); b1.z = cvtpk(S[3][0], S[3][1]); b1.w = cvtpk(S[3][2], S[3][3]);
                    const f32x4 z4 = (f32x4){0.f, 0.f, 0.f, 0.f};
                    const v2u vb = cur.vr;
                    f32x4 D0 = mfma16(cur.a[0][0], __builtin_bit_cast(bf16x8_t, b0), z4), D1 = mfma16(cur.a[1][0], __builtin_bit_cast(bf16x8_t, b0), z4);
                    const f32x4 E0 = __builtin_amdgcn_mfma_f32_16x16x16bf16_1k(cur.e21[0], __builtin_bit_cast(bf16x4_t, vb), z4, 0, 0, 0);
                    D0 = mfma16(cur.a[0][1], __builtin_bit_cast(bf16x8_t, b1), D0); D1 = mfma16(cur.a[1][1], __builtin_bit_cast(bf16x8_t, b1), D1);
                    const f32x4 E1 = __builtin_amdgcn_mfma_f32_16x16x16bf16_1k(cur.e21[1], __builtin_bit_cast(bf16x4_t, vb), D1, 0, 0, 0);
                    v2u db; db.x = cvtpk(D0[0], D0[1]); db.y = cvtpk(D0[2], D0[3]);
                    const f32x4 W0 = __builtin_amdgcn_mfma_f32_16x16x16bf16_1k(L.a2[0], __builtin_bit_cast(bf16x4_t, db), E0, 0, 0, 0);
                    const f32x4 W1 = __builtin_amdgcn_mfma_f32_16x16x16bf16_1k(L.a2[1], __builtin_bit_cast(bf16x4_t, db), E1, 0, 0, 0);
                    v4u ub; ub.x = cvtpk(W0[0], W0[1]); ub.y = cvtpk(W0[2], W0[3]); ub.z = vb.x; ub.w = vb.y;
#pragma unroll
                    for (int T = 0; T < 4; ++T) S[T] = mfma16(L.UA[T], __builtin_bit_cast(bf16x8_t, ub), S[T] * L.ge[T]);
                    { float* yp = YST + (size_t)(bt * R5_NCB + cc) * 256;
#pragma unroll
                      for (int i = 0; i < 4; ++i) yp[i * 16] = W1[i]; }
                    if (cc + 1 < R5_NCB) cur = nxt;
                }
                asm volatile("s_waitcnt lgkmcnt(0)" ::: "memory"); __builtin_amdgcn_s_barrier(); asm volatile("" ::: "memory");
            }
            __builtin_amdgcn_s_setprio(0);
        }
    }
}
enum { PH_PRE = 0, PH_NORM0, PH_G_IN, PH_GLA_A, PH_GLA_B, PH_GLA_C, PH_G_HGO, PH_FFN0, PH_GU0, PH_DN0, PH_COMB0,
       PH_LERP, PH_G_RKV, PH_G_L2, PH_RWPREP, PH_RWSCAN, PH_RWRO, PH_G_RWO, PH_FFN1, PH_GU1, PH_DN1, PH_COMB1, NPHASES };

template <int ph> __device__ __forceinline__ void run_phase(PP p, LAS unsigned char* lds, int tid, int lane, int wave, int G, int bx, int vcu) {
    unsigned char* ws = p->ws;
    typedef pg8::bf16_t bt;
    switch (ph) {
        case PH_PRE: phase_pre(p, lds, tid, lane, wave); break;
        case PH_NORM0: phase_norm0(p, lane, wave); break;
        case PH_G_IN: {
            pg8::Gemm g{(const bt*)(ws + WS_H), (const bt*)(ws + WS_WIN), NROW, 5120, D / 2}; pg8::StaticOrder S; S.init(NROW, 5120, G, bx);
            pg8::EpiStoreBf16 E{(bt*)(ws + WS_U + U_Z), 5120};
            pg8::gemm_phase<pg8::EpiStoreBf16, pg8::StaticOrder, true, true, true>(lds, g, S, E); } break;
        case PH_GLA_A: phase_gla_prep(p, lds, tid, lane, wave); break;
        case PH_GLA_B: phase_gla_scan(p, tid); break;
        case PH_GLA_C: phase_gla_out(p, lds, tid, lane, wave); break;
        case PH_G_HGO: {
            pg8::Gemm g{(const bt*)(ws + WS_A2), (const bt*)(ws + WS_WHGO), NROW, D, D}; pg8::StaticOrder S; S.init(NROW, D, G, bx);
            pg8::EpiResid E{p->in[I_X], p->in[I_CTX], (float*)(ws + WS_XR), modp(p, 0, 0, 2), 6144};
            pg8::gemm_phase<pg8::EpiResid, pg8::StaticOrder, true, true>(lds, g, S, E); } break;
        case PH_FFN0: phase_ffn_norm_route4(p, 0, NROW, lds, tid, lane, wave); break;
        case PH_FFN1: phase_ffn_norm_route4(p, 1, NLAT, lds, tid, lane, wave); break;
        case PH_GU0: case PH_GU1: { const int layer = (ph == PH_GU1);
            pg8::Gemm g{(const bt*)(ws + WS_U + U_XB), (const bt*)(ws + WS_WGU + (size_t)layer * NE * 2048 * D), CAP, 2048, D / 2};
            const int ntl = (int)((const unsigned*)(ws + WS_CTL))[CW_NT + layer];
            pg8::MoeOrder S; S.init((const int*)(ws + WS_ROUTE + RT_TILEE) + layer * 512, ntl, (LAS int*)(lds + 132096), 8, (size_t)2048 * D, G, vcu);
            pg8::EpiSwiglu E{p, layer};
            pg8::gemm_phase<pg8::EpiSwiglu, pg8::MoeOrder, true, true, true>(lds, g, S, E); } break;
        case PH_DN0: case PH_DN1: { const int layer = (ph == PH_DN1);
            pg8::Gemm g{(const bt*)(ws + WS_U + U_ACT), (const bt*)(ws + WS_WD + (size_t)layer * NE * D * D), CAP, D, D / 2};
            const int ntl = (int)((const unsigned*)(ws + WS_CTL))[CW_NT + layer];
            pg8::MoeOrder S; S.init((const int*)(ws + WS_ROUTE + RT_TILEE) + layer * 512, ntl, (LAS int*)(lds + 132096), 4, (size_t)D * D, G, vcu);
            pg8::EpiDown E{p, layer};
            pg8::gemm_phase<pg8::EpiDown, pg8::MoeOrder, true, true, true>(lds, g, S, E); } break;
        case PH_COMB0: phase_combine(p, 0, NROW, false, lane, wave); break;
        case PH_COMB1: phase_combine(p, 1, NLAT, true, lane, wave); break;
        case PH_LERP: phase_lerp(p, lds, tid, lane, wave); break;
        case PH_G_RKV: {
            pg8::Gemm g{(const bt*)(ws + WS_U + U_XL6), (const bt*)(ws + WS_WRKV), NROW, 3072, D};
            pg8::RkvL1Order S; S.init(NROW, G, bx, (const bt*)(ws + WS_WL1), (size_t)NROW * D * 2);
            pg8::EpiRkvL1 E{pg8::EpiStoreBf16{(bt*)(ws + WS_U + U_RKV), 3072}, pg8::EpiLora1{(bt*)(ws + WS_U + U_L1)}};
            pg8::gemm_phase<pg8::EpiRkvL1, pg8::RkvL1Order, true, true>(lds, g, S, E); } break;
        case PH_G_L2: phase_lora2(p, lds, tid, lane, wave); break;
        case PH_RWPREP: phase_rw_prep5(p, lds, lane, wave); break;
        case PH_RWSCAN: phase_rwkv_scan7(p, lds, vcu, tid, lane, wave); break;
        case PH_RWRO: phase_rw_readout(p, lane, wave); break;
        case PH_G_RWO: {
            pg8::Gemm g{(const bt*)(ws + WS_A2), (const bt*)(ws + WS_WRWO), NLAT, D, D}; pg8::StaticOrder S; S.init(NLAT, D, G, bx);
            float* XR = (float*)(ws + WS_XR);
            pg8::EpiResid E{XR, XR + (size_t)NLAT * D, XR, modp(p, 1, 0, 2), 6144};
            pg8::gemm_phase<pg8::EpiResid, pg8::StaticOrder, true, true>(lds, g, S, E); } break;
        default: break;
    }
}

#define MK_PROLOGUE \
    extern __shared__ __attribute__((aligned(16))) unsigned char lds_raw[]; \
    LAS unsigned char* lds = (LAS unsigned char*)lds_raw; \
    const int tid = threadIdx.x, lane = tid & 63, wave = __builtin_amdgcn_readfirstlane(tid >> 6); \
    const int G = gridDim.x, bx = blockIdx.x, vcu = (G % 8 == 0) ? (bx % 8) * (G / 8) + bx / 8 : bx;

#define XB_TMO      128
#define XB_XCNT(j)  (256  + 64 * (j))
#define XB_XSUB(j)  (1280 + 64 * (j))
#define XB_XGEN(j)  (2304 + 64 * (j))
#define XB_TOP      3328
#define XB_TOPGEN   3392
#define XCD_BAR_WORDS 3456
#define XB_SPIN_CAP (1u << 18)

__device__ __forceinline__ unsigned xb_ld(unsigned* p)              { return __hip_atomic_load(p, __ATOMIC_RELAXED, __HIP_MEMORY_SCOPE_AGENT); }
__device__ __forceinline__ unsigned xb_add(unsigned* p, unsigned v) { return __hip_atomic_fetch_add(p, v, __ATOMIC_RELAXED, __HIP_MEMORY_SCOPE_AGENT); }
__device__ __forceinline__ unsigned xb_xcc_id() { return (unsigned)__builtin_amdgcn_s_getreg((3 << 11) | 20) & 0xFu; }
#define XB_SPIN(cond, bar) do { unsigned _sp = 0; while (cond) { __builtin_amdgcn_s_sleep(1); \
    if ((++_sp & 255u) == 0u) { if (xb_ld(&(bar)[XB_TMO])) break; if (_sp > XB_SPIN_CAP) { atomicAdd(&(bar)[XB_TMO], 1u); break; } } } } while (0)

struct XcdBarrier {
    unsigned* bar; unsigned x;
    volatile LAS unsigned* st;
};

__device__ __forceinline__ XcdBarrier xcd_barrier_post(unsigned* bar, volatile LAS unsigned* st) {
    XcdBarrier b; b.bar = bar; b.x = xb_xcc_id(); b.st = st;
    if (threadIdx.x == 0) (void)xb_add(&bar[XB_XCNT(b.x)], 1u);
    return b;
}
__device__ __forceinline__ void xcd_barrier_complete(unsigned* bar, unsigned x, unsigned& nloc, unsigned& nx) {
    const unsigned G = gridDim.x * gridDim.y * gridDim.z;
    unsigned sum, cnt, mine, sp = 0u;
    for (;;) {
        sum = 0u; cnt = 0u; mine = 0u;
#pragma unroll
        for (unsigned j = 0; j < 16; ++j) { const unsigned c = xb_ld(&bar[XB_XCNT(j)]); sum += c; cnt += (c > 0u) ? 1u : 0u; mine = (j == x) ? c : mine; }
        if (sum == G) break;
        __builtin_amdgcn_s_sleep(1);
        if ((++sp & 255u) == 0u) { if (xb_ld(&bar[XB_TMO])) break; if (sp > XB_SPIN_CAP) { atomicAdd(&bar[XB_TMO], 1u); break; } }
    }
    nloc = mine > 0u ? mine : 1u; nx = cnt > 0u ? cnt : 1u;
}

__device__ __forceinline__ void xcd_barrier(const XcdBarrier& b) {
    asm volatile("s_waitcnt vmcnt(0)" ::: "memory");
    __syncthreads();
    if (threadIdx.x == 0) {
        unsigned* bar = b.bar;
        __builtin_amdgcn_s_waitcnt(0);
        unsigned nloc = b.st[0], nx = b.st[1];
        if (nloc == 0u) { xcd_barrier_complete(bar, b.x, nloc, nx); b.st[0] = nloc; b.st[1] = nx; }
        const unsigned old = xb_add(&bar[XB_XSUB(b.x)], 1u);
        const unsigned gen = old / nloc;
        if (old + 1u == (gen + 1u) * nloc) {
            __builtin_amdgcn_fence(__ATOMIC_RELEASE, "agent");
            asm volatile("s_waitcnt vmcnt(0)" ::: "memory");
            const unsigned og = xb_add(&bar[XB_TOP], 1u);
            const unsigned tg = og / nx;
            if (og + 1u == (tg + 1u) * nx) xb_add(&bar[XB_TOPGEN], 1u);
            else XB_SPIN(xb_ld(&bar[XB_TOPGEN]) == tg, bar);
            __builtin_amdgcn_fence(__ATOMIC_ACQUIRE, "agent");
            xb_add(&bar[XB_XGEN(b.x)], 1u);
            asm volatile("s_waitcnt vmcnt(0)" ::: "memory");
        } else {
            XB_SPIN(xb_ld(&bar[XB_XGEN(b.x)]) == gen, bar);
            __builtin_amdgcn_fence(__ATOMIC_ACQUIRE, "agent");
            asm volatile("s_waitcnt vmcnt(0)" ::: "memory");
        }
    }
    __syncthreads();
}

constexpr int LDSCTL_OFF = 131072, MISC_OFF = LDSCTL_OFF + 320;
__device__ __forceinline__ void grid_bar(PP kp, LAS unsigned char* lds) {
    PP q = kp; asm volatile("" : "+s"(q));
    XcdBarrier b; b.bar = (unsigned*)(q->ws + WS_CTL) + CW_BAR; b.x = xb_xcc_id(); b.st = (volatile LAS unsigned*)(lds + LDS_BYTES - 64);
    xcd_barrier(b);
}
namespace cg = cooperative_groups;
__global__ void __launch_bounds__(NTHREADS, 2) mk_fwd(Params pv) {
    MK_PROLOGUE
    cg::grid_group grid = cg::this_grid();
    PP kp = (PP)__builtin_amdgcn_kernarg_segment_ptr();
    const int lo = kp->ph_lo, hi = kp->ph_hi;
    for (int u = tid; u < (LDS_BYTES - LDSCTL_OFF) / 4; u += NTHREADS) ((LAS unsigned*)(lds + LDSCTL_OFF))[u] = 0u;
    __syncthreads();
    { XcdBarrier b0 = xcd_barrier_post((unsigned*)(kp->ws + WS_CTL) + CW_BAR, (volatile LAS unsigned*)(lds + LDS_BYTES - 64)); (void)b0; }
#ifndef REPEAT_MASK
#define REPEAT_MASK 0u
#endif
#define RUN(k) if (lo <= (k) && (k) < hi) { PP q = kp; asm volatile("" : "+s"(q)); run_phase<k>(q, lds, tid, lane, wave, G, bx, vcu); \
        if ((REPEAT_MASK >> (k)) & 1u) { grid_bar(kp, lds); PP q2 = kp; asm volatile("" : "+s"(q2)); run_phase<k>(q2, lds, tid, lane, wave, G, bx, vcu); } \
        if ((k) + 1 < hi) { if ((k) == 0) grid.sync(); else grid_bar(kp, lds); } }
    RUN(0) RUN(1) RUN(2) RUN(3) RUN(4) RUN(5) RUN(6) RUN(7) RUN(8) RUN(9) RUN(10) RUN(11) RUN(12) RUN(13) RUN(14) RUN(15) RUN(16) RUN(17) RUN(18) RUN(19) RUN(20) RUN(21)
#undef RUN
}

extern "C" void kernel_launch(void* const* d_in, const int* in_sizes, int n_in, void* d_out, int out_size, void* d_ws, size_t ws_size, hipStream_t stream) {
    static int grid = 0;
    if (grid == 0) {
        if (n_in != 35 || in_sizes[0] != NLAT * D || out_size != NLAT * D || ws_size < WS_END) {
            fprintf(stderr, "kernel_launch: unexpected problem (n_in %d, in0 %d, out %d, ws %zu < %zu)\n", n_in, n_in > 0 ? in_sizes[0] : -1, out_size, ws_size, (size_t)WS_END); grid = -1; return; }
        int dev = 0, cus = 0, per_cu = 0;
        if (hipGetDevice(&dev) != hipSuccess || hipDeviceGetAttribute(&cus, hipDeviceAttributeMultiprocessorCount, dev) != hipSuccess) { grid = -1; return; }
        if (hipFuncSetAttribute((const void*)mk_fwd, hipFuncAttributeMaxDynamicSharedMemorySize, LDS_BYTES) != hipSuccess) { fprintf(stderr, "kernel_launch: hipFuncSetAttribute failed\n"); grid = -1; return; }
        if (hipOccupancyMaxActiveBlocksPerMultiprocessor(&per_cu, (const void*)mk_fwd, NTHREADS, LDS_BYTES) != hipSuccess || per_cu < 1) { fprintf(stderr, "kernel_launch: occupancy query %d\n", per_cu); per_cu = 1; }
        (void)hipGetLastError();
        grid = cus * (per_cu < 1 ? 1 : per_cu);
    }
    if (grid < 0) return;
    (void)hipMemsetAsync((char*)d_ws + WS_CTL, 0, CTL_ZERO_BYTES, stream);
    Params p{};
    for (int i = 0; i < 35; ++i) p.in[i] = (const float*)d_in[i];
    p.out = (float*)d_out; p.ws = (unsigned char*)d_ws;
    p.ph_lo = 0; p.ph_hi = NPHASES;
    void* args[] = {&p};
    hipError_t e = hipLaunchCooperativeKernel((const void*)mk_fwd, dim3(grid), dim3(NTHREADS), args, LDS_BYTES, stream);
    if (e != hipSuccess) fprintf(stderr, "kernel_launch: cooperative launch failed: %s (grid %d)\n", hipGetErrorString(e), grid);
}
```

```cpp
#include <hip/hip_runtime.h>
#include <hip/hip_cooperative_groups.h>
#include <cstdio>
#include <cstdint>

namespace pg8 {
#define PG8_LAS __attribute__((address_space(3)))
typedef unsigned short bf16_t;
typedef short bf16x8 __attribute__((ext_vector_type(8)));
typedef float f32x4 __attribute__((ext_vector_type(4)));
typedef unsigned u32x4 __attribute__((ext_vector_type(4)));
constexpr int BM = 256, BK = 64, HALF = 128, HTB = HALF * BK * 2  , STAGE_BYTES = 8 * HTB, NXCD = 8, WGM = 8;

__host__ __device__ __forceinline__ int lds_byte(int r, int c) { const int st = (r >> 4) * 2 + (c >> 5), rr = r & 15, cc = c & 31, ob = rr * 64 + cc * 2; return st * 1024 + (ob ^ (((ob >> 9) & 1) << 5)); }
__host__ __device__ __forceinline__ void stage_rc(int b, int& R, int& C) { const int st = b / 1024, sb = b % 1024, swz = sb ^ (((sb >> 9) & 1) << 5); R = (st >> 1) * 16 + swz / 64; C = (st & 1) * 32 + (swz % 64) / 2; }
__host__ __device__ __forceinline__ int perm32(int rho) { const int n = rho >> 4, i = rho & 15; return 8 * (i >> 2) + 4 * n + (i & 3); }

struct Unit { int pm, pn, e; };
struct Gemm { const bf16_t* A; const bf16_t* Bt; int M, N, K; };

struct StaticOrder {
    int nM, nN, nwg, G, c;
    __host__ __device__ void init(int M, int N, int G_, int c_) { nM = M / BM; nN = N / BM; nwg = nM * nN; G = G_; c = c_; }
    __host__ __device__ bool next(int i, Unit& u) const { return at((long)i * G + c, u); }
    __host__ __device__ bool at(long L, Unit& u) const {
        if (L >= nwg) return false;
        int wgid = (int)L; { const int q = nwg / NXCD, r = nwg % NXCD, xcd = wgid % NXCD, off = wgid / NXCD; wgid = (xcd < r ? xcd * (q + 1) : r * (q + 1) + (xcd - r) * q) + off; }
        const int nig = WGM * nN, gid = wgid / nig, fm = gid * WGM, gsz = (nM - fm) < WGM ? (nM - fm) : WGM;
        u.pm = fm + ((wgid % nig) % gsz); u.pn = (wgid % nig) / gsz; u.e = 0; return true;
    }
    __device__ __forceinline__ const char* abase(const Gemm& g, const Unit& u, size_t tstep) const { return (const char*)g.A + (size_t)u.pm * tstep; }
    __device__ __forceinline__ const char* bbase(const Gemm& g, const Unit& u, size_t tstep) const { return (const char*)g.Bt + (size_t)u.pn * tstep; }
    __device__ __forceinline__ void a_ready(const Unit&) const {}
    __device__ __forceinline__ void done(const Unit&) const {}
};

__device__ __forceinline__ unsigned cvt_pk_bf16(float lo, float hi) { unsigned r; asm volatile("v_cvt_pk_bf16_f32 %0, %1, %2" : "=v"(r) : "v"(lo), "v"(hi)); return r; }

typedef int v4i_t __attribute__((ext_vector_type(4))); typedef int v8i_t __attribute__((ext_vector_type(8)));
template <bool FP8> struct Frag { bf16x8 v[2]; };
template <> struct Frag<true> { v8i_t v; };
__device__ __forceinline__ void ld_frag(Frag<false>& f, const PG8_LAS unsigned char* p0) { f.v[0] = *(const PG8_LAS bf16x8*)(p0); f.v[1] = *(const PG8_LAS bf16x8*)(p0 + 1024); }
__device__ __forceinline__ void ld_frag(Frag<true>& f, const PG8_LAS unsigned char* p0) { const v4i_t lo = *(const PG8_LAS v4i_t*)(p0), hi = *(const PG8_LAS v4i_t*)(p0 + 1024); f.v = (v8i_t){lo.x, lo.y, lo.z, lo.w, hi.x, hi.y, hi.z, hi.w}; }
__device__ __forceinline__ f32x4 mma_frag(const Frag<false>& b, const Frag<false>& a, f32x4 c) { c = __builtin_amdgcn_mfma_f32_16x16x32_bf16(b.v[0], a.v[0], c, 0, 0, 0); return __builtin_amdgcn_mfma_f32_16x16x32_bf16(b.v[1], a.v[1], c, 0, 0, 0); }
__device__ __forceinline__ f32x4 mma_frag(const Frag<true>& b, const Frag<true>& a, f32x4 c) {
    const int sw = 0x7A7A7A7A, sa = 0x7F7F7F7F;
    asm volatile("v_mfma_scale_f32_16x16x128_f8f6f4 %0, %1, %2, %0, %3, %4 op_sel_hi:[0,0,0]" : "+v"(c) : "v"(b.v), "v"(a.v), "v"(sw), "v"(sa));
    return c;
}

template <class Epi, class Sched, bool ALIGN_EPI = false, bool SP2 = false, bool FP8 = false>
__device__ __forceinline__ void gemm_phase(PG8_LAS unsigned char* lds, const Gemm g, const Sched& S, const Epi& E) {
    const int tid = threadIdx.x, wid = __builtin_amdgcn_readfirstlane(tid >> 6), lane = tid & 63, wr = wid >> 2, wc = wid & 3, fr = lane & 15, fq = lane >> 4;
    const int K = g.K, nt = K / BK;
    unsigned voffA[2], voffB[2];
#pragma unroll
    for (int i = 0; i < 2; ++i) { int R, C; stage_rc(tid * 16 + i * 8192, R, C); const int Rb = Epi::PERM ? ((R & ~31) + perm32(R & 31)) : R;
        voffA[i] = (unsigned)(R * K + C) * 2u; voffB[i] = (unsigned)(Rb * K + C) * 2u; }
    const size_t kstep = (size_t)(BK * 2);
    const size_t hstep = (size_t)HALF * K * 2;
    const size_t tstep = 2 * hstep;
    const unsigned ldsw = (unsigned)wid * 1024u;
    const int aoff = lds_byte(wr * 64 + fr, fq * 8), boff = lds_byte(wc * 32 + fr, fq * 8);
#define PG8_SA(b, h) (((b) * 2 + (h)) * HTB)
#define PG8_SB(b, h) ((4 + (b) * 2 + (h)) * HTB)
#define PG8_STAGE(bufoff, gbase, voff) do { _Pragma("unroll") for (int _i = 0; _i < 2; ++_i) \
        __builtin_amdgcn_global_load_lds((const unsigned*)((const char*)(gbase) + (voff)[_i]), (PG8_LAS unsigned*)(lds + (bufoff) + ldsw + _i * 8192), 16, 0, 0); } while (0)
#define PG8_LDA(dst, b, h) do { _Pragma("unroll") for (int m = 0; m < 4; ++m) ld_frag(dst[m], lds + PG8_SA(b, h) + aoff + m * 2048); } while (0)
#define PG8_LDB(dst, b, h) do { _Pragma("unroll") for (int n = 0; n < 2; ++n) ld_frag(dst[n], lds + PG8_SB(b, h) + boff + n * 2048); } while (0)
#define PG8_MMA(ai, bj, At, Bt) do { __builtin_amdgcn_s_setprio(1); _Pragma("unroll") for (int m = 0; m < 4; ++m) _Pragma("unroll") for (int n = 0; n < 2; ++n) \
        acc[ai][bj][m][n] = mma_frag(Bt[n], At[m], acc[ai][bj][m][n]); __builtin_amdgcn_s_setprio(0); } while (0)
#define PG8_WAIT_V(n) asm volatile("s_waitcnt vmcnt(" #n ")" ::: "memory")
#define PG8_WAIT_L(n) asm volatile("s_waitcnt lgkmcnt(" #n ")" ::: "memory")
#define PG8_BAR __builtin_amdgcn_s_barrier()
#define PG8_SCHED __builtin_amdgcn_sched_barrier(0)
    Unit cur, nxt; int ui = 0;
    if (!S.next(0, cur)) return;
    f32x4 acc[2][2][4][2];
#pragma unroll
    for (int a = 0; a < 2; ++a)
#pragma unroll
        for (int b = 0; b < 2; ++b)
#pragma unroll
            for (int m = 0; m < 4; ++m)
#pragma unroll
                for (int n = 0; n < 2; ++n) acc[a][b][m][n] = (f32x4){0.f, 0.f, 0.f, 0.f};
    Frag<FP8> At[4], B0[2], B1[2];
    const char* cA = S.abase(g, cur, tstep); const char* cB = S.bbase(g, cur, tstep);
    S.a_ready(cur);
    if constexpr (SP2) {
        PG8_STAGE(PG8_SB(0, 0), cB, voffB); PG8_STAGE(PG8_SB(0, 1), cB + hstep, voffB); PG8_STAGE(PG8_SA(0, 0), cA, voffA); PG8_STAGE(PG8_SA(0, 1), cA + hstep, voffA);
        if (wr == 1) PG8_BAR;
        PG8_WAIT_V(2); PG8_BAR;
        PG8_STAGE(PG8_SB(1, 0), cB + kstep, voffB); PG8_STAGE(PG8_SA(1, 0), cA + kstep, voffA); PG8_STAGE(PG8_SB(1, 1), cB + hstep + kstep, voffB);
        PG8_WAIT_V(6); PG8_BAR;
    } else {
        PG8_STAGE(PG8_SB(0, 0), cB, voffB); PG8_STAGE(PG8_SA(0, 0), cA, voffA); PG8_STAGE(PG8_SB(0, 1), cB + hstep, voffB); PG8_STAGE(PG8_SA(0, 1), cA + hstep, voffA);
        if (wr == 1) PG8_BAR;
        PG8_WAIT_V(4); PG8_BAR;
        PG8_STAGE(PG8_SB(1, 0), cB + kstep, voffB); PG8_STAGE(PG8_SA(1, 0), cA + kstep, voffA); PG8_STAGE(PG8_SB(1, 1), cB + hstep + kstep, voffB);
        PG8_WAIT_V(6); PG8_BAR;
    }
    for (;;) {
        const bool has_next = S.next(ui + 1, nxt);
        const char* nA = has_next ? S.abase(g, nxt, tstep) : cA; const char* nB = has_next ? S.bbase(g, nxt, tstep) : cB;
        _Pragma("unroll 1") for (int t = 0; t < nt; t += 2) {
            const bool last = (t == nt - 2);
            const char* a1 = cA + (size_t)(t + 1) * kstep;
            const char* a2 = last ? nA : cA + (size_t)(t + 2) * kstep; const char* b2 = last ? nB : cB + (size_t)(t + 2) * kstep;
            const char* a3 = a2 + kstep; const char* b3 = b2 + kstep;
            if (last && has_next) S.a_ready(nxt);
            if constexpr (SP2) {
            PG8_LDB(B0, 0, 0); PG8_LDB(B1, 0, 1); PG8_SCHED; PG8_LDA(At, 0, 0); PG8_STAGE(PG8_SA(1, 1), a1 + hstep, voffA);
            PG8_WAIT_V(8); PG8_WAIT_L(0); PG8_BAR; PG8_MMA(0, 0, At, B0); PG8_MMA(0, 1, At, B1); PG8_BAR; PG8_SCHED;
            PG8_LDA(At, 0, 1); PG8_STAGE(PG8_SB(0, 0), b2, voffB); PG8_STAGE(PG8_SB(0, 1), b2 + hstep, voffB); PG8_STAGE(PG8_SA(0, 0), a2, voffA);
            PG8_WAIT_V(8); PG8_WAIT_L(0); PG8_BAR; PG8_MMA(1, 0, At, B0); PG8_MMA(1, 1, At, B1); PG8_BAR; PG8_SCHED;
            PG8_LDB(B0, 1, 0); PG8_LDB(B1, 1, 1); PG8_SCHED; PG8_LDA(At, 1, 0); PG8_STAGE(PG8_SA(0, 1), a2 + hstep, voffA);
            PG8_WAIT_V(8); PG8_WAIT_L(0); PG8_BAR; PG8_MMA(0, 0, At, B0); PG8_MMA(0, 1, At, B1); PG8_BAR; PG8_SCHED;
            PG8_LDA(At, 1, 1); PG8_STAGE(PG8_SB(1, 0), b3, voffB); PG8_STAGE(PG8_SB(1, 1), b3 + hstep, voffB); PG8_STAGE(PG8_SA(1, 0), a3, voffA);
            PG8_WAIT_V(8); PG8_WAIT_L(0); PG8_BAR; PG8_MMA(1, 0, At, B0); PG8_MMA(1, 1, At, B1); PG8_BAR; PG8_SCHED;
            } else {
            PG8_LDB(B0, 0, 0); PG8_SCHED; PG8_LDA(At, 0, 0); PG8_STAGE(PG8_SA(1, 1), a1 + hstep, voffA);
            PG8_WAIT_L(8); PG8_BAR; PG8_WAIT_L(0); PG8_MMA(0, 0, At, B0); PG8_BAR; PG8_SCHED;
            PG8_LDB(B1, 0, 1); PG8_STAGE(PG8_SB(0, 0), b2, voffB);
            PG8_BAR; PG8_WAIT_L(0); PG8_MMA(0, 1, At, B1); PG8_BAR;
            PG8_LDA(At, 0, 1); PG8_STAGE(PG8_SA(0, 0), a2, voffA);
            PG8_BAR; PG8_WAIT_L(0); PG8_MMA(1, 0, At, B0); PG8_BAR; PG8_SCHED;
            PG8_STAGE(PG8_SB(0, 1), b2 + hstep, voffB);
            PG8_WAIT_V(6); PG8_BAR; PG8_MMA(1, 1, At, B1); PG8_BAR;
            PG8_LDB(B0, 1, 0); PG8_SCHED; PG8_LDA(At, 1, 0); PG8_STAGE(PG8_SA(0, 1), a2 + hstep, voffA);
            PG8_WAIT_L(8); PG8_BAR; PG8_WAIT_L(0); PG8_MMA(0, 0, At, B0); PG8_BAR; PG8_SCHED;
            PG8_LDB(B1, 1, 1); PG8_STAGE(PG8_SB(1, 0), b3, voffB);
            PG8_BAR; PG8_WAIT_L(0); PG8_MMA(0, 1, At, B1); PG8_BAR;
            PG8_LDA(At, 1, 1); PG8_STAGE(PG8_SA(1, 0), a3, voffA);
            PG8_BAR; PG8_WAIT_L(0); PG8_MMA(1, 0, At, B0); PG8_BAR; PG8_SCHED;
            PG8_STAGE(PG8_SB(1, 1), b3 + hstep, voffB);
            PG8_WAIT_V(6); PG8_BAR; PG8_MMA(1, 1, At, B1); PG8_BAR;
            }
        }
        if constexpr (FP8) { asm volatile("s_nop 15\n\ts_nop 15" ::: "memory"); }
        if constexpr (ALIGN_EPI) { if (wr == 0) PG8_BAR; }
        if constexpr (!Epi::AFTER_DRAIN) { E(acc, cur, wr, wc, fr, fq); S.done(cur); }
        if (!has_next) break;
#pragma unroll
        for (int a = 0; a < 2; ++a)
#pragma unroll
            for (int b = 0; b < 2; ++b)
#pragma unroll
                for (int m = 0; m < 4; ++m)
#pragma unroll
                    for (int n = 0; n < 2; ++n) acc[a][b][m][n] = (f32x4){0.f, 0.f, 0.f, 0.f};
        cur = nxt; cA = nA; cB = nB; ++ui;
        if constexpr (ALIGN_EPI) { if (wr == 1) PG8_BAR; }
    }
    PG8_WAIT_V(0);
    if constexpr (!ALIGN_EPI) { if (wr == 0) PG8_BAR; }
    PG8_BAR;
    if constexpr (Epi::AFTER_DRAIN) { E.fused(acc, cur, wr, wc, fr, fq, lds, wid, lane); S.done(cur); }
#undef PG8_SA
#undef PG8_SB
#undef PG8_STAGE
#undef PG8_LDA
#undef PG8_LDB
#undef PG8_MMA
#undef PG8_WAIT_V
#undef PG8_WAIT_L
#undef PG8_BAR
#undef PG8_SCHED
}
}

constexpr int D = 1024, NBATCH = 2, SEQ = 8192, CTXL = 256;
constexpr int NLAT = NBATCH * SEQ, NCTX = NBATCH * CTXL, NROW = NLAT + NCTX;
constexpr int NE = 32, TOPK = 4, MAXTILES = 296, CAP = MAXTILES * 256;
constexpr int NWAVES = 8, NTHREADS = 512;
constexpr float NORM_EPS = 1e-6f;
constexpr int LDS_BYTES = 147456;

constexpr size_t MiB = 1u << 20;
constexpr size_t WS_CTL = 0, CTL_ZERO_BYTES = 1 * MiB;
constexpr size_t WS_MOD = 1 * MiB;
constexpr size_t WS_ROUTE = 2 * MiB;
constexpr size_t RT_TOPI = 0, RT_TOPG = 320 * 1024, RT_POS = 640 * 1024, RT_SLOT = 960 * 1024, RT_RSTD = 1280 * 1024, RT_TILEE = 1408 * 1024;
constexpr size_t WS_WIN = 4 * MiB, WS_WHGO = 14 * MiB, WS_WRKV = 16 * MiB, WS_WL1 = 22 * MiB, WS_WL2 = 24 * MiB, WS_WRWO = 28 * MiB;
constexpr size_t WS_WGU = 32 * MiB, WS_WD = 288 * MiB;
constexpr size_t WS_XR = 416 * MiB, WS_H = 482 * MiB, WS_H2 = 515 * MiB, WS_A2 = 548 * MiB;
constexpr size_t WS_U = 584 * MiB;
constexpr size_t U_Z = 0, U_OD0 = 166 * MiB;
constexpr size_t U_XL6 = 0, U_RKV = 198 * MiB, U_L1 = 396 * MiB, U_WD = 410 * MiB, U_AD = 542 * MiB, U_G = 674 * MiB, U_OD1 = 740 * MiB;
constexpr size_t U_XB = 0, U_ACT = 148 * MiB, U_YS = 296 * MiB;
constexpr size_t WS_END = WS_U + 1352 * MiB;
constexpr int CW_CNT = 16384, CNT_STRIDE = 64;
constexpr int CW_NT = 128;
constexpr int CW_TOF = 8192, TOF_PER = 72;
constexpr int CW_BAR = 4096;

#define LAS __attribute__((address_space(3)))
typedef unsigned short bf16;
typedef unsigned v4u __attribute__((ext_vector_type(4)));
typedef unsigned v2u __attribute__((ext_vector_type(2)));
typedef float f32x4 __attribute__((ext_vector_type(4)));
#define LDS_WAIT() asm volatile("s_waitcnt lgkmcnt(0)" ::: "memory")
typedef float f32x2c __attribute__((ext_vector_type(2))); typedef __bf16 bf16x2c __attribute__((ext_vector_type(2)));
__device__ __forceinline__ unsigned pk2(float lo, float hi) { const f32x2c v = {lo, hi}; const bf16x2c b = __builtin_convertvector(v, bf16x2c); return __builtin_bit_cast(unsigned, b); }
__device__ __forceinline__ unsigned f2bf(float f) { return pk2(f, 0.f) & 0xffffu; }
__device__ __forceinline__ unsigned pk4_fp8(float a, float b, float c, float d) { unsigned w = 0u; w = __builtin_amdgcn_cvt_pk_fp8_f32(a, b, w, false); return __builtin_amdgcn_cvt_pk_fp8_f32(c, d, w, true); }
__device__ __forceinline__ float bf2f(unsigned b) { return __builtin_bit_cast(float, b << 16); }
__device__ __forceinline__ float wave_sum(float x) {
    x += __builtin_bit_cast(float, __builtin_amdgcn_update_dpp(0, __builtin_bit_cast(int, x), 0x128, 0xf, 0xf, false));
    x += __builtin_bit_cast(float, __builtin_amdgcn_update_dpp(0, __builtin_bit_cast(int, x), 0x124, 0xf, 0xf, false));
    x += __builtin_bit_cast(float, __builtin_amdgcn_update_dpp(0, __builtin_bit_cast(int, x), 0x122, 0xf, 0xf, false));
    x += __builtin_bit_cast(float, __builtin_amdgcn_update_dpp(0, __builtin_bit_cast(int, x), 0x121, 0xf, 0xf, false));
    x += __builtin_bit_cast(float, __builtin_amdgcn_update_dpp(0, __builtin_bit_cast(int, x), 0x142, 0xa, 0xf, false));
    x += __builtin_bit_cast(float, __builtin_amdgcn_update_dpp(0, __builtin_bit_cast(int, x), 0x143, 0xc, 0xf, false));
    return __builtin_bit_cast(float, __builtin_amdgcn_readlane(__builtin_bit_cast(int, x), 63));
}
__device__ __forceinline__ float sigm(float x) { return __builtin_amdgcn_rcpf(1.0f + __expf(-x)); }

struct Params { const float* in[35]; float* out; unsigned char* ws; int ph_lo, ph_hi; };
typedef const __attribute__((address_space(4))) Params* PP;
enum { I_X = 0, I_C, I_CTX, I_CCTX, I_ADAW, I_ADAB, I_NMIX, I_NFFN, I_HGWIN, I_HGGN, I_HGWOUT, I_HGLB, I_MU, I_WRKV, I_DECW0, I_DECW1, I_DECW2,
       I_A0, I_A1, I_A2, I_G1, I_G2, I_KK, I_KA, I_RK, I_LNXW, I_LNXB, I_RWOUT, I_ROUTW, I_ROUTB, I_WGU, I_BGU, I_WDN, I_BDN, I_FINALG };

__device__ __forceinline__ const float* modp(PP p, int l, int v, int j) { return (const float*)(p->ws + WS_MOD) + ((size_t)(l * 3 + v) * 6 + j) * D; }
__device__ __forceinline__ int row_vec(int row) { return row < NLAT ? (row >= SEQ ? 1 : 0) : 2; }

__device__ __forceinline__ void ti_load(const float* src, int src_ld, int lane, float (&rg)[32]) {
    if (src) {
#pragma unroll
        for (int i = 0; i < 32; ++i) rg[i] = src[(size_t)(2 * i + (lane >> 5)) * src_ld + (lane & 31)];
    }
}
__device__ __forceinline__ void ti_store(bool nonzero, int fp8, const float (&rg)[32], unsigned char* dst, int dst_ldb, LAS float* scr, int lane) {
    if (nonzero) {
#pragma unroll
        for (int i = 0; i < 32; ++i) scr[(2 * i + (lane >> 5)) * 33 + (lane & 31)] = rg[i];
    }
    LDS_WAIT(); asm volatile("" ::: "memory");
    if (fp8) {
        const int n = lane >> 1, hk = (lane & 1) * 32; const LAS float* s = scr + hk * 33 + n; unsigned w[8];
#pragma unroll
        for (int q = 0; q < 8; ++q) w[q] = pk4_fp8(s[(4 * q) * 33] * 32.f, s[(4 * q + 1) * 33] * 32.f, s[(4 * q + 2) * 33] * 32.f, s[(4 * q + 3) * 33] * 32.f);
        v4u* d = (v4u*)(dst + (size_t)n * dst_ldb + hk); d[0] = (v4u){w[0], w[1], w[2], w[3]}; d[1] = (v4u){w[4], w[5], w[6], w[7]};
    } else {
        const int c = lane & 7;
#pragma unroll
        for (int j = 0; j < 4; ++j) {
            const int n = (lane >> 3) + 8 * j; v4u o = (v4u){0u, 0u, 0u, 0u};
            if (nonzero) { const LAS float* s = scr + (8 * c) * 33 + n;
                o.x = pk2(s[0 * 33], s[1 * 33]); o.y = pk2(s[2 * 33], s[3 * 33]); o.z = pk2(s[4 * 33], s[5 * 33]); o.w = pk2(s[6 * 33], s[7 * 33]); }
            *(v4u*)(dst + (size_t)n * dst_ldb + 16 * c) = o;
        }
    }
    LDS_WAIT(); asm volatile("" ::: "memory");
}
__device__ __forceinline__ void ti_load4(const float* src, int src_ld, int lane, f32x4 (&rg)[8]) {
#pragma unroll
    for (int i = 0; i < 8; ++i) rg[i] = *(const f32x4*)(src + (size_t)(8 * i + (lane >> 3)) * src_ld + 4 * (lane & 7));
}
__device__ __forceinline__ void ti_store4_fp8(const f32x4 (&rg)[8], unsigned char* dst, int dst_ldb, LAS float* scr, int lane) {
#pragma unroll
    for (int i = 0; i < 8; ++i) *(LAS f32x4*)(scr + (8 * i + (lane >> 3)) * 36 + 4 * (lane & 7)) = rg[i];
    LDS_WAIT(); asm volatile("" ::: "memory");
    const int n = lane >> 1, hk = (lane & 1) * 32; const LAS float* s = scr + hk * 36 + n; unsigned w[8];
#pragma unroll
    for (int q = 0; q < 8; ++q) w[q] = pk4_fp8(s[(4 * q) * 36] * 32.f, s[(4 * q + 1) * 36] * 32.f, s[(4 * q + 2) * 36] * 32.f, s[(4 * q + 3) * 36] * 32.f);
    v4u* d = (v4u*)(dst + (size_t)n * dst_ldb + hk); d[0] = (v4u){w[0], w[1], w[2], w[3]}; d[1] = (v4u){w[4], w[5], w[6], w[7]};
    LDS_WAIT(); asm volatile("" ::: "memory");
}
struct ConvJob { const float* src; int src_ld; unsigned char* dst; int dst_ldb; int fp8; };
__device__ __forceinline__ ConvJob job_plain(const float* W, int K, int N, bf16* WT, int r) {
    const int nblk = N / 32, kb = r / nblk, nb = r % nblk;
    return ConvJob{W + (size_t)(kb * 64) * N + nb * 32, N, (unsigned char*)(WT + (size_t)(nb * 32) * K + kb * 64), K * 2, 0};
}
constexpr int IT_WIN = 16 * 160, IT_SQ = 16 * 32, IT_L1 = 16 * 24, IT_L2 = 160 * 6, IT_GU = 64 * 16 * 64, IT_DN = 64 * 16 * 32;
constexpr int IT_GU0 = IT_GU / 2, IT_DN0 = IT_DN / 2;
constexpr int IT_TOTAL = IT_WIN + IT_SQ + 3 * IT_SQ + IT_SQ + IT_L1 + IT_L2 + IT_GU0 + IT_DN0, IT_L1MOE = IT_GU0 + IT_DN0;
__device__ __forceinline__ ConvJob conv_job(PP p, int it) {
    unsigned char* ws = p->ws; int r = it;
    if (r < IT_WIN) { const int kb = r / 160, nb = r % 160;
        return ConvJob{p->in[I_HGWIN] + (size_t)(kb * 64) * 5120 + nb * 32, 5120, ws + WS_WIN + (size_t)(nb * 32) * D + kb * 64, D, 1}; } r -= IT_WIN;
    if (r < IT_SQ) return job_plain(p->in[I_HGWOUT], D, D, (bf16*)(ws + WS_WHGO), r); r -= IT_SQ;
    if (r < 3 * IT_SQ) { const int j = r / IT_SQ; return job_plain(p->in[I_WRKV] + (size_t)j * D * D, D, D, (bf16*)(ws + WS_WRKV) + (size_t)j * D * D, r % IT_SQ); } r -= 3 * IT_SQ;
    if (r < IT_SQ) return job_plain(p->in[I_RWOUT], D, D, (bf16*)(ws + WS_WRWO), r); r -= IT_SQ;
    if (r < IT_L1) {
        const int kb = r / 24, rg = r % 24, tile = rg >> 3, within = rg & 7; const float* src = nullptr; int ld = 64;
        if (within < 4) {
            if (tile == 0) src = p->in[I_DECW1] + (size_t)(within >> 1) * D * 64 + (size_t)(kb * 64) * 64 + (within & 1) * 32;
            else if (tile == 1) src = p->in[I_A1] + (size_t)(within >> 1) * D * 64 + (size_t)(kb * 64) * 64 + (within & 1) * 32;
            else { src = p->in[I_G1] + (size_t)(kb * 64) * 128 + within * 32; ld = 128; }
        }
        return ConvJob{src, ld, (unsigned char*)((bf16*)(ws + WS_WL1) + (size_t)(rg * 32) * D + kb * 64), D * 2, 0}; } r -= IT_L1;
    if (r < IT_L2) {
        const int rg = r / 6, kb = r % 6, n0 = rg * 32, blk = n0 >> 10, nn0 = n0 & 1023; const float* src = nullptr;
        if (blk < 2) { if (kb == blk) src = p->in[I_DECW2] + (size_t)blk * 64 * D + nn0; }
        else if (blk < 4) { if (kb == blk) src = p->in[I_A2] + (size_t)(blk - 2) * 64 * D + nn0; }
        else { if (kb >= 4) src = p->in[I_G2] + (size_t)(kb - 4) * 64 * D + nn0; }
        return ConvJob{src, D, (unsigned char*)((bf16*)(ws + WS_WL2) + (size_t)n0 * 384 + kb * 64), 384 * 2, 0}; } r -= IT_L2;
    if (r < IT_GU0) {
        const int mat = r >> 10, q = r & 1023, kb = q >> 6, nb = q & 63, n0 = nb * 32;
        const int j0 = n0 & 1023, drow = 256 * (j0 >> 7) + (n0 >= 1024 ? 128 : 0) + (j0 & 127);
        return ConvJob{p->in[I_WGU] + (size_t)mat * D * 2048 + (size_t)(kb * 64) * 2048 + n0, 2048, ws + WS_WGU + (size_t)mat * 2048 * D + (size_t)drow * D + kb * 64, D, 1}; } r -= IT_GU0;
    { const int mat = r >> 9, q = r & 511, kb = q >> 5, nb = q & 31;
      return ConvJob{p->in[I_WDN] + (size_t)mat * D * D + (size_t)(kb * 64) * D + nb * 32, D, ws + WS_WD + (size_t)mat * D * D + (size_t)(nb * 32) * D + kb * 64, D, 1}; }
}
__device__ __forceinline__ ConvJob conv_job_l1(PP p, int r) {
    unsigned char* ws = p->ws;
    if (r < IT_GU0) { const int mat = 32 + (r >> 10), q = r & 1023, kb = q >> 6, nb = q & 63, n0 = nb * 32;
        const int j0 = n0 & 1023, drow = 256 * (j0 >> 7) + (n0 >= 1024 ? 128 : 0) + (j0 & 127);
        return ConvJob{p->in[I_WGU] + (size_t)mat * D * 2048 + (size_t)(kb * 64) * 2048 + n0, 2048, ws + WS_WGU + (size_t)mat * 2048 * D + (size_t)drow * D + kb * 64, D, 1}; }
    r -= IT_GU0;
    { const int mat = 32 + (r >> 9), q = r & 511, kb = q >> 5, nb = q & 31;
      return ConvJob{p->in[I_WDN] + (size_t)mat * D * D + (size_t)(kb * 64) * D + nb * 32, D, ws + WS_WD + (size_t)mat * D * D + (size_t)(nb * 32) * D + kb * 64, D, 1}; }
}
__device__ __forceinline__ void phase_pre(PP p, LAS unsigned char* lds, int tid, int lane, int wave) {
    if (blockIdx.x < 192) {
        const int layer = blockIdx.x / 96, col = (blockIdx.x % 96) * 64 + lane;
        const float* W = p->in[I_ADAW] + (size_t)layer * D * 6144 + col;
        const float* c = p->in[I_C]; const float* cc = p->in[I_CCTX];
        float a0 = 0.f, a1 = 0.f, a2 = 0.f;
#pragma unroll 8
        for (int k = wave * 128; k < wave * 128 + 128; ++k) {
            const float wv = W[(size_t)k * 6144]; const float c0 = c[k], c1 = c[D + k], c2 = cc[k];
            a0 += c0 * sigm(c0) * wv; a1 += c1 * sigm(c1) * wv; a2 += c2 * sigm(c2) * wv;
        }
        LAS float* red = (LAS float*)lds;
        red[(wave * 3 + 0) * 64 + lane] = a0; red[(wave * 3 + 1) * 64 + lane] = a1; red[(wave * 3 + 2) * 64 + lane] = a2;
        __syncthreads();
        if (wave == 0) {
            float s0 = 0.f, s1 = 0.f, s2 = 0.f;
#pragma unroll
            for (int w = 0; w < 8; ++w) { s0 += red[(w * 3 + 0) * 64 + lane]; s1 += red[(w * 3 + 1) * 64 + lane]; s2 += red[(w * 3 + 2) * 64 + lane]; }
            const float bb = p->in[I_ADAB][layer * 6144 + col];
            float* M = (float*)(p->ws + WS_MOD) + (size_t)layer * 3 * 6144 + col;
            M[0] = s0 + bb; M[6144] = s1 + bb; M[2 * 6144] = s2 + bb;
        }
        __syncthreads();
    }
    LAS float* scr = (LAS float*)(lds + wave * 16384);
    const int gw = blockIdx.x * NWAVES + wave, NGW = gridDim.x * NWAVES;
    ConvJob nj{}; float nrg[32];
    if (gw < IT_TOTAL) { nj = conv_job(p, gw); ti_load(nj.src, nj.src_ld, lane, nrg); }
    for (int it = gw; it < IT_TOTAL; it += NGW) {
        const ConvJob cj = nj; float crg[32];
#pragma unroll
        for (int i = 0; i < 32; ++i) crg[i] = nrg[i];
        if (it + NGW < IT_TOTAL) { nj = conv_job(p, it + NGW); ti_load(nj.src, nj.src_ld, lane, nrg); }
        ti_store(cj.src != nullptr, cj.fp8, crg, cj.dst, cj.dst_ldb, scr, lane);
    }
}

__device__ __forceinline__ void load_row(const float* row, int lane, f32x4 (&v)[4]) {
#pragma unroll
    for (int j = 0; j < 4; ++j) v[j] = ((const f32x4*)row)[lane + 64 * j];
}
__device__ __forceinline__ float row_rstd(const f32x4 (&v)[4]) {
    float s = 0.f;
#pragma unroll
    for (int j = 0; j < 4; ++j) s += (v[j].x * v[j].x + v[j].y * v[j].y) + (v[j].z * v[j].z + v[j].w * v[j].w);
    return rsqrtf(wave_sum(s) * (1.0f / D) + NORM_EPS);
}
__device__ __forceinline__ void norm_mod(const f32x4 (&v)[4], float rstd, const float* g, const float* shift, const float* scale, int lane, f32x4 (&h)[4]) {
#pragma unroll
    for (int j = 0; j < 4; ++j) {
        const f32x4 gg = ((const f32x4*)g)[lane + 64 * j], sh = ((const f32x4*)shift)[lane + 64 * j], sc = ((const f32x4*)scale)[lane + 64 * j];
        h[j] = v[j] * rstd * gg * (sc + 1.0f) + sh;
    }
}
__device__ __forceinline__ void store_row_bf16(bf16* row, int lane, const f32x4 (&h)[4]) {
#pragma unroll
    for (int j = 0; j < 4; ++j) { v2u w; w.x = pk2(h[j].x, h[j].y); w.y = pk2(h[j].z, h[j].w); ((v2u*)row)[lane + 64 * j] = w; }
}
__device__ __forceinline__ const float* resid_row(PP p, int layer0_inputs, int row) {
    if (layer0_inputs) return row < NLAT ? p->in[I_X] + (size_t)row * D : p->in[I_CTX] + (size_t)(row - NLAT) * D;
    return (const float*)(p->ws + WS_XR) + (size_t)row * D;
}
__device__ __forceinline__ void phase_norm0(PP p, int lane, int wave) {
    const int gw = blockIdx.x * NWAVES + wave, NGW = gridDim.x * NWAVES;
    f32x4 vn[4];
    if (gw < NROW) load_row(resid_row(p, 1, gw), lane, vn);
    for (int row = gw; row < NROW; row += NGW) {
        f32x4 v[4], h[4];
#pragma unroll
        for (int j = 0; j < 4; ++j) v[j] = vn[j];
        if (row + NGW < NROW) load_row(resid_row(p, 1, row + NGW), lane, vn);
        const float rstd = row_rstd(v); const int vec = row_vec(row);
        norm_mod(v, rstd, p->in[I_NMIX], modp(p, 0, vec, 0), modp(p, 0, vec, 1), lane, h);
        { unsigned* hp = (unsigned*)(p->ws + WS_H + (size_t)row * D);
#pragma unroll
          for (int j = 0; j < 4; ++j) hp[lane + 64 * j] = pk4_fp8(h[j].x, h[j].y, h[j].z, h[j].w); }
    }
}
__device__ __forceinline__ void route_select(float (&part)[NE], const float* rb, int row, float* TOPG, int* SLOT, unsigned* cnt, unsigned* ntl, unsigned* tof, int* TILEE, int lane, bool write, int (&slot)[TOPK]) {
#pragma unroll
    for (int e = 0; e < NE; ++e) part[e] = part[e] + rb[e];
    unsigned taken = 0u; int idx[TOPK]; float val[TOPK];
#pragma unroll
    for (int k = 0; k < TOPK; ++k) {
        float best = -3.0e38f; int bi = 0;
#pragma unroll
        for (int e = 0; e < NE; ++e) { const bool ok = !((taken >> e) & 1u) && (part[e] > best); best = ok ? part[e] : best; bi = ok ? e : bi; }
        taken |= 1u << bi; idx[k] = bi; val[k] = best;
    }
    float ex[TOPK], se = 0.f;
#pragma unroll
    for (int k = 0; k < TOPK; ++k) { ex[k] = __expf(val[k] - val[0]); se += ex[k]; }
    int sl[TOPK] = {0, 0, 0, 0};
    if (lane == 0 && write) {
        unsigned pos[TOPK]; int til[TOPK];
#pragma unroll
        for (int k = 0; k < TOPK; ++k) pos[k] = atomicAdd(cnt + idx[k] * CNT_STRIDE, 1u);
#pragma unroll
        for (int k = 0; k < TOPK; ++k) { til[k] = -1;
            if ((pos[k] & 255u) == 0u) { const unsigned t = atomicAdd(ntl, 1u); til[k] = (int)t; TILEE[1 + t] = idx[k];
                __hip_atomic_store(tof + idx[k] * TOF_PER + (pos[k] >> 8), t + 1u, __ATOMIC_RELAXED, __HIP_MEMORY_SCOPE_AGENT); } }
        unsigned tq[TOPK];
#pragma unroll
        for (int k = 0; k < TOPK; ++k) tq[k] = (til[k] < 0) ? __hip_atomic_load(tof + idx[k] * TOF_PER + (pos[k] >> 8), __ATOMIC_RELAXED, __HIP_MEMORY_SCOPE_AGENT) : 1u;
#pragma unroll
        for (int k = 0; k < TOPK; ++k) {
            if (til[k] < 0) { unsigned t1 = tq[k], spins = 0u;
                while (t1 == 0u && ++spins < (1u << 22)) { __builtin_amdgcn_s_sleep(1); t1 = __hip_atomic_load(tof + idx[k] * TOF_PER + (pos[k] >> 8), __ATOMIC_RELAXED, __HIP_MEMORY_SCOPE_AGENT); }
                til[k] = (int)t1 - 1; if (til[k] < 0) til[k] = 0; }
            sl[k] = til[k] * 256 + (int)(pos[k] & 255u);
            SLOT[row * 4 + k] = sl[k]; TOPG[row * 4 + k] = ex[k] * __builtin_amdgcn_rcpf(se);
        }
    }
#pragma unroll
    for (int k = 0; k < TOPK; ++k) slot[k] = __builtin_amdgcn_readfirstlane(sl[k]);
}
__device__ __forceinline__ void phase_ffn_norm_route4(PP p, int layer, int nrows, LAS unsigned char* lds, int tid, int lane, int wave) {
    const int gw = blockIdx.x * NWAVES + wave, NGW = gridDim.x * NWAVES;
    const float* rw = p->in[I_ROUTW] + (size_t)layer * D * NE; const float* rb = p->in[I_ROUTB] + layer * NE;
    float* TOPG = (float*)(p->ws + WS_ROUTE + RT_TOPG); int* SLOT = (int*)(p->ws + WS_ROUTE + RT_SLOT); int* TILEE = (int*)(p->ws + WS_ROUTE + RT_TILEE) + layer * 512;
    unsigned* ctl = (unsigned*)(p->ws + WS_CTL); unsigned* cnt = ctl + CW_CNT + layer * NE * CNT_STRIDE; unsigned* ntl = ctl + CW_NT + layer; unsigned* tof = ctl + CW_TOF + layer * NE * TOF_PER;
    unsigned char* XB = p->ws + WS_U + U_XB;
    constexpr int MAXR = 72;
    LAS unsigned* FP8I = (LAS unsigned*)(lds + 69632);
    LAS int* ROWE = (LAS int*)(lds + 143360); LAS int* ROWP = ROWE + MAXR * 4; LAS float* ROWG = (LAS float*)(ROWP + MAXR * 4);
    LAS unsigned* HIST = (LAS unsigned*)(ROWG + MAXR * 4); LAS unsigned* BASE = HIST + 32;
    if (tid < 32) HIST[tid] = 0u;
    __syncthreads();
    int nloc = 0;
    LAS float* hs = (LAS float*)(lds + wave * 8704);
    for (int row0 = gw; row0 < nrows; row0 += 2 * NGW) {
        const bool has1 = row0 + NGW < nrows; const int row1 = has1 ? row0 + NGW : row0;
#pragma unroll
        for (int r = 0; r < 2; ++r) { const int row = r ? row1 : row0;
            f32x4 v[4], h[4]; load_row((const float*)(p->ws + WS_XR) + (size_t)row * D, lane, v); const float rstd = row_rstd(v); const int vec = row_vec(row);
            norm_mod(v, rstd, p->in[I_NFFN] + layer * D, modp(p, layer, vec, 3), modp(p, layer, vec, 4), lane, h);
#pragma unroll
            for (int j = 0; j < 4; ++j)
#pragma unroll
                for (int i = 0; i < 4; ++i) hs[r * 1024 + (4 * j + i) * 64 + lane] = h[j][i]; }
        LDS_WAIT(); asm volatile("" ::: "memory");
        float pa[NE], pb[NE];
        {
            const int e4 = lane & 7, kq = lane >> 3;
            f32x4 qa = (f32x4){0.f, 0.f, 0.f, 0.f}, qb = (f32x4){0.f, 0.f, 0.f, 0.f};
#pragma unroll 4
            for (int t = 0; t < 32; ++t) {
                const int u = kq + 8 * t, l = u & 63, j = u >> 6;
                const f32x4* wr = (const f32x4*)(rw + (size_t)(4 * u) * NE) + e4;
#pragma unroll
                for (int i = 0; i < 4; ++i) { const f32x4 w4 = wr[i * (NE / 4)]; const float x0 = hs[(4 * j + i) * 64 + l], x1 = hs[1024 + (4 * j + i) * 64 + l];
                    qa = qa + x0 * w4; qb = qb + x1 * w4; }
            }
#pragma unroll
            for (int o = 8; o < 64; o <<= 1) {
#pragma unroll
                for (int c = 0; c < 4; ++c) { qa[c] += __shfl_xor(qa[c], o); qb[c] += __shfl_xor(qb[c], o); } }
            LAS float* lg = hs + 2048;
            if (kq == 0) { *(LAS f32x4*)(lg + 4 * e4) = qa; *(LAS f32x4*)(lg + 32 + 4 * e4) = qb; }
            LDS_WAIT(); asm volatile("" ::: "memory");
#pragma unroll
            for (int q4 = 0; q4 < 8; ++q4) { const f32x4 va = *(const LAS f32x4*)(lg + 4 * q4), vb = *(const LAS f32x4*)(lg + 32 + 4 * q4);
#pragma unroll
                for (int c = 0; c < 4; ++c) { pa[4 * q4 + c] = va[c]; pb[4 * q4 + c] = vb[c]; } }
        }
#pragma unroll
        for (int r = 0; r < 2; ++r) { if (r == 1 && !has1) break;
            float part[NE];
#pragma unroll
            for (int e = 0; e < NE; ++e) part[e] = (r ? pb[e] : pa[e]) + rb[e];
            unsigned taken = 0u; int idx[TOPK]; float val[TOPK];
#pragma unroll
            for (int k = 0; k < TOPK; ++k) {
                float best = -3.0e38f; int bi = 0;
#pragma unroll
                for (int e = 0; e < NE; ++e) { const bool ok = !((taken >> e) & 1u) && (part[e] > best); best = ok ? part[e] : best; bi = ok ? e : bi; }
                taken |= 1u << bi; idx[k] = bi; val[k] = best;
            }
            float ex[TOPK], se = 0.f;
#pragma unroll
            for (int k = 0; k < TOPK; ++k) { ex[k] = __expf(val[k] - val[0]); se += ex[k]; }
            const int rs = wave * 9 + nloc + r;
            if (lane == 0) {
#pragma unroll
                for (int k = 0; k < TOPK; ++k) { ROWE[rs * 4 + k] = idx[k]; ROWP[rs * 4 + k] = (int)__hip_atomic_fetch_add(HIST + idx[k], 1u, __ATOMIC_RELAXED, __HIP_MEMORY_SCOPE_WORKGROUP); ROWG[rs * 4 + k] = ex[k] * __builtin_amdgcn_rcpf(se); } }
#pragma unroll
            for (int j = 0; j < 4; ++j) { const LAS float* hp = hs + r * 1024 + (4 * j) * 64 + lane; FP8I[rs * 256 + lane + 64 * j] = pk4_fp8(hp[0], hp[64], hp[128], hp[192]); }
        }
        nloc += has1 ? 2 : 1;
        LDS_WAIT(); asm volatile("" ::: "memory");
    }
    __syncthreads();
    if (tid < 32) { const unsigned n = HIST[tid]; unsigned base = 0u;
        if (n) { base = atomicAdd(cnt + tid * CNT_STRIDE, n);
            for (unsigned pb2 = (base + 255u) & ~255u; pb2 < base + n; pb2 += 256u) { const unsigned t = atomicAdd(ntl, 1u); TILEE[1 + t] = tid;
                __hip_atomic_store(tof + tid * TOF_PER + (pb2 >> 8), t + 1u, __ATOMIC_RELAXED, __HIP_MEMORY_SCOPE_AGENT); } }
        BASE[tid] = base; }
    __syncthreads();
    int slv = 0;
    if (lane < 4 * nloc) { const int rs = wave * 9 + (lane >> 2), k = lane & 3, li = lane >> 2;
        const int row = gw + li * NGW;
        const int e = ROWE[rs * 4 + k]; const unsigned pos = BASE[e] + (unsigned)ROWP[rs * 4 + k]; unsigned t1 = 0u, spins = 0u;
        while ((t1 = __hip_atomic_load(tof + e * TOF_PER + (pos >> 8), __ATOMIC_RELAXED, __HIP_MEMORY_SCOPE_AGENT)) == 0u && ++spins < (1u << 22)) __builtin_amdgcn_s_sleep(1);
        int til = (int)t1 - 1; if (til < 0) til = 0;
        slv = til * 256 + (int)(pos & 255u); SLOT[row * 4 + k] = slv; TOPG[row * 4 + k] = ROWG[rs * 4 + k]; }
    for (int li = 0; li < nloc; ++li) { const int rs = wave * 9 + li; unsigned w[4];
#pragma unroll
        for (int j = 0; j < 4; ++j) w[j] = FP8I[rs * 256 + lane + 64 * j];
#pragma unroll
        for (int k = 0; k < TOPK; ++k) { unsigned* d = (unsigned*)(XB + (size_t)__builtin_amdgcn_readlane(slv, 4 * li + k) * D);
#pragma unroll
            for (int j = 0; j < 4; ++j) d[lane + 64 * j] = w[j]; } }
}
__device__ __forceinline__ void phase_ffn_norm_route(PP p, int layer, int nrows, LAS unsigned char* lds, int lane, int wave) {
    const int gw = blockIdx.x * NWAVES + wave, NGW = gridDim.x * NWAVES;
    const float* rw = p->in[I_ROUTW] + (size_t)layer * D * NE; const float* rb = p->in[I_ROUTB] + layer * NE;
    float* TOPG = (float*)(p->ws + WS_ROUTE + RT_TOPG); int* SLOT = (int*)(p->ws + WS_ROUTE + RT_SLOT); int* TILEE = (int*)(p->ws + WS_ROUTE + RT_TILEE) + layer * 512;
    unsigned* ctl = (unsigned*)(p->ws + WS_CTL); unsigned* cnt = ctl + CW_CNT + layer * NE * CNT_STRIDE; unsigned* ntl = ctl + CW_NT + layer; unsigned* tof = ctl + CW_TOF + layer * NE * TOF_PER;
    unsigned char* XB = p->ws + WS_U + U_XB;
    LAS float* hs = (LAS float*)(lds + wave * 8704);
    for (int row0 = gw; row0 < nrows; row0 += 2 * NGW) {
        const bool has1 = row0 + NGW < nrows; const int row1 = has1 ? row0 + NGW : row0;
#pragma unroll
        for (int r = 0; r < 2; ++r) { const int row = r ? row1 : row0;
            f32x4 v[4], h[4]; load_row((const float*)(p->ws + WS_XR) + (size_t)row * D, lane, v); const float rstd = row_rstd(v); const int vec = row_vec(row);
            norm_mod(v, rstd, p->in[I_NFFN] + layer * D, modp(p, layer, vec, 3), modp(p, layer, vec, 4), lane, h);
#pragma unroll
            for (int j = 0; j < 4; ++j)
#pragma unroll
                for (int i = 0; i < 4; ++i) hs[r * 1024 + (4 * j + i) * 64 + lane] = h[j][i]; }
        LDS_WAIT(); asm volatile("" ::: "memory");
        float pa[NE], pb[NE];
        {
            const int e4 = lane & 7, kq = lane >> 3;
            f32x4 qa = (f32x4){0.f, 0.f, 0.f, 0.f}, qb = (f32x4){0.f, 0.f, 0.f, 0.f};
#pragma unroll 4
            for (int t = 0; t < 32; ++t) {
                const int u = kq + 8 * t, l = u & 63, j = u >> 6;
                const f32x4* wr = (const f32x4*)(rw + (size_t)(4 * u) * NE) + e4;
#pragma unroll
                for (int i = 0; i < 4; ++i) { const f32x4 w4 = wr[i * (NE / 4)]; const float x0 = hs[(4 * j + i) * 64 + l], x1 = hs[1024 + (4 * j + i) * 64 + l];
                    qa = qa + x0 * w4; qb = qb + x1 * w4; }
            }
#pragma unroll
            for (int o = 8; o < 64; o <<= 1) {
#pragma unroll
                for (int c = 0; c < 4; ++c) { qa[c] += __shfl_xor(qa[c], o); qb[c] += __shfl_xor(qb[c], o); } }
            LAS float* lg = hs + 2048;
            if (kq == 0) { *(LAS f32x4*)(lg + 4 * e4) = qa; *(LAS f32x4*)(lg + 32 + 4 * e4) = qb; }
            LDS_WAIT(); asm volatile("" ::: "memory");
#pragma unroll
            for (int q4 = 0; q4 < 8; ++q4) { const f32x4 va = *(const LAS f32x4*)(lg + 4 * q4), vb = *(const LAS f32x4*)(lg + 32 + 4 * q4);
#pragma unroll
                for (int c = 0; c < 4; ++c) { pa[4 * q4 + c] = va[c]; pb[4 * q4 + c] = vb[c]; } }
        }
        int s0[TOPK], s1[TOPK];
        route_select(pa, rb, row0, TOPG, SLOT, cnt, ntl, tof, TILEE, lane, true, s0);
        route_select(pb, rb, row1, TOPG, SLOT, cnt, ntl, tof, TILEE, lane, has1, s1);
#pragma unroll
        for (int r = 0; r < 2; ++r) { if (r == 1 && !has1) break;
            unsigned w[4];
#pragma unroll
            for (int j = 0; j < 4; ++j) { const LAS float* hp = hs + r * 1024 + (4 * j) * 64 + lane; w[j] = pk4_fp8(hp[0], hp[64], hp[128], hp[192]); }
#pragma unroll
            for (int k = 0; k < TOPK; ++k) { unsigned* d = (unsigned*)(XB + (size_t)(r ? s1[k] : s0[k]) * D);
#pragma unroll
                for (int j = 0; j < 4; ++j) d[lane + 64 * j] = w[j]; } }
        LDS_WAIT(); asm volatile("" ::: "memory");
    }
}
__device__ __forceinline__ void phase_combine(PP p, int layer, int nrows, bool final_out, int lane, int wave) {
    const int gw = blockIdx.x * NWAVES + wave, NGW = gridDim.x * NWAVES;
    const float* TOPG = (const float*)(p->ws + WS_ROUTE + RT_TOPG); const int* SLOT = (const int*)(p->ws + WS_ROUTE + RT_SLOT);
    const bf16* YS = (const bf16*)(p->ws + WS_U + U_YS); float* XR = (float*)(p->ws + WS_XR); float* RSTD = (float*)(p->ws + WS_ROUTE + RT_RSTD);
    f32x4 vn[4]; f32x4 gn4 = (f32x4){0.f, 0.f, 0.f, 0.f}; int sn[4] = {0, 0, 0, 0};
    if (gw < nrows) { load_row(XR + (size_t)gw * D, lane, vn); gn4 = *(const f32x4*)(TOPG + gw * 4);
#pragma unroll
        for (int k = 0; k < TOPK; ++k) sn[k] = SLOT[gw * 4 + k]; }
    for (int row = gw; row < nrows; row += NGW) {
        f32x4 v[4], acc[4]; const f32x4 g4 = gn4; int sc[4];
#pragma unroll
        for (int j = 0; j < 4; ++j) { v[j] = vn[j]; sc[j] = sn[j]; }
        if (row + NGW < nrows) { const int rn = row + NGW; load_row(XR + (size_t)rn * D, lane, vn); gn4 = *(const f32x4*)(TOPG + rn * 4);
#pragma unroll
            for (int k = 0; k < TOPK; ++k) sn[k] = SLOT[rn * 4 + k]; }
#pragma unroll
        for (int j = 0; j < 4; ++j) acc[j] = (f32x4){0.f, 0.f, 0.f, 0.f};
#pragma unroll
        for (int k = 0; k < TOPK; ++k) {
            const float gk = g4[k]; const v2u* ys = (const v2u*)(YS + (size_t)sc[k] * D);
#pragma unroll
            for (int j = 0; j < 4; ++j) { const v2u w = ys[lane + 64 * j];
                acc[j].x += gk * bf2f(w.x & 0xffffu); acc[j].y += gk * bf2f(w.x >> 16); acc[j].z += gk * bf2f(w.y & 0xffffu); acc[j].w += gk * bf2f(w.y >> 16); }
        }
        const float* m5 = modp(p, layer, row_vec(row), 5);
#pragma unroll
        for (int j = 0; j < 4; ++j) v[j] = v[j] + ((const f32x4*)m5)[lane + 64 * j] * acc[j];
        const float rstd = row_rstd(v);
        if (final_out) {
#pragma unroll
            for (int j = 0; j < 4; ++j) ((f32x4*)(p->out + (size_t)row * D))[lane + 64 * j] = v[j] * rstd * ((const f32x4*)p->in[I_FINALG])[lane + 64 * j];
        } else {
#pragma unroll
            for (int j = 0; j < 4; ++j) ((f32x4*)(XR + (size_t)row * D))[lane + 64 * j] = v[j];
            if (lane == 0) RSTD[row] = rstd;
        }
    }
}

__device__ __forceinline__ int step_row(int b, int dir, int step) {
    if (step < CTXL) { const int t = dir ? (CTXL - 1 - step) : step; return NLAT + b * CTXL + t; }
    const int s = step - CTXL; const int t = dir ? (SEQ - 1 - s) : s; return b * SEQ + t;
}
constexpr int NSTEP = CTXL + SEQ;

__device__ __forceinline__ void phase_hg_readout(PP p, int lane, int wave) {
    const int gw = blockIdx.x * NWAVES + wave, NGW = gridDim.x * NWAVES;
    const bf16* Z = (const bf16*)(p->ws + WS_U + U_Z); const float* OD = (const float*)(p->ws + WS_U + U_OD0); bf16* A2 = (bf16*)(p->ws + WS_A2);
    const float* gn = p->in[I_HGGN];
    for (int row = gw; row < NROW; row += NGW) {
#pragma unroll
        for (int h = 0; h < 8; ++h) {
            const int c = h * 128 + 2 * lane;
            const float2 a = *(const float2*)(OD + (size_t)row * D + c), bq = *(const float2*)(OD + (size_t)(NROW + row) * D + c);
            const float o0 = a.x + bq.x, o1 = a.y + bq.y;
            const float rstd = rsqrtf(wave_sum(o0 * o0 + o1 * o1) * (1.0f / 128.0f) + NORM_EPS);
            const unsigned gz = *(const unsigned*)(Z + (size_t)row * 5120 + 4096 + c); const float g0 = bf2f(gz & 0xffffu), g1 = bf2f(gz >> 16);
            const float r0 = o0 * rstd * gn[2 * lane] * (g0 * sigm(g0)), r1 = o1 * rstd * gn[2 * lane + 1] * (g1 * sigm(g1));
            *(unsigned*)(A2 + (size_t)row * D + c) = pk2(r0, r1);
        }
    }
}

__device__ __forceinline__ void phase_lerp(PP p, LAS unsigned char* lds, int tid, int lane, int wave) {
    const int gw = blockIdx.x * NWAVES + wave, NGW = gridDim.x * NWAVES;
    const float* XR = (const float*)(p->ws + WS_XR); const float* RSTD = (const float*)(p->ws + WS_ROUTE + RT_RSTD);
    bf16* XL6 = (bf16*)(p->ws + WS_U + U_XL6); const float* g = p->in[I_NMIX] + D; const float* mu = p->in[I_MU];
    LAS float* TGS = (LAS float*)lds;
    LAS float* TS0 = TGS + 3 * D;
    LAS float* TMU = TS0 + 3 * D;
#pragma unroll
    for (int u = tid; u < 3 * D; u += NTHREADS) { const int vec = u >> 10, c = u & (D - 1); TGS[u] = g[c] * (modp(p, 1, vec, 1)[c] + 1.0f); TS0[u] = modp(p, 1, vec, 0)[c]; }
#pragma unroll
    for (int u = tid; u < 6 * D; u += NTHREADS) { const int s = u >> 10, c = u & (D - 1); const int m = (s == 0) ? 0 : (s == 1) ? 2 : (s == 2) ? 3 : (s == 3) ? 1 : (s == 4) ? 4 : 5; TMU[u] = mu[m * D + c]; }
    __syncthreads();
    auto nbrs = [&](int row, int (&nb)[4]) {
        if (row < NLAT) { const int t = row & (SEQ - 1), w = t & 63, r = t >> 6;
            nb[0] = (w >= 1) ? row - 1 : -1; nb[1] = (w < 63) ? row + 1 : -1; nb[2] = (r >= 1) ? row - 64 : -1; nb[3] = (r < SEQ / 64 - 1) ? row + 64 : -1;
        } else { const int t = (row - NLAT) & (CTXL - 1);
            nb[0] = nb[1] = (t >= 1) ? row - 1 : -1; nb[2] = nb[3] = (t < CTXL - 1) ? row + 1 : -1; } };
    f32x4 nxs[4], nxn[4]; float nrs = 0.f, nrn[4] = {0.f, 0.f, 0.f, 0.f};
    auto fetch = [&](int row) { int nb[4]; nbrs(row, nb); nrs = RSTD[row];
#pragma unroll
        for (int j = 0; j < 4; ++j) { const int ci = lane + 64 * j; nxs[j] = ((const f32x4*)(XR + (size_t)row * D))[ci];
            const int nr = nb[j] >= 0 ? nb[j] : row; nxn[j] = ((const f32x4*)(XR + (size_t)nr * D))[ci]; nrn[j] = nb[j] >= 0 ? RSTD[nr] : 0.f; } };
    if (gw < NROW) fetch(gw);
    for (int row = gw; row < NROW; row += NGW) {
        const int vec = row_vec(row); int nb[4]; nbrs(row, nb);
        f32x4 xs[4], xn[4]; float rn[4]; const float rs = nrs;
#pragma unroll
        for (int j = 0; j < 4; ++j) { xs[j] = nxs[j]; xn[j] = nxn[j]; rn[j] = nrn[j]; }
        if (row + NGW < NROW) fetch(row + NGW);
#pragma unroll
        for (int j = 0; j < 4; ++j) {
            const int ci = lane + 64 * j;
            const f32x4 gs = ((const LAS f32x4*)(TGS + vec * D))[ci], s0 = ((const LAS f32x4*)(TS0 + vec * D))[ci];
            const f32x4 hs = xs[j] * rs * gs + s0;
            f32x4 hn = (f32x4){0.f, 0.f, 0.f, 0.f};
            if (nb[j] >= 0) hn = xn[j] * rn[j] * gs + s0;
            const f32x4 dx = hn - hs;
#pragma unroll
            for (int s = 0; s < 6; ++s) {
                const f32x4 o = hs + dx * ((const LAS f32x4*)(TMU + s * D))[ci];
                v2u w; w.x = pk2(o.x, o.y); w.y = pk2(o.z, o.w);
                ((v2u*)(XL6 + ((size_t)s * NROW + row) * D))[ci] = w;
            }
        }
    }
    __syncthreads();
}
__device__ __forceinline__ float row16_allsum(float x) {
    x += __builtin_bit_cast(float, __builtin_amdgcn_update_dpp(0, __builtin_bit_cast(int, x), 0x128, 0xf, 0xf, false));
    x += __builtin_bit_cast(float, __builtin_amdgcn_update_dpp(0, __builtin_bit_cast(int, x), 0x124, 0xf, 0xf, false));
    x += __builtin_bit_cast(float, __builtin_amdgcn_update_dpp(0, __builtin_bit_cast(int, x), 0x122, 0xf, 0xf, false));
    x += __builtin_bit_cast(float, __builtin_amdgcn_update_dpp(0, __builtin_bit_cast(int, x), 0x121, 0xf, 0xf, false));
    return x;
}
__device__ __forceinline__ f32x4 bf4(v2u w) { return (f32x4){bf2f(w.x & 0xffffu), bf2f(w.x >> 16), bf2f(w.y & 0xffffu), bf2f(w.y >> 16)}; }
__device__ __forceinline__ void phase_rw_readout(PP p, int lane, int wave) {
    const int gw = blockIdx.x * NWAVES + wave, NGW = gridDim.x * NWAVES;
    const bf16* RKV = (const bf16*)(p->ws + WS_U + U_RKV); const bf16* AD = (const bf16*)(p->ws + WS_U + U_AD); const bf16* G = (const bf16*)(p->ws + WS_U + U_G);
    const float* OD = (const float*)(p->ws + WS_U + U_OD1); bf16* A2 = (bf16*)(p->ws + WS_A2);
    const int hq = lane >> 4, c4 = lane & 15, slab = c4 >> 2, v0 = (4 * c4) & 15;
    f32x4 lw[4], lb[4], ka[4], rk[4];
#pragma unroll
    for (int hg = 0; hg < 4; ++hg) { const int ch = (4 * hg + hq) * 64 + 4 * c4;
        lw[hg] = *(const f32x4*)(p->in[I_LNXW] + ch); lb[hg] = *(const f32x4*)(p->in[I_LNXB] + ch); ka[hg] = *(const f32x4*)(p->in[I_KA] + ch); rk[hg] = *(const f32x4*)(p->in[I_RK] + ch); }
    for (int row = gw; row < NLAT; row += NGW) {
        const int bq = row >> 13, tq = row & (SEQ - 1);
        f32x4 y0[4], y1[4]; v2u lr[4], lk[4], lv[4], la0[4], la1[4], lg[4];
#pragma unroll
        for (int hg = 0; hg < 4; ++hg) {
            const int h = 4 * hg + hq, ch = h * 64 + 4 * c4;
            const int u0 = (bq * 32 + h) * 4 + slab, u1 = (bq * 32 + 16 + h) * 4 + slab;
            y0[hg] = *(const f32x4*)(OD + ((size_t)u0 * NSTEP + CTXL + tq) * 16 + v0); y1[hg] = *(const f32x4*)(OD + ((size_t)u1 * NSTEP + CTXL + (SEQ - 1 - tq)) * 16 + v0);
            lr[hg] = *(const v2u*)(RKV + (size_t)row * 3072 + ch); lk[hg] = *(const v2u*)(RKV + (size_t)row * 3072 + 1024 + ch); lv[hg] = *(const v2u*)(RKV + (size_t)row * 3072 + 2048 + ch);
            la0[hg] = *(const v2u*)(AD + (size_t)row * D + ch); la1[hg] = *(const v2u*)(AD + ((size_t)NROW + row) * D + ch); lg[hg] = *(const v2u*)(G + (size_t)row * D + ch);
        }
#pragma unroll
        for (int hg = 0; hg < 4; ++hg) {
            const int h = 4 * hg + hq, ch = h * 64 + 4 * c4;
            const f32x4 y = y0[hg] + y1[hg];
            const f32x4 r = bf4(lr[hg]), k = bf4(lk[hg]), v = bf4(lv[hg]);
            const f32x4 a0 = bf4(la0[hg]), a1 = bf4(la1[hg]), g = bf4(lg[hg]);
            const float mean = row16_allsum((y[0] + y[1]) + (y[2] + y[3])) * (1.0f / 64.0f);
            const f32x4 d = y - mean;
            const float var = row16_allsum((d[0] * d[0] + d[1] * d[1]) + (d[2] * d[2] + d[3] * d[3])) * (1.0f / 64.0f);
            f32x4 yn = d * rsqrtf(var + 64.0e-5f) * lw[hg] + lb[hg];
            const f32x4 kd0 = k * ((a0 - 1.0f) * ka[hg] + 1.0f), kd1 = k * ((a1 - 1.0f) * ka[hg] + 1.0f);
            const f32x4 t0 = r * kd0 * rk[hg], t1 = r * kd1 * rk[hg];
            const float s0 = row16_allsum((t0[0] + t0[1]) + (t0[2] + t0[3])), s1 = row16_allsum((t1[0] + t1[1]) + (t1[2] + t1[3]));
            yn = yn + v * (s0 + s1);
            const f32x4 o = yn * g;
            v2u w; w.x = pk2(o[0], o[1]); w.y = pk2(o[2], o[3]);
            *(v2u*)(A2 + (size_t)row * D + ch) = w;
        }
    }
}

namespace pg8 {
struct SelOrder : StaticOrder {
    int div, sel0; size_t stride;
    __device__ __forceinline__ const char* abase(const Gemm& g, const Unit& u, size_t tstep) const { return (const char*)g.A + (size_t)(sel0 + u.pn / div) * stride + (size_t)u.pm * tstep; }
};
struct RkvL1Order {
    StaticOrder s1, s2; int G, c; const bf16_t* B2; size_t stride;
    __device__ __forceinline__ void init(int M, int G_, int c_, const bf16_t* b2, size_t st) { s1.init(M, 3072, G_, 0); s2.init(M, 768, G_, 0); G = G_; c = c_; B2 = b2; stride = st; }
    __device__ __forceinline__ bool next(int i, Unit& u) const { const long L = (long)i * G + c; if (L < s1.nwg) return s1.at(L, u); if (!s2.at(L - s1.nwg, u)) return false; u.e = 1; return true; }
    __device__ __forceinline__ const char* abase(const Gemm& g, const Unit& u, size_t tstep) const { return (const char*)g.A + (size_t)(u.e ? 3 + u.pn : u.pn / 4) * stride + (size_t)u.pm * tstep; }
    __device__ __forceinline__ const char* bbase(const Gemm& g, const Unit& u, size_t tstep) const { return (const char*)(u.e ? B2 : g.Bt) + (size_t)u.pn * tstep; }
    __device__ __forceinline__ void a_ready(const Unit&) const {}
    __device__ __forceinline__ void done(const Unit&) const {}
};
struct MoeOrder {
    const int* tilee; const PG8_LAS int* ord; int nt, ntn, G, c; size_t estride;
    __device__ __forceinline__ void init(const int* te, int nt_, PG8_LAS int* ordbuf, int ntn_, size_t es, int G_, int c_) {
        tilee = te; nt = nt_; ntn = ntn_; estride = es; G = G_; c = c_; ord = ordbuf;
        { const int t = threadIdx.x; PG8_LAS int* E = ordbuf + 512;
          int et = 0; if (t < nt) { et = te[1 + t]; E[t] = et; }
          asm volatile("s_waitcnt vmcnt(0) lgkmcnt(0)" ::: "memory"); __builtin_amdgcn_s_barrier(); asm volatile("" ::: "memory");
          if (t < nt) { int rank = 0;
#pragma unroll 8
              for (int u = 0; u < nt; ++u) { const int eu = E[u]; rank += (eu < et || (eu == et && u < t)) ? 1 : 0; }
              ordbuf[rank] = t; } }
        asm volatile("s_waitcnt lgkmcnt(0)" ::: "memory"); __builtin_amdgcn_s_barrier(); asm volatile("" ::: "memory");
    }
    __device__ __forceinline__ bool next(int i, Unit& u) const { const long L = (long)i * G + c; if (L >= (long)nt * ntn) return false; u.pm = ord[(int)(L / ntn)]; u.pn = (int)(L % ntn); u.e = tilee[1 + u.pm]; return true; }
    __device__ __forceinline__ const char* abase(const Gemm& g, const Unit& u, size_t tstep) const { return (const char*)g.A + (size_t)u.pm * tstep; }
    __device__ __forceinline__ const char* bbase(const Gemm& g, const Unit& u, size_t tstep) const { return (const char*)g.Bt + (size_t)u.e * estride + (size_t)u.pn * tstep; }
    __device__ __forceinline__ void a_ready(const Unit&) const {}
    __device__ __forceinline__ void done(const Unit&) const {}
};
struct EpiStoreBf16 {
    static constexpr bool PERM = true, AFTER_DRAIN = false;
    bf16_t* O; int ldc;
    __device__ __forceinline__ void operator()(const f32x4 (&acc)[2][2][4][2], const Unit& u, int wr, int wc, int fr, int fq) const {
        const int row0 = u.pm * BM + wr * 64 + fr, col0 = u.pn * BM + wc * 32 + 8 * fq;
#pragma unroll
        for (int ai = 0; ai < 2; ++ai)
#pragma unroll
            for (int m = 0; m < 4; ++m) { bf16_t* rowp = O + (size_t)(row0 + ai * HALF + m * 16) * ldc + col0;
#pragma unroll
                for (int bj = 0; bj < 2; ++bj) { const f32x4 v0 = acc[ai][bj][m][0], v1 = acc[ai][bj][m][1];
                    u32x4 w; w.x = cvt_pk_bf16(v0[0], v0[1]); w.y = cvt_pk_bf16(v0[2], v0[3]); w.z = cvt_pk_bf16(v1[0], v1[1]); w.w = cvt_pk_bf16(v1[2], v1[3]);
                    *(u32x4*)(rowp + bj * HALF) = w; } }
    }
};
struct EpiStoreF32 {
    static constexpr bool PERM = false, AFTER_DRAIN = false;
    float* C; int ldc;
    __device__ __forceinline__ void operator()(const f32x4 (&acc)[2][2][4][2], const Unit& u, int wr, int wc, int fr, int fq) const {
        const int row0 = u.pm * BM + wr * 64 + fr, col0 = u.pn * BM + wc * 32 + 4 * fq;
#pragma unroll
        for (int ai = 0; ai < 2; ++ai)
#pragma unroll
            for (int m = 0; m < 4; ++m) { float* rowp = C + (size_t)(row0 + ai * HALF + m * 16) * ldc + col0;
#pragma unroll
                for (int bj = 0; bj < 2; ++bj)
#pragma unroll
                    for (int n = 0; n < 2; ++n) *(f32x4*)(rowp + bj * HALF + n * 16) = acc[ai][bj][m][n]; }
    }
};
struct EpiResid {
    static constexpr bool PERM = false, AFTER_DRAIN = false;
    const float* base_lat; const float* base_ctx; float* out; const float* gate; int gstride;
    __device__ __forceinline__ void operator()(const f32x4 (&acc)[2][2][4][2], const Unit& u, int wr, int wc, int fr, int fq) const {
        const int row0 = u.pm * BM + wr * 64 + fr, col0 = u.pn * BM + wc * 32 + 4 * fq;
#pragma unroll
        for (int ai = 0; ai < 2; ++ai)
#pragma unroll
            for (int m = 0; m < 4; ++m) { const int row = row0 + ai * HALF + m * 16;
                const float* bp = (row < 16384) ? base_lat + (size_t)row * 1024 : base_ctx + (size_t)(row - 16384) * 1024;
                const float* gp = gate + (size_t)(row < 16384 ? (row >= 8192 ? 1 : 0) : 2) * gstride;
                float* op = out + (size_t)row * 1024;
#pragma unroll
                for (int bj = 0; bj < 2; ++bj)
#pragma unroll
                    for (int n = 0; n < 2; ++n) { const int c = col0 + bj * HALF + n * 16;
                        *(f32x4*)(op + c) = *(const f32x4*)(bp + c) + *(const f32x4*)(gp + c) * acc[ai][bj][m][n]; } }
    }
};
__device__ __forceinline__ float sigm_(float x) { return __builtin_amdgcn_rcpf(1.0f + __expf(-x)); }
struct EpiSwiglu {
    static constexpr bool PERM = true, AFTER_DRAIN = false;
    PP p; int layer;
    __device__ __forceinline__ void operator()(const f32x4 (&acc)[2][2][4][2], const Unit& u, int wr, int wc, int fr, int fq) const {
        PP q_ = p; asm volatile("" : "+s"(q_));
        unsigned char* O = q_->ws + WS_U + U_ACT; const float* bgu = q_->in[I_BGU] + (size_t)layer * NE * 2048;
        const int row0 = u.pm * BM + wr * 64 + fr, col0 = u.pn * HALF + wc * 32 + 8 * fq;
        const float* bg = bgu + (size_t)u.e * 2048 + col0; f32x4 bgv[2], buv[2];
#pragma unroll
        for (int n = 0; n < 2; ++n) { bgv[n] = *(const f32x4*)(bg + 4 * n); buv[n] = *(const f32x4*)(bg + 1024 + 4 * n); }
#pragma unroll
        for (int ai = 0; ai < 2; ++ai)
#pragma unroll
            for (int m = 0; m < 4; ++m) { float r[8];
#pragma unroll
                for (int n = 0; n < 2; ++n) { const f32x4 g4 = acc[ai][0][m][n] + bgv[n], u4 = acc[ai][1][m][n] + buv[n];
#pragma unroll
                    for (int j = 0; j < 4; ++j) { const float g = fminf(g4[j], 7.0f), uu = fminf(fmaxf(u4[j], -7.0f), 7.0f); r[4 * n + j] = g * sigm_(1.702f * g) * (uu + 1.0f); } }
                unsigned w0 = 0u, w1 = 0u;
                w0 = __builtin_amdgcn_cvt_pk_fp8_f32(r[0], r[1], w0, false); w0 = __builtin_amdgcn_cvt_pk_fp8_f32(r[2], r[3], w0, true);
                w1 = __builtin_amdgcn_cvt_pk_fp8_f32(r[4], r[5], w1, false); w1 = __builtin_amdgcn_cvt_pk_fp8_f32(r[6], r[7], w1, true);
                *(unsigned long long*)(O + (size_t)(row0 + ai * HALF + m * 16) * 1024 + col0) = (unsigned long long)w0 | ((unsigned long long)w1 << 32); }
    }
};
struct EpiDown {
    static constexpr bool PERM = true, AFTER_DRAIN = false;
    PP p; int layer;
    __device__ __forceinline__ void operator()(const f32x4 (&acc)[2][2][4][2], const Unit& u, int wr, int wc, int fr, int fq) const {
        PP q_ = p; asm volatile("" : "+s"(q_));
        bf16_t* O = (bf16_t*)(q_->ws + WS_U + U_YS); const float* bdn = q_->in[I_BDN] + (size_t)layer * NE * 1024;
        const int row0 = u.pm * BM + wr * 64 + fr, col0 = u.pn * BM + wc * 32 + 8 * fq;
        const float* bp = bdn + (size_t)u.e * 1024 + col0; f32x4 bv[2][2];
#pragma unroll
        for (int bj = 0; bj < 2; ++bj)
#pragma unroll
            for (int n = 0; n < 2; ++n) bv[bj][n] = *(const f32x4*)(bp + bj * HALF + 4 * n);
#pragma unroll
        for (int ai = 0; ai < 2; ++ai)
#pragma unroll
            for (int m = 0; m < 4; ++m) { bf16_t* rowp = O + (size_t)(row0 + ai * HALF + m * 16) * 1024 + col0;
#pragma unroll
                for (int bj = 0; bj < 2; ++bj) { const f32x4 v0 = acc[ai][bj][m][0] + bv[bj][0], v1 = acc[ai][bj][m][1] + bv[bj][1];
                    u32x4 w; w.x = cvt_pk_bf16(v0[0], v0[1]); w.y = cvt_pk_bf16(v0[2], v0[3]); w.z = cvt_pk_bf16(v1[0], v1[1]); w.w = cvt_pk_bf16(v1[2], v1[3]);
                    *(u32x4*)(rowp + bj * HALF) = w; } }
    }
};
struct EpiLora1 {
    static constexpr bool PERM = true, AFTER_DRAIN = false;
    bf16_t* O;
    __device__ __forceinline__ void operator()(const f32x4 (&acc)[2][2][4][2], const Unit& u, int wr, int wc, int fr, int fq) const {
        const int row0 = u.pm * BM + wr * 64 + fr, col0 = u.pn * HALF + wc * 32 + 8 * fq;
#pragma unroll
        for (int ai = 0; ai < 2; ++ai)
#pragma unroll
            for (int m = 0; m < 4; ++m) { float r[8];
#pragma unroll
                for (int n = 0; n < 2; ++n)
#pragma unroll
                    for (int j = 0; j < 4; ++j) { const float x = acc[ai][0][m][n][j]; r[4 * n + j] = (u.pn == 0) ? (2.0f * sigm_(2.0f * x) - 1.0f) : (u.pn == 1) ? x : sigm_(x); }
                u32x4 w; w.x = cvt_pk_bf16(r[0], r[1]); w.y = cvt_pk_bf16(r[2], r[3]); w.z = cvt_pk_bf16(r[4], r[5]); w.w = cvt_pk_bf16(r[6], r[7]);
                *(u32x4*)(O + (size_t)(row0 + ai * HALF + m * 16) * 384 + col0) = w; }
    }
};
struct EpiRkvL1 {
    static constexpr bool PERM = true, AFTER_DRAIN = false;
    EpiStoreBf16 rkv; EpiLora1 l1;
    __device__ __forceinline__ void operator()(const f32x4 (&acc)[2][2][4][2], const Unit& u, int wr, int wc, int fr, int fq) const { if (u.e) l1(acc, u, wr, wc, fr, fq); else rkv(acc, u, wr, wc, fr, fq); }
};
struct EpiLora2 {
    static constexpr bool PERM = false, AFTER_DRAIN = false;
    bf16_t* WD; bf16_t* AD; bf16_t* G; const float* w0; const float* a0;
    __device__ __forceinline__ void operator()(const f32x4 (&acc)[2][2][4][2], const Unit& u, int wr, int wc, int fr, int fq) const {
        const int row0 = u.pm * BM + wr * 64 + fr, blk = u.pn >> 2, col0 = (u.pn & 3) * BM + wc * 32 + 4 * fq;
        bf16_t* dst = (blk < 2) ? WD + (size_t)blk * 16896 * 1024 : (blk < 4) ? AD + (size_t)(blk - 2) * 16896 * 1024 : G;
        const float* bias = (blk < 2) ? w0 + blk * 1024 : a0 + ((blk - 2) & 1) * 1024;
#pragma unroll
        for (int ai = 0; ai < 2; ++ai)
#pragma unroll
            for (int m = 0; m < 4; ++m) { bf16_t* rowp = dst + (size_t)(row0 + ai * HALF + m * 16) * 1024;
#pragma unroll
                for (int bj = 0; bj < 2; ++bj)
#pragma unroll
                    for (int n = 0; n < 2; ++n) { const int c = col0 + bj * HALF + n * 16; f32x4 v = acc[ai][bj][m][n];
                        const f32x4 bb = *(const f32x4*)(bias + c);
                        if (blk < 2) { for (int j = 0; j < 4; ++j) v[j] = -0.60653066f * sigm_(v[j] + bb[j]); }
                        else if (blk < 4) { for (int j = 0; j < 4; ++j) v[j] = sigm_(v[j] + bb[j]); }
                        unsigned lo = cvt_pk_bf16(v[0], v[1]), hi = cvt_pk_bf16(v[2], v[3]);
                        *(unsigned long long*)(rowp + c) = (unsigned long long)lo | ((unsigned long long)hi << 32); }
                asm volatile("" ::: "memory"); }
    }
};
}

constexpr int GLA_NCH = NSTEP / 64;
constexpr int GLA_ITEMS = 2 * NBATCH * GLA_NCH * 8;
constexpr size_t U_DS = 298 * MiB, U_OI = 430 * MiB, U_QT = 562 * MiB, U_LAM = 628 * MiB;
typedef short bf16x8_t __attribute__((ext_vector_type(8)));
typedef float f32x2g __attribute__((ext_vector_type(2)));
__device__ __forceinline__ f32x4 mfma16(bf16x8_t a, bf16x8_t b, f32x4 c) { return __builtin_amdgcn_mfma_f32_16x16x32_bf16(a, b, c, 0, 0, 0); }

__device__ __forceinline__ void phase_gla_prep(PP p, LAS unsigned char* lds, int tid, int lane, int wave) {
    constexpr int PQ = 272, PT = 144;
    LAS unsigned char* QA = lds;
    LAS unsigned char* QX = QA + 64 * PQ;
    LAS unsigned char* KB = QX + 48 * PQ;
    LAS unsigned char* KD = KB + 64 * PQ;
    LAS unsigned char* KT = KD + 64 * PQ;
    LAS unsigned char* VT = KT + 128 * PT;
    LAS unsigned char* PI = VT + 128 * PT;
    LAS float* GT = (LAS float*)(PI + 64 * PT);
    const bf16* Z = (const bf16*)(p->ws + WS_U + U_Z);
    bf16* DS = (bf16*)(p->ws + WS_U + U_DS); v2u* OI = (v2u*)(p->ws + WS_U + U_OI); bf16* QT = (bf16*)(p->ws + WS_U + U_QT); float* LAM = (float*)(p->ws + WS_U + U_LAM);
    const int kp = tid & 63, gg = tid >> 6, g = gg >> 1, hh = gg & 1, k0 = 2 * kp, kq = lane >> 4, c16 = lane & 15;
    unsigned zf[8], zq[8], zv[8];
    auto ldz = [&](int item2) {
        const int h2 = item2 & 7, cc2 = (item2 >> 3) % GLA_NCH, db2 = (item2 >> 3) / GLA_NCH, b2 = db2 & 1, dir2 = db2 >> 1;
#pragma unroll
        for (int i = 0; i < 8; ++i) { const size_t zr = (size_t)step_row(b2, dir2, 64 * cc2 + 8 * gg + i) * 5120 + h2 * 128 + k0;
            zf[i] = *(const unsigned*)(Z + zr + 1024 * (1 + dir2)); zq[i] = *(const unsigned*)(Z + zr); zv[i] = *(const unsigned*)(Z + zr + 3072); } };
    if ((int)blockIdx.x < GLA_ITEMS) ldz(blockIdx.x);
    for (int item = blockIdx.x; item < GLA_ITEMS; item += gridDim.x) {
        const int h = item & 7, db = (item >> 3) / GLA_NCH, dir = db >> 1;
        float lbv[2];
#pragma unroll
        for (int e = 0; e < 2; ++e) { const float* lb = p->in[I_HGLB] + (size_t)dir * 3 * D + h * 128 + k0 + e; const float a0 = lb[0], a1 = lb[D], a2 = lb[2 * D];
            const float mx = fmaxf(a0, fmaxf(a1, a2)); const float e0 = __expf(a0 - mx), e1 = __expf(a1 - mx), e2 = __expf(a2 - mx); lbv[e] = e0 / (e0 + e1 + e2); }
        for (int u = tid; u < 64 * PT / 4; u += NTHREADS) ((LAS unsigned*)PI)[u] = 0u;
        float cs[2][8], kin[2][8], qs[2][8], run[2] = {0.f, 0.f}; unsigned vlo[4], vhi[4];
#pragma unroll
        for (int i = 0; i < 8; ++i) {
#pragma unroll
            for (int e = 0; e < 2; ++e) {
                const float fh = bf2f(e ? (zf[i] >> 16) : (zf[i] & 0xffffu)), qv = bf2f(e ? (zq[i] >> 16) : (zq[i] & 0xffffu));
                const float f = lbv[e] + (1.f - lbv[e]) * sigm(fh);
                run[e] += __logf(f); cs[e][i] = run[e]; kin[e][i] = 1.f - f; qs[e][i] = qv * sigm(qv);
            }
            if (i & 1) { vlo[i >> 1] |= zv[i] << 16; vhi[i >> 1] |= zv[i] & 0xffff0000u; } else { vlo[i >> 1] = zv[i] & 0xffffu; vhi[i >> 1] = zv[i] >> 16; }
        }
        if (item + (int)gridDim.x < GLA_ITEMS) ldz(item + gridDim.x);
        *(LAS f32x2g*)(GT + gg * 128 + k0) = (f32x2g){run[0], run[1]};
        *(LAS v4u*)(VT + k0 * PT + 16 * gg) = (v4u){vlo[0], vlo[1], vlo[2], vlo[3]};
        *(LAS v4u*)(VT + (k0 + 1) * PT + 16 * gg) = (v4u){vhi[0], vhi[1], vhi[2], vhi[3]};
        __syncthreads();
        f32x2g t8[8];
#pragma unroll
        for (int u = 0; u < 8; ++u) t8[u] = *(const LAS f32x2g*)(GT + u * 128 + k0);
        unsigned ktl[4], kth[4];
        float rgv[2], totv[2], runSv[2], lov[2], t1v[2], t2v[2];
#pragma unroll
        for (int e = 0; e < 2; ++e) {
            const float s0 = e ? t8[0].y : t8[0].x, s1 = e ? t8[1].y : t8[1].x, s2 = e ? t8[2].y : t8[2].x, s3 = e ? t8[3].y : t8[3].x;
            const float s4 = e ? t8[4].y : t8[4].x, s5 = e ? t8[5].y : t8[5].x, s6 = e ? t8[6].y : t8[6].x, s7 = e ? t8[7].y : t8[7].x;
            const float q0 = s0 + s1, q1 = s2 + s3, q2 = s4 + s5, q3 = s6 + s7;
            rgv[e] = (g > 0 ? q0 : 0.f) + (g > 1 ? q1 : 0.f) + (g > 2 ? q2 : 0.f); totv[e] = (q0 + q1) + (q2 + q3);
            runSv[e] = (g == 0) ? q0 : (g == 1) ? q1 : (g == 2) ? q2 : q3;
            const float first = (g == 0) ? s0 : (g == 1) ? s2 : (g == 2) ? s4 : s6;
            lov[e] = hh ? first : 0.f; t1v[e] = q1; t2v[e] = q2;
        }
        float erg[2], einv[2], eend[2], ex1[2], ex2[2];
#pragma unroll
        for (int e = 0; e < 2; ++e) { erg[e] = __expf(rgv[e]); einv[e] = __expf(-runSv[e]); eend[e] = __expf(totv[e] - (rgv[e] + runSv[e]));
            ex1[e] = (g == 2) ? __expf(t1v[e]) : __expf(t2v[e]); ex2[e] = __expf(t1v[e] + t2v[e]); }
        bf16* qtp = QT + (size_t)item * 64 * 128 + (size_t)(16 * g + 8 * hh) * 128 + k0;
#pragma unroll
        for (int i = 0; i < 8; ++i) {
            float qh[2], kb[2];
#pragma unroll
            for (int e = 0; e < 2; ++e) { const float cr = lov[e] + cs[e][i]; qh[e] = qs[e][i] * __expf(cr); kb[e] = kin[e][i] * __expf(runSv[e] - cr); }
            const int ro = (16 * g + 8 * hh + i) * PQ + 2 * k0;
            *(LAS unsigned*)(QA + ro) = pk2(qh[0], qh[1]);
            *(LAS unsigned*)(KB + ro) = pk2(kb[0], kb[1]);
            *(LAS unsigned*)(KD + ro) = pk2(kb[0] * einv[0], kb[1] * einv[1]);
            if (g == 2) *(LAS unsigned*)(QX + (8 * hh + i) * PQ + 2 * k0) = pk2(qh[0] * ex1[0], qh[1] * ex1[1]);
            if (g == 3) { *(LAS unsigned*)(QX + (16 + 8 * hh + i) * PQ + 2 * k0) = pk2(qh[0] * ex1[0], qh[1] * ex1[1]); *(LAS unsigned*)(QX + (32 + 8 * hh + i) * PQ + 2 * k0) = pk2(qh[0] * ex2[0], qh[1] * ex2[1]); }
            *(unsigned*)(qtp + (size_t)i * 128) = pk2(qh[0] * erg[0], qh[1] * erg[1]);
            const unsigned kv0 = f2bf(kb[0] * eend[0]), kv1 = f2bf(kb[1] * eend[1]);
            if (i & 1) { ktl[i >> 1] |= kv0 << 16; kth[i >> 1] |= kv1 << 16; } else { ktl[i >> 1] = kv0; kth[i >> 1] = kv1; }
        }
        *(LAS v4u*)(KT + k0 * PT + 16 * gg) = (v4u){ktl[0], ktl[1], ktl[2], ktl[3]};
        *(LAS v4u*)(KT + (k0 + 1) * PT + 16 * gg) = (v4u){kth[0], kth[1], kth[2], kth[3]};
        if (gg == 0) *(f32x2g*)(LAM + (size_t)item * 128 + k0) = (f32x2g){__expf(totv[0]), __expf(totv[1])};
        __syncthreads();
        for (int blk = wave; blk < 10; blk += 8) {
            const int gi = (blk >= 6) ? 3 : (blk >= 3) ? 2 : (blk >= 1) ? 1 : 0, ji = blk - ((gi * (gi + 1)) >> 1);
            const LAS unsigned char* ab = (ji + 1 >= gi) ? QA + 16 * gi * PQ : (gi == 2) ? QX : (ji == 1) ? QX + 16 * PQ : QX + 32 * PQ;
            const LAS unsigned char* bb = ((ji == gi) ? KD : KB) + 16 * ji * PQ;
            f32x4 acc = (f32x4){0.f, 0.f, 0.f, 0.f};
#pragma unroll
            for (int s = 0; s < 4; ++s) {
                const bf16x8_t a = *(const LAS bf16x8_t*)(ab + c16 * PQ + (32 * s + 8 * kq) * 2), bv = *(const LAS bf16x8_t*)(bb + c16 * PQ + (32 * s + 8 * kq) * 2);
                acc = mfma16(a, bv, acc);
            }
#pragma unroll
            for (int j = 0; j < 4; ++j) { const int tau = 4 * kq + j; const float val = (ji == gi && c16 > tau) ? 0.f : acc[j];
                *(LAS unsigned short*)(PI + (16 * gi + tau) * PT + (16 * ji + c16) * 2) = (unsigned short)f2bf(val); }
        }
        __syncthreads();
        {
            const LAS unsigned char* vb = VT + (16 * wave + c16) * PT + 16 * kq;
            const bf16x8_t v0 = *(const LAS bf16x8_t*)(vb), v1 = *(const LAS bf16x8_t*)(vb + 64);
#pragma unroll
            for (int gi = 0; gi < 4; ++gi) {
                const LAS unsigned char* pb = PI + (16 * gi + c16) * PT + 16 * kq;
                f32x4 acc = mfma16(*(const LAS bf16x8_t*)(pb), v0, (f32x4){0.f, 0.f, 0.f, 0.f});
                if (gi >= 2) acc = mfma16(*(const LAS bf16x8_t*)(pb + 64), v1, acc);
                { v2u w; w.x = pk2(acc[0], acc[1]); w.y = pk2(acc[2], acc[3]); OI[((size_t)item * 8 + wave) * 256 + gi * 64 + lane] = w; }
            }
            bf16* dsp = DS + (size_t)item * 128 * 128 + (size_t)(16 * wave + c16) * 128 + 4 * kq;
#pragma unroll
            for (int m = 0; m < 8; ++m) {
                const LAS unsigned char* kb2 = KT + (16 * m + c16) * PT + 16 * kq;
                f32x4 acc = mfma16(*(const LAS bf16x8_t*)(kb2), v0, (f32x4){0.f, 0.f, 0.f, 0.f});
                acc = mfma16(*(const LAS bf16x8_t*)(kb2 + 64), v1, acc);
                v2u w; w.x = pk2(acc[0], acc[1]); w.y = pk2(acc[2], acc[3]);
                *(v2u*)(dsp + 16 * m) = w;
            }
        }
        __syncthreads();
    }
}
__device__ __forceinline__ void phase_gla_scan(PP p, int tid) {
    bf16* DS = (bf16*)(p->ws + WS_U + U_DS); const float* LAM = (const float*)(p->ws + WS_U + U_LAM);
    const int nthr = gridDim.x * NTHREADS;
    for (int e = blockIdx.x * NTHREADS + tid; e < 32 * 2048; e += nthr) {
        const int chain = e >> 11, el = e & 2047, h = chain & 7, db = chain >> 3, k8 = (el & 15) * 8;
        float s[8];
#pragma unroll
        for (int i = 0; i < 8; ++i) s[i] = 0.f;
        for (int c0 = 0; c0 < GLA_NCH; c0 += 6) {
            v4u d[6]; f32x4 l0[6], l1[6];
#pragma unroll
            for (int u = 0; u < 6; ++u) { const size_t item = ((size_t)db * GLA_NCH + c0 + u) * 8 + h;
                d[u] = *(const v4u*)(DS + item * 16384 + (size_t)el * 8); l0[u] = *(const f32x4*)(LAM + item * 128 + k8); l1[u] = *(const f32x4*)(LAM + item * 128 + k8 + 4); }
#pragma unroll
            for (int u = 0; u < 6; ++u) { const size_t item = ((size_t)db * GLA_NCH + c0 + u) * 8 + h;
                v4u o; o.x = pk2(s[0], s[1]); o.y = pk2(s[2], s[3]); o.z = pk2(s[4], s[5]); o.w = pk2(s[6], s[7]);
                *(v4u*)(DS + item * 16384 + (size_t)el * 8) = o;
                s[0] = l0[u].x * s[0] + bf2f(d[u].x & 0xffffu); s[1] = l0[u].y * s[1] + bf2f(d[u].x >> 16);
                s[2] = l0[u].z * s[2] + bf2f(d[u].y & 0xffffu); s[3] = l0[u].w * s[3] + bf2f(d[u].y >> 16);
                s[4] = l1[u].x * s[4] + bf2f(d[u].z & 0xffffu); s[5] = l1[u].y * s[5] + bf2f(d[u].z >> 16);
                s[6] = l1[u].z * s[6] + bf2f(d[u].w & 0xffffu); s[7] = l1[u].w * s[7] + bf2f(d[u].w >> 16); }
        }
    }
}
__device__ __forceinline__ void phase_gla_out(PP p, LAS unsigned char* lds, int tid, int lane, int wave) {
    const bf16* DS = (const bf16*)(p->ws + WS_U + U_DS); const v2u* OI = (const v2u*)(p->ws + WS_U + U_OI); const bf16* QT = (const bf16*)(p->ws + WS_U + U_QT);
    const bf16* Z = (const bf16*)(p->ws + WS_U + U_Z); bf16* A2 = (bf16*)(p->ws + WS_A2); const float* gn = p->in[I_HGGN];
    constexpr int PQ = 272;
    LAS unsigned char* QL = lds;
    LAS unsigned char* GL_ = lds + 2 * 64 * PQ;
    LAS unsigned char* OL = GL_ + 64 * PQ;
    LAS float* SSQ = (LAS float*)(OL + 64 * PQ);
    LAS float* RST = SSQ + 512;
    const int kq = lane >> 4, c16 = lane & 15;
    const int srow = tid >> 3, sch = tid & 7;
    constexpr int NIT = NBATCH * GLA_NCH * 8;
    struct Pre { v4u q[2][2]; v4u g[2]; bf16x8_t bv[2][4]; v2u ow[2][4]; };
    auto decode = [&](int it, int& h, int& jc, int& b, int (&item)[2], int& tok0) {
        h = it & 7; jc = (it >> 3) % GLA_NCH; b = (it >> 3) / GLA_NCH;
        const int cb = (jc < 4) ? 3 - jc : 135 - jc;
        item[0] = ((0 * 2 + b) * GLA_NCH + jc) * 8 + h; item[1] = ((1 * 2 + b) * GLA_NCH + cb) * 8 + h;
        tok0 = (jc < 4) ? NLAT + b * CTXL + 64 * jc : b * SEQ + 64 * (jc - 4); };
    auto fetch = [&](int it, Pre& P) {
        int h, jc, b, item[2], tok0; decode(it, h, jc, b, item, tok0);
#pragma unroll
        for (int d = 0; d < 2; ++d) {
            const v4u* qs = (const v4u*)(QT + (size_t)item[d] * 8192 + srow * 128 + sch * 16); P.q[d][0] = qs[0]; P.q[d][1] = qs[1];
            const bf16* sp = DS + (size_t)item[d] * 16384 + (size_t)(16 * wave + c16) * 128 + 8 * kq;
#pragma unroll
            for (int s2 = 0; s2 < 4; ++s2) P.bv[d][s2] = *(const bf16x8_t*)(sp + 32 * s2);
#pragma unroll
            for (int gi = 0; gi < 4; ++gi) P.ow[d][gi] = OI[((size_t)item[d] * 8 + wave) * 256 + gi * 64 + lane];
        }
        const v4u* gs = (const v4u*)(Z + (size_t)(tok0 + srow) * 5120 + 4096 + h * 128 + sch * 16); P.g[0] = gs[0]; P.g[1] = gs[1]; };
    Pre nx;
    if ((int)blockIdx.x < NIT) fetch(blockIdx.x, nx);
    for (int it = blockIdx.x; it < NIT; it += gridDim.x) {
        int h, jc, b, item[2], tok0; decode(it, h, jc, b, item, tok0);
#pragma unroll
        for (int d = 0; d < 2; ++d) { LAS v4u* dq = (LAS v4u*)(QL + d * 64 * PQ + srow * PQ + sch * 32); dq[0] = nx.q[d][0]; dq[1] = nx.q[d][1]; }
        { LAS v4u* dg = (LAS v4u*)(GL_ + srow * PQ + sch * 32); dg[0] = nx.g[0]; dg[1] = nx.g[1]; }
        bf16x8_t bv[2][4]; v2u ow[2][4];
#pragma unroll
        for (int d = 0; d < 2; ++d)
#pragma unroll
            for (int u = 0; u < 4; ++u) { bv[d][u] = nx.bv[d][u]; ow[d][u] = nx.ow[d][u]; }
        __syncthreads();
        if (it + (int)gridDim.x < NIT) fetch(it + gridDim.x, nx);
        f32x4 acc[2][4];
#pragma unroll
        for (int d = 0; d < 2; ++d)
#pragma unroll
            for (int gi = 0; gi < 4; ++gi) {
                const LAS unsigned char* qp = QL + d * 64 * PQ + (16 * gi + c16) * PQ + 16 * kq;
                f32x4 a4 = (f32x4){bf2f(ow[d][gi].x & 0xffffu), bf2f(ow[d][gi].x >> 16), bf2f(ow[d][gi].y & 0xffffu), bf2f(ow[d][gi].y >> 16)};
#pragma unroll
                for (int s2 = 0; s2 < 4; ++s2) a4 = mfma16(*(const LAS bf16x8_t*)(qp + 64 * s2), bv[d][s2], a4);
                acc[d][gi] = a4;
            }
        f32x4 o[4]; float ss[4][4];
#pragma unroll
        for (int gi = 0; gi < 4; ++gi)
#pragma unroll
            for (int j = 0; j < 4; ++j) { const float v = acc[0][gi][j] + __shfl_xor(acc[1][3 - gi][3 - j], 48); o[gi][j] = v;
                float q = v * v;
                q += __builtin_bit_cast(float, __builtin_amdgcn_update_dpp(0, __builtin_bit_cast(int, q), 0x128, 0xf, 0xf, false));
                q += __builtin_bit_cast(float, __builtin_amdgcn_update_dpp(0, __builtin_bit_cast(int, q), 0x124, 0xf, 0xf, false));
                q += __builtin_bit_cast(float, __builtin_amdgcn_update_dpp(0, __builtin_bit_cast(int, q), 0x122, 0xf, 0xf, false));
                q += __builtin_bit_cast(float, __builtin_amdgcn_update_dpp(0, __builtin_bit_cast(int, q), 0x121, 0xf, 0xf, false));
                ss[gi][j] = q; }
        if (c16 == 0) {
#pragma unroll
            for (int gi = 0; gi < 4; ++gi)
#pragma unroll
                for (int j = 0; j < 4; ++j) SSQ[(16 * gi + 4 * kq + j) * 8 + wave] = ss[gi][j]; }
        __syncthreads();
        if (tid < 64) { const f32x4 s0 = *(const LAS f32x4*)(SSQ + tid * 8), s1 = *(const LAS f32x4*)(SSQ + tid * 8 + 4);
            RST[tid] = rsqrtf(((s0[0] + s0[1]) + (s0[2] + s0[3]) + (s1[0] + s1[1]) + (s1[2] + s1[3])) * (1.0f / 128.0f) + NORM_EPS); }
        __syncthreads();
        const int vl = 16 * wave + c16; const float gw_ = gn[vl];
#pragma unroll
        for (int gi = 0; gi < 4; ++gi)
#pragma unroll
            for (int j = 0; j < 4; ++j) { const int tk = 16 * gi + 4 * kq + j;
                const float g = bf2f(*(const LAS unsigned short*)(GL_ + tk * PQ + vl * 2)); const float r = o[gi][j] * RST[tk] * gw_ * (g * sigm(g));
                *(LAS unsigned short*)(OL + tk * PQ + vl * 2) = (unsigned short)f2bf(r); }
        __syncthreads();
        { const LAS v4u* so = (const LAS v4u*)(OL + srow * PQ + sch * 32); v4u* dst = (v4u*)(A2 + (size_t)(tok0 + srow) * D + h * 128 + sch * 16); dst[0] = so[0]; dst[1] = so[1]; }
        __syncthreads();
    }
}

typedef short bf16x4_t __attribute__((ext_vector_type(4)));
typedef float f32x2_t __attribute__((ext_vector_type(2))); typedef __bf16 bf16x2v_t __attribute__((ext_vector_type(2)));
__device__ __forceinline__ unsigned cvtpk(float lo, float hi) { const f32x2_t v = {lo, hi}; const bf16x2v_t b = __builtin_convertvector(v, bf16x2v_t); return __builtin_bit_cast(unsigned, b); }
constexpr int R4_DOTA = 0, R4_UPA = 2048, R4_A1 = 4096, R4_A2 = 4352, R4_G7 = 4608, R4_VT = 4864, R4_IMG = 6912, R4_SLOT = 5376, R4_NCH = NSTEP / 8, R4_NCB = 8;
constexpr size_t U_IMG = 872 * MiB;
constexpr size_t U_YST = U_OD1;
__device__ __forceinline__ void phase_rw_prep(PP p, LAS unsigned char* lds, int lane, int wave) {
    const int gw = blockIdx.x * NWAVES + wave, NGW = gridDim.x * NWAVES;
    const bf16* RKV = (const bf16*)(p->ws + WS_U + U_RKV); unsigned char* IMG = p->ws + WS_U + U_IMG;
    LAS unsigned char* da = lds + wave * 8192; LAS unsigned char* gb = da + 2048; LAS float* GL = (LAS float*)(da + 4096);
    LAS unsigned char* a12 = da + 5120;
    const int m = lane & 15, q = lane >> 4;
    const int s2 = lane >> 5, tp = (lane >> 4) & 1, kq = (lane & 15) >> 2, ii = (lane & 3) + 4 * tp, dpos = ((s2 * 4 + kq) * 8 + ii) * 2;
    float nrx[8], nkx[8], nvx[8], nlw[8], nav[8];
    auto ld = [&](int it2) {
        const int chain = it2 & 63, chunk = it2 >> 6, b = chain >> 5, dir = (chain >> 4) & 1, h = chain & 15, ch = h * 64 + lane;
        const bf16* WDp = (const bf16*)(p->ws + WS_U + U_WD) + (size_t)dir * NROW * D; const bf16* ADp = (const bf16*)(p->ws + WS_U + U_AD) + (size_t)dir * NROW * D;
#pragma unroll
        for (int j = 0; j < 8; ++j) { const int row = step_row(b, dir, chunk * 8 + j);
            nrx[j] = bf2f(RKV[(size_t)row * 3072 + ch]); nkx[j] = bf2f(RKV[(size_t)row * 3072 + 1024 + ch]); nvx[j] = bf2f(RKV[(size_t)row * 3072 + 2048 + ch]);
            nlw[j] = bf2f(WDp[(size_t)row * D + ch]); nav[j] = bf2f(ADp[(size_t)row * D + ch]); } };
    if (gw < 64 * R4_NCH) ld(gw);
    for (int it = gw; it < 64 * R4_NCH; it += NGW) {
        const int chain = it & 63, chunk = it >> 6, h = chain & 15, ch = h * 64 + lane;
        const float kkw = p->in[I_KK][ch], kaw = p->in[I_KA][ch];
        float rx[8], kx[8], vx[8], lw[8], av[8], kn[8];
#pragma unroll
        for (int j = 0; j < 8; ++j) { rx[j] = nrx[j]; kx[j] = nkx[j]; vx[j] = nvx[j]; lw[j] = nlw[j]; av[j] = nav[j]; }
        if (it + NGW < 64 * R4_NCH) ld(it + NGW);
#pragma unroll
        for (int j = 0; j < 8; ++j) { const float t = kx[j] * kkw; kn[j] = t * __builtin_amdgcn_rsqf(fmaxf(wave_sum(t * t), 1e-24f)); }
        float bj[8]; { float bb = 0.f;
#pragma unroll
            for (int j = 0; j < 8; ++j) { bb += lw[j]; bj[j] = bb; } }
        const float e7 = __expf(bj[7]);
        unsigned upa[8]; float ebprev = 1.f;
#pragma unroll
        for (int j = 0; j < 8; ++j) {
            const float eb = __expf(bj[j]), einv = __builtin_amdgcn_rcpf(eb), e7j = e7 * einv;
            const float beta = kn[j] * av[j], kd = kx[j] * (1.f + (av[j] - 1.f) * kaw);
            *(LAS unsigned short*)(da + j * 128 + dpos) = (unsigned short)f2bf(kn[j] * ebprev);
            *(LAS unsigned short*)(da + (8 + j) * 128 + dpos) = (unsigned short)f2bf(rx[j] * eb);
            *(LAS unsigned short*)(gb + j * 128 + dpos) = (unsigned short)f2bf(beta * einv);
            *(LAS unsigned short*)(gb + (8 + j) * 128 + dpos) = (unsigned short)f2bf(kd * einv);
            const unsigned ub = f2bf(-beta * e7j), uk = f2bf(kd * e7j);
            if (j & 1) { upa[j >> 1] |= ub << 16; upa[4 + (j >> 1)] |= uk << 16; } else { upa[j >> 1] = ub; upa[4 + (j >> 1)] = uk; }
            ebprev = eb;
        }
        unsigned char* img = IMG + ((size_t)chain * R4_NCH + chunk) * R4_IMG;
        { v4u* d = (v4u*)(img + R4_UPA + lane * 32); d[0] = (v4u){upa[0], upa[1], upa[2], upa[3]}; d[1] = (v4u){upa[4], upa[5], upa[6], upa[7]}; }
        ((float*)(img + R4_G7))[lane] = e7;
        { f32x4* d = (f32x4*)(img + R4_VT + lane * 32); d[0] = (f32x4){vx[0], vx[1], vx[2], vx[3]}; d[1] = (f32x4){vx[4], vx[5], vx[6], vx[7]}; }
        LDS_WAIT(); asm volatile("" ::: "memory");
        { v4u* d = (v4u*)(img + R4_DOTA); d[lane] = ((const LAS v4u*)da)[lane]; d[64 + lane] = ((const LAS v4u*)da)[64 + lane]; }
        f32x4 G = (f32x4){0.f, 0.f, 0.f, 0.f};
#pragma unroll
        for (int s = 0; s < 2; ++s) G = mfma16(*(const LAS bf16x8_t*)(da + m * 128 + (s * 4 + q) * 16), *(const LAS bf16x8_t*)(gb + m * 128 + (s * 4 + q) * 16), G);
        if (m >= 8) { const int i = m - 8;
#pragma unroll
            for (int jp = 0; jp < 4; ++jp) { const int row = 4 * q + jp; const bool keep = (row < 8) ? (i < row) : (i <= row - 8);
                *(LAS unsigned short*)(a12 + row * 16 + i * 2) = (unsigned short)f2bf(keep ? G[jp] : 0.f); } }
#pragma unroll
        for (int jp = 0; jp < 4; ++jp) GL[(4 * q + jp) * 16 + m] = G[jp];
        LDS_WAIT(); asm volatile("" ::: "memory");
        const int c = lane & 7; float Tc[8], M2[8];
#pragma unroll
        for (int j = 0; j < 8; ++j) { float t = (j == c) ? 1.f : 0.f; const f32x4 ra = *(const LAS f32x4*)(GL + j * 16), rb = *(const LAS f32x4*)(GL + j * 16 + 4);
#pragma unroll
            for (int i = 0; i < j; ++i) t -= (i < 4 ? ra[i & 3] : rb[i & 3]) * Tc[i];
            Tc[j] = t; }
#pragma unroll
        for (int j = 0; j < 8; ++j) { float t = 0.f; const f32x4 ra = *(const LAS f32x4*)(GL + (8 + j) * 16), rb = *(const LAS f32x4*)(GL + (8 + j) * 16 + 4);
#pragma unroll
            for (int i = 0; i <= j; ++i) t -= (i < 4 ? ra[i & 3] : rb[i & 3]) * Tc[i];
            M2[j] = t; }
        if (lane < 8) {
#pragma unroll
            for (int j = 0; j < 8; ++j) { *(LAS unsigned short*)(a12 + 256 + j * 16 + c * 2) = (unsigned short)f2bf(Tc[j]); *(LAS unsigned short*)(a12 + 256 + (8 + j) * 16 + c * 2) = (unsigned short)f2bf(M2[j]); } }
        LDS_WAIT(); asm volatile("" ::: "memory");
        if (lane < 32) ((v4u*)(img + R4_A1))[lane] = ((const LAS v4u*)a12)[lane];
        LDS_WAIT(); asm volatile("" ::: "memory");
    }
}
constexpr int R4L_NCB = 6, R4L_SLOT = 6144;
__device__ __forceinline__ void phase_rwkv_scan4(PP p, LAS unsigned char* lds, int vcu, int tid, int lane, int wave) {
    const int m = lane & 15, q = lane >> 4;
    const unsigned char* IMG = p->ws + WS_U + U_IMG;
    for (int unit = vcu; unit < 256; unit += gridDim.x) {
        const int chain = unit >> 2, slab = unit & 3, b = chain >> 5, dir = (chain >> 4) & 1, h = chain & 15;
        float* YST = (float*)(p->ws + WS_U + U_YST) + (size_t)unit * NSTEP * 16 + (q >= 2 ? 4 * (q - 2) : 0) * 16 + m;
        const unsigned char* cimg = IMG + (size_t)chain * R4_NCH * R4_IMG;
        f32x4 S[4];
#pragma unroll
        for (int T = 0; T < 4; ++T) S[T] = (f32x4){0.f, 0.f, 0.f, 0.f};
        v2u idf; { const int c0 = 4 * q; idf.x = ((c0 == m) ? 0x3F80u : 0u) | ((c0 + 1 == m) ? 0x3F800000u : 0u); idf.y = ((c0 + 2 == m) ? 0x3F80u : 0u) | ((c0 + 3 == m) ? 0x3F800000u : 0u); }
        auto issue = [&](int bt) {
#pragma unroll
            for (int k = 0; k < 2 * R4L_NCB; ++k) { const int ii = (wave - 1) + 3 * k, cc = ii / 6, part = ii - cc * 6, pi = part * 64 + lane;
                const unsigned char* src = cimg + (size_t)(bt * R4L_NCB + cc) * R4_IMG + (pi < 304 ? pi * 16 : (pi < 336 ? R4_VT + slab * 512 + (pi - 304) * 16 : 0));
                __builtin_amdgcn_global_load_lds((const unsigned*)src, (LAS unsigned*)(lds + ((bt & 1) * R4L_NCB + cc) * R4L_SLOT + part * 1024), 16, 0, 0); } };
        float crg[32]; int cit = (int)(blockIdx.x * 4 + (wave - 4)); ConvJob cj; bool cpend = false, cloaded = false;
        LAS float* cscr = (LAS float*)(lds + 2 * R4L_NCB * R4L_SLOT + (wave & 3) * 8448);
        if (wave >= 4 && cit < IT_L1MOE) { cj = conv_job_l1(p, cit); ti_load(cj.src, cj.src_ld, lane, crg); cpend = true; cloaded = true; }
        __syncthreads();
        if (wave >= 1 && wave < 4) { issue(0); asm volatile("s_waitcnt vmcnt(0)" ::: "memory"); }
        __syncthreads();
        constexpr int NB4 = R4_NCH / R4L_NCB;
        for (int bt = 0; bt < NB4; ++bt) {
            if (wave >= 4) {
                const int ph3 = bt % 3;
                if (ph3 == 0) { if (cpend && cloaded) { ti_store(true, cj.fp8, crg, cj.dst, cj.dst_ldb, cscr, lane); cloaded = false; cit += 4 * (int)gridDim.x; cpend = cit < IT_L1MOE; } }
                else if (ph3 == 1) { if (cpend && !cloaded) { cj = conv_job_l1(p, cit); ti_load(cj.src, cj.src_ld, lane, crg); cloaded = true; } } }
            else if (wave >= 1) { if (bt + 1 < NB4) issue(bt + 1); asm volatile("s_waitcnt vmcnt(0)" ::: "memory"); }
            else {
                __builtin_amdgcn_s_setprio(3);
                struct Ops { bf16x8_t a0, a1; v2u A1u, A2u; bf16x4_t UA[4]; f32x4 g7[4]; f32x4 vr; };
                auto rd = [&](int cc, Ops& o) {
                    const LAS unsigned char* sl = lds + ((bt & 1) * R4L_NCB + cc) * R4L_SLOT;
                    o.a0 = *(const LAS bf16x8_t*)(sl + R4_DOTA + m * 128 + q * 16); o.a1 = *(const LAS bf16x8_t*)(sl + R4_DOTA + m * 128 + (4 + q) * 16);
                    o.A1u = *(const LAS v2u*)(sl + R4_A1 + m * 16 + (q & 1) * 8); o.A2u = *(const LAS v2u*)(sl + R4_A2 + m * 16 + (q & 1) * 8);
#pragma unroll
                    for (int T = 0; T < 4; ++T) { o.UA[T] = *(const LAS bf16x4_t*)(sl + R4_UPA + (16 * T + m) * 32 + q * 8); o.g7[T] = *(const LAS f32x4*)(sl + R4_G7 + (16 * T + 4 * q) * 4); }
                    o.vr = *(const LAS f32x4*)(sl + R4_VT + m * 32 + (q & 1) * 16); };
                Ops cur, nxt; rd(0, cur);
#pragma unroll
                for (int cc = 0; cc < R4L_NCB; ++cc) {
                    if (cc + 1 < R4L_NCB) rd(cc + 1, nxt);
                    __builtin_amdgcn_sched_barrier(0);
                    v2u A1u = cur.A1u, A2u = cur.A2u;
                    if (q >= 2) { A1u = (v2u){0u, 0u}; A2u = idf; }
                    v4u b0, b1;
                    b0.x = cvtpk(S[0][0], S[0][1]); b0.y = cvtpk(S[0][2], S[0][3]); b0.z = cvtpk(S[1][0], S[1][1]); b0.w = cvtpk(S[1][2], S[1][3]);
                    b1.x = cvtpk(S[2][0], S[2][1]); b1.y = cvtpk(S[2][2], S[2][3]); b1.z = cvtpk(S[3][0], S[3][1]); b1.w = cvtpk(S[3][2], S[3][3]);
                    f32x4 Dd = mfma16(cur.a0, __builtin_bit_cast(bf16x8_t, b0), (f32x4){0.f, 0.f, 0.f, 0.f});
                    Dd = mfma16(cur.a1, __builtin_bit_cast(bf16x8_t, b1), Dd);
                    v2u vb; vb.x = cvtpk(cur.vr[0], cur.vr[1]); vb.y = cvtpk(cur.vr[2], cur.vr[3]);
                    const f32x4 Z = __builtin_amdgcn_mfma_f32_16x16x16bf16_1k(__builtin_bit_cast(bf16x4_t, A1u), __builtin_bit_cast(bf16x4_t, vb), Dd, 0, 0, 0);
                    v2u zb; zb.x = cvtpk(Z[0], Z[1]); zb.y = cvtpk(Z[2], Z[3]);
                    const f32x4 W = __builtin_amdgcn_mfma_f32_16x16x16bf16_1k(__builtin_bit_cast(bf16x4_t, A2u), __builtin_bit_cast(bf16x4_t, zb), (f32x4){0.f, 0.f, 0.f, 0.f}, 0, 0, 0);
                    v2u wb; wb.x = cvtpk(W[0], W[1]); wb.y = cvtpk(W[2], W[3]);
                    const v2u ub = (q < 2) ? wb : vb;
#pragma unroll
                    for (int T = 0; T < 4; ++T) S[T] = __builtin_amdgcn_mfma_f32_16x16x16bf16_1k(cur.UA[T], __builtin_bit_cast(bf16x4_t, ub), S[T] * cur.g7[T], 0, 0, 0);
                    if (q >= 2) { float* yp = YST + (size_t)(bt * R4L_NCB + cc) * 128;
#pragma unroll
                        for (int i = 0; i < 4; ++i) yp[i * 16] = W[i]; }
                    if (cc + 1 < R4L_NCB) cur = nxt;
                }
            }
            asm volatile("s_waitcnt lgkmcnt(0)" ::: "memory"); __builtin_amdgcn_s_barrier(); asm volatile("" ::: "memory");
        }
        if (wave >= 4) { while (cpend) { if (!cloaded) { cj = conv_job_l1(p, cit); ti_load(cj.src, cj.src_ld, lane, crg); } ti_store(true, cj.fp8, crg, cj.dst, cj.dst_ldb, cscr, lane); cloaded = false; cit += 4 * (int)gridDim.x; cpend = cit < IT_L1MOE; } }
    }
}

__device__ __forceinline__ void phase_lora2(PP p, LAS unsigned char* lds, int tid, int lane, int wave) {
    const bf16* L1 = (const bf16*)(p->ws + WS_U + U_L1); const bf16* W2 = (const bf16*)(p->ws + WS_WL2);
    const int c16 = lane & 15, kq = lane >> 4;
    const int part = blockIdx.x % 12, wgp = blockIdx.x / 12, nwg = (gridDim.x - part + 11) / 12;
    const int blk = (part < 8) ? (part >> 1) : 4, col0 = (part < 8) ? (part & 1) * 512 : (part - 8) * 256, ncol = (part < 8) ? 512 : 256;
    const int koff = (blk < 4) ? blk * 64 : 256, nks = (blk < 4) ? 2 : 4, K = nks * 32, WP = K * 2 + 16;
    LAS unsigned char* wl = lds;
    constexpr int PS = 272;
    LAS unsigned char* stg = lds + 73728 + wave * (16 * PS);
    { const int ppr = K / 8;
#pragma unroll 8
      for (int u = tid; u < ncol * ppr; u += NTHREADS) { const int c = u / ppr, pc = u - c * ppr;
          *(LAS v4u*)(wl + c * WP + pc * 16) = *(const v4u*)(W2 + (size_t)(blk * 1024 + col0 + c) * 384 + koff + pc * 8); } }
    const float* bias = ((blk < 2) ? p->in[I_DECW0] + blk * D : p->in[I_A0] + ((blk - 2) & 1) * D) + col0;
    LAS float* bl = (LAS float*)(lds + 108544);
    if (blk < 4) { for (int u = tid; u < ncol; u += NTHREADS) bl[u] = bias[u]; }
    __syncthreads();
    bf16* dstb = (bf16*)(p->ws + WS_U + ((blk < 2) ? U_WD : (blk < 4) ? U_AD : U_G)) + (size_t)((blk < 4) ? (blk & 1) : 0) * NROW * D + col0;
    for (int rt = wgp * NWAVES + wave; rt < NROW / 16; rt += nwg * NWAVES) {
        const bf16* lp = L1 + (size_t)(rt * 16 + c16) * 384 + koff + 8 * kq;
        bf16x8_t bfr[4];
#pragma unroll
        for (int s = 0; s < 4; ++s) if (s < nks) bfr[s] = *(const bf16x8_t*)(lp + 32 * s);
        bf16* dst = dstb + (size_t)(rt * 16) * D;
        for (int ps = 0; ps < ncol / 128; ++ps) {
#pragma unroll 4
            for (int ct = 0; ct < 8; ++ct) {
                const int c0 = ps * 128 + ct * 16;
                const LAS unsigned char* wp = wl + (c0 + c16) * WP + 16 * kq;
                f32x4 acc = (f32x4){0.f, 0.f, 0.f, 0.f};
#pragma unroll
                for (int s = 0; s < 4; ++s) if (s < nks) acc = mfma16(*(const LAS bf16x8_t*)(wp + 64 * s), bfr[s], acc);
                const f32x4 bb = (blk < 4) ? *(const LAS f32x4*)(bl + c0 + 4 * kq) : (f32x4){0.f, 0.f, 0.f, 0.f};
                if (blk < 2) { for (int j = 0; j < 4; ++j) acc[j] = -0.60653066f * sigm(acc[j] + bb[j]); }
                else if (blk < 4) { for (int j = 0; j < 4; ++j) acc[j] = sigm(acc[j] + bb[j]); }
                v2u w; w.x = pk2(acc[0], acc[1]); w.y = pk2(acc[2], acc[3]);
                *(LAS v2u*)(stg + c16 * PS + (ct * 16 + 4 * kq) * 2) = w;
            }
            LDS_WAIT(); asm volatile("" ::: "memory");
#pragma unroll
            for (int i = 0; i < 4; ++i) { const int row = 4 * i + (lane >> 4), cb = lane & 15;
                *(v4u*)(dst + (size_t)row * D + ps * 128 + cb * 8) = *(const LAS v4u*)(stg + row * PS + cb * 16); }
            LDS_WAIT(); asm volatile("" ::: "memory");
        }
    }
    __syncthreads();
}

constexpr int R5_DOTA = 0, R5_UPA = 4096, R5_A21 = 8192, R5_A2 = 9216, R5_GE = 10240, R5_VT = 10496, R5_IMG = 12544, R5_NCH = NSTEP / 16, R5_NCB = 3, R5_SLOT = 12288, R5_NST = 3;
__device__ __forceinline__ void phase_rw_prep5(PP p, LAS unsigned char* lds, int lane, int wave) {
    const int gw = blockIdx.x * NWAVES + wave, NGW = gridDim.x * NWAVES;
    const bf16* RKV = (const bf16*)(p->ws + WS_U + U_RKV); unsigned char* IMG = p->ws + WS_U + U_IMG;
    LAS unsigned char* da = lds + wave * 14336;
    LAS unsigned char* gb = da + 4096; LAS float* GL = (LAS float*)(da + 8192); LAS unsigned char* a12 = da + 12288; LAS float* TM = (LAS float*)gb;
    const int m = lane & 15, q = lane >> 4;
    const int s2 = lane >> 5, tp = (lane >> 4) & 1, kq = (lane & 15) >> 2, ii = (lane & 3) + 4 * tp, dpos = ((s2 * 4 + kq) * 8 + ii) * 2;
    float nrx[16], nkx[16], nvx[16], nlw[16], nav[16];
    auto ld = [&](int it2) {
        const int chain = it2 & 63, chunk = it2 >> 6, b = chain >> 5, dir = (chain >> 4) & 1, h = chain & 15, ch = h * 64 + lane;
        const bf16* WDp = (const bf16*)(p->ws + WS_U + U_WD) + (size_t)dir * NROW * D; const bf16* ADp = (const bf16*)(p->ws + WS_U + U_AD) + (size_t)dir * NROW * D;
#pragma unroll
        for (int j = 0; j < 16; ++j) { const int row = step_row(b, dir, chunk * 16 + j);
            nrx[j] = bf2f(RKV[(size_t)row * 3072 + ch]); nkx[j] = bf2f(RKV[(size_t)row * 3072 + 1024 + ch]); nvx[j] = bf2f(RKV[(size_t)row * 3072 + 2048 + ch]);
            nlw[j] = bf2f(WDp[(size_t)row * D + ch]); nav[j] = bf2f(ADp[(size_t)row * D + ch]); } };
    if (gw < 64 * R5_NCH) ld(gw);
    const float kkw = p->in[I_KK][((gw & 63) & 15) * 64 + lane], kaw = p->in[I_KA][((gw & 63) & 15) * 64 + lane];
    for (int it = gw; it < 64 * R5_NCH; it += NGW) {
        const int chain = it & 63, chunk = it >> 6, h = chain & 15, ch = h * 64 + lane;
        unsigned char* img = IMG + ((size_t)chain * R5_NCH + chunk) * R5_IMG;
        float upf[32]; float bb = 0.f, ebprev = 1.f, eb = 1.f;
#pragma unroll
        for (int j = 0; j < 16; ++j) {
            const float t = nkx[j] * kkw; const float kn = t * __builtin_amdgcn_rsqf(fmaxf(wave_sum(t * t), 1e-24f));
            bb += nlw[j]; eb = __expf(bb); const float einv = __builtin_amdgcn_rcpf(eb);
            const float beta = kn * nav[j], kdv = nkx[j] * (1.f + (nav[j] - 1.f) * kaw);
            *(LAS unsigned short*)(da + j * 128 + dpos) = (unsigned short)f2bf(kn * ebprev);
            *(LAS unsigned short*)(da + (16 + j) * 128 + dpos) = (unsigned short)f2bf(nrx[j] * eb);
            *(LAS unsigned short*)(gb + j * 128 + dpos) = (unsigned short)f2bf(beta * einv);
            *(LAS unsigned short*)(gb + (16 + j) * 128 + dpos) = (unsigned short)f2bf(kdv * einv);
            upf[8 * (j >> 2) + (j & 3)] = -beta * einv; upf[8 * (j >> 2) + 4 + (j & 3)] = kdv * einv;
            ebprev = eb;
        }
        const float eE = eb;
        { v4u* d = (v4u*)(img + R5_UPA + lane * 16);
#pragma unroll
          for (int u = 0; u < 4; ++u) d[64 * u] = (v4u){pk2(upf[8 * u] * eE, upf[8 * u + 1] * eE), pk2(upf[8 * u + 2] * eE, upf[8 * u + 3] * eE), pk2(upf[8 * u + 4] * eE, upf[8 * u + 5] * eE), pk2(upf[8 * u + 6] * eE, upf[8 * u + 7] * eE)}; }
        ((float*)(img + R5_GE))[lane] = eE;
        { v2u* d = (v2u*)(img + R5_VT + (lane >> 4) * 512 + (lane & 15) * 8);
#pragma unroll
          for (int u = 0; u < 4; ++u) d[16 * u] = (v2u){pk2(nvx[4 * u], nvx[4 * u + 1]), pk2(nvx[4 * u + 2], nvx[4 * u + 3])}; }
        if (it + NGW < 64 * R5_NCH) ld(it + NGW);
        LDS_WAIT(); asm volatile("" ::: "memory");
        { v4u* d = (v4u*)(img + R5_DOTA);
#pragma unroll
          for (int u = 0; u < 4; ++u) d[64 * u + lane] = ((const LAS v4u*)da)[64 * u + lane]; }
#pragma unroll
        for (int rb = 0; rb < 2; ++rb)
#pragma unroll
            for (int cb = 0; cb < 2; ++cb) { f32x4 Gt = (f32x4){0.f, 0.f, 0.f, 0.f};
#pragma unroll
                for (int s = 0; s < 2; ++s) Gt = mfma16(*(const LAS bf16x8_t*)(da + (16 * rb + m) * 128 + (s * 4 + q) * 16), *(const LAS bf16x8_t*)(gb + (16 * cb + m) * 128 + (s * 4 + q) * 16), Gt);
#pragma unroll
                for (int jp = 0; jp < 4; ++jp) GL[(16 * rb + 4 * q + jp) * 32 + 16 * cb + m] = Gt[jp]; }
        LDS_WAIT(); asm volatile("" ::: "memory");
        const int c = lane & 15; float Tc[16], M2[16];
#pragma unroll
        for (int j = 0; j < 16; ++j) { float t = (j == c) ? 1.f : 0.f;
#pragma unroll
            for (int i4 = 0; i4 < (j + 3) / 4; ++i4) { const f32x4 rr = *(const LAS f32x4*)(GL + j * 32 + 4 * i4);
#pragma unroll
                for (int e = 0; e < 4; ++e) if (4 * i4 + e < j) t -= rr[e] * Tc[4 * i4 + e]; }
            Tc[j] = t; }
#pragma unroll
        for (int j = 0; j < 16; ++j) { float t = 0.f;
#pragma unroll
            for (int i4 = 0; i4 < (j + 4) / 4; ++i4) { const f32x4 rr = *(const LAS f32x4*)(GL + (16 + j) * 32 + 4 * i4);
#pragma unroll
                for (int e = 0; e < 4; ++e) if (4 * i4 + e <= j) t -= rr[e] * Tc[4 * i4 + e]; }
            M2[j] = t; }
        if (lane < 16) {
#pragma unroll
            for (int j = 0; j < 16; ++j) { *(LAS unsigned short*)(a12 + 1024 + j * 32 + c * 2) = (unsigned short)f2bf(Tc[j]); *(LAS unsigned short*)(a12 + 1024 + (16 + j) * 32 + c * 2) = (unsigned short)f2bf(M2[j]);
                TM[j * 16 + c] = Tc[j]; TM[(16 + j) * 16 + c] = M2[j]; } }
        LDS_WAIT(); asm volatile("" ::: "memory");
        { const int r = lane >> 1, i0 = 8 * (lane & 1); float e8[8];
#pragma unroll
          for (int x = 0; x < 8; ++x) e8[x] = 0.f;
#pragma unroll
          for (int mm = 1; mm < 16; ++mm) { const float tv = TM[r * 16 + mm]; const f32x4 ca = *(const LAS f32x4*)(GL + mm * 32 + 16 + i0), cb4 = *(const LAS f32x4*)(GL + mm * 32 + 16 + i0 + 4);
#pragma unroll
              for (int x = 0; x < 4; ++x) { e8[x] += (i0 + x < mm) ? tv * ca[x] : 0.f; e8[4 + x] += (i0 + 4 + x < mm) ? tv * cb4[x] : 0.f; } }
          if (r >= 16) { const int jj = r - 16; const f32x4 da4 = *(const LAS f32x4*)(GL + r * 32 + 16 + i0), db4 = *(const LAS f32x4*)(GL + r * 32 + 16 + i0 + 4);
#pragma unroll
              for (int x = 0; x < 4; ++x) { e8[x] += (i0 + x <= jj) ? da4[x] : 0.f; e8[4 + x] += (i0 + 4 + x <= jj) ? db4[x] : 0.f; } }
          *(LAS v4u*)(a12 + r * 32 + i0 * 2) = (v4u){pk2(e8[0], e8[1]), pk2(e8[2], e8[3]), pk2(e8[4], e8[5]), pk2(e8[6], e8[7])}; }
        LDS_WAIT(); asm volatile("" ::: "memory");
        { v4u* d = (v4u*)(img + R5_A21); d[lane] = ((const LAS v4u*)a12)[lane]; d[64 + lane] = ((const LAS v4u*)a12)[64 + lane]; }
        LDS_WAIT(); asm volatile("" ::: "memory");
    }
}
constexpr int R7_SLOT = 12288, R7_NPC = 12;
__device__ __forceinline__ void phase_rwkv_scan7(PP p, LAS unsigned char* lds, int vcu, int tid, int lane, int wave) {
    const int m = lane & 15, q = lane >> 4;
    constexpr int NB5 = R5_NCH / R5_NCB;
    const int nsc = ((int)gridDim.x + 1) >> 1, ncv = (int)gridDim.x >> 1;
    if (vcu & 1) {
        LAS float* scr = (LAS float*)(lds + wave * 16384);
        const int cw = vcu >> 1, NGW = ncv * NWAVES; int it = cw * NWAVES + wave;
#ifdef PROBE_NOCONV_REPEAT
        if (*(volatile LAS int*)(lds + LDS_BYTES - 32) != 0) it = IT_L1MOE;
#endif
        ConvJob j0{}, j1{}, j2{}; f32x4 r0[8], r1[8], r2[8];
        if (it < IT_L1MOE) { j0 = conv_job_l1(p, it); ti_load4(j0.src, j0.src_ld, lane, r0); }
        if (it + NGW < IT_L1MOE) { j1 = conv_job_l1(p, it + NGW); ti_load4(j1.src, j1.src_ld, lane, r1); }
        if (it + 2 * NGW < IT_L1MOE) { j2 = conv_job_l1(p, it + 2 * NGW); ti_load4(j2.src, j2.src_ld, lane, r2); }
        for (; it < IT_L1MOE; it += 3 * NGW) {
            { const ConvJob cj = j0; f32x4 c[8];
#pragma unroll
              for (int i = 0; i < 8; ++i) c[i] = r0[i];
              if (it + 3 * NGW < IT_L1MOE) { j0 = conv_job_l1(p, it + 3 * NGW); ti_load4(j0.src, j0.src_ld, lane, r0); }
              ti_store4_fp8(c, cj.dst, cj.dst_ldb, scr, lane); }
            if (it + NGW < IT_L1MOE) { const ConvJob cj = j1; f32x4 c[8];
#pragma unroll
              for (int i = 0; i < 8; ++i) c[i] = r1[i];
              if (it + 4 * NGW < IT_L1MOE) { j1 = conv_job_l1(p, it + 4 * NGW); ti_load4(j1.src, j1.src_ld, lane, r1); }
              ti_store4_fp8(c, cj.dst, cj.dst_ldb, scr, lane); }
            if (it + 2 * NGW < IT_L1MOE) { const ConvJob cj = j2; f32x4 c[8];
#pragma unroll
              for (int i = 0; i < 8; ++i) c[i] = r2[i];
              if (it + 5 * NGW < IT_L1MOE) { j2 = conv_job_l1(p, it + 5 * NGW); ti_load4(j2.src, j2.src_ld, lane, r2); }
              ti_store4_fp8(c, cj.dst, cj.dst_ldb, scr, lane); }
        }
        return;
    }
    const unsigned char* IMG = p->ws + WS_U + U_IMG;
    for (int su = vcu >> 1; su < 128; su += nsc) {
        const int chain = su >> 1, pair = su & 1;
        const unsigned char* cimg = IMG + (size_t)chain * R5_NCH * R5_IMG;
        const int li = (wave == 2) ? 0 : (wave == 3) ? 1 : (wave == 6) ? 2 : -1;
        auto issue = [&](int bt) {
            const unsigned char* ci = cimg + (size_t)(bt * R5_NCB + li) * R5_IMG;
            LAS unsigned char* dl = lds + ((bt % R5_NST) * R5_NCB + li) * R7_SLOT;
#pragma unroll
            for (int k = 0; k < R7_NPC; ++k) { const int pi = k * 64 + lane;
                const unsigned char* src = ci + (pi < 656 ? pi * 16 : (pi < 720 ? R5_VT + pair * 1024 + (pi - 656) * 16 : 0));
                __builtin_amdgcn_global_load_lds((const unsigned*)src, (LAS unsigned*)(dl + k * 1024), 16, 0, 0); } };
        __syncthreads();
        if (li >= 0) { issue(0); issue(1); asm volatile("s_waitcnt vmcnt(12)" ::: "memory"); }
        __syncthreads();
        if (wave >= 2) {
            if (li >= 0) {
                for (int bt = 0; bt < NB5; ++bt) {
                    if (bt + 2 < NB5) { issue(bt + 2); asm volatile("s_waitcnt vmcnt(12)" ::: "memory"); } else asm volatile("s_waitcnt vmcnt(0)" ::: "memory");
                    asm volatile("s_waitcnt lgkmcnt(0)" ::: "memory"); __builtin_amdgcn_s_barrier(); asm volatile("" ::: "memory");
                }
            } else {
                for (int bt = 0; bt < NB5; ++bt) { asm volatile("s_waitcnt lgkmcnt(0)" ::: "memory"); __builtin_amdgcn_s_barrier(); asm volatile("" ::: "memory"); }
            }
        } else {
            const int unit = chain * 4 + pair * 2 + wave;
            float* YST = (float*)(p->ws + WS_U + U_YST) + (size_t)unit * NSTEP * 16 + (4 * q) * 16 + m;
            f32x4 S[4];
#pragma unroll
            for (int T = 0; T < 4; ++T) S[T] = (f32x4){0.f, 0.f, 0.f, 0.f};
            __builtin_amdgcn_s_setprio(3);
            for (int bt = 0; bt < NB5; ++bt) {
                struct OpsE { bf16x8_t a[2][2]; bf16x4_t e21[2]; v2u vr; };
                struct OpsL { bf16x4_t a2[2]; bf16x8_t UA[4]; f32x4 ge[4]; };
                auto rdE = [&](int cc, OpsE& o) {
                    const LAS unsigned char* sl = lds + ((bt % R5_NST) * R5_NCB + cc) * R7_SLOT;
#pragma unroll
                    for (int rb = 0; rb < 2; ++rb) {
#pragma unroll
                        for (int s = 0; s < 2; ++s) o.a[rb][s] = *(const LAS bf16x8_t*)(sl + R5_DOTA + (16 * rb + m) * 128 + (s * 4 + q) * 16);
                        o.e21[rb] = *(const LAS bf16x4_t*)(sl + R5_A21 + (16 * rb + m) * 32 + q * 8); }
                    o.vr = *(const LAS v2u*)(sl + R5_VT + wave * 512 + q * 128 + m * 8); };
                auto rdL = [&](int cc, OpsL& o) {
                    const LAS unsigned char* sl = lds + ((bt % R5_NST) * R5_NCB + cc) * R7_SLOT;
#pragma unroll
                    for (int rb = 0; rb < 2; ++rb) o.a2[rb] = *(const LAS bf16x4_t*)(sl + R5_A2 + (16 * rb + m) * 32 + q * 8);
#pragma unroll
                    for (int T = 0; T < 4; ++T) { o.UA[T] = *(const LAS bf16x8_t*)(sl + R5_UPA + q * 1024 + (16 * T + m) * 16); o.ge[T] = *(const LAS f32x4*)(sl + R5_GE + (16 * T + 4 * q) * 4); } };
                OpsE cur, nxt; OpsL L; rdE(0, cur);
#pragma unroll
                for (int cc = 0; cc < R5_NCB; ++cc) {
                    rdL(cc, L);
                    if (cc + 1 < R5_NCB) rdE(cc + 1, nxt);
                    __builtin_amdgcn_sched_barrier(0);
                    v4u b0, b1;
                    b0.x = cvtpk(S[0][0], S[0][1]); b0.y = cvtpk(S[0][2], S[0][3]); b0.z = cvtpk(S[1][0], S[1][1]); b0.w = cvtpk(S[1][2], S[1][3]);
                    b1.x = cvtpk(S[2][0], S[2][1]); b1.y = cvtpk(S[2][2], S[2][3]); b1.z = cvtpk(S[3][0], S[3][1]); b1.w = cvtpk(S[3][2], S[3][3]);
                    const f32x4 z4 = (f32x4){0.f, 0.f, 0.f, 0.f};
                    const v2u vb = cur.vr;
                    f32x4 D0 = mfma16(cur.a[0][0], __builtin_bit_cast(bf16x8_t, b0), z4), D1 = mfma16(cur.a[1][0], __builtin_bit_cast(bf16x8_t, b0), z4);
                    const f32x4 E0 = __builtin_amdgcn_mfma_f32_16x16x16bf16_1k(cur.e21[0], __builtin_bit_cast(bf16x4_t, vb), z4, 0, 0, 0);
                    D0 = mfma16(cur.a[0][1], __builtin_bit_cast(bf16x8_t, b1), D0); D1 = mfma16(cur.a[1][1], __builtin_bit_cast(bf16x8_t, b1), D1);
                    const f32x4 E1 = __builtin_amdgcn_mfma_f32_16x16x16bf16_1k(cur.e21[1], __builtin_bit_cast(bf16x4_t, vb), D1, 0, 0, 0);
                    v2u db; db.x = cvtpk(D0[0], D0[1]); db.y = cvtpk(D0[2], D0[3]);
                    const f32x4 W0 = __builtin_amdgcn_mfma_f32_16x16x16bf16_1k(L.a2[0], __builtin_bit_cast(bf16x4_t, db), E0, 0, 0, 0);
                    const f32x4 W1 = __builtin_amdgcn_mfma_f32_16x16x16bf16_1k(L.a2[1], __builtin_bit_cast(bf16x4_t, db), E1, 0, 0, 0);
                    v4u ub; ub.x = cvtpk(W0[0], W0[1]); ub.y = cvtpk(W0[2], W0[3]); ub.z = vb.x; ub.w = vb.y;
#pragma unroll
                    for (int T = 0; T < 4; ++T) S[T] = mfma16(L.UA[T], __builtin_bit_cast(bf16x8_t, ub), S[T] * L.ge[T]);
                    { float* yp = YST + (size_t)(bt * R5_NCB + cc) * 256;
#pragma unroll
                      for (int i = 0; i < 4; ++i) yp[i * 16] = W1[i]; }
                    if (cc + 1 < R5_NCB) cur = nxt;
                }
                asm volatile("s_waitcnt lgkmcnt(0)" ::: "memory"); __builtin_amdgcn_s_barrier(); asm volatile("" ::: "memory");
            }
            __builtin_amdgcn_s_setprio(0);
        }
    }
}
enum { PH_PRE = 0, PH_NORM0, PH_G_IN, PH_GLA_A, PH_GLA_B, PH_GLA_C, PH_G_HGO, PH_FFN0, PH_GU0, PH_DN0, PH_COMB0,
       PH_LERP, PH_G_RKV, PH_G_L2, PH_RWPREP, PH_RWSCAN, PH_RWRO, PH_G_RWO, PH_FFN1, PH_GU1, PH_DN1, PH_COMB1, NPHASES };

template <int ph> __device__ __forceinline__ void run_phase(PP p, LAS unsigned char* lds, int tid, int lane, int wave, int G, int bx, int vcu) {
    unsigned char* ws = p->ws;
    typedef pg8::bf16_t bt;
    switch (ph) {
        case PH_PRE: phase_pre(p, lds, tid, lane, wave); break;
        case PH_NORM0: phase_norm0(p, lane, wave); break;
        case PH_G_IN: {
            pg8::Gemm g{(const bt*)(ws + WS_H), (const bt*)(ws + WS_WIN), NROW, 5120, D / 2}; pg8::StaticOrder S; S.init(NROW, 5120, G, bx);
            pg8::EpiStoreBf16 E{(bt*)(ws + WS_U + U_Z), 5120};
            pg8::gemm_phase<pg8::EpiStoreBf16, pg8::StaticOrder, true, true, true>(lds, g, S, E); } break;
        case PH_GLA_A: phase_gla_prep(p, lds, tid, lane, wave); break;
        case PH_GLA_B: phase_gla_scan(p, tid); break;
        case PH_GLA_C: phase_gla_out(p, lds, tid, lane, wave); break;
        case PH_G_HGO: {
            pg8::Gemm g{(const bt*)(ws + WS_A2), (const bt*)(ws + WS_WHGO), NROW, D, D}; pg8::StaticOrder S; S.init(NROW, D, G, bx);
            pg8::EpiResid E{p->in[I_X], p->in[I_CTX], (float*)(ws + WS_XR), modp(p, 0, 0, 2), 6144};
            pg8::gemm_phase<pg8::EpiResid, pg8::StaticOrder, true, true>(lds, g, S, E); } break;
        case PH_FFN0: phase_ffn_norm_route4(p, 0, NROW, lds, tid, lane, wave); break;
        case PH_FFN1: phase_ffn_norm_route4(p, 1, NLAT, lds, tid, lane, wave); break;
        case PH_GU0: case PH_GU1: { const int layer = (ph == PH_GU1);
            pg8::Gemm g{(const bt*)(ws + WS_U + U_XB), (const bt*)(ws + WS_WGU + (size_t)layer * NE * 2048 * D), CAP, 2048, D / 2};
            const int ntl = (int)((const unsigned*)(ws + WS_CTL))[CW_NT + layer];
            pg8::MoeOrder S; S.init((const int*)(ws + WS_ROUTE + RT_TILEE) + layer * 512, ntl, (LAS int*)(lds + 132096), 8, (size_t)2048 * D, G, vcu);
            pg8::EpiSwiglu E{p, layer};
            pg8::gemm_phase<pg8::EpiSwiglu, pg8::MoeOrder, true, true, true>(lds, g, S, E); } break;
        case PH_DN0: case PH_DN1: { const int layer = (ph == PH_DN1);
            pg8::Gemm g{(const bt*)(ws + WS_U + U_ACT), (const bt*)(ws + WS_WD + (size_t)layer * NE * D * D), CAP, D, D / 2};
            const int ntl = (int)((const unsigned*)(ws + WS_CTL))[CW_NT + layer];
            pg8::MoeOrder S; S.init((const int*)(ws + WS_ROUTE + RT_TILEE) + layer * 512, ntl, (LAS int*)(lds + 132096), 4, (size_t)D * D, G, vcu);
            pg8::EpiDown E{p, layer};
            pg8::gemm_phase<pg8::EpiDown, pg8::MoeOrder, true, true, true>(lds, g, S, E); } break;
        case PH_COMB0: phase_combine(p, 0, NROW, false, lane, wave); break;
        case PH_COMB1: phase_combine(p, 1, NLAT, true, lane, wave); break;
        case PH_LERP: phase_lerp(p, lds, tid, lane, wave); break;
        case PH_G_RKV: {
            pg8::Gemm g{(const bt*)(ws + WS_U + U_XL6), (const bt*)(ws + WS_WRKV), NROW, 3072, D};
            pg8::RkvL1Order S; S.init(NROW, G, bx, (const bt*)(ws + WS_WL1), (size_t)NROW * D * 2);
            pg8::EpiRkvL1 E{pg8::EpiStoreBf16{(bt*)(ws + WS_U + U_RKV), 3072}, pg8::EpiLora1{(bt*)(ws + WS_U + U_L1)}};
            pg8::gemm_phase<pg8::EpiRkvL1, pg8::RkvL1Order, true, true>(lds, g, S, E); } break;
        case PH_G_L2: phase_lora2(p, lds, tid, lane, wave); break;
        case PH_RWPREP: phase_rw_prep5(p, lds, lane, wave); break;
        case PH_RWSCAN: phase_rwkv_scan7(p, lds, vcu, tid, lane, wave); break;
        case PH_RWRO: phase_rw_readout(p, lane, wave); break;
        case PH_G_RWO: {
            pg8::Gemm g{(const bt*)(ws + WS_A2), (const bt*)(ws + WS_WRWO), NLAT, D, D}; pg8::StaticOrder S; S.init(NLAT, D, G, bx);
            float* XR = (float*)(ws + WS_XR);
            pg8::EpiResid E{XR, XR + (size_t)NLAT * D, XR, modp(p, 1, 0, 2), 6144};
            pg8::gemm_phase<pg8::EpiResid, pg8::StaticOrder, true, true>(lds, g, S, E); } break;
        default: break;
    }
}

#define MK_PROLOGUE \
    extern __shared__ __attribute__((aligned(16))) unsigned char lds_raw[]; \
    LAS unsigned char* lds = (LAS unsigned char*)lds_raw; \
    const int tid = threadIdx.x, lane = tid & 63, wave = __builtin_amdgcn_readfirstlane(tid >> 6); \
    const int G = gridDim.x, bx = blockIdx.x, vcu = (G % 8 == 0) ? (bx % 8) * (G / 8) + bx / 8 : bx;

#define XB_TMO      128
#define XB_XCNT(j)  (256  + 64 * (j))
#define XB_XSUB(j)  (1280 + 64 * (j))
#define XB_XGEN(j)  (2304 + 64 * (j))
#define XB_TOP      3328
#define XB_TOPGEN   3392
#define XCD_BAR_WORDS 3456
#define XB_SPIN_CAP (1u << 18)

__device__ __forceinline__ unsigned xb_ld(unsigned* p)              { return __hip_atomic_load(p, __ATOMIC_RELAXED, __HIP_MEMORY_SCOPE_AGENT); }
__device__ __forceinline__ unsigned xb_add(unsigned* p, unsigned v) { return __hip_atomic_fetch_add(p, v, __ATOMIC_RELAXED, __HIP_MEMORY_SCOPE_AGENT); }
__device__ __forceinline__ unsigned xb_xcc_id() { return (unsigned)__builtin_amdgcn_s_getreg((3 << 11) | 20) & 0xFu; }
#define XB_SPIN(cond, bar) do { unsigned _sp = 0; while (cond) { __builtin_amdgcn_s_sleep(1); \
    if ((++_sp & 255u) == 0u) { if (xb_ld(&(bar)[XB_TMO])) break; if (_sp > XB_SPIN_CAP) { atomicAdd(&(bar)[XB_TMO], 1u); break; } } } } while (0)

struct XcdBarrier {
    unsigned* bar; unsigned x;
    volatile LAS unsigned* st;
};

__device__ __forceinline__ XcdBarrier xcd_barrier_post(unsigned* bar, volatile LAS unsigned* st) {
    XcdBarrier b; b.bar = bar; b.x = xb_xcc_id(); b.st = st;
    if (threadIdx.x == 0) (void)xb_add(&bar[XB_XCNT(b.x)], 1u);
    return b;
}
__device__ __forceinline__ void xcd_barrier_complete(unsigned* bar, unsigned x, unsigned& nloc, unsigned& nx) {
    const unsigned G = gridDim.x * gridDim.y * gridDim.z;
    unsigned sum, cnt, mine, sp = 0u;
    for (;;) {
        sum = 0u; cnt = 0u; mine = 0u;
#pragma unroll
        for (unsigned j = 0; j < 16; ++j) { const unsigned c = xb_ld(&bar[XB_XCNT(j)]); sum += c; cnt += (c > 0u) ? 1u : 0u; mine = (j == x) ? c : mine; }
        if (sum == G) break;
        __builtin_amdgcn_s_sleep(1);
        if ((++sp & 255u) == 0u) { if (xb_ld(&bar[XB_TMO])) break; if (sp > XB_SPIN_CAP) { atomicAdd(&bar[XB_TMO], 1u); break; } }
    }
    nloc = mine > 0u ? mine : 1u; nx = cnt > 0u ? cnt : 1u;
}

__device__ __forceinline__ void xcd_barrier(const XcdBarrier& b) {
    asm volatile("s_waitcnt vmcnt(0)" ::: "memory");
    __syncthreads();
    if (threadIdx.x == 0) {
        unsigned* bar = b.bar;
        __builtin_amdgcn_s_waitcnt(0);
        unsigned nloc = b.st[0], nx = b.st[1];
        if (nloc == 0u) { xcd_barrier_complete(bar, b.x, nloc, nx); b.st[0] = nloc; b.st[1] = nx; }
        const unsigned old = xb_add(&bar[XB_XSUB(b.x)], 1u);
        const unsigned gen = old / nloc;
        if (old + 1u == (gen + 1u) * nloc) {
            __builtin_amdgcn_fence(__ATOMIC_RELEASE, "agent");
            asm volatile("s_waitcnt vmcnt(0)" ::: "memory");
            const unsigned og = xb_add(&bar[XB_TOP], 1u);
            const unsigned tg = og / nx;
            if (og + 1u == (tg + 1u) * nx) xb_add(&bar[XB_TOPGEN], 1u);
            else XB_SPIN(xb_ld(&bar[XB_TOPGEN]) == tg, bar);
            __builtin_amdgcn_fence(__ATOMIC_ACQUIRE, "agent");
            xb_add(&bar[XB_XGEN(b.x)], 1u);
            asm volatile("s_waitcnt vmcnt(0)" ::: "memory");
        } else {
            XB_SPIN(xb_ld(&bar[XB_XGEN(b.x)]) == gen, bar);
            __builtin_amdgcn_fence(__ATOMIC_ACQUIRE, "agent");
            asm volatile("s_waitcnt vmcnt(0)" ::: "memory");
        }
    }
    __syncthreads();
}

constexpr int LDSCTL_OFF = 131072, MISC_OFF = LDSCTL_OFF + 320;
__device__ __forceinline__ void grid_bar(PP kp, LAS unsigned char* lds) {
    PP q = kp; asm volatile("" : "+s"(q));
    XcdBarrier b; b.bar = (unsigned*)(q->ws + WS_CTL) + CW_BAR; b.x = xb_xcc_id(); b.st = (volatile LAS unsigned*)(lds + LDS_BYTES - 64);
    xcd_barrier(b);
}
namespace cg = cooperative_groups;
__global__ void __launch_bounds__(NTHREADS, 2) mk_fwd(Params pv) {
    MK_PROLOGUE
    cg::grid_group grid = cg::this_grid();
    PP kp = (PP)__builtin_amdgcn_kernarg_segment_ptr();
    const int lo = kp->ph_lo, hi = kp->ph_hi;
    for (int u = tid; u < (LDS_BYTES - LDSCTL_OFF) / 4; u += NTHREADS) ((LAS unsigned*)(lds + LDSCTL_OFF))[u] = 0u;
    __syncthreads();
    { XcdBarrier b0 = xcd_barrier_post((unsigned*)(kp->ws + WS_CTL) + CW_BAR, (volatile LAS unsigned*)(lds + LDS_BYTES - 64)); (void)b0; }
#ifndef REPEAT_MASK
#define REPEAT_MASK 0u
#endif
#define RUN(k) if (lo <= (k) && (k) < hi) { PP q = kp; asm volatile("" : "+s"(q)); run_phase<k>(q, lds, tid, lane, wave, G, bx, vcu); \
        if ((REPEAT_MASK >> (k)) & 1u) { grid_bar(kp, lds); PP q2 = kp; asm volatile("" : "+s"(q2)); run_phase<k>(q2, lds, tid, lane, wave, G, bx, vcu); } \
        if ((k) + 1 < hi) { if ((k) == 0) grid.sync(); else grid_bar(kp, lds); } }
    RUN(0) RUN(1) RUN(2) RUN(3) RUN(4) RUN(5) RUN(6) RUN(7) RUN(8) RUN(9) RUN(10) RUN(11) RUN(12) RUN(13) RUN(14) RUN(15) RUN(16) RUN(17) RUN(18) RUN(19) RUN(20) RUN(21)
#undef RUN
}

extern "C" void kernel_launch(void* const* d_in, const int* in_sizes, int n_in, void* d_out, int out_size, void* d_ws, size_t ws_size, hipStream_t stream) {
    static int grid = 0;
    if (grid == 0) {
        if (n_in != 35 || in_sizes[0] != NLAT * D || out_size != NLAT * D || ws_size < WS_END) {
            fprintf(stderr, "kernel_launch: unexpected problem (n_in %d, in0 %d, out %d, ws %zu < %zu)\n", n_in, n_in > 0 ? in_sizes[0] : -1, out_size, ws_size, (size_t)WS_END); grid = -1; return; }
        int dev = 0, cus = 0, per_cu = 0;
        if (hipGetDevice(&dev) != hipSuccess || hipDeviceGetAttribute(&cus, hipDeviceAttributeMultiprocessorCount, dev) != hipSuccess) { grid = -1; return; }
        if (hipFuncSetAttribute((const void*)mk_fwd, hipFuncAttributeMaxDynamicSharedMemorySize, LDS_BYTES) != hipSuccess) { fprintf(stderr, "kernel_launch: hipFuncSetAttribute failed\n"); grid = -1; return; }
        if (hipOccupancyMaxActiveBlocksPerMultiprocessor(&per_cu, (const void*)mk_fwd, NTHREADS, LDS_BYTES) != hipSuccess || per_cu < 1) { fprintf(stderr, "kernel_launch: occupancy query %d\n", per_cu); per_cu = 1; }
        (void)hipGetLastError();
        grid = cus * (per_cu < 1 ? 1 : per_cu);
    }
    if (grid < 0) return;
    (void)hipMemsetAsync((char*)d_ws + WS_CTL, 0, CTL_ZERO_BYTES, stream);
    Params p{};
    for (int i = 0; i < 35; ++i) p.in[i] = (const float*)d_in[i];
    p.out = (float*)d_out; p.ws = (unsigned char*)d_ws;
    p.ph_lo = 0; p.ph_hi = NPHASES;
    void* args[] = {&p};
    hipError_t e = hipLaunchCooperativeKernel((const void*)mk_fwd, dim3(grid), dim3(NTHREADS), args, LDS_BYTES, stream);
    if (e != hipSuccess) fprintf(stderr, "kernel_launch: cooperative launch failed: %s (grid %d)\n", hipGetErrorString(e), grid);
}
```

```cpp
#include <hip/hip_runtime.h>
#include <hip/hip_cooperative_groups.h>
#include <cstdio>
#include <cstdint>

namespace pg8 {
#define PG8_LAS __attribute__((address_space(3)))
typedef unsigned short bf16_t;
typedef short bf16x8 __attribute__((ext_vector_type(8)));
typedef float f32x4 __attribute__((ext_vector_type(4)));
typedef unsigned u32x4 __attribute__((ext_vector_type(4)));
constexpr int BM = 256, BK = 64, HALF = 128, HTB = HALF * BK * 2  , STAGE_BYTES = 8 * HTB, NXCD = 8, WGM = 8;

__host__ __device__ __forceinline__ int lds_byte(int r, int c) { const int st = (r >> 4) * 2 + (c >> 5), rr = r & 15, cc = c & 31, ob = rr * 64 + cc * 2; return st * 1024 + (ob ^ (((ob >> 9) & 1) << 5)); }
__host__ __device__ __forceinline__ void stage_rc(int b, int& R, int& C) { const int st = b / 1024, sb = b % 1024, swz = sb ^ (((sb >> 9) & 1) << 5); R = (st >> 1) * 16 + swz / 64; C = (st & 1) * 32 + (swz % 64) / 2; }
__host__ __device__ __forceinline__ int perm32(int rho) { const int n = rho >> 4, i = rho & 15; return 8 * (i >> 2) + 4 * n + (i & 3); }

struct Unit { int pm, pn, e; };
struct Gemm { const bf16_t* A; const bf16_t* Bt; int M, N, K; };

struct StaticOrder {
    int nM, nN, nwg, G, c;
    __host__ __device__ void init(int M, int N, int G_, int c_) { nM = M / BM; nN = N / BM; nwg = nM * nN; G = G_; c = c_; }
    __host__ __device__ bool next(int i, Unit& u) const { return at((long)i * G + c, u); }
    __host__ __device__ bool at(long L, Unit& u) const {
        if (L >= nwg) return false;
        int wgid = (int)L; { const int q = nwg / NXCD, r = nwg % NXCD, xcd = wgid % NXCD, off = wgid / NXCD; wgid = (xcd < r ? xcd * (q + 1) : r * (q + 1) + (xcd - r) * q) + off; }
        const int nig = WGM * nN, gid = wgid / nig, fm = gid * WGM, gsz = (nM - fm) < WGM ? (nM - fm) : WGM;
        u.pm = fm + ((wgid % nig) % gsz); u.pn = (wgid % nig) / gsz; u.e = 0; return true;
    }
    __device__ __forceinline__ const char* abase(const Gemm& g, const Unit& u, size_t tstep) const { return (const char*)g.A + (size_t)u.pm * tstep; }
    __device__ __forceinline__ const char* bbase(const Gemm& g, const Unit& u, size_t tstep) const { return (const char*)g.Bt + (size_t)u.pn * tstep; }
    __device__ __forceinline__ void a_ready(const Unit&) const {}
    __device__ __forceinline__ void done(const Unit&) const {}
};

__device__ __forceinline__ unsigned cvt_pk_bf16(float lo, float hi) { unsigned r; asm volatile("v_cvt_pk_bf16_f32 %0, %1, %2" : "=v"(r) : "v"(lo), "v"(hi)); return r; }

typedef int v4i_t __attribute__((ext_vector_type(4))); typedef int v8i_t __attribute__((ext_vector_type(8)));
template <bool FP8> struct Frag { bf16x8 v[2]; };
template <> struct Frag<true> { v8i_t v; };
__device__ __forceinline__ void ld_frag(Frag<false>& f, const PG8_LAS unsigned char* p0) { f.v[0] = *(const PG8_LAS bf16x8*)(p0); f.v[1] = *(const PG8_LAS bf16x8*)(p0 + 1024); }
__device__ __forceinline__ void ld_frag(Frag<true>& f, const PG8_LAS unsigned char* p0) { const v4i_t lo = *(const PG8_LAS v4i_t*)(p0), hi = *(const PG8_LAS v4i_t*)(p0 + 1024); f.v = (v8i_t){lo.x, lo.y, lo.z, lo.w, hi.x, hi.y, hi.z, hi.w}; }
__device__ __forceinline__ f32x4 mma_frag(const Frag<false>& b, const Frag<false>& a, f32x4 c) { c = __builtin_amdgcn_mfma_f32_16x16x32_bf16(b.v[0], a.v[0], c, 0, 0, 0); return __builtin_amdgcn_mfma_f32_16x16x32_bf16(b.v[1], a.v[1], c, 0, 0, 0); }
__device__ __forceinline__ f32x4 mma_frag(const Frag<true>& b, const Frag<true>& a, f32x4 c) {
    const int sw = 0x7A7A7A7A, sa = 0x7F7F7F7F;
    asm volatile("v_mfma_scale_f32_16x16x128_f8f6f4 %0, %1, %2, %0, %3, %4 op_sel_hi:[0,0,0]" : "+v"(c) : "v"(b.v), "v"(a.v), "v"(sw), "v"(sa));
    return c;
}

template <class Epi, class Sched, bool ALIGN_EPI = false, bool SP2 = false, bool FP8 = false, bool PRE = false>
__device__ __forceinline__ void gemm_phase(PG8_LAS unsigned char* lds, const Gemm g, const Sched& S, const Epi& E) {
    const int tid = threadIdx.x, wid = __builtin_amdgcn_readfirstlane(tid >> 6), lane = tid & 63, wr = wid >> 2, wc = wid & 3, fr = lane & 15, fq = lane >> 4;
    const int K = g.K, nt = K / BK;
    unsigned voffA[2], voffB[2];
#pragma unroll
    for (int i = 0; i < 2; ++i) { int R, C; stage_rc(tid * 16 + i * 8192, R, C); const int Rb = Epi::PERM ? ((R & ~31) + perm32(R & 31)) : R;
        voffA[i] = (unsigned)(R * K + C) * 2u; voffB[i] = (unsigned)(Rb * K + C) * 2u; }
    const size_t kstep = (size_t)(BK * 2);
    const size_t hstep = (size_t)HALF * K * 2;
    const size_t tstep = 2 * hstep;
    const unsigned ldsw = (unsigned)wid * 1024u;
    const int aoff = lds_byte(wr * 64 + fr, fq * 8), boff = lds_byte(wc * 32 + fr, fq * 8);
#define PG8_SA(b, h) (((b) * 2 + (h)) * HTB)
#define PG8_SB(b, h) ((4 + (b) * 2 + (h)) * HTB)
#define PG8_STAGE(bufoff, gbase, voff) do { _Pragma("unroll") for (int _i = 0; _i < 2; ++_i) \
        __builtin_amdgcn_global_load_lds((const unsigned*)((const char*)(gbase) + (voff)[_i]), (PG8_LAS unsigned*)(lds + (bufoff) + ldsw + _i * 8192), 16, 0, 0); } while (0)
#define PG8_LDA(dst, b, h) do { _Pragma("unroll") for (int m = 0; m < 4; ++m) ld_frag(dst[m], lds + PG8_SA(b, h) + aoff + m * 2048); } while (0)
#define PG8_LDB(dst, b, h) do { _Pragma("unroll") for (int n = 0; n < 2; ++n) ld_frag(dst[n], lds + PG8_SB(b, h) + boff + n * 2048); } while (0)
#define PG8_MMA(ai, bj, At, Bt) do { __builtin_amdgcn_s_setprio(1); _Pragma("unroll") for (int m = 0; m < 4; ++m) _Pragma("unroll") for (int n = 0; n < 2; ++n) \
        acc[ai][bj][m][n] = mma_frag(Bt[n], At[m], acc[ai][bj][m][n]); __builtin_amdgcn_s_setprio(0); } while (0)
#define PG8_WAIT_V(n) asm volatile("s_waitcnt vmcnt(" #n ")" ::: "memory")
#define PG8_WAIT_L(n) asm volatile("s_waitcnt lgkmcnt(" #n ")" ::: "memory")
#define PG8_BAR __builtin_amdgcn_s_barrier()
#define PG8_SCHED __builtin_amdgcn_sched_barrier(0)
    Unit cur, nxt; int ui = 0;
    if (!S.next(0, cur)) return;
    f32x4 acc[2][2][4][2];
#pragma unroll
    for (int a = 0; a < 2; ++a)
#pragma unroll
        for (int b = 0; b < 2; ++b)
#pragma unroll
            for (int m = 0; m < 4; ++m)
#pragma unroll
                for (int n = 0; n < 2; ++n) acc[a][b][m][n] = (f32x4){0.f, 0.f, 0.f, 0.f};
    Frag<FP8> At[4], B0[2], B1[2];
    const char* cA = S.abase(g, cur, tstep); const char* cB = S.bbase(g, cur, tstep);
    S.a_ready(cur);
    if constexpr (SP2) {
        PG8_STAGE(PG8_SB(0, 0), cB, voffB); PG8_STAGE(PG8_SB(0, 1), cB + hstep, voffB); PG8_STAGE(PG8_SA(0, 0), cA, voffA); PG8_STAGE(PG8_SA(0, 1), cA + hstep, voffA);
        if (wr == 1) PG8_BAR;
        PG8_WAIT_V(2); PG8_BAR;
        PG8_STAGE(PG8_SB(1, 0), cB + kstep, voffB); PG8_STAGE(PG8_SA(1, 0), cA + kstep, voffA); PG8_STAGE(PG8_SB(1, 1), cB + hstep + kstep, voffB);
        PG8_WAIT_V(6); PG8_BAR;
    } else {
        PG8_STAGE(PG8_SB(0, 0), cB, voffB); PG8_STAGE(PG8_SA(0, 0), cA, voffA); PG8_STAGE(PG8_SB(0, 1), cB + hstep, voffB); PG8_STAGE(PG8_SA(0, 1), cA + hstep, voffA);
        if (wr == 1) PG8_BAR;
        PG8_WAIT_V(4); PG8_BAR;
        PG8_STAGE(PG8_SB(1, 0), cB + kstep, voffB); PG8_STAGE(PG8_SA(1, 0), cA + kstep, voffA); PG8_STAGE(PG8_SB(1, 1), cB + hstep + kstep, voffB);
        PG8_WAIT_V(6); PG8_BAR;
    }
    typename Epi::Pre pre;
    for (;;) {
        const bool has_next = S.next(ui + 1, nxt);
        const char* nA = has_next ? S.abase(g, nxt, tstep) : cA; const char* nB = has_next ? S.bbase(g, nxt, tstep) : cB;
        _Pragma("unroll 1") for (int t = 0; t < nt; t += 2) {
            const bool last = (t == nt - 2);
            const char* a1 = cA + (size_t)(t + 1) * kstep;
            const char* a2 = last ? nA : cA + (size_t)(t + 2) * kstep; const char* b2 = last ? nB : cB + (size_t)(t + 2) * kstep;
            const char* a3 = a2 + kstep; const char* b3 = b2 + kstep;
            if (last && has_next) S.a_ready(nxt);
            if constexpr (PRE) { if (last) E.prefetch(cur, wr, wc, fr, fq, pre); }
            if constexpr (SP2) {
            PG8_LDB(B0, 0, 0); PG8_LDB(B1, 0, 1); PG8_SCHED; PG8_LDA(At, 0, 0); PG8_STAGE(PG8_SA(1, 1), a1 + hstep, voffA);
            PG8_WAIT_V(8); PG8_WAIT_L(0); PG8_BAR; PG8_MMA(0, 0, At, B0); PG8_MMA(0, 1, At, B1); PG8_BAR; PG8_SCHED;
            PG8_LDA(At, 0, 1); PG8_STAGE(PG8_SB(0, 0), b2, voffB); PG8_STAGE(PG8_SB(0, 1), b2 + hstep, voffB); PG8_STAGE(PG8_SA(0, 0), a2, voffA);
            PG8_WAIT_V(8); PG8_WAIT_L(0); PG8_BAR; PG8_MMA(1, 0, At, B0); PG8_MMA(1, 1, At, B1); PG8_BAR; PG8_SCHED;
            PG8_LDB(B0, 1, 0); PG8_LDB(B1, 1, 1); PG8_SCHED; PG8_LDA(At, 1, 0); PG8_STAGE(PG8_SA(0, 1), a2 + hstep, voffA);
            PG8_WAIT_V(8); PG8_WAIT_L(0); PG8_BAR; PG8_MMA(0, 0, At, B0); PG8_MMA(0, 1, At, B1); PG8_BAR; PG8_SCHED;
            PG8_LDA(At, 1, 1); PG8_STAGE(PG8_SB(1, 0), b3, voffB); PG8_STAGE(PG8_SB(1, 1), b3 + hstep, voffB); PG8_STAGE(PG8_SA(1, 0), a3, voffA);
            PG8_WAIT_V(8); PG8_WAIT_L(0); PG8_BAR; PG8_MMA(1, 0, At, B0); PG8_MMA(1, 1, At, B1); PG8_BAR; PG8_SCHED;
            } else {
            PG8_LDB(B0, 0, 0); PG8_SCHED; PG8_LDA(At, 0, 0); PG8_STAGE(PG8_SA(1, 1), a1 + hstep, voffA);
            PG8_WAIT_L(8); PG8_BAR; PG8_WAIT_L(0); PG8_MMA(0, 0, At, B0); PG8_BAR; PG8_SCHED;
            PG8_LDB(B1, 0, 1); PG8_STAGE(PG8_SB(0, 0), b2, voffB);
            PG8_BAR; PG8_WAIT_L(0); PG8_MMA(0, 1, At, B1); PG8_BAR;
            PG8_LDA(At, 0, 1); PG8_STAGE(PG8_SA(0, 0), a2, voffA);
            PG8_BAR; PG8_WAIT_L(0); PG8_MMA(1, 0, At, B0); PG8_BAR; PG8_SCHED;
            PG8_STAGE(PG8_SB(0, 1), b2 + hstep, voffB);
            PG8_WAIT_V(6); PG8_BAR; PG8_MMA(1, 1, At, B1); PG8_BAR;
            PG8_LDB(B0, 1, 0); PG8_SCHED; PG8_LDA(At, 1, 0); PG8_STAGE(PG8_SA(0, 1), a2 + hstep, voffA);
            PG8_WAIT_L(8); PG8_BAR; PG8_WAIT_L(0); PG8_MMA(0, 0, At, B0); PG8_BAR; PG8_SCHED;
            PG8_LDB(B1, 1, 1); PG8_STAGE(PG8_SB(1, 0), b3, voffB);
            PG8_BAR; PG8_WAIT_L(0); PG8_MMA(0, 1, At, B1); PG8_BAR;
            PG8_LDA(At, 1, 1); PG8_STAGE(PG8_SA(1, 0), a3, voffA);
            PG8_BAR; PG8_WAIT_L(0); PG8_MMA(1, 0, At, B0); PG8_BAR; PG8_SCHED;
            PG8_STAGE(PG8_SB(1, 1), b3 + hstep, voffB);
            PG8_WAIT_V(6); PG8_BAR; PG8_MMA(1, 1, At, B1); PG8_BAR;
            }
        }
        if constexpr (FP8) { asm volatile("s_nop 15\n\ts_nop 15" ::: "memory"); }
        if constexpr (ALIGN_EPI) { if (wr == 0) PG8_BAR; }
        if constexpr (PRE) { E(acc, cur, wr, wc, fr, fq, pre); S.done(cur); } else
        if constexpr (!Epi::AFTER_DRAIN) { E(acc, cur, wr, wc, fr, fq); S.done(cur); }
        if (!has_next) break;
#pragma unroll
        for (int a = 0; a < 2; ++a)
#pragma unroll
            for (int b = 0; b < 2; ++b)
#pragma unroll
                for (int m = 0; m < 4; ++m)
#pragma unroll
                    for (int n = 0; n < 2; ++n) acc[a][b][m][n] = (f32x4){0.f, 0.f, 0.f, 0.f};
        cur = nxt; cA = nA; cB = nB; ++ui;
        if constexpr (ALIGN_EPI) { if (wr == 1) PG8_BAR; }
    }
    PG8_WAIT_V(0);
    if constexpr (!ALIGN_EPI) { if (wr == 0) PG8_BAR; }
    PG8_BAR;
    if constexpr (Epi::AFTER_DRAIN) { E.fused(acc, cur, wr, wc, fr, fq, lds, wid, lane); S.done(cur); }
#undef PG8_SA
#undef PG8_SB
#undef PG8_STAGE
#undef PG8_LDA
#undef PG8_LDB
#undef PG8_MMA
#undef PG8_WAIT_V
#undef PG8_WAIT_L
#undef PG8_BAR
#undef PG8_SCHED
}
}

constexpr int D = 1024, NBATCH = 2, SEQ = 8192, CTXL = 256;
constexpr int NLAT = NBATCH * SEQ, NCTX = NBATCH * CTXL, NROW = NLAT + NCTX;
constexpr int NE = 32, TOPK = 4, MAXTILES = 296, CAP = MAXTILES * 256;
constexpr int NWAVES = 8, NTHREADS = 512;
constexpr float NORM_EPS = 1e-6f;
constexpr int LDS_BYTES = 147456;

constexpr size_t MiB = 1u << 20;
constexpr size_t WS_CTL = 0, CTL_ZERO_BYTES = 1 * MiB;
constexpr size_t WS_MOD = 1 * MiB;
constexpr size_t WS_ROUTE = 2 * MiB;
constexpr size_t RT_TOPI = 0, RT_TOPG = 320 * 1024, RT_POS = 640 * 1024, RT_SLOT = 960 * 1024, RT_RSTD = 1280 * 1024, RT_TILEE = 1408 * 1024;
constexpr size_t WS_WIN = 4 * MiB, WS_WHGO = 14 * MiB, WS_WRKV = 16 * MiB, WS_WL1 = 22 * MiB, WS_WL2 = 24 * MiB, WS_WRWO = 28 * MiB;
constexpr size_t WS_WGU = 32 * MiB, WS_WD = 288 * MiB;
constexpr size_t WS_XR = 416 * MiB, WS_H = 482 * MiB, WS_H2 = 515 * MiB, WS_A2 = 548 * MiB;
constexpr size_t WS_U = 584 * MiB;
constexpr size_t U_Z = 0, U_OD0 = 166 * MiB;
constexpr size_t U_XL6 = 0, U_RKV = 198 * MiB, U_L1 = 396 * MiB, U_WD = 410 * MiB, U_AD = 542 * MiB, U_G = 674 * MiB, U_OD1 = 740 * MiB;
constexpr size_t U_XB = 0, U_ACT = 148 * MiB, U_YS = 296 * MiB;
constexpr size_t WS_END = WS_U + 1352 * MiB;
constexpr int CW_CNT = 16384, CNT_STRIDE = 64;
constexpr int CW_NT = 128;
constexpr int CW_TOF = 8192, TOF_PER = 72;
constexpr int CW_BAR = 4096;

#define LAS __attribute__((address_space(3)))
typedef unsigned short bf16;
typedef unsigned v4u __attribute__((ext_vector_type(4)));
typedef unsigned v2u __attribute__((ext_vector_type(2)));
typedef float f32x4 __attribute__((ext_vector_type(4)));
#define LDS_WAIT() asm volatile("s_waitcnt lgkmcnt(0)" ::: "memory")
typedef float f32x2c __attribute__((ext_vector_type(2))); typedef __bf16 bf16x2c __attribute__((ext_vector_type(2)));
__device__ __forceinline__ unsigned pk2(float lo, float hi) { const f32x2c v = {lo, hi}; const bf16x2c b = __builtin_convertvector(v, bf16x2c); return __builtin_bit_cast(unsigned, b); }
__device__ __forceinline__ unsigned f2bf(float f) { return pk2(f, 0.f) & 0xffffu; }
__device__ __forceinline__ unsigned pk4_fp8(float a, float b, float c, float d) { unsigned w = 0u; w = __builtin_amdgcn_cvt_pk_fp8_f32(a, b, w, false); return __builtin_amdgcn_cvt_pk_fp8_f32(c, d, w, true); }
__device__ __forceinline__ float bf2f(unsigned b) { return __builtin_bit_cast(float, b << 16); }
__device__ __forceinline__ float wave_sum(float x) {
    x += __builtin_bit_cast(float, __builtin_amdgcn_update_dpp(0, __builtin_bit_cast(int, x), 0x128, 0xf, 0xf, false));
    x += __builtin_bit_cast(float, __builtin_amdgcn_update_dpp(0, __builtin_bit_cast(int, x), 0x124, 0xf, 0xf, false));
    x += __builtin_bit_cast(float, __builtin_amdgcn_update_dpp(0, __builtin_bit_cast(int, x), 0x122, 0xf, 0xf, false));
    x += __builtin_bit_cast(float, __builtin_amdgcn_update_dpp(0, __builtin_bit_cast(int, x), 0x121, 0xf, 0xf, false));
    x += __builtin_bit_cast(float, __builtin_amdgcn_update_dpp(0, __builtin_bit_cast(int, x), 0x142, 0xa, 0xf, false));
    x += __builtin_bit_cast(float, __builtin_amdgcn_update_dpp(0, __builtin_bit_cast(int, x), 0x143, 0xc, 0xf, false));
    return __builtin_bit_cast(float, __builtin_amdgcn_readlane(__builtin_bit_cast(int, x), 63));
}
__device__ __forceinline__ float sigm(float x) { return __builtin_amdgcn_rcpf(1.0f + __expf(-x)); }

struct Params { const float* in[35]; float* out; unsigned char* ws; int ph_lo, ph_hi; };
typedef const __attribute__((address_space(4))) Params* PP;
enum { I_X = 0, I_C, I_CTX, I_CCTX, I_ADAW, I_ADAB, I_NMIX, I_NFFN, I_HGWIN, I_HGGN, I_HGWOUT, I_HGLB, I_MU, I_WRKV, I_DECW0, I_DECW1, I_DECW2,
       I_A0, I_A1, I_A2, I_G1, I_G2, I_KK, I_KA, I_RK, I_LNXW, I_LNXB, I_RWOUT, I_ROUTW, I_ROUTB, I_WGU, I_BGU, I_WDN, I_BDN, I_FINALG };

__device__ __forceinline__ const float* modp(PP p, int l, int v, int j) { return (const float*)(p->ws + WS_MOD) + ((size_t)(l * 3 + v) * 6 + j) * D; }
__device__ __forceinline__ int row_vec(int row) { return row < NLAT ? (row >= SEQ ? 1 : 0) : 2; }

__device__ __forceinline__ void ti_load(const float* src, int src_ld, int lane, float (&rg)[32]) {
    if (src) {
#pragma unroll
        for (int i = 0; i < 32; ++i) rg[i] = src[(size_t)(2 * i + (lane >> 5)) * src_ld + (lane & 31)];
    }
}
__device__ __forceinline__ void ti_store(bool nonzero, int fp8, const float (&rg)[32], unsigned char* dst, int dst_ldb, LAS float* scr, int lane) {
    if (nonzero) {
#pragma unroll
        for (int i = 0; i < 32; ++i) scr[(2 * i + (lane >> 5)) * 33 + (lane & 31)] = rg[i];
    }
    LDS_WAIT(); asm volatile("" ::: "memory");
    if (fp8) {
        const int n = lane >> 1, hk = (lane & 1) * 32; const LAS float* s = scr + hk * 33 + n; unsigned w[8];
#pragma unroll
        for (int q = 0; q < 8; ++q) w[q] = pk4_fp8(s[(4 * q) * 33] * 32.f, s[(4 * q + 1) * 33] * 32.f, s[(4 * q + 2) * 33] * 32.f, s[(4 * q + 3) * 33] * 32.f);
        v4u* d = (v4u*)(dst + (size_t)n * dst_ldb + hk); d[0] = (v4u){w[0], w[1], w[2], w[3]}; d[1] = (v4u){w[4], w[5], w[6], w[7]};
    } else {
        const int c = lane & 7;
#pragma unroll
        for (int j = 0; j < 4; ++j) {
            const int n = (lane >> 3) + 8 * j; v4u o = (v4u){0u, 0u, 0u, 0u};
            if (nonzero) { const LAS float* s = scr + (8 * c) * 33 + n;
                o.x = pk2(s[0 * 33], s[1 * 33]); o.y = pk2(s[2 * 33], s[3 * 33]); o.z = pk2(s[4 * 33], s[5 * 33]); o.w = pk2(s[6 * 33], s[7 * 33]); }
            *(v4u*)(dst + (size_t)n * dst_ldb + 16 * c) = o;
        }
    }
    LDS_WAIT(); asm volatile("" ::: "memory");
}
__device__ __forceinline__ void ti_load4(const float* src, int src_ld, int lane, f32x4 (&rg)[8]) {
#pragma unroll
    for (int i = 0; i < 8; ++i) rg[i] = *(const f32x4*)(src + (size_t)(8 * i + (lane >> 3)) * src_ld + 4 * (lane & 7));
}
__device__ __forceinline__ void ti_store4_fp8(const f32x4 (&rg)[8], unsigned char* dst, int dst_ldb, LAS float* scr, int lane) {
#pragma unroll
    for (int i = 0; i < 8; ++i) *(LAS f32x4*)(scr + (8 * i + (lane >> 3)) * 36 + 4 * (lane & 7)) = rg[i];
    LDS_WAIT(); asm volatile("" ::: "memory");
    const int n = lane >> 1, hk = (lane & 1) * 32; const LAS float* s = scr + hk * 36 + n; unsigned w[8];
#pragma unroll
    for (int q = 0; q < 8; ++q) w[q] = pk4_fp8(s[(4 * q) * 36] * 32.f, s[(4 * q + 1) * 36] * 32.f, s[(4 * q + 2) * 36] * 32.f, s[(4 * q + 3) * 36] * 32.f);
    v4u* d = (v4u*)(dst + (size_t)n * dst_ldb + hk); d[0] = (v4u){w[0], w[1], w[2], w[3]}; d[1] = (v4u){w[4], w[5], w[6], w[7]};
    LDS_WAIT(); asm volatile("" ::: "memory");
}
struct ConvJob { const float* src; int src_ld; unsigned char* dst; int dst_ldb; int fp8; };
__device__ __forceinline__ ConvJob job_plain(const float* W, int K, int N, bf16* WT, int r) {
    const int nblk = N / 32, kb = r / nblk, nb = r % nblk;
    return ConvJob{W + (size_t)(kb * 64) * N + nb * 32, N, (unsigned char*)(WT + (size_t)(nb * 32) * K + kb * 64), K * 2, 0};
}
constexpr int IT_WIN = 16 * 160, IT_SQ = 16 * 32, IT_L1 = 16 * 24, IT_L2 = 160 * 6, IT_GU = 64 * 16 * 64, IT_DN = 64 * 16 * 32;
constexpr int IT_GU0 = IT_GU / 2, IT_DN0 = IT_DN / 2;
constexpr int IT_TOTAL = IT_WIN + IT_SQ + 3 * IT_SQ + IT_SQ + IT_L1 + IT_L2 + IT_GU0 + IT_DN0, IT_L1MOE = IT_GU0 + IT_DN0;
__device__ __forceinline__ ConvJob conv_job(PP p, int it) {
    unsigned char* ws = p->ws; int r = it;
    if (r < IT_WIN) { const int kb = r / 160, nb = r % 160;
        return ConvJob{p->in[I_HGWIN] + (size_t)(kb * 64) * 5120 + nb * 32, 5120, ws + WS_WIN + (size_t)(nb * 32) * D + kb * 64, D, 1}; } r -= IT_WIN;
    if (r < IT_SQ) return job_plain(p->in[I_HGWOUT], D, D, (bf16*)(ws + WS_WHGO), r); r -= IT_SQ;
    if (r < 3 * IT_SQ) { const int j = r / IT_SQ; return job_plain(p->in[I_WRKV] + (size_t)j * D * D, D, D, (bf16*)(ws + WS_WRKV) + (size_t)j * D * D, r % IT_SQ); } r -= 3 * IT_SQ;
    if (r < IT_SQ) return job_plain(p->in[I_RWOUT], D, D, (bf16*)(ws + WS_WRWO), r); r -= IT_SQ;
    if (r < IT_L1) {
        const int kb = r / 24, rg = r % 24, tile = rg >> 3, within = rg & 7; const float* src = nullptr; int ld = 64;
        if (within < 4) {
            if (tile == 0) src = p->in[I_DECW1] + (size_t)(within >> 1) * D * 64 + (size_t)(kb * 64) * 64 + (within & 1) * 32;
            else if (tile == 1) src = p->in[I_A1] + (size_t)(within >> 1) * D * 64 + (size_t)(kb * 64) * 64 + (within & 1) * 32;
            else { src = p->in[I_G1] + (size_t)(kb * 64) * 128 + within * 32; ld = 128; }
        }
        return ConvJob{src, ld, (unsigned char*)((bf16*)(ws + WS_WL1) + (size_t)(rg * 32) * D + kb * 64), D * 2, 0}; } r -= IT_L1;
    if (r < IT_L2) {
        const int rg = r / 6, kb = r % 6, n0 = rg * 32, blk = n0 >> 10, nn0 = n0 & 1023; const float* src = nullptr;
        if (blk < 2) { if (kb == blk) src = p->in[I_DECW2] + (size_t)blk * 64 * D + nn0; }
        else if (blk < 4) { if (kb == blk) src = p->in[I_A2] + (size_t)(blk - 2) * 64 * D + nn0; }
        else { if (kb >= 4) src = p->in[I_G2] + (size_t)(kb - 4) * 64 * D + nn0; }
        return ConvJob{src, D, (unsigned char*)((bf16*)(ws + WS_WL2) + (size_t)n0 * 384 + kb * 64), 384 * 2, 0}; } r -= IT_L2;
    if (r < IT_GU0) {
        const int mat = r >> 10, q = r & 1023, kb = q >> 6, nb = q & 63, n0 = nb * 32;
        const int j0 = n0 & 1023, drow = 256 * (j0 >> 7) + (n0 >= 1024 ? 128 : 0) + (j0 & 127);
        return ConvJob{p->in[I_WGU] + (size_t)mat * D * 2048 + (size_t)(kb * 64) * 2048 + n0, 2048, ws + WS_WGU + (size_t)mat * 2048 * D + (size_t)drow * D + kb * 64, D, 1}; } r -= IT_GU0;
    { const int mat = r >> 9, q = r & 511, kb = q >> 5, nb = q & 31;
      return ConvJob{p->in[I_WDN] + (size_t)mat * D * D + (size_t)(kb * 64) * D + nb * 32, D, ws + WS_WD + (size_t)mat * D * D + (size_t)(nb * 32) * D + kb * 64, D, 1}; }
}
__device__ __forceinline__ ConvJob conv_job_l1(PP p, int r) {
    unsigned char* ws = p->ws;
    if (r < IT_GU0) { const int mat = 32 + (r >> 10), q = r & 1023, kb = q >> 6, nb = q & 63, n0 = nb * 32;
        const int j0 = n0 & 1023, drow = 256 * (j0 >> 7) + (n0 >= 1024 ? 128 : 0) + (j0 & 127);
        return ConvJob{p->in[I_WGU] + (size_t)mat * D * 2048 + (size_t)(kb * 64) * 2048 + n0, 2048, ws + WS_WGU + (size_t)mat * 2048 * D + (size_t)drow * D + kb * 64, D, 1}; }
    r -= IT_GU0;
    { const int mat = 32 + (r >> 9), q = r & 511, kb = q >> 5, nb = q & 31;
      return ConvJob{p->in[I_WDN] + (size_t)mat * D * D + (size_t)(kb * 64) * D + nb * 32, D, ws + WS_WD + (size_t)mat * D * D + (size_t)(nb * 32) * D + kb * 64, D, 1}; }
}
__device__ __forceinline__ void phase_pre(PP p, LAS unsigned char* lds, int tid, int lane, int wave) {
    if (blockIdx.x < 192) {
        const int layer = blockIdx.x / 96, col = (blockIdx.x % 96) * 64 + lane;
        const float* W = p->in[I_ADAW] + (size_t)layer * D * 6144 + col;
        const float* c = p->in[I_C]; const float* cc = p->in[I_CCTX];
        float a0 = 0.f, a1 = 0.f, a2 = 0.f;
#pragma unroll 8
        for (int k = wave * 128; k < wave * 128 + 128; ++k) {
            const float wv = W[(size_t)k * 6144]; const float c0 = c[k], c1 = c[D + k], c2 = cc[k];
            a0 += c0 * sigm(c0) * wv; a1 += c1 * sigm(c1) * wv; a2 += c2 * sigm(c2) * wv;
        }
        LAS float* red = (LAS float*)lds;
        red[(wave * 3 + 0) * 64 + lane] = a0; red[(wave * 3 + 1) * 64 + lane] = a1; red[(wave * 3 + 2) * 64 + lane] = a2;
        __syncthreads();
        if (wave == 0) {
            float s0 = 0.f, s1 = 0.f, s2 = 0.f;
#pragma unroll
            for (int w = 0; w < 8; ++w) { s0 += red[(w * 3 + 0) * 64 + lane]; s1 += red[(w * 3 + 1) * 64 + lane]; s2 += red[(w * 3 + 2) * 64 + lane]; }
            const float bb = p->in[I_ADAB][layer * 6144 + col];
            float* M = (float*)(p->ws + WS_MOD) + (size_t)layer * 3 * 6144 + col;
            M[0] = s0 + bb; M[6144] = s1 + bb; M[2 * 6144] = s2 + bb;
        }
        __syncthreads();
    }
    LAS float* scr = (LAS float*)(lds + wave * 16384);
    const int gw = blockIdx.x * NWAVES + wave, NGW = gridDim.x * NWAVES;
    ConvJob nj{}; float nrg[32];
    if (gw < IT_TOTAL) { nj = conv_job(p, gw); ti_load(nj.src, nj.src_ld, lane, nrg); }
    for (int it = gw; it < IT_TOTAL; it += NGW) {
        const ConvJob cj = nj; float crg[32];
#pragma unroll
        for (int i = 0; i < 32; ++i) crg[i] = nrg[i];
        if (it + NGW < IT_TOTAL) { nj = conv_job(p, it + NGW); ti_load(nj.src, nj.src_ld, lane, nrg); }
        ti_store(cj.src != nullptr, cj.fp8, crg, cj.dst, cj.dst_ldb, scr, lane);
    }
}

__device__ __forceinline__ void load_row(const float* row, int lane, f32x4 (&v)[4]) {
#pragma unroll
    for (int j = 0; j < 4; ++j) v[j] = ((const f32x4*)row)[lane + 64 * j];
}
__device__ __forceinline__ float row_rstd(const f32x4 (&v)[4]) {
    float s = 0.f;
#pragma unroll
    for (int j = 0; j < 4; ++j) s += (v[j].x * v[j].x + v[j].y * v[j].y) + (v[j].z * v[j].z + v[j].w * v[j].w);
    return rsqrtf(wave_sum(s) * (1.0f / D) + NORM_EPS);
}
__device__ __forceinline__ void norm_mod(const f32x4 (&v)[4], float rstd, const float* g, const float* shift, const float* scale, int lane, f32x4 (&h)[4]) {
#pragma unroll
    for (int j = 0; j < 4; ++j) {
        const f32x4 gg = ((const f32x4*)g)[lane + 64 * j], sh = ((const f32x4*)shift)[lane + 64 * j], sc = ((const f32x4*)scale)[lane + 64 * j];
        h[j] = v[j] * rstd * gg * (sc + 1.0f) + sh;
    }
}
__device__ __forceinline__ void store_row_bf16(bf16* row, int lane, const f32x4 (&h)[4]) {
#pragma unroll
    for (int j = 0; j < 4; ++j) { v2u w; w.x = pk2(h[j].x, h[j].y); w.y = pk2(h[j].z, h[j].w); ((v2u*)row)[lane + 64 * j] = w; }
}
__device__ __forceinline__ const float* resid_row(PP p, int layer0_inputs, int row) {
    if (layer0_inputs) return row < NLAT ? p->in[I_X] + (size_t)row * D : p->in[I_CTX] + (size_t)(row - NLAT) * D;
    return (const float*)(p->ws + WS_XR) + (size_t)row * D;
}
__device__ __forceinline__ void phase_norm0(PP p, int lane, int wave) {
    const int gw = blockIdx.x * NWAVES + wave, NGW = gridDim.x * NWAVES;
    f32x4 vn[4];
    if (gw < NROW) load_row(resid_row(p, 1, gw), lane, vn);
    for (int row = gw; row < NROW; row += NGW) {
        f32x4 v[4], h[4];
#pragma unroll
        for (int j = 0; j < 4; ++j) v[j] = vn[j];
        if (row + NGW < NROW) load_row(resid_row(p, 1, row + NGW), lane, vn);
        const float rstd = row_rstd(v); const int vec = row_vec(row);
        norm_mod(v, rstd, p->in[I_NMIX], modp(p, 0, vec, 0), modp(p, 0, vec, 1), lane, h);
        { unsigned* hp = (unsigned*)(p->ws + WS_H + (size_t)row * D);
#pragma unroll
          for (int j = 0; j < 4; ++j) hp[lane + 64 * j] = pk4_fp8(h[j].x, h[j].y, h[j].z, h[j].w); }
    }
}
__device__ __forceinline__ void route_select(float (&part)[NE], const float* rb, int row, float* TOPG, int* SLOT, unsigned* cnt, unsigned* ntl, unsigned* tof, int* TILEE, int lane, bool write, int (&slot)[TOPK]) {
#pragma unroll
    for (int e = 0; e < NE; ++e) part[e] = part[e] + rb[e];
    unsigned taken = 0u; int idx[TOPK]; float val[TOPK];
#pragma unroll
    for (int k = 0; k < TOPK; ++k) {
        float best = -3.0e38f; int bi = 0;
#pragma unroll
        for (int e = 0; e < NE; ++e) { const bool ok = !((taken >> e) & 1u) && (part[e] > best); best = ok ? part[e] : best; bi = ok ? e : bi; }
        taken |= 1u << bi; idx[k] = bi; val[k] = best;
    }
    float ex[TOPK], se = 0.f;
#pragma unroll
    for (int k = 0; k < TOPK; ++k) { ex[k] = __expf(val[k] - val[0]); se += ex[k]; }
    int sl[TOPK] = {0, 0, 0, 0};
    if (lane == 0 && write) {
        unsigned pos[TOPK]; int til[TOPK];
#pragma unroll
        for (int k = 0; k < TOPK; ++k) pos[k] = atomicAdd(cnt + idx[k] * CNT_STRIDE, 1u);
#pragma unroll
        for (int k = 0; k < TOPK; ++k) { til[k] = -1;
            if ((pos[k] & 255u) == 0u) { const unsigned t = atomicAdd(ntl, 1u); til[k] = (int)t; TILEE[1 + t] = idx[k];
                __hip_atomic_store(tof + idx[k] * TOF_PER + (pos[k] >> 8), t + 1u, __ATOMIC_RELAXED, __HIP_MEMORY_SCOPE_AGENT); } }
        unsigned tq[TOPK];
#pragma unroll
        for (int k = 0; k < TOPK; ++k) tq[k] = (til[k] < 0) ? __hip_atomic_load(tof + idx[k] * TOF_PER + (pos[k] >> 8), __ATOMIC_RELAXED, __HIP_MEMORY_SCOPE_AGENT) : 1u;
#pragma unroll
        for (int k = 0; k < TOPK; ++k) {
            if (til[k] < 0) { unsigned t1 = tq[k], spins = 0u;
                while (t1 == 0u && ++spins < (1u << 22)) { __builtin_amdgcn_s_sleep(1); t1 = __hip_atomic_load(tof + idx[k] * TOF_PER + (pos[k] >> 8), __ATOMIC_RELAXED, __HIP_MEMORY_SCOPE_AGENT); }
                til[k] = (int)t1 - 1; if (til[k] < 0) til[k] = 0; }
            sl[k] = til[k] * 256 + (int)(pos[k] & 255u);
            SLOT[row * 4 + k] = sl[k]; TOPG[row * 4 + k] = ex[k] * __builtin_amdgcn_rcpf(se);
        }
    }
#pragma unroll
    for (int k = 0; k < TOPK; ++k) slot[k] = __builtin_amdgcn_readfirstlane(sl[k]);
}
__device__ __forceinline__ void phase_ffn_norm_route4(PP p, int layer, int nrows, LAS unsigned char* lds, int tid, int lane, int wave) {
    const int gw = blockIdx.x * NWAVES + wave, NGW = gridDim.x * NWAVES;
    const float* rw = p->in[I_ROUTW] + (size_t)layer * D * NE; const float* rb = p->in[I_ROUTB] + layer * NE;
    float* TOPG = (float*)(p->ws + WS_ROUTE + RT_TOPG); int* SLOT = (int*)(p->ws + WS_ROUTE + RT_SLOT); int* TILEE = (int*)(p->ws + WS_ROUTE + RT_TILEE) + layer * 512;
    unsigned* ctl = (unsigned*)(p->ws + WS_CTL); unsigned* cnt = ctl + CW_CNT + layer * NE * CNT_STRIDE; unsigned* ntl = ctl + CW_NT + layer; unsigned* tof = ctl + CW_TOF + layer * NE * TOF_PER;
    unsigned char* XB = p->ws + WS_U + U_XB;
    constexpr int MAXR = 72;
    LAS unsigned* FP8I = (LAS unsigned*)(lds + 69632);
    LAS int* ROWE = (LAS int*)(lds + 143360); LAS int* ROWP = ROWE + MAXR * 4; LAS float* ROWG = (LAS float*)(ROWP + MAXR * 4);
    LAS unsigned* HIST = (LAS unsigned*)(ROWG + MAXR * 4); LAS unsigned* BASE = HIST + 32;
    if (tid < 32) HIST[tid] = 0u;
    __syncthreads();
    int nloc = 0;
    LAS float* hs = (LAS float*)(lds + wave * 8704);
    for (int row0 = gw; row0 < nrows; row0 += 2 * NGW) {
        const bool has1 = row0 + NGW < nrows; const int row1 = has1 ? row0 + NGW : row0;
#pragma unroll
        for (int r = 0; r < 2; ++r) { const int row = r ? row1 : row0;
            f32x4 v[4], h[4]; load_row((const float*)(p->ws + WS_XR) + (size_t)row * D, lane, v); const float rstd = row_rstd(v); const int vec = row_vec(row);
            norm_mod(v, rstd, p->in[I_NFFN] + layer * D, modp(p, layer, vec, 3), modp(p, layer, vec, 4), lane, h);
#pragma unroll
            for (int j = 0; j < 4; ++j)
#pragma unroll
                for (int i = 0; i < 4; ++i) hs[r * 1024 + (4 * j + i) * 64 + lane] = h[j][i]; }
        LDS_WAIT(); asm volatile("" ::: "memory");
        float pa[NE], pb[NE];
        {
            const int e4 = lane & 7, kq = lane >> 3;
            f32x4 qa = (f32x4){0.f, 0.f, 0.f, 0.f}, qb = (f32x4){0.f, 0.f, 0.f, 0.f};
#pragma unroll 4
            for (int t = 0; t < 32; ++t) {
                const int u = kq + 8 * t, l = u & 63, j = u >> 6;
                const f32x4* wr = (const f32x4*)(rw + (size_t)(4 * u) * NE) + e4;
#pragma unroll
                for (int i = 0; i < 4; ++i) { const f32x4 w4 = wr[i * (NE / 4)]; const float x0 = hs[(4 * j + i) * 64 + l], x1 = hs[1024 + (4 * j + i) * 64 + l];
                    qa = qa + x0 * w4; qb = qb + x1 * w4; }
            }
#pragma unroll
            for (int o = 8; o < 64; o <<= 1) {
#pragma unroll
                for (int c = 0; c < 4; ++c) { qa[c] += __shfl_xor(qa[c], o); qb[c] += __shfl_xor(qb[c], o); } }
            LAS float* lg = hs + 2048;
            if (kq == 0) { *(LAS f32x4*)(lg + 4 * e4) = qa; *(LAS f32x4*)(lg + 32 + 4 * e4) = qb; }
            LDS_WAIT(); asm volatile("" ::: "memory");
#pragma unroll
            for (int q4 = 0; q4 < 8; ++q4) { const f32x4 va = *(const LAS f32x4*)(lg + 4 * q4), vb = *(const LAS f32x4*)(lg + 32 + 4 * q4);
#pragma unroll
                for (int c = 0; c < 4; ++c) { pa[4 * q4 + c] = va[c]; pb[4 * q4 + c] = vb[c]; } }
        }
#pragma unroll
        for (int r = 0; r < 2; ++r) { if (r == 1 && !has1) break;
            float part[NE];
#pragma unroll
            for (int e = 0; e < NE; ++e) part[e] = (r ? pb[e] : pa[e]) + rb[e];
            unsigned taken = 0u; int idx[TOPK]; float val[TOPK];
#pragma unroll
            for (int k = 0; k < TOPK; ++k) {
                float best = -3.0e38f; int bi = 0;
#pragma unroll
                for (int e = 0; e < NE; ++e) { const bool ok = !((taken >> e) & 1u) && (part[e] > best); best = ok ? part[e] : best; bi = ok ? e : bi; }
                taken |= 1u << bi; idx[k] = bi; val[k] = best;
            }
            float ex[TOPK], se = 0.f;
#pragma unroll
            for (int k = 0; k < TOPK; ++k) { ex[k] = __expf(val[k] - val[0]); se += ex[k]; }
            const int rs = wave * 9 + nloc + r;
            if (lane == 0) {
#pragma unroll
                for (int k = 0; k < TOPK; ++k) { ROWE[rs * 4 + k] = idx[k]; ROWP[rs * 4 + k] = (int)__hip_atomic_fetch_add(HIST + idx[k], 1u, __ATOMIC_RELAXED, __HIP_MEMORY_SCOPE_WORKGROUP); ROWG[rs * 4 + k] = ex[k] * __builtin_amdgcn_rcpf(se); } }
#pragma unroll
            for (int j = 0; j < 4; ++j) { const LAS float* hp = hs + r * 1024 + (4 * j) * 64 + lane; FP8I[rs * 256 + lane + 64 * j] = pk4_fp8(hp[0], hp[64], hp[128], hp[192]); }
        }
        nloc += has1 ? 2 : 1;
        LDS_WAIT(); asm volatile("" ::: "memory");
    }
    __syncthreads();
    if (tid < 32) { const unsigned n = HIST[tid]; unsigned base = 0u;
        if (n) { base = atomicAdd(cnt + tid * CNT_STRIDE, n);
            for (unsigned pb2 = (base + 255u) & ~255u; pb2 < base + n; pb2 += 256u) { const unsigned t = atomicAdd(ntl, 1u); TILEE[1 + t] = tid;
                __hip_atomic_store(tof + tid * TOF_PER + (pb2 >> 8), t + 1u, __ATOMIC_RELAXED, __HIP_MEMORY_SCOPE_AGENT); } }
        BASE[tid] = base; }
    __syncthreads();
    int slv = 0;
    if (lane < 4 * nloc) { const int rs = wave * 9 + (lane >> 2), k = lane & 3, li = lane >> 2;
        const int row = gw + li * NGW;
        const int e = ROWE[rs * 4 + k]; const unsigned pos = BASE[e] + (unsigned)ROWP[rs * 4 + k]; unsigned t1 = 0u, spins = 0u;
        while ((t1 = __hip_atomic_load(tof + e * TOF_PER + (pos >> 8), __ATOMIC_RELAXED, __HIP_MEMORY_SCOPE_AGENT)) == 0u && ++spins < (1u << 22)) __builtin_amdgcn_s_sleep(1);
        int til = (int)t1 - 1; if (til < 0) til = 0;
        slv = til * 256 + (int)(pos & 255u); SLOT[row * 4 + k] = slv; TOPG[row * 4 + k] = ROWG[rs * 4 + k]; }
    for (int li = 0; li < nloc; ++li) { const int rs = wave * 9 + li; unsigned w[4];
#pragma unroll
        for (int j = 0; j < 4; ++j) w[j] = FP8I[rs * 256 + lane + 64 * j];
#pragma unroll
        for (int k = 0; k < TOPK; ++k) { unsigned* d = (unsigned*)(XB + (size_t)__builtin_amdgcn_readlane(slv, 4 * li + k) * D);
#pragma unroll
            for (int j = 0; j < 4; ++j) d[lane + 64 * j] = w[j]; } }
}
__device__ __forceinline__ void phase_ffn_norm_route(PP p, int layer, int nrows, LAS unsigned char* lds, int lane, int wave) {
    const int gw = blockIdx.x * NWAVES + wave, NGW = gridDim.x * NWAVES;
    const float* rw = p->in[I_ROUTW] + (size_t)layer * D * NE; const float* rb = p->in[I_ROUTB] + layer * NE;
    float* TOPG = (float*)(p->ws + WS_ROUTE + RT_TOPG); int* SLOT = (int*)(p->ws + WS_ROUTE + RT_SLOT); int* TILEE = (int*)(p->ws + WS_ROUTE + RT_TILEE) + layer * 512;
    unsigned* ctl = (unsigned*)(p->ws + WS_CTL); unsigned* cnt = ctl + CW_CNT + layer * NE * CNT_STRIDE; unsigned* ntl = ctl + CW_NT + layer; unsigned* tof = ctl + CW_TOF + layer * NE * TOF_PER;
    unsigned char* XB = p->ws + WS_U + U_XB;
    LAS float* hs = (LAS float*)(lds + wave * 8704);
    for (int row0 = gw; row0 < nrows; row0 += 2 * NGW) {
        const bool has1 = row0 + NGW < nrows; const int row1 = has1 ? row0 + NGW : row0;
#pragma unroll
        for (int r = 0; r < 2; ++r) { const int row = r ? row1 : row0;
            f32x4 v[4], h[4]; load_row((const float*)(p->ws + WS_XR) + (size_t)row * D, lane, v); const float rstd = row_rstd(v); const int vec = row_vec(row);
            norm_mod(v, rstd, p->in[I_NFFN] + layer * D, modp(p, layer, vec, 3), modp(p, layer, vec, 4), lane, h);
#pragma unroll
            for (int j = 0; j < 4; ++j)
#pragma unroll
                for (int i = 0; i < 4; ++i) hs[r * 1024 + (4 * j + i) * 64 + lane] = h[j][i]; }
        LDS_WAIT(); asm volatile("" ::: "memory");
        float pa[NE], pb[NE];
        {
            const int e4 = lane & 7, kq = lane >> 3;
            f32x4 qa = (f32x4){0.f, 0.f, 0.f, 0.f}, qb = (f32x4){0.f, 0.f, 0.f, 0.f};
#pragma unroll 4
            for (int t = 0; t < 32; ++t) {
                const int u = kq + 8 * t, l = u & 63, j = u >> 6;
                const f32x4* wr = (const f32x4*)(rw + (size_t)(4 * u) * NE) + e4;
#pragma unroll
                for (int i = 0; i < 4; ++i) { const f32x4 w4 = wr[i * (NE / 4)]; const float x0 = hs[(4 * j + i) * 64 + l], x1 = hs[1024 + (4 * j + i) * 64 + l];
                    qa = qa + x0 * w4; qb = qb + x1 * w4; }
            }
#pragma unroll
            for (int o = 8; o < 64; o <<= 1) {
#pragma unroll
                for (int c = 0; c < 4; ++c) { qa[c] += __shfl_xor(qa[c], o); qb[c] += __shfl_xor(qb[c], o); } }
            LAS float* lg = hs + 2048;
            if (kq == 0) { *(LAS f32x4*)(lg + 4 * e4) = qa; *(LAS f32x4*)(lg + 32 + 4 * e4) = qb; }
            LDS_WAIT(); asm volatile("" ::: "memory");
#pragma unroll
            for (int q4 = 0; q4 < 8; ++q4) { const f32x4 va = *(const LAS f32x4*)(lg + 4 * q4), vb = *(const LAS f32x4*)(lg + 32 + 4 * q4);
#pragma unroll
                for (int c = 0; c < 4; ++c) { pa[4 * q4 + c] = va[c]; pb[4 * q4 + c] = vb[c]; } }
        }
        int s0[TOPK], s1[TOPK];
        route_select(pa, rb, row0, TOPG, SLOT, cnt, ntl, tof, TILEE, lane, true, s0);
        route_select(pb, rb, row1, TOPG, SLOT, cnt, ntl, tof, TILEE, lane, has1, s1);
#pragma unroll
        for (int r = 0; r < 2; ++r) { if (r == 1 && !has1) break;
            unsigned w[4];
#pragma unroll
            for (int j = 0; j < 4; ++j) { const LAS float* hp = hs + r * 1024 + (4 * j) * 64 + lane; w[j] = pk4_fp8(hp[0], hp[64], hp[128], hp[192]); }
#pragma unroll
            for (int k = 0; k < TOPK; ++k) { unsigned* d = (unsigned*)(XB + (size_t)(r ? s1[k] : s0[k]) * D);
#pragma unroll
                for (int j = 0; j < 4; ++j) d[lane + 64 * j] = w[j]; } }
        LDS_WAIT(); asm volatile("" ::: "memory");
    }
}
__device__ __forceinline__ void phase_combine(PP p, int layer, int nrows, bool final_out, int lane, int wave) {
    const int gw = blockIdx.x * NWAVES + wave, NGW = gridDim.x * NWAVES;
    const float* TOPG = (const float*)(p->ws + WS_ROUTE + RT_TOPG); const int* SLOT = (const int*)(p->ws + WS_ROUTE + RT_SLOT);
    const bf16* YS = (const bf16*)(p->ws + WS_U + U_YS); float* XR = (float*)(p->ws + WS_XR); float* RSTD = (float*)(p->ws + WS_ROUTE + RT_RSTD);
    f32x4 vn[4]; f32x4 gn4 = (f32x4){0.f, 0.f, 0.f, 0.f}; int sn[4] = {0, 0, 0, 0};
    if (gw < nrows) { load_row(XR + (size_t)gw * D, lane, vn); gn4 = *(const f32x4*)(TOPG + gw * 4);
#pragma unroll
        for (int k = 0; k < TOPK; ++k) sn[k] = SLOT[gw * 4 + k]; }
    for (int row = gw; row < nrows; row += NGW) {
        f32x4 v[4], acc[4]; const f32x4 g4 = gn4; int sc[4];
#pragma unroll
        for (int j = 0; j < 4; ++j) { v[j] = vn[j]; sc[j] = sn[j]; }
        if (row + NGW < nrows) { const int rn = row + NGW; load_row(XR + (size_t)rn * D, lane, vn); gn4 = *(const f32x4*)(TOPG + rn * 4);
#pragma unroll
            for (int k = 0; k < TOPK; ++k) sn[k] = SLOT[rn * 4 + k]; }
#pragma unroll
        for (int j = 0; j < 4; ++j) acc[j] = (f32x4){0.f, 0.f, 0.f, 0.f};
#pragma unroll
        for (int k = 0; k < TOPK; ++k) {
            const float gk = g4[k]; const v2u* ys = (const v2u*)(YS + (size_t)sc[k] * D);
#pragma unroll
            for (int j = 0; j < 4; ++j) { const v2u w = ys[lane + 64 * j];
                acc[j].x += gk * bf2f(w.x & 0xffffu); acc[j].y += gk * bf2f(w.x >> 16); acc[j].z += gk * bf2f(w.y & 0xffffu); acc[j].w += gk * bf2f(w.y >> 16); }
        }
        const float* m5 = modp(p, layer, row_vec(row), 5);
#pragma unroll
        for (int j = 0; j < 4; ++j) v[j] = v[j] + ((const f32x4*)m5)[lane + 64 * j] * acc[j];
        const float rstd = row_rstd(v);
        if (final_out) {
#pragma unroll
            for (int j = 0; j < 4; ++j) ((f32x4*)(p->out + (size_t)row * D))[lane + 64 * j] = v[j] * rstd * ((const f32x4*)p->in[I_FINALG])[lane + 64 * j];
        } else {
#pragma unroll
            for (int j = 0; j < 4; ++j) ((f32x4*)(XR + (size_t)row * D))[lane + 64 * j] = v[j];
            if (lane == 0) RSTD[row] = rstd;
        }
    }
}

__device__ __forceinline__ int step_row(int b, int dir, int step) {
    if (step < CTXL) { const int t = dir ? (CTXL - 1 - step) : step; return NLAT + b * CTXL + t; }
    const int s = step - CTXL; const int t = dir ? (SEQ - 1 - s) : s; return b * SEQ + t;
}
constexpr int NSTEP = CTXL + SEQ;

__device__ __forceinline__ void phase_hg_readout(PP p, int lane, int wave) {
    const int gw = blockIdx.x * NWAVES + wave, NGW = gridDim.x * NWAVES;
    const bf16* Z = (const bf16*)(p->ws + WS_U + U_Z); const float* OD = (const float*)(p->ws + WS_U + U_OD0); bf16* A2 = (bf16*)(p->ws + WS_A2);
    const float* gn = p->in[I_HGGN];
    for (int row = gw; row < NROW; row += NGW) {
#pragma unroll
        for (int h = 0; h < 8; ++h) {
            const int c = h * 128 + 2 * lane;
            const float2 a = *(const float2*)(OD + (size_t)row * D + c), bq = *(const float2*)(OD + (size_t)(NROW + row) * D + c);
            const float o0 = a.x + bq.x, o1 = a.y + bq.y;
            const float rstd = rsqrtf(wave_sum(o0 * o0 + o1 * o1) * (1.0f / 128.0f) + NORM_EPS);
            const unsigned gz = *(const unsigned*)(Z + (size_t)row * 5120 + 4096 + c); const float g0 = bf2f(gz & 0xffffu), g1 = bf2f(gz >> 16);
            const float r0 = o0 * rstd * gn[2 * lane] * (g0 * sigm(g0)), r1 = o1 * rstd * gn[2 * lane + 1] * (g1 * sigm(g1));
            *(unsigned*)(A2 + (size_t)row * D + c) = pk2(r0, r1);
        }
    }
}

__device__ __forceinline__ void phase_lerp(PP p, LAS unsigned char* lds, int tid, int lane, int wave) {
    const int gw = blockIdx.x * NWAVES + wave, NGW = gridDim.x * NWAVES;
    const float* XR = (const float*)(p->ws + WS_XR); const float* RSTD = (const float*)(p->ws + WS_ROUTE + RT_RSTD);
    bf16* XL6 = (bf16*)(p->ws + WS_U + U_XL6); const float* g = p->in[I_NMIX] + D; const float* mu = p->in[I_MU];
    LAS float* TGS = (LAS float*)lds;
    LAS float* TS0 = TGS + 3 * D;
    LAS float* TMU = TS0 + 3 * D;
#pragma unroll
    for (int u = tid; u < 3 * D; u += NTHREADS) { const int vec = u >> 10, c = u & (D - 1); TGS[u] = g[c] * (modp(p, 1, vec, 1)[c] + 1.0f); TS0[u] = modp(p, 1, vec, 0)[c]; }
#pragma unroll
    for (int u = tid; u < 6 * D; u += NTHREADS) { const int s = u >> 10, c = u & (D - 1); const int m = (s == 0) ? 0 : (s == 1) ? 2 : (s == 2) ? 3 : (s == 3) ? 1 : (s == 4) ? 4 : 5; TMU[u] = mu[m * D + c]; }
    __syncthreads();
    auto nbrs = [&](int row, int (&nb)[4]) {
        if (row < NLAT) { const int t = row & (SEQ - 1), w = t & 63, r = t >> 6;
            nb[0] = (w >= 1) ? row - 1 : -1; nb[1] = (w < 63) ? row + 1 : -1; nb[2] = (r >= 1) ? row - 64 : -1; nb[3] = (r < SEQ / 64 - 1) ? row + 64 : -1;
        } else { const int t = (row - NLAT) & (CTXL - 1);
            nb[0] = nb[1] = (t >= 1) ? row - 1 : -1; nb[2] = nb[3] = (t < CTXL - 1) ? row + 1 : -1; } };
    f32x4 nxs[4], nxn[4]; float nrs = 0.f, nrn[4] = {0.f, 0.f, 0.f, 0.f};
    auto fetch = [&](int row) { int nb[4]; nbrs(row, nb); nrs = RSTD[row];
#pragma unroll
        for (int j = 0; j < 4; ++j) { const int ci = lane + 64 * j; nxs[j] = ((const f32x4*)(XR + (size_t)row * D))[ci];
            const int nr = nb[j] >= 0 ? nb[j] : row; nxn[j] = ((const f32x4*)(XR + (size_t)nr * D))[ci]; nrn[j] = nb[j] >= 0 ? RSTD[nr] : 0.f; } };
    if (gw < NROW) fetch(gw);
    for (int row = gw; row < NROW; row += NGW) {
        const int vec = row_vec(row); int nb[4]; nbrs(row, nb);
        f32x4 xs[4], xn[4]; float rn[4]; const float rs = nrs;
#pragma unroll
        for (int j = 0; j < 4; ++j) { xs[j] = nxs[j]; xn[j] = nxn[j]; rn[j] = nrn[j]; }
        if (row + NGW < NROW) fetch(row + NGW);
#pragma unroll
        for (int j = 0; j < 4; ++j) {
            const int ci = lane + 64 * j;
            const f32x4 gs = ((const LAS f32x4*)(TGS + vec * D))[ci], s0 = ((const LAS f32x4*)(TS0 + vec * D))[ci];
            const f32x4 hs = xs[j] * rs * gs + s0;
            f32x4 hn = (f32x4){0.f, 0.f, 0.f, 0.f};
            if (nb[j] >= 0) hn = xn[j] * rn[j] * gs + s0;
            const f32x4 dx = hn - hs;
#pragma unroll
            for (int s = 0; s < 6; ++s) {
                const f32x4 o = hs + dx * ((const LAS f32x4*)(TMU + s * D))[ci];
                v2u w; w.x = pk2(o.x, o.y); w.y = pk2(o.z, o.w);
                ((v2u*)(XL6 + ((size_t)s * NROW + row) * D))[ci] = w;
            }
        }
    }
    __syncthreads();
}
__device__ __forceinline__ float row16_allsum(float x) {
    x += __builtin_bit_cast(float, __builtin_amdgcn_update_dpp(0, __builtin_bit_cast(int, x), 0x128, 0xf, 0xf, false));
    x += __builtin_bit_cast(float, __builtin_amdgcn_update_dpp(0, __builtin_bit_cast(int, x), 0x124, 0xf, 0xf, false));
    x += __builtin_bit_cast(float, __builtin_amdgcn_update_dpp(0, __builtin_bit_cast(int, x), 0x122, 0xf, 0xf, false));
    x += __builtin_bit_cast(float, __builtin_amdgcn_update_dpp(0, __builtin_bit_cast(int, x), 0x121, 0xf, 0xf, false));
    return x;
}
__device__ __forceinline__ f32x4 bf4(v2u w) { return (f32x4){bf2f(w.x & 0xffffu), bf2f(w.x >> 16), bf2f(w.y & 0xffffu), bf2f(w.y >> 16)}; }
__device__ __forceinline__ void phase_rw_readout(PP p, int lane, int wave) {
    const int gw = blockIdx.x * NWAVES + wave, NGW = gridDim.x * NWAVES;
    const bf16* RKV = (const bf16*)(p->ws + WS_U + U_RKV); const bf16* AD = (const bf16*)(p->ws + WS_U + U_AD); const bf16* G = (const bf16*)(p->ws + WS_U + U_G);
    const float* OD = (const float*)(p->ws + WS_U + U_OD1); bf16* A2 = (bf16*)(p->ws + WS_A2);
    const int hq = lane >> 4, c4 = lane & 15, slab = c4 >> 2, v0 = (4 * c4) & 15;
    f32x4 lw[4], lb[4], ka[4], rk[4];
#pragma unroll
    for (int hg = 0; hg < 4; ++hg) { const int ch = (4 * hg + hq) * 64 + 4 * c4;
        lw[hg] = *(const f32x4*)(p->in[I_LNXW] + ch); lb[hg] = *(const f32x4*)(p->in[I_LNXB] + ch); ka[hg] = *(const f32x4*)(p->in[I_KA] + ch); rk[hg] = *(const f32x4*)(p->in[I_RK] + ch); }
    for (int row = gw; row < NLAT; row += NGW) {
        const int bq = row >> 13, tq = row & (SEQ - 1);
        f32x4 y0[4], y1[4]; v2u lr[4], lk[4], lv[4], la0[4], la1[4], lg[4];
#pragma unroll
        for (int hg = 0; hg < 4; ++hg) {
            const int h = 4 * hg + hq, ch = h * 64 + 4 * c4;
            const int u0 = (bq * 32 + h) * 4 + slab, u1 = (bq * 32 + 16 + h) * 4 + slab;
            y0[hg] = *(const f32x4*)(OD + ((size_t)u0 * NSTEP + CTXL + tq) * 16 + v0); y1[hg] = *(const f32x4*)(OD + ((size_t)u1 * NSTEP + CTXL + (SEQ - 1 - tq)) * 16 + v0);
            lr[hg] = *(const v2u*)(RKV + (size_t)row * 3072 + ch); lk[hg] = *(const v2u*)(RKV + (size_t)row * 3072 + 1024 + ch); lv[hg] = *(const v2u*)(RKV + (size_t)row * 3072 + 2048 + ch);
            la0[hg] = *(const v2u*)(AD + (size_t)row * D + ch); la1[hg] = *(const v2u*)(AD + ((size_t)NROW + row) * D + ch); lg[hg] = *(const v2u*)(G + (size_t)row * D + ch);
        }
#pragma unroll
        for (int hg = 0; hg < 4; ++hg) {
            const int h = 4 * hg + hq, ch = h * 64 + 4 * c4;
            const f32x4 y = y0[hg] + y1[hg];
            const f32x4 r = bf4(lr[hg]), k = bf4(lk[hg]), v = bf4(lv[hg]);
            const f32x4 a0 = bf4(la0[hg]), a1 = bf4(la1[hg]), g = bf4(lg[hg]);
            const float mean = row16_allsum((y[0] + y[1]) + (y[2] + y[3])) * (1.0f / 64.0f);
            const f32x4 d = y - mean;
            const float var = row16_allsum((d[0] * d[0] + d[1] * d[1]) + (d[2] * d[2] + d[3] * d[3])) * (1.0f / 64.0f);
            f32x4 yn = d * rsqrtf(var + 64.0e-5f) * lw[hg] + lb[hg];
            const f32x4 kd0 = k * ((a0 - 1.0f) * ka[hg] + 1.0f), kd1 = k * ((a1 - 1.0f) * ka[hg] + 1.0f);
            const f32x4 t0 = r * kd0 * rk[hg], t1 = r * kd1 * rk[hg];
            const float s0 = row16_allsum((t0[0] + t0[1]) + (t0[2] + t0[3])), s1 = row16_allsum((t1[0] + t1[1]) + (t1[2] + t1[3]));
            yn = yn + v * (s0 + s1);
            const f32x4 o = yn * g;
            v2u w; w.x = pk2(o[0], o[1]); w.y = pk2(o[2], o[3]);
            *(v2u*)(A2 + (size_t)row * D + ch) = w;
        }
    }
}

namespace pg8 {
struct SelOrder : StaticOrder {
    int div, sel0; size_t stride;
    __device__ __forceinline__ const char* abase(const Gemm& g, const Unit& u, size_t tstep) const { return (const char*)g.A + (size_t)(sel0 + u.pn / div) * stride + (size_t)u.pm * tstep; }
};
struct RkvL1Order {
    StaticOrder s1, s2; int G, c; const bf16_t* B2; size_t stride;
    __device__ __forceinline__ void init(int M, int G_, int c_, const bf16_t* b2, size_t st) { s1.init(M, 3072, G_, 0); s2.init(M, 768, G_, 0); G = G_; c = c_; B2 = b2; stride = st; }
    __device__ __forceinline__ bool next(int i, Unit& u) const { const long L = (long)i * G + c; if (L < s1.nwg) return s1.at(L, u); if (!s2.at(L - s1.nwg, u)) return false; u.e = 1; return true; }
    __device__ __forceinline__ const char* abase(const Gemm& g, const Unit& u, size_t tstep) const { return (const char*)g.A + (size_t)(u.e ? 3 + u.pn : u.pn / 4) * stride + (size_t)u.pm * tstep; }
    __device__ __forceinline__ const char* bbase(const Gemm& g, const Unit& u, size_t tstep) const { return (const char*)(u.e ? B2 : g.Bt) + (size_t)u.pn * tstep; }
    __device__ __forceinline__ void a_ready(const Unit&) const {}
    __device__ __forceinline__ void done(const Unit&) const {}
};
struct MoeOrder {
    const int* tilee; const PG8_LAS int* ord; int nt, ntn, G, c; size_t estride;
    __device__ __forceinline__ void init(const int* te, int nt_, PG8_LAS int* ordbuf, int ntn_, size_t es, int G_, int c_) {
        tilee = te; nt = nt_; ntn = ntn_; estride = es; G = G_; c = c_; ord = ordbuf;
        { const int t = threadIdx.x; PG8_LAS int* E = ordbuf + 512;
          int et = 0; if (t < nt) { et = te[1 + t]; E[t] = et; }
          asm volatile("s_waitcnt vmcnt(0) lgkmcnt(0)" ::: "memory"); __builtin_amdgcn_s_barrier(); asm volatile("" ::: "memory");
          if (t < nt) { int rank = 0;
#pragma unroll 8
              for (int u = 0; u < nt; ++u) { const int eu = E[u]; rank += (eu < et || (eu == et && u < t)) ? 1 : 0; }
              ordbuf[rank] = t; } }
        asm volatile("s_waitcnt lgkmcnt(0)" ::: "memory"); __builtin_amdgcn_s_barrier(); asm volatile("" ::: "memory");
    }
    __device__ __forceinline__ bool next(int i, Unit& u) const { const long L = (long)i * G + c; if (L >= (long)nt * ntn) return false; u.pm = ord[(int)(L / ntn)]; u.pn = (int)(L % ntn); u.e = tilee[1 + u.pm]; return true; }
    __device__ __forceinline__ const char* abase(const Gemm& g, const Unit& u, size_t tstep) const { return (const char*)g.A + (size_t)u.pm * tstep; }
    __device__ __forceinline__ const char* bbase(const Gemm& g, const Unit& u, size_t tstep) const { return (const char*)g.Bt + (size_t)u.e * estride + (size_t)u.pn * tstep; }
    __device__ __forceinline__ void a_ready(const Unit&) const {}
    __device__ __forceinline__ void done(const Unit&) const {}
};
struct EpiStoreBf16 {
    struct Pre {};
    static constexpr bool PERM = true, AFTER_DRAIN = false;
    bf16_t* O; int ldc;
    __device__ __forceinline__ void operator()(const f32x4 (&acc)[2][2][4][2], const Unit& u, int wr, int wc, int fr, int fq) const {
        const int row0 = u.pm * BM + wr * 64 + fr, col0 = u.pn * BM + wc * 32 + 8 * fq;
#pragma unroll
        for (int ai = 0; ai < 2; ++ai)
#pragma unroll
            for (int m = 0; m < 4; ++m) { bf16_t* rowp = O + (size_t)(row0 + ai * HALF + m * 16) * ldc + col0;
#pragma unroll
                for (int bj = 0; bj < 2; ++bj) { const f32x4 v0 = acc[ai][bj][m][0], v1 = acc[ai][bj][m][1];
                    u32x4 w; w.x = cvt_pk_bf16(v0[0], v0[1]); w.y = cvt_pk_bf16(v0[2], v0[3]); w.z = cvt_pk_bf16(v1[0], v1[1]); w.w = cvt_pk_bf16(v1[2], v1[3]);
                    *(u32x4*)(rowp + bj * HALF) = w; } }
    }
};
struct EpiStoreF32 {
    struct Pre {};
    static constexpr bool PERM = false, AFTER_DRAIN = false;
    float* C; int ldc;
    __device__ __forceinline__ void operator()(const f32x4 (&acc)[2][2][4][2], const Unit& u, int wr, int wc, int fr, int fq) const {
        const int row0 = u.pm * BM + wr * 64 + fr, col0 = u.pn * BM + wc * 32 + 4 * fq;
#pragma unroll
        for (int ai = 0; ai < 2; ++ai)
#pragma unroll
            for (int m = 0; m < 4; ++m) { float* rowp = C + (size_t)(row0 + ai * HALF + m * 16) * ldc + col0;
#pragma unroll
                for (int bj = 0; bj < 2; ++bj)
#pragma unroll
                    for (int n = 0; n < 2; ++n) *(f32x4*)(rowp + bj * HALF + n * 16) = acc[ai][bj][m][n]; }
    }
};
struct EpiResid {
    struct Pre {};
    static constexpr bool PERM = false, AFTER_DRAIN = false;
    const float* base_lat; const float* base_ctx; float* out; const float* gate; int gstride;
    __device__ __forceinline__ void operator()(const f32x4 (&acc)[2][2][4][2], const Unit& u, int wr, int wc, int fr, int fq) const {
        const int row0 = u.pm * BM + wr * 64 + fr, col0 = u.pn * BM + wc * 32 + 4 * fq;
#pragma unroll
        for (int ai = 0; ai < 2; ++ai)
#pragma unroll
            for (int m = 0; m < 4; ++m) { const int row = row0 + ai * HALF + m * 16;
                const float* bp = (row < 16384) ? base_lat + (size_t)row * 1024 : base_ctx + (size_t)(row - 16384) * 1024;
                const float* gp = gate + (size_t)(row < 16384 ? (row >= 8192 ? 1 : 0) : 2) * gstride;
                float* op = out + (size_t)row * 1024;
#pragma unroll
                for (int bj = 0; bj < 2; ++bj)
#pragma unroll
                    for (int n = 0; n < 2; ++n) { const int c = col0 + bj * HALF + n * 16;
                        *(f32x4*)(op + c) = *(const f32x4*)(bp + c) + *(const f32x4*)(gp + c) * acc[ai][bj][m][n]; } }
    }
};
__device__ __forceinline__ float sigm_(float x) { return __builtin_amdgcn_rcpf(1.0f + __expf(-x)); }
struct EpiSwiglu {
    static constexpr bool PERM = true, AFTER_DRAIN = false;
    PP p; int layer;
    struct Pre { f32x4 bgv[2], buv[2]; };
    __device__ __forceinline__ void prefetch(const Unit& u, int wr, int wc, int fr, int fq, Pre& pre) const {
        PP q_ = p; asm volatile("" : "+s"(q_));
        const float* bg = q_->in[I_BGU] + (size_t)layer * NE * 2048 + (size_t)u.e * 2048 + u.pn * HALF + wc * 32 + 8 * fq;
#pragma unroll
        for (int n = 0; n < 2; ++n) { pre.bgv[n] = *(const f32x4*)(bg + 4 * n); pre.buv[n] = *(const f32x4*)(bg + 1024 + 4 * n); }
    }
    __device__ __forceinline__ void operator()(const f32x4 (&acc)[2][2][4][2], const Unit& u, int wr, int wc, int fr, int fq, const Pre& pre) const {
        PP q_ = p; asm volatile("" : "+s"(q_));
        unsigned char* O = q_->ws + WS_U + U_ACT;
        const int row0 = u.pm * BM + wr * 64 + fr, col0 = u.pn * HALF + wc * 32 + 8 * fq;
        f32x4 bgv[2], buv[2];
#pragma unroll
        for (int n = 0; n < 2; ++n) { bgv[n] = pre.bgv[n]; buv[n] = pre.buv[n]; }
#pragma unroll
        for (int ai = 0; ai < 2; ++ai)
#pragma unroll
            for (int m = 0; m < 4; ++m) { float r[8];
#pragma unroll
                for (int n = 0; n < 2; ++n) { const f32x4 g4 = acc[ai][0][m][n] + bgv[n], u4 = acc[ai][1][m][n] + buv[n];
#pragma unroll
                    for (int j = 0; j < 4; ++j) { const float g = fminf(g4[j], 7.0f), uu = fminf(fmaxf(u4[j], -7.0f), 7.0f); r[4 * n + j] = g * sigm_(1.702f * g) * (uu + 1.0f); } }
                unsigned w0 = 0u, w1 = 0u;
                w0 = __builtin_amdgcn_cvt_pk_fp8_f32(r[0], r[1], w0, false); w0 = __builtin_amdgcn_cvt_pk_fp8_f32(r[2], r[3], w0, true);
                w1 = __builtin_amdgcn_cvt_pk_fp8_f32(r[4], r[5], w1, false); w1 = __builtin_amdgcn_cvt_pk_fp8_f32(r[6], r[7], w1, true);
                *(unsigned long long*)(O + (size_t)(row0 + ai * HALF + m * 16) * 1024 + col0) = (unsigned long long)w0 | ((unsigned long long)w1 << 32); }
    }
};
struct EpiDown {
    static constexpr bool PERM = true, AFTER_DRAIN = false;
    PP p; int layer;
    struct Pre { f32x4 bv[2][2]; };
    __device__ __forceinline__ void prefetch(const Unit& u, int wr, int wc, int fr, int fq, Pre& pre) const {
        PP q_ = p; asm volatile("" : "+s"(q_));
        const float* bp = q_->in[I_BDN] + (size_t)layer * NE * 1024 + (size_t)u.e * 1024 + u.pn * BM + wc * 32 + 8 * fq;
#pragma unroll
        for (int bj = 0; bj < 2; ++bj)
#pragma unroll
            for (int n = 0; n < 2; ++n) pre.bv[bj][n] = *(const f32x4*)(bp + bj * HALF + 4 * n);
    }
    __device__ __forceinline__ void operator()(const f32x4 (&acc)[2][2][4][2], const Unit& u, int wr, int wc, int fr, int fq, const Pre& pre) const {
        PP q_ = p; asm volatile("" : "+s"(q_));
        bf16_t* O = (bf16_t*)(q_->ws + WS_U + U_YS);
        const int row0 = u.pm * BM + wr * 64 + fr, col0 = u.pn * BM + wc * 32 + 8 * fq;
        f32x4 bv[2][2];
#pragma unroll
        for (int bj = 0; bj < 2; ++bj)
#pragma unroll
            for (int n = 0; n < 2; ++n) bv[bj][n] = pre.bv[bj][n];
#pragma unroll
        for (int ai = 0; ai < 2; ++ai)
#pragma unroll
            for (int m = 0; m < 4; ++m) { bf16_t* rowp = O + (size_t)(row0 + ai * HALF + m * 16) * 1024 + col0;
#pragma unroll
                for (int bj = 0; bj < 2; ++bj) { const f32x4 v0 = acc[ai][bj][m][0] + bv[bj][0], v1 = acc[ai][bj][m][1] + bv[bj][1];
                    u32x4 w; w.x = cvt_pk_bf16(v0[0], v0[1]); w.y = cvt_pk_bf16(v0[2], v0[3]); w.z = cvt_pk_bf16(v1[0], v1[1]); w.w = cvt_pk_bf16(v1[2], v1[3]);
                    *(u32x4*)(rowp + bj * HALF) = w; } }
    }
};
struct EpiLora1 {
    struct Pre {};
    static constexpr bool PERM = true, AFTER_DRAIN = false;
    bf16_t* O;
    __device__ __forceinline__ void operator()(const f32x4 (&acc)[2][2][4][2], const Unit& u, int wr, int wc, int fr, int fq) const {
        const int row0 = u.pm * BM + wr * 64 + fr, col0 = u.pn * HALF + wc * 32 + 8 * fq;
#pragma unroll
        for (int ai = 0; ai < 2; ++ai)
#pragma unroll
            for (int m = 0; m < 4; ++m) { float r[8];
#pragma unroll
                for (int n = 0; n < 2; ++n)
#pragma unroll
                    for (int j = 0; j < 4; ++j) { const float x = acc[ai][0][m][n][j]; r[4 * n + j] = (u.pn == 0) ? (2.0f * sigm_(2.0f * x) - 1.0f) : (u.pn == 1) ? x : sigm_(x); }
                u32x4 w; w.x = cvt_pk_bf16(r[0], r[1]); w.y = cvt_pk_bf16(r[2], r[3]); w.z = cvt_pk_bf16(r[4], r[5]); w.w = cvt_pk_bf16(r[6], r[7]);
                *(u32x4*)(O + (size_t)(row0 + ai * HALF + m * 16) * 384 + col0) = w; }
    }
};
struct EpiRkvL1 {
    struct Pre {};
    static constexpr bool PERM = true, AFTER_DRAIN = false;
    EpiStoreBf16 rkv; EpiLora1 l1;
    __device__ __forceinline__ void operator()(const f32x4 (&acc)[2][2][4][2], const Unit& u, int wr, int wc, int fr, int fq) const { if (u.e) l1(acc, u, wr, wc, fr, fq); else rkv(acc, u, wr, wc, fr, fq); }
};
struct EpiLora2 {
    struct Pre {};
    static constexpr bool PERM = false, AFTER_DRAIN = false;
    bf16_t* WD; bf16_t* AD; bf16_t* G; const float* w0; const float* a0;
    __device__ __forceinline__ void operator()(const f32x4 (&acc)[2][2][4][2], const Unit& u, int wr, int wc, int fr, int fq) const {
        const int row0 = u.pm * BM + wr * 64 + fr, blk = u.pn >> 2, col0 = (u.pn & 3) * BM + wc * 32 + 4 * fq;
        bf16_t* dst = (blk < 2) ? WD + (size_t)blk * 16896 * 1024 : (blk < 4) ? AD + (size_t)(blk - 2) * 16896 * 1024 : G;
        const float* bias = (blk < 2) ? w0 + blk * 1024 : a0 + ((blk - 2) & 1) * 1024;
#pragma unroll
        for (int ai = 0; ai < 2; ++ai)
#pragma unroll
            for (int m = 0; m < 4; ++m) { bf16_t* rowp = dst + (size_t)(row0 + ai * HALF + m * 16) * 1024;
#pragma unroll
                for (int bj = 0; bj < 2; ++bj)
#pragma unroll
                    for (int n = 0; n < 2; ++n) { const int c = col0 + bj * HALF + n * 16; f32x4 v = acc[ai][bj][m][n];
                        const f32x4 bb = *(const f32x4*)(bias + c);
                        if (blk < 2) { for (int j = 0; j < 4; ++j) v[j] = -0.60653066f * sigm_(v[j] + bb[j]); }
                        else if (blk < 4) { for (int j = 0; j < 4; ++j) v[j] = sigm_(v[j] + bb[j]); }
                        unsigned lo = cvt_pk_bf16(v[0], v[1]), hi = cvt_pk_bf16(v[2], v[3]);
                        *(unsigned long long*)(rowp + c) = (unsigned long long)lo | ((unsigned long long)hi << 32); }
                asm volatile("" ::: "memory"); }
    }
};
}

constexpr int GLA_NCH = NSTEP / 64;
constexpr int GLA_ITEMS = 2 * NBATCH * GLA_NCH * 8;
constexpr size_t U_DS = 298 * MiB, U_OI = 430 * MiB, U_QT = 562 * MiB, U_LAM = 628 * MiB;
typedef short bf16x8_t __attribute__((ext_vector_type(8)));
typedef float f32x2g __attribute__((ext_vector_type(2)));
__device__ __forceinline__ f32x4 mfma16(bf16x8_t a, bf16x8_t b, f32x4 c) { return __builtin_amdgcn_mfma_f32_16x16x32_bf16(a, b, c, 0, 0, 0); }

__device__ __forceinline__ void phase_gla_prep(PP p, LAS unsigned char* lds, int tid, int lane, int wave) {
    constexpr int PQ = 272, PT = 144;
    LAS unsigned char* QA = lds;
    LAS unsigned char* QX = QA + 64 * PQ;
    LAS unsigned char* KB = QX + 48 * PQ;
    LAS unsigned char* KD = KB + 64 * PQ;
    LAS unsigned char* KT = KD + 64 * PQ;
    LAS unsigned char* VT = KT + 128 * PT;
    LAS unsigned char* PI = VT + 128 * PT;
    LAS float* GT = (LAS float*)(PI + 64 * PT);
    const bf16* Z = (const bf16*)(p->ws + WS_U + U_Z);
    bf16* DS = (bf16*)(p->ws + WS_U + U_DS); v2u* OI = (v2u*)(p->ws + WS_U + U_OI); bf16* QT = (bf16*)(p->ws + WS_U + U_QT); float* LAM = (float*)(p->ws + WS_U + U_LAM);
    const int kp = tid & 63, gg = tid >> 6, g = gg >> 1, hh = gg & 1, k0 = 2 * kp, kq = lane >> 4, c16 = lane & 15;
    unsigned zf[8], zq[8], zv[8];
    f32x2g nlb[3] = {};
    auto ldz = [&](int item2) {
        const int h2 = item2 & 7, cc2 = (item2 >> 3) % GLA_NCH, db2 = (item2 >> 3) / GLA_NCH, b2 = db2 & 1, dir2 = db2 >> 1;
        { const float* lb = p->in[I_HGLB] + (size_t)dir2 * 3 * D + h2 * 128 + k0; nlb[0] = *(const f32x2g*)lb; nlb[1] = *(const f32x2g*)(lb + D); nlb[2] = *(const f32x2g*)(lb + 2 * D); }
#pragma unroll
        for (int i = 0; i < 8; ++i) { const size_t zr = (size_t)step_row(b2, dir2, 64 * cc2 + 8 * gg + i) * 5120 + h2 * 128 + k0;
            zf[i] = *(const unsigned*)(Z + zr + 1024 * (1 + dir2)); zq[i] = *(const unsigned*)(Z + zr); zv[i] = *(const unsigned*)(Z + zr + 3072); } };
    if ((int)blockIdx.x < GLA_ITEMS) ldz(blockIdx.x);
    for (int item = blockIdx.x; item < GLA_ITEMS; item += gridDim.x) {
        const int h = item & 7, db = (item >> 3) / GLA_NCH, dir = db >> 1;
        float lbv[2];
#pragma unroll
        for (int e = 0; e < 2; ++e) { const float a0 = e ? nlb[0].y : nlb[0].x, a1 = e ? nlb[1].y : nlb[1].x, a2 = e ? nlb[2].y : nlb[2].x;
            const float mx = fmaxf(a0, fmaxf(a1, a2)); const float e0 = __expf(a0 - mx), e1 = __expf(a1 - mx), e2 = __expf(a2 - mx); lbv[e] = e0 / (e0 + e1 + e2); }
        for (int u = tid; u < 64 * PT / 4; u += NTHREADS) ((LAS unsigned*)PI)[u] = 0u;
        float cs[2][8], kin[2][8], qs[2][8], run[2] = {0.f, 0.f}; unsigned vlo[4], vhi[4];
#pragma unroll
        for (int i = 0; i < 8; ++i) {
#pragma unroll
            for (int e = 0; e < 2; ++e) {
                const float fh = bf2f(e ? (zf[i] >> 16) : (zf[i] & 0xffffu)), qv = bf2f(e ? (zq[i] >> 16) : (zq[i] & 0xffffu));
                const float f = lbv[e] + (1.f - lbv[e]) * sigm(fh);
                run[e] += __logf(f); cs[e][i] = run[e]; kin[e][i] = 1.f - f; qs[e][i] = qv * sigm(qv);
            }
            if (i & 1) { vlo[i >> 1] |= zv[i] << 16; vhi[i >> 1] |= zv[i] & 0xffff0000u; } else { vlo[i >> 1] = zv[i] & 0xffffu; vhi[i >> 1] = zv[i] >> 16; }
        }
        if (item + (int)gridDim.x < GLA_ITEMS) ldz(item + gridDim.x);
        *(LAS f32x2g*)(GT + gg * 128 + k0) = (f32x2g){run[0], run[1]};
        *(LAS v4u*)(VT + k0 * PT + 16 * gg) = (v4u){vlo[0], vlo[1], vlo[2], vlo[3]};
        *(LAS v4u*)(VT + (k0 + 1) * PT + 16 * gg) = (v4u){vhi[0], vhi[1], vhi[2], vhi[3]};
        __syncthreads();
        f32x2g t8[8];
#pragma unroll
        for (int u = 0; u < 8; ++u) t8[u] = *(const LAS f32x2g*)(GT + u * 128 + k0);
        unsigned ktl[4], kth[4];
        float rgv[2], totv[2], runSv[2], lov[2], t1v[2], t2v[2];
#pragma unroll
        for (int e = 0; e < 2; ++e) {
            const float s0 = e ? t8[0].y : t8[0].x, s1 = e ? t8[1].y : t8[1].x, s2 = e ? t8[2].y : t8[2].x, s3 = e ? t8[3].y : t8[3].x;
            const float s4 = e ? t8[4].y : t8[4].x, s5 = e ? t8[5].y : t8[5].x, s6 = e ? t8[6].y : t8[6].x, s7 = e ? t8[7].y : t8[7].x;
            const float q0 = s0 + s1, q1 = s2 + s3, q2 = s4 + s5, q3 = s6 + s7;
            rgv[e] = (g > 0 ? q0 : 0.f) + (g > 1 ? q1 : 0.f) + (g > 2 ? q2 : 0.f); totv[e] = (q0 + q1) + (q2 + q3);
            runSv[e] = (g == 0) ? q0 : (g == 1) ? q1 : (g == 2) ? q2 : q3;
            const float first = (g == 0) ? s0 : (g == 1) ? s2 : (g == 2) ? s4 : s6;
            lov[e] = hh ? first : 0.f; t1v[e] = q1; t2v[e] = q2;
        }
        float erg[2], einv[2], eend[2], ex1[2], ex2[2];
#pragma unroll
        for (int e = 0; e < 2; ++e) { erg[e] = __expf(rgv[e]); einv[e] = __expf(-runSv[e]); eend[e] = __expf(totv[e] - (rgv[e] + runSv[e]));
            ex1[e] = (g == 2) ? __expf(t1v[e]) : __expf(t2v[e]); ex2[e] = __expf(t1v[e] + t2v[e]); }
        bf16* qtp = QT + (size_t)item * 64 * 128 + (size_t)(16 * g + 8 * hh) * 128 + k0;
#pragma unroll
        for (int i = 0; i < 8; ++i) {
            float qh[2], kb[2];
#pragma unroll
            for (int e = 0; e < 2; ++e) { const float cr = lov[e] + cs[e][i]; qh[e] = qs[e][i] * __expf(cr); kb[e] = kin[e][i] * __expf(runSv[e] - cr); }
            const int ro = (16 * g + 8 * hh + i) * PQ + 2 * k0;
            *(LAS unsigned*)(QA + ro) = pk2(qh[0], qh[1]);
            *(LAS unsigned*)(KB + ro) = pk2(kb[0], kb[1]);
            *(LAS unsigned*)(KD + ro) = pk2(kb[0] * einv[0], kb[1] * einv[1]);
            if (g == 2) *(LAS unsigned*)(QX + (8 * hh + i) * PQ + 2 * k0) = pk2(qh[0] * ex1[0], qh[1] * ex1[1]);
            if (g == 3) { *(LAS unsigned*)(QX + (16 + 8 * hh + i) * PQ + 2 * k0) = pk2(qh[0] * ex1[0], qh[1] * ex1[1]); *(LAS unsigned*)(QX + (32 + 8 * hh + i) * PQ + 2 * k0) = pk2(qh[0] * ex2[0], qh[1] * ex2[1]); }
            *(unsigned*)(qtp + (size_t)i * 128) = pk2(qh[0] * erg[0], qh[1] * erg[1]);
            const unsigned kv0 = f2bf(kb[0] * eend[0]), kv1 = f2bf(kb[1] * eend[1]);
            if (i & 1) { ktl[i >> 1] |= kv0 << 16; kth[i >> 1] |= kv1 << 16; } else { ktl[i >> 1] = kv0; kth[i >> 1] = kv1; }
        }
        *(LAS v4u*)(KT + k0 * PT + 16 * gg) = (v4u){ktl[0], ktl[1], ktl[2], ktl[3]};
        *(LAS v4u*)(KT + (k0 + 1) * PT + 16 * gg) = (v4u){kth[0], kth[1], kth[2], kth[3]};
        if (gg == 0) *(f32x2g*)(LAM + (size_t)item * 128 + k0) = (f32x2g){__expf(totv[0]), __expf(totv[1])};
        __syncthreads();
        for (int blk = wave; blk < 10; blk += 8) {
            const int gi = (blk >= 6) ? 3 : (blk >= 3) ? 2 : (blk >= 1) ? 1 : 0, ji = blk - ((gi * (gi + 1)) >> 1);
            const LAS unsigned char* ab = (ji + 1 >= gi) ? QA + 16 * gi * PQ : (gi == 2) ? QX : (ji == 1) ? QX + 16 * PQ : QX + 32 * PQ;
            const LAS unsigned char* bb = ((ji == gi) ? KD : KB) + 16 * ji * PQ;
            f32x4 acc = (f32x4){0.f, 0.f, 0.f, 0.f};
#pragma unroll
            for (int s = 0; s < 4; ++s) {
                const bf16x8_t a = *(const LAS bf16x8_t*)(ab + c16 * PQ + (32 * s + 8 * kq) * 2), bv = *(const LAS bf16x8_t*)(bb + c16 * PQ + (32 * s + 8 * kq) * 2);
                acc = mfma16(a, bv, acc);
            }
#pragma unroll
            for (int j = 0; j < 4; ++j) { const int tau = 4 * kq + j; const float val = (ji == gi && c16 > tau) ? 0.f : acc[j];
                *(LAS unsigned short*)(PI + (16 * gi + tau) * PT + (16 * ji + c16) * 2) = (unsigned short)f2bf(val); }
        }
        __syncthreads();
        {
            const LAS unsigned char* vb = VT + (16 * wave + c16) * PT + 16 * kq;
            const bf16x8_t v0 = *(const LAS bf16x8_t*)(vb), v1 = *(const LAS bf16x8_t*)(vb + 64);
#pragma unroll
            for (int gi = 0; gi < 4; ++gi) {
                const LAS unsigned char* pb = PI + (16 * gi + c16) * PT + 16 * kq;
                f32x4 acc = mfma16(*(const LAS bf16x8_t*)(pb), v0, (f32x4){0.f, 0.f, 0.f, 0.f});
                if (gi >= 2) acc = mfma16(*(const LAS bf16x8_t*)(pb + 64), v1, acc);
                { v2u w; w.x = pk2(acc[0], acc[1]); w.y = pk2(acc[2], acc[3]); OI[((size_t)item * 8 + wave) * 256 + gi * 64 + lane] = w; }
            }
            bf16* dsp = DS + (size_t)item * 128 * 128 + (size_t)(16 * wave + c16) * 128 + 4 * kq;
#pragma unroll
            for (int m = 0; m < 8; ++m) {
                const LAS unsigned char* kb2 = KT + (16 * m + c16) * PT + 16 * kq;
                f32x4 acc = mfma16(*(const LAS bf16x8_t*)(kb2), v0, (f32x4){0.f, 0.f, 0.f, 0.f});
                acc = mfma16(*(const LAS bf16x8_t*)(kb2 + 64), v1, acc);
                v2u w; w.x = pk2(acc[0], acc[1]); w.y = pk2(acc[2], acc[3]);
                *(v2u*)(dsp + 16 * m) = w;
            }
        }
        __syncthreads();
    }
}
__device__ __forceinline__ void phase_gla_scan(PP p, int tid) {
    bf16* DS = (bf16*)(p->ws + WS_U + U_DS); const float* LAM = (const float*)(p->ws + WS_U + U_LAM);
    const int nthr = gridDim.x * NTHREADS;
    for (int e = blockIdx.x * NTHREADS + tid; e < 32 * 2048; e += nthr) {
        const int chain = e >> 11, el = e & 2047, h = chain & 7, db = chain >> 3, k8 = (el & 15) * 8;
        float s[8];
#pragma unroll
        for (int i = 0; i < 8; ++i) s[i] = 0.f;
        for (int c0 = 0; c0 < GLA_NCH; c0 += 6) {
            v4u d[6]; f32x4 l0[6], l1[6];
#pragma unroll
            for (int u = 0; u < 6; ++u) { const size_t item = ((size_t)db * GLA_NCH + c0 + u) * 8 + h;
                d[u] = *(const v4u*)(DS + item * 16384 + (size_t)el * 8); l0[u] = *(const f32x4*)(LAM + item * 128 + k8); l1[u] = *(const f32x4*)(LAM + item * 128 + k8 + 4); }
#pragma unroll
            for (int u = 0; u < 6; ++u) { const size_t item = ((size_t)db * GLA_NCH + c0 + u) * 8 + h;
                v4u o; o.x = pk2(s[0], s[1]); o.y = pk2(s[2], s[3]); o.z = pk2(s[4], s[5]); o.w = pk2(s[6], s[7]);
                *(v4u*)(DS + item * 16384 + (size_t)el * 8) = o;
                s[0] = l0[u].x * s[0] + bf2f(d[u].x & 0xffffu); s[1] = l0[u].y * s[1] + bf2f(d[u].x >> 16);
                s[2] = l0[u].z * s[2] + bf2f(d[u].y & 0xffffu); s[3] = l0[u].w * s[3] + bf2f(d[u].y >> 16);
                s[4] = l1[u].x * s[4] + bf2f(d[u].z & 0xffffu); s[5] = l1[u].y * s[5] + bf2f(d[u].z >> 16);
                s[6] = l1[u].z * s[6] + bf2f(d[u].w & 0xffffu); s[7] = l1[u].w * s[7] + bf2f(d[u].w >> 16); }
        }
    }
}
__device__ __forceinline__ void phase_gla_out(PP p, LAS unsigned char* lds, int tid, int lane, int wave) {
    const bf16* DS = (const bf16*)(p->ws + WS_U + U_DS); const v2u* OI = (const v2u*)(p->ws + WS_U + U_OI); const bf16* QT = (const bf16*)(p->ws + WS_U + U_QT);
    const bf16* Z = (const bf16*)(p->ws + WS_U + U_Z); bf16* A2 = (bf16*)(p->ws + WS_A2); const float* gn = p->in[I_HGGN];
    constexpr int PQ = 272;
    LAS unsigned char* QL = lds;
    LAS unsigned char* GL_ = lds + 2 * 64 * PQ;
    LAS unsigned char* OL = GL_ + 64 * PQ;
    LAS float* SSQ = (LAS float*)(OL + 64 * PQ);
    LAS float* RST = SSQ + 512;
    const int kq = lane >> 4, c16 = lane & 15;
    const int srow = tid >> 3, sch = tid & 7;
    constexpr int NIT = NBATCH * GLA_NCH * 8;
    struct Pre { v4u q[2][2]; v4u g[2]; bf16x8_t bv[2][4]; v2u ow[2][4]; };
    auto decode = [&](int it, int& h, int& jc, int& b, int (&item)[2], int& tok0) {
        h = it & 7; jc = (it >> 3) % GLA_NCH; b = (it >> 3) / GLA_NCH;
        const int cb = (jc < 4) ? 3 - jc : 135 - jc;
        item[0] = ((0 * 2 + b) * GLA_NCH + jc) * 8 + h; item[1] = ((1 * 2 + b) * GLA_NCH + cb) * 8 + h;
        tok0 = (jc < 4) ? NLAT + b * CTXL + 64 * jc : b * SEQ + 64 * (jc - 4); };
    auto fetch = [&](int it, Pre& P) {
        int h, jc, b, item[2], tok0; decode(it, h, jc, b, item, tok0);
#pragma unroll
        for (int d = 0; d < 2; ++d) {
            const v4u* qs = (const v4u*)(QT + (size_t)item[d] * 8192 + srow * 128 + sch * 16); P.q[d][0] = qs[0]; P.q[d][1] = qs[1];
            const bf16* sp = DS + (size_t)item[d] * 16384 + (size_t)(16 * wave + c16) * 128 + 8 * kq;
#pragma unroll
            for (int s2 = 0; s2 < 4; ++s2) P.bv[d][s2] = *(const bf16x8_t*)(sp + 32 * s2);
#pragma unroll
            for (int gi = 0; gi < 4; ++gi) P.ow[d][gi] = OI[((size_t)item[d] * 8 + wave) * 256 + gi * 64 + lane];
        }
        const v4u* gs = (const v4u*)(Z + (size_t)(tok0 + srow) * 5120 + 4096 + h * 128 + sch * 16); P.g[0] = gs[0]; P.g[1] = gs[1]; };
    Pre nx;
    if ((int)blockIdx.x < NIT) fetch(blockIdx.x, nx);
    for (int it = blockIdx.x; it < NIT; it += gridDim.x) {
        int h, jc, b, item[2], tok0; decode(it, h, jc, b, item, tok0);
#pragma unroll
        for (int d = 0; d < 2; ++d) { LAS v4u* dq = (LAS v4u*)(QL + d * 64 * PQ + srow * PQ + sch * 32); dq[0] = nx.q[d][0]; dq[1] = nx.q[d][1]; }
        { LAS v4u* dg = (LAS v4u*)(GL_ + srow * PQ + sch * 32); dg[0] = nx.g[0]; dg[1] = nx.g[1]; }
        bf16x8_t bv[2][4]; v2u ow[2][4];
#pragma unroll
        for (int d = 0; d < 2; ++d)
#pragma unroll
            for (int u = 0; u < 4; ++u) { bv[d][u] = nx.bv[d][u]; ow[d][u] = nx.ow[d][u]; }
        __syncthreads();
        if (it + (int)gridDim.x < NIT) fetch(it + gridDim.x, nx);
        f32x4 acc[2][4];
#pragma unroll
        for (int d = 0; d < 2; ++d)
#pragma unroll
            for (int gi = 0; gi < 4; ++gi) {
                const LAS unsigned char* qp = QL + d * 64 * PQ + (16 * gi + c16) * PQ + 16 * kq;
                f32x4 a4 = (f32x4){bf2f(ow[d][gi].x & 0xffffu), bf2f(ow[d][gi].x >> 16), bf2f(ow[d][gi].y & 0xffffu), bf2f(ow[d][gi].y >> 16)};
#pragma unroll
                for (int s2 = 0; s2 < 4; ++s2) a4 = mfma16(*(const LAS bf16x8_t*)(qp + 64 * s2), bv[d][s2], a4);
                acc[d][gi] = a4;
            }
        f32x4 o[4]; float ss[4][4];
#pragma unroll
        for (int gi = 0; gi < 4; ++gi)
#pragma unroll
            for (int j = 0; j < 4; ++j) { const float v = acc[0][gi][j] + __shfl_xor(acc[1][3 - gi][3 - j], 48); o[gi][j] = v;
                float q = v * v;
                q += __builtin_bit_cast(float, __builtin_amdgcn_update_dpp(0, __builtin_bit_cast(int, q), 0x128, 0xf, 0xf, false));
                q += __builtin_bit_cast(float, __builtin_amdgcn_update_dpp(0, __builtin_bit_cast(int, q), 0x124, 0xf, 0xf, false));
                q += __builtin_bit_cast(float, __builtin_amdgcn_update_dpp(0, __builtin_bit_cast(int, q), 0x122, 0xf, 0xf, false));
                q += __builtin_bit_cast(float, __builtin_amdgcn_update_dpp(0, __builtin_bit_cast(int, q), 0x121, 0xf, 0xf, false));
                ss[gi][j] = q; }
        if (c16 == 0) {
#pragma unroll
            for (int gi = 0; gi < 4; ++gi)
#pragma unroll
                for (int j = 0; j < 4; ++j) SSQ[(16 * gi + 4 * kq + j) * 8 + wave] = ss[gi][j]; }
        __syncthreads();
        if (tid < 64) { const f32x4 s0 = *(const LAS f32x4*)(SSQ + tid * 8), s1 = *(const LAS f32x4*)(SSQ + tid * 8 + 4);
            RST[tid] = rsqrtf(((s0[0] + s0[1]) + (s0[2] + s0[3]) + (s1[0] + s1[1]) + (s1[2] + s1[3])) * (1.0f / 128.0f) + NORM_EPS); }
        __syncthreads();
        const int vl = 16 * wave + c16; const float gw_ = gn[vl];
#pragma unroll
        for (int gi = 0; gi < 4; ++gi)
#pragma unroll
            for (int j = 0; j < 4; ++j) { const int tk = 16 * gi + 4 * kq + j;
                const float g = bf2f(*(const LAS unsigned short*)(GL_ + tk * PQ + vl * 2)); const float r = o[gi][j] * RST[tk] * gw_ * (g * sigm(g));
                *(LAS unsigned short*)(OL + tk * PQ + vl * 2) = (unsigned short)f2bf(r); }
        __syncthreads();
        { const LAS v4u* so = (const LAS v4u*)(OL + srow * PQ + sch * 32); v4u* dst = (v4u*)(A2 + (size_t)(tok0 + srow) * D + h * 128 + sch * 16); dst[0] = so[0]; dst[1] = so[1]; }
        __syncthreads();
    }
}

typedef short bf16x4_t __attribute__((ext_vector_type(4)));
typedef float f32x2_t __attribute__((ext_vector_type(2))); typedef __bf16 bf16x2v_t __attribute__((ext_vector_type(2)));
__device__ __forceinline__ unsigned cvtpk(float lo, float hi) { const f32x2_t v = {lo, hi}; const bf16x2v_t b = __builtin_convertvector(v, bf16x2v_t); return __builtin_bit_cast(unsigned, b); }
constexpr int R4_DOTA = 0, R4_UPA = 2048, R4_A1 = 4096, R4_A2 = 4352, R4_G7 = 4608, R4_VT = 4864, R4_IMG = 6912, R4_SLOT = 5376, R4_NCH = NSTEP / 8, R4_NCB = 8;
constexpr size_t U_IMG = 872 * MiB;
constexpr size_t U_YST = U_OD1;
__device__ __forceinline__ void phase_rw_prep(PP p, LAS unsigned char* lds, int lane, int wave) {
    const int gw = blockIdx.x * NWAVES + wave, NGW = gridDim.x * NWAVES;
    const bf16* RKV = (const bf16*)(p->ws + WS_U + U_RKV); unsigned char* IMG = p->ws + WS_U + U_IMG;
    LAS unsigned char* da = lds + wave * 8192; LAS unsigned char* gb = da + 2048; LAS float* GL = (LAS float*)(da + 4096);
    LAS unsigned char* a12 = da + 5120;
    const int m = lane & 15, q = lane >> 4;
    const int s2 = lane >> 5, tp = (lane >> 4) & 1, kq = (lane & 15) >> 2, ii = (lane & 3) + 4 * tp, dpos = ((s2 * 4 + kq) * 8 + ii) * 2;
    float nrx[8], nkx[8], nvx[8], nlw[8], nav[8];
    auto ld = [&](int it2) {
        const int chain = it2 & 63, chunk = it2 >> 6, b = chain >> 5, dir = (chain >> 4) & 1, h = chain & 15, ch = h * 64 + lane;
        const bf16* WDp = (const bf16*)(p->ws + WS_U + U_WD) + (size_t)dir * NROW * D; const bf16* ADp = (const bf16*)(p->ws + WS_U + U_AD) + (size_t)dir * NROW * D;
#pragma unroll
        for (int j = 0; j < 8; ++j) { const int row = step_row(b, dir, chunk * 8 + j);
            nrx[j] = bf2f(RKV[(size_t)row * 3072 + ch]); nkx[j] = bf2f(RKV[(size_t)row * 3072 + 1024 + ch]); nvx[j] = bf2f(RKV[(size_t)row * 3072 + 2048 + ch]);
            nlw[j] = bf2f(WDp[(size_t)row * D + ch]); nav[j] = bf2f(ADp[(size_t)row * D + ch]); } };
    if (gw < 64 * R4_NCH) ld(gw);
    for (int it = gw; it < 64 * R4_NCH; it += NGW) {
        const int chain = it & 63, chunk = it >> 6, h = chain & 15, ch = h * 64 + lane;
        const float kkw = p->in[I_KK][ch], kaw = p->in[I_KA][ch];
        float rx[8], kx[8], vx[8], lw[8], av[8], kn[8];
#pragma unroll
        for (int j = 0; j < 8; ++j) { rx[j] = nrx[j]; kx[j] = nkx[j]; vx[j] = nvx[j]; lw[j] = nlw[j]; av[j] = nav[j]; }
        if (it + NGW < 64 * R4_NCH) ld(it + NGW);
#pragma unroll
        for (int j = 0; j < 8; ++j) { const float t = kx[j] * kkw; kn[j] = t * __builtin_amdgcn_rsqf(fmaxf(wave_sum(t * t), 1e-24f)); }
        float bj[8]; { float bb = 0.f;
#pragma unroll
            for (int j = 0; j < 8; ++j) { bb += lw[j]; bj[j] = bb; } }
        const float e7 = __expf(bj[7]);
        unsigned upa[8]; float ebprev = 1.f;
#pragma unroll
        for (int j = 0; j < 8; ++j) {
            const float eb = __expf(bj[j]), einv = __builtin_amdgcn_rcpf(eb), e7j = e7 * einv;
            const float beta = kn[j] * av[j], kd = kx[j] * (1.f + (av[j] - 1.f) * kaw);
            *(LAS unsigned short*)(da + j * 128 + dpos) = (unsigned short)f2bf(kn[j] * ebprev);
            *(LAS unsigned short*)(da + (8 + j) * 128 + dpos) = (unsigned short)f2bf(rx[j] * eb);
            *(LAS unsigned short*)(gb + j * 128 + dpos) = (unsigned short)f2bf(beta * einv);
            *(LAS unsigned short*)(gb + (8 + j) * 128 + dpos) = (unsigned short)f2bf(kd * einv);
            const unsigned ub = f2bf(-beta * e7j), uk = f2bf(kd * e7j);
            if (j & 1) { upa[j >> 1] |= ub << 16; upa[4 + (j >> 1)] |= uk << 16; } else { upa[j >> 1] = ub; upa[4 + (j >> 1)] = uk; }
            ebprev = eb;
        }
        unsigned char* img = IMG + ((size_t)chain * R4_NCH + chunk) * R4_IMG;
        { v4u* d = (v4u*)(img + R4_UPA + lane * 32); d[0] = (v4u){upa[0], upa[1], upa[2], upa[3]}; d[1] = (v4u){upa[4], upa[5], upa[6], upa[7]}; }
        ((float*)(img + R4_G7))[lane] = e7;
        { f32x4* d = (f32x4*)(img + R4_VT + lane * 32); d[0] = (f32x4){vx[0], vx[1], vx[2], vx[3]}; d[1] = (f32x4){vx[4], vx[5], vx[6], vx[7]}; }
        LDS_WAIT(); asm volatile("" ::: "memory");
        { v4u* d = (v4u*)(img + R4_DOTA); d[lane] = ((const LAS v4u*)da)[lane]; d[64 + lane] = ((const LAS v4u*)da)[64 + lane]; }
        f32x4 G = (f32x4){0.f, 0.f, 0.f, 0.f};
#pragma unroll
        for (int s = 0; s < 2; ++s) G = mfma16(*(const LAS bf16x8_t*)(da + m * 128 + (s * 4 + q) * 16), *(const LAS bf16x8_t*)(gb + m * 128 + (s * 4 + q) * 16), G);
        if (m >= 8) { const int i = m - 8;
#pragma unroll
            for (int jp = 0; jp < 4; ++jp) { const int row = 4 * q + jp; const bool keep = (row < 8) ? (i < row) : (i <= row - 8);
                *(LAS unsigned short*)(a12 + row * 16 + i * 2) = (unsigned short)f2bf(keep ? G[jp] : 0.f); } }
#pragma unroll
        for (int jp = 0; jp < 4; ++jp) GL[(4 * q + jp) * 16 + m] = G[jp];
        LDS_WAIT(); asm volatile("" ::: "memory");
        const int c = lane & 7; float Tc[8], M2[8];
#pragma unroll
        for (int j = 0; j < 8; ++j) { float t = (j == c) ? 1.f : 0.f; const f32x4 ra = *(const LAS f32x4*)(GL + j * 16), rb = *(const LAS f32x4*)(GL + j * 16 + 4);
#pragma unroll
            for (int i = 0; i < j; ++i) t -= (i < 4 ? ra[i & 3] : rb[i & 3]) * Tc[i];
            Tc[j] = t; }
#pragma unroll
        for (int j = 0; j < 8; ++j) { float t = 0.f; const f32x4 ra = *(const LAS f32x4*)(GL + (8 + j) * 16), rb = *(const LAS f32x4*)(GL + (8 + j) * 16 + 4);
#pragma unroll
            for (int i = 0; i <= j; ++i) t -= (i < 4 ? ra[i & 3] : rb[i & 3]) * Tc[i];
            M2[j] = t; }
        if (lane < 8) {
#pragma unroll
            for (int j = 0; j < 8; ++j) { *(LAS unsigned short*)(a12 + 256 + j * 16 + c * 2) = (unsigned short)f2bf(Tc[j]); *(LAS unsigned short*)(a12 + 256 + (8 + j) * 16 + c * 2) = (unsigned short)f2bf(M2[j]); } }
        LDS_WAIT(); asm volatile("" ::: "memory");
        if (lane < 32) ((v4u*)(img + R4_A1))[lane] = ((const LAS v4u*)a12)[lane];
        LDS_WAIT(); asm volatile("" ::: "memory");
    }
}
constexpr int R4L_NCB = 6, R4L_SLOT = 6144;
__device__ __forceinline__ void phase_rwkv_scan4(PP p, LAS unsigned char* lds, int vcu, int tid, int lane, int wave) {
    const int m = lane & 15, q = lane >> 4;
    const unsigned char* IMG = p->ws + WS_U + U_IMG;
    for (int unit = vcu; unit < 256; unit += gridDim.x) {
        const int chain = unit >> 2, slab = unit & 3, b = chain >> 5, dir = (chain >> 4) & 1, h = chain & 15;
        float* YST = (float*)(p->ws + WS_U + U_YST) + (size_t)unit * NSTEP * 16 + (q >= 2 ? 4 * (q - 2) : 0) * 16 + m;
        const unsigned char* cimg = IMG + (size_t)chain * R4_NCH * R4_IMG;
        f32x4 S[4];
#pragma unroll
        for (int T = 0; T < 4; ++T) S[T] = (f32x4){0.f, 0.f, 0.f, 0.f};
        v2u idf; { const int c0 = 4 * q; idf.x = ((c0 == m) ? 0x3F80u : 0u) | ((c0 + 1 == m) ? 0x3F800000u : 0u); idf.y = ((c0 + 2 == m) ? 0x3F80u : 0u) | ((c0 + 3 == m) ? 0x3F800000u : 0u); }
        auto issue = [&](int bt) {
#pragma unroll
            for (int k = 0; k < 2 * R4L_NCB; ++k) { const int ii = (wave - 1) + 3 * k, cc = ii / 6, part = ii - cc * 6, pi = part * 64 + lane;
                const unsigned char* src = cimg + (size_t)(bt * R4L_NCB + cc) * R4_IMG + (pi < 304 ? pi * 16 : (pi < 336 ? R4_VT + slab * 512 + (pi - 304) * 16 : 0));
                __builtin_amdgcn_global_load_lds((const unsigned*)src, (LAS unsigned*)(lds + ((bt & 1) * R4L_NCB + cc) * R4L_SLOT + part * 1024), 16, 0, 0); } };
        float crg[32]; int cit = (int)(blockIdx.x * 4 + (wave - 4)); ConvJob cj; bool cpend = false, cloaded = false;
        LAS float* cscr = (LAS float*)(lds + 2 * R4L_NCB * R4L_SLOT + (wave & 3) * 8448);
        if (wave >= 4 && cit < IT_L1MOE) { cj = conv_job_l1(p, cit); ti_load(cj.src, cj.src_ld, lane, crg); cpend = true; cloaded = true; }
        __syncthreads();
        if (wave >= 1 && wave < 4) { issue(0); asm volatile("s_waitcnt vmcnt(0)" ::: "memory"); }
        __syncthreads();
        constexpr int NB4 = R4_NCH / R4L_NCB;
        for (int bt = 0; bt < NB4; ++bt) {
            if (wave >= 4) {
                const int ph3 = bt % 3;
                if (ph3 == 0) { if (cpend && cloaded) { ti_store(true, cj.fp8, crg, cj.dst, cj.dst_ldb, cscr, lane); cloaded = false; cit += 4 * (int)gridDim.x; cpend = cit < IT_L1MOE; } }
                else if (ph3 == 1) { if (cpend && !cloaded) { cj = conv_job_l1(p, cit); ti_load(cj.src, cj.src_ld, lane, crg); cloaded = true; } } }
            else if (wave >= 1) { if (bt + 1 < NB4) issue(bt + 1); asm volatile("s_waitcnt vmcnt(0)" ::: "memory"); }
            else {
                __builtin_amdgcn_s_setprio(3);
                struct Ops { bf16x8_t a0, a1; v2u A1u, A2u; bf16x4_t UA[4]; f32x4 g7[4]; f32x4 vr; };
                auto rd = [&](int cc, Ops& o) {
                    const LAS unsigned char* sl = lds + ((bt & 1) * R4L_NCB + cc) * R4L_SLOT;
                    o.a0 = *(const LAS bf16x8_t*)(sl + R4_DOTA + m * 128 + q * 16); o.a1 = *(const LAS bf16x8_t*)(sl + R4_DOTA + m * 128 + (4 + q) * 16);
                    o.A1u = *(const LAS v2u*)(sl + R4_A1 + m * 16 + (q & 1) * 8); o.A2u = *(const LAS v2u*)(sl + R4_A2 + m * 16 + (q & 1) * 8);
#pragma unroll
                    for (int T = 0; T < 4; ++T) { o.UA[T] = *(const LAS bf16x4_t*)(sl + R4_UPA + (16 * T + m) * 32 + q * 8); o.g7[T] = *(const LAS f32x4*)(sl + R4_G7 + (16 * T + 4 * q) * 4); }
                    o.vr = *(const LAS f32x4*)(sl + R4_VT + m * 32 + (q & 1) * 16); };
                Ops cur, nxt; rd(0, cur);
#pragma unroll
                for (int cc = 0; cc < R4L_NCB; ++cc) {
                    if (cc + 1 < R4L_NCB) rd(cc + 1, nxt);
                    __builtin_amdgcn_sched_barrier(0);
                    v2u A1u = cur.A1u, A2u = cur.A2u;
                    if (q >= 2) { A1u = (v2u){0u, 0u}; A2u = idf; }
                    v4u b0, b1;
                    b0.x = cvtpk(S[0][0], S[0][1]); b0.y = cvtpk(S[0][2], S[0][3]); b0.z = cvtpk(S[1][0], S[1][1]); b0.w = cvtpk(S[1][2], S[1][3]);
                    b1.x = cvtpk(S[2][0], S[2][1]); b1.y = cvtpk(S[2][2], S[2][3]); b1.z = cvtpk(S[3][0], S[3][1]); b1.w = cvtpk(S[3][2], S[3][3]);
                    f32x4 Dd = mfma16(cur.a0, __builtin_bit_cast(bf16x8_t, b0), (f32x4){0.f, 0.f, 0.f, 0.f});
                    Dd = mfma16(cur.a1, __builtin_bit_cast(bf16x8_t, b1), Dd);
                    v2u vb; vb.x = cvtpk(cur.vr[0], cur.vr[1]); vb.y = cvtpk(cur.vr[2], cur.vr[3]);
                    const f32x4 Z = __builtin_amdgcn_mfma_f32_16x16x16bf16_1k(__builtin_bit_cast(bf16x4_t, A1u), __builtin_bit_cast(bf16x4_t, vb), Dd, 0, 0, 0);
                    v2u zb; zb.x = cvtpk(Z[0], Z[1]); zb.y = cvtpk(Z[2], Z[3]);
                    const f32x4 W = __builtin_amdgcn_mfma_f32_16x16x16bf16_1k(__builtin_bit_cast(bf16x4_t, A2u), __builtin_bit_cast(bf16x4_t, zb), (f32x4){0.f, 0.f, 0.f, 0.f}, 0, 0, 0);
                    v2u wb; wb.x = cvtpk(W[0], W[1]); wb.y = cvtpk(W[2], W[3]);
                    const v2u ub = (q < 2) ? wb : vb;
#pragma unroll
                    for (int T = 0; T < 4; ++T) S[T] = __builtin_amdgcn_mfma_f32_16x16x16bf16_1k(cur.UA[T], __builtin_bit_cast(bf16x4_t, ub), S[T] * cur.g7[T], 0, 0, 0);
                    if (q >= 2) { float* yp = YST + (size_t)(bt * R4L_NCB + cc) * 128;
#pragma unroll
                        for (int i = 0; i < 4; ++i) yp[i * 16] = W[i]; }
                    if (cc + 1 < R4L_NCB) cur = nxt;
                }
            }
            asm volatile("s_waitcnt lgkmcnt(0)" ::: "memory"); __builtin_amdgcn_s_barrier(); asm volatile("" ::: "memory");
        }
        if (wave >= 4) { while (cpend) { if (!cloaded) { cj = conv_job_l1(p, cit); ti_load(cj.src, cj.src_ld, lane, crg); } ti_store(true, cj.fp8, crg, cj.dst, cj.dst_ldb, cscr, lane); cloaded = false; cit += 4 * (int)gridDim.x; cpend = cit < IT_L1MOE; } }
    }
}

__device__ __forceinline__ void phase_lora2(PP p, LAS unsigned char* lds, int tid, int lane, int wave) {
    const bf16* L1 = (const bf16*)(p->ws + WS_U + U_L1); const bf16* W2 = (const bf16*)(p->ws + WS_WL2);
    const int c16 = lane & 15, kq = lane >> 4;
    const int part = blockIdx.x % 12, wgp = blockIdx.x / 12, nwg = (gridDim.x - part + 11) / 12;
    const int blk = (part < 8) ? (part >> 1) : 4, col0 = (part < 8) ? (part & 1) * 512 : (part - 8) * 256, ncol = (part < 8) ? 512 : 256;
    const int koff = (blk < 4) ? blk * 64 : 256, nks = (blk < 4) ? 2 : 4, K = nks * 32, WP = K * 2 + 16;
    LAS unsigned char* wl = lds;
    constexpr int PS = 272;
    LAS unsigned char* stg = lds + 73728 + wave * (16 * PS);
    { const int ppr = K / 8;
#pragma unroll 8
      for (int u = tid; u < ncol * ppr; u += NTHREADS) { const int c = u / ppr, pc = u - c * ppr;
          *(LAS v4u*)(wl + c * WP + pc * 16) = *(const v4u*)(W2 + (size_t)(blk * 1024 + col0 + c) * 384 + koff + pc * 8); } }
    const float* bias = ((blk < 2) ? p->in[I_DECW0] + blk * D : p->in[I_A0] + ((blk - 2) & 1) * D) + col0;
    LAS float* bl = (LAS float*)(lds + 108544);
    if (blk < 4) { for (int u = tid; u < ncol; u += NTHREADS) bl[u] = bias[u]; }
    __syncthreads();
    bf16* dstb = (bf16*)(p->ws + WS_U + ((blk < 2) ? U_WD : (blk < 4) ? U_AD : U_G)) + (size_t)((blk < 4) ? (blk & 1) : 0) * NROW * D + col0;
    for (int rt = wgp * NWAVES + wave; rt < NROW / 16; rt += nwg * NWAVES) {
        const bf16* lp = L1 + (size_t)(rt * 16 + c16) * 384 + koff + 8 * kq;
        bf16x8_t bfr[4];
#pragma unroll
        for (int s = 0; s < 4; ++s) if (s < nks) bfr[s] = *(const bf16x8_t*)(lp + 32 * s);
        bf16* dst = dstb + (size_t)(rt * 16) * D;
        for (int ps = 0; ps < ncol / 128; ++ps) {
#pragma unroll 4
            for (int ct = 0; ct < 8; ++ct) {
                const int c0 = ps * 128 + ct * 16;
                const LAS unsigned char* wp = wl + (c0 + c16) * WP + 16 * kq;
                f32x4 acc = (f32x4){0.f, 0.f, 0.f, 0.f};
#pragma unroll
                for (int s = 0; s < 4; ++s) if (s < nks) acc = mfma16(*(const LAS bf16x8_t*)(wp + 64 * s), bfr[s], acc);
                const f32x4 bb = (blk < 4) ? *(const LAS f32x4*)(bl + c0 + 4 * kq) : (f32x4){0.f, 0.f, 0.f, 0.f};
                if (blk < 2) { for (int j = 0; j < 4; ++j) acc[j] = -0.60653066f * sigm(acc[j] + bb[j]); }
                else if (blk < 4) { for (int j = 0; j < 4; ++j) acc[j] = sigm(acc[j] + bb[j]); }
                v2u w; w.x = pk2(acc[0], acc[1]); w.y = pk2(acc[2], acc[3]);
                *(LAS v2u*)(stg + c16 * PS + (ct * 16 + 4 * kq) * 2) = w;
            }
            LDS_WAIT(); asm volatile("" ::: "memory");
#pragma unroll
            for (int i = 0; i < 4; ++i) { const int row = 4 * i + (lane >> 4), cb = lane & 15;
                *(v4u*)(dst + (size_t)row * D + ps * 128 + cb * 8) = *(const LAS v4u*)(stg + row * PS + cb * 16); }
            LDS_WAIT(); asm volatile("" ::: "memory");
        }
    }
    __syncthreads();
}

constexpr int R5_DOTA = 0, R5_UPA = 4096, R5_A21 = 8192, R5_A2 = 9216, R5_GE = 10240, R5_VT = 10496, R5_IMG = 12544, R5_NCH = NSTEP / 16, R5_NCB = 3, R5_SLOT = 12288, R5_NST = 3;
__device__ __forceinline__ void phase_rw_prep5(PP p, LAS unsigned char* lds, int lane, int wave) {
    const int gw = blockIdx.x * NWAVES + wave, NGW = gridDim.x * NWAVES;
    const bf16* RKV = (const bf16*)(p->ws + WS_U + U_RKV); unsigned char* IMG = p->ws + WS_U + U_IMG;
    LAS unsigned char* da = lds + wave * 14336;
    LAS unsigned char* gb = da + 4096; LAS float* GL = (LAS float*)(da + 8192); LAS unsigned char* a12 = da + 12288; LAS float* TM = (LAS float*)gb;
    const int m = lane & 15, q = lane >> 4;
    const int s2 = lane >> 5, tp = (lane >> 4) & 1, kq = (lane & 15) >> 2, ii = (lane & 3) + 4 * tp, dpos = ((s2 * 4 + kq) * 8 + ii) * 2;
    float nrx[16], nkx[16], nvx[16], nlw[16], nav[16];
    auto ld = [&](int it2) {
        const int chain = it2 & 63, chunk = it2 >> 6, b = chain >> 5, dir = (chain >> 4) & 1, h = chain & 15, ch = h * 64 + lane;
        const bf16* WDp = (const bf16*)(p->ws + WS_U + U_WD) + (size_t)dir * NROW * D; const bf16* ADp = (const bf16*)(p->ws + WS_U + U_AD) + (size_t)dir * NROW * D;
#pragma unroll
        for (int j = 0; j < 16; ++j) { const int row = step_row(b, dir, chunk * 16 + j);
            nrx[j] = bf2f(RKV[(size_t)row * 3072 + ch]); nkx[j] = bf2f(RKV[(size_t)row * 3072 + 1024 + ch]); nvx[j] = bf2f(RKV[(size_t)row * 3072 + 2048 + ch]);
            nlw[j] = bf2f(WDp[(size_t)row * D + ch]); nav[j] = bf2f(ADp[(size_t)row * D + ch]); } };
    if (gw < 64 * R5_NCH) ld(gw);
    const float kkw = p->in[I_KK][((gw & 63) & 15) * 64 + lane], kaw = p->in[I_KA][((gw & 63) & 15) * 64 + lane];
    for (int it = gw; it < 64 * R5_NCH; it += NGW) {
        const int chain = it & 63, chunk = it >> 6, h = chain & 15, ch = h * 64 + lane;
        unsigned char* img = IMG + ((size_t)chain * R5_NCH + chunk) * R5_IMG;
        float upf[32]; float bb = 0.f, ebprev = 1.f, eb = 1.f;
#pragma unroll
        for (int j = 0; j < 16; ++j) {
            const float t = nkx[j] * kkw; const float kn = t * __builtin_amdgcn_rsqf(fmaxf(wave_sum(t * t), 1e-24f));
            bb += nlw[j]; eb = __expf(bb); const float einv = __builtin_amdgcn_rcpf(eb);
            const float beta = kn * nav[j], kdv = nkx[j] * (1.f + (nav[j] - 1.f) * kaw);
            *(LAS unsigned short*)(da + j * 128 + dpos) = (unsigned short)f2bf(kn * ebprev);
            *(LAS unsigned short*)(da + (16 + j) * 128 + dpos) = (unsigned short)f2bf(nrx[j] * eb);
            *(LAS unsigned short*)(gb + j * 128 + dpos) = (unsigned short)f2bf(beta * einv);
            *(LAS unsigned short*)(gb + (16 + j) * 128 + dpos) = (unsigned short)f2bf(kdv * einv);
            upf[8 * (j >> 2) + (j & 3)] = -beta * einv; upf[8 * (j >> 2) + 4 + (j & 3)] = kdv * einv;
            ebprev = eb;
        }
        const float eE = eb;
        { v4u* d = (v4u*)(img + R5_UPA + lane * 16);
#pragma unroll
          for (int u = 0; u < 4; ++u) d[64 * u] = (v4u){pk2(upf[8 * u] * eE, upf[8 * u + 1] * eE), pk2(upf[8 * u + 2] * eE, upf[8 * u + 3] * eE), pk2(upf[8 * u + 4] * eE, upf[8 * u + 5] * eE), pk2(upf[8 * u + 6] * eE, upf[8 * u + 7] * eE)}; }
        ((float*)(img + R5_GE))[lane] = eE;
        { v2u* d = (v2u*)(img + R5_VT + (lane >> 4) * 512 + (lane & 15) * 8);
#pragma unroll
          for (int u = 0; u < 4; ++u) d[16 * u] = (v2u){pk2(nvx[4 * u], nvx[4 * u + 1]), pk2(nvx[4 * u + 2], nvx[4 * u + 3])}; }
        if (it + NGW < 64 * R5_NCH) ld(it + NGW);
        LDS_WAIT(); asm volatile("" ::: "memory");
        { v4u* d = (v4u*)(img + R5_DOTA);
#pragma unroll
          for (int u = 0; u < 4; ++u) d[64 * u + lane] = ((const LAS v4u*)da)[64 * u + lane]; }
#pragma unroll
        for (int rb = 0; rb < 2; ++rb)
#pragma unroll
            for (int cb = 0; cb < 2; ++cb) { f32x4 Gt = (f32x4){0.f, 0.f, 0.f, 0.f};
#pragma unroll
                for (int s = 0; s < 2; ++s) Gt = mfma16(*(const LAS bf16x8_t*)(da + (16 * rb + m) * 128 + (s * 4 + q) * 16), *(const LAS bf16x8_t*)(gb + (16 * cb + m) * 128 + (s * 4 + q) * 16), Gt);
#pragma unroll
                for (int jp = 0; jp < 4; ++jp) GL[(16 * rb + 4 * q + jp) * 32 + 16 * cb + m] = Gt[jp]; }
        LDS_WAIT(); asm volatile("" ::: "memory");
        const int c = lane & 15; float Tc[16], M2[16];
#pragma unroll
        for (int j = 0; j < 16; ++j) { float t = (j == c) ? 1.f : 0.f;
#pragma unroll
            for (int i4 = 0; i4 < (j + 3) / 4; ++i4) { const f32x4 rr = *(const LAS f32x4*)(GL + j * 32 + 4 * i4);
#pragma unroll
                for (int e = 0; e < 4; ++e) if (4 * i4 + e < j) t -= rr[e] * Tc[4 * i4 + e]; }
            Tc[j] = t; }
#pragma unroll
        for (int j = 0; j < 16; ++j) { float t = 0.f;
#pragma unroll
            for (int i4 = 0; i4 < (j + 4) / 4; ++i4) { const f32x4 rr = *(const LAS f32x4*)(GL + (16 + j) * 32 + 4 * i4);
#pragma unroll
                for (int e = 0; e < 4; ++e) if (4 * i4 + e <= j) t -= rr[e] * Tc[4 * i4 + e]; }
            M2[j] = t; }
        if (lane < 16) {
#pragma unroll
            for (int j = 0; j < 16; ++j) { *(LAS unsigned short*)(a12 + 1024 + j * 32 + c * 2) = (unsigned short)f2bf(Tc[j]); *(LAS unsigned short*)(a12 + 1024 + (16 + j) * 32 + c * 2) = (unsigned short)f2bf(M2[j]);
                TM[j * 16 + c] = Tc[j]; TM[(16 + j) * 16 + c] = M2[j]; } }
        LDS_WAIT(); asm volatile("" ::: "memory");
        { const int r = lane >> 1, i0 = 8 * (lane & 1); float e8[8];
#pragma unroll
          for (int x = 0; x < 8; ++x) e8[x] = 0.f;
#pragma unroll
          for (int mm = 1; mm < 16; ++mm) { const float tv = TM[r * 16 + mm]; const f32x4 ca = *(const LAS f32x4*)(GL + mm * 32 + 16 + i0), cb4 = *(const LAS f32x4*)(GL + mm * 32 + 16 + i0 + 4);
#pragma unroll
              for (int x = 0; x < 4; ++x) { e8[x] += (i0 + x < mm) ? tv * ca[x] : 0.f; e8[4 + x] += (i0 + 4 + x < mm) ? tv * cb4[x] : 0.f; } }
          if (r >= 16) { const int jj = r - 16; const f32x4 da4 = *(const LAS f32x4*)(GL + r * 32 + 16 + i0), db4 = *(const LAS f32x4*)(GL + r * 32 + 16 + i0 + 4);
#pragma unroll
              for (int x = 0; x < 4; ++x) { e8[x] += (i0 + x <= jj) ? da4[x] : 0.f; e8[4 + x] += (i0 + 4 + x <= jj) ? db4[x] : 0.f; } }
          *(LAS v4u*)(a12 + r * 32 + i0 * 2) = (v4u){pk2(e8[0], e8[1]), pk2(e8[2], e8[3]), pk2(e8[4], e8[5]), pk2(e8[6], e8[7])}; }
        LDS_WAIT(); asm volatile("" ::: "memory");
        { v4u* d = (v4u*)(img + R5_A21); d[lane] = ((const LAS v4u*)a12)[lane]; d[64 + lane] = ((const LAS v4u*)a12)[64 + lane]; }
        LDS_WAIT(); asm volatile("" ::: "memory");
    }
}
constexpr int R7_SLOT = 12288, R7_NPC = 12;
__device__ __forceinline__ void phase_rwkv_scan7(PP p, LAS unsigned char* lds, int vcu, int tid, int lane, int wave) {
    const int m = lane & 15, q = lane >> 4;
    constexpr int NB5 = R5_NCH / R5_NCB;
    const int nsc = ((int)gridDim.x + 1) >> 1, ncv = (int)gridDim.x >> 1;
    if (vcu & 1) {
        LAS float* scr = (LAS float*)(lds + wave * 16384);
        const int cw = vcu >> 1, NGW = ncv * NWAVES; int it = cw * NWAVES + wave;
#ifdef PROBE_NOCONV_REPEAT
        if (*(volatile LAS int*)(lds + LDS_BYTES - 32) != 0) it = IT_L1MOE;
#endif
        ConvJob j0{}, j1{}, j2{}; f32x4 r0[8], r1[8], r2[8];
        if (it < IT_L1MOE) { j0 = conv_job_l1(p, it); ti_load4(j0.src, j0.src_ld, lane, r0); }
        if (it + NGW < IT_L1MOE) { j1 = conv_job_l1(p, it + NGW); ti_load4(j1.src, j1.src_ld, lane, r1); }
        if (it + 2 * NGW < IT_L1MOE) { j2 = conv_job_l1(p, it + 2 * NGW); ti_load4(j2.src, j2.src_ld, lane, r2); }
        for (; it < IT_L1MOE; it += 3 * NGW) {
            { const ConvJob cj = j0; f32x4 c[8];
#pragma unroll
              for (int i = 0; i < 8; ++i) c[i] = r0[i];
              if (it + 3 * NGW < IT_L1MOE) { j0 = conv_job_l1(p, it + 3 * NGW); ti_load4(j0.src, j0.src_ld, lane, r0); }
              ti_store4_fp8(c, cj.dst, cj.dst_ldb, scr, lane); }
            if (it + NGW < IT_L1MOE) { const ConvJob cj = j1; f32x4 c[8];
#pragma unroll
              for (int i = 0; i < 8; ++i) c[i] = r1[i];
              if (it + 4 * NGW < IT_L1MOE) { j1 = conv_job_l1(p, it + 4 * NGW); ti_load4(j1.src, j1.src_ld, lane, r1); }
              ti_store4_fp8(c, cj.dst, cj.dst_ldb, scr, lane); }
            if (it + 2 * NGW < IT_L1MOE) { const ConvJob cj = j2; f32x4 c[8];
#pragma unroll
              for (int i = 0; i < 8; ++i) c[i] = r2[i];
              if (it + 5 * NGW < IT_L1MOE) { j2 = conv_job_l1(p, it + 5 * NGW); ti_load4(j2.src, j2.src_ld, lane, r2); }
              ti_store4_fp8(c, cj.dst, cj.dst_ldb, scr, lane); }
        }
        return;
    }
    const unsigned char* IMG = p->ws + WS_U + U_IMG;
    for (int su = vcu >> 1; su < 128; su += nsc) {
        const int chain = su >> 1, pair = su & 1;
        const unsigned char* cimg = IMG + (size_t)chain * R5_NCH * R5_IMG;
        const int li = (wave == 2) ? 0 : (wave == 3) ? 1 : (wave == 6) ? 2 : -1;
        auto issue = [&](int bt) {
            const unsigned char* ci = cimg + (size_t)(bt * R5_NCB + li) * R5_IMG;
            LAS unsigned char* dl = lds + ((bt % R5_NST) * R5_NCB + li) * R7_SLOT;
#pragma unroll
            for (int k = 0; k < R7_NPC; ++k) { const int pi = k * 64 + lane;
                const unsigned char* src = ci + (pi < 656 ? pi * 16 : (pi < 720 ? R5_VT + pair * 1024 + (pi - 656) * 16 : 0));
                __builtin_amdgcn_global_load_lds((const unsigned*)src, (LAS unsigned*)(dl + k * 1024), 16, 0, 0); } };
        __syncthreads();
        if (li >= 0) { issue(0); issue(1); asm volatile("s_waitcnt vmcnt(12)" ::: "memory"); }
        __syncthreads();
        if (wave >= 2) {
            if (li >= 0) {
                for (int bt = 0; bt < NB5; ++bt) {
                    if (bt + 2 < NB5) { issue(bt + 2); asm volatile("s_waitcnt vmcnt(12)" ::: "memory"); } else asm volatile("s_waitcnt vmcnt(0)" ::: "memory");
                    asm volatile("s_waitcnt lgkmcnt(0)" ::: "memory"); __builtin_amdgcn_s_barrier(); asm volatile("" ::: "memory");
                }
            } else {
                for (int bt = 0; bt < NB5; ++bt) { asm volatile("s_waitcnt lgkmcnt(0)" ::: "memory"); __builtin_amdgcn_s_barrier(); asm volatile("" ::: "memory"); }
            }
        } else {
            const int unit = chain * 4 + pair * 2 + wave;
            float* YST = (float*)(p->ws + WS_U + U_YST) + (size_t)unit * NSTEP * 16 + (4 * q) * 16 + m;
            f32x4 S[4];
#pragma unroll
            for (int T = 0; T < 4; ++T) S[T] = (f32x4){0.f, 0.f, 0.f, 0.f};
            __builtin_amdgcn_s_setprio(3);
            for (int bt = 0; bt < NB5; ++bt) {
                struct OpsE { bf16x8_t a[2][2]; bf16x4_t e21[2]; v2u vr; };
                struct OpsL { bf16x4_t a2[2]; bf16x8_t UA[4]; f32x4 ge[4]; };
                auto rdE = [&](int cc, OpsE& o) {
                    const LAS unsigned char* sl = lds + ((bt % R5_NST) * R5_NCB + cc) * R7_SLOT;
#pragma unroll
                    for (int rb = 0; rb < 2; ++rb) {
#pragma unroll
                        for (int s = 0; s < 2; ++s) o.a[rb][s] = *(const LAS bf16x8_t*)(sl + R5_DOTA + (16 * rb + m) * 128 + (s * 4 + q) * 16);
                        o.e21[rb] = *(const LAS bf16x4_t*)(sl + R5_A21 + (16 * rb + m) * 32 + q * 8); }
                    o.vr = *(const LAS v2u*)(sl + R5_VT + wave * 512 + q * 128 + m * 8); };
                auto rdL = [&](int cc, OpsL& o) {
                    const LAS unsigned char* sl = lds + ((bt % R5_NST) * R5_NCB + cc) * R7_SLOT;
#pragma unroll
                    for (int rb = 0; rb < 2; ++rb) o.a2[rb] = *(const LAS bf16x4_t*)(sl + R5_A2 + (16 * rb + m) * 32 + q * 8);
#pragma unroll
                    for (int T = 0; T < 4; ++T) { o.UA[T] = *(const LAS bf16x8_t*)(sl + R5_UPA + q * 1024 + (16 * T + m) * 16); o.ge[T] = *(const LAS f32x4*)(sl + R5_GE + (16 * T + 4 * q) * 4); } };
                OpsE cur, nxt; OpsL L; rdE(0, cur);
#pragma unroll
                for (int cc = 0; cc < R5_NCB; ++cc) {
                    rdL(cc, L);
                    if (cc + 1 < R5_NCB) rdE(cc + 1, nxt);
                    __builtin_amdgcn_sched_barrier(0);
                    v4u b0, b1;
                    b0.x = cvtpk(S[0][0], S[0][1]); b0.y = cvtpk(S[0][2], S[0][3]); b0.z = cvtpk(S[1][0], S[1][1]); b0.w = cvtpk(S[1][2], S[1][3]);
                    b1.x = cvtpk(S[2][0], S[2][1]); b1.y = cvtpk(S[2][2], S[2][3]); b1.z = cvtpk(S[3][0], S[3][1]); b1.w = cvtpk(S[3][2], S[3][3]);
                    const f32x4 z4 = (f32x4){0.f, 0.f, 0.f, 0.f};
                    const v2u vb = cur.vr;
                    f32x4 D0 = mfma16(cur.a[0][0], __builtin_bit_cast(bf16x8_t, b0), z4), D1 = mfma16(cur.a[1][0], __builtin_bit_cast(bf16x8_t, b0), z4);
                    const f32x4 E0 = __builtin_amdgcn_mfma_f32_16x16x16bf16_1k(cur.e21[0], __builtin_bit_cast(bf16x4_t, vb), z4, 0, 0, 0);
                    D0 = mfma16(cur.a[0][1], __builtin_bit_cast(bf16x8_t, b1), D0); D1 = mfma16(cur.a[1][1], __builtin_bit_cast(bf16x8_t, b1), D1);
                    const f32x4 E1 = __builtin_amdgcn_mfma_f32_16x16x16bf16_1k(cur.e21[1], __builtin_bit_cast(bf16x4_t, vb), D1, 0, 0, 0);
                    v2u db; db.x = cvtpk(D0[0], D0[1]); db.y = cvtpk(D0[2], D0[3]);
                    const f32x4 W0 = __builtin_amdgcn_mfma_f32_16x16x16bf16_1k(L.a2[0], __builtin_bit_cast(bf16x4_t, db), E0, 0, 0, 0);
                    const f32x4 W1 = __builtin_amdgcn_mfma_f32_16x16x16bf16_1k(L.a2[1], __builtin_bit_cast(bf16x4_t, db), E1, 0, 0, 0);
                    v4u ub; ub.x = cvtpk(W0[0], W0[1]); ub.y = cvtpk(W0[2], W0[3]); ub.z = vb.x; ub.w = vb.y;
#pragma unroll
                    for (int T = 0; T < 4; ++T) S[T] = mfma16(L.UA[T], __builtin_bit_cast(bf16x8_t, ub), S[T] * L.ge[T]);
                    { float* yp = YST + (size_t)(bt * R5_NCB + cc) * 256;
#pragma unroll
                      for (int i = 0; i < 4; ++i) yp[i * 16] = W1[i]; }
                    if (cc + 1 < R5_NCB) cur = nxt;
                }
                asm volatile("s_waitcnt lgkmcnt(0)" ::: "memory"); __builtin_amdgcn_s_barrier(); asm volatile("" ::: "memory");
            }
            __builtin_amdgcn_s_setprio(0);
        }
    }
}
enum { PH_PRE = 0, PH_NORM0, PH_G_IN, PH_GLA_A, PH_GLA_B, PH_GLA_C, PH_G_HGO, PH_FFN0, PH_GU0, PH_DN0, PH_COMB0,
       PH_LERP, PH_G_RKV, PH_G_L2, PH_RWPREP, PH_RWSCAN, PH_RWRO, PH_G_RWO, PH_FFN1, PH_GU1, PH_DN1, PH_COMB1, NPHASES };

template <int ph> __device__ __forceinline__ void run_phase(PP p, LAS unsigned char* lds, int tid, int lane, int wave, int G, int bx, int vcu) {
    unsigned char* ws = p->ws;
    typedef pg8::bf16_t bt;
    switch (ph) {
        case PH_PRE: phase_pre(p, lds, tid, lane, wave); break;
        case PH_NORM0: phase_norm0(p, lane, wave); break;
        case PH_G_IN: {
            pg8::Gemm g{(const bt*)(ws + WS_H), (const bt*)(ws + WS_WIN), NROW, 5120, D / 2}; pg8::StaticOrder S; S.init(NROW, 5120, G, bx);
            pg8::EpiStoreBf16 E{(bt*)(ws + WS_U + U_Z), 5120};
            pg8::gemm_phase<pg8::EpiStoreBf16, pg8::StaticOrder, true, true, true>(lds, g, S, E); } break;
        case PH_GLA_A: phase_gla_prep(p, lds, tid, lane, wave); break;
        case PH_GLA_B: phase_gla_scan(p, tid); break;
        case PH_GLA_C: phase_gla_out(p, lds, tid, lane, wave); break;
        case PH_G_HGO: {
            pg8::Gemm g{(const bt*)(ws + WS_A2), (const bt*)(ws + WS_WHGO), NROW, D, D}; pg8::StaticOrder S; S.init(NROW, D, G, bx);
            pg8::EpiResid E{p->in[I_X], p->in[I_CTX], (float*)(ws + WS_XR), modp(p, 0, 0, 2), 6144};
            pg8::gemm_phase<pg8::EpiResid, pg8::StaticOrder, true, true>(lds, g, S, E); } break;
        case PH_FFN0: phase_ffn_norm_route4(p, 0, NROW, lds, tid, lane, wave); break;
        case PH_FFN1: phase_ffn_norm_route4(p, 1, NLAT, lds, tid, lane, wave); break;
        case PH_GU0: case PH_GU1: { const int layer = (ph == PH_GU1);
            pg8::Gemm g{(const bt*)(ws + WS_U + U_XB), (const bt*)(ws + WS_WGU + (size_t)layer * NE * 2048 * D), CAP, 2048, D / 2};
            const int ntl = (int)((const unsigned*)(ws + WS_CTL))[CW_NT + layer];
            pg8::MoeOrder S; S.init((const int*)(ws + WS_ROUTE + RT_TILEE) + layer * 512, ntl, (LAS int*)(lds + 132096), 8, (size_t)2048 * D, G, vcu);
            pg8::EpiSwiglu E{p, layer};
            pg8::gemm_phase<pg8::EpiSwiglu, pg8::MoeOrder, true, true, true, true>(lds, g, S, E); } break;
        case PH_DN0: case PH_DN1: { const int layer = (ph == PH_DN1);
            pg8::Gemm g{(const bt*)(ws + WS_U + U_ACT), (const bt*)(ws + WS_WD + (size_t)layer * NE * D * D), CAP, D, D / 2};
            const int ntl = (int)((const unsigned*)(ws + WS_CTL))[CW_NT + layer];
            pg8::MoeOrder S; S.init((const int*)(ws + WS_ROUTE + RT_TILEE) + layer * 512, ntl, (LAS int*)(lds + 132096), 4, (size_t)D * D, G, vcu);
            pg8::EpiDown E{p, layer};
            pg8::gemm_phase<pg8::EpiDown, pg8::MoeOrder, true, true, true, true>(lds, g, S, E); } break;
        case PH_COMB0: phase_combine(p, 0, NROW, false, lane, wave); break;
        case PH_COMB1: phase_combine(p, 1, NLAT, true, lane, wave); break;
        case PH_LERP: phase_lerp(p, lds, tid, lane, wave); break;
        case PH_G_RKV: {
            pg8::Gemm g{(const bt*)(ws + WS_U + U_XL6), (const bt*)(ws + WS_WRKV), NROW, 3072, D};
            pg8::RkvL1Order S; S.init(NROW, G, bx, (const bt*)(ws + WS_WL1), (size_t)NROW * D * 2);
            pg8::EpiRkvL1 E{pg8::EpiStoreBf16{(bt*)(ws + WS_U + U_RKV), 3072}, pg8::EpiLora1{(bt*)(ws + WS_U + U_L1)}};
            pg8::gemm_phase<pg8::EpiRkvL1, pg8::RkvL1Order, true, true>(lds, g, S, E); } break;
        case PH_G_L2: phase_lora2(p, lds, tid, lane, wave); break;
        case PH_RWPREP: phase_rw_prep5(p, lds, lane, wave); break;
        case PH_RWSCAN: phase_rwkv_scan7(p, lds, vcu, tid, lane, wave); break;
        case PH_RWRO: phase_rw_readout(p, lane, wave); break;
        case PH_G_RWO: {
            pg8::Gemm g{(const bt*)(ws + WS_A2), (const bt*)(ws + WS_WRWO), NLAT, D, D}; pg8::StaticOrder S; S.init(NLAT, D, G, bx);
            float* XR = (float*)(ws + WS_XR);
            pg8::EpiResid E{XR, XR + (size_t)NLAT * D, XR, modp(p, 1, 0, 2), 6144};
            pg8::gemm_phase<pg8::EpiResid, pg8::StaticOrder, true, true>(lds, g, S, E); } break;
        default: break;
    }
}

#define MK_PROLOGUE \
    extern __shared__ __attribute__((aligned(16))) unsigned char lds_raw[]; \
    LAS unsigned char* lds = (LAS unsigned char*)lds_raw; \
    const int tid = threadIdx.x, lane = tid & 63, wave = __builtin_amdgcn_readfirstlane(tid >> 6); \
    const int G = gridDim.x, bx = blockIdx.x, vcu = (G % 8 == 0) ? (bx % 8) * (G / 8) + bx / 8 : bx;

#define XB_TMO      128
#define XB_XCNT(j)  (256  + 64 * (j))
#define XB_XSUB(j)  (1280 + 64 * (j))
#define XB_XGEN(j)  (2304 + 64 * (j))
#define XB_TOP      3328
#define XB_TOPGEN   3392
#define XCD_BAR_WORDS 3456
#define XB_SPIN_CAP (1u << 18)

__device__ __forceinline__ unsigned xb_ld(unsigned* p)              { return __hip_atomic_load(p, __ATOMIC_RELAXED, __HIP_MEMORY_SCOPE_AGENT); }
__device__ __forceinline__ unsigned xb_add(unsigned* p, unsigned v) { return __hip_atomic_fetch_add(p, v, __ATOMIC_RELAXED, __HIP_MEMORY_SCOPE_AGENT); }
__device__ __forceinline__ unsigned xb_xcc_id() { return (unsigned)__builtin_amdgcn_s_getreg((3 << 11) | 20) & 0xFu; }
#define XB_SPIN(cond, bar) do { unsigned _sp = 0; while (cond) { __builtin_amdgcn_s_sleep(1); \
    if ((++_sp & 255u) == 0u) { if (xb_ld(&(bar)[XB_TMO])) break; if (_sp > XB_SPIN_CAP) { atomicAdd(&(bar)[XB_TMO], 1u); break; } } } } while (0)

struct XcdBarrier {
    unsigned* bar; unsigned x;
    volatile LAS unsigned* st;
};

__device__ __forceinline__ XcdBarrier xcd_barrier_post(unsigned* bar, volatile LAS unsigned* st) {
    XcdBarrier b; b.bar = bar; b.x = xb_xcc_id(); b.st = st;
    if (threadIdx.x == 0) (void)xb_add(&bar[XB_XCNT(b.x)], 1u);
    return b;
}
__device__ __forceinline__ void xcd_barrier_complete(unsigned* bar, unsigned x, unsigned& nloc, unsigned& nx) {
    const unsigned G = gridDim.x * gridDim.y * gridDim.z;
    unsigned sum, cnt, mine, sp = 0u;
    for (;;) {
        sum = 0u; cnt = 0u; mine = 0u;
#pragma unroll
        for (unsigned j = 0; j < 16; ++j) { const unsigned c = xb_ld(&bar[XB_XCNT(j)]); sum += c; cnt += (c > 0u) ? 1u : 0u; mine = (j == x) ? c : mine; }
        if (sum == G) break;
        __builtin_amdgcn_s_sleep(1);
        if ((++sp & 255u) == 0u) { if (xb_ld(&bar[XB_TMO])) break; if (sp > XB_SPIN_CAP) { atomicAdd(&bar[XB_TMO], 1u); break; } }
    }
    nloc = mine > 0u ? mine : 1u; nx = cnt > 0u ? cnt : 1u;
}

__device__ __forceinline__ void xcd_barrier(const XcdBarrier& b) {
    asm volatile("s_waitcnt vmcnt(0)" ::: "memory");
    __syncthreads();
    if (threadIdx.x == 0) {
        unsigned* bar = b.bar;
        __builtin_amdgcn_s_waitcnt(0);
        unsigned nloc = b.st[0], nx = b.st[1];
        if (nloc == 0u) { xcd_barrier_complete(bar, b.x, nloc, nx); b.st[0] = nloc; b.st[1] = nx; }
        const unsigned old = xb_add(&bar[XB_XSUB(b.x)], 1u);
        const unsigned gen = old / nloc;
        if (old + 1u == (gen + 1u) * nloc) {
            __builtin_amdgcn_fence(__ATOMIC_RELEASE, "agent");
            asm volatile("s_waitcnt vmcnt(0)" ::: "memory");
            const unsigned og = xb_add(&bar[XB_TOP], 1u);
            const unsigned tg = og / nx;
            if (og + 1u == (tg + 1u) * nx) xb_add(&bar[XB_TOPGEN], 1u);
            else XB_SPIN(xb_ld(&bar[XB_TOPGEN]) == tg, bar);
            __builtin_amdgcn_fence(__ATOMIC_ACQUIRE, "agent");
            xb_add(&bar[XB_XGEN(b.x)], 1u);
            asm volatile("s_waitcnt vmcnt(0)" ::: "memory");
        } else {
            XB_SPIN(xb_ld(&bar[XB_XGEN(b.x)]) == gen, bar);
            __builtin_amdgcn_fence(__ATOMIC_ACQUIRE, "agent");
            asm volatile("s_waitcnt vmcnt(0)" ::: "memory");
        }
    }
    __syncthreads();
}

constexpr int LDSCTL_OFF = 131072, MISC_OFF = LDSCTL_OFF + 320;
__device__ __forceinline__ void grid_bar(PP kp, LAS unsigned char* lds) {
    PP q = kp; asm volatile("" : "+s"(q));
    XcdBarrier b; b.bar = (unsigned*)(q->ws + WS_CTL) + CW_BAR; b.x = xb_xcc_id(); b.st = (volatile LAS unsigned*)(lds + LDS_BYTES - 64);
    xcd_barrier(b);
}
namespace cg = cooperative_groups;
__global__ void __launch_bounds__(NTHREADS, 2) mk_fwd(Params pv) {
    MK_PROLOGUE
    cg::grid_group grid = cg::this_grid();
    PP kp = (PP)__builtin_amdgcn_kernarg_segment_ptr();
    const int lo = kp->ph_lo, hi = kp->ph_hi;
    for (int u = tid; u < (LDS_BYTES - LDSCTL_OFF) / 4; u += NTHREADS) ((LAS unsigned*)(lds + LDSCTL_OFF))[u] = 0u;
    __syncthreads();
    { XcdBarrier b0 = xcd_barrier_post((unsigned*)(kp->ws + WS_CTL) + CW_BAR, (volatile LAS unsigned*)(lds + LDS_BYTES - 64)); (void)b0; }
#ifndef REPEAT_MASK
#define REPEAT_MASK 0u
#endif
#define RUN(k) if (lo <= (k) && (k) < hi) { PP q = kp; asm volatile("" : "+s"(q)); run_phase<k>(q, lds, tid, lane, wave, G, bx, vcu); \
        if ((REPEAT_MASK >> (k)) & 1u) { grid_bar(kp, lds); PP q2 = kp; asm volatile("" : "+s"(q2)); run_phase<k>(q2, lds, tid, lane, wave, G, bx, vcu); } \
        if ((k) + 1 < hi) { if ((k) == 0) grid.sync(); else grid_bar(kp, lds); } }
    RUN(0) RUN(1) RUN(2) RUN(3) RUN(4) RUN(5) RUN(6) RUN(7) RUN(8) RUN(9) RUN(10) RUN(11) RUN(12) RUN(13) RUN(14) RUN(15) RUN(16) RUN(17) RUN(18) RUN(19) RUN(20) RUN(21)
#undef RUN
}

extern "C" void kernel_launch(void* const* d_in, const int* in_sizes, int n_in, void* d_out, int out_size, void* d_ws, size_t ws_size, hipStream_t stream) {
    static int grid = 0;
    if (grid == 0) {
        if (n_in != 35 || in_sizes[0] != NLAT * D || out_size != NLAT * D || ws_size < WS_END) {
            fprintf(stderr, "kernel_launch: unexpected problem (n_in %d, in0 %d, out %d, ws %zu < %zu)\n", n_in, n_in > 0 ? in_sizes[0] : -1, out_size, ws_size, (size_t)WS_END); grid = -1; return; }
        int dev = 0, cus = 0, per_cu = 0;
        if (hipGetDevice(&dev) != hipSuccess || hipDeviceGetAttribute(&cus, hipDeviceAttributeMultiprocessorCount, dev) != hipSuccess) { grid = -1; return; }
        if (hipFuncSetAttribute((const void*)mk_fwd, hipFuncAttributeMaxDynamicSharedMemorySize, LDS_BYTES) != hipSuccess) { fprintf(stderr, "kernel_launch: hipFuncSetAttribute failed\n"); grid = -1; return; }
        if (hipOccupancyMaxActiveBlocksPerMultiprocessor(&per_cu, (const void*)mk_fwd, NTHREADS, LDS_BYTES) != hipSuccess || per_cu < 1) { fprintf(stderr, "kernel_launch: occupancy query %d\n", per_cu); per_cu = 1; }
        (void)hipGetLastError();
        grid = cus * (per_cu < 1 ? 1 : per_cu);
    }
    if (grid < 0) return;
    (void)hipMemsetAsync((char*)d_ws + WS_CTL, 0, CTL_ZERO_BYTES, stream);
    Params p{};
    for (int i = 0; i < 35; ++i) p.in[i] = (const float*)d_in[i];
    p.out = (float*)d_out; p.ws = (unsigned char*)d_ws;
    p.ph_lo = 0; p.ph_hi = NPHASES;
    void* args[] = {&p};
    hipError_t e = hipLaunchCooperativeKernel((const void*)mk_fwd, dim3(grid), dim3(NTHREADS), args, LDS_BYTES, stream);
    if (e != hipSuccess) fprintf(stderr, "kernel_launch: cooperative launch failed: %s (grid %d)\n", hipGetErrorString(e), grid);
}
```

```cpp
#include <hip/hip_runtime.h>
#include <hip/hip_cooperative_groups.h>
#include <cstdio>
#include <cstdint>

namespace pg8 {
#define PG8_LAS __attribute__((address_space(3)))
typedef unsigned short bf16_t;
typedef short bf16x8 __attribute__((ext_vector_type(8)));
typedef float f32x4 __attribute__((ext_vector_type(4)));
typedef unsigned u32x4 __attribute__((ext_vector_type(4)));
constexpr int BM = 256, BK = 64, HALF = 128, HTB = HALF * BK * 2  , STAGE_BYTES = 8 * HTB, NXCD = 8, WGM = 8;

__host__ __device__ __forceinline__ int lds_byte(int r, int c) { const int st = (r >> 4) * 2 + (c >> 5), rr = r & 15, cc = c & 31, ob = rr * 64 + cc * 2; return st * 1024 + (ob ^ (((ob >> 9) & 1) << 5)); }
__host__ __device__ __forceinline__ void stage_rc(int b, int& R, int& C) { const int st = b / 1024, sb = b % 1024, swz = sb ^ (((sb >> 9) & 1) << 5); R = (st >> 1) * 16 + swz / 64; C = (st & 1) * 32 + (swz % 64) / 2; }
__host__ __device__ __forceinline__ int perm32(int rho) { const int n = rho >> 4, i = rho & 15; return 8 * (i >> 2) + 4 * n + (i & 3); }

struct Unit { int pm, pn, e; };
struct Gemm { const bf16_t* A; const bf16_t* Bt; int M, N, K; };

struct StaticOrder {
    int nM, nN, nwg, G, c;
    __host__ __device__ void init(int M, int N, int G_, int c_) { nM = M / BM; nN = N / BM; nwg = nM * nN; G = G_; c = c_; }
    __host__ __device__ bool next(int i, Unit& u) const { return at((long)i * G + c, u); }
    __host__ __device__ bool at(long L, Unit& u) const {
        if (L >= nwg) return false;
        int wgid = (int)L; { const int q = nwg / NXCD, r = nwg % NXCD, xcd = wgid % NXCD, off = wgid / NXCD; wgid = (xcd < r ? xcd * (q + 1) : r * (q + 1) + (xcd - r) * q) + off; }
        const int nig = WGM * nN, gid = wgid / nig, fm = gid * WGM, gsz = (nM - fm) < WGM ? (nM - fm) : WGM;
        u.pm = fm + ((wgid % nig) % gsz); u.pn = (wgid % nig) / gsz; u.e = 0; return true;
    }
    __device__ __forceinline__ const char* abase(const Gemm& g, const Unit& u, size_t tstep) const { return (const char*)g.A + (size_t)u.pm * tstep; }
    __device__ __forceinline__ const char* bbase(const Gemm& g, const Unit& u, size_t tstep) const { return (const char*)g.Bt + (size_t)u.pn * tstep; }
    __device__ __forceinline__ void a_ready(const Unit&) const {}
    __device__ __forceinline__ void done(const Unit&) const {}
};

__device__ __forceinline__ unsigned cvt_pk_bf16(float lo, float hi) { unsigned r; asm volatile("v_cvt_pk_bf16_f32 %0, %1, %2" : "=v"(r) : "v"(lo), "v"(hi)); return r; }

typedef int v4i_t __attribute__((ext_vector_type(4))); typedef int v8i_t __attribute__((ext_vector_type(8)));
template <bool FP8> struct Frag { bf16x8 v[2]; };
template <> struct Frag<true> { v8i_t v; };
__device__ __forceinline__ void ld_frag(Frag<false>& f, const PG8_LAS unsigned char* p0) { f.v[0] = *(const PG8_LAS bf16x8*)(p0); f.v[1] = *(const PG8_LAS bf16x8*)(p0 + 1024); }
__device__ __forceinline__ void ld_frag(Frag<true>& f, const PG8_LAS unsigned char* p0) { const v4i_t lo = *(const PG8_LAS v4i_t*)(p0), hi = *(const PG8_LAS v4i_t*)(p0 + 1024); f.v = (v8i_t){lo.x, lo.y, lo.z, lo.w, hi.x, hi.y, hi.z, hi.w}; }
__device__ __forceinline__ f32x4 mma_frag(const Frag<false>& b, const Frag<false>& a, f32x4 c) { c = __builtin_amdgcn_mfma_f32_16x16x32_bf16(b.v[0], a.v[0], c, 0, 0, 0); return __builtin_amdgcn_mfma_f32_16x16x32_bf16(b.v[1], a.v[1], c, 0, 0, 0); }
__device__ __forceinline__ f32x4 mma_frag(const Frag<true>& b, const Frag<true>& a, f32x4 c) {
    const int sw = 0x7A7A7A7A, sa = 0x7F7F7F7F;
    asm volatile("v_mfma_scale_f32_16x16x128_f8f6f4 %0, %1, %2, %0, %3, %4 op_sel_hi:[0,0,0]" : "+v"(c) : "v"(b.v), "v"(a.v), "v"(sw), "v"(sa));
    return c;
}

template <class Epi, class Sched, bool ALIGN_EPI = false, bool SP2 = false, bool FP8 = false, bool PRE = false>
__device__ __forceinline__ void gemm_phase(PG8_LAS unsigned char* lds, const Gemm g, const Sched& S, const Epi& E) {
    const int tid = threadIdx.x, wid = __builtin_amdgcn_readfirstlane(tid >> 6), lane = tid & 63, wr = wid >> 2, wc = wid & 3, fr = lane & 15, fq = lane >> 4;
    const int K = g.K, nt = K / BK;
    unsigned voffA[2], voffB[2];
#pragma unroll
    for (int i = 0; i < 2; ++i) { int R, C; stage_rc(tid * 16 + i * 8192, R, C); const int Rb = Epi::PERM ? ((R & ~31) + perm32(R & 31)) : R;
        voffA[i] = (unsigned)(R * K + C) * 2u; voffB[i] = (unsigned)(Rb * K + C) * 2u; }
    const size_t kstep = (size_t)(BK * 2);
    const size_t hstep = (size_t)HALF * K * 2;
    const size_t tstep = 2 * hstep;
    const unsigned ldsw = (unsigned)wid * 1024u;
    const int aoff = lds_byte(wr * 64 + fr, fq * 8), boff = lds_byte(wc * 32 + fr, fq * 8);
#define PG8_SA(b, h) (((b) * 2 + (h)) * HTB)
#define PG8_SB(b, h) ((4 + (b) * 2 + (h)) * HTB)
#define PG8_STAGE(bufoff, gbase, voff) do { _Pragma("unroll") for (int _i = 0; _i < 2; ++_i) \
        __builtin_amdgcn_global_load_lds((const unsigned*)((const char*)(gbase) + (voff)[_i]), (PG8_LAS unsigned*)(lds + (bufoff) + ldsw + _i * 8192), 16, 0, 0); } while (0)
#define PG8_LDA(dst, b, h) do { _Pragma("unroll") for (int m = 0; m < 4; ++m) ld_frag(dst[m], lds + PG8_SA(b, h) + aoff + m * 2048); } while (0)
#define PG8_LDB(dst, b, h) do { _Pragma("unroll") for (int n = 0; n < 2; ++n) ld_frag(dst[n], lds + PG8_SB(b, h) + boff + n * 2048); } while (0)
#define PG8_MMA(ai, bj, At, Bt) do { __builtin_amdgcn_s_setprio(1); _Pragma("unroll") for (int m = 0; m < 4; ++m) _Pragma("unroll") for (int n = 0; n < 2; ++n) \
        acc[ai][bj][m][n] = mma_frag(Bt[n], At[m], acc[ai][bj][m][n]); __builtin_amdgcn_s_setprio(0); } while (0)
#define PG8_WAIT_V(n) asm volatile("s_waitcnt vmcnt(" #n ")" ::: "memory")
#define PG8_WAIT_L(n) asm volatile("s_waitcnt lgkmcnt(" #n ")" ::: "memory")
#define PG8_BAR __builtin_amdgcn_s_barrier()
#define PG8_SCHED __builtin_amdgcn_sched_barrier(0)
    Unit cur, nxt; int ui = 0;
    if (!S.next(0, cur)) return;
    f32x4 acc[2][2][4][2];
#pragma unroll
    for (int a = 0; a < 2; ++a)
#pragma unroll
        for (int b = 0; b < 2; ++b)
#pragma unroll
            for (int m = 0; m < 4; ++m)
#pragma unroll
                for (int n = 0; n < 2; ++n) acc[a][b][m][n] = (f32x4){0.f, 0.f, 0.f, 0.f};
    Frag<FP8> At[4], B0[2], B1[2];
    const char* cA = S.abase(g, cur, tstep); const char* cB = S.bbase(g, cur, tstep);
    S.a_ready(cur);
    if constexpr (SP2) {
        PG8_STAGE(PG8_SB(0, 0), cB, voffB); PG8_STAGE(PG8_SB(0, 1), cB + hstep, voffB); PG8_STAGE(PG8_SA(0, 0), cA, voffA); PG8_STAGE(PG8_SA(0, 1), cA + hstep, voffA);
        if (wr == 1) PG8_BAR;
        PG8_WAIT_V(2); PG8_BAR;
        PG8_STAGE(PG8_SB(1, 0), cB + kstep, voffB); PG8_STAGE(PG8_SA(1, 0), cA + kstep, voffA); PG8_STAGE(PG8_SB(1, 1), cB + hstep + kstep, voffB);
        PG8_WAIT_V(6); PG8_BAR;
    } else {
        PG8_STAGE(PG8_SB(0, 0), cB, voffB); PG8_STAGE(PG8_SA(0, 0), cA, voffA); PG8_STAGE(PG8_SB(0, 1), cB + hstep, voffB); PG8_STAGE(PG8_SA(0, 1), cA + hstep, voffA);
        if (wr == 1) PG8_BAR;
        PG8_WAIT_V(4); PG8_BAR;
        PG8_STAGE(PG8_SB(1, 0), cB + kstep, voffB); PG8_STAGE(PG8_SA(1, 0), cA + kstep, voffA); PG8_STAGE(PG8_SB(1, 1), cB + hstep + kstep, voffB);
        PG8_WAIT_V(6); PG8_BAR;
    }
    typename Epi::Pre pre;
    for (;;) {
        const bool has_next = S.next(ui + 1, nxt);
        const char* nA = has_next ? S.abase(g, nxt, tstep) : cA; const char* nB = has_next ? S.bbase(g, nxt, tstep) : cB;
        _Pragma("unroll 1") for (int t = 0; t < nt; t += 2) {
            const bool last = (t == nt - 2);
            const char* a1 = cA + (size_t)(t + 1) * kstep;
            const char* a2 = last ? nA : cA + (size_t)(t + 2) * kstep; const char* b2 = last ? nB : cB + (size_t)(t + 2) * kstep;
            const char* a3 = a2 + kstep; const char* b3 = b2 + kstep;
            if (last && has_next) S.a_ready(nxt);
            if constexpr (PRE) { if (last) E.prefetch(cur, wr, wc, fr, fq, pre); }
            if constexpr (SP2) {
            PG8_LDB(B0, 0, 0); PG8_LDB(B1, 0, 1); PG8_SCHED; PG8_LDA(At, 0, 0); PG8_STAGE(PG8_SA(1, 1), a1 + hstep, voffA);
            PG8_WAIT_V(8); PG8_WAIT_L(0); PG8_BAR; PG8_MMA(0, 0, At, B0); PG8_MMA(0, 1, At, B1); PG8_BAR; PG8_SCHED;
            PG8_LDA(At, 0, 1); PG8_STAGE(PG8_SB(0, 0), b2, voffB); PG8_STAGE(PG8_SB(0, 1), b2 + hstep, voffB); PG8_STAGE(PG8_SA(0, 0), a2, voffA);
            PG8_WAIT_V(8); PG8_WAIT_L(0); PG8_BAR; PG8_MMA(1, 0, At, B0); PG8_MMA(1, 1, At, B1); PG8_BAR; PG8_SCHED;
            PG8_LDB(B0, 1, 0); PG8_LDB(B1, 1, 1); PG8_SCHED; PG8_LDA(At, 1, 0); PG8_STAGE(PG8_SA(0, 1), a2 + hstep, voffA);
            PG8_WAIT_V(8); PG8_WAIT_L(0); PG8_BAR; PG8_MMA(0, 0, At, B0); PG8_MMA(0, 1, At, B1); PG8_BAR; PG8_SCHED;
            PG8_LDA(At, 1, 1); PG8_STAGE(PG8_SB(1, 0), b3, voffB); PG8_STAGE(PG8_SB(1, 1), b3 + hstep, voffB); PG8_STAGE(PG8_SA(1, 0), a3, voffA);
            PG8_WAIT_V(8); PG8_WAIT_L(0); PG8_BAR; PG8_MMA(1, 0, At, B0); PG8_MMA(1, 1, At, B1); PG8_BAR; PG8_SCHED;
            } else {
            PG8_LDB(B0, 0, 0); PG8_SCHED; PG8_LDA(At, 0, 0); PG8_STAGE(PG8_SA(1, 1), a1 + hstep, voffA);
            PG8_WAIT_L(8); PG8_BAR; PG8_WAIT_L(0); PG8_MMA(0, 0, At, B0); PG8_BAR; PG8_SCHED;
            PG8_LDB(B1, 0, 1); PG8_STAGE(PG8_SB(0, 0), b2, voffB);
            PG8_BAR; PG8_WAIT_L(0); PG8_MMA(0, 1, At, B1); PG8_BAR;
            PG8_LDA(At, 0, 1); PG8_STAGE(PG8_SA(0, 0), a2, voffA);
            PG8_BAR; PG8_WAIT_L(0); PG8_MMA(1, 0, At, B0); PG8_BAR; PG8_SCHED;
            PG8_STAGE(PG8_SB(0, 1), b2 + hstep, voffB);
            PG8_WAIT_V(6); PG8_BAR; PG8_MMA(1, 1, At, B1); PG8_BAR;
            PG8_LDB(B0, 1, 0); PG8_SCHED; PG8_LDA(At, 1, 0); PG8_STAGE(PG8_SA(0, 1), a2 + hstep, voffA);
            PG8_WAIT_L(8); PG8_BAR; PG8_WAIT_L(0); PG8_MMA(0, 0, At, B0); PG8_BAR; PG8_SCHED;
            PG8_LDB(B1, 1, 1); PG8_STAGE(PG8_SB(1, 0), b3, voffB);
            PG8_BAR; PG8_WAIT_L(0); PG8_MMA(0, 1, At, B1); PG8_BAR;
            PG8_LDA(At, 1, 1); PG8_STAGE(PG8_SA(1, 0), a3, voffA);
            PG8_BAR; PG8_WAIT_L(0); PG8_MMA(1, 0, At, B0); PG8_BAR; PG8_SCHED;
            PG8_STAGE(PG8_SB(1, 1), b3 + hstep, voffB);
            PG8_WAIT_V(6); PG8_BAR; PG8_MMA(1, 1, At, B1); PG8_BAR;
            }
        }
        if constexpr (FP8) { asm volatile("s_nop 15\n\ts_nop 15" ::: "memory"); }
        if constexpr (ALIGN_EPI) { if (wr == 0) PG8_BAR; }
        if constexpr (PRE) { E(acc, cur, wr, wc, fr, fq, pre); S.done(cur); } else
        if constexpr (!Epi::AFTER_DRAIN) { E(acc, cur, wr, wc, fr, fq); S.done(cur); }
        if (!has_next) break;
#pragma unroll
        for (int a = 0; a < 2; ++a)
#pragma unroll
            for (int b = 0; b < 2; ++b)
#pragma unroll
                for (int m = 0; m < 4; ++m)
#pragma unroll
                    for (int n = 0; n < 2; ++n) acc[a][b][m][n] = (f32x4){0.f, 0.f, 0.f, 0.f};
        cur = nxt; cA = nA; cB = nB; ++ui;
        if constexpr (ALIGN_EPI) { if (wr == 1) PG8_BAR; }
    }
    PG8_WAIT_V(0);
    if constexpr (!ALIGN_EPI) { if (wr == 0) PG8_BAR; }
    PG8_BAR;
    if constexpr (Epi::AFTER_DRAIN) { E.fused(acc, cur, wr, wc, fr, fq, lds, wid, lane); S.done(cur); }
#undef PG8_SA
#undef PG8_SB
#undef PG8_STAGE
#undef PG8_LDA
#undef PG8_LDB
#undef PG8_MMA
#undef PG8_WAIT_V
#undef PG8_WAIT_L
#undef PG8_BAR
#undef PG8_SCHED
}
}

constexpr int D = 1024, NBATCH = 2, SEQ = 8192, CTXL = 256;
constexpr int NLAT = NBATCH * SEQ, NCTX = NBATCH * CTXL, NROW = NLAT + NCTX;
constexpr int NE = 32, TOPK = 4, MAXTILES = 296, CAP = MAXTILES * 256;
constexpr int NWAVES = 8, NTHREADS = 512;
constexpr float NORM_EPS = 1e-6f;
constexpr int LDS_BYTES = 147456;

constexpr size_t MiB = 1u << 20;
constexpr size_t WS_CTL = 0, CTL_ZERO_BYTES = 1 * MiB;
constexpr size_t WS_MOD = 1 * MiB;
constexpr size_t WS_ROUTE = 2 * MiB;
constexpr size_t RT_TOPI = 0, RT_TOPG = 320 * 1024, RT_POS = 640 * 1024, RT_SLOT = 960 * 1024, RT_RSTD = 1280 * 1024, RT_TILEE = 1408 * 1024;
constexpr size_t WS_WIN = 4 * MiB, WS_WHGO = 14 * MiB, WS_WRKV = 16 * MiB, WS_WL1 = 22 * MiB, WS_WL2 = 24 * MiB, WS_WRWO = 28 * MiB;
constexpr size_t WS_WGU = 32 * MiB, WS_WD = 288 * MiB;
constexpr size_t WS_XR = 416 * MiB, WS_H = 482 * MiB, WS_H2 = 515 * MiB, WS_A2 = 548 * MiB;
constexpr size_t WS_U = 584 * MiB;
constexpr size_t U_Z = 0, U_OD0 = 166 * MiB;
constexpr size_t U_XL6 = 0, U_RKV = 198 * MiB, U_L1 = 396 * MiB, U_WD = 410 * MiB, U_AD = 542 * MiB, U_G = 674 * MiB, U_OD1 = 740 * MiB;
constexpr size_t U_XB = 0, U_ACT = 148 * MiB, U_YS = 296 * MiB;
constexpr size_t WS_END = WS_U + 1352 * MiB;
constexpr int CW_CNT = 16384, CNT_STRIDE = 64;
constexpr int CW_NT = 128;
constexpr int CW_TOF = 8192, TOF_PER = 72;
constexpr int CW_BAR = 4096;

#define LAS __attribute__((address_space(3)))
typedef unsigned short bf16;
typedef unsigned v4u __attribute__((ext_vector_type(4)));
typedef unsigned v2u __attribute__((ext_vector_type(2)));
typedef float f32x4 __attribute__((ext_vector_type(4)));
#define LDS_WAIT() asm volatile("s_waitcnt lgkmcnt(0)" ::: "memory")
typedef float f32x2c __attribute__((ext_vector_type(2))); typedef __bf16 bf16x2c __attribute__((ext_vector_type(2)));
__device__ __forceinline__ unsigned pk2(float lo, float hi) { const f32x2c v = {lo, hi}; const bf16x2c b = __builtin_convertvector(v, bf16x2c); return __builtin_bit_cast(unsigned, b); }
__device__ __forceinline__ unsigned f2bf(float f) { return pk2(f, 0.f) & 0xffffu; }
__device__ __forceinline__ unsigned pk4_fp8(float a, float b, float c, float d) { unsigned w = 0u; w = __builtin_amdgcn_cvt_pk_fp8_f32(a, b, w, false); return __builtin_amdgcn_cvt_pk_fp8_f32(c, d, w, true); }
__device__ __forceinline__ float bf2f(unsigned b) { return __builtin_bit_cast(float, b << 16); }
__device__ __forceinline__ float wave_sum(float x) {
    x += __builtin_bit_cast(float, __builtin_amdgcn_update_dpp(0, __builtin_bit_cast(int, x), 0x128, 0xf, 0xf, false));
    x += __builtin_bit_cast(float, __builtin_amdgcn_update_dpp(0, __builtin_bit_cast(int, x), 0x124, 0xf, 0xf, false));
    x += __builtin_bit_cast(float, __builtin_amdgcn_update_dpp(0, __builtin_bit_cast(int, x), 0x122, 0xf, 0xf, false));
    x += __builtin_bit_cast(float, __builtin_amdgcn_update_dpp(0, __builtin_bit_cast(int, x), 0x121, 0xf, 0xf, false));
    x += __builtin_bit_cast(float, __builtin_amdgcn_update_dpp(0, __builtin_bit_cast(int, x), 0x142, 0xa, 0xf, false));
    x += __builtin_bit_cast(float, __builtin_amdgcn_update_dpp(0, __builtin_bit_cast(int, x), 0x143, 0xc, 0xf, false));
    return __builtin_bit_cast(float, __builtin_amdgcn_readlane(__builtin_bit_cast(int, x), 63));
}
__device__ __forceinline__ float sigm(float x) { return __builtin_amdgcn_rcpf(1.0f + __expf(-x)); }

struct Params { const float* in[35]; float* out; unsigned char* ws; int ph_lo, ph_hi; };
typedef const __attribute__((address_space(4))) Params* PP;
enum { I_X = 0, I_C, I_CTX, I_CCTX, I_ADAW, I_ADAB, I_NMIX, I_NFFN, I_HGWIN, I_HGGN, I_HGWOUT, I_HGLB, I_MU, I_WRKV, I_DECW0, I_DECW1, I_DECW2,
       I_A0, I_A1, I_A2, I_G1, I_G2, I_KK, I_KA, I_RK, I_LNXW, I_LNXB, I_RWOUT, I_ROUTW, I_ROUTB, I_WGU, I_BGU, I_WDN, I_BDN, I_FINALG };

__device__ __forceinline__ const float* modp(PP p, int l, int v, int j) { return (const float*)(p->ws + WS_MOD) + ((size_t)(l * 3 + v) * 6 + j) * D; }
__device__ __forceinline__ int row_vec(int row) { return row < NLAT ? (row >= SEQ ? 1 : 0) : 2; }

__device__ __forceinline__ void ti_load(const float* src, int src_ld, int lane, float (&rg)[32]) {
    if (src) {
#pragma unroll
        for (int i = 0; i < 32; ++i) rg[i] = src[(size_t)(2 * i + (lane >> 5)) * src_ld + (lane & 31)];
    }
}
__device__ __forceinline__ void ti_store(bool nonzero, int fp8, const float (&rg)[32], unsigned char* dst, int dst_ldb, LAS float* scr, int lane) {
    if (nonzero) {
#pragma unroll
        for (int i = 0; i < 32; ++i) scr[(2 * i + (lane >> 5)) * 33 + (lane & 31)] = rg[i];
    }
    LDS_WAIT(); asm volatile("" ::: "memory");
    if (fp8) {
        const int n = lane >> 1, hk = (lane & 1) * 32; const LAS float* s = scr + hk * 33 + n; unsigned w[8];
#pragma unroll
        for (int q = 0; q < 8; ++q) w[q] = pk4_fp8(s[(4 * q) * 33] * 32.f, s[(4 * q + 1) * 33] * 32.f, s[(4 * q + 2) * 33] * 32.f, s[(4 * q + 3) * 33] * 32.f);
        v4u* d = (v4u*)(dst + (size_t)n * dst_ldb + hk); d[0] = (v4u){w[0], w[1], w[2], w[3]}; d[1] = (v4u){w[4], w[5], w[6], w[7]};
    } else {
        const int c = lane & 7;
#pragma unroll
        for (int j = 0; j < 4; ++j) {
            const int n = (lane >> 3) + 8 * j; v4u o = (v4u){0u, 0u, 0u, 0u};
            if (nonzero) { const LAS float* s = scr + (8 * c) * 33 + n;
                o.x = pk2(s[0 * 33], s[1 * 33]); o.y = pk2(s[2 * 33], s[3 * 33]); o.z = pk2(s[4 * 33], s[5 * 33]); o.w = pk2(s[6 * 33], s[7 * 33]); }
            *(v4u*)(dst + (size_t)n * dst_ldb + 16 * c) = o;
        }
    }
    LDS_WAIT(); asm volatile("" ::: "memory");
}
__device__ __forceinline__ void ti_load4(const float* src, int src_ld, int lane, f32x4 (&rg)[8]) {
#pragma unroll
    for (int i = 0; i < 8; ++i) rg[i] = *(const f32x4*)(src + (size_t)(8 * i + (lane >> 3)) * src_ld + 4 * (lane & 7));
}
__device__ __forceinline__ void ti_store4_fp8(const f32x4 (&rg)[8], unsigned char* dst, int dst_ldb, LAS float* scr, int lane) {
#pragma unroll
    for (int i = 0; i < 8; ++i) *(LAS f32x4*)(scr + (8 * i + (lane >> 3)) * 36 + 4 * (lane & 7)) = rg[i];
    LDS_WAIT(); asm volatile("" ::: "memory");
    const int n = lane >> 1, hk = (lane & 1) * 32; const LAS float* s = scr + hk * 36 + n; unsigned w[8];
#pragma unroll
    for (int q = 0; q < 8; ++q) w[q] = pk4_fp8(s[(4 * q) * 36] * 32.f, s[(4 * q + 1) * 36] * 32.f, s[(4 * q + 2) * 36] * 32.f, s[(4 * q + 3) * 36] * 32.f);
    v4u* d = (v4u*)(dst + (size_t)n * dst_ldb + hk); d[0] = (v4u){w[0], w[1], w[2], w[3]}; d[1] = (v4u){w[4], w[5], w[6], w[7]};
    LDS_WAIT(); asm volatile("" ::: "memory");
}
struct ConvJob { const float* src; int src_ld; unsigned char* dst; int dst_ldb; int fp8; };
__device__ __forceinline__ ConvJob job_plain(const float* W, int K, int N, bf16* WT, int r) {
    const int nblk = N / 32, kb = r / nblk, nb = r % nblk;
    return ConvJob{W + (size_t)(kb * 64) * N + nb * 32, N, (unsigned char*)(WT + (size_t)(nb * 32) * K + kb * 64), K * 2, 0};
}
constexpr int IT_WIN = 16 * 160, IT_SQ = 16 * 32, IT_L1 = 16 * 24, IT_L2 = 160 * 6, IT_GU = 64 * 16 * 64, IT_DN = 64 * 16 * 32;
constexpr int IT_GU0 = IT_GU / 2, IT_DN0 = IT_DN / 2;
constexpr int IT_TOTAL = IT_WIN + IT_SQ + 3 * IT_SQ + IT_SQ + IT_L1 + IT_L2 + IT_GU0 + IT_DN0, IT_L1MOE = IT_GU0 + IT_DN0;
__device__ __forceinline__ ConvJob conv_job(PP p, int it) {
    unsigned char* ws = p->ws; int r = it;
    if (r < IT_WIN) { const int kb = r / 160, nb = r % 160;
        return ConvJob{p->in[I_HGWIN] + (size_t)(kb * 64) * 5120 + nb * 32, 5120, ws + WS_WIN + (size_t)(nb * 32) * D + kb * 64, D, 1}; } r -= IT_WIN;
    if (r < IT_SQ) return job_plain(p->in[I_HGWOUT], D, D, (bf16*)(ws + WS_WHGO), r); r -= IT_SQ;
    if (r < 3 * IT_SQ) { const int j = r / IT_SQ; return job_plain(p->in[I_WRKV] + (size_t)j * D * D, D, D, (bf16*)(ws + WS_WRKV) + (size_t)j * D * D, r % IT_SQ); } r -= 3 * IT_SQ;
    if (r < IT_SQ) return job_plain(p->in[I_RWOUT], D, D, (bf16*)(ws + WS_WRWO), r); r -= IT_SQ;
    if (r < IT_L1) {
        const int kb = r / 24, rg = r % 24, tile = rg >> 3, within = rg & 7; const float* src = nullptr; int ld = 64;
        if (within < 4) {
            if (tile == 0) src = p->in[I_DECW1] + (size_t)(within >> 1) * D * 64 + (size_t)(kb * 64) * 64 + (within & 1) * 32;
            else if (tile == 1) src = p->in[I_A1] + (size_t)(within >> 1) * D * 64 + (size_t)(kb * 64) * 64 + (within & 1) * 32;
            else { src = p->in[I_G1] + (size_t)(kb * 64) * 128 + within * 32; ld = 128; }
        }
        return ConvJob{src, ld, (unsigned char*)((bf16*)(ws + WS_WL1) + (size_t)(rg * 32) * D + kb * 64), D * 2, 0}; } r -= IT_L1;
    if (r < IT_L2) {
        const int rg = r / 6, kb = r % 6, n0 = rg * 32, blk = n0 >> 10, nn0 = n0 & 1023; const float* src = nullptr;
        if (blk < 2) { if (kb == blk) src = p->in[I_DECW2] + (size_t)blk * 64 * D + nn0; }
        else if (blk < 4) { if (kb == blk) src = p->in[I_A2] + (size_t)(blk - 2) * 64 * D + nn0; }
        else { if (kb >= 4) src = p->in[I_G2] + (size_t)(kb - 4) * 64 * D + nn0; }
        return ConvJob{src, D, (unsigned char*)((bf16*)(ws + WS_WL2) + (size_t)n0 * 384 + kb * 64), 384 * 2, 0}; } r -= IT_L2;
    if (r < IT_GU0) {
        const int mat = r >> 10, q = r & 1023, kb = q >> 6, nb = q & 63, n0 = nb * 32;
        const int j0 = n0 & 1023, drow = 256 * (j0 >> 7) + (n0 >= 1024 ? 128 : 0) + (j0 & 127);
        return ConvJob{p->in[I_WGU] + (size_t)mat * D * 2048 + (size_t)(kb * 64) * 2048 + n0, 2048, ws + WS_WGU + (size_t)mat * 2048 * D + (size_t)drow * D + kb * 64, D, 1}; } r -= IT_GU0;
    { const int mat = r >> 9, q = r & 511, kb = q >> 5, nb = q & 31;
      return ConvJob{p->in[I_WDN] + (size_t)mat * D * D + (size_t)(kb * 64) * D + nb * 32, D, ws + WS_WD + (size_t)mat * D * D + (size_t)(nb * 32) * D + kb * 64, D, 1}; }
}
__device__ __forceinline__ ConvJob conv_job_l1(PP p, int r) {
    unsigned char* ws = p->ws;
    if (r < IT_GU0) { const int mat = 32 + (r >> 10), q = r & 1023, kb = q >> 6, nb = q & 63, n0 = nb * 32;
        const int j0 = n0 & 1023, drow = 256 * (j0 >> 7) + (n0 >= 1024 ? 128 : 0) + (j0 & 127);
        return ConvJob{p->in[I_WGU] + (size_t)mat * D * 2048 + (size_t)(kb * 64) * 2048 + n0, 2048, ws + WS_WGU + (size_t)mat * 2048 * D + (size_t)drow * D + kb * 64, D, 1}; }
    r -= IT_GU0;
    { const int mat = 32 + (r >> 9), q = r & 511, kb = q >> 5, nb = q & 31;
      return ConvJob{p->in[I_WDN] + (size_t)mat * D * D + (size_t)(kb * 64) * D + nb * 32, D, ws + WS_WD + (size_t)mat * D * D + (size_t)(nb * 32) * D + kb * 64, D, 1}; }
}
__device__ __forceinline__ void phase_pre(PP p, LAS unsigned char* lds, int tid, int lane, int wave) {
    if (blockIdx.x < 192) {
        const int layer = blockIdx.x / 96, col = (blockIdx.x % 96) * 64 + lane;
        const float* W = p->in[I_ADAW] + (size_t)layer * D * 6144 + col;
        const float* c = p->in[I_C]; const float* cc = p->in[I_CCTX];
        float a0 = 0.f, a1 = 0.f, a2 = 0.f;
#pragma unroll 8
        for (int k = wave * 128; k < wave * 128 + 128; ++k) {
            const float wv = W[(size_t)k * 6144]; const float c0 = c[k], c1 = c[D + k], c2 = cc[k];
            a0 += c0 * sigm(c0) * wv; a1 += c1 * sigm(c1) * wv; a2 += c2 * sigm(c2) * wv;
        }
        LAS float* red = (LAS float*)lds;
        red[(wave * 3 + 0) * 64 + lane] = a0; red[(wave * 3 + 1) * 64 + lane] = a1; red[(wave * 3 + 2) * 64 + lane] = a2;
        __syncthreads();
        if (wave == 0) {
            float s0 = 0.f, s1 = 0.f, s2 = 0.f;
#pragma unroll
            for (int w = 0; w < 8; ++w) { s0 += red[(w * 3 + 0) * 64 + lane]; s1 += red[(w * 3 + 1) * 64 + lane]; s2 += red[(w * 3 + 2) * 64 + lane]; }
            const float bb = p->in[I_ADAB][layer * 6144 + col];
            float* M = (float*)(p->ws + WS_MOD) + (size_t)layer * 3 * 6144 + col;
            M[0] = s0 + bb; M[6144] = s1 + bb; M[2 * 6144] = s2 + bb;
        }
        __syncthreads();
    }
    LAS float* scr = (LAS float*)(lds + wave * 16384);
    const int gw = blockIdx.x * NWAVES + wave, NGW = gridDim.x * NWAVES;
    ConvJob nj{}; float nrg[32];
    if (gw < IT_TOTAL) { nj = conv_job(p, gw); ti_load(nj.src, nj.src_ld, lane, nrg); }
    for (int it = gw; it < IT_TOTAL; it += NGW) {
        const ConvJob cj = nj; float crg[32];
#pragma unroll
        for (int i = 0; i < 32; ++i) crg[i] = nrg[i];
        if (it + NGW < IT_TOTAL) { nj = conv_job(p, it + NGW); ti_load(nj.src, nj.src_ld, lane, nrg); }
        ti_store(cj.src != nullptr, cj.fp8, crg, cj.dst, cj.dst_ldb, scr, lane);
    }
}

__device__ __forceinline__ void load_row(const float* row, int lane, f32x4 (&v)[4]) {
#pragma unroll
    for (int j = 0; j < 4; ++j) v[j] = ((const f32x4*)row)[lane + 64 * j];
}
__device__ __forceinline__ float row_rstd(const f32x4 (&v)[4]) {
    float s = 0.f;
#pragma unroll
    for (int j = 0; j < 4; ++j) s += (v[j].x * v[j].x + v[j].y * v[j].y) + (v[j].z * v[j].z + v[j].w * v[j].w);
    return rsqrtf(wave_sum(s) * (1.0f / D) + NORM_EPS);
}
__device__ __forceinline__ void norm_mod(const f32x4 (&v)[4], float rstd, const float* g, const float* shift, const float* scale, int lane, f32x4 (&h)[4]) {
#pragma unroll
    for (int j = 0; j < 4; ++j) {
        const f32x4 gg = ((const f32x4*)g)[lane + 64 * j], sh = ((const f32x4*)shift)[lane + 64 * j], sc = ((const f32x4*)scale)[lane + 64 * j];
        h[j] = v[j] * rstd * gg * (sc + 1.0f) + sh;
    }
}
__device__ __forceinline__ void store_row_bf16(bf16* row, int lane, const f32x4 (&h)[4]) {
#pragma unroll
    for (int j = 0; j < 4; ++j) { v2u w; w.x = pk2(h[j].x, h[j].y); w.y = pk2(h[j].z, h[j].w); ((v2u*)row)[lane + 64 * j] = w; }
}
__device__ __forceinline__ const float* resid_row(PP p, int layer0_inputs, int row) {
    if (layer0_inputs) return row < NLAT ? p->in[I_X] + (size_t)row * D : p->in[I_CTX] + (size_t)(row - NLAT) * D;
    return (const float*)(p->ws + WS_XR) + (size_t)row * D;
}
__device__ __forceinline__ void phase_norm0(PP p, int lane, int wave) {
    const int gw = blockIdx.x * NWAVES + wave, NGW = gridDim.x * NWAVES;
    f32x4 vn[4];
    if (gw < NROW) load_row(resid_row(p, 1, gw), lane, vn);
    for (int row = gw; row < NROW; row += NGW) {
        f32x4 v[4], h[4];
#pragma unroll
        for (int j = 0; j < 4; ++j) v[j] = vn[j];
        if (row + NGW < NROW) load_row(resid_row(p, 1, row + NGW), lane, vn);
        const float rstd = row_rstd(v); const int vec = row_vec(row);
        norm_mod(v, rstd, p->in[I_NMIX], modp(p, 0, vec, 0), modp(p, 0, vec, 1), lane, h);
        { unsigned* hp = (unsigned*)(p->ws + WS_H + (size_t)row * D);
#pragma unroll
          for (int j = 0; j < 4; ++j) hp[lane + 64 * j] = pk4_fp8(h[j].x, h[j].y, h[j].z, h[j].w); }
    }
}
__device__ __forceinline__ void route_select(float (&part)[NE], const float* rb, int row, float* TOPG, int* SLOT, unsigned* cnt, unsigned* ntl, unsigned* tof, int* TILEE, int lane, bool write, int (&slot)[TOPK]) {
#pragma unroll
    for (int e = 0; e < NE; ++e) part[e] = part[e] + rb[e];
    unsigned taken = 0u; int idx[TOPK]; float val[TOPK];
#pragma unroll
    for (int k = 0; k < TOPK; ++k) {
        float best = -3.0e38f; int bi = 0;
#pragma unroll
        for (int e = 0; e < NE; ++e) { const bool ok = !((taken >> e) & 1u) && (part[e] > best); best = ok ? part[e] : best; bi = ok ? e : bi; }
        taken |= 1u << bi; idx[k] = bi; val[k] = best;
    }
    float ex[TOPK], se = 0.f;
#pragma unroll
    for (int k = 0; k < TOPK; ++k) { ex[k] = __expf(val[k] - val[0]); se += ex[k]; }
    int sl[TOPK] = {0, 0, 0, 0};
    if (lane == 0 && write) {
        unsigned pos[TOPK]; int til[TOPK];
#pragma unroll
        for (int k = 0; k < TOPK; ++k) pos[k] = atomicAdd(cnt + idx[k] * CNT_STRIDE, 1u);
#pragma unroll
        for (int k = 0; k < TOPK; ++k) { til[k] = -1;
            if ((pos[k] & 255u) == 0u) { const unsigned t = atomicAdd(ntl, 1u); til[k] = (int)t; TILEE[1 + t] = idx[k];
                __hip_atomic_store(tof + idx[k] * TOF_PER + (pos[k] >> 8), t + 1u, __ATOMIC_RELAXED, __HIP_MEMORY_SCOPE_AGENT); } }
        unsigned tq[TOPK];
#pragma unroll
        for (int k = 0; k < TOPK; ++k) tq[k] = (til[k] < 0) ? __hip_atomic_load(tof + idx[k] * TOF_PER + (pos[k] >> 8), __ATOMIC_RELAXED, __HIP_MEMORY_SCOPE_AGENT) : 1u;
#pragma unroll
        for (int k = 0; k < TOPK; ++k) {
            if (til[k] < 0) { unsigned t1 = tq[k], spins = 0u;
                while (t1 == 0u && ++spins < (1u << 22)) { __builtin_amdgcn_s_sleep(1); t1 = __hip_atomic_load(tof + idx[k] * TOF_PER + (pos[k] >> 8), __ATOMIC_RELAXED, __HIP_MEMORY_SCOPE_AGENT); }
                til[k] = (int)t1 - 1; if (til[k] < 0) til[k] = 0; }
            sl[k] = til[k] * 256 + (int)(pos[k] & 255u);
            SLOT[row * 4 + k] = sl[k]; TOPG[row * 4 + k] = ex[k] * __builtin_amdgcn_rcpf(se);
        }
    }
#pragma unroll
    for (int k = 0; k < TOPK; ++k) slot[k] = __builtin_amdgcn_readfirstlane(sl[k]);
}
__device__ __forceinline__ void phase_ffn_norm_route4(PP p, int layer, int nrows, LAS unsigned char* lds, int tid, int lane, int wave) {
    const int gw = blockIdx.x * NWAVES + wave, NGW = gridDim.x * NWAVES;
    const float* rw = p->in[I_ROUTW] + (size_t)layer * D * NE; const float* rb = p->in[I_ROUTB] + layer * NE;
    float* TOPG = (float*)(p->ws + WS_ROUTE + RT_TOPG); int* SLOT = (int*)(p->ws + WS_ROUTE + RT_SLOT); int* TILEE = (int*)(p->ws + WS_ROUTE + RT_TILEE) + layer * 512;
    unsigned* ctl = (unsigned*)(p->ws + WS_CTL); unsigned* cnt = ctl + CW_CNT + layer * NE * CNT_STRIDE; unsigned* ntl = ctl + CW_NT + layer; unsigned* tof = ctl + CW_TOF + layer * NE * TOF_PER;
    unsigned char* XB = p->ws + WS_U + U_XB;
    constexpr int MAXR = 72;
    LAS unsigned* FP8I = (LAS unsigned*)(lds + 69632);
    LAS int* ROWE = (LAS int*)(lds + 143360); LAS int* ROWP = ROWE + MAXR * 4; LAS float* ROWG = (LAS float*)(ROWP + MAXR * 4);
    LAS unsigned* HIST = (LAS unsigned*)(ROWG + MAXR * 4); LAS unsigned* BASE = HIST + 32;
    if (tid < 32) HIST[tid] = 0u;
    __syncthreads();
    int nloc = 0;
    LAS float* hs = (LAS float*)(lds + wave * 8704);
    for (int row0 = gw; row0 < nrows; row0 += 2 * NGW) {
        const bool has1 = row0 + NGW < nrows; const int row1 = has1 ? row0 + NGW : row0;
#pragma unroll
        for (int r = 0; r < 2; ++r) { const int row = r ? row1 : row0;
            f32x4 v[4], h[4]; load_row((const float*)(p->ws + WS_XR) + (size_t)row * D, lane, v); const float rstd = row_rstd(v); const int vec = row_vec(row);
            norm_mod(v, rstd, p->in[I_NFFN] + layer * D, modp(p, layer, vec, 3), modp(p, layer, vec, 4), lane, h);
#pragma unroll
            for (int j = 0; j < 4; ++j) *(LAS f32x4*)(hs + r * 1024 + j * 256 + lane * 4) = h[j]; }
        LDS_WAIT(); asm volatile("" ::: "memory");
        float mine;
        {
            const int e4 = lane & 7, kq = lane >> 3;
            f32x4 qa = (f32x4){0.f, 0.f, 0.f, 0.f}, qb = (f32x4){0.f, 0.f, 0.f, 0.f};
#pragma unroll 4
            for (int t = 0; t < 32; ++t) {
                const int u = kq + 8 * t, l = u & 63, j = u >> 6;
                const f32x4* wr = (const f32x4*)(rw + (size_t)(4 * u) * NE) + e4;
                const f32x4 xa = *(const LAS f32x4*)(hs + j * 256 + l * 4), xb = *(const LAS f32x4*)(hs + 1024 + j * 256 + l * 4);
#pragma unroll
                for (int i = 0; i < 4; ++i) { const f32x4 w4 = wr[i * (NE / 4)]; const float x0 = xa[i], x1 = xb[i];
                    qa = qa + x0 * w4; qb = qb + x1 * w4; }
            }
#pragma unroll
            for (int o = 8; o < 64; o <<= 1) {
#pragma unroll
                for (int c = 0; c < 4; ++c) { qa[c] += __shfl_xor(qa[c], o); qb[c] += __shfl_xor(qb[c], o); } }
            LAS float* lg = hs + 2048;
            if (kq == 0) { *(LAS f32x4*)(lg + 4 * e4) = qa; *(LAS f32x4*)(lg + 32 + 4 * e4) = qb; }
            LDS_WAIT(); asm volatile("" ::: "memory");
            mine = lg[lane] + rb[lane & 31];
        }
        int idx2[2][TOPK]; float val2[2][TOPK];
        { float cur = mine;
#pragma unroll
          for (int k = 0; k < TOPK; ++k) {
              float mx = cur;
#pragma unroll
              for (int o = 1; o < 32; o <<= 1) mx = fmaxf(mx, __shfl_xor(mx, o));
              const unsigned long long bal = __ballot(cur == mx);
              const int ia = __ffs((unsigned)(bal & 0xffffffffull)) - 1, ib = __ffs((unsigned)(bal >> 32)) - 1;
              idx2[0][k] = ia; idx2[1][k] = ib;
              val2[0][k] = __builtin_bit_cast(float, __builtin_amdgcn_readlane(__builtin_bit_cast(int, mx), 0)); val2[1][k] = __builtin_bit_cast(float, __builtin_amdgcn_readlane(__builtin_bit_cast(int, mx), 32));
              cur = (lane == ia || lane == 32 + ib) ? -3.0e38f : cur; } }
#pragma unroll
        for (int r = 0; r < 2; ++r) { if (r == 1 && !has1) break;
            int idx[TOPK]; float val[TOPK];
#pragma unroll
            for (int k = 0; k < TOPK; ++k) { idx[k] = idx2[r][k]; val[k] = val2[r][k]; }
            float ex[TOPK], se = 0.f;
#pragma unroll
            for (int k = 0; k < TOPK; ++k) { ex[k] = __expf(val[k] - val[0]); se += ex[k]; }
            const int rs = wave * 9 + nloc + r;
            if (lane == 0) {
#pragma unroll
                for (int k = 0; k < TOPK; ++k) { ROWE[rs * 4 + k] = idx[k]; ROWP[rs * 4 + k] = (int)__hip_atomic_fetch_add(HIST + idx[k], 1u, __ATOMIC_RELAXED, __HIP_MEMORY_SCOPE_WORKGROUP); ROWG[rs * 4 + k] = ex[k] * __builtin_amdgcn_rcpf(se); } }
#pragma unroll
            for (int j = 0; j < 4; ++j) { const f32x4 hv = *(const LAS f32x4*)(hs + r * 1024 + j * 256 + lane * 4); FP8I[rs * 256 + lane + 64 * j] = pk4_fp8(hv[0], hv[1], hv[2], hv[3]); }
        }
        nloc += has1 ? 2 : 1;
        LDS_WAIT(); asm volatile("" ::: "memory");
    }
    __syncthreads();
    if (tid < 32) { const unsigned n = HIST[tid]; unsigned base = 0u;
        if (n) { base = atomicAdd(cnt + tid * CNT_STRIDE, n);
            for (unsigned pb2 = (base + 255u) & ~255u; pb2 < base + n; pb2 += 256u) { const unsigned t = atomicAdd(ntl, 1u); TILEE[1 + t] = tid;
                __hip_atomic_store(tof + tid * TOF_PER + (pb2 >> 8), t + 1u, __ATOMIC_RELAXED, __HIP_MEMORY_SCOPE_AGENT); } }
        BASE[tid] = base; }
    __syncthreads();
    int slv = 0;
    if (lane < 4 * nloc) { const int rs = wave * 9 + (lane >> 2), k = lane & 3, li = lane >> 2;
        const int row = gw + li * NGW;
        const int e = ROWE[rs * 4 + k]; const unsigned pos = BASE[e] + (unsigned)ROWP[rs * 4 + k]; unsigned t1 = 0u, spins = 0u;
        while ((t1 = __hip_atomic_load(tof + e * TOF_PER + (pos >> 8), __ATOMIC_RELAXED, __HIP_MEMORY_SCOPE_AGENT)) == 0u && ++spins < (1u << 22)) __builtin_amdgcn_s_sleep(1);
        int til = (int)t1 - 1; if (til < 0) til = 0;
        slv = til * 256 + (int)(pos & 255u); SLOT[row * 4 + k] = slv; TOPG[row * 4 + k] = ROWG[rs * 4 + k]; }
    for (int li = 0; li < nloc; ++li) { const int rs = wave * 9 + li; unsigned w[4];
#pragma unroll
        for (int j = 0; j < 4; ++j) w[j] = FP8I[rs * 256 + lane + 64 * j];
#pragma unroll
        for (int k = 0; k < TOPK; ++k) { unsigned* d = (unsigned*)(XB + (size_t)__builtin_amdgcn_readlane(slv, 4 * li + k) * D);
#pragma unroll
            for (int j = 0; j < 4; ++j) d[lane + 64 * j] = w[j]; } }
}
__device__ __forceinline__ void phase_ffn_norm_route(PP p, int layer, int nrows, LAS unsigned char* lds, int lane, int wave) {
    const int gw = blockIdx.x * NWAVES + wave, NGW = gridDim.x * NWAVES;
    const float* rw = p->in[I_ROUTW] + (size_t)layer * D * NE; const float* rb = p->in[I_ROUTB] + layer * NE;
    float* TOPG = (float*)(p->ws + WS_ROUTE + RT_TOPG); int* SLOT = (int*)(p->ws + WS_ROUTE + RT_SLOT); int* TILEE = (int*)(p->ws + WS_ROUTE + RT_TILEE) + layer * 512;
    unsigned* ctl = (unsigned*)(p->ws + WS_CTL); unsigned* cnt = ctl + CW_CNT + layer * NE * CNT_STRIDE; unsigned* ntl = ctl + CW_NT + layer; unsigned* tof = ctl + CW_TOF + layer * NE * TOF_PER;
    unsigned char* XB = p->ws + WS_U + U_XB;
    LAS float* hs = (LAS float*)(lds + wave * 8704);
    for (int row0 = gw; row0 < nrows; row0 += 2 * NGW) {
        const bool has1 = row0 + NGW < nrows; const int row1 = has1 ? row0 + NGW : row0;
#pragma unroll
        for (int r = 0; r < 2; ++r) { const int row = r ? row1 : row0;
            f32x4 v[4], h[4]; load_row((const float*)(p->ws + WS_XR) + (size_t)row * D, lane, v); const float rstd = row_rstd(v); const int vec = row_vec(row);
            norm_mod(v, rstd, p->in[I_NFFN] + layer * D, modp(p, layer, vec, 3), modp(p, layer, vec, 4), lane, h);
#pragma unroll
            for (int j = 0; j < 4; ++j)
#pragma unroll
                for (int i = 0; i < 4; ++i) hs[r * 1024 + (4 * j + i) * 64 + lane] = h[j][i]; }
        LDS_WAIT(); asm volatile("" ::: "memory");
        float pa[NE], pb[NE];
        {
            const int e4 = lane & 7, kq = lane >> 3;
            f32x4 qa = (f32x4){0.f, 0.f, 0.f, 0.f}, qb = (f32x4){0.f, 0.f, 0.f, 0.f};
#pragma unroll 4
            for (int t = 0; t < 32; ++t) {
                const int u = kq + 8 * t, l = u & 63, j = u >> 6;
                const f32x4* wr = (const f32x4*)(rw + (size_t)(4 * u) * NE) + e4;
#pragma unroll
                for (int i = 0; i < 4; ++i) { const f32x4 w4 = wr[i * (NE / 4)]; const float x0 = hs[(4 * j + i) * 64 + l], x1 = hs[1024 + (4 * j + i) * 64 + l];
                    qa = qa + x0 * w4; qb = qb + x1 * w4; }
            }
#pragma unroll
            for (int o = 8; o < 64; o <<= 1) {
#pragma unroll
                for (int c = 0; c < 4; ++c) { qa[c] += __shfl_xor(qa[c], o); qb[c] += __shfl_xor(qb[c], o); } }
            LAS float* lg = hs + 2048;
            if (kq == 0) { *(LAS f32x4*)(lg + 4 * e4) = qa; *(LAS f32x4*)(lg + 32 + 4 * e4) = qb; }
            LDS_WAIT(); asm volatile("" ::: "memory");
#pragma unroll
            for (int q4 = 0; q4 < 8; ++q4) { const f32x4 va = *(const LAS f32x4*)(lg + 4 * q4), vb = *(const LAS f32x4*)(lg + 32 + 4 * q4);
#pragma unroll
                for (int c = 0; c < 4; ++c) { pa[4 * q4 + c] = va[c]; pb[4 * q4 + c] = vb[c]; } }
        }
        int s0[TOPK], s1[TOPK];
        route_select(pa, rb, row0, TOPG, SLOT, cnt, ntl, tof, TILEE, lane, true, s0);
        route_select(pb, rb, row1, TOPG, SLOT, cnt, ntl, tof, TILEE, lane, has1, s1);
#pragma unroll
        for (int r = 0; r < 2; ++r) { if (r == 1 && !has1) break;
            unsigned w[4];
#pragma unroll
            for (int j = 0; j < 4; ++j) { const LAS float* hp = hs + r * 1024 + (4 * j) * 64 + lane; w[j] = pk4_fp8(hp[0], hp[64], hp[128], hp[192]); }
#pragma unroll
            for (int k = 0; k < TOPK; ++k) { unsigned* d = (unsigned*)(XB + (size_t)(r ? s1[k] : s0[k]) * D);
#pragma unroll
                for (int j = 0; j < 4; ++j) d[lane + 64 * j] = w[j]; } }
        LDS_WAIT(); asm volatile("" ::: "memory");
    }
}
__device__ __forceinline__ void phase_combine(PP p, int layer, int nrows, bool final_out, int lane, int wave) {
    const int gw = blockIdx.x * NWAVES + wave, NGW = gridDim.x * NWAVES;
    const float* TOPG = (const float*)(p->ws + WS_ROUTE + RT_TOPG); const int* SLOT = (const int*)(p->ws + WS_ROUTE + RT_SLOT);
    const bf16* YS = (const bf16*)(p->ws + WS_U + U_YS); float* XR = (float*)(p->ws + WS_XR); float* RSTD = (float*)(p->ws + WS_ROUTE + RT_RSTD);
    f32x4 vn[4]; f32x4 gn4 = (f32x4){0.f, 0.f, 0.f, 0.f}; int sn[4] = {0, 0, 0, 0};
    if (gw < nrows) { load_row(XR + (size_t)gw * D, lane, vn); gn4 = *(const f32x4*)(TOPG + gw * 4);
#pragma unroll
        for (int k = 0; k < TOPK; ++k) sn[k] = SLOT[gw * 4 + k]; }
    for (int row = gw; row < nrows; row += NGW) {
        f32x4 v[4], acc[4]; const f32x4 g4 = gn4; int sc[4];
#pragma unroll
        for (int j = 0; j < 4; ++j) { v[j] = vn[j]; sc[j] = sn[j]; }
        if (row + NGW < nrows) { const int rn = row + NGW; load_row(XR + (size_t)rn * D, lane, vn); gn4 = *(const f32x4*)(TOPG + rn * 4);
#pragma unroll
            for (int k = 0; k < TOPK; ++k) sn[k] = SLOT[rn * 4 + k]; }
#pragma unroll
        for (int j = 0; j < 4; ++j) acc[j] = (f32x4){0.f, 0.f, 0.f, 0.f};
#pragma unroll
        for (int k = 0; k < TOPK; ++k) {
            const float gk = g4[k]; const v2u* ys = (const v2u*)(YS + (size_t)sc[k] * D);
#pragma unroll
            for (int j = 0; j < 4; ++j) { const v2u w = ys[lane + 64 * j];
                acc[j].x += gk * bf2f(w.x & 0xffffu); acc[j].y += gk * bf2f(w.x >> 16); acc[j].z += gk * bf2f(w.y & 0xffffu); acc[j].w += gk * bf2f(w.y >> 16); }
        }
        const float* m5 = modp(p, layer, row_vec(row), 5);
#pragma unroll
        for (int j = 0; j < 4; ++j) v[j] = v[j] + ((const f32x4*)m5)[lane + 64 * j] * acc[j];
        const float rstd = row_rstd(v);
        if (final_out) {
#pragma unroll
            for (int j = 0; j < 4; ++j) ((f32x4*)(p->out + (size_t)row * D))[lane + 64 * j] = v[j] * rstd * ((const f32x4*)p->in[I_FINALG])[lane + 64 * j];
        } else {
#pragma unroll
            for (int j = 0; j < 4; ++j) ((f32x4*)(XR + (size_t)row * D))[lane + 64 * j] = v[j];
            if (lane == 0) RSTD[row] = rstd;
        }
    }
}

__device__ __forceinline__ int step_row(int b, int dir, int step) {
    if (step < CTXL) { const int t = dir ? (CTXL - 1 - step) : step; return NLAT + b * CTXL + t; }
    const int s = step - CTXL; const int t = dir ? (SEQ - 1 - s) : s; return b * SEQ + t;
}
constexpr int NSTEP = CTXL + SEQ;

__device__ __forceinline__ void phase_hg_readout(PP p, int lane, int wave) {
    const int gw = blockIdx.x * NWAVES + wave, NGW = gridDim.x * NWAVES;
    const bf16* Z = (const bf16*)(p->ws + WS_U + U_Z); const float* OD = (const float*)(p->ws + WS_U + U_OD0); bf16* A2 = (bf16*)(p->ws + WS_A2);
    const float* gn = p->in[I_HGGN];
    for (int row = gw; row < NROW; row += NGW) {
#pragma unroll
        for (int h = 0; h < 8; ++h) {
            const int c = h * 128 + 2 * lane;
            const float2 a = *(const float2*)(OD + (size_t)row * D + c), bq = *(const float2*)(OD + (size_t)(NROW + row) * D + c);
            const float o0 = a.x + bq.x, o1 = a.y + bq.y;
            const float rstd = rsqrtf(wave_sum(o0 * o0 + o1 * o1) * (1.0f / 128.0f) + NORM_EPS);
            const unsigned gz = *(const unsigned*)(Z + (size_t)row * 5120 + 4096 + c); const float g0 = bf2f(gz & 0xffffu), g1 = bf2f(gz >> 16);
            const float r0 = o0 * rstd * gn[2 * lane] * (g0 * sigm(g0)), r1 = o1 * rstd * gn[2 * lane + 1] * (g1 * sigm(g1));
            *(unsigned*)(A2 + (size_t)row * D + c) = pk2(r0, r1);
        }
    }
}

__device__ __forceinline__ void phase_lerp(PP p, LAS unsigned char* lds, int tid, int lane, int wave) {
    const int gw = blockIdx.x * NWAVES + wave, NGW = gridDim.x * NWAVES;
    const float* XR = (const float*)(p->ws + WS_XR); const float* RSTD = (const float*)(p->ws + WS_ROUTE + RT_RSTD);
    bf16* XL6 = (bf16*)(p->ws + WS_U + U_XL6); const float* g = p->in[I_NMIX] + D; const float* mu = p->in[I_MU];
    LAS float* TGS = (LAS float*)lds;
    LAS float* TS0 = TGS + 3 * D;
    LAS float* TMU = TS0 + 3 * D;
#pragma unroll
    for (int u = tid; u < 3 * D; u += NTHREADS) { const int vec = u >> 10, c = u & (D - 1); TGS[u] = g[c] * (modp(p, 1, vec, 1)[c] + 1.0f); TS0[u] = modp(p, 1, vec, 0)[c]; }
#pragma unroll
    for (int u = tid; u < 6 * D; u += NTHREADS) { const int s = u >> 10, c = u & (D - 1); const int m = (s == 0) ? 0 : (s == 1) ? 2 : (s == 2) ? 3 : (s == 3) ? 1 : (s == 4) ? 4 : 5; TMU[u] = mu[m * D + c]; }
    __syncthreads();
    auto nbrs = [&](int row, int (&nb)[4]) {
        if (row < NLAT) { const int t = row & (SEQ - 1), w = t & 63, r = t >> 6;
            nb[0] = (w >= 1) ? row - 1 : -1; nb[1] = (w < 63) ? row + 1 : -1; nb[2] = (r >= 1) ? row - 64 : -1; nb[3] = (r < SEQ / 64 - 1) ? row + 64 : -1;
        } else { const int t = (row - NLAT) & (CTXL - 1);
            nb[0] = nb[1] = (t >= 1) ? row - 1 : -1; nb[2] = nb[3] = (t < CTXL - 1) ? row + 1 : -1; } };
    f32x4 nxs[4], nxn[4]; float nrs = 0.f, nrn[4] = {0.f, 0.f, 0.f, 0.f};
    auto fetch = [&](int row) { int nb[4]; nbrs(row, nb); nrs = RSTD[row];
#pragma unroll
        for (int j = 0; j < 4; ++j) { const int ci = lane + 64 * j; nxs[j] = ((const f32x4*)(XR + (size_t)row * D))[ci];
            const int nr = nb[j] >= 0 ? nb[j] : row; nxn[j] = ((const f32x4*)(XR + (size_t)nr * D))[ci]; nrn[j] = nb[j] >= 0 ? RSTD[nr] : 0.f; } };
    if (gw < NROW) fetch(gw);
    for (int row = gw; row < NROW; row += NGW) {
        const int vec = row_vec(row); int nb[4]; nbrs(row, nb);
        f32x4 xs[4], xn[4]; float rn[4]; const float rs = nrs;
#pragma unroll
        for (int j = 0; j < 4; ++j) { xs[j] = nxs[j]; xn[j] = nxn[j]; rn[j] = nrn[j]; }
        if (row + NGW < NROW) fetch(row + NGW);
#pragma unroll
        for (int j = 0; j < 4; ++j) {
            const int ci = lane + 64 * j;
            const f32x4 gs = ((const LAS f32x4*)(TGS + vec * D))[ci], s0 = ((const LAS f32x4*)(TS0 + vec * D))[ci];
            const f32x4 hs = xs[j] * rs * gs + s0;
            f32x4 hn = (f32x4){0.f, 0.f, 0.f, 0.f};
            if (nb[j] >= 0) hn = xn[j] * rn[j] * gs + s0;
            const f32x4 dx = hn - hs;
#pragma unroll
            for (int s = 0; s < 6; ++s) {
                const f32x4 o = hs + dx * ((const LAS f32x4*)(TMU + s * D))[ci];
                v2u w; w.x = pk2(o.x, o.y); w.y = pk2(o.z, o.w);
                ((v2u*)(XL6 + ((size_t)s * NROW + row) * D))[ci] = w;
            }
        }
    }
    __syncthreads();
}
__device__ __forceinline__ float row16_allsum(float x) {
    x += __builtin_bit_cast(float, __builtin_amdgcn_update_dpp(0, __builtin_bit_cast(int, x), 0x128, 0xf, 0xf, false));
    x += __builtin_bit_cast(float, __builtin_amdgcn_update_dpp(0, __builtin_bit_cast(int, x), 0x124, 0xf, 0xf, false));
    x += __builtin_bit_cast(float, __builtin_amdgcn_update_dpp(0, __builtin_bit_cast(int, x), 0x122, 0xf, 0xf, false));
    x += __builtin_bit_cast(float, __builtin_amdgcn_update_dpp(0, __builtin_bit_cast(int, x), 0x121, 0xf, 0xf, false));
    return x;
}
__device__ __forceinline__ f32x4 bf4(v2u w) { return (f32x4){bf2f(w.x & 0xffffu), bf2f(w.x >> 16), bf2f(w.y & 0xffffu), bf2f(w.y >> 16)}; }
__device__ __forceinline__ void phase_rw_readout(PP p, int lane, int wave) {
    const int gw = blockIdx.x * NWAVES + wave, NGW = gridDim.x * NWAVES;
    const bf16* RKV = (const bf16*)(p->ws + WS_U + U_RKV); const bf16* AD = (const bf16*)(p->ws + WS_U + U_AD); const bf16* G = (const bf16*)(p->ws + WS_U + U_G);
    const unsigned* OD = (const unsigned*)(p->ws + WS_U + U_OD1); bf16* A2 = (bf16*)(p->ws + WS_A2);
    const int hq = lane >> 4, c4 = lane & 15, slab = c4 >> 2, v0 = (4 * c4) & 15;
    f32x4 lw[4], lb[4], ka[4], rk[4];
#pragma unroll
    for (int hg = 0; hg < 4; ++hg) { const int ch = (4 * hg + hq) * 64 + 4 * c4;
        lw[hg] = *(const f32x4*)(p->in[I_LNXW] + ch); lb[hg] = *(const f32x4*)(p->in[I_LNXB] + ch); ka[hg] = *(const f32x4*)(p->in[I_KA] + ch); rk[hg] = *(const f32x4*)(p->in[I_RK] + ch); }
    for (int row = gw; row < NLAT; row += NGW) {
        const int bq = row >> 13, tq = row & (SEQ - 1);
        f32x4 y0[4], y1[4]; v2u lr[4], lk[4], lv[4], la0[4], la1[4], lg[4];
#pragma unroll
        for (int hg = 0; hg < 4; ++hg) {
            const int h = 4 * hg + hq, ch = h * 64 + 4 * c4;
            const int u0 = (bq * 32 + h) * 4 + slab, u1 = (bq * 32 + 16 + h) * 4 + slab;
            { const int sa = CTXL + tq, sb = CTXL + (SEQ - 1 - tq);
              const v4u wa = *(const v4u*)(OD + (size_t)u0 * NSTEP * 8 + (sa >> 4) * 128 + ((sa & 3) >> 1) * 64 + ((sa >> 2) & 3) * 16 + v0);
              const v4u wb = *(const v4u*)(OD + (size_t)u1 * NSTEP * 8 + (sb >> 4) * 128 + ((sb & 3) >> 1) * 64 + ((sb >> 2) & 3) * 16 + v0);
              const int sha = (sa & 1) * 16, shb = (sb & 1) * 16;
#pragma unroll
              for (int c = 0; c < 4; ++c) { y0[hg][c] = (float)__builtin_bit_cast(_Float16, (unsigned short)(wa[c] >> sha)); y1[hg][c] = (float)__builtin_bit_cast(_Float16, (unsigned short)(wb[c] >> shb)); } }
            lr[hg] = *(const v2u*)(RKV + (size_t)row * 3072 + ch); lk[hg] = *(const v2u*)(RKV + (size_t)row * 3072 + 1024 + ch); lv[hg] = *(const v2u*)(RKV + (size_t)row * 3072 + 2048 + ch);
            la0[hg] = *(const v2u*)(AD + (size_t)row * D + ch); la1[hg] = *(const v2u*)(AD + ((size_t)NROW + row) * D + ch); lg[hg] = *(const v2u*)(G + (size_t)row * D + ch);
        }
#pragma unroll
        for (int hg = 0; hg < 4; ++hg) {
            const int h = 4 * hg + hq, ch = h * 64 + 4 * c4;
            const f32x4 y = y0[hg] + y1[hg];
            const f32x4 r = bf4(lr[hg]), k = bf4(lk[hg]), v = bf4(lv[hg]);
            const f32x4 a0 = bf4(la0[hg]), a1 = bf4(la1[hg]), g = bf4(lg[hg]);
            const float mean = row16_allsum((y[0] + y[1]) + (y[2] + y[3])) * (1.0f / 64.0f);
            const f32x4 d = y - mean;
            const float var = row16_allsum((d[0] * d[0] + d[1] * d[1]) + (d[2] * d[2] + d[3] * d[3])) * (1.0f / 64.0f);
            f32x4 yn = d * rsqrtf(var + 64.0e-5f) * lw[hg] + lb[hg];
            const f32x4 kd0 = k * ((a0 - 1.0f) * ka[hg] + 1.0f), kd1 = k * ((a1 - 1.0f) * ka[hg] + 1.0f);
            const f32x4 t0 = r * kd0 * rk[hg], t1 = r * kd1 * rk[hg];
            const float s0 = row16_allsum((t0[0] + t0[1]) + (t0[2] + t0[3])), s1 = row16_allsum((t1[0] + t1[1]) + (t1[2] + t1[3]));
            yn = yn + v * (s0 + s1);
            const f32x4 o = yn * g;
            v2u w; w.x = pk2(o[0], o[1]); w.y = pk2(o[2], o[3]);
            *(v2u*)(A2 + (size_t)row * D + ch) = w;
        }
    }
}

namespace pg8 {
struct SelOrder : StaticOrder {
    int div, sel0; size_t stride;
    __device__ __forceinline__ const char* abase(const Gemm& g, const Unit& u, size_t tstep) const { return (const char*)g.A + (size_t)(sel0 + u.pn / div) * stride + (size_t)u.pm * tstep; }
};
struct RkvL1Order {
    StaticOrder s1, s2; int G, c; const bf16_t* B2; size_t stride;
    __device__ __forceinline__ void init(int M, int G_, int c_, const bf16_t* b2, size_t st) { s1.init(M, 3072, G_, 0); s2.init(M, 768, G_, 0); G = G_; c = c_; B2 = b2; stride = st; }
    __device__ __forceinline__ bool next(int i, Unit& u) const { const long L = (long)i * G + c; if (L < s1.nwg) return s1.at(L, u); if (!s2.at(L - s1.nwg, u)) return false; u.e = 1; return true; }
    __device__ __forceinline__ const char* abase(const Gemm& g, const Unit& u, size_t tstep) const { return (const char*)g.A + (size_t)(u.e ? 3 + u.pn : u.pn / 4) * stride + (size_t)u.pm * tstep; }
    __device__ __forceinline__ const char* bbase(const Gemm& g, const Unit& u, size_t tstep) const { return (const char*)(u.e ? B2 : g.Bt) + (size_t)u.pn * tstep; }
    __device__ __forceinline__ void a_ready(const Unit&) const {}
    __device__ __forceinline__ void done(const Unit&) const {}
};
struct MoeOrder {
    const int* tilee; const PG8_LAS int* ord; int nt, ntn, G, c; size_t estride;
    __device__ __forceinline__ void init(const int* te, int nt_, PG8_LAS int* ordbuf, int ntn_, size_t es, int G_, int c_) {
        tilee = te; nt = nt_; ntn = ntn_; estride = es; G = G_; c = c_; ord = ordbuf;
        { const int t = threadIdx.x; PG8_LAS int* E = ordbuf + 512;
          int et = 0; if (t < nt) { et = te[1 + t]; E[t] = et; }
          asm volatile("s_waitcnt vmcnt(0) lgkmcnt(0)" ::: "memory"); __builtin_amdgcn_s_barrier(); asm volatile("" ::: "memory");
          if (t < nt) { int rank = 0;
#pragma unroll 8
              for (int u = 0; u < nt; ++u) { const int eu = E[u]; rank += (eu < et || (eu == et && u < t)) ? 1 : 0; }
              ordbuf[rank] = t; } }
        asm volatile("s_waitcnt lgkmcnt(0)" ::: "memory"); __builtin_amdgcn_s_barrier(); asm volatile("" ::: "memory");
    }
    __device__ __forceinline__ bool next(int i, Unit& u) const { const long L = (long)i * G + c; if (L >= (long)nt * ntn) return false; u.pm = ord[(int)(L / ntn)]; u.pn = (int)(L % ntn); u.e = tilee[1 + u.pm]; return true; }
    __device__ __forceinline__ const char* abase(const Gemm& g, const Unit& u, size_t tstep) const { return (const char*)g.A + (size_t)u.pm * tstep; }
    __device__ __forceinline__ const char* bbase(const Gemm& g, const Unit& u, size_t tstep) const { return (const char*)g.Bt + (size_t)u.e * estride + (size_t)u.pn * tstep; }
    __device__ __forceinline__ void a_ready(const Unit&) const {}
    __device__ __forceinline__ void done(const Unit&) const {}
};
struct EpiStoreBf16 {
    struct Pre {};
    static constexpr bool PERM = true, AFTER_DRAIN = false;
    bf16_t* O; int ldc;
    __device__ __forceinline__ void operator()(const f32x4 (&acc)[2][2][4][2], const Unit& u, int wr, int wc, int fr, int fq) const {
        const int row0 = u.pm * BM + wr * 64 + fr, col0 = u.pn * BM + wc * 32 + 8 * fq;
#pragma unroll
        for (int ai = 0; ai < 2; ++ai)
#pragma unroll
            for (int m = 0; m < 4; ++m) { bf16_t* rowp = O + (size_t)(row0 + ai * HALF + m * 16) * ldc + col0;
#pragma unroll
                for (int bj = 0; bj < 2; ++bj) { const f32x4 v0 = acc[ai][bj][m][0], v1 = acc[ai][bj][m][1];
                    u32x4 w; w.x = cvt_pk_bf16(v0[0], v0[1]); w.y = cvt_pk_bf16(v0[2], v0[3]); w.z = cvt_pk_bf16(v1[0], v1[1]); w.w = cvt_pk_bf16(v1[2], v1[3]);
                    *(u32x4*)(rowp + bj * HALF) = w; } }
    }
};
struct EpiStoreF32 {
    struct Pre {};
    static constexpr bool PERM = false, AFTER_DRAIN = false;
    float* C; int ldc;
    __device__ __forceinline__ void operator()(const f32x4 (&acc)[2][2][4][2], const Unit& u, int wr, int wc, int fr, int fq) const {
        const int row0 = u.pm * BM + wr * 64 + fr, col0 = u.pn * BM + wc * 32 + 4 * fq;
#pragma unroll
        for (int ai = 0; ai < 2; ++ai)
#pragma unroll
            for (int m = 0; m < 4; ++m) { float* rowp = C + (size_t)(row0 + ai * HALF + m * 16) * ldc + col0;
#pragma unroll
                for (int bj = 0; bj < 2; ++bj)
#pragma unroll
                    for (int n = 0; n < 2; ++n) *(f32x4*)(rowp + bj * HALF + n * 16) = acc[ai][bj][m][n]; }
    }
};
struct EpiResid {
    struct Pre {};
    static constexpr bool PERM = false, AFTER_DRAIN = false;
    const float* base_lat; const float* base_ctx; float* out; const float* gate; int gstride;
    __device__ __forceinline__ void operator()(const f32x4 (&acc)[2][2][4][2], const Unit& u, int wr, int wc, int fr, int fq) const {
        const int row0 = u.pm * BM + wr * 64 + fr, col0 = u.pn * BM + wc * 32 + 4 * fq;
#pragma unroll
        for (int ai = 0; ai < 2; ++ai)
#pragma unroll
            for (int m = 0; m < 4; ++m) { const int row = row0 + ai * HALF + m * 16;
                const float* bp = (row < 16384) ? base_lat + (size_t)row * 1024 : base_ctx + (size_t)(row - 16384) * 1024;
                const float* gp = gate + (size_t)(row < 16384 ? (row >= 8192 ? 1 : 0) : 2) * gstride;
                float* op = out + (size_t)row * 1024;
#pragma unroll
                for (int bj = 0; bj < 2; ++bj)
#pragma unroll
                    for (int n = 0; n < 2; ++n) { const int c = col0 + bj * HALF + n * 16;
                        *(f32x4*)(op + c) = *(const f32x4*)(bp + c) + *(const f32x4*)(gp + c) * acc[ai][bj][m][n]; } }
    }
};
__device__ __forceinline__ float sigm_(float x) { return __builtin_amdgcn_rcpf(1.0f + __expf(-x)); }
struct EpiSwiglu {
    static constexpr bool PERM = true, AFTER_DRAIN = false;
    PP p; int layer;
    struct Pre { f32x4 bgv[2], buv[2]; };
    __device__ __forceinline__ void prefetch(const Unit& u, int wr, int wc, int fr, int fq, Pre& pre) const {
        PP q_ = p; asm volatile("" : "+s"(q_));
        const float* bg = q_->in[I_BGU] + (size_t)layer * NE * 2048 + (size_t)u.e * 2048 + u.pn * HALF + wc * 32 + 8 * fq;
#pragma unroll
        for (int n = 0; n < 2; ++n) { pre.bgv[n] = *(const f32x4*)(bg + 4 * n); pre.buv[n] = *(const f32x4*)(bg + 1024 + 4 * n); }
    }
    __device__ __forceinline__ void operator()(const f32x4 (&acc)[2][2][4][2], const Unit& u, int wr, int wc, int fr, int fq, const Pre& pre) const {
        PP q_ = p; asm volatile("" : "+s"(q_));
        unsigned char* O = q_->ws + WS_U + U_ACT;
        const int row0 = u.pm * BM + wr * 64 + fr, col0 = u.pn * HALF + wc * 32 + 8 * fq;
        f32x4 bgv[2], buv[2];
#pragma unroll
        for (int n = 0; n < 2; ++n) { bgv[n] = pre.bgv[n]; buv[n] = pre.buv[n]; }
#pragma unroll
        for (int ai = 0; ai < 2; ++ai)
#pragma unroll
            for (int m = 0; m < 4; ++m) { float r[8];
#pragma unroll
                for (int n = 0; n < 2; ++n) { const f32x4 g4 = acc[ai][0][m][n] + bgv[n], u4 = acc[ai][1][m][n] + buv[n];
#pragma unroll
                    for (int j = 0; j < 4; ++j) { const float g = fminf(g4[j], 7.0f), uu = fminf(fmaxf(u4[j], -7.0f), 7.0f); r[4 * n + j] = g * sigm_(1.702f * g) * (uu + 1.0f); } }
                unsigned w0 = 0u, w1 = 0u;
                w0 = __builtin_amdgcn_cvt_pk_fp8_f32(r[0], r[1], w0, false); w0 = __builtin_amdgcn_cvt_pk_fp8_f32(r[2], r[3], w0, true);
                w1 = __builtin_amdgcn_cvt_pk_fp8_f32(r[4], r[5], w1, false); w1 = __builtin_amdgcn_cvt_pk_fp8_f32(r[6], r[7], w1, true);
                *(unsigned long long*)(O + (size_t)(row0 + ai * HALF + m * 16) * 1024 + col0) = (unsigned long long)w0 | ((unsigned long long)w1 << 32); }
    }
};
struct EpiDown {
    static constexpr bool PERM = true, AFTER_DRAIN = false;
    PP p; int layer;
    struct Pre { f32x4 bv[2][2]; };
    __device__ __forceinline__ void prefetch(const Unit& u, int wr, int wc, int fr, int fq, Pre& pre) const {
        PP q_ = p; asm volatile("" : "+s"(q_));
        const float* bp = q_->in[I_BDN] + (size_t)layer * NE * 1024 + (size_t)u.e * 1024 + u.pn * BM + wc * 32 + 8 * fq;
#pragma unroll
        for (int bj = 0; bj < 2; ++bj)
#pragma unroll
            for (int n = 0; n < 2; ++n) pre.bv[bj][n] = *(const f32x4*)(bp + bj * HALF + 4 * n);
    }
    __device__ __forceinline__ void operator()(const f32x4 (&acc)[2][2][4][2], const Unit& u, int wr, int wc, int fr, int fq, const Pre& pre) const {
        PP q_ = p; asm volatile("" : "+s"(q_));
        bf16_t* O = (bf16_t*)(q_->ws + WS_U + U_YS);
        const int row0 = u.pm * BM + wr * 64 + fr, col0 = u.pn * BM + wc * 32 + 8 * fq;
        f32x4 bv[2][2];
#pragma unroll
        for (int bj = 0; bj < 2; ++bj)
#pragma unroll
            for (int n = 0; n < 2; ++n) bv[bj][n] = pre.bv[bj][n];
#pragma unroll
        for (int ai = 0; ai < 2; ++ai)
#pragma unroll
            for (int m = 0; m < 4; ++m) { bf16_t* rowp = O + (size_t)(row0 + ai * HALF + m * 16) * 1024 + col0;
#pragma unroll
                for (int bj = 0; bj < 2; ++bj) { const f32x4 v0 = acc[ai][bj][m][0] + bv[bj][0], v1 = acc[ai][bj][m][1] + bv[bj][1];
                    u32x4 w; w.x = cvt_pk_bf16(v0[0], v0[1]); w.y = cvt_pk_bf16(v0[2], v0[3]); w.z = cvt_pk_bf16(v1[0], v1[1]); w.w = cvt_pk_bf16(v1[2], v1[3]);
                    *(u32x4*)(rowp + bj * HALF) = w; } }
    }
};
struct EpiLora1 {
    struct Pre {};
    static constexpr bool PERM = true, AFTER_DRAIN = false;
    bf16_t* O;
    __device__ __forceinline__ void operator()(const f32x4 (&acc)[2][2][4][2], const Unit& u, int wr, int wc, int fr, int fq) const {
        const int row0 = u.pm * BM + wr * 64 + fr, col0 = u.pn * HALF + wc * 32 + 8 * fq;
#pragma unroll
        for (int ai = 0; ai < 2; ++ai)
#pragma unroll
            for (int m = 0; m < 4; ++m) { float r[8];
#pragma unroll
                for (int n = 0; n < 2; ++n)
#pragma unroll
                    for (int j = 0; j < 4; ++j) { const float x = acc[ai][0][m][n][j]; r[4 * n + j] = (u.pn == 0) ? (2.0f * sigm_(2.0f * x) - 1.0f) : (u.pn == 1) ? x : sigm_(x); }
                u32x4 w; w.x = cvt_pk_bf16(r[0], r[1]); w.y = cvt_pk_bf16(r[2], r[3]); w.z = cvt_pk_bf16(r[4], r[5]); w.w = cvt_pk_bf16(r[6], r[7]);
                *(u32x4*)(O + (size_t)(row0 + ai * HALF + m * 16) * 384 + col0) = w; }
    }
};
struct EpiRkvL1 {
    struct Pre {};
    static constexpr bool PERM = true, AFTER_DRAIN = false;
    EpiStoreBf16 rkv; EpiLora1 l1;
    __device__ __forceinline__ void operator()(const f32x4 (&acc)[2][2][4][2], const Unit& u, int wr, int wc, int fr, int fq) const { if (u.e) l1(acc, u, wr, wc, fr, fq); else rkv(acc, u, wr, wc, fr, fq); }
};
struct EpiLora2 {
    struct Pre {};
    static constexpr bool PERM = false, AFTER_DRAIN = false;
    bf16_t* WD; bf16_t* AD; bf16_t* G; const float* w0; const float* a0;
    __device__ __forceinline__ void operator()(const f32x4 (&acc)[2][2][4][2], const Unit& u, int wr, int wc, int fr, int fq) const {
        const int row0 = u.pm * BM + wr * 64 + fr, blk = u.pn >> 2, col0 = (u.pn & 3) * BM + wc * 32 + 4 * fq;
        bf16_t* dst = (blk < 2) ? WD + (size_t)blk * 16896 * 1024 : (blk < 4) ? AD + (size_t)(blk - 2) * 16896 * 1024 : G;
        const float* bias = (blk < 2) ? w0 + blk * 1024 : a0 + ((blk - 2) & 1) * 1024;
#pragma unroll
        for (int ai = 0; ai < 2; ++ai)
#pragma unroll
            for (int m = 0; m < 4; ++m) { bf16_t* rowp = dst + (size_t)(row0 + ai * HALF + m * 16) * 1024;
#pragma unroll
                for (int bj = 0; bj < 2; ++bj)
#pragma unroll
                    for (int n = 0; n < 2; ++n) { const int c = col0 + bj * HALF + n * 16; f32x4 v = acc[ai][bj][m][n];
                        const f32x4 bb = *(const f32x4*)(bias + c);
                        if (blk < 2) { for (int j = 0; j < 4; ++j) v[j] = -0.60653066f * sigm_(v[j] + bb[j]); }
                        else if (blk < 4) { for (int j = 0; j < 4; ++j) v[j] = sigm_(v[j] + bb[j]); }
                        unsigned lo = cvt_pk_bf16(v[0], v[1]), hi = cvt_pk_bf16(v[2], v[3]);
                        *(unsigned long long*)(rowp + c) = (unsigned long long)lo | ((unsigned long long)hi << 32); }
                asm volatile("" ::: "memory"); }
    }
};
}

constexpr int GLA_NCH = NSTEP / 64;
constexpr int GLA_ITEMS = 2 * NBATCH * GLA_NCH * 8;
constexpr size_t U_DS = 298 * MiB, U_OI = 430 * MiB, U_QT = 562 * MiB, U_LAM = 628 * MiB;
typedef short bf16x8_t __attribute__((ext_vector_type(8)));
typedef float f32x2g __attribute__((ext_vector_type(2)));
__device__ __forceinline__ f32x4 mfma16(bf16x8_t a, bf16x8_t b, f32x4 c) { return __builtin_amdgcn_mfma_f32_16x16x32_bf16(a, b, c, 0, 0, 0); }

__device__ __forceinline__ void phase_gla_prep(PP p, LAS unsigned char* lds, int tid, int lane, int wave) {
    constexpr int PQ = 272, PT = 144;
    LAS unsigned char* QA = lds;
    LAS unsigned char* QX = QA + 64 * PQ;
    LAS unsigned char* KB = QX + 48 * PQ;
    LAS unsigned char* KD = KB + 64 * PQ;
    LAS unsigned char* KT = KD + 64 * PQ;
    LAS unsigned char* VT = KT + 128 * PT;
    LAS unsigned char* PI = VT + 128 * PT;
    LAS float* GT = (LAS float*)(PI + 64 * PT);
    const bf16* Z = (const bf16*)(p->ws + WS_U + U_Z);
    bf16* DS = (bf16*)(p->ws + WS_U + U_DS); v2u* OI = (v2u*)(p->ws + WS_U + U_OI); bf16* QT = (bf16*)(p->ws + WS_U + U_QT); float* LAM = (float*)(p->ws + WS_U + U_LAM);
    const int kp = tid & 63, gg = tid >> 6, g = gg >> 1, hh = gg & 1, k0 = 2 * kp, kq = lane >> 4, c16 = lane & 15;
    unsigned zf[8], zq[8], zv[8];
    f32x2g nlb[3] = {};
    auto ldz = [&](int item2) {
        const int h2 = item2 & 7, cc2 = (item2 >> 3) % GLA_NCH, db2 = (item2 >> 3) / GLA_NCH, b2 = db2 & 1, dir2 = db2 >> 1;
        { const float* lb = p->in[I_HGLB] + (size_t)dir2 * 3 * D + h2 * 128 + k0; nlb[0] = *(const f32x2g*)lb; nlb[1] = *(const f32x2g*)(lb + D); nlb[2] = *(const f32x2g*)(lb + 2 * D); }
#pragma unroll
        for (int i = 0; i < 8; ++i) { const size_t zr = (size_t)step_row(b2, dir2, 64 * cc2 + 8 * gg + i) * 5120 + h2 * 128 + k0;
            zf[i] = *(const unsigned*)(Z + zr + 1024 * (1 + dir2)); zq[i] = *(const unsigned*)(Z + zr); zv[i] = *(const unsigned*)(Z + zr + 3072); } };
    if ((int)blockIdx.x < GLA_ITEMS) ldz(blockIdx.x);
    for (int item = blockIdx.x; item < GLA_ITEMS; item += gridDim.x) {
        const int h = item & 7, db = (item >> 3) / GLA_NCH, dir = db >> 1;
        float lbv[2];
#pragma unroll
        for (int e = 0; e < 2; ++e) { const float a0 = e ? nlb[0].y : nlb[0].x, a1 = e ? nlb[1].y : nlb[1].x, a2 = e ? nlb[2].y : nlb[2].x;
            const float mx = fmaxf(a0, fmaxf(a1, a2)); const float e0 = __expf(a0 - mx), e1 = __expf(a1 - mx), e2 = __expf(a2 - mx); lbv[e] = e0 / (e0 + e1 + e2); }
        for (int u = tid; u < 64 * PT / 4; u += NTHREADS) ((LAS unsigned*)PI)[u] = 0u;
        float cs[2][8], kin[2][8], qs[2][8], run[2] = {0.f, 0.f}; unsigned vlo[4], vhi[4];
#pragma unroll
        for (int i = 0; i < 8; ++i) {
#pragma unroll
            for (int e = 0; e < 2; ++e) {
                const float fh = bf2f(e ? (zf[i] >> 16) : (zf[i] & 0xffffu)), qv = bf2f(e ? (zq[i] >> 16) : (zq[i] & 0xffffu));
                const float f = lbv[e] + (1.f - lbv[e]) * sigm(fh);
                run[e] += __logf(f); cs[e][i] = run[e]; kin[e][i] = 1.f - f; qs[e][i] = qv * sigm(qv);
            }
            if (i & 1) { vlo[i >> 1] |= zv[i] << 16; vhi[i >> 1] |= zv[i] & 0xffff0000u; } else { vlo[i >> 1] = zv[i] & 0xffffu; vhi[i >> 1] = zv[i] >> 16; }
        }
        if (item + (int)gridDim.x < GLA_ITEMS) ldz(item + gridDim.x);
        *(LAS f32x2g*)(GT + gg * 128 + k0) = (f32x2g){run[0], run[1]};
        *(LAS v4u*)(VT + k0 * PT + 16 * gg) = (v4u){vlo[0], vlo[1], vlo[2], vlo[3]};
        *(LAS v4u*)(VT + (k0 + 1) * PT + 16 * gg) = (v4u){vhi[0], vhi[1], vhi[2], vhi[3]};
        __syncthreads();
        f32x2g t8[8];
#pragma unroll
        for (int u = 0; u < 8; ++u) t8[u] = *(const LAS f32x2g*)(GT + u * 128 + k0);
        unsigned ktl[4], kth[4];
        float rgv[2], totv[2], runSv[2], lov[2], t1v[2], t2v[2];
#pragma unroll
        for (int e = 0; e < 2; ++e) {
            const float s0 = e ? t8[0].y : t8[0].x, s1 = e ? t8[1].y : t8[1].x, s2 = e ? t8[2].y : t8[2].x, s3 = e ? t8[3].y : t8[3].x;
            const float s4 = e ? t8[4].y : t8[4].x, s5 = e ? t8[5].y : t8[5].x, s6 = e ? t8[6].y : t8[6].x, s7 = e ? t8[7].y : t8[7].x;
            const float q0 = s0 + s1, q1 = s2 + s3, q2 = s4 + s5, q3 = s6 + s7;
            rgv[e] = (g > 0 ? q0 : 0.f) + (g > 1 ? q1 : 0.f) + (g > 2 ? q2 : 0.f); totv[e] = (q0 + q1) + (q2 + q3);
            runSv[e] = (g == 0) ? q0 : (g == 1) ? q1 : (g == 2) ? q2 : q3;
            const float first = (g == 0) ? s0 : (g == 1) ? s2 : (g == 2) ? s4 : s6;
            lov[e] = hh ? first : 0.f; t1v[e] = q1; t2v[e] = q2;
        }
        float erg[2], einv[2], eend[2], ex1[2], ex2[2];
#pragma unroll
        for (int e = 0; e < 2; ++e) { erg[e] = __expf(rgv[e]); einv[e] = __expf(-runSv[e]); eend[e] = __expf(totv[e] - (rgv[e] + runSv[e]));
            ex1[e] = (g == 2) ? __expf(t1v[e]) : __expf(t2v[e]); ex2[e] = __expf(t1v[e] + t2v[e]); }
        bf16* qtp = QT + (size_t)item * 64 * 128 + (size_t)(16 * g + 8 * hh) * 128 + k0;
#pragma unroll
        for (int i = 0; i < 8; ++i) {
            float qh[2], kb[2];
#pragma unroll
            for (int e = 0; e < 2; ++e) { const float cr = lov[e] + cs[e][i]; qh[e] = qs[e][i] * __expf(cr); kb[e] = kin[e][i] * __expf(runSv[e] - cr); }
            const int ro = (16 * g + 8 * hh + i) * PQ + 2 * k0;
            *(LAS unsigned*)(QA + ro) = pk2(qh[0], qh[1]);
            *(LAS unsigned*)(KB + ro) = pk2(kb[0], kb[1]);
            *(LAS unsigned*)(KD + ro) = pk2(kb[0] * einv[0], kb[1] * einv[1]);
            if (g == 2) *(LAS unsigned*)(QX + (8 * hh + i) * PQ + 2 * k0) = pk2(qh[0] * ex1[0], qh[1] * ex1[1]);
            if (g == 3) { *(LAS unsigned*)(QX + (16 + 8 * hh + i) * PQ + 2 * k0) = pk2(qh[0] * ex1[0], qh[1] * ex1[1]); *(LAS unsigned*)(QX + (32 + 8 * hh + i) * PQ + 2 * k0) = pk2(qh[0] * ex2[0], qh[1] * ex2[1]); }
            *(unsigned*)(qtp + (size_t)i * 128) = pk2(qh[0] * erg[0], qh[1] * erg[1]);
            const unsigned kv0 = f2bf(kb[0] * eend[0]), kv1 = f2bf(kb[1] * eend[1]);
            if (i & 1) { ktl[i >> 1] |= kv0 << 16; kth[i >> 1] |= kv1 << 16; } else { ktl[i >> 1] = kv0; kth[i >> 1] = kv1; }
        }
        *(LAS v4u*)(KT + k0 * PT + 16 * gg) = (v4u){ktl[0], ktl[1], ktl[2], ktl[3]};
        *(LAS v4u*)(KT + (k0 + 1) * PT + 16 * gg) = (v4u){kth[0], kth[1], kth[2], kth[3]};
        if (gg == 0) *(f32x2g*)(LAM + (size_t)item * 128 + k0) = (f32x2g){__expf(totv[0]), __expf(totv[1])};
        __syncthreads();
        for (int blk = wave; blk < 10; blk += 8) {
            const int gi = (blk >= 6) ? 3 : (blk >= 3) ? 2 : (blk >= 1) ? 1 : 0, ji = blk - ((gi * (gi + 1)) >> 1);
            const LAS unsigned char* ab = (ji + 1 >= gi) ? QA + 16 * gi * PQ : (gi == 2) ? QX : (ji == 1) ? QX + 16 * PQ : QX + 32 * PQ;
            const LAS unsigned char* bb = ((ji == gi) ? KD : KB) + 16 * ji * PQ;
            f32x4 acc = (f32x4){0.f, 0.f, 0.f, 0.f};
#pragma unroll
            for (int s = 0; s < 4; ++s) {
                const bf16x8_t a = *(const LAS bf16x8_t*)(ab + c16 * PQ + (32 * s + 8 * kq) * 2), bv = *(const LAS bf16x8_t*)(bb + c16 * PQ + (32 * s + 8 * kq) * 2);
                acc = mfma16(a, bv, acc);
            }
#pragma unroll
            for (int j = 0; j < 4; ++j) { const int tau = 4 * kq + j; const float val = (ji == gi && c16 > tau) ? 0.f : acc[j];
                *(LAS unsigned short*)(PI + (16 * gi + tau) * PT + (16 * ji + c16) * 2) = (unsigned short)f2bf(val); }
        }
        __syncthreads();
        {
            const LAS unsigned char* vb = VT + (16 * wave + c16) * PT + 16 * kq;
            const bf16x8_t v0 = *(const LAS bf16x8_t*)(vb), v1 = *(const LAS bf16x8_t*)(vb + 64);
#pragma unroll
            for (int gi = 0; gi < 4; ++gi) {
                const LAS unsigned char* pb = PI + (16 * gi + c16) * PT + 16 * kq;
                f32x4 acc = mfma16(*(const LAS bf16x8_t*)(pb), v0, (f32x4){0.f, 0.f, 0.f, 0.f});
                if (gi >= 2) acc = mfma16(*(const LAS bf16x8_t*)(pb + 64), v1, acc);
                { v2u w; w.x = pk2(acc[0], acc[1]); w.y = pk2(acc[2], acc[3]); OI[((size_t)item * 8 + wave) * 256 + gi * 64 + lane] = w; }
            }
            LAS unsigned char* stg = lds + wave * 4352;
#pragma unroll
            for (int m = 0; m < 8; ++m) {
                const LAS unsigned char* kb2 = KT + (16 * m + c16) * PT + 16 * kq;
                f32x4 acc = mfma16(*(const LAS bf16x8_t*)(kb2), v0, (f32x4){0.f, 0.f, 0.f, 0.f});
                acc = mfma16(*(const LAS bf16x8_t*)(kb2 + 64), v1, acc);
                v2u w; w.x = pk2(acc[0], acc[1]); w.y = pk2(acc[2], acc[3]);
                *(LAS v2u*)(stg + c16 * 272 + (16 * m + 4 * kq) * 2) = w;
            }
            LDS_WAIT(); asm volatile("" ::: "memory");
            bf16* dsb = DS + (size_t)item * 128 * 128 + (size_t)(16 * wave) * 128;
#pragma unroll
            for (int u = 0; u < 4; ++u) { const int piece = lane + 64 * u, row = piece >> 4, seg = piece & 15;
                *(v4u*)(dsb + row * 128 + seg * 8) = *(const LAS v4u*)(stg + row * 272 + seg * 16); }
        }
        __syncthreads();
    }
}
__device__ __forceinline__ void phase_gla_scan(PP p, int tid) {
    bf16* DS = (bf16*)(p->ws + WS_U + U_DS); const float* LAM = (const float*)(p->ws + WS_U + U_LAM);
    const int nthr = gridDim.x * NTHREADS;
    for (int e = blockIdx.x * NTHREADS + tid; e < 32 * 2048; e += nthr) {
        const int chain = e >> 11, el = e & 2047, h = chain & 7, db = chain >> 3, k8 = (el & 15) * 8;
        float s[8];
#pragma unroll
        for (int i = 0; i < 8; ++i) s[i] = 0.f;
        for (int c0 = 0; c0 < GLA_NCH; c0 += 6) {
            v4u d[6]; f32x4 l0[6], l1[6];
#pragma unroll
            for (int u = 0; u < 6; ++u) { const size_t item = ((size_t)db * GLA_NCH + c0 + u) * 8 + h;
                d[u] = *(const v4u*)(DS + item * 16384 + (size_t)el * 8); l0[u] = *(const f32x4*)(LAM + item * 128 + k8); l1[u] = *(const f32x4*)(LAM + item * 128 + k8 + 4); }
#pragma unroll
            for (int u = 0; u < 6; ++u) { const size_t item = ((size_t)db * GLA_NCH + c0 + u) * 8 + h;
                v4u o; o.x = pk2(s[0], s[1]); o.y = pk2(s[2], s[3]); o.z = pk2(s[4], s[5]); o.w = pk2(s[6], s[7]);
                *(v4u*)(DS + item * 16384 + (size_t)el * 8) = o;
                s[0] = l0[u].x * s[0] + bf2f(d[u].x & 0xffffu); s[1] = l0[u].y * s[1] + bf2f(d[u].x >> 16);
                s[2] = l0[u].z * s[2] + bf2f(d[u].y & 0xffffu); s[3] = l0[u].w * s[3] + bf2f(d[u].y >> 16);
                s[4] = l1[u].x * s[4] + bf2f(d[u].z & 0xffffu); s[5] = l1[u].y * s[5] + bf2f(d[u].z >> 16);
                s[6] = l1[u].z * s[6] + bf2f(d[u].w & 0xffffu); s[7] = l1[u].w * s[7] + bf2f(d[u].w >> 16); }
        }
    }
}
__device__ __forceinline__ void phase_gla_out(PP p, LAS unsigned char* lds, int tid, int lane, int wave) {
    const bf16* DS = (const bf16*)(p->ws + WS_U + U_DS); const v2u* OI = (const v2u*)(p->ws + WS_U + U_OI); const bf16* QT = (const bf16*)(p->ws + WS_U + U_QT);
    const bf16* Z = (const bf16*)(p->ws + WS_U + U_Z); bf16* A2 = (bf16*)(p->ws + WS_A2); const float* gn = p->in[I_HGGN];
    constexpr int PQ = 272;
    LAS unsigned char* QL = lds;
    LAS unsigned char* GL_ = lds + 2 * 64 * PQ;
    LAS unsigned char* OL = GL_ + 64 * PQ;
    LAS float* SSQ = (LAS float*)(OL + 64 * PQ);
    LAS float* RST = SSQ + 512;
    const int kq = lane >> 4, c16 = lane & 15;
    const int srow = tid >> 3, sch = tid & 7;
    constexpr int NIT = NBATCH * GLA_NCH * 8;
    struct Pre { v4u q[2][2]; v4u g[2]; bf16x8_t bv[2][4]; v2u ow[2][4]; };
    auto decode = [&](int it, int& h, int& jc, int& b, int (&item)[2], int& tok0) {
        h = it & 7; jc = (it >> 3) % GLA_NCH; b = (it >> 3) / GLA_NCH;
        const int cb = (jc < 4) ? 3 - jc : 135 - jc;
        item[0] = ((0 * 2 + b) * GLA_NCH + jc) * 8 + h; item[1] = ((1 * 2 + b) * GLA_NCH + cb) * 8 + h;
        tok0 = (jc < 4) ? NLAT + b * CTXL + 64 * jc : b * SEQ + 64 * (jc - 4); };
    auto fetch = [&](int it, Pre& P) {
        int h, jc, b, item[2], tok0; decode(it, h, jc, b, item, tok0);
#pragma unroll
        for (int d = 0; d < 2; ++d) {
            const v4u* qs = (const v4u*)(QT + (size_t)item[d] * 8192 + srow * 128 + sch * 16); P.q[d][0] = qs[0]; P.q[d][1] = qs[1];
            const bf16* sp = DS + (size_t)item[d] * 16384 + (size_t)(16 * wave + c16) * 128 + 8 * kq;
#pragma unroll
            for (int s2 = 0; s2 < 4; ++s2) P.bv[d][s2] = *(const bf16x8_t*)(sp + 32 * s2);
#pragma unroll
            for (int gi = 0; gi < 4; ++gi) P.ow[d][gi] = OI[((size_t)item[d] * 8 + wave) * 256 + gi * 64 + lane];
        }
        const v4u* gs = (const v4u*)(Z + (size_t)(tok0 + srow) * 5120 + 4096 + h * 128 + sch * 16); P.g[0] = gs[0]; P.g[1] = gs[1]; };
    Pre nx;
    if ((int)blockIdx.x < NIT) fetch(blockIdx.x, nx);
    for (int it = blockIdx.x; it < NIT; it += gridDim.x) {
        int h, jc, b, item[2], tok0; decode(it, h, jc, b, item, tok0);
#pragma unroll
        for (int d = 0; d < 2; ++d) { LAS v4u* dq = (LAS v4u*)(QL + d * 64 * PQ + srow * PQ + sch * 32); dq[0] = nx.q[d][0]; dq[1] = nx.q[d][1]; }
        { LAS v4u* dg = (LAS v4u*)(GL_ + srow * PQ + sch * 32); dg[0] = nx.g[0]; dg[1] = nx.g[1]; }
        bf16x8_t bv[2][4]; v2u ow[2][4];
#pragma unroll
        for (int d = 0; d < 2; ++d)
#pragma unroll
            for (int u = 0; u < 4; ++u) { bv[d][u] = nx.bv[d][u]; ow[d][u] = nx.ow[d][u]; }
        __syncthreads();
        if (it + (int)gridDim.x < NIT) fetch(it + gridDim.x, nx);
        f32x4 acc[2][4];
#pragma unroll
        for (int d = 0; d < 2; ++d)
#pragma unroll
            for (int gi = 0; gi < 4; ++gi) {
                const LAS unsigned char* qp = QL + d * 64 * PQ + (16 * gi + c16) * PQ + 16 * kq;
                f32x4 a4 = (f32x4){bf2f(ow[d][gi].x & 0xffffu), bf2f(ow[d][gi].x >> 16), bf2f(ow[d][gi].y & 0xffffu), bf2f(ow[d][gi].y >> 16)};
#pragma unroll
                for (int s2 = 0; s2 < 4; ++s2) a4 = mfma16(*(const LAS bf16x8_t*)(qp + 64 * s2), bv[d][s2], a4);
                acc[d][gi] = a4;
            }
        f32x4 o[4]; float ss[4][4];
#pragma unroll
        for (int gi = 0; gi < 4; ++gi)
#pragma unroll
            for (int j = 0; j < 4; ++j) { const float v = acc[0][gi][j] + __shfl_xor(acc[1][3 - gi][3 - j], 48); o[gi][j] = v;
                float q = v * v;
                q += __builtin_bit_cast(float, __builtin_amdgcn_update_dpp(0, __builtin_bit_cast(int, q), 0x128, 0xf, 0xf, false));
                q += __builtin_bit_cast(float, __builtin_amdgcn_update_dpp(0, __builtin_bit_cast(int, q), 0x124, 0xf, 0xf, false));
                q += __builtin_bit_cast(float, __builtin_amdgcn_update_dpp(0, __builtin_bit_cast(int, q), 0x122, 0xf, 0xf, false));
                q += __builtin_bit_cast(float, __builtin_amdgcn_update_dpp(0, __builtin_bit_cast(int, q), 0x121, 0xf, 0xf, false));
                ss[gi][j] = q; }
        if (c16 == 0) {
#pragma unroll
            for (int gi = 0; gi < 4; ++gi)
#pragma unroll
                for (int j = 0; j < 4; ++j) SSQ[(16 * gi + 4 * kq + j) * 8 + wave] = ss[gi][j]; }
        __syncthreads();
        if (tid < 64) { const f32x4 s0 = *(const LAS f32x4*)(SSQ + tid * 8), s1 = *(const LAS f32x4*)(SSQ + tid * 8 + 4);
            RST[tid] = rsqrtf(((s0[0] + s0[1]) + (s0[2] + s0[3]) + (s1[0] + s1[1]) + (s1[2] + s1[3])) * (1.0f / 128.0f) + NORM_EPS); }
        __syncthreads();
        const int vl = 16 * wave + c16; const float gw_ = gn[vl];
#pragma unroll
        for (int gi = 0; gi < 4; ++gi)
#pragma unroll
            for (int j = 0; j < 4; ++j) { const int tk = 16 * gi + 4 * kq + j;
                const float g = bf2f(*(const LAS unsigned short*)(GL_ + tk * PQ + vl * 2)); const float r = o[gi][j] * RST[tk] * gw_ * (g * sigm(g));
                *(LAS unsigned short*)(OL + tk * PQ + vl * 2) = (unsigned short)f2bf(r); }
        __syncthreads();
        { const LAS v4u* so = (const LAS v4u*)(OL + srow * PQ + sch * 32); v4u* dst = (v4u*)(A2 + (size_t)(tok0 + srow) * D + h * 128 + sch * 16); dst[0] = so[0]; dst[1] = so[1]; }
        __syncthreads();
    }
}

typedef short bf16x4_t __attribute__((ext_vector_type(4)));
typedef float f32x2_t __attribute__((ext_vector_type(2))); typedef __bf16 bf16x2v_t __attribute__((ext_vector_type(2)));
__device__ __forceinline__ unsigned cvtpk(float lo, float hi) { const f32x2_t v = {lo, hi}; const bf16x2v_t b = __builtin_convertvector(v, bf16x2v_t); return __builtin_bit_cast(unsigned, b); }
constexpr int R4_DOTA = 0, R4_UPA = 2048, R4_A1 = 4096, R4_A2 = 4352, R4_G7 = 4608, R4_VT = 4864, R4_IMG = 6912, R4_SLOT = 5376, R4_NCH = NSTEP / 8, R4_NCB = 8;
constexpr size_t U_IMG = 872 * MiB;
constexpr size_t U_YST = U_OD1;
__device__ __forceinline__ void phase_rw_prep(PP p, LAS unsigned char* lds, int lane, int wave) {
    const int gw = blockIdx.x * NWAVES + wave, NGW = gridDim.x * NWAVES;
    const bf16* RKV = (const bf16*)(p->ws + WS_U + U_RKV); unsigned char* IMG = p->ws + WS_U + U_IMG;
    LAS unsigned char* da = lds + wave * 8192; LAS unsigned char* gb = da + 2048; LAS float* GL = (LAS float*)(da + 4096);
    LAS unsigned char* a12 = da + 5120;
    const int m = lane & 15, q = lane >> 4;
    const int s2 = lane >> 5, tp = (lane >> 4) & 1, kq = (lane & 15) >> 2, ii = (lane & 3) + 4 * tp, dpos = ((s2 * 4 + kq) * 8 + ii) * 2;
    float nrx[8], nkx[8], nvx[8], nlw[8], nav[8];
    auto ld = [&](int it2) {
        const int chain = it2 & 63, chunk = it2 >> 6, b = chain >> 5, dir = (chain >> 4) & 1, h = chain & 15, ch = h * 64 + lane;
        const bf16* WDp = (const bf16*)(p->ws + WS_U + U_WD) + (size_t)dir * NROW * D; const bf16* ADp = (const bf16*)(p->ws + WS_U + U_AD) + (size_t)dir * NROW * D;
#pragma unroll
        for (int j = 0; j < 8; ++j) { const int row = step_row(b, dir, chunk * 8 + j);
            nrx[j] = bf2f(RKV[(size_t)row * 3072 + ch]); nkx[j] = bf2f(RKV[(size_t)row * 3072 + 1024 + ch]); nvx[j] = bf2f(RKV[(size_t)row * 3072 + 2048 + ch]);
            nlw[j] = bf2f(WDp[(size_t)row * D + ch]); nav[j] = bf2f(ADp[(size_t)row * D + ch]); } };
    if (gw < 64 * R4_NCH) ld(gw);
    for (int it = gw; it < 64 * R4_NCH; it += NGW) {
        const int chain = it & 63, chunk = it >> 6, h = chain & 15, ch = h * 64 + lane;
        const float kkw = p->in[I_KK][ch], kaw = p->in[I_KA][ch];
        float rx[8], kx[8], vx[8], lw[8], av[8], kn[8];
#pragma unroll
        for (int j = 0; j < 8; ++j) { rx[j] = nrx[j]; kx[j] = nkx[j]; vx[j] = nvx[j]; lw[j] = nlw[j]; av[j] = nav[j]; }
        if (it + NGW < 64 * R4_NCH) ld(it + NGW);
#pragma unroll
        for (int j = 0; j < 8; ++j) { const float t = kx[j] * kkw; kn[j] = t * __builtin_amdgcn_rsqf(fmaxf(wave_sum(t * t), 1e-24f)); }
        float bj[8]; { float bb = 0.f;
#pragma unroll
            for (int j = 0; j < 8; ++j) { bb += lw[j]; bj[j] = bb; } }
        const float e7 = __expf(bj[7]);
        unsigned upa[8]; float ebprev = 1.f;
#pragma unroll
        for (int j = 0; j < 8; ++j) {
            const float eb = __expf(bj[j]), einv = __builtin_amdgcn_rcpf(eb), e7j = e7 * einv;
            const float beta = kn[j] * av[j], kd = kx[j] * (1.f + (av[j] - 1.f) * kaw);
            *(LAS unsigned short*)(da + j * 128 + dpos) = (unsigned short)f2bf(kn[j] * ebprev);
            *(LAS unsigned short*)(da + (8 + j) * 128 + dpos) = (unsigned short)f2bf(rx[j] * eb);
            *(LAS unsigned short*)(gb + j * 128 + dpos) = (unsigned short)f2bf(beta * einv);
            *(LAS unsigned short*)(gb + (8 + j) * 128 + dpos) = (unsigned short)f2bf(kd * einv);
            const unsigned ub = f2bf(-beta * e7j), uk = f2bf(kd * e7j);
            if (j & 1) { upa[j >> 1] |= ub << 16; upa[4 + (j >> 1)] |= uk << 16; } else { upa[j >> 1] = ub; upa[4 + (j >> 1)] = uk; }
            ebprev = eb;
        }
        unsigned char* img = IMG + ((size_t)chain * R4_NCH + chunk) * R4_IMG;
        { v4u* d = (v4u*)(img + R4_UPA + lane * 32); d[0] = (v4u){upa[0], upa[1], upa[2], upa[3]}; d[1] = (v4u){upa[4], upa[5], upa[6], upa[7]}; }
        ((float*)(img + R4_G7))[lane] = e7;
        { f32x4* d = (f32x4*)(img + R4_VT + lane * 32); d[0] = (f32x4){vx[0], vx[1], vx[2], vx[3]}; d[1] = (f32x4){vx[4], vx[5], vx[6], vx[7]}; }
        LDS_WAIT(); asm volatile("" ::: "memory");
        { v4u* d = (v4u*)(img + R4_DOTA); d[lane] = ((const LAS v4u*)da)[lane]; d[64 + lane] = ((const LAS v4u*)da)[64 + lane]; }
        f32x4 G = (f32x4){0.f, 0.f, 0.f, 0.f};
#pragma unroll
        for (int s = 0; s < 2; ++s) G = mfma16(*(const LAS bf16x8_t*)(da + m * 128 + (s * 4 + q) * 16), *(const LAS bf16x8_t*)(gb + m * 128 + (s * 4 + q) * 16), G);
        if (m >= 8) { const int i = m - 8;
#pragma unroll
            for (int jp = 0; jp < 4; ++jp) { const int row = 4 * q + jp; const bool keep = (row < 8) ? (i < row) : (i <= row - 8);
                *(LAS unsigned short*)(a12 + row * 16 + i * 2) = (unsigned short)f2bf(keep ? G[jp] : 0.f); } }
#pragma unroll
        for (int jp = 0; jp < 4; ++jp) GL[(4 * q + jp) * 16 + m] = G[jp];
        LDS_WAIT(); asm volatile("" ::: "memory");
        const int c = lane & 7; float Tc[8], M2[8];
#pragma unroll
        for (int j = 0; j < 8; ++j) { float t = (j == c) ? 1.f : 0.f; const f32x4 ra = *(const LAS f32x4*)(GL + j * 16), rb = *(const LAS f32x4*)(GL + j * 16 + 4);
#pragma unroll
            for (int i = 0; i < j; ++i) t -= (i < 4 ? ra[i & 3] : rb[i & 3]) * Tc[i];
            Tc[j] = t; }
#pragma unroll
        for (int j = 0; j < 8; ++j) { float t = 0.f; const f32x4 ra = *(const LAS f32x4*)(GL + (8 + j) * 16), rb = *(const LAS f32x4*)(GL + (8 + j) * 16 + 4);
#pragma unroll
            for (int i = 0; i <= j; ++i) t -= (i < 4 ? ra[i & 3] : rb[i & 3]) * Tc[i];
            M2[j] = t; }
        if (lane < 8) {
#pragma unroll
            for (int j = 0; j < 8; ++j) { *(LAS unsigned short*)(a12 + 256 + j * 16 + c * 2) = (unsigned short)f2bf(Tc[j]); *(LAS unsigned short*)(a12 + 256 + (8 + j) * 16 + c * 2) = (unsigned short)f2bf(M2[j]); } }
        LDS_WAIT(); asm volatile("" ::: "memory");
        if (lane < 32) ((v4u*)(img + R4_A1))[lane] = ((const LAS v4u*)a12)[lane];
        LDS_WAIT(); asm volatile("" ::: "memory");
    }
}
constexpr int R4L_NCB = 6, R4L_SLOT = 6144;
__device__ __forceinline__ void phase_rwkv_scan4(PP p, LAS unsigned char* lds, int vcu, int tid, int lane, int wave) {
    const int m = lane & 15, q = lane >> 4;
    const unsigned char* IMG = p->ws + WS_U + U_IMG;
    for (int unit = vcu; unit < 256; unit += gridDim.x) {
        const int chain = unit >> 2, slab = unit & 3, b = chain >> 5, dir = (chain >> 4) & 1, h = chain & 15;
        float* YST = (float*)(p->ws + WS_U + U_YST) + (size_t)unit * NSTEP * 16 + (q >= 2 ? 4 * (q - 2) : 0) * 16 + m;
        const unsigned char* cimg = IMG + (size_t)chain * R4_NCH * R4_IMG;
        f32x4 S[4];
#pragma unroll
        for (int T = 0; T < 4; ++T) S[T] = (f32x4){0.f, 0.f, 0.f, 0.f};
        v2u idf; { const int c0 = 4 * q; idf.x = ((c0 == m) ? 0x3F80u : 0u) | ((c0 + 1 == m) ? 0x3F800000u : 0u); idf.y = ((c0 + 2 == m) ? 0x3F80u : 0u) | ((c0 + 3 == m) ? 0x3F800000u : 0u); }
        auto issue = [&](int bt) {
#pragma unroll
            for (int k = 0; k < 2 * R4L_NCB; ++k) { const int ii = (wave - 1) + 3 * k, cc = ii / 6, part = ii - cc * 6, pi = part * 64 + lane;
                const unsigned char* src = cimg + (size_t)(bt * R4L_NCB + cc) * R4_IMG + (pi < 304 ? pi * 16 : (pi < 336 ? R4_VT + slab * 512 + (pi - 304) * 16 : 0));
                __builtin_amdgcn_global_load_lds((const unsigned*)src, (LAS unsigned*)(lds + ((bt & 1) * R4L_NCB + cc) * R4L_SLOT + part * 1024), 16, 0, 0); } };
        float crg[32]; int cit = (int)(blockIdx.x * 4 + (wave - 4)); ConvJob cj; bool cpend = false, cloaded = false;
        LAS float* cscr = (LAS float*)(lds + 2 * R4L_NCB * R4L_SLOT + (wave & 3) * 8448);
        if (wave >= 4 && cit < IT_L1MOE) { cj = conv_job_l1(p, cit); ti_load(cj.src, cj.src_ld, lane, crg); cpend = true; cloaded = true; }
        __syncthreads();
        if (wave >= 1 && wave < 4) { issue(0); asm volatile("s_waitcnt vmcnt(0)" ::: "memory"); }
        __syncthreads();
        constexpr int NB4 = R4_NCH / R4L_NCB;
        for (int bt = 0; bt < NB4; ++bt) {
            if (wave >= 4) {
                const int ph3 = bt % 3;
                if (ph3 == 0) { if (cpend && cloaded) { ti_store(true, cj.fp8, crg, cj.dst, cj.dst_ldb, cscr, lane); cloaded = false; cit += 4 * (int)gridDim.x; cpend = cit < IT_L1MOE; } }
                else if (ph3 == 1) { if (cpend && !cloaded) { cj = conv_job_l1(p, cit); ti_load(cj.src, cj.src_ld, lane, crg); cloaded = true; } } }
            else if (wave >= 1) { if (bt + 1 < NB4) issue(bt + 1); asm volatile("s_waitcnt vmcnt(0)" ::: "memory"); }
            else {
                __builtin_amdgcn_s_setprio(3);
                struct Ops { bf16x8_t a0, a1; v2u A1u, A2u; bf16x4_t UA[4]; f32x4 g7[4]; f32x4 vr; };
                auto rd = [&](int cc, Ops& o) {
                    const LAS unsigned char* sl = lds + ((bt & 1) * R4L_NCB + cc) * R4L_SLOT;
                    o.a0 = *(const LAS bf16x8_t*)(sl + R4_DOTA + m * 128 + q * 16); o.a1 = *(const LAS bf16x8_t*)(sl + R4_DOTA + m * 128 + (4 + q) * 16);
                    o.A1u = *(const LAS v2u*)(sl + R4_A1 + m * 16 + (q & 1) * 8); o.A2u = *(const LAS v2u*)(sl + R4_A2 + m * 16 + (q & 1) * 8);
#pragma unroll
                    for (int T = 0; T < 4; ++T) { o.UA[T] = *(const LAS bf16x4_t*)(sl + R4_UPA + (16 * T + m) * 32 + q * 8); o.g7[T] = *(const LAS f32x4*)(sl + R4_G7 + (16 * T + 4 * q) * 4); }
                    o.vr = *(const LAS f32x4*)(sl + R4_VT + m * 32 + (q & 1) * 16); };
                Ops cur, nxt; rd(0, cur);
#pragma unroll
                for (int cc = 0; cc < R4L_NCB; ++cc) {
                    if (cc + 1 < R4L_NCB) rd(cc + 1, nxt);
                    __builtin_amdgcn_sched_barrier(0);
                    v2u A1u = cur.A1u, A2u = cur.A2u;
                    if (q >= 2) { A1u = (v2u){0u, 0u}; A2u = idf; }
                    v4u b0, b1;
                    b0.x = cvtpk(S[0][0], S[0][1]); b0.y = cvtpk(S[0][2], S[0][3]); b0.z = cvtpk(S[1][0], S[1][1]); b0.w = cvtpk(S[1][2], S[1][3]);
                    b1.x = cvtpk(S[2][0], S[2][1]); b1.y = cvtpk(S[2][2], S[2][3]); b1.z = cvtpk(S[3][0], S[3][1]); b1.w = cvtpk(S[3][2], S[3][3]);
                    f32x4 Dd = mfma16(cur.a0, __builtin_bit_cast(bf16x8_t, b0), (f32x4){0.f, 0.f, 0.f, 0.f});
                    Dd = mfma16(cur.a1, __builtin_bit_cast(bf16x8_t, b1), Dd);
                    v2u vb; vb.x = cvtpk(cur.vr[0], cur.vr[1]); vb.y = cvtpk(cur.vr[2], cur.vr[3]);
                    const f32x4 Z = __builtin_amdgcn_mfma_f32_16x16x16bf16_1k(__builtin_bit_cast(bf16x4_t, A1u), __builtin_bit_cast(bf16x4_t, vb), Dd, 0, 0, 0);
                    v2u zb; zb.x = cvtpk(Z[0], Z[1]); zb.y = cvtpk(Z[2], Z[3]);
                    const f32x4 W = __builtin_amdgcn_mfma_f32_16x16x16bf16_1k(__builtin_bit_cast(bf16x4_t, A2u), __builtin_bit_cast(bf16x4_t, zb), (f32x4){0.f, 0.f, 0.f, 0.f}, 0, 0, 0);
                    v2u wb; wb.x = cvtpk(W[0], W[1]); wb.y = cvtpk(W[2], W[3]);
                    const v2u ub = (q < 2) ? wb : vb;
#pragma unroll
                    for (int T = 0; T < 4; ++T) S[T] = __builtin_amdgcn_mfma_f32_16x16x16bf16_1k(cur.UA[T], __builtin_bit_cast(bf16x4_t, ub), S[T] * cur.g7[T], 0, 0, 0);
                    if (q >= 2) { float* yp = YST + (size_t)(bt * R4L_NCB + cc) * 128;
#pragma unroll
                        for (int i = 0; i < 4; ++i) yp[i * 16] = W[i]; }
                    if (cc + 1 < R4L_NCB) cur = nxt;
                }
            }
            asm volatile("s_waitcnt lgkmcnt(0)" ::: "memory"); __builtin_amdgcn_s_barrier(); asm volatile("" ::: "memory");
        }
        if (wave >= 4) { while (cpend) { if (!cloaded) { cj = conv_job_l1(p, cit); ti_load(cj.src, cj.src_ld, lane, crg); } ti_store(true, cj.fp8, crg, cj.dst, cj.dst_ldb, cscr, lane); cloaded = false; cit += 4 * (int)gridDim.x; cpend = cit < IT_L1MOE; } }
    }
}

__device__ __forceinline__ void phase_lora2(PP p, LAS unsigned char* lds, int tid, int lane, int wave) {
    const bf16* L1 = (const bf16*)(p->ws + WS_U + U_L1); const bf16* W2 = (const bf16*)(p->ws + WS_WL2);
    const int c16 = lane & 15, kq = lane >> 4;
    const int part = blockIdx.x % 12, wgp = blockIdx.x / 12, nwg = (gridDim.x - part + 11) / 12;
    const int blk = (part < 8) ? (part >> 1) : 4, col0 = (part < 8) ? (part & 1) * 512 : (part - 8) * 256, ncol = (part < 8) ? 512 : 256;
    const int koff = (blk < 4) ? blk * 64 : 256, nks = (blk < 4) ? 2 : 4, K = nks * 32, WP = K * 2 + 16;
    LAS unsigned char* wl = lds;
    constexpr int PS = 272;
    LAS unsigned char* stg = lds + 73728 + wave * (16 * PS);
    { const int ppr = K / 8;
#pragma unroll 8
      for (int u = tid; u < ncol * ppr; u += NTHREADS) { const int c = u / ppr, pc = u - c * ppr;
          *(LAS v4u*)(wl + c * WP + pc * 16) = *(const v4u*)(W2 + (size_t)(blk * 1024 + col0 + c) * 384 + koff + pc * 8); } }
    const float* bias = ((blk < 2) ? p->in[I_DECW0] + blk * D : p->in[I_A0] + ((blk - 2) & 1) * D) + col0;
    LAS float* bl = (LAS float*)(lds + 108544);
    if (blk < 4) { for (int u = tid; u < ncol; u += NTHREADS) bl[u] = bias[u]; }
    __syncthreads();
    bf16* dstb = (bf16*)(p->ws + WS_U + ((blk < 2) ? U_WD : (blk < 4) ? U_AD : U_G)) + (size_t)((blk < 4) ? (blk & 1) : 0) * NROW * D + col0;
    for (int rt = wgp * NWAVES + wave; rt < NROW / 16; rt += nwg * NWAVES) {
        const bf16* lp = L1 + (size_t)(rt * 16 + c16) * 384 + koff + 8 * kq;
        bf16x8_t bfr[4];
#pragma unroll
        for (int s = 0; s < 4; ++s) if (s < nks) bfr[s] = *(const bf16x8_t*)(lp + 32 * s);
        bf16* dst = dstb + (size_t)(rt * 16) * D;
        for (int ps = 0; ps < ncol / 128; ++ps) {
#pragma unroll 4
            for (int ct = 0; ct < 8; ++ct) {
                const int c0 = ps * 128 + ct * 16;
                const LAS unsigned char* wp = wl + (c0 + c16) * WP + 16 * kq;
                f32x4 acc = (f32x4){0.f, 0.f, 0.f, 0.f};
#pragma unroll
                for (int s = 0; s < 4; ++s) if (s < nks) acc = mfma16(*(const LAS bf16x8_t*)(wp + 64 * s), bfr[s], acc);
                const f32x4 bb = (blk < 4) ? *(const LAS f32x4*)(bl + c0 + 4 * kq) : (f32x4){0.f, 0.f, 0.f, 0.f};
                if (blk < 2) { for (int j = 0; j < 4; ++j) acc[j] = -0.60653066f * sigm(acc[j] + bb[j]); }
                else if (blk < 4) { for (int j = 0; j < 4; ++j) acc[j] = sigm(acc[j] + bb[j]); }
                v2u w; w.x = pk2(acc[0], acc[1]); w.y = pk2(acc[2], acc[3]);
                *(LAS v2u*)(stg + c16 * PS + (ct * 16 + 4 * kq) * 2) = w;
            }
            LDS_WAIT(); asm volatile("" ::: "memory");
#pragma unroll
            for (int i = 0; i < 4; ++i) { const int row = 4 * i + (lane >> 4), cb = lane & 15;
                *(v4u*)(dst + (size_t)row * D + ps * 128 + cb * 8) = *(const LAS v4u*)(stg + row * PS + cb * 16); }
            LDS_WAIT(); asm volatile("" ::: "memory");
        }
    }
    __syncthreads();
}

constexpr int R5_DOTA = 0, R5_UPA = 4096, R5_A21 = 8192, R5_A2 = 9216, R5_GE = 10240, R5_VT = 10496, R5_IMG = 10496, R5_NCH = NSTEP / 16, R5_NCB = 3, R5_SLOT = 12288, R5_NST = 3;
__device__ __forceinline__ void phase_rw_prep5(PP p, LAS unsigned char* lds, int lane, int wave) {
    const int gw = blockIdx.x * NWAVES + wave, NGW = gridDim.x * NWAVES;
    const bf16* RKV = (const bf16*)(p->ws + WS_U + U_RKV); unsigned char* IMG = p->ws + WS_U + U_IMG;
    LAS unsigned char* da = lds + wave * 14336;
    LAS unsigned char* gb = da + 4096; LAS float* GL = (LAS float*)(da + 8192); LAS unsigned char* a12 = da + 12288; LAS float* TM = (LAS float*)gb;
    const int m = lane & 15, q = lane >> 4;
    const int s2 = lane >> 5, tp = (lane >> 4) & 1, kq = (lane & 15) >> 2, ii = (lane & 3) + 4 * tp, dpos = ((s2 * 4 + kq) * 8 + ii) * 2;
    float nrx[16], nkx[16], nlw[16], nav[16];
    auto ld = [&](int it2) {
        const int chain = it2 & 63, chunk = it2 >> 6, b = chain >> 5, dir = (chain >> 4) & 1, h = chain & 15, ch = h * 64 + lane;
        const bf16* WDp = (const bf16*)(p->ws + WS_U + U_WD) + (size_t)dir * NROW * D; const bf16* ADp = (const bf16*)(p->ws + WS_U + U_AD) + (size_t)dir * NROW * D;
#pragma unroll
        for (int j = 0; j < 16; ++j) { const int row = step_row(b, dir, chunk * 16 + j);
            nrx[j] = bf2f(RKV[(size_t)row * 3072 + ch]); nkx[j] = bf2f(RKV[(size_t)row * 3072 + 1024 + ch]);
            nlw[j] = bf2f(WDp[(size_t)row * D + ch]); nav[j] = bf2f(ADp[(size_t)row * D + ch]); } };
    if (gw < 64 * R5_NCH) ld(gw);
    const float kkw = p->in[I_KK][((gw & 63) & 15) * 64 + lane], kaw = p->in[I_KA][((gw & 63) & 15) * 64 + lane];
    for (int it = gw; it < 64 * R5_NCH; it += NGW) {
        const int chain = it & 63, chunk = it >> 6, h = chain & 15, ch = h * 64 + lane;
        unsigned char* img = IMG + ((size_t)chain * R5_NCH + chunk) * R5_IMG;
        float upf[32]; float bb = 0.f, ebprev = 1.f, eb = 1.f;
        float ssq;
        { float x8[8], x4[4], x2[2];
          const bool b3 = (lane & 8) != 0, b2 = (lane & 4) != 0, b1 = (lane & 2) != 0, b0 = (lane & 1) != 0;
#pragma unroll
          for (int i = 0; i < 8; ++i) { const float tl = nkx[i] * kkw, th = nkx[i + 8] * kkw; const float sl = tl * tl, sh = th * th;
              x8[i] = (b3 ? sh : sl) + __builtin_bit_cast(float, __builtin_amdgcn_update_dpp(0, __builtin_bit_cast(int, b3 ? sl : sh), 0x140, 0xf, 0xf, false)); }
#pragma unroll
          for (int i = 0; i < 4; ++i) x4[i] = (b2 ? x8[i + 4] : x8[i]) + __builtin_bit_cast(float, __builtin_amdgcn_update_dpp(0, __builtin_bit_cast(int, b2 ? x8[i] : x8[i + 4]), 0x141, 0xf, 0xf, false));
#pragma unroll
          for (int i = 0; i < 2; ++i) x2[i] = (b1 ? x4[i + 2] : x4[i]) + __builtin_bit_cast(float, __builtin_amdgcn_update_dpp(0, __builtin_bit_cast(int, b1 ? x4[i] : x4[i + 2]), 0x1B, 0xf, 0xf, false));
          ssq = (b0 ? x2[1] : x2[0]) + __builtin_bit_cast(float, __builtin_amdgcn_update_dpp(0, __builtin_bit_cast(int, b0 ? x2[0] : x2[1]), 0xB1, 0xf, 0xf, false));
          ssq += __shfl_xor(ssq, 16); ssq += __shfl_xor(ssq, 32); }
#pragma unroll
        for (int j = 0; j < 16; ++j) {
            const float t = nkx[j] * kkw; const float kn = t * __builtin_amdgcn_rsqf(fmaxf(__builtin_bit_cast(float, __builtin_amdgcn_readlane(__builtin_bit_cast(int, ssq), j)), 1e-24f));
            bb += nlw[j]; eb = __expf(bb); const float einv = __builtin_amdgcn_rcpf(eb);
            const float beta = kn * nav[j], kdv = nkx[j] * (1.f + (nav[j] - 1.f) * kaw);
            *(LAS unsigned short*)(da + j * 128 + dpos) = (unsigned short)f2bf(kn * ebprev);
            *(LAS unsigned short*)(da + (16 + j) * 128 + dpos) = (unsigned short)f2bf(nrx[j] * eb);
            *(LAS unsigned short*)(gb + j * 128 + dpos) = (unsigned short)f2bf(beta * einv);
            *(LAS unsigned short*)(gb + (16 + j) * 128 + dpos) = (unsigned short)f2bf(kdv * einv);
            upf[8 * (j >> 2) + (j & 3)] = -beta * einv; upf[8 * (j >> 2) + 4 + (j & 3)] = kdv * einv;
            ebprev = eb;
        }
        const float eE = eb;
        { v4u* d = (v4u*)(img + R5_UPA + lane * 16);
#pragma unroll
          for (int u = 0; u < 4; ++u) d[64 * u] = (v4u){pk2(upf[8 * u] * eE, upf[8 * u + 1] * eE), pk2(upf[8 * u + 2] * eE, upf[8 * u + 3] * eE), pk2(upf[8 * u + 4] * eE, upf[8 * u + 5] * eE), pk2(upf[8 * u + 6] * eE, upf[8 * u + 7] * eE)}; }
        ((float*)(img + R5_GE))[lane] = eE;
        if (it + NGW < 64 * R5_NCH) ld(it + NGW);
        LDS_WAIT(); asm volatile("" ::: "memory");
        { v4u* d = (v4u*)(img + R5_DOTA);
#pragma unroll
          for (int u = 0; u < 4; ++u) d[64 * u + lane] = ((const LAS v4u*)da)[64 * u + lane]; }
#pragma unroll
        for (int rb = 0; rb < 2; ++rb)
#pragma unroll
            for (int cb = 0; cb < 2; ++cb) { f32x4 Gt = (f32x4){0.f, 0.f, 0.f, 0.f};
#pragma unroll
                for (int s = 0; s < 2; ++s) Gt = mfma16(*(const LAS bf16x8_t*)(da + (16 * rb + m) * 128 + (s * 4 + q) * 16), *(const LAS bf16x8_t*)(gb + (16 * cb + m) * 128 + (s * 4 + q) * 16), Gt);
#pragma unroll
                for (int jp = 0; jp < 4; ++jp) GL[(16 * rb + 4 * q + jp) * 32 + 16 * cb + m] = Gt[jp]; }
        LDS_WAIT(); asm volatile("" ::: "memory");
        const int c = lane & 15; float Tc[16];
#pragma unroll
        for (int j = 0; j < 16; ++j) { float t = (j == c) ? 1.f : 0.f;
#pragma unroll
            for (int i4 = 0; i4 < (j + 3) / 4; ++i4) { const f32x4 rr = *(const LAS f32x4*)(GL + j * 32 + 4 * i4);
#pragma unroll
                for (int e = 0; e < 4; ++e) if (4 * i4 + e < j) t -= rr[e] * Tc[4 * i4 + e]; }
            Tc[j] = t; }
        int mo = lane & 15, qo = lane >> 4; asm volatile("" : "+v"(mo), "+v"(qo));
        __builtin_amdgcn_sched_barrier(0);
        f32x4 M2v = (f32x4){0.f, 0.f, 0.f, 0.f};
#pragma unroll
        for (int s4 = 0; s4 < 4; ++s4) { const int k = 4 * s4 + qo;
            const float av = (k <= mo) ? -GL[(16 + mo) * 32 + k] : 0.f;
            const float bv = (qo == 0) ? Tc[4 * s4] : (qo == 1) ? Tc[4 * s4 + 1] : (qo == 2) ? Tc[4 * s4 + 2] : Tc[4 * s4 + 3];
            M2v = __builtin_amdgcn_mfma_f32_16x16x4f32(av, bv, M2v, 0, 0, 0); }
        __builtin_amdgcn_sched_barrier(0);
        if (lane < 16) {
#pragma unroll
            for (int j = 0; j < 16; ++j) { *(LAS unsigned short*)(a12 + 1024 + j * 32 + mo * 2) = (unsigned short)f2bf(Tc[j]); TM[j * 16 + mo] = Tc[j]; } }
#pragma unroll
        for (int r = 0; r < 4; ++r) { const int jr = 4 * qo + r; *(LAS unsigned short*)(a12 + 1024 + (16 + jr) * 32 + mo * 2) = (unsigned short)f2bf(M2v[r]); TM[(16 + jr) * 16 + mo] = M2v[r]; }
        LDS_WAIT(); asm volatile("" ::: "memory");
#pragma unroll
        for (int rb = 0; rb < 2; ++rb) { __builtin_amdgcn_sched_barrier(0); f32x4 E = (f32x4){0.f, 0.f, 0.f, 0.f};
#pragma unroll
            for (int s4 = 0; s4 < 4; ++s4) { const int k = 4 * s4 + qo;
                const float av = TM[(16 * rb + mo) * 16 + k];
                const float bv = (mo < k) ? GL[k * 32 + 16 + mo] : 0.f;
                E = __builtin_amdgcn_mfma_f32_16x16x4f32(av, bv, E, 0, 0, 0); }
#pragma unroll
            for (int r = 0; r < 4; ++r) { const int jr = 4 * qo + r; float v = E[r];
                if (rb == 1) v += (mo <= jr) ? GL[(16 + jr) * 32 + 16 + mo] : 0.f;
                *(LAS unsigned short*)(a12 + (16 * rb + jr) * 32 + mo * 2) = (unsigned short)f2bf(v); } }
        LDS_WAIT(); asm volatile("" ::: "memory");
        { v4u* d = (v4u*)(img + R5_A21); d[lane] = ((const LAS v4u*)a12)[lane]; d[64 + lane] = ((const LAS v4u*)a12)[64 + lane]; }
        LDS_WAIT(); asm volatile("" ::: "memory");
    }
}
constexpr int R7_SLOT = 12288, R7_NPC = 11;
__device__ __forceinline__ void phase_rwkv_scan7(PP p, LAS unsigned char* lds, int vcu, int tid, int lane, int wave) {
    const int m = lane & 15, q = lane >> 4;
    constexpr int NB5 = R5_NCH / R5_NCB;
    const int nsc = ((int)gridDim.x + 1) >> 1, ncv = (int)gridDim.x >> 1;
    if (vcu & 1) {
        LAS float* scr = (LAS float*)(lds + wave * 16384);
        const int cw = vcu >> 1, NGW = ncv * NWAVES; int it = cw * NWAVES + wave;
#ifdef PROBE_NOCONV_REPEAT
        if (*(volatile LAS int*)(lds + LDS_BYTES - 32) != 0) it = IT_L1MOE;
#endif
        ConvJob j0{}, j1{}, j2{}; f32x4 r0[8], r1[8], r2[8];
        if (it < IT_L1MOE) { j0 = conv_job_l1(p, it); ti_load4(j0.src, j0.src_ld, lane, r0); }
        if (it + NGW < IT_L1MOE) { j1 = conv_job_l1(p, it + NGW); ti_load4(j1.src, j1.src_ld, lane, r1); }
        if (it + 2 * NGW < IT_L1MOE) { j2 = conv_job_l1(p, it + 2 * NGW); ti_load4(j2.src, j2.src_ld, lane, r2); }
        for (; it < IT_L1MOE; it += 3 * NGW) {
            { const ConvJob cj = j0; f32x4 c[8];
#pragma unroll
              for (int i = 0; i < 8; ++i) c[i] = r0[i];
              if (it + 3 * NGW < IT_L1MOE) { j0 = conv_job_l1(p, it + 3 * NGW); ti_load4(j0.src, j0.src_ld, lane, r0); }
              ti_store4_fp8(c, cj.dst, cj.dst_ldb, scr, lane); }
            if (it + NGW < IT_L1MOE) { const ConvJob cj = j1; f32x4 c[8];
#pragma unroll
              for (int i = 0; i < 8; ++i) c[i] = r1[i];
              if (it + 4 * NGW < IT_L1MOE) { j1 = conv_job_l1(p, it + 4 * NGW); ti_load4(j1.src, j1.src_ld, lane, r1); }
              ti_store4_fp8(c, cj.dst, cj.dst_ldb, scr, lane); }
            if (it + 2 * NGW < IT_L1MOE) { const ConvJob cj = j2; f32x4 c[8];
#pragma unroll
              for (int i = 0; i < 8; ++i) c[i] = r2[i];
              if (it + 5 * NGW < IT_L1MOE) { j2 = conv_job_l1(p, it + 5 * NGW); ti_load4(j2.src, j2.src_ld, lane, r2); }
              ti_store4_fp8(c, cj.dst, cj.dst_ldb, scr, lane); }
        }
        return;
    }
    const unsigned char* IMG = p->ws + WS_U + U_IMG;
    for (int su = vcu >> 1; su < 128; su += nsc) {
        const int chain = su >> 1, pair = su & 1;
        const unsigned char* cimg = IMG + (size_t)chain * R5_NCH * R5_IMG;
        const unsigned char* vb = p->ws + WS_U + U_RKV + 4096 + (chain & 15) * 128 + pair * 64;
        const int li = (wave == 2) ? 0 : (wave == 3) ? 1 : (wave == 6) ? 2 : -1;
        auto issue = [&](int bt) {
            const unsigned char* ci = cimg + (size_t)(bt * R5_NCB + li) * R5_IMG;
            LAS unsigned char* dl = lds + ((bt % R5_NST) * R5_NCB + li) * R7_SLOT;
#pragma unroll
            for (int k = 0; k < R7_NPC; ++k) { const int pi = k * 64 + lane;
                const unsigned char* src = ci + (pi < 656 ? pi * 16 : 0);
                __builtin_amdgcn_global_load_lds((const unsigned*)src, (LAS unsigned*)(dl + k * 1024), 16, 0, 0); } };
        struct VS { unsigned x0, x1, x2, x3, x4, x5, x6, x7; };
        auto vload = [&](int bt, VS& r) {
            const unsigned char* a[4];
#pragma unroll
            for (int i = 0; i < 4; ++i) a[i] = vb + (size_t)step_row(chain >> 5, (chain >> 4) & 1, (bt * R5_NCB + li) * 16 + 4 * (lane >> 4) + i) * 6144 + (lane & 15) * 2;
            asm volatile("global_load_ushort %0, %1, off" : "=v"(r.x0) : "v"(a[0]) : "memory");
            asm volatile("global_load_ushort %0, %1, off" : "=v"(r.x1) : "v"(a[1]) : "memory");
            asm volatile("global_load_ushort %0, %1, off" : "=v"(r.x2) : "v"(a[2]) : "memory");
            asm volatile("global_load_ushort %0, %1, off" : "=v"(r.x3) : "v"(a[3]) : "memory");
            asm volatile("global_load_ushort %0, %1, off offset:32" : "=v"(r.x4) : "v"(a[0]) : "memory");
            asm volatile("global_load_ushort %0, %1, off offset:32" : "=v"(r.x5) : "v"(a[1]) : "memory");
            asm volatile("global_load_ushort %0, %1, off offset:32" : "=v"(r.x6) : "v"(a[2]) : "memory");
            asm volatile("global_load_ushort %0, %1, off offset:32" : "=v"(r.x7) : "v"(a[3]) : "memory"); };
        auto vput = [&](int bt, VS& r) {
            asm volatile("" : "+v"(r.x0), "+v"(r.x1), "+v"(r.x2), "+v"(r.x3), "+v"(r.x4), "+v"(r.x5), "+v"(r.x6), "+v"(r.x7) :: "memory");
            LAS unsigned char* d = lds + ((bt % R5_NST) * R5_NCB + li) * R7_SLOT + R5_VT + lane * 8;
            *(LAS v2u*)d = (v2u){r.x0 | (r.x1 << 16), r.x2 | (r.x3 << 16)}; *(LAS v2u*)(d + 512) = (v2u){r.x4 | (r.x5 << 16), r.x6 | (r.x7 << 16)}; };
        VS va = {0u, 0u, 0u, 0u, 0u, 0u, 0u, 0u}, vc = {0u, 0u, 0u, 0u, 0u, 0u, 0u, 0u};
        __syncthreads();
        if (li >= 0) { vload(0, va); issue(0); vload(1, vc); issue(1); asm volatile("s_waitcnt vmcnt(19)" ::: "memory"); vput(0, va); }
        __syncthreads();
        if (wave >= 2) {
            if (li >= 0) {
                for (int bt = 0; bt < NB5; bt += 2) {
                    if (bt + 2 < NB5) { vload(bt + 2, va); issue(bt + 2); asm volatile("s_waitcnt vmcnt(19)" ::: "memory"); } else asm volatile("s_waitcnt vmcnt(0)" ::: "memory");
                    if (bt + 1 < NB5) vput(bt + 1, vc);
                    asm volatile("s_waitcnt lgkmcnt(0)" ::: "memory"); __builtin_amdgcn_s_barrier(); asm volatile("" ::: "memory");
                    if (bt + 3 < NB5) { vload(bt + 3, vc); issue(bt + 3); asm volatile("s_waitcnt vmcnt(19)" ::: "memory"); } else asm volatile("s_waitcnt vmcnt(0)" ::: "memory");
                    if (bt + 2 < NB5) vput(bt + 2, va);
                    asm volatile("s_waitcnt lgkmcnt(0)" ::: "memory"); __builtin_amdgcn_s_barrier(); asm volatile("" ::: "memory");
                }
            } else {
                for (int bt = 0; bt < NB5; ++bt) { asm volatile("s_waitcnt lgkmcnt(0)" ::: "memory"); __builtin_amdgcn_s_barrier(); asm volatile("" ::: "memory"); }
            }
        } else {
            const int unit = chain * 4 + pair * 2 + wave;
            unsigned* YST = (unsigned*)(p->ws + WS_U + U_YST) + (size_t)unit * NSTEP * 8 + q * 16 + m;
            f32x4 S[4];
#pragma unroll
            for (int T = 0; T < 4; ++T) S[T] = (f32x4){0.f, 0.f, 0.f, 0.f};
            __builtin_amdgcn_s_setprio(3);
            for (int bt = 0; bt < NB5; ++bt) {
                struct OpsE { bf16x8_t a[2][2]; bf16x4_t e21[2]; v2u vr; };
                struct OpsL { bf16x4_t a2[2]; bf16x8_t UA[4]; f32x4 ge[4]; };
                auto rdE = [&](int cc, OpsE& o) {
                    const LAS unsigned char* sl = lds + ((bt % R5_NST) * R5_NCB + cc) * R7_SLOT;
#pragma unroll
                    for (int rb = 0; rb < 2; ++rb) {
#pragma unroll
                        for (int s = 0; s < 2; ++s) o.a[rb][s] = *(const LAS bf16x8_t*)(sl + R5_DOTA + (16 * rb + m) * 128 + (s * 4 + q) * 16);
                        o.e21[rb] = *(const LAS bf16x4_t*)(sl + R5_A21 + (16 * rb + m) * 32 + q * 8); }
                    o.vr = *(const LAS v2u*)(sl + R5_VT + wave * 512 + q * 128 + m * 8); };
                auto rdL = [&](int cc, OpsL& o) {
                    const LAS unsigned char* sl = lds + ((bt % R5_NST) * R5_NCB + cc) * R7_SLOT;
#pragma unroll
                    for (int rb = 0; rb < 2; ++rb) o.a2[rb] = *(const LAS bf16x4_t*)(sl + R5_A2 + (16 * rb + m) * 32 + q * 8);
#pragma unroll
                    for (int T = 0; T < 4; ++T) { o.UA[T] = *(const LAS bf16x8_t*)(sl + R5_UPA + q * 1024 + (16 * T + m) * 16); o.ge[T] = *(const LAS f32x4*)(sl + R5_GE + (16 * T + 4 * q) * 4); } };
                OpsE cur, nxt; OpsL L; rdE(0, cur);
#pragma unroll
                for (int cc = 0; cc < R5_NCB; ++cc) {
                    rdL(cc, L);
                    if (cc + 1 < R5_NCB) rdE(cc + 1, nxt);
                    __builtin_amdgcn_sched_barrier(0);
                    v4u b0, b1;
                    b0.x = cvtpk(S[0][0], S[0][1]); b0.y = cvtpk(S[0][2], S[0][3]); b0.z = cvtpk(S[1][0], S[1][1]); b0.w = cvtpk(S[1][2], S[1][3]);
                    b1.x = cvtpk(S[2][0], S[2][1]); b1.y = cvtpk(S[2][2], S[2][3]); b1.z = cvtpk(S[3][0], S[3][1]); b1.w = cvtpk(S[3][2], S[3][3]);
                    const f32x4 z4 = (f32x4){0.f, 0.f, 0.f, 0.f};
                    const v2u vb = cur.vr;
                    f32x4 D0 = mfma16(cur.a[0][0], __builtin_bit_cast(bf16x8_t, b0), z4), D1 = mfma16(cur.a[1][0], __builtin_bit_cast(bf16x8_t, b0), z4);
                    const f32x4 E0 = __builtin_amdgcn_mfma_f32_16x16x16bf16_1k(cur.e21[0], __builtin_bit_cast(bf16x4_t, vb), z4, 0, 0, 0);
                    D0 = mfma16(cur.a[0][1], __builtin_bit_cast(bf16x8_t, b1), D0); D1 = mfma16(cur.a[1][1], __builtin_bit_cast(bf16x8_t, b1), D1);
                    const f32x4 E1 = __builtin_amdgcn_mfma_f32_16x16x16bf16_1k(cur.e21[1], __builtin_bit_cast(bf16x4_t, vb), D1, 0, 0, 0);
                    v2u db; db.x = cvtpk(D0[0], D0[1]); db.y = cvtpk(D0[2], D0[3]);
                    const f32x4 W0 = __builtin_amdgcn_mfma_f32_16x16x16bf16_1k(L.a2[0], __builtin_bit_cast(bf16x4_t, db), E0, 0, 0, 0);
                    const f32x4 W1 = __builtin_amdgcn_mfma_f32_16x16x16bf16_1k(L.a2[1], __builtin_bit_cast(bf16x4_t, db), E1, 0, 0, 0);
                    v4u ub; ub.x = cvtpk(W0[0], W0[1]); ub.y = cvtpk(W0[2], W0[3]); ub.z = vb.x; ub.w = vb.y;
#pragma unroll
                    for (int T = 0; T < 4; ++T) S[T] = mfma16(L.UA[T], __builtin_bit_cast(bf16x8_t, ub), S[T] * L.ge[T]);
                    { unsigned* yp = YST + (size_t)(bt * R5_NCB + cc) * 128;
                      typedef __fp16 h2_t __attribute__((ext_vector_type(2)));
                      const h2_t p01 = __builtin_amdgcn_cvt_pkrtz(W1[0], W1[1]), p23 = __builtin_amdgcn_cvt_pkrtz(W1[2], W1[3]);
                      yp[0] = __builtin_bit_cast(unsigned, p01); yp[64] = __builtin_bit_cast(unsigned, p23); }
                    if (cc + 1 < R5_NCB) cur = nxt;
                }
                asm volatile("s_waitcnt lgkmcnt(0)" ::: "memory"); __builtin_amdgcn_s_barrier(); asm volatile("" ::: "memory");
            }
            __builtin_amdgcn_s_setprio(0);
        }
    }
}
enum { PH_PRE = 0, PH_NORM0, PH_G_IN, PH_GLA_A, PH_GLA_B, PH_GLA_C, PH_G_HGO, PH_FFN0, PH_GU0, PH_DN0, PH_COMB0,
       PH_LERP, PH_G_RKV, PH_G_L2, PH_RWPREP, PH_RWSCAN, PH_RWRO, PH_G_RWO, PH_FFN1, PH_GU1, PH_DN1, PH_COMB1, NPHASES };

template <int ph> __device__ __forceinline__ void run_phase(PP p, LAS unsigned char* lds, int tid, int lane, int wave, int G, int bx, int vcu) {
    unsigned char* ws = p->ws;
    typedef pg8::bf16_t bt;
    switch (ph) {
        case PH_PRE: phase_pre(p, lds, tid, lane, wave); break;
        case PH_NORM0: phase_norm0(p, lane, wave); break;
        case PH_G_IN: {
            pg8::Gemm g{(const bt*)(ws + WS_H), (const bt*)(ws + WS_WIN), NROW, 5120, D / 2}; pg8::StaticOrder S; S.init(NROW, 5120, G, bx);
            pg8::EpiStoreBf16 E{(bt*)(ws + WS_U + U_Z), 5120};
            pg8::gemm_phase<pg8::EpiStoreBf16, pg8::StaticOrder, true, true, true>(lds, g, S, E); } break;
        case PH_GLA_A: phase_gla_prep(p, lds, tid, lane, wave); break;
        case PH_GLA_B: phase_gla_scan(p, tid); break;
        case PH_GLA_C: phase_gla_out(p, lds, tid, lane, wave); break;
        case PH_G_HGO: {
            pg8::Gemm g{(const bt*)(ws + WS_A2), (const bt*)(ws + WS_WHGO), NROW, D, D}; pg8::StaticOrder S; S.init(NROW, D, G, bx);
            pg8::EpiResid E{p->in[I_X], p->in[I_CTX], (float*)(ws + WS_XR), modp(p, 0, 0, 2), 6144};
            pg8::gemm_phase<pg8::EpiResid, pg8::StaticOrder, true, true>(lds, g, S, E); } break;
        case PH_FFN0: phase_ffn_norm_route4(p, 0, NROW, lds, tid, lane, wave); break;
        case PH_FFN1: phase_ffn_norm_route4(p, 1, NLAT, lds, tid, lane, wave); break;
        case PH_GU0: case PH_GU1: { const int layer = (ph == PH_GU1);
            pg8::Gemm g{(const bt*)(ws + WS_U + U_XB), (const bt*)(ws + WS_WGU + (size_t)layer * NE * 2048 * D), CAP, 2048, D / 2};
            const int ntl = (int)((const unsigned*)(ws + WS_CTL))[CW_NT + layer];
            pg8::MoeOrder S; S.init((const int*)(ws + WS_ROUTE + RT_TILEE) + layer * 512, ntl, (LAS int*)(lds + 132096), 8, (size_t)2048 * D, G, vcu);
            pg8::EpiSwiglu E{p, layer};
            pg8::gemm_phase<pg8::EpiSwiglu, pg8::MoeOrder, true, true, true, true>(lds, g, S, E); } break;
        case PH_DN0: case PH_DN1: { const int layer = (ph == PH_DN1);
            pg8::Gemm g{(const bt*)(ws + WS_U + U_ACT), (const bt*)(ws + WS_WD + (size_t)layer * NE * D * D), CAP, D, D / 2};
            const int ntl = (int)((const unsigned*)(ws + WS_CTL))[CW_NT + layer];
            pg8::MoeOrder S; S.init((const int*)(ws + WS_ROUTE + RT_TILEE) + layer * 512, ntl, (LAS int*)(lds + 132096), 4, (size_t)D * D, G, vcu);
            pg8::EpiDown E{p, layer};
            pg8::gemm_phase<pg8::EpiDown, pg8::MoeOrder, true, true, true, true>(lds, g, S, E); } break;
        case PH_COMB0: phase_combine(p, 0, NROW, false, lane, wave); break;
        case PH_COMB1: phase_combine(p, 1, NLAT, true, lane, wave); break;
        case PH_LERP: phase_lerp(p, lds, tid, lane, wave); break;
        case PH_G_RKV: {
            pg8::Gemm g{(const bt*)(ws + WS_U + U_XL6), (const bt*)(ws + WS_WRKV), NROW, 3072, D};
            pg8::RkvL1Order S; S.init(NROW, G, bx, (const bt*)(ws + WS_WL1), (size_t)NROW * D * 2);
            pg8::EpiRkvL1 E{pg8::EpiStoreBf16{(bt*)(ws + WS_U + U_RKV), 3072}, pg8::EpiLora1{(bt*)(ws + WS_U + U_L1)}};
            pg8::gemm_phase<pg8::EpiRkvL1, pg8::RkvL1Order, true, true>(lds, g, S, E); } break;
        case PH_G_L2: phase_lora2(p, lds, tid, lane, wave); break;
        case PH_RWPREP: phase_rw_prep5(p, lds, lane, wave); break;
        case PH_RWSCAN: phase_rwkv_scan7(p, lds, vcu, tid, lane, wave); break;
        case PH_RWRO: phase_rw_readout(p, lane, wave); break;
        case PH_G_RWO: {
            pg8::Gemm g{(const bt*)(ws + WS_A2), (const bt*)(ws + WS_WRWO), NLAT, D, D}; pg8::StaticOrder S; S.init(NLAT, D, G, bx);
            float* XR = (float*)(ws + WS_XR);
            pg8::EpiResid E{XR, XR + (size_t)NLAT * D, XR, modp(p, 1, 0, 2), 6144};
            pg8::gemm_phase<pg8::EpiResid, pg8::StaticOrder, true, true>(lds, g, S, E); } break;
        default: break;
    }
}

#define MK_PROLOGUE \
    extern __shared__ __attribute__((aligned(16))) unsigned char lds_raw[]; \
    LAS unsigned char* lds = (LAS unsigned char*)lds_raw; \
    const int tid = threadIdx.x, lane = tid & 63, wave = __builtin_amdgcn_readfirstlane(tid >> 6); \
    const int G = gridDim.x, bx = blockIdx.x, vcu = (G % 8 == 0) ? (bx % 8) * (G / 8) + bx / 8 : bx;

#define XB_TMO      128
#define XB_XCNT(j)  (256  + 64 * (j))
#define XB_XSUB(j)  (1280 + 64 * (j))
#define XB_XGEN(j)  (2304 + 64 * (j))
#define XB_TOP      3328
#define XB_TOPGEN   3392
#define XCD_BAR_WORDS 3456
#define XB_SPIN_CAP (1u << 18)

__device__ __forceinline__ unsigned xb_ld(unsigned* p)              { return __hip_atomic_load(p, __ATOMIC_RELAXED, __HIP_MEMORY_SCOPE_AGENT); }
__device__ __forceinline__ unsigned xb_add(unsigned* p, unsigned v) { return __hip_atomic_fetch_add(p, v, __ATOMIC_RELAXED, __HIP_MEMORY_SCOPE_AGENT); }
__device__ __forceinline__ unsigned xb_xcc_id() { return (unsigned)__builtin_amdgcn_s_getreg((3 << 11) | 20) & 0xFu; }
#define XB_SPIN(cond, bar) do { unsigned _sp = 0; while (cond) { __builtin_amdgcn_s_sleep(1); \
    if ((++_sp & 255u) == 0u) { if (xb_ld(&(bar)[XB_TMO])) break; if (_sp > XB_SPIN_CAP) { atomicAdd(&(bar)[XB_TMO], 1u); break; } } } } while (0)

struct XcdBarrier {
    unsigned* bar; unsigned x;
    volatile LAS unsigned* st;
};

__device__ __forceinline__ XcdBarrier xcd_barrier_post(unsigned* bar, volatile LAS unsigned* st) {
    XcdBarrier b; b.bar = bar; b.x = xb_xcc_id(); b.st = st;
    if (threadIdx.x == 0) (void)xb_add(&bar[XB_XCNT(b.x)], 1u);
    return b;
}
__device__ __forceinline__ void xcd_barrier_complete(unsigned* bar, unsigned x, unsigned& nloc, unsigned& nx) {
    const unsigned G = gridDim.x * gridDim.y * gridDim.z;
    unsigned sum, cnt, mine, sp = 0u;
    for (;;) {
        sum = 0u; cnt = 0u; mine = 0u;
#pragma unroll
        for (unsigned j = 0; j < 16; ++j) { const unsigned c = xb_ld(&bar[XB_XCNT(j)]); sum += c; cnt += (c > 0u) ? 1u : 0u; mine = (j == x) ? c : mine; }
        if (sum == G) break;
        __builtin_amdgcn_s_sleep(1);
        if ((++sp & 255u) == 0u) { if (xb_ld(&bar[XB_TMO])) break; if (sp > XB_SPIN_CAP) { atomicAdd(&bar[XB_TMO], 1u); break; } }
    }
    nloc = mine > 0u ? mine : 1u; nx = cnt > 0u ? cnt : 1u;
}

__device__ __forceinline__ void xcd_barrier(const XcdBarrier& b) {
    asm volatile("s_waitcnt vmcnt(0)" ::: "memory");
    __syncthreads();
    if (threadIdx.x == 0) {
        unsigned* bar = b.bar;
        __builtin_amdgcn_s_waitcnt(0);
        unsigned nloc = b.st[0], nx = b.st[1];
        if (nloc == 0u) { xcd_barrier_complete(bar, b.x, nloc, nx); b.st[0] = nloc; b.st[1] = nx; }
        const unsigned old = xb_add(&bar[XB_XSUB(b.x)], 1u);
        const unsigned gen = old / nloc;
        if (old + 1u == (gen + 1u) * nloc) {
            __builtin_amdgcn_fence(__ATOMIC_RELEASE, "agent");
            asm volatile("s_waitcnt vmcnt(0)" ::: "memory");
            const unsigned og = xb_add(&bar[XB_TOP], 1u);
            const unsigned tg = og / nx;
            if (og + 1u == (tg + 1u) * nx) xb_add(&bar[XB_TOPGEN], 1u);
            else XB_SPIN(xb_ld(&bar[XB_TOPGEN]) == tg, bar);
            __builtin_amdgcn_fence(__ATOMIC_ACQUIRE, "agent");
            xb_add(&bar[XB_XGEN(b.x)], 1u);
            asm volatile("s_waitcnt vmcnt(0)" ::: "memory");
        } else {
            XB_SPIN(xb_ld(&bar[XB_XGEN(b.x)]) == gen, bar);
            __builtin_amdgcn_fence(__ATOMIC_ACQUIRE, "agent");
            asm volatile("s_waitcnt vmcnt(0)" ::: "memory");
        }
    }
    __syncthreads();
}

constexpr int LDSCTL_OFF = 131072, MISC_OFF = LDSCTL_OFF + 320;
__device__ __forceinline__ void grid_bar(PP kp, LAS unsigned char* lds) {
    PP q = kp; asm volatile("" : "+s"(q));
    XcdBarrier b; b.bar = (unsigned*)(q->ws + WS_CTL) + CW_BAR; b.x = xb_xcc_id(); b.st = (volatile LAS unsigned*)(lds + LDS_BYTES - 64);
    xcd_barrier(b);
}
namespace cg = cooperative_groups;
__global__ void __launch_bounds__(NTHREADS, 2) mk_fwd(Params pv) {
    MK_PROLOGUE
    cg::grid_group grid = cg::this_grid();
    PP kp = (PP)__builtin_amdgcn_kernarg_segment_ptr();
    const int lo = kp->ph_lo, hi = kp->ph_hi;
    for (int u = tid; u < (LDS_BYTES - LDSCTL_OFF) / 4; u += NTHREADS) ((LAS unsigned*)(lds + LDSCTL_OFF))[u] = 0u;
    __syncthreads();
    { XcdBarrier b0 = xcd_barrier_post((unsigned*)(kp->ws + WS_CTL) + CW_BAR, (volatile LAS unsigned*)(lds + LDS_BYTES - 64)); (void)b0; }
#ifndef REPEAT_MASK
#define REPEAT_MASK 0u
#endif
#define RUN(k) if (lo <= (k) && (k) < hi) { PP q = kp; asm volatile("" : "+s"(q)); run_phase<k>(q, lds, tid, lane, wave, G, bx, vcu); \
        if ((REPEAT_MASK >> (k)) & 1u) { grid_bar(kp, lds); PP q2 = kp; asm volatile("" : "+s"(q2)); run_phase<k>(q2, lds, tid, lane, wave, G, bx, vcu); } \
        if ((k) + 1 < hi) { if ((k) == 0) grid.sync(); else grid_bar(kp, lds); } }
    RUN(0) RUN(1) RUN(2) RUN(3) RUN(4) RUN(5) RUN(6) RUN(7) RUN(8) RUN(9) RUN(10) RUN(11) RUN(12) RUN(13) RUN(14) RUN(15) RUN(16) RUN(17) RUN(18) RUN(19) RUN(20) RUN(21)
#undef RUN
}

extern "C" void kernel_launch(void* const* d_in, const int* in_sizes, int n_in, void* d_out, int out_size, void* d_ws, size_t ws_size, hipStream_t stream) {
    static int grid = 0;
    if (grid == 0) {
        if (n_in != 35 || in_sizes[0] != NLAT * D || out_size != NLAT * D || ws_size < WS_END) {
            fprintf(stderr, "kernel_launch: unexpected problem (n_in %d, in0 %d, out %d, ws %zu < %zu)\n", n_in, n_in > 0 ? in_sizes[0] : -1, out_size, ws_size, (size_t)WS_END); grid = -1; return; }
        int dev = 0, cus = 0, per_cu = 0;
        if (hipGetDevice(&dev) != hipSuccess || hipDeviceGetAttribute(&cus, hipDeviceAttributeMultiprocessorCount, dev) != hipSuccess) { grid = -1; return; }
        if (hipFuncSetAttribute((const void*)mk_fwd, hipFuncAttributeMaxDynamicSharedMemorySize, LDS_BYTES) != hipSuccess) { fprintf(stderr, "kernel_launch: hipFuncSetAttribute failed\n"); grid = -1; return; }
        if (hipOccupancyMaxActiveBlocksPerMultiprocessor(&per_cu, (const void*)mk_fwd, NTHREADS, LDS_BYTES) != hipSuccess || per_cu < 1) { fprintf(stderr, "kernel_launch: occupancy query %d\n", per_cu); per_cu = 1; }
        (void)hipGetLastError();
        grid = cus * (per_cu < 1 ? 1 : per_cu);
    }
    if (grid < 0) return;
    (void)hipMemsetAsync((char*)d_ws + WS_CTL, 0, CTL_ZERO_BYTES, stream);
    Params p{};
    for (int i = 0; i < 35; ++i) p.in[i] = (const float*)d_in[i];
    p.out = (float*)d_out; p.ws = (unsigned char*)d_ws;
    p.ph_lo = 0; p.ph_hi = NPHASES;
    void* args[] = {&p};
    hipError_t e = hipLaunchCooperativeKernel((const void*)mk_fwd, dim3(grid), dim3(NTHREADS), args, LDS_BYTES, stream);
    if (e != hipSuccess) fprintf(stderr, "kernel_launch: cooperative launch failed: %s (grid %d)\n", hipGetErrorString(e), grid);
}
```
